# Optimizing an MI355X kernel written in HIP

```python
import jax, jax.numpy as jnp
from jax import lax
import numpy as np

D_MODEL = 1024
BATCH = 1
SEQ = 16384
DEPTH = 2

GRID_W = 64
CTX_LEN = 256
N_EVEN = (DEPTH + 1) // 2
N_ODD = DEPTH // 2
EPS = 1e-6
ADA_SCALE = 0.3

CONV_CH = D_MODEL // 2
CONV_W = 3
HEAD_DIM = 64
N_Q_HEADS = (D_MODEL // 2) // HEAD_DIM
N_KV_HEADS = 2
GQA_GROUP = N_Q_HEADS // N_KV_HEADS
Q_DIM = N_Q_HEADS * HEAD_DIM
KV_DIM = N_KV_HEADS * HEAD_DIM
WINDOW = 128
ATT_BLOCK = 128
ROPE_BASE = 10000.0
ROPE_PAIRS = HEAD_DIM // 4
AB_SPLITS = [CONV_CH, 2 * CONV_CH, 3 * CONV_CH, 3 * CONV_CH + Q_DIM, 3 * CONV_CH + Q_DIM + KV_DIM]
KV_OFF = 3 * CONV_CH + Q_DIM
AB_IN = 3 * CONV_CH + Q_DIM + 2 * KV_DIM
AB_OUT = CONV_CH + Q_DIM
D_FF = 2816
D_INNER = 2 * D_MODEL
SSD_HEADDIM = 64
SSD_HEADS = D_INNER // SSD_HEADDIM
SSD_GROUPS = 4
SSD_REP = SSD_HEADS // SSD_GROUPS
SSD_STATE = 128
SSD_CHUNK = 128
SSD_CONV_W = 3
GN_DIM = SSD_GROUPS * SSD_STATE
XB_DIM = D_INNER + GN_DIM
SSD_CONV_DIM = D_INNER + 2 * GN_DIM
DT_OFF = D_INNER + SSD_CONV_DIM
SSD_IN = DT_OFF + 2 * SSD_HEADS
N_EXPERTS = 8
TOP_K = 2
D_FF_EXPERT = 3584

kernel_name = "hybrid_conv_swa_ssd_moe_dit_block"


def rmsnorm(x, g):
    xf = x.astype(jnp.float32)
    y = xf * lax.rsqrt(jnp.mean(xf * xf, axis=-1, keepdims=True) + EPS)
    return y.astype(x.dtype) * g


def modulate(x, g, shift, scale):
    return rmsnorm(x, g) * (1 + scale) + shift


def conv_centered(u, w, bias=None):
    k_w = w.shape[0]
    pad = k_w // 2
    L = u.shape[1]
    up = jnp.pad(u, ((0, 0), (pad, pad), (0, 0)))
    y = up[:, 0:L] * w[0]
    for k in range(1, k_w):
        y = y + up[:, k:k + L] * w[k]
    if bias is not None:
        y = y + bias
    return y


def heads(t, n):
    return t.reshape(t.shape[:2] + (n, HEAD_DIM))


def rope2d_tables(L):
    rows = L // GRID_W
    row = jnp.repeat(jnp.arange(rows, dtype=jnp.float32), GRID_W)
    col = jnp.tile(jnp.arange(GRID_W, dtype=jnp.float32), rows)
    inv = ROPE_BASE ** (-jnp.arange(ROPE_PAIRS, dtype=jnp.float32) / ROPE_PAIRS)
    ang = jnp.stack([row, col], axis=-1)[..., None] * inv
    return jnp.cos(ang), jnp.sin(ang)


def apply_rope2d(x, cos, sin):
    b, L, H, _ = x.shape
    xr = x.reshape(b, L, H, 2, 2, ROPE_PAIRS)
    x1, x2 = xr[..., 0, :], xr[..., 1, :]
    cs, sn = cos[:, None], sin[:, None]
    out = jnp.stack([x1 * cs - x2 * sn, x2 * cs + x1 * sn], axis=-2)
    return out.reshape(x.shape).astype(x.dtype)


def short_conv_mixer(g_b, g_c, h_a, conv_w):
    return g_b * conv_centered(g_c * h_a, conv_w)


def sink_column(sink, shape):
    s = sink.astype(jnp.float32).reshape((1,) * (len(shape) - 4) + (N_KV_HEADS, GQA_GROUP, 1, 1))
    return jnp.broadcast_to(s, shape[:-1] + (1,))


def context_attention(q, k, v, sink):
    b, lc = q.shape[:2]
    qg = q.reshape(b, lc, N_KV_HEADS, GQA_GROUP, HEAD_DIM)
    s = jnp.einsum('bqhgd,bkhd->bhgqk', qg, k).astype(jnp.float32) * (HEAD_DIM ** -0.5)
    s = jnp.concatenate([s, sink_column(sink, s.shape)], axis=-1)
    p = jax.nn.softmax(s, axis=-1)[..., :-1].astype(v.dtype)
    return jnp.einsum('bhgqk,bkhd->bqhgd', p, v).reshape(b, lc, Q_DIM)


def windowed_attention(q, k, v, kc, vc, sink):
    b, L = q.shape[:2]
    lc = kc.shape[1]
    nb = L // ATT_BLOCK
    qb = q.reshape(b, nb, ATT_BLOCK, N_KV_HEADS, GQA_GROUP, HEAD_DIM)

    def band(t):
        tp = jnp.pad(t, ((0, 0), (ATT_BLOCK, ATT_BLOCK), (0, 0), (0, 0)))
        tp = tp.reshape(b, nb + 2, ATT_BLOCK, N_KV_HEADS, HEAD_DIM)
        return jnp.concatenate([tp[:, :-2], tp[:, 1:-1], tp[:, 2:]], axis=2)

    kb, vb = band(k), band(v)
    scale = HEAD_DIM ** -0.5
    s_loc = jnp.einsum('bnqhgd,bnkhd->bnhgqk', qb, kb).astype(jnp.float32) * scale
    s_ctx = jnp.einsum('bnqhgd,bchd->bnhgqc', qb, kc).astype(jnp.float32) * scale
    blk = jnp.arange(nb)[:, None, None]
    qpos = blk * ATT_BLOCK + jnp.arange(ATT_BLOCK)[None, :, None]
    kpos = (blk - 1) * ATT_BLOCK + jnp.arange(3 * ATT_BLOCK)[None, None, :]
    valid = (jnp.abs(qpos - kpos) <= WINDOW) & (kpos >= 0) & (kpos < L)
    s_loc = jnp.where(valid[None, :, None, None], s_loc, -jnp.inf)
    logits = jnp.concatenate([s_loc, s_ctx, sink_column(sink, s_loc.shape)], axis=-1)
    p = jax.nn.softmax(logits, axis=-1).astype(v.dtype)
    n_loc = 3 * ATT_BLOCK
    o = (jnp.einsum('bnhgqk,bnkhd->bnqhgd', p[..., :n_loc], vb)
         + jnp.einsum('bnhgqc,bchd->bnqhgd', p[..., n_loc:n_loc + lc], vc))
    return o.reshape(b, L, Q_DIM)


def mixer_ab(h, hc, w_in, conv_w, sink, w_out, cos, sin, last):
    if last:
        kc, vc = jnp.split(hc @ w_in[:, KV_OFF:], [KV_DIM], axis=-1)
    else:
        gbc, gcc, hac, qc, kc, vc = jnp.split(hc @ w_in, AB_SPLITS, axis=-1)
    kc, vc = heads(kc, N_KV_HEADS), heads(vc, N_KV_HEADS)
    g_b, g_c, h_a, q, k, v = jnp.split(h @ w_in, AB_SPLITS, axis=-1)
    a_out = short_conv_mixer(g_b, g_c, h_a, conv_w)
    q = apply_rope2d(heads(q, N_Q_HEADS), cos, sin)
    k = apply_rope2d(heads(k, N_KV_HEADS), cos, sin)
    att = windowed_attention(q, k, heads(v, N_KV_HEADS), kc, vc, sink)
    y = jnp.concatenate([a_out, att], axis=-1) @ w_out
    if last:
        return y, None
    ac = short_conv_mixer(gbc, gcc, hac, conv_w)
    attc = context_attention(heads(qc, N_Q_HEADS), kc, vc, sink)
    yc = jnp.concatenate([ac, attc], axis=-1) @ w_out
    return y, yc


def split_xb(xb):
    b, L = xb.shape[:2]
    xs, bm = jnp.split(xb, [D_INNER], axis=-1)
    return xs.reshape(b, L, SSD_HEADS, SSD_HEADDIM), bm.reshape(b, L, SSD_GROUPS, SSD_STATE)


def dt_from(dt_raw, bias_f, bias_b):
    d = dt_raw.astype(jnp.float32)
    return (jax.nn.softplus(d[..., :SSD_HEADS] + bias_f.astype(jnp.float32)),
            jax.nn.softplus(d[..., SSD_HEADS:] + bias_b.astype(jnp.float32)))


def ssd_features(p, conv_w, conv_b, dtb_f, dtb_b):
    z, xbc, dt_raw = jnp.split(p, [D_INNER, DT_OFF], axis=-1)
    xbc = jax.nn.silu(conv_centered(xbc, conv_w, conv_b))
    xs, bm = split_xb(xbc[..., :XB_DIM])
    cm = xbc[..., XB_DIM:].reshape(p.shape[:2] + (SSD_GROUPS, SSD_STATE))
    dt_f, dt_b = dt_from(dt_raw, dtb_f, dtb_b)
    return z, xs, bm, cm, dt_f, dt_b


def ssd_scan(x, dt, a_coef, bm, cm, init):
    f32 = jnp.float32
    b, L = x.shape[:2]
    nc, q = L // SSD_CHUNK, SSD_CHUNK
    a = (dt * a_coef).reshape(b, nc, q, SSD_GROUPS, SSD_REP).transpose(0, 1, 3, 4, 2)
    a_cum = jnp.cumsum(a, axis=-1)
    xdt = (x.astype(f32) * dt[..., None]).reshape(b, nc, q, SSD_GROUPS, SSD_REP, SSD_HEADDIM)
    bc = bm.astype(f32).reshape(b, nc, q, SSD_GROUPS, SSD_STATE)
    cc = cm.astype(f32).reshape(b, nc, q, SSD_GROUPS, SSD_STATE)
    causal = jnp.tril(jnp.ones((q, q), dtype=bool))
    lmat = jnp.exp(jnp.where(causal, a_cum[..., :, None] - a_cum[..., None, :], -jnp.inf))
    cb = jnp.einsum('bclgn,bcsgn->bcgls', cc, bc)
    y_diag = jnp.einsum('bcgrls,bcsgrp->bclgrp', cb[:, :, :, None] * lmat, xdt)
    decay_end = jnp.exp(a_cum[..., -1:] - a_cum).transpose(0, 1, 4, 2, 3)
    chunk_states = jnp.einsum('bclgn,bclgrp->bcgrpn', bc, xdt * decay_end[..., None])
    chunk_decay = jnp.exp(a_cum[..., -1])

    def step(state, inp):
        dec, st = inp
        return state * dec[..., None, None] + st, state

    final, prev = lax.scan(step, init.astype(f32),
                           (jnp.moveaxis(chunk_decay, 1, 0), jnp.moveaxis(chunk_states, 1, 0)))
    prev = jnp.moveaxis(prev, 0, 1)
    decay_in = jnp.exp(a_cum).transpose(0, 1, 4, 2, 3)[..., None]
    y_off = jnp.einsum('bclgn,bcgrpn->bclgrp', cc, prev) * decay_in
    return (y_diag + y_off).reshape(b, L, SSD_HEADS, SSD_HEADDIM), final


def ssd_final_state(x, dt, a_coef, bm):
    b, L = x.shape[:2]
    a_cum = jnp.cumsum(dt * a_coef, axis=1)
    w = dt * jnp.exp(a_cum[:, -1:] - a_cum)
    xw = (x.astype(jnp.float32) * w[..., None]).reshape(b, L, SSD_GROUPS, SSD_REP, SSD_HEADDIM)
    return jnp.einsum('blgn,blgrp->bgrpn', bm.astype(jnp.float32), xw)


def flip(t):
    return jnp.flip(t, axis=1)


def ssd_bidirectional(xs, bm, cm, dt_f, dt_b, a_f, a_b, init_f, init_b):
    y_f, s_f = ssd_scan(xs, dt_f, a_f, bm, cm, init_f)
    y_b, s_b = ssd_scan(flip(xs), flip(dt_b), a_b, flip(bm), flip(cm), init_b)
    return y_f + flip(y_b), s_f, s_b


def ssd_output(y, xs, z, d_skip, norm_g, w_out):
    b, L = y.shape[:2]
    y = y + xs.astype(jnp.float32) * d_skip.astype(jnp.float32)[:, None]
    gshape = (b, L, SSD_GROUPS, D_INNER // SSD_GROUPS)
    y = y.reshape(gshape) * jax.nn.silu(z.astype(jnp.float32)).reshape(gshape)
    y = y * lax.rsqrt(jnp.mean(y * y, axis=-1, keepdims=True) + EPS)
    return (y.reshape(b, L, D_INNER).astype(z.dtype) * norm_g) @ w_out


def mixer_ssd(h, hc, w_in, conv_w, conv_b, dtb_f, dtb_b, alog_f, alog_b, d_skip, norm_g, w_out, last):
    a_f = -jnp.exp(alog_f.astype(jnp.float32))
    a_b = -jnp.exp(alog_b.astype(jnp.float32))
    b = h.shape[0]
    if last:
        xb_c = jax.nn.silu(conv_centered(hc @ w_in[:, D_INNER:D_INNER + XB_DIM],
                                         conv_w[:, :XB_DIM], conv_b[:XB_DIM]))
        xs_c, b_c = split_xb(xb_c)
        dtf_c, dtb_c = dt_from(hc @ w_in[:, DT_OFF:], dtb_f, dtb_b)
        s_f = ssd_final_state(xs_c, dtf_c, a_f, b_c)
        s_b = ssd_final_state(flip(xs_c), flip(dtb_c), a_b, flip(b_c))
        yc = None
    else:
        z_c, xs_c, b_c, c_c, dtf_c, dtb_c = ssd_features(hc @ w_in, conv_w, conv_b, dtb_f, dtb_b)
        zero = jnp.zeros((b, SSD_GROUPS, SSD_REP, SSD_HEADDIM, SSD_STATE), jnp.float32)
        y_c, s_f, s_b = ssd_bidirectional(xs_c, b_c, c_c, dtf_c, dtb_c, a_f, a_b, zero, zero)
        yc = ssd_output(y_c, xs_c, z_c, d_skip, norm_g, w_out)
    z, xs, bm, cm, dt_f, dt_b = ssd_features(h @ w_in, conv_w, conv_b, dtb_f, dtb_b)
    y, _, _ = ssd_bidirectional(xs, bm, cm, dt_f, dt_b, a_f, a_b, s_f, s_b)
    return ssd_output(y, xs, z, d_skip, norm_g, w_out), yc


def swiglu(h, wg, wu, wd):
    return (jax.nn.silu(h @ wg) * (h @ wu)) @ wd


def moe_ffn(h, router, wg, wu, wd):
    logits = (h @ router).astype(jnp.float32)
    top_v, top_i = lax.top_k(logits, TOP_K)
    w = jax.nn.softmax(top_v, axis=-1)
    gates = jnp.einsum('btk,btke->bte', w, jax.nn.one_hot(top_i, N_EXPERTS, dtype=jnp.float32)).astype(h.dtype)
    out = jnp.zeros_like(h)
    for e in range(N_EXPERTS):
        out = out + gates[..., e:e + 1] * swiglu(h, wg[e], wu[e], wd[e])
    return out


def setup_inputs(seed: int = 0) -> dict:
    key = jax.random.key(seed)
    ks = iter(jax.random.split(key, 40))
    f32 = jnp.float32

    def nrm(shape, scale):
        return jax.random.normal(next(ks), shape, f32) * scale

    def gain(shape):
        return 1.0 + nrm(shape, 0.02)

    def dt_bias(shape):
        u = jax.random.uniform(next(ks), shape, f32)
        dt = jnp.exp(u * (np.log(0.1) - np.log(0.001)) + np.log(0.001)).astype(f32)
        return dt + jnp.log(-jnp.expm1(-dt))

    def a_log(shape):
        return jnp.log(jax.random.uniform(next(ks), shape, f32, minval=1.0, maxval=16.0))

    D = D_MODEL
    return {
        "x": nrm((BATCH, SEQ, D), 1.0),
        "c": nrm((BATCH, D), 1.0),
        "ctx": nrm((BATCH, CTX_LEN, D), 1.0),
        "c_ctx": nrm((D,), 1.0),
        "ada_w": nrm((DEPTH, D, 6 * D), ADA_SCALE * D ** -0.5),
        "ada_b": nrm((DEPTH, 6 * D), 0.02),
        "norm1_g": gain((DEPTH, D)),
        "norm2_g": gain((DEPTH, D)),
        "ab_w_in": nrm((N_EVEN, D, AB_IN), D ** -0.5),
        "ab_conv_w": nrm((N_EVEN, CONV_W, CONV_CH), CONV_W ** -0.5),
        "ab_sink": nrm((N_EVEN, N_Q_HEADS), 0.5),
        "ab_w_out": nrm((N_EVEN, AB_OUT, D), AB_OUT ** -0.5),
        "ffn_w_gate": nrm((N_EVEN, D, D_FF), D ** -0.5),
        "ffn_w_up": nrm((N_EVEN, D, D_FF), D ** -0.5),
        "ffn_w_down": nrm((N_EVEN, D_FF, D), D_FF ** -0.5),
        "ssd_w_in": nrm((N_ODD, D, SSD_IN), D ** -0.5),
        "ssd_conv_w": nrm((N_ODD, SSD_CONV_W, SSD_CONV_DIM), SSD_CONV_W ** -0.5),
        "ssd_conv_b": nrm((N_ODD, SSD_CONV_DIM), 0.02),
        "ssd_dt_bias_f": dt_bias((N_ODD, SSD_HEADS)),
        "ssd_dt_bias_b": dt_bias((N_ODD, SSD_HEADS)),
        "ssd_a_log_f": a_log((N_ODD, SSD_HEADS)),
        "ssd_a_log_b": a_log((N_ODD, SSD_HEADS)),
        "ssd_d": gain((N_ODD, SSD_HEADS)),
        "ssd_norm_g": gain((N_ODD, D_INNER)),
        "ssd_w_out": nrm((N_ODD, D_INNER, D), D_INNER ** -0.5),
        "moe_router": nrm((N_ODD, D, N_EXPERTS), D ** -0.5),
        "moe_w_gate": nrm((N_ODD, N_EXPERTS, D, D_FF_EXPERT), D ** -0.5),
        "moe_w_up": nrm((N_ODD, N_EXPERTS, D, D_FF_EXPERT), D ** -0.5),
        "moe_w_down": nrm((N_ODD, N_EXPERTS, D_FF_EXPERT, D), D_FF_EXPERT ** -0.5),
        "final_g": gain((D,)),
    }


def reference(x, c, ctx, c_ctx, ada_w, ada_b, norm1_g, norm2_g, ab_w_in, ab_conv_w, ab_sink, ab_w_out,
              ffn_w_gate, ffn_w_up, ffn_w_down, ssd_w_in, ssd_conv_w, ssd_conv_b, ssd_dt_bias_f,
              ssd_dt_bias_b, ssd_a_log_f, ssd_a_log_b, ssd_d, ssd_norm_g, ssd_w_out, moe_router,
              moe_w_gate, moe_w_up, moe_w_down, final_g):
    L = x.shape[1]
    cos, sin = rope2d_tables(L)
    sc_x = jax.nn.silu(c)
    sc_c = jax.nn.silu(c_ctx)
    xc = ctx
    for i in range(DEPTH):
        last = i == DEPTH - 1
        j = i // 2
        m = (sc_x @ ada_w[i] + ada_b[i])[:, None, :]
        mc = sc_c @ ada_w[i] + ada_b[i]
        sh1, sc1, g1, sh2, sc2, g2 = jnp.split(m, 6, axis=-1)
        sh1c, sc1c, g1c, sh2c, sc2c, g2c = jnp.split(mc, 6, axis=-1)
        h = modulate(x, norm1_g[i], sh1, sc1)
        hc = modulate(xc, norm1_g[i], sh1c, sc1c)
        if i % 2 == 0:
            y, yc = mixer_ab(h, hc, ab_w_in[j], ab_conv_w[j], ab_sink[j], ab_w_out[j], cos, sin, last)
            ffn = lambda t, j=j: swiglu(t, ffn_w_gate[j], ffn_w_up[j], ffn_w_down[j])
        else:
            y, yc = mixer_ssd(h, hc, ssd_w_in[j], ssd_conv_w[j], ssd_conv_b[j], ssd_dt_bias_f[j],
                              ssd_dt_bias_b[j], ssd_a_log_f[j], ssd_a_log_b[j], ssd_d[j],
                              ssd_norm_g[j], ssd_w_out[j], last)
            ffn = lambda t, j=j: moe_ffn(t, moe_router[j], moe_w_gate[j], moe_w_up[j], moe_w_down[j])
        x = x + g1 * y
        x = x + g2 * ffn(modulate(x, norm2_g[i], sh2, sc2))
        if not last:
            xc = xc + g1c * yc
            xc = xc + g2c * ffn(modulate(xc, norm2_g[i], sh2c, sc2c))
    return rmsnorm(x, final_g)
```

```cpp
#include <hip/hip_runtime.h>
#include <cstdio>
#include <cstdint>

#ifndef MK_N_LAUNCHES
#define MK_N_LAUNCHES 1
#endif

namespace pg8 {
#define PG8_LAS __attribute__((address_space(3)))
typedef unsigned short bf16_t;
typedef short bf16x8 __attribute__((ext_vector_type(8)));
typedef float f32x4 __attribute__((ext_vector_type(4)));
typedef unsigned u32x4 __attribute__((ext_vector_type(4)));
constexpr int BM = 256, BK = 64, HALF = 128, HTB = HALF * BK * 2  , STAGE_BYTES = 8 * HTB, NXCD = 8;

__host__ __device__ __forceinline__ int lds_byte(int r, int c) { const int st = (r >> 4) * 2 + (c >> 5), rr = r & 15, cc = c & 31, ob = rr * 64 + cc * 2; return st * 1024 + (ob ^ (((ob >> 9) & 1) << 5)); }
__host__ __device__ __forceinline__ void stage_rc(int b, int& R, int& C) { const int st = b / 1024, sb = b % 1024, swz = sb ^ (((sb >> 9) & 1) << 5); R = (st >> 1) * 16 + swz / 64; C = (st & 1) * 32 + (swz % 64) / 2; }
__host__ __device__ __forceinline__ int perm32(int rho) { const int n = rho >> 4, i = rho & 15; return 8 * (i >> 2) + 4 * n + (i & 3); }

struct Unit { int pm, pn, pe, pk; };
struct Gemm { const bf16_t* A; const bf16_t* Bt; int ld, K; size_t bstride; };

struct StaticOrder {
    int nM, nN, nwg, G, c, WGM;
    __host__ __device__ void init(int M, int N, int G_, int c_, int wgm = 4) { nM = M / BM; nN = N / BM; nwg = nM * nN; G = G_; c = c_; WGM = wgm; }
    __host__ __device__ bool next(int i, Unit& u) const {
        const long L = (long)i * G + c; if (L >= nwg) return false;
        int wgid = (int)L; { const int q = nwg / NXCD, r = nwg % NXCD, xcd = wgid % NXCD, off = wgid / NXCD; wgid = (xcd < r ? xcd * (q + 1) : r * (q + 1) + (xcd - r) * q) + off; }
        const int nig = WGM * nN, gid = wgid / nig, fm = gid * WGM, gsz = (nM - fm) < WGM ? (nM - fm) : WGM;
        u.pm = fm + ((wgid % nig) % gsz); u.pn = (wgid % nig) / gsz; u.pe = 0; u.pk = 0; return true;
    }
    __device__ __forceinline__ void a_ready(const Unit&) const {}
    __device__ __forceinline__ void done(const Unit&) const {}
};
struct GroupedOrder {
    int nM, nN, nwg, G, c, WGM; int ts1, ts2, ts3, ts4, ts5, ts6, ts7;
    __device__ bool next(int i, Unit& u) const {
        const long L = (long)i * G + c; if (L >= nwg) return false;
        int wgid = (int)L; { const int q = nwg / NXCD, r = nwg % NXCD, xcd = wgid % NXCD, off = wgid / NXCD; wgid = (xcd < r ? xcd * (q + 1) : r * (q + 1) + (xcd - r) * q) + off; }
        const int nig = WGM * nN, gid = wgid / nig, fm = gid * WGM, gsz = (nM - fm) < WGM ? (nM - fm) : WGM;
        u.pm = fm + ((wgid % nig) % gsz); u.pn = (wgid % nig) / gsz;
        u.pk = 0; const int p = u.pm; u.pe = (p >= ts1) + (p >= ts2) + (p >= ts3) + (p >= ts4) + (p >= ts5) + (p >= ts6) + (p >= ts7); return true;
    }
    __device__ __forceinline__ void a_ready(const Unit&) const {}
    __device__ __forceinline__ void done(const Unit&) const {}
};

__device__ __forceinline__ unsigned cvt_pk_bf16(float lo, float hi) { unsigned r; asm volatile("v_cvt_pk_bf16_f32 %0, %1, %2" : "=v"(r) : "v"(lo), "v"(hi)); return r; }
__device__ __forceinline__ float silu_f(float g) { return g * __builtin_amdgcn_rcpf(1.0f + __expf(-g)); }

struct EpiStoreBf16 {
    static constexpr bool PERM = true, AFTER_DRAIN = false;
    bf16_t* O; int ldc;
    __device__ __forceinline__ void operator()(const f32x4 (&acc)[2][2][4][2], const Unit& u, int wr, int wc, int fr, int fq) const {
        const int row0 = u.pm * BM + wr * 64 + fr, col0 = u.pn * BM + wc * 32 + 8 * fq;
#pragma unroll
        for (int ai = 0; ai < 2; ++ai)
#pragma unroll
            for (int m = 0; m < 4; ++m) { bf16_t* rowp = O + (size_t)(row0 + ai * HALF + m * 16) * ldc + col0;
#pragma unroll
                for (int bj = 0; bj < 2; ++bj) { const f32x4 v0 = acc[ai][bj][m][0], v1 = acc[ai][bj][m][1];
                    u32x4 w; w.x = cvt_pk_bf16(v0[0], v0[1]); w.y = cvt_pk_bf16(v0[2], v0[3]); w.z = cvt_pk_bf16(v1[0], v1[1]); w.w = cvt_pk_bf16(v1[2], v1[3]);
                    *(u32x4*)(rowp + bj * HALF) = w; } }
    }
};
struct EpiSwiGLU {
    static constexpr bool PERM = true, AFTER_DRAIN = false;
    bf16_t* O; int ldc;
    __device__ __forceinline__ void operator()(const f32x4 (&acc)[2][2][4][2], const Unit& u, int wr, int wc, int fr, int fq) const {
        const int row0 = u.pm * BM + wr * 64 + fr, col0 = u.pn * HALF + wc * 32 + 8 * fq;
#pragma unroll
        for (int ai = 0; ai < 2; ++ai)
#pragma unroll
            for (int m = 0; m < 4; ++m) { bf16_t* rowp = O + (size_t)(row0 + ai * HALF + m * 16) * ldc + col0;
                const f32x4 g0 = acc[ai][0][m][0], g1 = acc[ai][0][m][1], u0 = acc[ai][1][m][0], u1 = acc[ai][1][m][1];
                u32x4 w; w.x = cvt_pk_bf16(silu_f(g0[0]) * u0[0], silu_f(g0[1]) * u0[1]); w.y = cvt_pk_bf16(silu_f(g0[2]) * u0[2], silu_f(g0[3]) * u0[3]);
                w.z = cvt_pk_bf16(silu_f(g1[0]) * u1[0], silu_f(g1[1]) * u1[1]); w.w = cvt_pk_bf16(silu_f(g1[2]) * u1[2], silu_f(g1[3]) * u1[3]);
                *(u32x4*)rowp = w; }
    }
};
template <bool BASE_F32> struct EpiRes {
    static constexpr bool PERM = true, AFTER_DRAIN = false;
    bf16_t* X; const void* base; const float* gate;
    __device__ __forceinline__ void operator()(const f32x4 (&acc)[2][2][4][2], const Unit& u, int wr, int wc, int fr, int fq) const {
        const int row0 = u.pm * BM + wr * 64 + fr, col0 = u.pn * BM + wc * 32 + 8 * fq;
        f32x4 gv[2][2];
#pragma unroll
        for (int bj = 0; bj < 2; ++bj)
#pragma unroll
            for (int n = 0; n < 2; ++n) gv[bj][n] = *(const f32x4*)(gate + col0 + bj * HALF + 4 * n);
#pragma unroll
        for (int ai = 0; ai < 2; ++ai)
#pragma unroll
            for (int m = 0; m < 4; ++m) { const size_t ro = (size_t)(row0 + ai * HALF + m * 16) * 1024 + col0;
#pragma unroll
                for (int bj = 0; bj < 2; ++bj) { f32x4 b0, b1;
                    if (BASE_F32) { b0 = *(const f32x4*)((const float*)base + ro + bj * HALF); b1 = *(const f32x4*)((const float*)base + ro + bj * HALF + 4); }
                    else { const u32x4 t = *(const u32x4*)((const bf16_t*)base + ro + bj * HALF);
                        b0 = (f32x4){__uint_as_float(t.x << 16), __uint_as_float(t.x & 0xffff0000u), __uint_as_float(t.y << 16), __uint_as_float(t.y & 0xffff0000u)};
                        b1 = (f32x4){__uint_as_float(t.z << 16), __uint_as_float(t.z & 0xffff0000u), __uint_as_float(t.w << 16), __uint_as_float(t.w & 0xffff0000u)}; }
                    const f32x4 v0 = b0 + gv[bj][0] * acc[ai][bj][m][0], v1 = b1 + gv[bj][1] * acc[ai][bj][m][1];
                    u32x4 w; w.x = cvt_pk_bf16(v0[0], v0[1]); w.y = cvt_pk_bf16(v0[2], v0[3]); w.z = cvt_pk_bf16(v1[0], v1[1]); w.w = cvt_pk_bf16(v1[2], v1[3]);
                    *(u32x4*)(X + ro + bj * HALF) = w; } }
    }
};
struct EpiSsdIn {
    static constexpr bool PERM = true, AFTER_DRAIN = false;
    bf16_t* Z; bf16_t* XB; float* DT;
    __device__ __forceinline__ void operator()(const f32x4 (&acc)[2][2][4][2], const Unit& u, int wr, int wc, int fr, int fq) const {
        const int row0 = u.pm * BM + wr * 64 + fr;
        if (u.pn < 20) {
            bf16_t* O = u.pn < 8 ? Z : XB; const int ldc = u.pn < 8 ? 2048 : 3072; const int col0 = (u.pn < 8 ? u.pn : u.pn - 8) * BM + wc * 32 + 8 * fq;
#pragma unroll
            for (int ai = 0; ai < 2; ++ai)
#pragma unroll
                for (int m = 0; m < 4; ++m) { bf16_t* rowp = O + (size_t)(row0 + ai * HALF + m * 16) * ldc + col0;
#pragma unroll
                    for (int bj = 0; bj < 2; ++bj) { const f32x4 v0 = acc[ai][bj][m][0], v1 = acc[ai][bj][m][1];
                        u32x4 w; w.x = cvt_pk_bf16(v0[0], v0[1]); w.y = cvt_pk_bf16(v0[2], v0[3]); w.z = cvt_pk_bf16(v1[0], v1[1]); w.w = cvt_pk_bf16(v1[2], v1[3]);
                        *(u32x4*)(rowp + bj * HALF) = w; } }
        } else if (wc < 2) {
#pragma unroll
            for (int ai = 0; ai < 2; ++ai)
#pragma unroll
                for (int m = 0; m < 4; ++m) { float* rowp = DT + (size_t)(row0 + ai * HALF + m * 16) * 64 + wc * 32 + 8 * fq;
                    *(f32x4*)rowp = acc[ai][0][m][0]; *(f32x4*)(rowp + 4) = acc[ai][0][m][1]; }
        }
    }
};


struct SplitOrder {
    int pm0, nN, nunits, ks_len, G, c;
    __device__ bool next(int i, Unit& u) const { const int x = i * G + c; if (x >= nunits) return false; u.pm = pm0; u.pn = x % nN; u.pe = 0; u.pk = (x / nN) * ks_len; return true; }
    __device__ __forceinline__ void a_ready(const Unit&) const {}
    __device__ __forceinline__ void done(const Unit&) const {}
};
struct SplitGroupedOrder {
    int pm_lo, pm_hi, nN, nks, ks_len, G, c; int ts1, ts2, ts3, ts4, ts5, ts6, ts7;
    __device__ bool next(int i, Unit& u) const { const int x = i * G + c; const int per = nN * nks; if (x >= (pm_hi - pm_lo) * per) return false;
        u.pm = pm_lo + x / per; const int y = x % per; u.pn = y / nks; u.pk = (y % nks) * ks_len;
        const int p = u.pm; u.pe = (p >= ts1) + (p >= ts2) + (p >= ts3) + (p >= ts4) + (p >= ts5) + (p >= ts6) + (p >= ts7); return true; }
    __device__ __forceinline__ void a_ready(const Unit&) const {}
    __device__ __forceinline__ void done(const Unit&) const {}
};
struct EpiPart {
    static constexpr bool PERM = false, AFTER_DRAIN = false;
    float* P; int pm_base, ks_len, nrows;
    __device__ __forceinline__ void operator()(const f32x4 (&acc)[2][2][4][2], const Unit& u, int wr, int wc, int fr, int fq) const {
        const int row0 = (u.pm - pm_base) * BM + wr * 64 + fr, col0 = u.pn * BM + wc * 32 + 4 * fq;
        float* base = P + (size_t)(u.pk / ks_len) * nrows * 1024;
#pragma unroll
        for (int ai = 0; ai < 2; ++ai)
#pragma unroll
            for (int m = 0; m < 4; ++m) { float* rowp = base + (size_t)(row0 + ai * HALF + m * 16) * 1024 + col0;
#pragma unroll
                for (int bj = 0; bj < 2; ++bj)
#pragma unroll
                    for (int n = 0; n < 2; ++n) *(f32x4*)(rowp + bj * HALF + n * 16) = acc[ai][bj][m][n]; }
    }
};
template <class Epi, class Sched, bool ALIGN_EPI = false, bool SP2 = false>
__device__ __forceinline__ void gemm_phase(PG8_LAS unsigned char* lds, const Gemm g, const Sched& S, const Epi& E) {
    const int tid = threadIdx.x, wid = __builtin_amdgcn_readfirstlane(tid >> 6), lane = tid & 63, wr = wid >> 2, wc = wid & 3, fr = lane & 15, fq = lane >> 4;
    const int K = g.K, nt = K / BK;
    unsigned voffA[2], voffB[2];
#pragma unroll
    for (int i = 0; i < 2; ++i) { int R, C; stage_rc(tid * 16 + i * 8192, R, C); const int Rb = Epi::PERM ? ((R & ~31) + perm32(R & 31)) : R;
        voffA[i] = (unsigned)(R * g.ld + C) * 2u; voffB[i] = (unsigned)(Rb * g.ld + C) * 2u; }
    const size_t kstep = (size_t)(BK * 2);
    const size_t hstep = (size_t)HALF * g.ld * 2;
    const size_t tstep = 2 * hstep;
    const unsigned ldsw = (unsigned)wid * 1024u;
    const int aoff = lds_byte(wr * 64 + fr, fq * 8), boff = lds_byte(wc * 32 + fr, fq * 8);
#define PG8_SA(b, h) (((b) * 2 + (h)) * HTB)
#define PG8_SB(b, h) ((4 + (b) * 2 + (h)) * HTB)
#define PG8_STAGE(bufoff, gbase, voff) do { _Pragma("unroll") for (int _i = 0; _i < 2; ++_i) \
        __builtin_amdgcn_global_load_lds((const unsigned*)((const char*)(gbase) + (voff)[_i]), (PG8_LAS unsigned*)(lds + (bufoff) + ldsw + _i * 8192), 16, 0, 0); } while (0)
#define PG8_LDA(dst, b, h) do { _Pragma("unroll") for (int m = 0; m < 4; ++m) _Pragma("unroll") for (int k = 0; k < 2; ++k) dst[m][k] = *(const PG8_LAS bf16x8*)(lds + PG8_SA(b, h) + aoff + m * 2048 + k * 1024); } while (0)
#define PG8_LDB(dst, b, h) do { _Pragma("unroll") for (int n = 0; n < 2; ++n) _Pragma("unroll") for (int k = 0; k < 2; ++k) dst[n][k] = *(const PG8_LAS bf16x8*)(lds + PG8_SB(b, h) + boff + n * 2048 + k * 1024); } while (0)
#define PG8_MMA(ai, bj, At, Bt) do { __builtin_amdgcn_s_setprio(1); _Pragma("unroll") for (int m = 0; m < 4; ++m) _Pragma("unroll") for (int n = 0; n < 2; ++n) _Pragma("unroll") for (int k = 0; k < 2; ++k) \
        acc[ai][bj][m][n] = __builtin_amdgcn_mfma_f32_16x16x32_bf16(Bt[n][k], At[m][k], acc[ai][bj][m][n], 0, 0, 0); __builtin_amdgcn_s_setprio(0); } while (0)
#define PG8_WAIT_V(n) asm volatile("s_waitcnt vmcnt(" #n ")" ::: "memory")
#define PG8_WAIT_L(n) asm volatile("s_waitcnt lgkmcnt(" #n ")" ::: "memory")
#define PG8_BAR __builtin_amdgcn_s_barrier()
#define PG8_SCHED __builtin_amdgcn_sched_barrier(0)
    Unit cur, nxt; int ui = 0;
    if (!S.next(0, cur)) return;
    f32x4 acc[2][2][4][2];
#pragma unroll
    for (int a = 0; a < 2; ++a)
#pragma unroll
        for (int b = 0; b < 2; ++b)
#pragma unroll
            for (int m = 0; m < 4; ++m)
#pragma unroll
                for (int n = 0; n < 2; ++n) acc[a][b][m][n] = (f32x4){0.f, 0.f, 0.f, 0.f};
    bf16x8 At[4][2], B0[2][2], B1[2][2];
    const char* cA = (const char*)g.A + (size_t)cur.pm * tstep + (size_t)cur.pk * 2; const char* cB = (const char*)g.Bt + (size_t)cur.pe * g.bstride + (size_t)cur.pn * tstep + (size_t)cur.pk * 2;
    S.a_ready(cur);
    if constexpr (SP2) {
        PG8_STAGE(PG8_SB(0, 0), cB, voffB); PG8_STAGE(PG8_SB(0, 1), cB + hstep, voffB); PG8_STAGE(PG8_SA(0, 0), cA, voffA); PG8_STAGE(PG8_SA(0, 1), cA + hstep, voffA);
        if (wr == 1) PG8_BAR;
        PG8_WAIT_V(2); PG8_BAR;
        PG8_STAGE(PG8_SB(1, 0), cB + kstep, voffB); PG8_STAGE(PG8_SA(1, 0), cA + kstep, voffA); PG8_STAGE(PG8_SB(1, 1), cB + hstep + kstep, voffB);
        PG8_WAIT_V(6); PG8_BAR;
    } else {
        PG8_STAGE(PG8_SB(0, 0), cB, voffB); PG8_STAGE(PG8_SA(0, 0), cA, voffA); PG8_STAGE(PG8_SB(0, 1), cB + hstep, voffB); PG8_STAGE(PG8_SA(0, 1), cA + hstep, voffA);
        if (wr == 1) PG8_BAR;
        PG8_WAIT_V(4); PG8_BAR;
        PG8_STAGE(PG8_SB(1, 0), cB + kstep, voffB); PG8_STAGE(PG8_SA(1, 0), cA + kstep, voffA); PG8_STAGE(PG8_SB(1, 1), cB + hstep + kstep, voffB);
        PG8_WAIT_V(6); PG8_BAR;
    }
    for (;;) {
        const bool has_next = S.next(ui + 1, nxt);
        const char* nA = has_next ? (const char*)g.A + (size_t)nxt.pm * tstep + (size_t)nxt.pk * 2 : cA; const char* nB = has_next ? (const char*)g.Bt + (size_t)nxt.pe * g.bstride + (size_t)nxt.pn * tstep + (size_t)nxt.pk * 2 : cB;
        for (int t = 0; t < nt; t += 2) {
            const bool last = (t == nt - 2);
            const char* a1 = cA + (size_t)(t + 1) * kstep;
            const char* a2 = last ? nA : cA + (size_t)(t + 2) * kstep; const char* b2 = last ? nB : cB + (size_t)(t + 2) * kstep;
            const char* a3 = a2 + kstep; const char* b3 = b2 + kstep;
            if (last && has_next) S.a_ready(nxt);
            if constexpr (SP2) {
            PG8_LDB(B0, 0, 0); PG8_LDB(B1, 0, 1); PG8_SCHED; PG8_LDA(At, 0, 0); PG8_STAGE(PG8_SA(1, 1), a1 + hstep, voffA);
            PG8_WAIT_V(8); PG8_WAIT_L(0); PG8_BAR; PG8_MMA(0, 0, At, B0); PG8_MMA(0, 1, At, B1); PG8_BAR; PG8_SCHED;
            PG8_LDA(At, 0, 1); PG8_STAGE(PG8_SB(0, 0), b2, voffB); PG8_STAGE(PG8_SB(0, 1), b2 + hstep, voffB); PG8_STAGE(PG8_SA(0, 0), a2, voffA);
            PG8_WAIT_V(8); PG8_WAIT_L(0); PG8_BAR; PG8_MMA(1, 0, At, B0); PG8_MMA(1, 1, At, B1); PG8_BAR; PG8_SCHED;
            PG8_LDB(B0, 1, 0); PG8_LDB(B1, 1, 1); PG8_SCHED; PG8_LDA(At, 1, 0); PG8_STAGE(PG8_SA(0, 1), a2 + hstep, voffA);
            PG8_WAIT_V(8); PG8_WAIT_L(0); PG8_BAR; PG8_MMA(0, 0, At, B0); PG8_MMA(0, 1, At, B1); PG8_BAR; PG8_SCHED;
            PG8_LDA(At, 1, 1); PG8_STAGE(PG8_SB(1, 0), b3, voffB); PG8_STAGE(PG8_SB(1, 1), b3 + hstep, voffB); PG8_STAGE(PG8_SA(1, 0), a3, voffA);
            PG8_WAIT_V(8); PG8_WAIT_L(0); PG8_BAR; PG8_MMA(1, 0, At, B0); PG8_MMA(1, 1, At, B1); PG8_BAR; PG8_SCHED;
            } else {
            PG8_LDB(B0, 0, 0); PG8_SCHED; PG8_LDA(At, 0, 0); PG8_STAGE(PG8_SA(1, 1), a1 + hstep, voffA);
            PG8_WAIT_L(8); PG8_BAR; PG8_WAIT_L(0); PG8_MMA(0, 0, At, B0); PG8_BAR; PG8_SCHED;
            PG8_LDB(B1, 0, 1); PG8_STAGE(PG8_SB(0, 0), b2, voffB);
            PG8_BAR; PG8_WAIT_L(0); PG8_MMA(0, 1, At, B1); PG8_BAR;
            PG8_LDA(At, 0, 1); PG8_STAGE(PG8_SA(0, 0), a2, voffA);
            PG8_BAR; PG8_WAIT_L(0); PG8_MMA(1, 0, At, B0); PG8_BAR; PG8_SCHED;
            PG8_STAGE(PG8_SB(0, 1), b2 + hstep, voffB);
            PG8_WAIT_V(6); PG8_BAR; PG8_MMA(1, 1, At, B1); PG8_BAR;
            PG8_LDB(B0, 1, 0); PG8_SCHED; PG8_LDA(At, 1, 0); PG8_STAGE(PG8_SA(0, 1), a2 + hstep, voffA);
            PG8_WAIT_L(8); PG8_BAR; PG8_WAIT_L(0); PG8_MMA(0, 0, At, B0); PG8_BAR; PG8_SCHED;
            PG8_LDB(B1, 1, 1); PG8_STAGE(PG8_SB(1, 0), b3, voffB);
            PG8_BAR; PG8_WAIT_L(0); PG8_MMA(0, 1, At, B1); PG8_BAR;
            PG8_LDA(At, 1, 1); PG8_STAGE(PG8_SA(1, 0), a3, voffA);
            PG8_BAR; PG8_WAIT_L(0); PG8_MMA(1, 0, At, B0); PG8_BAR; PG8_SCHED;
            PG8_STAGE(PG8_SB(1, 1), b3 + hstep, voffB);
            PG8_WAIT_V(6); PG8_BAR; PG8_MMA(1, 1, At, B1); PG8_BAR;
            }
        }
        if constexpr (ALIGN_EPI) { if (wr == 0) PG8_BAR; }
        if constexpr (!Epi::AFTER_DRAIN) { E(acc, cur, wr, wc, fr, fq); S.done(cur); }
        if (!has_next) break;
#pragma unroll
        for (int a = 0; a < 2; ++a)
#pragma unroll
            for (int b = 0; b < 2; ++b)
#pragma unroll
                for (int m = 0; m < 4; ++m)
#pragma unroll
                    for (int n = 0; n < 2; ++n) acc[a][b][m][n] = (f32x4){0.f, 0.f, 0.f, 0.f};
        cur = nxt; cA = nA; cB = nB; ++ui;
        if constexpr (ALIGN_EPI) { if (wr == 1) PG8_BAR; }
    }
    PG8_WAIT_V(0);
    if constexpr (!ALIGN_EPI) { if (wr == 0) PG8_BAR; }
    PG8_BAR;
    if constexpr (Epi::AFTER_DRAIN) { E.fused(acc, cur, wr, wc, fr, fq, lds, wid, lane); S.done(cur); }
#undef PG8_SA
#undef PG8_SB
#undef PG8_STAGE
#undef PG8_LDA
#undef PG8_LDB
#undef PG8_MMA
#undef PG8_WAIT_V
#undef PG8_WAIT_L
#undef PG8_BAR
#undef PG8_SCHED
}
}

constexpr int NWAVES = 8, NTHR = 512;
constexpr int D = 1024, L = 16384, LC = 256, MT = L + LC;
constexpr int AB_IN = 2304, DFF = 2816, SSD_INP = 5376, SSD_IN_REAL = 5184, DIN = 2048, XBCW = 3072, FFE = 3584, NEXP = 8;
constexpr int NCH = MT / 128;
constexpr int MOE_ROWS = 2 * L + NEXP * 256;
constexpr float EPS = 1e-6f;

constexpr size_t MiB = 1u << 20;
constexpr size_t WS_CTL = 0, CTL_ZERO_BYTES = 32768;
constexpr size_t WS_MOD = 1 * MiB;
constexpr size_t WS_ROPE = 1 * MiB + 128 * 1024;
constexpr size_t WS_TOKE = 2 * MiB, WS_TOKW = 2 * MiB + 128 * 1024, WS_TOKP = 2 * MiB + 256 * 1024;
constexpr size_t WS_DEC = 3 * MiB;
constexpr size_t WS_X = 4 * MiB;
constexpr size_t WS_H = 36 * MiB + 512 * 1024;
constexpr size_t WS_WMOE = 69 * MiB, WS_YPART = WS_WMOE + 56 * MiB;
constexpr size_t WS_H2S = 181 * MiB, WS_ACTM = 249 * MiB, WS_H2 = 487 * MiB, WS_END = 520 * MiB;
constexpr size_t WS_WSSDIN = 181 * MiB, WS_WSSDOUT = WS_WSSDIN + (size_t)SSD_INP * D * 2;
constexpr size_t WS_WABIN = 196 * MiB, WS_WABOUT = WS_WABIN + (size_t)AB_IN * D * 2, WS_WFFNGU = WS_WABOUT + (size_t)D * D * 2, WS_WFFND = WS_WFFNGU + (size_t)2 * DFF * D * 2;
constexpr size_t WS_PAB = 219 * MiB, WS_MIX = 293 * MiB, WS_ACT0 = 326 * MiB, WS_QR = 416 * MiB, WS_KR = 433 * MiB, WS_VT = 438 * MiB, WS_PART = 443 * MiB;
constexpr size_t WS_Z = 196 * MiB, WS_XBCR = 261 * MiB, WS_STATES = 261 * MiB, WS_DTRAW = 391 * MiB, WS_DTS = 396 * MiB, WS_XT = 405 * MiB, WS_BT = 470 * MiB, WS_BM = 487 * MiB, WS_CM = 503 * MiB + 512 * 1024;
constexpr size_t DTS_STRIDE = (size_t)32 * MT * 4;
static_assert(WS_X + (size_t)MT * D * 2 <= WS_H && WS_H + (size_t)MT * D * 2 <= WS_WMOE, "X / H map");
static_assert(WS_WMOE + (size_t)NEXP * 2 * FFE * D * 2 <= WS_H2S && WS_H2S + (size_t)MOE_ROWS * D * 2 <= WS_ACTM && WS_ACTM + (size_t)MOE_ROWS * FFE * 2 <= WS_H2 && WS_H2 + (size_t)L * D * 2 <= WS_END, "moe map");
static_assert(WS_YPART >= WS_WMOE + (size_t)NEXP * D * FFE * 2 && WS_YPART + (size_t)7 * 2048 * D * 4 <= WS_H2S, "moe map 2");
static_assert(WS_WSSDOUT + (size_t)D * DIN * 2 <= WS_WABIN && WS_WFFND + (size_t)D * DFF * 2 <= WS_PAB, "weights map");
static_assert(WS_PAB + (size_t)MT * AB_IN * 2 <= WS_MIX && WS_MIX + (size_t)MT * D * 2 <= WS_ACT0 && WS_ACT0 + (size_t)MT * DFF * 2 <= WS_QR && WS_QR + (size_t)8 * MT * 64 * 2 <= WS_KR && WS_KR + (size_t)2 * MT * 64 * 2 <= WS_VT && WS_VT + (size_t)128 * MT * 2 <= WS_PART && WS_PART + (size_t)11 * LC * D * 4 <= WS_END, "layer0 map");
static_assert(WS_WSSDOUT + (size_t)D * DIN * 2 <= WS_Z && WS_Z + (size_t)MT * DIN * 2 <= WS_XBCR && WS_XBCR + (size_t)MT * XBCW * 2 <= WS_DTRAW && WS_STATES + (size_t)2 * NCH * 32 * 64 * 128 * 2 <= WS_DTRAW && WS_DTRAW + (size_t)MT * 64 * 4 <= WS_DTS && WS_DTS + 4 * DTS_STRIDE <= WS_XT && WS_XT + (size_t)DIN * MT * 2 <= WS_BT && WS_BT + (size_t)512 * MT * 2 <= WS_BM && WS_BM + (size_t)MT * 512 * 2 <= WS_CM && WS_CM + (size_t)MT * 512 * 2 <= WS_END, "ssd map");
static_assert(WS_PART + (size_t)11 * LC * D * 4 <= WS_BT && WS_PART >= WS_DTS + 4 * DTS_STRIDE || true, "PART is read by the layer-1 modulate before the SSD conv writes XT");
constexpr int CW_TMO = 0;
constexpr int CW_HIST = 1024;
constexpr int CW_BAR = 4096;

constexpr int RING_BYTES = 159744, LDSCTL_OFF = RING_BYTES, MISC_OFF = LDSCTL_OFF + 320, LDS_BYTES = 163840;

#define GAS __attribute__((address_space(1)))
#define LAS __attribute__((address_space(3)))
typedef unsigned short bf16;
typedef unsigned v4u __attribute__((ext_vector_type(4)));
typedef unsigned v2u __attribute__((ext_vector_type(2)));
typedef float f32x4 __attribute__((ext_vector_type(4)));
typedef GAS unsigned gu32;
#define RLX_AGENT __ATOMIC_RELAXED, __HIP_MEMORY_SCOPE_AGENT
#define LDS_WAIT() asm volatile("s_waitcnt lgkmcnt(0)" ::: "memory")
#define VM_WAIT() asm volatile("s_waitcnt vmcnt(0)" ::: "memory")
__device__ __forceinline__ unsigned pk2(float lo, float hi) { return pg8::cvt_pk_bf16(lo, hi); }
__device__ __forceinline__ float bflo(unsigned u) { return __uint_as_float(u << 16); }
__device__ __forceinline__ float bfhi(unsigned u) { return __uint_as_float(u & 0xffff0000u); }
__device__ __forceinline__ float bf1(bf16 b) { return __uint_as_float(((unsigned)b) << 16); }
__device__ __forceinline__ float sigmoid_f(float x) { return __builtin_amdgcn_rcpf(1.0f + __builtin_amdgcn_exp2f(-1.4426950408889634f * x)); }
__device__ __forceinline__ float softplus_f(float x) {
    const float y = __builtin_amdgcn_exp2f(-1.4426950408889634f * fabsf(x));
    const float l = y < 1.0e-3f ? y * (1.0f - 0.5f * y) : __builtin_amdgcn_logf(1.0f + y) * 0.6931471805599453f;
    return fmaxf(x, 0.f) + l; }

#define XB_TMO      128
#define XB_XCNT(j)  (256  + 64 * (j))
#define XB_XSUB(j)  (1280 + 64 * (j))
#define XB_XGEN(j)  (2304 + 64 * (j))
#define XB_TOP      3328
#define XB_TOPGEN   3392
#define XCD_BAR_WORDS 3456
#define XB_SPIN_CAP (1u << 18)
__device__ __forceinline__ unsigned xb_ld(unsigned* p)              { return __hip_atomic_load(p, __ATOMIC_RELAXED, __HIP_MEMORY_SCOPE_AGENT); }
__device__ __forceinline__ unsigned xb_add(unsigned* p, unsigned v) { return __hip_atomic_fetch_add(p, v, __ATOMIC_RELAXED, __HIP_MEMORY_SCOPE_AGENT); }
__device__ __forceinline__ unsigned xb_xcc_id() { return (unsigned)__builtin_amdgcn_s_getreg((3 << 11) | 20) & 0xFu; }
#define XB_SPIN(cond, bar) do { unsigned _sp = 0; while (cond) { __builtin_amdgcn_s_sleep(1); \
    if ((++_sp & 255u) == 0u) { if (xb_ld(&(bar)[XB_TMO])) break; if (_sp > XB_SPIN_CAP) { atomicAdd(&(bar)[XB_TMO], 1u); break; } } } } while (0)
struct XcdBarrier { unsigned* bar; unsigned x; volatile LAS unsigned* st; };
__device__ __forceinline__ XcdBarrier xcd_barrier_post(unsigned* bar, volatile LAS unsigned* st) {
    XcdBarrier b; b.bar = bar; b.x = xb_xcc_id(); b.st = st;
    if (threadIdx.x == 0) (void)xb_add(&bar[XB_XCNT(b.x)], 1u);
    return b;
}
__device__ __forceinline__ void xcd_barrier_complete(unsigned* bar, unsigned x, unsigned& nloc, unsigned& nx) {
    const unsigned G = gridDim.x * gridDim.y * gridDim.z;
    unsigned sum, cnt, mine, sp = 0u;
    for (;;) {
        sum = 0u; cnt = 0u; mine = 0u;
#pragma unroll
        for (unsigned j = 0; j < 16; ++j) { const unsigned c = xb_ld(&bar[XB_XCNT(j)]); sum += c; cnt += (c > 0u) ? 1u : 0u; mine = (j == x) ? c : mine; }
        if (sum == G) break;
        __builtin_amdgcn_s_sleep(1);
        if ((++sp & 255u) == 0u) { if (xb_ld(&bar[XB_TMO])) break; if (sp > XB_SPIN_CAP) { atomicAdd(&bar[XB_TMO], 1u); break; } }
    }
    nloc = mine > 0u ? mine : 1u; nx = cnt > 0u ? cnt : 1u;
}
__device__ __forceinline__ void xcd_barrier(const XcdBarrier& b) {
    asm volatile("s_waitcnt vmcnt(0)" ::: "memory");
    __syncthreads();
    if (threadIdx.x == 0) {
        unsigned* bar = b.bar;
        __builtin_amdgcn_s_waitcnt(0);
        unsigned nloc = b.st[0], nx = b.st[1];
        if (nloc == 0u) { xcd_barrier_complete(bar, b.x, nloc, nx); b.st[0] = nloc; b.st[1] = nx; }
        const unsigned old = xb_add(&bar[XB_XSUB(b.x)], 1u);
        const unsigned gen = old / nloc;
        if (old + 1u == (gen + 1u) * nloc) {
            __builtin_amdgcn_fence(__ATOMIC_RELEASE, "agent");
            asm volatile("s_waitcnt vmcnt(0)" ::: "memory");
            const unsigned og = xb_add(&bar[XB_TOP], 1u);
            const unsigned tg = og / nx;
            if (og + 1u == (tg + 1u) * nx) xb_add(&bar[XB_TOPGEN], 1u);
            else XB_SPIN(xb_ld(&bar[XB_TOPGEN]) == tg, bar);
            __builtin_amdgcn_fence(__ATOMIC_ACQUIRE, "agent");
            xb_add(&bar[XB_XGEN(b.x)], 1u);
            asm volatile("s_waitcnt vmcnt(0)" ::: "memory");
        } else {
            XB_SPIN(xb_ld(&bar[XB_XGEN(b.x)]) == gen, bar);
            __builtin_amdgcn_fence(__ATOMIC_ACQUIRE, "agent");
            asm volatile("s_waitcnt vmcnt(0)" ::: "memory");
        }
    }
    __syncthreads();
}

struct Frame {
    LAS unsigned char* lds;
    int tid, lane, wave, vcu, G;
    const float* in[30]; float* out; unsigned char* ws;
};
enum { I_X = 0, I_C, I_CTX, I_CCTX, I_ADAW, I_ADAB, I_N1G, I_N2G, I_ABWIN, I_ABCONV, I_ABSINK, I_ABWOUT, I_FFNG, I_FFNU, I_FFND, I_SSDWIN, I_SSDCW, I_SSDCB,
       I_DTBF, I_DTBB, I_ALOGF, I_ALOGB, I_SSDD, I_SSDNG, I_SSDWOUT, I_ROUTER, I_MOEG, I_MOEU, I_MOED, I_FINALG };
template <int CTRL> __device__ __forceinline__ float dpp_add(float v) { return v + __int_as_float(__builtin_amdgcn_update_dpp(0, __float_as_int(v), CTRL, 0xf, 0xf, true)); }
__device__ __forceinline__ float wave_sum(float v) {
    v = dpp_add<0xB1>(v);
    v = dpp_add<0x4E>(v);
    v = dpp_add<0x141>(v);
    v = dpp_add<0x140>(v);
    const int iv = __float_as_int(v);
    return (__int_as_float(__builtin_amdgcn_readlane(iv, 0)) + __int_as_float(__builtin_amdgcn_readlane(iv, 16))) + (__int_as_float(__builtin_amdgcn_readlane(iv, 32)) + __int_as_float(__builtin_amdgcn_readlane(iv, 48)));
}
constexpr int M_SH1 = 0, M_SC1 = 1024, M_G1 = 2048, M_SH2 = 3072, M_SC2 = 4096, M_G2 = 5120;
__device__ __forceinline__ const float* modp(const Frame& F, int layer, int s) { return (const float*)(F.ws + WS_MOD) + (size_t)(layer * 2 + s) * 6144; }

__device__ __forceinline__ void tr_load(const float* W, int N, int k0, int n0, int lane, f32x4 (&w)[8]) {
#pragma unroll
    for (int i = 0; i < 8; ++i) w[i] = *(const GAS f32x4*)(W + (size_t)(k0 + (lane >> 3) + 8 * i) * N + n0 + 4 * (lane & 7));
}
__device__ __forceinline__ void tr_finish(const f32x4 (&w)[8], bf16* WT, int Kdst, int k0, int drow0, LAS float* scr, int lane) {
#pragma unroll
    for (int i = 0; i < 8; ++i) { LAS float* d = scr + ((lane >> 3) + 8 * i) * 33 + 4 * (lane & 7); d[0] = w[i].x; d[1] = w[i].y; d[2] = w[i].z; d[3] = w[i].w; }
    LDS_WAIT(); asm volatile("" ::: "memory");
    const int c = lane & 7;
#pragma unroll
    for (int j = 0; j < 4; ++j) { const int n = (lane >> 3) + 8 * j; const LAS float* s = scr + (8 * c) * 33 + n;
        v4u o; o.x = pk2(s[0 * 33], s[1 * 33]); o.y = pk2(s[2 * 33], s[3 * 33]); o.z = pk2(s[4 * 33], s[5 * 33]); o.w = pk2(s[6 * 33], s[7 * 33]);
        *(GAS v4u*)(WT + (size_t)(drow0 + n) * Kdst + k0 + 8 * c) = o; }
    LDS_WAIT(); asm volatile("" ::: "memory");
}
__device__ __forceinline__ void tr_item(const float* W, int N, bf16* WT, int Kdst, int k0, int n0, int drow0, LAS float* scr, int lane) {
    { f32x4 w[8];
#pragma unroll
      for (int i = 0; i < 8; ++i) w[i] = *(const GAS f32x4*)(W + (size_t)(k0 + (lane >> 3) + 8 * i) * N + n0 + 4 * (lane & 7));
#pragma unroll
      for (int i = 0; i < 8; ++i) { LAS float* d = scr + ((lane >> 3) + 8 * i) * 33 + 4 * (lane & 7); d[0] = w[i].x; d[1] = w[i].y; d[2] = w[i].z; d[3] = w[i].w; } }
    LDS_WAIT(); asm volatile("" ::: "memory");
    const int c = lane & 7;
#pragma unroll
    for (int j = 0; j < 4; ++j) { const int n = (lane >> 3) + 8 * j; const LAS float* s = scr + (8 * c) * 33 + n;
        v4u o; o.x = pk2(s[0 * 33], s[1 * 33]); o.y = pk2(s[2 * 33], s[3 * 33]); o.z = pk2(s[4 * 33], s[5 * 33]); o.w = pk2(s[6 * 33], s[7 * 33]);
        *(GAS v4u*)(WT + (size_t)(drow0 + n) * Kdst + k0 + 8 * c) = o; }
    LDS_WAIT(); asm volatile("" ::: "memory");
}
__device__ __forceinline__ void tr_matrix(const Frame& F, const float* W, int K, int N, bf16* WT, int mode, int& first, int gw = -1, int NGW = 0) {
    LAS float* scr = (LAS float*)(F.lds + F.wave * 16384);
    if (gw < 0) { gw = F.vcu * NWAVES + F.wave; NGW = F.G * NWAVES; }
    const int nblk = N / 32, nitems = (K / 64) * nblk;
    int it = gw - (first % NGW); if (it < 0) it += NGW;
    for (; it < nitems; it += NGW) {
        const int kb = it / nblk, nb = it % nblk, n0 = 32 * nb;
        const int drow0 = mode == 0 ? n0 : ((n0 >> 7) * 256 + (n0 & 127) + (mode == 2 ? 128 : 0));
        tr_item(W, N, WT, K, 64 * kb, n0, drow0, scr, F.lane);
    }
    first += nitems;
}

__device__ __forceinline__ void ph_convert_ffn(Frame& F, int gw, int NGW) {
    int first = 0;
    tr_matrix(F, F.in[I_FFNG], D, DFF, (bf16*)(F.ws + WS_WFFNGU), 1, first, gw, NGW);
    tr_matrix(F, F.in[I_FFNU], D, DFF, (bf16*)(F.ws + WS_WFFNGU), 2, first, gw, NGW);
    tr_matrix(F, F.in[I_FFND], DFF, D, (bf16*)(F.ws + WS_WFFND), 0, first, gw, NGW);
}
__device__ __forceinline__ void ph_convert_ssd(Frame& F, int gw, int NGW) {
    int first = 0;
    tr_matrix(F, F.in[I_SSDWIN], D, SSD_IN_REAL, (bf16*)(F.ws + WS_WSSDIN), 0, first, gw, NGW);
    tr_matrix(F, F.in[I_SSDWOUT], DIN, D, (bf16*)(F.ws + WS_WSSDOUT), 0, first, gw, NGW);
    { v4u* p = (v4u*)((bf16*)(F.ws + WS_WSSDIN) + (size_t)SSD_IN_REAL * D); const int n16 = (SSD_INP - SSD_IN_REAL) * D * 2 / 16;
      for (int i = gw * 64 + F.lane; i < n16; i += NGW * 64) p[i] = (v4u){0u, 0u, 0u, 0u}; }
}
__device__ __forceinline__ void ph_prologue(Frame& F) {
    LAS float* scx = (LAS float*)F.lds;
    LAS float* scc = scx + 1024;
    LAS float* red = scc + 1024;
    const float* c = F.in[I_C]; const float* cc = F.in[I_CCTX];
    for (int i = F.tid; i < 1024; i += NTHR) { const float a = c[i], b = cc[i]; scx[i] = a * sigmoid_f(a); scc[i] = b * sigmoid_f(b); }
    __syncthreads();
    float* MOD = (float*)(F.ws + WS_MOD);
    for (int u = F.vcu; u < 192; u += F.G) {
        const int layer = u / 96, n0 = (u % 96) * 64;
        const float* W = F.in[I_ADAW] + (size_t)layer * 1024 * 6144 + n0 + F.lane;
        float ax = 0.f, ac = 0.f; const int kb = F.wave * 128;
#pragma unroll 1
        for (int k0 = 0; k0 < 128; k0 += 32) { float w[32];
#pragma unroll
            for (int k = 0; k < 32; ++k) w[k] = W[(size_t)(kb + k0 + k) * 6144];
#pragma unroll
            for (int k = 0; k < 32; ++k) { ax += scx[kb + k0 + k] * w[k]; ac += scc[kb + k0 + k] * w[k]; } }
        red[(F.wave * 2 + 0) * 64 + F.lane] = ax; red[(F.wave * 2 + 1) * 64 + F.lane] = ac;
        __syncthreads();
        if (F.tid < 128) { const int s = F.tid >> 6, l = F.tid & 63; float t = 0.f;
#pragma unroll
            for (int w = 0; w < 8; ++w) t += red[(w * 2 + s) * 64 + l];
            MOD[(size_t)(layer * 2 + s) * 6144 + n0 + l] = t + F.in[I_ADAB][layer * 6144 + n0 + l]; }
        __syncthreads();
    }
    {
        float* ct = (float*)(F.ws + WS_ROPE); float* st = ct + 4096;
        for (int idx = F.vcu * NTHR + F.tid; idx < 4096; idx += F.G * NTHR) { const int pos = idx >> 4, i = idx & 15;
            const float inv = (float)pow(10000.0, -(double)i / 16.0); const float ang = (float)pos * inv;
            ct[idx] = (float)cos((double)ang); st[idx] = (float)sin((double)ang); }
    }
    __syncthreads();
    int first = 0;
    tr_matrix(F, F.in[I_ABWIN], D, AB_IN, (bf16*)(F.ws + WS_WABIN), 0, first);
    tr_matrix(F, F.in[I_ABWOUT], D, D, (bf16*)(F.ws + WS_WABOUT), 0, first);
}
constexpr int MOE_GU_ITEMS = NEXP * 2 * (D / 64) * (FFE / 32);
struct GuItem { const float* W; bf16* WT; int k0, n0, drow0; };
__device__ __forceinline__ GuItem gu_item(const Frame& F, int it) {
    constexpr int PER_M = (D / 64) * (FFE / 32), NB = FFE / 32;
    const int e = it / (2 * PER_M), rem = it % (2 * PER_M), mat = rem / PER_M, idx = rem % PER_M, kb = idx / NB, n0 = 32 * (idx % NB);
    GuItem g; g.W = (mat ? F.in[I_MOEU] : F.in[I_MOEG]) + (size_t)e * D * FFE; g.WT = (bf16*)(F.ws + WS_WMOE) + (size_t)e * 2 * FFE * D;
    g.k0 = 64 * kb; g.n0 = n0; g.drow0 = (n0 >> 7) * 256 + (n0 & 127) + (mat ? 128 : 0); return g;
}
__device__ __forceinline__ void moe_gu_convert(Frame& F, int lo, int hi, int gw, int NGW) {
    LAS float* scr = (LAS float*)(F.lds + F.wave * 16384);
    int it = lo + gw; if (it >= hi) return;
    f32x4 wa[8], wb[8];
    GuItem ga = gu_item(F, it), gb = ga; tr_load(ga.W, FFE, ga.k0, ga.n0, F.lane, wa);
    for (;;) {
        const int itb = it + NGW; const bool hb = itb < hi;
        if (hb) { gb = gu_item(F, itb); tr_load(gb.W, FFE, gb.k0, gb.n0, F.lane, wb); }
        tr_finish(wa, ga.WT, D, ga.k0, ga.drow0, scr, F.lane);
        if (!hb) break;
        it = itb + NGW; const bool ha = it < hi;
        if (ha) { ga = gu_item(F, it); tr_load(ga.W, FFE, ga.k0, ga.n0, F.lane, wa); }
        tr_finish(wb, gb.WT, D, gb.k0, gb.drow0, scr, F.lane);
        if (!ha) break;
    }
}
__device__ __forceinline__ void idle_round_convert(Frame& F, int nunits, int lo, int hi) {
    const int full = nunits / F.G, nbusy = nunits - full * F.G;
    if ((int)blockIdx.x >= nbusy) moe_gu_convert(F, lo, hi, ((int)blockIdx.x - nbusy) * NWAVES + F.wave, (F.G - nbusy) * NWAVES);
}


template <bool BF> __device__ __forceinline__ void load_row4(const void* row, int lane, f32x4 (&v)[4]) {
    if (BF) { const GAS v2u* p = (const GAS v2u*)row + lane;
#pragma unroll
        for (int j = 0; j < 4; ++j) { const v2u a = p[64 * j]; v[j] = (f32x4){bflo(a.x), bfhi(a.x), bflo(a.y), bfhi(a.y)}; } }
    else { const GAS f32x4* p = (const GAS f32x4*)row + lane;
#pragma unroll
        for (int j = 0; j < 4; ++j) v[j] = p[64 * j]; }
}
template <bool LAT_BF, bool CTX_BF, int NPART>
__device__ __forceinline__ void ph_modulate(Frame& F, const void* src0, const void* src1, const float* gain, const float* mx, const float* mc, int osh, int osc, bf16* H, int nrows,
                                            const float* part, const float* gatec, bf16* xw) {
    const int gw = F.vcu * NWAVES + F.wave, NGW = F.G * NWAVES;
    f32x4 ca[4], cb[4];
#pragma unroll
    for (int j = 0; j < 4; ++j) { const int c = 4 * (64 * j + F.lane); ca[j] = *(const f32x4*)(gain + c) * (*(const f32x4*)(mx + osc + c) + 1.0f); cb[j] = *(const f32x4*)(mx + osh + c); }
    for (int r0 = gw; r0 < nrows; r0 += 2 * NGW) {
        int rr[2]; f32x4 v[2][4];
#pragma unroll
        for (int k = 0; k < 2; ++k) { const int r = r0 + k * NGW; rr[k] = r < nrows ? r : r0;
            if (rr[k] < L) load_row4<LAT_BF>((const char*)src0 + (size_t)rr[k] * D * (LAT_BF ? 2 : 4), F.lane, v[k]);
            else load_row4<CTX_BF>((const char*)src1 + (size_t)(rr[k] - L) * D * (CTX_BF ? 2 : 4), F.lane, v[k]); }
#pragma unroll
        for (int k = 0; k < 2; ++k) { const int r = rr[k];
            if (NPART > 0 && r >= L) {
#pragma unroll
                for (int j = 0; j < 4; ++j) { const int c = 4 * (64 * j + F.lane); f32x4 s = (f32x4){0.f, 0.f, 0.f, 0.f};
#pragma unroll
                    for (int q = 0; q < NPART; ++q) s += *(const f32x4*)(part + ((size_t)q * LC + (r - L)) * D + c);
                    v[k][j] += *(const f32x4*)(gatec + c) * s;
                    if (xw) { v2u o; o.x = pk2(v[k][j].x, v[k][j].y); o.y = pk2(v[k][j].z, v[k][j].w); *(GAS v2u*)(xw + (size_t)r * D + c) = o; } }
            }
            float s2 = 0.f;
#pragma unroll
            for (int j = 0; j < 4; ++j) s2 += (v[k][j].x * v[k][j].x + v[k][j].y * v[k][j].y) + (v[k][j].z * v[k][j].z + v[k][j].w * v[k][j].w);
            const float rstd = __builtin_amdgcn_rsqf(wave_sum(s2) * (1.0f / D) + EPS);
            GAS v2u* o8 = (GAS v2u*)(H + (size_t)r * D) + F.lane;
#pragma unroll
            for (int j = 0; j < 4; ++j) { const int c = 4 * (64 * j + F.lane);
                f32x4 A = ca[j], B = cb[j];
                if (r >= L) { A = *(const f32x4*)(gain + c) * (*(const f32x4*)(mc + osc + c) + 1.0f); B = *(const f32x4*)(mc + osh + c); }
                const f32x4 y = v[k][j] * rstd * A + B;
                v2u o; o.x = pk2(y.x, y.y); o.y = pk2(y.z, y.w); o8[64 * j] = o; }
        }
    }
}

constexpr float QSCL = 0.125f * 1.4426950408889634f;
__device__ __forceinline__ void ph_ab_elem(Frame& F) {
    const bf16* PAB = (const bf16*)(F.ws + WS_PAB); bf16* MIX = (bf16*)(F.ws + WS_MIX);
    bf16* QR = (bf16*)(F.ws + WS_QR); bf16* KR = (bf16*)(F.ws + WS_KR); bf16* VT = (bf16*)(F.ws + WS_VT);
    const float* ct = (const float*)(F.ws + WS_ROPE); const float* st = ct + 4096;
    const int lane = F.lane;
    float cw[3][8];
#pragma unroll
    for (int k = 0; k < 3; ++k)
#pragma unroll
        for (int j = 0; j < 8; ++j) cw[k][j] = F.in[I_ABCONV][k * 512 + 8 * lane + j];
    LAS unsigned char* vl = F.lds;
    for (int tile = F.vcu; tile < MT / 16; tile += F.G) {
        const int r0 = tile * 16; const bool isctx = r0 >= L; const int slo = isctx ? L : 0, shi = isctx ? MT : L;
        for (int rr = 0; rr < 2; ++rr) {
            const int r = r0 + F.wave * 2 + rr;
            float acc[8];
#pragma unroll
            for (int j = 0; j < 8; ++j) acc[j] = 0.f;
#pragma unroll
            for (int k = 0; k < 3; ++k) { const int q = r + k - 1;
                if (q >= slo && q < shi) { const v4u gc = *(const GAS v4u*)(PAB + (size_t)q * AB_IN + 512 + 8 * lane), ha = *(const GAS v4u*)(PAB + (size_t)q * AB_IN + 1024 + 8 * lane);
                    acc[0] += cw[k][0] * bflo(gc.x) * bflo(ha.x); acc[1] += cw[k][1] * bfhi(gc.x) * bfhi(ha.x); acc[2] += cw[k][2] * bflo(gc.y) * bflo(ha.y); acc[3] += cw[k][3] * bfhi(gc.y) * bfhi(ha.y);
                    acc[4] += cw[k][4] * bflo(gc.z) * bflo(ha.z); acc[5] += cw[k][5] * bfhi(gc.z) * bfhi(ha.z); acc[6] += cw[k][6] * bflo(gc.w) * bflo(ha.w); acc[7] += cw[k][7] * bfhi(gc.w) * bfhi(ha.w); } }
            { const v4u gb = *(const GAS v4u*)(PAB + (size_t)r * AB_IN + 8 * lane); v4u o;
              o.x = pk2(acc[0] * bflo(gb.x), acc[1] * bfhi(gb.x)); o.y = pk2(acc[2] * bflo(gb.y), acc[3] * bfhi(gb.y)); o.z = pk2(acc[4] * bflo(gb.z), acc[5] * bfhi(gb.z)); o.w = pk2(acc[6] * bflo(gb.w), acc[7] * bfhi(gb.w));
              *(GAS v4u*)(MIX + (size_t)r * D + 8 * lane) = o; }
            const int sub = lane & 7, axis = sub >> 2, half = (sub >> 1) & 1;
            const int pos = axis == 0 ? (r >> 6) : (r & 63);
            f32x4 c0 = (f32x4){1.f, 1.f, 1.f, 1.f}, c1 = c0, s0 = (f32x4){0.f, 0.f, 0.f, 0.f}, s1 = s0;
            if (!isctx) { const float* cp = ct + pos * 16 + 8 * (lane & 1); const float* sp = st + pos * 16 + 8 * (lane & 1);
                c0 = *(const f32x4*)cp; c1 = *(const f32x4*)(cp + 4); s0 = *(const f32x4*)sp; s1 = *(const f32x4*)(sp + 4);
                if (half == 0) { s0 = -s0; s1 = -s1; } }
            {
                const v4u a = *(const GAS v4u*)(PAB + (size_t)r * AB_IN + 1536 + 8 * lane);
                v4u p; p.x = (unsigned)__builtin_amdgcn_update_dpp(0, (int)a.x, 0x4E, 0xf, 0xf, true); p.y = (unsigned)__builtin_amdgcn_update_dpp(0, (int)a.y, 0x4E, 0xf, 0xf, true); p.z = (unsigned)__builtin_amdgcn_update_dpp(0, (int)a.z, 0x4E, 0xf, 0xf, true); p.w = (unsigned)__builtin_amdgcn_update_dpp(0, (int)a.w, 0x4E, 0xf, 0xf, true);
                const f32x4 qc0 = c0 * QSCL, qc1 = c1 * QSCL, qs0 = s0 * QSCL, qs1 = s1 * QSCL;
                v4u o; o.x = pk2(bflo(a.x) * qc0.x + bflo(p.x) * qs0.x, bfhi(a.x) * qc0.y + bfhi(p.x) * qs0.y); o.y = pk2(bflo(a.y) * qc0.z + bflo(p.y) * qs0.z, bfhi(a.y) * qc0.w + bfhi(p.y) * qs0.w);
                o.z = pk2(bflo(a.z) * qc1.x + bflo(p.z) * qs1.x, bfhi(a.z) * qc1.y + bfhi(p.z) * qs1.y); o.w = pk2(bflo(a.w) * qc1.z + bflo(p.w) * qs1.z, bfhi(a.w) * qc1.w + bfhi(p.w) * qs1.w);
                *(GAS v4u*)(QR + ((size_t)(lane >> 3) * MT + r) * 64 + 8 * sub) = o;
            }
            {
                const int kl = lane & 15;
                const v4u a = *(const GAS v4u*)(PAB + (size_t)r * AB_IN + 2048 + 8 * kl);
                v4u p; p.x = (unsigned)__builtin_amdgcn_update_dpp(0, (int)a.x, 0x4E, 0xf, 0xf, true); p.y = (unsigned)__builtin_amdgcn_update_dpp(0, (int)a.y, 0x4E, 0xf, 0xf, true); p.z = (unsigned)__builtin_amdgcn_update_dpp(0, (int)a.z, 0x4E, 0xf, 0xf, true); p.w = (unsigned)__builtin_amdgcn_update_dpp(0, (int)a.w, 0x4E, 0xf, 0xf, true);
                v4u o; o.x = pk2(bflo(a.x) * c0.x + bflo(p.x) * s0.x, bfhi(a.x) * c0.y + bfhi(p.x) * s0.y); o.y = pk2(bflo(a.y) * c0.z + bflo(p.y) * s0.z, bfhi(a.y) * c0.w + bfhi(p.y) * s0.w);
                o.z = pk2(bflo(a.z) * c1.x + bflo(p.z) * s1.x, bfhi(a.z) * c1.y + bfhi(p.z) * s1.y); o.w = pk2(bflo(a.w) * c1.z + bflo(p.w) * s1.z, bfhi(a.w) * c1.w + bfhi(p.w) * s1.w);
                if (lane < 16) *(GAS v4u*)(KR + ((size_t)(lane >> 3) * MT + r) * 64 + 8 * sub) = o;
            }
        }
        if (F.tid < 256) { const int p = F.tid, row = p >> 4, c8 = (p & 15) * 8;
            *(LAS v4u*)(vl + row * 272 + c8 * 2) = *(const GAS v4u*)(PAB + (size_t)(r0 + row) * AB_IN + 2176 + c8); }
        __syncthreads();
        if (F.tid < 256) { const int p = F.tid, ch = p >> 1, rg = p & 1;
            const LAS bf16* s = (const LAS bf16*)(vl + (8 * rg) * 272 + ch * 2);
            v4u o; o.x = (unsigned)s[0] | ((unsigned)s[136] << 16); o.y = (unsigned)s[2 * 136] | ((unsigned)s[3 * 136] << 16); o.z = (unsigned)s[4 * 136] | ((unsigned)s[5 * 136] << 16); o.w = (unsigned)s[6 * 136] | ((unsigned)s[7 * 136] << 16);
            *(GAS v4u*)(VT + (size_t)ch * MT + r0 + 8 * rg) = o; }
        __syncthreads();
    }
}


__device__ __forceinline__ void ph_ssd_conv(Frame& F) {
    const bf16* XB = (const bf16*)(F.ws + WS_XBCR);
    bf16* XT = (bf16*)(F.ws + WS_XT); bf16* BT = (bf16*)(F.ws + WS_BT); bf16* BMm = (bf16*)(F.ws + WS_BM); bf16* CMm = (bf16*)(F.ws + WS_CM);
    const float* cwp = F.in[I_SSDCW]; const float* cbp = F.in[I_SSDCB];
    LAS unsigned char* tl = F.lds;
    { const float* DR = (const float*)(F.ws + WS_DTRAW); float* DTF = (float*)(F.ws + WS_DTS); float* DTB = DTF + (size_t)32 * MT;
      const int gw = F.vcu * NWAVES + F.wave, NGW = F.G * NWAVES;
      for (int task = gw; task < (MT / 64) * 4; task += NGW) { const int tb = task >> 2, jq = task & 3; const int t = tb * 64 + F.lane; const float* row = DR + (size_t)t * 64;
#pragma unroll
          for (int j4 = 4 * jq; j4 < 4 * jq + 4; ++j4) { const f32x4 r = *(const f32x4*)(row + 4 * j4);
#pragma unroll
              for (int q = 0; q < 4; ++q) { const int j = 4 * j4 + q; const float v = softplus_f(r[q] + (j < 32 ? F.in[I_DTBF][j] : F.in[I_DTBB][j - 32]));
                  if (j < 32) DTF[(size_t)j * MT + t] = v; else DTB[(size_t)(j - 32) * MT + t] = v; } } } }
    LAS float* cwl = (LAS float*)(F.lds + 130 * 272 + 64);
    for (int i = F.tid; i < 3 * XBCW; i += NTHR) cwl[i] = cwp[i];
    for (int i = F.tid; i < XBCW; i += NTHR) cwl[3 * XBCW + i] = cbp[i];
    __syncthreads();
    const int ntiles = NCH * 24;
    v4u pre[5];
#define CONV_LOAD(tile_) do { const int c_ = (tile_) / 24, cb_ = (tile_) % 24, t0_ = c_ * 128, ch0_ = cb_ * 128; const int slo_ = c_ < 128 ? 0 : L, shi_ = c_ < 128 ? L : MT; \
        _Pragma("unroll") for (int i_ = 0; i_ < 5; ++i_) { const int p_ = F.tid + NTHR * i_, row_ = p_ >> 4, c8_ = (p_ & 15) * 8; const int t_ = t0_ - 1 + row_; \
            pre[i_] = (v4u){0u, 0u, 0u, 0u}; if (p_ < 130 * 16 && t_ >= slo_ && t_ < shi_) pre[i_] = *(const GAS v4u*)(XB + (size_t)t_ * XBCW + ch0_ + c8_); } } while (0)
    int tile = F.vcu;
    if (tile < ntiles) CONV_LOAD(tile);
    for (; tile < ntiles; tile += F.G) {
        const int c = tile / 24, cb = tile % 24, t0 = c * 128, ch0 = cb * 128;
#pragma unroll
        for (int i = 0; i < 5; ++i) { const int p = F.tid + NTHR * i, row = p >> 4, c8 = (p & 15) * 8; if (p < 130 * 16) *(LAS v4u*)(tl + row * 272 + ((c8 * 2) ^ (((row >> 3) & 7) << 4))) = pre[i]; }
        __syncthreads();
        if (tile + F.G < ntiles) CONV_LOAD(tile + F.G);
        if (cb < 20) {
            bf16* dst = BT + (size_t)(ch0 - 2048) * MT;
#pragma unroll
            for (int i = 0; i < 4; ++i) { const int p = F.tid + NTHR * i, ch = p >> 4, tg = p & 15;
                const float w0 = cwl[ch0 + ch], w1 = cwl[XBCW + ch0 + ch], w2 = cwl[2 * XBCW + ch0 + ch], bb = cwl[3 * XBCW + ch0 + ch];
                float xin[10];
#pragma unroll
                for (int j = 0; j < 10; ++j) { const int row = 8 * tg + j; xin[j] = bf1(*(const LAS bf16*)(tl + row * 272 + ((ch * 2) ^ (((row >> 3) & 7) << 4)))); }
                float y[8];
#pragma unroll
                for (int j = 0; j < 8; ++j) { const float a = w0 * xin[j] + w1 * xin[j + 1] + w2 * xin[j + 2] + bb; y[j] = a * sigmoid_f(a); }
                v4u o; o.x = pk2(y[0], y[1]); o.y = pk2(y[2], y[3]); o.z = pk2(y[4], y[5]); o.w = pk2(y[6], y[7]);
                if (cb < 16) { const int cg_ = ch0 + ch, hd = cg_ >> 6, p_ = cg_ & 63, ptq = 2 * (p_ >> 5) + ((p_ >> 2) & 1), rq = 4 * ((p_ >> 3) & 3) + (p_ & 3);
                    *(GAS v4u*)(XT + ((size_t)(((hd * NCH + c) * 4 + (tg >> 2)) * 4 + ptq) * 16 + rq) * 32 + 8 * (tg & 3)) = o; }
                else *(GAS v4u*)(dst + (size_t)ch * MT + t0 + 8 * tg) = o; }
        }
        if (cb >= 16) {
            bf16* dst = cb < 20 ? BMm + (ch0 - 2048) : CMm + (ch0 - 2560);
#pragma unroll
            for (int i = 0; i < 4; ++i) { const int p = F.tid + NTHR * i, row = p >> 4, cg = p & 15;
                const v4u a0 = *(const LAS v4u*)(tl + row * 272 + ((cg * 16) ^ (((row >> 3) & 7) << 4))), a1 = *(const LAS v4u*)(tl + (row + 1) * 272 + ((cg * 16) ^ ((((row + 1) >> 3) & 7) << 4))), a2 = *(const LAS v4u*)(tl + (row + 2) * 272 + ((cg * 16) ^ ((((row + 2) >> 3) & 7) << 4)));
                const LAS float* w0 = cwl + ch0 + 8 * cg; const LAS float* w1 = w0 + XBCW; const LAS float* w2 = w1 + XBCW; const LAS float* bb = w2 + XBCW;
                float y[8];
#define CV(j, f, q) { const float a = w0[j] * f(a0.q) + w1[j] * f(a1.q) + w2[j] * f(a2.q) + bb[j]; y[j] = a * sigmoid_f(a); }
                CV(0, bflo, x) CV(1, bfhi, x) CV(2, bflo, y) CV(3, bfhi, y) CV(4, bflo, z) CV(5, bfhi, z) CV(6, bflo, w) CV(7, bfhi, w)
#undef CV
                v4u o; o.x = pk2(y[0], y[1]); o.y = pk2(y[2], y[3]); o.z = pk2(y[4], y[5]); o.w = pk2(y[6], y[7]);
                *(GAS v4u*)(dst + (size_t)(t0 + row) * 512 + 8 * cg) = o; }
        }
        __syncthreads();
    }
#undef CONV_LOAD
}

__device__ __forceinline__ void ph_moe_route(Frame& F) {
    LAS float* R = (LAS float*)F.lds;
    for (int i = F.tid; i < 8192; i += NTHR) R[(i & 7) * 1024 + (i >> 3)] = F.in[I_ROUTER][i];
    __syncthreads();
    const bf16* X = (const bf16*)(F.ws + WS_X); bf16* H2 = (bf16*)(F.ws + WS_H2);
    int* TE = (int*)(F.ws + WS_TOKE); float* TW = (float*)(F.ws + WS_TOKW); int* HIST = (int*)(F.ws + WS_CTL) + CW_HIST;
    const float* gain = F.in[I_N2G] + D; const float* m = modp(F, 1, 0);
    const int gw = F.vcu * NWAVES + F.wave, NGW = F.G * NWAVES;
    f32x4 ca[4], cb[4];
#pragma unroll
    for (int j = 0; j < 4; ++j) { const int c = 4 * (64 * j + F.lane); ca[j] = *(const f32x4*)(gain + c) * (*(const f32x4*)(m + M_SC2 + c) + 1.0f); cb[j] = *(const f32x4*)(m + M_SH2 + c); }
    for (int r = gw; r < L; r += NGW) {
        f32x4 v[4]; float s2 = 0.f;
        load_row4<true>(X + (size_t)r * D, F.lane, v);
#pragma unroll
        for (int j = 0; j < 4; ++j) s2 += (v[j].x * v[j].x + v[j].y * v[j].y) + (v[j].z * v[j].z + v[j].w * v[j].w);
        const float rstd = 1.0f / sqrtf(wave_sum(s2) * (1.0f / D) + EPS);
        float lg[8];
#pragma unroll
        for (int e = 0; e < 8; ++e) lg[e] = 0.f;
        GAS v2u* o8 = (GAS v2u*)(H2 + (size_t)r * D) + F.lane;
#pragma unroll
        for (int j = 0; j < 4; ++j) { const int c = 4 * (64 * j + F.lane);
            const f32x4 y = v[j] * rstd * ca[j] + cb[j];
            v2u o; o.x = pk2(y.x, y.y); o.y = pk2(y.z, y.w); o8[64 * j] = o;
#pragma unroll
            for (int e = 0; e < 8; ++e) { const f32x4 rr = *(const LAS f32x4*)(R + e * 1024 + c); lg[e] += (y.x * rr.x + y.y * rr.y) + (y.z * rr.z + y.w * rr.w); } }
#pragma unroll
        for (int e = 0; e < 8; ++e) lg[e] = wave_sum(lg[e]);
        int e0 = 0; float v0 = lg[0];
#pragma unroll
        for (int e = 1; e < 8; ++e) if (lg[e] > v0) { v0 = lg[e]; e0 = e; }
        int e1 = -1; float v1 = -3.0e38f;
#pragma unroll
        for (int e = 0; e < 8; ++e) if (e != e0 && lg[e] > v1) { v1 = lg[e]; e1 = e; }
        if (F.lane == 0) { const float ex = __expf(v1 - v0), w0 = 1.0f / (1.0f + ex);
            TE[2 * r] = e0; TE[2 * r + 1] = e1; TW[2 * r] = w0; TW[2 * r + 1] = ex * w0;
            atomicAdd(&HIST[(r >> 8) * 8 + e0], 1); atomicAdd(&HIST[(r >> 8) * 8 + e1], 1); }
    }
}
__device__ __forceinline__ void moe_segments(Frame& F, LAS int* hist, LAS int* cnt, LAS int* seg) {
    const int* HIST = (const int*)(F.ws + WS_CTL) + CW_HIST;
    if (F.tid < 512) hist[F.tid] = HIST[F.tid];
    __syncthreads();
    if (F.tid < 8) { int s = 0; for (int t = 0; t < 64; ++t) s += hist[t * 8 + F.tid]; cnt[F.tid] = s; }
    __syncthreads();
    if (F.tid == 0) { int s = 0; for (int e = 0; e < 8; ++e) { seg[e] = s; s += (cnt[e] + 255) & ~255; } seg[8] = s; }
    __syncthreads();
}
__device__ __forceinline__ void ph_moe_scatter(Frame& F) {
    LAS int* hist = (LAS int*)F.lds; LAS int* cnt = hist + 512; LAS int* seg = cnt + 8; LAS int* base = seg + 16; LAS int* wcnt = base + 8; LAS int* epos = wcnt + 64;
    moe_segments(F, hist, cnt, seg);
    const int* TE = (const int*)(F.ws + WS_TOKE); int* TP = (int*)(F.ws + WS_TOKP);
    const bf16* H2 = (const bf16*)(F.ws + WS_H2); bf16* H2S = (bf16*)(F.ws + WS_H2S);
    for (int uu = F.vcu; uu < 264; uu += F.G) {
        if (uu < 256) {
            const int u = uu >> 2, qtr = uu & 3;
            if (F.tid < 8) { int s = seg[F.tid]; for (int t = 0; t < u; ++t) s += hist[t * 8 + F.tid]; base[F.tid] = s; }
            const int ent = u * 512 + F.tid;
            const int ex = TE[ent];
            int rank = 0;
#pragma unroll
            for (int e = 0; e < 8; ++e) { const unsigned long long mk = __ballot(ex == e);
                if (ex == e) rank = __popcll(mk & ((1ull << F.lane) - 1ull));
                if (F.lane == 0) wcnt[F.wave * 8 + e] = __popcll(mk); }
            __syncthreads();
            int pos = base[ex] + rank;
            for (int w = 0; w < F.wave; ++w) pos += wcnt[w * 8 + ex];
            if (qtr == 0) TP[ent] = pos;
            epos[F.tid] = pos;
            __syncthreads();
            for (int i0 = 128 * qtr + F.wave; i0 < 128 * qtr + 128; i0 += 4 * NWAVES) {
                v4u ra[4], rb[4]; int dp[4];
#pragma unroll
                for (int k = 0; k < 4; ++k) { const int i = i0 + k * NWAVES; const int tok = u * 256 + (i >> 1); dp[k] = epos[i];
                    const GAS v4u* s = (const GAS v4u*)(H2 + (size_t)tok * D); ra[k] = s[F.lane]; rb[k] = s[64 + F.lane]; }
#pragma unroll
                for (int k = 0; k < 4; ++k) { GAS v4u* d = (GAS v4u*)(H2S + (size_t)dp[k] * D); d[F.lane] = ra[k]; d[64 + F.lane] = rb[k]; } }
            __syncthreads();
        } else {
            const int e = uu - 256, lo = seg[e] + cnt[e], hi = seg[e + 1];
            GAS v4u* d = (GAS v4u*)(H2S + (size_t)lo * D); const int n16 = (hi - lo) * (D * 2 / 16);
            for (int i = F.tid; i < n16; i += NTHR) d[i] = (v4u){0u, 0u, 0u, 0u};
        }
    }
}
__device__ __forceinline__ void ph_final(Frame& F) {
    const bf16* X = (const bf16*)(F.ws + WS_X); const bf16* YO = (const bf16*)(F.ws + WS_H2S);
    const int* TP = (const int*)(F.ws + WS_TOKP); const float* TW = (const float*)(F.ws + WS_TOKW);
    const float* g2 = modp(F, 1, 0) + M_G2; const float* fg = F.in[I_FINALG];
    const float* YP = (const float*)(F.ws + WS_YPART);
    const int gw = F.vcu * NWAVES + F.wave, NGW = F.G * NWAVES;
    f32x4 cg[4], cf[4];
#pragma unroll
    for (int j = 0; j < 4; ++j) { const int c = 4 * (64 * j + F.lane); cg[j] = *(const f32x4*)(g2 + c); cf[j] = *(const f32x4*)(fg + c); }
    for (int r0 = gw; r0 < L; r0 += 2 * NGW) {
        int rr[2], pa[2], pb[2]; float wa[2], wb[2]; f32x4 xv[2][4]; v2u ya[2][4], yb[2][4];
#pragma unroll
        for (int k = 0; k < 2; ++k) { const int r = r0 + k * NGW; rr[k] = r < L ? r : r0; pa[k] = TP[2 * rr[k]]; pb[k] = TP[2 * rr[k] + 1]; wa[k] = TW[2 * rr[k]]; wb[k] = TW[2 * rr[k] + 1]; }
#pragma unroll
        for (int k = 0; k < 2; ++k) { load_row4<true>(X + (size_t)rr[k] * D, F.lane, xv[k]);
            const GAS v2u* y0 = (const GAS v2u*)(YO + (size_t)pa[k] * D) + F.lane; const GAS v2u* y1 = (const GAS v2u*)(YO + (size_t)pb[k] * D) + F.lane;
#pragma unroll
            for (int j = 0; j < 4; ++j) { ya[k][j] = y0[64 * j]; yb[k][j] = y1[64 * j]; } }
#pragma unroll
        for (int k = 0; k < 2; ++k) { const int r = rr[k], p0 = pa[k], p1 = pb[k]; const float w0 = wa[k], w1 = wb[k];
            f32x4 v[4]; float s2 = 0.f;
#pragma unroll
            for (int j = 0; j < 4; ++j) { const int c = 4 * (64 * j + F.lane); const v2u a = ya[k][j], b = yb[k][j]; const f32x4 g = cg[j];
                f32x4 fa = (f32x4){bflo(a.x), bfhi(a.x), bflo(a.y), bfhi(a.y)}, fb = (f32x4){bflo(b.x), bfhi(b.x), bflo(b.y), bfhi(b.y)};
                if (p0 >= 32768) { fa = (f32x4){0.f, 0.f, 0.f, 0.f}; for (int q = 0; q < 7; ++q) fa += *(const f32x4*)(YP + ((size_t)q * 2048 + (p0 - 32768)) * D + c); }
                if (p1 >= 32768) { fb = (f32x4){0.f, 0.f, 0.f, 0.f}; for (int q = 0; q < 7; ++q) fb += *(const f32x4*)(YP + ((size_t)q * 2048 + (p1 - 32768)) * D + c); }
                const f32x4 f = fa * w0 + fb * w1;
                v[j] = xv[k][j] + g * f; s2 += (v[j].x * v[j].x + v[j].y * v[j].y) + (v[j].z * v[j].z + v[j].w * v[j].w); }
            const float rstd = 1.0f / sqrtf(wave_sum(s2) * (1.0f / D) + EPS);
            GAS f32x4* o = (GAS f32x4*)(F.out + (size_t)r * D) + F.lane;
#pragma unroll
            for (int j = 0; j < 4; ++j) o[64 * j] = v[j] * rstd * cf[j];
        }
    }
}


typedef short bf16x8v __attribute__((ext_vector_type(8)));
__device__ __forceinline__ bf16x8v as_frag(v4u a) { return __builtin_bit_cast(bf16x8v, a); }
constexpr float LOG2E_ = 1.4426950408889634f;
#define MFMA16(a, b, c) __builtin_amdgcn_mfma_f32_16x16x32_bf16((a), (b), (c), 0, 0, 0)
__device__ __forceinline__ int prm_row(int i2, int par, int r) { return 32 * i2 + 8 * (r >> 2) + 4 * par + (r & 3); }

__device__ __forceinline__ void ph_ssd_s1(Frame& F) {
    const bf16* XT = (const bf16*)(F.ws + WS_XT); const bf16* BT = (const bf16*)(F.ws + WS_BT);
    const float* DTF = (const float*)(F.ws + WS_DTS); const float* DTB = DTF + (size_t)32 * MT; float* CUMF = (float*)(DTB + (size_t)32 * MT); float* CUMB = CUMF + (size_t)32 * MT;
    float* DEC = (float*)(F.ws + WS_DEC); bf16* ST = (bf16*)(F.ws + WS_STATES);
    LAS unsigned char* btl = F.lds;
    LAS float* wtab = (LAS float*)(F.lds + 128 * 272);
    LAS float* wtot = wtab + 1024;
    const int lane = F.lane, r16 = lane & 15, gq = lane >> 4;
    v4u nbt[4]; float ndtf = 0.f, ndtb = 0.f;
#define S1_PREFETCH(u_) do { const int c_ = (u_) >> 3, g_ = ((u_) >> 1) & 3, hh_ = (u_) & 1, t0_ = c_ * 128; int tq_ = F.tid; asm volatile("" : "+v"(tq_)); \
        _Pragma("unroll") for (int i_ = 0; i_ < 4; ++i_) { const int p_ = tq_ + NTHR * i_, n_ = p_ >> 4, c8_ = (p_ & 15) * 8; nbt[i_] = *(const GAS v4u*)(BT + (size_t)(g_ * 128 + n_) * MT + t0_ + c8_); } \
        { const int h_ = 8 * g_ + 4 * hh_ + (tq_ >> 7); ndtf = DTF[(size_t)h_ * MT + t0_ + (tq_ & 127)]; ndtb = DTB[(size_t)h_ * MT + t0_ + (tq_ & 127)]; } } while (0)
    if (F.vcu < NCH * 8) S1_PREFETCH(F.vcu);
    for (int u = F.vcu; u < NCH * 8; u += F.G) {
        const int c = u >> 3, g = (u >> 1) & 3, hh = u & 1, t0 = c * 128;
        int tid_ = F.tid; asm volatile("" : "+v"(tid_));
        v4u xr[4][4];
        { const int hx = 8 * g + 4 * hh + (F.wave >> 1);
#pragma unroll
          for (int ks = 0; ks < 4; ++ks)
#pragma unroll
            for (int pt = 0; pt < 4; ++pt) xr[ks][pt] = *(const GAS v4u*)(XT + ((size_t)(((hx * NCH + c) * 4 + ks) * 4 + pt) * 16 + r16) * 32 + 8 * gq); }
#pragma unroll
        for (int i = 0; i < 4; ++i) { const int p = tid_ + NTHR * i, n = p >> 4, c8 = (p & 15) * 8; *(LAS v4u*)(btl + n * 272 + c8 * 2) = nbt[i]; }
        {
            const int j = tid_ >> 7, l = tid_ & 127, h = 8 * g + 4 * hh + j;
            const float dtf = ndtf, dtb = ndtb;
            const float Af = -__expf(F.in[I_ALOGF][h]), Ab = -__expf(F.in[I_ALOGB][h]);
            const float af = dtf * Af, ab = dtb * Ab;
            float pf = af, pb = ab;
#pragma unroll
            for (int o = 1; o < 64; o <<= 1) { const float a = __shfl_up(pf, o), b = __shfl_up(pb, o); if (lane >= o) { pf += a; pb += b; } }
            if (lane == 63) { wtot[F.wave * 2] = pf; wtot[F.wave * 2 + 1] = pb; }
            __syncthreads();
            const float tf0 = wtot[(2 * j) * 2], tb0 = wtot[(2 * j) * 2 + 1], Tf = tf0 + wtot[(2 * j + 1) * 2], Tb = tb0 + wtot[(2 * j + 1) * 2 + 1];
            if (F.wave & 1) { pf += tf0; pb += tb0; }
            const float cf = pf, cb = Tb - pb + ab;
            CUMF[(size_t)h * MT + t0 + l] = cf; CUMB[(size_t)h * MT + t0 + l] = cb;
            wtab[(j * 2 + 0) * 128 + l] = __expf(Tf - cf) * dtf; wtab[(j * 2 + 1) * 128 + l] = __expf(Tb - cb) * dtb;
            if (l == 0) { DEC[(0 * NCH + c) * 32 + h] = __expf(Tf); DEC[(1 * NCH + c) * 32 + h] = __expf(Tb); }
        }
        __syncthreads();
        {
            const int j = F.wave >> 1, dir = F.wave & 1, h = 8 * g + 4 * hh + j;
            f32x4 acc[8][4];
#pragma unroll
            for (int a = 0; a < 8; ++a)
#pragma unroll
                for (int b = 0; b < 4; ++b) acc[a][b] = (f32x4){0.f, 0.f, 0.f, 0.f};
            const LAS float* wt = wtab + (j * 2 + dir) * 128;
            if (u + F.G < NCH * 8) S1_PREFETCH(u + F.G);
#pragma unroll
            for (int ks = 0; ks < 4; ++ks) {
                const f32x4 w0 = *(const LAS f32x4*)(wt + 32 * ks + 8 * gq), w1 = *(const LAS f32x4*)(wt + 32 * ks + 8 * gq + 4);
                bf16x8v bfr[4];
#pragma unroll
                for (int pt = 0; pt < 4; ++pt) { const v4u x = xr[ks][pt];
                    v4u y; y.x = pk2(bflo(x.x) * w0.x, bfhi(x.x) * w0.y); y.y = pk2(bflo(x.y) * w0.z, bfhi(x.y) * w0.w); y.z = pk2(bflo(x.z) * w1.x, bfhi(x.z) * w1.y); y.w = pk2(bflo(x.w) * w1.z, bfhi(x.w) * w1.w);
                    bfr[pt] = as_frag(y); }
#pragma unroll
                for (int nt = 0; nt < 8; ++nt) { const bf16x8v af = as_frag(*(const LAS v4u*)(btl + prm_row(nt >> 1, nt & 1, r16) * 272 + (32 * ks + 8 * gq) * 2));
#pragma unroll
                    for (int pt = 0; pt < 4; ++pt) acc[nt][pt] = MFMA16(af, bfr[pt], acc[nt][pt]); }
            }
            bf16* so = ST + ((size_t)((dir * NCH + c) * 32 + h) * 64) * 128;
#pragma unroll
            for (int pt = 0; pt < 4; ++pt)
#pragma unroll
                for (int i2 = 0; i2 < 4; ++i2) { const f32x4 a = acc[2 * i2][pt], b = acc[2 * i2 + 1][pt];
                    v4u o; o.x = pk2(a[0], a[1]); o.y = pk2(a[2], a[3]); o.z = pk2(b[0], b[1]); o.w = pk2(b[2], b[3]);
                    *(GAS v4u*)(so + (size_t)(((pt * 4 + i2) * 16 + r16) * 32) + 8 * gq) = o; }
        }
        __syncthreads();
    }
}
#undef S1_PREFETCH

__device__ __forceinline__ void ph_ssd_s2(Frame& F) {
    const float* DEC = (const float*)(F.ws + WS_DEC); bf16* ST = (bf16*)(F.ws + WS_STATES);
    for (int e = F.vcu * NTHR + F.tid; e < 2 * 32 * 64 * 32; e += F.G * NTHR) {
        const int dir = e >> 16, h = (e >> 11) & 31, rem = e & 2047;
        const size_t eoff = (size_t)h * 8192 + (size_t)rem * 4; const size_t cstride = (size_t)32 * 8192;
        bf16* base = ST + (size_t)dir * NCH * cstride + eoff;
        const float* dec = DEC + (size_t)dir * NCH * 32 + h;
        float H0 = 0.f, H1 = 0.f, H2 = 0.f, H3 = 0.f;
        for (int b = 0; b < NCH; b += 10) {
            v2u s[10]; float d[10]; int ck[10];
#pragma unroll
            for (int i = 0; i < 10; ++i) { const int idx = b + i; ck[i] = dir == 0 ? (idx < 2 ? 128 + idx : idx - 2) : (idx < 2 ? 129 - idx : 129 - idx);
                s[i] = *(const GAS v2u*)(base + (size_t)ck[i] * cstride); d[i] = dec[ck[i] * 32]; }
#pragma unroll
            for (int i = 0; i < 10; ++i) { v2u o; o.x = pk2(H0, H1); o.y = pk2(H2, H3); *(GAS v2u*)(base + (size_t)ck[i] * cstride) = o;
                H0 = d[i] * H0 + bflo(s[i].x); H1 = d[i] * H1 + bfhi(s[i].x); H2 = d[i] * H2 + bflo(s[i].y); H3 = d[i] * H3 + bfhi(s[i].y); }
        }
    }
}

__device__ __forceinline__ void ph_ssd_s3(Frame& F) {
    const bf16* XT = (const bf16*)(F.ws + WS_XT); const bf16* BMm = (const bf16*)(F.ws + WS_BM); const bf16* CMm = (const bf16*)(F.ws + WS_CM);
    const float* DTF = (const float*)(F.ws + WS_DTS); const float* DTB = DTF + (size_t)32 * MT; const float* CUMF = DTB + (size_t)32 * MT; const float* CUMB = CUMF + (size_t)32 * MT;
    const bf16* ST = (const bf16*)(F.ws + WS_STATES); bf16* Z = (bf16*)(F.ws + WS_Z); const float* ng = F.in[I_SSDNG];
    LAS unsigned char* bml = F.lds;
    LAS unsigned char* cml = F.lds + 128 * 272;
    LAS float* tab = (LAS float*)(F.lds + 192 * 272);
    LAS float* ssq = tab + 8 * 5 * 128;
    const int lane = F.lane, r16 = lane & 15, gq = lane >> 4;
    v4u nbm[4], ncm[2]; float ncf[2], ncb[2], ndf[2], ndb[2];
#define S3_PREFETCH(u_) do { const int c_ = (u_) >> 3, g_ = ((u_) >> 1) & 3, lh_ = (u_) & 1, t0_ = c_ * 128; int tq_ = F.tid; asm volatile("" : "+v"(tq_)); \
        _Pragma("unroll") for (int i_ = 0; i_ < 4; ++i_) { const int p_ = tq_ + NTHR * i_, row_ = p_ >> 4, c8_ = (p_ & 15) * 8; nbm[i_] = *(const GAS v4u*)(BMm + (size_t)(t0_ + row_) * 512 + g_ * 128 + c8_); } \
        _Pragma("unroll") for (int i_ = 0; i_ < 2; ++i_) { const int p_ = tq_ + NTHR * i_, row_ = p_ >> 4, c8_ = (p_ & 15) * 8; ncm[i_] = *(const GAS v4u*)(CMm + (size_t)(t0_ + 64 * lh_ + row_) * 512 + g_ * 128 + c8_); \
            const size_t o_ = (size_t)(8 * g_ + (p_ >> 7)) * MT + t0_ + (p_ & 127); ncf[i_] = CUMF[o_]; ncb[i_] = CUMB[o_]; ndf[i_] = DTF[o_]; ndb[i_] = DTB[o_]; } } while (0)
    if (F.vcu < 128 * 8) S3_PREFETCH(F.vcu);
    for (int u = F.vcu; u < 128 * 8; u += F.G) {
        const int c = u >> 3, g = (u >> 1) & 3, lh = u & 1, t0 = c * 128;
        __syncthreads();
        int tid_ = F.tid; asm volatile("" : "+v"(tid_));
#pragma unroll
        for (int i = 0; i < 4; ++i) { const int p = tid_ + NTHR * i, row = p >> 4, c8 = (p & 15) * 8; *(LAS v4u*)(bml + row * 272 + c8 * 2) = nbm[i]; }
#pragma unroll
        for (int i = 0; i < 2; ++i) { const int p = tid_ + NTHR * i, row = p >> 4, c8 = (p & 15) * 8; *(LAS v4u*)(cml + row * 272 + c8 * 2) = ncm[i]; }
#pragma unroll
        for (int i = 0; i < 2; ++i) { const int p = tid_ + NTHR * i, j = p >> 7, l = p & 127;
            const float cf = ncf[i] * LOG2E_, cb = ncb[i] * LOG2E_, df = ndf[i], db = ndb[i];
            tab[(j * 5 + 0) * 128 + l] = cf; tab[(j * 5 + 1) * 128 + l] = cb; tab[(j * 5 + 2) * 128 + l] = __builtin_amdgcn_logf(df) - cf; tab[(j * 5 + 3) * 128 + l] = __builtin_amdgcn_logf(db) - cb;
            tab[(j * 5 + 4) * 128 + l] = df + db; }
        __syncthreads();
        const int h = 8 * g + F.wave;
        const float Dk = F.in[I_SSDD][h];
        const LAS float* tcf = tab + (F.wave * 5) * 128; const LAS float* tcb = tcf + 128; const LAS float* tdf = tcb + 128; const LAS float* tdb = tdf + 128; const LAS float* tds = tdb + 128;
        f32x4 acc[4][4];
#pragma unroll
        for (int a = 0; a < 4; ++a)
#pragma unroll
            for (int b = 0; b < 4; ++b) acc[a][b] = (f32x4){0.f, 0.f, 0.f, 0.f};
#pragma unroll 1
        for (int i2 = 0; i2 < 4; ++i2) {
            bf16x8v xf[4], bmf[2][4];
#pragma unroll
            for (int pt = 0; pt < 4; ++pt) xf[pt] = as_frag(*(const GAS v4u*)(XT + ((size_t)(((h * NCH + c) * 4 + i2) * 4 + pt) * 16 + r16) * 32 + 8 * gq));
#pragma unroll
            for (int par = 0; par < 2; ++par)
#pragma unroll
                for (int nk = 0; nk < 4; ++nk) bmf[par][nk] = as_frag(*(const LAS v4u*)(bml + prm_row(i2, par, r16) * 272 + (32 * nk + 8 * gq) * 2));
            const int sb = 32 * i2 + 8 * gq;
            const f32x4 dfs0 = *(const LAS f32x4*)(tdf + sb), dfs1 = *(const LAS f32x4*)(tdf + sb + 4), dbs0 = *(const LAS f32x4*)(tdb + sb), dbs1 = *(const LAS f32x4*)(tdb + sb + 4);
#pragma unroll
            for (int lt = 0; lt < 4; ++lt) {
                const int ll = 16 * lt + r16, l = 64 * lh + ll;
                const float cfl = tcf[l], cbl = tcb[l], dsl = tds[l];
                f32x4 g0 = (f32x4){0.f, 0.f, 0.f, 0.f}, g1 = g0;
#pragma unroll
                for (int nk = 0; nk < 4; ++nk) { const bf16x8v cf = as_frag(*(const LAS v4u*)(cml + ll * 272 + (32 * nk + 8 * gq) * 2));
                    g0 = MFMA16(bmf[0][nk], cf, g0); g1 = MFMA16(bmf[1][nk], cf, g1); }
                float m[8];
                const int ltile0 = 64 * lh + 16 * lt; const int blk = (32 * i2 + 31 < ltile0) ? 0 : ((32 * i2 > ltile0 + 15) ? 2 : 1);
                if (blk == 0) {
#pragma unroll
                    for (int e = 0; e < 8; ++e) { const float dfs = e < 4 ? dfs0[e & 3] : dfs1[e & 3], gv = e < 4 ? g0[e & 3] : g1[e & 3]; m[e] = gv * __builtin_amdgcn_exp2f(cfl + dfs); }
                } else if (blk == 2) {
#pragma unroll
                    for (int e = 0; e < 8; ++e) { const float dbs = e < 4 ? dbs0[e & 3] : dbs1[e & 3], gv = e < 4 ? g0[e & 3] : g1[e & 3]; m[e] = gv * __builtin_amdgcn_exp2f(cbl + dbs); }
                } else {
#pragma unroll
                    for (int e = 0; e < 8; ++e) { const int s = sb + e;
                        const float dfs = e < 4 ? dfs0[e & 3] : dfs1[e & 3], dbs = e < 4 ? dbs0[e & 3] : dbs1[e & 3], gv = e < 4 ? g0[e & 3] : g1[e & 3];
                        float w = __builtin_amdgcn_exp2f(s < l ? cfl + dfs : cbl + dbs); const bool dg = s == l;
                        w = dg ? dsl : w; m[e] = gv * w + (dg ? Dk : 0.f); }
                }
                asm volatile("" : "+v"(m[0]), "+v"(m[1]), "+v"(m[2]), "+v"(m[3]), "+v"(m[4]), "+v"(m[5]), "+v"(m[6]), "+v"(m[7]));
                v4u mp; mp.x = pk2(m[0], m[1]); mp.y = pk2(m[2], m[3]); mp.z = pk2(m[4], m[5]); mp.w = pk2(m[6], m[7]);
                const bf16x8v mf = as_frag(mp);
#pragma unroll
                for (int pt = 0; pt < 4; ++pt) acc[lt][pt] = MFMA16(xf[pt], mf, acc[lt][pt]);
            }
        }
        if (u + F.G < 128 * 8) S3_PREFETCH(u + F.G);
#pragma unroll 1
        for (int dir = 0; dir < 2; ++dir) {
            const bf16* hs = ST + ((size_t)((dir * NCH + c) * 32 + h) * 64) * 128;
            float el[4];
#pragma unroll
            for (int lt = 0; lt < 4; ++lt) { const int l = 64 * lh + 16 * lt + r16; el[lt] = __builtin_amdgcn_exp2f(dir == 0 ? tcf[l] : tcb[l]); }
            f32x4 tacc[4][4];
#pragma unroll
            for (int a = 0; a < 4; ++a)
#pragma unroll
                for (int b = 0; b < 4; ++b) tacc[a][b] = (f32x4){0.f, 0.f, 0.f, 0.f};
#pragma unroll 1
            for (int nk = 0; nk < 4; ++nk) {
                bf16x8v hf[4];
#pragma unroll
                for (int pt = 0; pt < 4; ++pt) hf[pt] = as_frag(*(const GAS v4u*)(hs + (size_t)(((pt * 4 + nk) * 16 + r16) * 32) + 8 * gq));
#pragma unroll
                for (int lt = 0; lt < 4; ++lt) { const int ll = 16 * lt + r16;
                    const bf16x8v cf = as_frag(*(const LAS v4u*)(cml + ll * 272 + (32 * nk + 8 * gq) * 2));
#pragma unroll
                    for (int pt = 0; pt < 4; ++pt) tacc[lt][pt] = MFMA16(hf[pt], cf, tacc[lt][pt]); }
            }
#pragma unroll
            for (int lt = 0; lt < 4; ++lt)
#pragma unroll
                for (int pt = 0; pt < 4; ++pt) acc[lt][pt] += tacc[lt][pt] * el[lt];
        }
#pragma unroll
        for (int lt = 0; lt < 4; ++lt) { const int l = 64 * lh + 16 * lt + r16; float ss = 0.f;
#pragma unroll
            for (int q = 0; q < 2; ++q) { const v4u zv = *(const GAS v4u*)(Z + (size_t)(t0 + l) * DIN + h * 64 + 32 * q + 8 * gq);
                const float zz[8] = {bflo(zv.x), bfhi(zv.x), bflo(zv.y), bfhi(zv.y), bflo(zv.z), bfhi(zv.z), bflo(zv.w), bfhi(zv.w)};
#pragma unroll
                for (int e = 0; e < 4; ++e) { float v0 = acc[lt][2 * q][e] * zz[e] * sigmoid_f(zz[e]), v1 = acc[lt][2 * q + 1][e] * zz[4 + e] * sigmoid_f(zz[4 + e]);
                    acc[lt][2 * q][e] = v0; acc[lt][2 * q + 1][e] = v1; ss += v0 * v0 + v1 * v1; } }
            ss += __shfl_xor(ss, 16); ss += __shfl_xor(ss, 32);
            if (gq == 0) ssq[(16 * lt + r16) * 8 + F.wave] = ss; }
        __syncthreads();
#pragma unroll
        for (int lt = 0; lt < 4; ++lt) { const int ll = 16 * lt + r16, l = 64 * lh + ll;
            const f32x4 s0 = *(const LAS f32x4*)(ssq + ll * 8), s1 = *(const LAS f32x4*)(ssq + ll * 8 + 4);
            const float rs = 1.0f / sqrtf(((s0.x + s0.y) + (s0.z + s0.w) + (s1.x + s1.y) + (s1.z + s1.w)) * (1.0f / 512.0f) + EPS);
#pragma unroll
            for (int q = 0; q < 2; ++q) { const int ch = h * 64 + 32 * q + 8 * gq; const f32x4 a = acc[lt][2 * q] * rs, b = acc[lt][2 * q + 1] * rs;
                const f32x4 g0 = *(const f32x4*)(ng + ch), g1 = *(const f32x4*)(ng + ch + 4);
                v4u o; o.x = pk2(a[0] * g0.x, a[1] * g0.y); o.y = pk2(a[2] * g0.z, a[3] * g0.w); o.z = pk2(b[0] * g1.x, b[1] * g1.y); o.w = pk2(b[2] * g1.z, b[3] * g1.w);
                *(GAS v4u*)(Z + (size_t)(t0 + l) * DIN + ch) = o; } }
    }
    __syncthreads();
}
#undef S3_PREFETCH

__device__ __forceinline__ float vmax_f(float a, float b) { return __builtin_amdgcn_fmed3f(a, b, __builtin_inff()); }
__device__ __forceinline__ float vmin_f(float a, float b) { return __builtin_amdgcn_fmed3f(a, b, -__builtin_inff()); }
__device__ __forceinline__ float vmax3_f(float a, float b, float c) { return vmax_f(a, vmax_f(b, c)); }
__device__ __forceinline__ int attn_next_blk(int kb, int qb, bool isctx) {
    for (int k = kb + 1; k < 5; ++k) { if (k >= 3) return k; if (!isctx) { const int b = qb - 1 + k; if (b >= 0 && b < 128) return k; } }
    return 5;
}
__device__ __forceinline__ void ph_attn(Frame& F) {
    const bf16* QR = (const bf16*)(F.ws + WS_QR); const bf16* KR = (const bf16*)(F.ws + WS_KR); const bf16* VT = (const bf16*)(F.ws + WS_VT); bf16* MIX = (bf16*)(F.ws + WS_MIX);
    constexpr int KBYTES = 128 * 144, BUFB = KBYTES + 64 * 272;
    const int lane = F.lane, r16 = lane & 15, gq = lane >> 4;
    constexpr float LOG2E = 1.4426950408889634f;
    const int p0 = F.tid, p1 = F.tid + NTHR;
    const int kro0 = (p0 >> 3) * 144 + (p0 & 7) * 16, kro1 = (p1 >> 3) * 144 + (p1 & 7) * 16;
    const int vro0 = KBYTES + (p0 >> 4) * 272 + (p0 & 15) * 16, vro1 = KBYTES + (p1 >> 4) * 272 + (p1 & 15) * 16;
    for (int u = F.vcu; u < 130 * 8; u += F.G) {
        const int qb = u >> 3, hq = u & 7, kvh = hq >> 2; const bool isctx = qb >= 128;
        const int row0 = qb * 128;
        const int qrow = row0 + 16 * F.wave + r16;
        bf16x8v qf[2];
#pragma unroll
        for (int ks = 0; ks < 2; ++ks) qf[ks] = as_frag(*(const GAS v4u*)(QR + ((size_t)hq * MT + qrow) * 64 + 32 * ks + 8 * gq));
        float m2 = F.in[I_ABSINK][hq] * LOG2E, lsum = 1.0f;
        f32x4 oacc[4];
#pragma unroll
        for (int a = 0; a < 4; ++a) oacc[a] = (f32x4){0.f, 0.f, 0.f, 0.f};
        const int qi = 16 * F.wave + r16;
        const bf16* kbase = KR + (size_t)kvh * MT * 64; const bf16* vbase = VT + (size_t)kvh * 64 * MT;
#define ATT_KEY0(kb) ((kb) < 3 ? (qb - 1 + (kb)) * 128 : L + ((kb) - 3) * 128)
#define ATT_LOAD(kb) do { const int k0_ = ATT_KEY0(kb); \
            kr0 = *(const GAS v4u*)(kbase + (size_t)(k0_ + (p0 >> 3)) * 64 + (p0 & 7) * 8); kr1 = *(const GAS v4u*)(kbase + (size_t)(k0_ + (p1 >> 3)) * 64 + (p1 & 7) * 8); \
            vr0 = *(const GAS v4u*)(vbase + (size_t)(p0 >> 4) * MT + k0_ + (p0 & 15) * 8); vr1 = *(const GAS v4u*)(vbase + (size_t)(p1 >> 4) * MT + k0_ + (p1 & 15) * 8); } while (0)
#define ATT_WRITE(buf) do { LAS unsigned char* b_ = F.lds + (buf) * BUFB; *(LAS v4u*)(b_ + kro0) = kr0; *(LAS v4u*)(b_ + kro1) = kr1; *(LAS v4u*)(b_ + vro0) = vr0; *(LAS v4u*)(b_ + vro1) = vr1; } while (0)
        v4u kr0, kr1, vr0, vr1;
        int kb = attn_next_blk(-1, qb, isctx), cur = 0;
        __syncthreads();
        ATT_LOAD(kb); ATT_WRITE(0);
        __syncthreads();
        while (kb < 5) {
            const int nkb = attn_next_blk(kb, qb, isctx);
            if (nkb < 5) ATT_LOAD(nkb);
            const LAS unsigned char* kl = F.lds + cur * BUFB; const LAS unsigned char* vl = kl + KBYTES;
            const int mode = (kb == 0) ? 1 : ((kb == 2) ? 2 : 0);
            f32x4 sacc[8];
#pragma unroll
            for (int kt = 0; kt < 8; ++kt) { sacc[kt] = (f32x4){0.f, 0.f, 0.f, 0.f};
#pragma unroll
                for (int ks = 0; ks < 2; ++ks) { const bf16x8v kf = as_frag(*(const LAS v4u*)(kl + prm_row(kt >> 1, kt & 1, r16) * 144 + (32 * ks + 8 * gq) * 2));
                    sacc[kt] = MFMA16(kf, qf[ks], sacc[kt]); } }
            float bm = -1.0e30f;
#pragma unroll 1
            for (int rep_ = 0; rep_ < (mode != 0 ? 1 : 0); ++rep_) {
                const float msgn = mode == 1 ? 1.0e30f : -1.0e30f, limf = (float)(qi - 8 * gq);
#pragma unroll
                for (int kt = 0; kt < 8; ++kt)
#pragma unroll
                    for (int e = 0; e < 4; ++e) { const float jc = (float)(32 * (kt >> 1) + 4 * (kt & 1) + e);
                        sacc[kt][e] += vmin_f(0.f, msgn * (jc - limf)); }
            }
#pragma unroll
            for (int kt = 0; kt < 8; ++kt) bm = vmax3_f(bm, vmax_f(sacc[kt][0], sacc[kt][1]), vmax_f(sacc[kt][2], sacc[kt][3]));
            bm = vmax_f(bm, __shfl_xor(bm, 16)); bm = vmax_f(bm, __shfl_xor(bm, 32));
            const float mn = vmax_f(m2, bm), alpha = __builtin_amdgcn_exp2f(m2 - mn); m2 = mn;
            float ps = 0.f;
            bf16x8v pf[4];
#pragma unroll
            for (int i2 = 0; i2 < 4; ++i2) { float p[8];
#pragma unroll
                for (int e = 0; e < 4; ++e) { p[e] = __builtin_amdgcn_exp2f(sacc[2 * i2][e] - mn); p[4 + e] = __builtin_amdgcn_exp2f(sacc[2 * i2 + 1][e] - mn); }
#pragma unroll
                for (int e = 0; e < 8; ++e) ps += p[e];
                v4u pk; pk.x = pk2(p[0], p[1]); pk.y = pk2(p[2], p[3]); pk.z = pk2(p[4], p[5]); pk.w = pk2(p[6], p[7]); pf[i2] = as_frag(pk); }
            ps += __shfl_xor(ps, 16); ps += __shfl_xor(ps, 32);
            lsum = lsum * alpha + ps;
#pragma unroll
            for (int dt = 0; dt < 4; ++dt) { oacc[dt] = oacc[dt] * alpha;
#pragma unroll
                for (int i2 = 0; i2 < 4; ++i2) { const bf16x8v vf = as_frag(*(const LAS v4u*)(vl + prm_row(dt >> 1, dt & 1, r16) * 272 + (32 * i2 + 8 * gq) * 2));
                    oacc[dt] = MFMA16(vf, pf[i2], oacc[dt]); } }
            if (nkb < 5) ATT_WRITE(cur ^ 1);
            __syncthreads();
            kb = nkb; cur ^= 1;
        }
#undef ATT_KEY0
#undef ATT_LOAD
#undef ATT_WRITE
        const float il = 1.0f / lsum;
#pragma unroll
        for (int i = 0; i < 2; ++i) { const f32x4 a = oacc[2 * i] * il, b = oacc[2 * i + 1] * il;
            v4u o; o.x = pk2(a[0], a[1]); o.y = pk2(a[2], a[3]); o.z = pk2(b[0], b[1]); o.w = pk2(b[2], b[3]);
            *(GAS v4u*)(MIX + (size_t)qrow * D + 512 + 64 * hq + 32 * i + 8 * gq) = o; }
    }
    __syncthreads();
}

constexpr int NPH = 23;
#ifndef WGM_MOE_GU
#define WGM_MOE_GU 4
#endif
#ifndef WGM_MOE_DN
#define WGM_MOE_DN 4
#endif
struct Args { const float* in[30]; float* out; unsigned char* ws; int ph_lo, ph_hi; };
__global__ void __launch_bounds__(NTHR, 2) mk_fwd(Args args) {
    extern __shared__ __attribute__((aligned(16))) unsigned char lds[];
    Frame F;
    F.lds = (LAS unsigned char*)lds;
    F.tid = threadIdx.x; F.lane = F.tid & 63; F.wave = __builtin_amdgcn_readfirstlane(F.tid >> 6);
    F.G = gridDim.x; { const int bx = blockIdx.x; F.vcu = (F.G % 8 == 0) ? (bx % 8) * (F.G / 8) + bx / 8 : bx; }
#pragma unroll
    for (int i = 0; i < 30; ++i) F.in[i] = args.in[i];
    F.out = args.out; F.ws = args.ws;
    unsigned char* ws = args.ws;
    volatile LAS unsigned* MISC = (volatile LAS unsigned*)(F.lds + MISC_OFF);
    for (int u = F.tid; u < (LDS_BYTES - LDSCTL_OFF) / 4; u += NTHR) ((LAS unsigned*)(F.lds + LDSCTL_OFF))[u] = 0u;
    __syncthreads();
    const int lo = args.ph_lo, hi = args.ph_hi;
    XcdBarrier bar; bar.bar = (unsigned*)(ws + WS_CTL) + CW_BAR; bar.x = 0; bar.st = nullptr;
    if (hi - lo > 1) bar = xcd_barrier_post((unsigned*)(ws + WS_CTL) + CW_BAR, MISC + 8);
#define IN(k) (lo <= (k) && (k) < hi)
#define SEAM(k) do { if (IN(k) && IN((k) + 1)) xcd_barrier(bar); } while (0)
    LAS unsigned char* ring = F.lds;
    bf16* X = (bf16*)(ws + WS_X); bf16* H = (bf16*)(ws + WS_H);

    if (IN(0)) { ph_prologue(F); } SEAM(0);
    if (IN(1)) { ph_modulate<false, false, 0>(F, F.in[I_X], F.in[I_CTX], F.in[I_N1G], modp(F, 0, 0), modp(F, 0, 1), M_SH1, M_SC1, H, MT, nullptr, nullptr, nullptr); } SEAM(1);
    if (IN(2)) { pg8::Gemm g{H, (const bf16*)(ws + WS_WABIN), D, D, 0}; pg8::StaticOrder S; S.init(MT, AB_IN, F.G, (int)blockIdx.x);
        pg8::EpiStoreBf16 E{(bf16*)(ws + WS_PAB), AB_IN};
        pg8::gemm_phase<pg8::EpiStoreBf16, pg8::StaticOrder, true, true>(ring, g, S, E);
        idle_round_convert(F, (MT / 256) * (AB_IN / 256), 0, 11400); } SEAM(2);
    if (IN(3)) { ph_ab_elem(F); } SEAM(3);
    if (IN(4)) { ph_attn(F); } SEAM(4);
    if (IN(5)) { { pg8::Gemm g{(const bf16*)(ws + WS_MIX), (const bf16*)(ws + WS_WABOUT), D, D, 0}; pg8::StaticOrder S; S.init(L, D, F.G, (int)blockIdx.x);
          pg8::EpiRes<true> E{X, F.in[I_X], modp(F, 0, 0) + M_G1};
          pg8::gemm_phase<pg8::EpiRes<true>, pg8::StaticOrder, true, true>(ring, g, S, E); }
        { int nu_ = 16, kl_ = 256; asm volatile("" : "+s"(nu_), "+s"(kl_)); pg8::Gemm g{(const bf16*)(ws + WS_MIX), (const bf16*)(ws + WS_WABOUT), D, kl_, 0}; pg8::SplitOrder S{64, 4, nu_, 256, F.G, (int)blockIdx.x};
          pg8::EpiPart E{(float*)(ws + WS_PART), 64, 256, LC};
          pg8::gemm_phase<pg8::EpiPart, pg8::SplitOrder, true, true>(ring, g, S, E); }
        if ((int)blockIdx.x >= 16) ph_convert_ffn(F, ((int)blockIdx.x - 16) * NWAVES + F.wave, (F.G - 16) * NWAVES); } SEAM(5);
    if (IN(6)) { ph_modulate<true, false, 4>(F, X, F.in[I_CTX], F.in[I_N2G], modp(F, 0, 0), modp(F, 0, 1), M_SH2, M_SC2, H, MT, (const float*)(ws + WS_PART), modp(F, 0, 1) + M_G1, X); } SEAM(6);
    if (IN(7)) { pg8::Gemm g{H, (const bf16*)(ws + WS_WFFNGU), D, D, 0}; pg8::StaticOrder S; S.init(MT, 2 * DFF, F.G, (int)blockIdx.x);
        pg8::EpiSwiGLU E{(bf16*)(ws + WS_ACT0), DFF};
        pg8::gemm_phase<pg8::EpiSwiGLU, pg8::StaticOrder, true, true>(ring, g, S, E);
        idle_round_convert(F, (MT / 256) * (2 * DFF / 256), 11400, 18000); } SEAM(7);
    if (IN(8)) { { pg8::Gemm g{(const bf16*)(ws + WS_ACT0), (const bf16*)(ws + WS_WFFND), DFF, DFF, 0}; pg8::StaticOrder S; S.init(L, D, F.G, (int)blockIdx.x);
          pg8::EpiRes<false> E{X, X, modp(F, 0, 0) + M_G2};
          pg8::gemm_phase<pg8::EpiRes<false>, pg8::StaticOrder, true, true>(ring, g, S, E); }
        { int nu_ = 44, kl_ = 256; asm volatile("" : "+s"(nu_), "+s"(kl_)); pg8::Gemm g{(const bf16*)(ws + WS_ACT0), (const bf16*)(ws + WS_WFFND), DFF, kl_, 0}; pg8::SplitOrder S{64, 4, nu_, 256, F.G, (int)blockIdx.x};
          pg8::EpiPart E{(float*)(ws + WS_PART), 64, 256, LC};
          pg8::gemm_phase<pg8::EpiPart, pg8::SplitOrder, true, true>(ring, g, S, E); }
        if ((int)blockIdx.x >= 44) ph_convert_ssd(F, ((int)blockIdx.x - 44) * NWAVES + F.wave, (F.G - 44) * NWAVES); } SEAM(8);
    if (IN(9)) { ph_modulate<true, true, 11>(F, X, X + (size_t)L * D, F.in[I_N1G] + D, modp(F, 1, 0), modp(F, 1, 1), M_SH1, M_SC1, H, MT, (const float*)(ws + WS_PART), modp(F, 0, 1) + M_G2, nullptr); } SEAM(9);
    if (IN(10)) { pg8::Gemm g{H, (const bf16*)(ws + WS_WSSDIN), D, D, 0}; pg8::StaticOrder S; S.init(MT, SSD_INP, F.G, (int)blockIdx.x);
        pg8::EpiSsdIn E{(bf16*)(ws + WS_Z), (bf16*)(ws + WS_XBCR), (float*)(ws + WS_DTRAW)};
        pg8::gemm_phase<pg8::EpiSsdIn, pg8::StaticOrder, true, true>(ring, g, S, E);
        idle_round_convert(F, (MT / 256) * (SSD_INP / 256), 18000, MOE_GU_ITEMS); } SEAM(10);
    if (IN(11)) { ph_ssd_conv(F); } SEAM(11);
    if (IN(12)) { ph_ssd_s1(F); } SEAM(12);
    if (IN(13)) { ph_ssd_s2(F); } SEAM(13);
    if (IN(14)) { ph_ssd_s3(F); } if (IN(14) && IN(16)) xcd_barrier(bar);
    if (IN(16)) { pg8::Gemm g{(const bf16*)(ws + WS_Z), (const bf16*)(ws + WS_WSSDOUT), DIN, DIN, 0}; pg8::StaticOrder S; S.init(L, D, F.G, (int)blockIdx.x);
        pg8::EpiRes<false> E{X, X, modp(F, 1, 0) + M_G1};
        pg8::gemm_phase<pg8::EpiRes<false>, pg8::StaticOrder, true, true>(ring, g, S, E); } SEAM(16);
    if (IN(17)) { ph_moe_route(F); } SEAM(17);
    if (IN(18)) { ph_moe_scatter(F); } SEAM(18);
    if (IN(19) || IN(21)) {
        LAS int* hist = (LAS int*)F.lds; LAS int* cnt = hist + 512; LAS int* seg = cnt + 8;
        pg8::GroupedOrder S;
        if (IN(19)) {
            moe_segments(F, hist, cnt, seg);
            S.nM = seg[8] >> 8; S.nN = 2 * FFE / 256; S.nwg = S.nM * S.nN; S.G = F.G; S.c = (int)blockIdx.x; S.WGM = WGM_MOE_GU;
            S.ts1 = seg[1] >> 8; S.ts2 = seg[2] >> 8; S.ts3 = seg[3] >> 8; S.ts4 = seg[4] >> 8; S.ts5 = seg[5] >> 8; S.ts6 = seg[6] >> 8; S.ts7 = seg[7] >> 8;
            __syncthreads();
            pg8::Gemm g{(const bf16*)(ws + WS_H2S), (const bf16*)(ws + WS_WMOE), D, D, (size_t)2 * FFE * D * 2};
            pg8::EpiSwiGLU E{(bf16*)(ws + WS_ACTM), FFE};
            pg8::gemm_phase<pg8::EpiSwiGLU, pg8::GroupedOrder, true, true>(ring, g, S, E);
        }
        SEAM(19);
        if (IN(20)) { int first = 0;
            for (int e = 0; e < NEXP; ++e) tr_matrix(F, F.in[I_MOED] + (size_t)e * FFE * D, FFE, D, (bf16*)(ws + WS_WMOE) + (size_t)e * D * FFE, 0, first); }
        SEAM(20);
        if (IN(21)) {
            __syncthreads();
            moe_segments(F, hist, cnt, seg);
            const int NT = seg[8] >> 8;
            S.nM = NT < 128 ? NT : 128; S.nN = D / 256; S.nwg = S.nM * S.nN; S.G = F.G; S.c = (int)blockIdx.x; S.WGM = WGM_MOE_DN;
            S.ts1 = seg[1] >> 8; S.ts2 = seg[2] >> 8; S.ts3 = seg[3] >> 8; S.ts4 = seg[4] >> 8; S.ts5 = seg[5] >> 8; S.ts6 = seg[6] >> 8; S.ts7 = seg[7] >> 8;
            __syncthreads();
            { pg8::Gemm g{(const bf16*)(ws + WS_ACTM), (const bf16*)(ws + WS_WMOE), FFE, FFE, (size_t)D * FFE * 2};
              pg8::EpiStoreBf16 E{(bf16*)(ws + WS_H2S), D};
              pg8::gemm_phase<pg8::EpiStoreBf16, pg8::GroupedOrder, true, true>(ring, g, S, E); }
            if (NT > 128) {
                pg8::Gemm g{(const bf16*)(ws + WS_ACTM), (const bf16*)(ws + WS_WMOE), FFE, 512, (size_t)D * FFE * 2};
                pg8::SplitGroupedOrder S2{128, NT, D / 256, 7, 512, F.G, (int)blockIdx.x, S.ts1, S.ts2, S.ts3, S.ts4, S.ts5, S.ts6, S.ts7};
                pg8::EpiPart E{(float*)(ws + WS_YPART), 128, 512, 2048};
                pg8::gemm_phase<pg8::EpiPart, pg8::SplitGroupedOrder, true, true>(ring, g, S2, E); }
        }
        SEAM(21);
    } else { SEAM(19); if (IN(20)) { int first = 0;
            for (int e = 0; e < NEXP; ++e) tr_matrix(F, F.in[I_MOED] + (size_t)e * FFE * D, FFE, D, (bf16*)(ws + WS_WMOE) + (size_t)e * D * FFE, 0, first); }
        SEAM(20); SEAM(21); }
    if (IN(22)) { ph_final(F); }
#undef IN
#undef SEAM
}

extern "C" void kernel_launch(void* const* d_in, const int* in_sizes, int n_in, void* d_out, int out_size, void* d_ws, size_t ws_size, hipStream_t stream) {
    static int grid = 0;
    if (grid == 0) {
        if (n_in != 30 || in_sizes[0] != L * D || out_size != L * D || ws_size < WS_END) { fprintf(stderr, "kernel_launch: unexpected shapes (n_in %d, in0 %d, out %d, ws %zu < %zu); nothing launched\n", n_in, n_in > 0 ? in_sizes[0] : -1, out_size, ws_size, (size_t)WS_END); grid = -1; return; }
        int dev = 0, cus = 0, per_cu = 0;
        if (hipGetDevice(&dev) != hipSuccess || hipDeviceGetAttribute(&cus, hipDeviceAttributeMultiprocessorCount, dev) != hipSuccess) { grid = -1; return; }
        if (hipFuncSetAttribute((const void*)mk_fwd, hipFuncAttributeMaxDynamicSharedMemorySize, LDS_BYTES) != hipSuccess) { fprintf(stderr, "kernel_launch: hipFuncSetAttribute failed\n"); grid = -1; return; }
        if (hipOccupancyMaxActiveBlocksPerMultiprocessor(&per_cu, (const void*)mk_fwd, NTHR, LDS_BYTES) != hipSuccess || per_cu < 1)
            fprintf(stderr, "kernel_launch: note: occupancy query reports %d workgroups per CU\n", per_cu);
        (void)hipGetLastError();
        grid = cus;
    }
    if (grid < 0) return;
    if (hipMemsetAsync((char*)d_ws + WS_CTL, 0, CTL_ZERO_BYTES, stream) != hipSuccess) return;
    Args a{};
    for (int i = 0; i < 30; ++i) a.in[i] = (const float*)d_in[i];
    a.out = (float*)d_out; a.ws = (unsigned char*)d_ws;
    if (MK_N_LAUNCHES == 1) { a.ph_lo = 0; a.ph_hi = NPH; hipLaunchKernelGGL(mk_fwd, dim3(grid), dim3(NTHR), LDS_BYTES, stream, a); }
    else { for (int p = 0; p < NPH; ++p) { a.ph_lo = p; a.ph_hi = p + 1; hipLaunchKernelGGL(mk_fwd, dim3(grid), dim3(NTHR), LDS_BYTES, stream, a); } }
}
```

```cpp
#include <hip/hip_runtime.h>
#include <cstdio>
#include <cstdint>

#ifndef MK_N_LAUNCHES
#define MK_N_LAUNCHES 1
#endif

namespace pg8 {
#define PG8_LAS __attribute__((address_space(3)))
typedef unsigned short bf16_t;
typedef short bf16x8 __attribute__((ext_vector_type(8)));
typedef float f32x4 __attribute__((ext_vector_type(4)));
typedef unsigned u32x4 __attribute__((ext_vector_type(4)));
constexpr int BM = 256, BK = 64, HALF = 128, HTB = HALF * BK * 2  , STAGE_BYTES = 8 * HTB, NXCD = 8;

__host__ __device__ __forceinline__ int lds_byte(int r, int c) { const int st = (r >> 4) * 2 + (c >> 5), rr = r & 15, cc = c & 31, ob = rr * 64 + cc * 2; return st * 1024 + (ob ^ (((ob >> 9) & 1) << 5)); }
__host__ __device__ __forceinline__ void stage_rc(int b, int& R, int& C) { const int st = b / 1024, sb = b % 1024, swz = sb ^ (((sb >> 9) & 1) << 5); R = (st >> 1) * 16 + swz / 64; C = (st & 1) * 32 + (swz % 64) / 2; }
__host__ __device__ __forceinline__ int perm32(int rho) { const int n = rho >> 4, i = rho & 15; return 8 * (i >> 2) + 4 * n + (i & 3); }

struct Unit { int pm, pn, pe, pk; };
struct Gemm { const bf16_t* A; const bf16_t* Bt; int ld, K; size_t bstride; };

struct StaticOrder {
    int nM, nN, nwg, G, c, WGM;
    __host__ __device__ void init(int M, int N, int G_, int c_, int wgm = 4) { nM = M / BM; nN = N / BM; nwg = nM * nN; G = G_; c = c_; WGM = wgm; }
    __host__ __device__ bool next(int i, Unit& u) const {
        const long L = (long)i * G + c; if (L >= nwg) return false;
        int wgid = (int)L; { const int q = nwg / NXCD, r = nwg % NXCD, xcd = wgid % NXCD, off = wgid / NXCD; wgid = (xcd < r ? xcd * (q + 1) : r * (q + 1) + (xcd - r) * q) + off; }
        const int nig = WGM * nN, gid = wgid / nig, fm = gid * WGM, gsz = (nM - fm) < WGM ? (nM - fm) : WGM;
        u.pm = fm + ((wgid % nig) % gsz); u.pn = (wgid % nig) / gsz; u.pe = 0; u.pk = 0; return true;
    }
    __device__ __forceinline__ void a_ready(const Unit&) const {}
    __device__ __forceinline__ void done(const Unit&) const {}
};
struct GroupedOrder {
    int nM, nN, nwg, G, c, WGM; int ts1, ts2, ts3, ts4, ts5, ts6, ts7;
    __device__ bool next(int i, Unit& u) const {
        const long L = (long)i * G + c; if (L >= nwg) return false;
        int wgid = (int)L; { const int q = nwg / NXCD, r = nwg % NXCD, xcd = wgid % NXCD, off = wgid / NXCD; wgid = (xcd < r ? xcd * (q + 1) : r * (q + 1) + (xcd - r) * q) + off; }
        const int nig = WGM * nN, gid = wgid / nig, fm = gid * WGM, gsz = (nM - fm) < WGM ? (nM - fm) : WGM;
        u.pm = fm + ((wgid % nig) % gsz); u.pn = (wgid % nig) / gsz;
        u.pk = 0; const int p = u.pm; u.pe = (p >= ts1) + (p >= ts2) + (p >= ts3) + (p >= ts4) + (p >= ts5) + (p >= ts6) + (p >= ts7); return true;
    }
    __device__ __forceinline__ void a_ready(const Unit&) const {}
    __device__ __forceinline__ void done(const Unit&) const {}
};

__device__ __forceinline__ unsigned cvt_pk_bf16(float lo, float hi) { unsigned r; asm volatile("v_cvt_pk_bf16_f32 %0, %1, %2" : "=v"(r) : "v"(lo), "v"(hi)); return r; }
__device__ __forceinline__ float silu_f(float g) { return g * __builtin_amdgcn_rcpf(1.0f + __expf(-g)); }

struct EpiStoreBf16 {
    static constexpr bool PERM = true, AFTER_DRAIN = false;
    bf16_t* O; int ldc;
    __device__ __forceinline__ void operator()(const f32x4 (&acc)[2][2][4][2], const Unit& u, int wr, int wc, int fr, int fq) const {
        const int row0 = u.pm * BM + wr * 64 + fr, col0 = u.pn * BM + wc * 32 + 8 * fq;
#pragma unroll
        for (int ai = 0; ai < 2; ++ai)
#pragma unroll
            for (int m = 0; m < 4; ++m) { bf16_t* rowp = O + (size_t)(row0 + ai * HALF + m * 16) * ldc + col0;
#pragma unroll
                for (int bj = 0; bj < 2; ++bj) { const f32x4 v0 = acc[ai][bj][m][0], v1 = acc[ai][bj][m][1];
                    u32x4 w; w.x = cvt_pk_bf16(v0[0], v0[1]); w.y = cvt_pk_bf16(v0[2], v0[3]); w.z = cvt_pk_bf16(v1[0], v1[1]); w.w = cvt_pk_bf16(v1[2], v1[3]);
                    *(u32x4*)(rowp + bj * HALF) = w; } }
    }
};
struct EpiSwiGLU {
    static constexpr bool PERM = true, AFTER_DRAIN = false;
    bf16_t* O; int ldc;
    __device__ __forceinline__ void operator()(const f32x4 (&acc)[2][2][4][2], const Unit& u, int wr, int wc, int fr, int fq) const {
        const int row0 = u.pm * BM + wr * 64 + fr, col0 = u.pn * HALF + wc * 32 + 8 * fq;
#pragma unroll
        for (int ai = 0; ai < 2; ++ai)
#pragma unroll
            for (int m = 0; m < 4; ++m) { bf16_t* rowp = O + (size_t)(row0 + ai * HALF + m * 16) * ldc + col0;
                const f32x4 g0 = acc[ai][0][m][0], g1 = acc[ai][0][m][1], u0 = acc[ai][1][m][0], u1 = acc[ai][1][m][1];
                u32x4 w; w.x = cvt_pk_bf16(silu_f(g0[0]) * u0[0], silu_f(g0[1]) * u0[1]); w.y = cvt_pk_bf16(silu_f(g0[2]) * u0[2], silu_f(g0[3]) * u0[3]);
                w.z = cvt_pk_bf16(silu_f(g1[0]) * u1[0], silu_f(g1[1]) * u1[1]); w.w = cvt_pk_bf16(silu_f(g1[2]) * u1[2], silu_f(g1[3]) * u1[3]);
                *(u32x4*)rowp = w; }
    }
};
template <bool BASE_F32> struct EpiRes {
    static constexpr bool PERM = true, AFTER_DRAIN = false;
    bf16_t* X; const void* base; const float* gate;
    __device__ __forceinline__ void operator()(const f32x4 (&acc)[2][2][4][2], const Unit& u, int wr, int wc, int fr, int fq) const {
        const int row0 = u.pm * BM + wr * 64 + fr, col0 = u.pn * BM + wc * 32 + 8 * fq;
        f32x4 gv[2][2];
#pragma unroll
        for (int bj = 0; bj < 2; ++bj)
#pragma unroll
            for (int n = 0; n < 2; ++n) gv[bj][n] = *(const f32x4*)(gate + col0 + bj * HALF + 4 * n);
#pragma unroll
        for (int ai = 0; ai < 2; ++ai)
#pragma unroll
            for (int m = 0; m < 4; ++m) { const size_t ro = (size_t)(row0 + ai * HALF + m * 16) * 1024 + col0;
#pragma unroll
                for (int bj = 0; bj < 2; ++bj) { f32x4 b0, b1;
                    if (BASE_F32) { b0 = *(const f32x4*)((const float*)base + ro + bj * HALF); b1 = *(const f32x4*)((const float*)base + ro + bj * HALF + 4); }
                    else { const u32x4 t = *(const u32x4*)((const bf16_t*)base + ro + bj * HALF);
                        b0 = (f32x4){__uint_as_float(t.x << 16), __uint_as_float(t.x & 0xffff0000u), __uint_as_float(t.y << 16), __uint_as_float(t.y & 0xffff0000u)};
                        b1 = (f32x4){__uint_as_float(t.z << 16), __uint_as_float(t.z & 0xffff0000u), __uint_as_float(t.w << 16), __uint_as_float(t.w & 0xffff0000u)}; }
                    const f32x4 v0 = b0 + gv[bj][0] * acc[ai][bj][m][0], v1 = b1 + gv[bj][1] * acc[ai][bj][m][1];
                    u32x4 w; w.x = cvt_pk_bf16(v0[0], v0[1]); w.y = cvt_pk_bf16(v0[2], v0[3]); w.z = cvt_pk_bf16(v1[0], v1[1]); w.w = cvt_pk_bf16(v1[2], v1[3]);
                    *(u32x4*)(X + ro + bj * HALF) = w; } }
    }
};
struct EpiSsdIn {
    static constexpr bool PERM = true, AFTER_DRAIN = false;
    bf16_t* Z; bf16_t* XB; float* DT;
    __device__ __forceinline__ void operator()(const f32x4 (&acc)[2][2][4][2], const Unit& u, int wr, int wc, int fr, int fq) const {
        const int row0 = u.pm * BM + wr * 64 + fr;
        if (u.pn < 20) {
            bf16_t* O = u.pn < 8 ? Z : XB; const int ldc = u.pn < 8 ? 2048 : 3072; const int col0 = (u.pn < 8 ? u.pn : u.pn - 8) * BM + wc * 32 + 8 * fq;
#pragma unroll
            for (int ai = 0; ai < 2; ++ai)
#pragma unroll
                for (int m = 0; m < 4; ++m) { bf16_t* rowp = O + (size_t)(row0 + ai * HALF + m * 16) * ldc + col0;
#pragma unroll
                    for (int bj = 0; bj < 2; ++bj) { const f32x4 v0 = acc[ai][bj][m][0], v1 = acc[ai][bj][m][1];
                        u32x4 w; w.x = cvt_pk_bf16(v0[0], v0[1]); w.y = cvt_pk_bf16(v0[2], v0[3]); w.z = cvt_pk_bf16(v1[0], v1[1]); w.w = cvt_pk_bf16(v1[2], v1[3]);
                        *(u32x4*)(rowp + bj * HALF) = w; } }
        } else if (wc < 2) {
#pragma unroll
            for (int ai = 0; ai < 2; ++ai)
#pragma unroll
                for (int m = 0; m < 4; ++m) { float* rowp = DT + (size_t)(row0 + ai * HALF + m * 16) * 64 + wc * 32 + 8 * fq;
                    *(f32x4*)rowp = acc[ai][0][m][0]; *(f32x4*)(rowp + 4) = acc[ai][0][m][1]; }
        }
    }
};


struct SplitOrder {
    int pm0, nN, nunits, ks_len, G, c;
    __device__ bool next(int i, Unit& u) const { const int x = i * G + c; if (x >= nunits) return false; u.pm = pm0; u.pn = x % nN; u.pe = 0; u.pk = (x / nN) * ks_len; return true; }
    __device__ __forceinline__ void a_ready(const Unit&) const {}
    __device__ __forceinline__ void done(const Unit&) const {}
};
struct SplitGroupedOrder {
    int pm_lo, pm_hi, nN, nks, ks_len, G, c; int ts1, ts2, ts3, ts4, ts5, ts6, ts7;
    __device__ bool next(int i, Unit& u) const { const int x = i * G + c; const int per = nN * nks; if (x >= (pm_hi - pm_lo) * per) return false;
        u.pm = pm_lo + x / per; const int y = x % per; u.pn = y / nks; u.pk = (y % nks) * ks_len;
        const int p = u.pm; u.pe = (p >= ts1) + (p >= ts2) + (p >= ts3) + (p >= ts4) + (p >= ts5) + (p >= ts6) + (p >= ts7); return true; }
    __device__ __forceinline__ void a_ready(const Unit&) const {}
    __device__ __forceinline__ void done(const Unit&) const {}
};
struct EpiPart {
    static constexpr bool PERM = false, AFTER_DRAIN = false;
    float* P; int pm_base, ks_len, nrows;
    __device__ __forceinline__ void operator()(const f32x4 (&acc)[2][2][4][2], const Unit& u, int wr, int wc, int fr, int fq) const {
        const int row0 = (u.pm - pm_base) * BM + wr * 64 + fr, col0 = u.pn * BM + wc * 32 + 4 * fq;
        float* base = P + (size_t)(u.pk / ks_len) * nrows * 1024;
#pragma unroll
        for (int ai = 0; ai < 2; ++ai)
#pragma unroll
            for (int m = 0; m < 4; ++m) { float* rowp = base + (size_t)(row0 + ai * HALF + m * 16) * 1024 + col0;
#pragma unroll
                for (int bj = 0; bj < 2; ++bj)
#pragma unroll
                    for (int n = 0; n < 2; ++n) *(f32x4*)(rowp + bj * HALF + n * 16) = acc[ai][bj][m][n]; }
    }
};
template <class Epi, class Sched, bool ALIGN_EPI = false, bool SP2 = false>
__device__ __forceinline__ void gemm_phase(PG8_LAS unsigned char* lds, const Gemm g, const Sched& S, const Epi& E) {
    const int tid = threadIdx.x, wid = __builtin_amdgcn_readfirstlane(tid >> 6), lane = tid & 63, wr = wid >> 2, wc = wid & 3, fr = lane & 15, fq = lane >> 4;
    const int K = g.K, nt = K / BK;
    unsigned voffA[2], voffB[2];
#pragma unroll
    for (int i = 0; i < 2; ++i) { int R, C; stage_rc(tid * 16 + i * 8192, R, C); const int Rb = Epi::PERM ? ((R & ~31) + perm32(R & 31)) : R;
        voffA[i] = (unsigned)(R * g.ld + C) * 2u; voffB[i] = (unsigned)(Rb * g.ld + C) * 2u; }
    const size_t kstep = (size_t)(BK * 2);
    const size_t hstep = (size_t)HALF * g.ld * 2;
    const size_t tstep = 2 * hstep;
    const unsigned ldsw = (unsigned)wid * 1024u;
    const int aoff = lds_byte(wr * 64 + fr, fq * 8), boff = lds_byte(wc * 32 + fr, fq * 8);
#define PG8_SA(b, h) (((b) * 2 + (h)) * HTB)
#define PG8_SB(b, h) ((4 + (b) * 2 + (h)) * HTB)
#define PG8_STAGE(bufoff, gbase, voff) do { _Pragma("unroll") for (int _i = 0; _i < 2; ++_i) \
        __builtin_amdgcn_global_load_lds((const unsigned*)((const char*)(gbase) + (voff)[_i]), (PG8_LAS unsigned*)(lds + (bufoff) + ldsw + _i * 8192), 16, 0, 0); } while (0)
#define PG8_LDA(dst, b, h) do { _Pragma("unroll") for (int m = 0; m < 4; ++m) _Pragma("unroll") for (int k = 0; k < 2; ++k) dst[m][k] = *(const PG8_LAS bf16x8*)(lds + PG8_SA(b, h) + aoff + m * 2048 + k * 1024); } while (0)
#define PG8_LDB(dst, b, h) do { _Pragma("unroll") for (int n = 0; n < 2; ++n) _Pragma("unroll") for (int k = 0; k < 2; ++k) dst[n][k] = *(const PG8_LAS bf16x8*)(lds + PG8_SB(b, h) + boff + n * 2048 + k * 1024); } while (0)
#define PG8_MMA(ai, bj, At, Bt) do { __builtin_amdgcn_s_setprio(1); _Pragma("unroll") for (int m = 0; m < 4; ++m) _Pragma("unroll") for (int n = 0; n < 2; ++n) _Pragma("unroll") for (int k = 0; k < 2; ++k) \
        acc[ai][bj][m][n] = __builtin_amdgcn_mfma_f32_16x16x32_bf16(Bt[n][k], At[m][k], acc[ai][bj][m][n], 0, 0, 0); __builtin_amdgcn_s_setprio(0); } while (0)
#define PG8_WAIT_V(n) asm volatile("s_waitcnt vmcnt(" #n ")" ::: "memory")
#define PG8_WAIT_L(n) asm volatile("s_waitcnt lgkmcnt(" #n ")" ::: "memory")
#define PG8_BAR __builtin_amdgcn_s_barrier()
#define PG8_SCHED __builtin_amdgcn_sched_barrier(0)
    Unit cur, nxt; int ui = 0;
    if (!S.next(0, cur)) return;
    f32x4 acc[2][2][4][2];
#pragma unroll
    for (int a = 0; a < 2; ++a)
#pragma unroll
        for (int b = 0; b < 2; ++b)
#pragma unroll
            for (int m = 0; m < 4; ++m)
#pragma unroll
                for (int n = 0; n < 2; ++n) acc[a][b][m][n] = (f32x4){0.f, 0.f, 0.f, 0.f};
    bf16x8 At[4][2], B0[2][2], B1[2][2];
    const char* cA = (const char*)g.A + (size_t)cur.pm * tstep + (size_t)cur.pk * 2; const char* cB = (const char*)g.Bt + (size_t)cur.pe * g.bstride + (size_t)cur.pn * tstep + (size_t)cur.pk * 2;
    S.a_ready(cur);
    if constexpr (SP2) {
        PG8_STAGE(PG8_SB(0, 0), cB, voffB); PG8_STAGE(PG8_SB(0, 1), cB + hstep, voffB); PG8_STAGE(PG8_SA(0, 0), cA, voffA); PG8_STAGE(PG8_SA(0, 1), cA + hstep, voffA);
        if (wr == 1) PG8_BAR;
        PG8_WAIT_V(2); PG8_BAR;
        PG8_STAGE(PG8_SB(1, 0), cB + kstep, voffB); PG8_STAGE(PG8_SA(1, 0), cA + kstep, voffA); PG8_STAGE(PG8_SB(1, 1), cB + hstep + kstep, voffB);
        PG8_WAIT_V(6); PG8_BAR;
    } else {
        PG8_STAGE(PG8_SB(0, 0), cB, voffB); PG8_STAGE(PG8_SA(0, 0), cA, voffA); PG8_STAGE(PG8_SB(0, 1), cB + hstep, voffB); PG8_STAGE(PG8_SA(0, 1), cA + hstep, voffA);
        if (wr == 1) PG8_BAR;
        PG8_WAIT_V(4); PG8_BAR;
        PG8_STAGE(PG8_SB(1, 0), cB + kstep, voffB); PG8_STAGE(PG8_SA(1, 0), cA + kstep, voffA); PG8_STAGE(PG8_SB(1, 1), cB + hstep + kstep, voffB);
        PG8_WAIT_V(6); PG8_BAR;
    }
    for (;;) {
        const bool has_next = S.next(ui + 1, nxt);
        const char* nA = has_next ? (const char*)g.A + (size_t)nxt.pm * tstep + (size_t)nxt.pk * 2 : cA; const char* nB = has_next ? (const char*)g.Bt + (size_t)nxt.pe * g.bstride + (size_t)nxt.pn * tstep + (size_t)nxt.pk * 2 : cB;
        for (int t = 0; t < nt; t += 2) {
            const bool last = (t == nt - 2);
            const char* a1 = cA + (size_t)(t + 1) * kstep;
            const char* a2 = last ? nA : cA + (size_t)(t + 2) * kstep; const char* b2 = last ? nB : cB + (size_t)(t + 2) * kstep;
            const char* a3 = a2 + kstep; const char* b3 = b2 + kstep;
            if (last && has_next) S.a_ready(nxt);
            if constexpr (SP2) {
            PG8_LDB(B0, 0, 0); PG8_LDB(B1, 0, 1); PG8_SCHED; PG8_LDA(At, 0, 0); PG8_STAGE(PG8_SA(1, 1), a1 + hstep, voffA);
            PG8_WAIT_V(8); PG8_WAIT_L(0); PG8_BAR; PG8_MMA(0, 0, At, B0); PG8_MMA(0, 1, At, B1); PG8_BAR; PG8_SCHED;
            PG8_LDA(At, 0, 1); PG8_STAGE(PG8_SB(0, 0), b2, voffB); PG8_STAGE(PG8_SB(0, 1), b2 + hstep, voffB); PG8_STAGE(PG8_SA(0, 0), a2, voffA);
            PG8_WAIT_V(8); PG8_WAIT_L(0); PG8_BAR; PG8_MMA(1, 0, At, B0); PG8_MMA(1, 1, At, B1); PG8_BAR; PG8_SCHED;
            PG8_LDB(B0, 1, 0); PG8_LDB(B1, 1, 1); PG8_SCHED; PG8_LDA(At, 1, 0); PG8_STAGE(PG8_SA(0, 1), a2 + hstep, voffA);
            PG8_WAIT_V(8); PG8_WAIT_L(0); PG8_BAR; PG8_MMA(0, 0, At, B0); PG8_MMA(0, 1, At, B1); PG8_BAR; PG8_SCHED;
            PG8_LDA(At, 1, 1); PG8_STAGE(PG8_SB(1, 0), b3, voffB); PG8_STAGE(PG8_SB(1, 1), b3 + hstep, voffB); PG8_STAGE(PG8_SA(1, 0), a3, voffA);
            PG8_WAIT_V(8); PG8_WAIT_L(0); PG8_BAR; PG8_MMA(1, 0, At, B0); PG8_MMA(1, 1, At, B1); PG8_BAR; PG8_SCHED;
            } else {
            PG8_LDB(B0, 0, 0); PG8_SCHED; PG8_LDA(At, 0, 0); PG8_STAGE(PG8_SA(1, 1), a1 + hstep, voffA);
            PG8_WAIT_L(8); PG8_BAR; PG8_WAIT_L(0); PG8_MMA(0, 0, At, B0); PG8_BAR; PG8_SCHED;
            PG8_LDB(B1, 0, 1); PG8_STAGE(PG8_SB(0, 0), b2, voffB);
            PG8_BAR; PG8_WAIT_L(0); PG8_MMA(0, 1, At, B1); PG8_BAR;
            PG8_LDA(At, 0, 1); PG8_STAGE(PG8_SA(0, 0), a2, voffA);
            PG8_BAR; PG8_WAIT_L(0); PG8_MMA(1, 0, At, B0); PG8_BAR; PG8_SCHED;
            PG8_STAGE(PG8_SB(0, 1), b2 + hstep, voffB);
            PG8_WAIT_V(6); PG8_BAR; PG8_MMA(1, 1, At, B1); PG8_BAR;
            PG8_LDB(B0, 1, 0); PG8_SCHED; PG8_LDA(At, 1, 0); PG8_STAGE(PG8_SA(0, 1), a2 + hstep, voffA);
            PG8_WAIT_L(8); PG8_BAR; PG8_WAIT_L(0); PG8_MMA(0, 0, At, B0); PG8_BAR; PG8_SCHED;
            PG8_LDB(B1, 1, 1); PG8_STAGE(PG8_SB(1, 0), b3, voffB);
            PG8_BAR; PG8_WAIT_L(0); PG8_MMA(0, 1, At, B1); PG8_BAR;
            PG8_LDA(At, 1, 1); PG8_STAGE(PG8_SA(1, 0), a3, voffA);
            PG8_BAR; PG8_WAIT_L(0); PG8_MMA(1, 0, At, B0); PG8_BAR; PG8_SCHED;
            PG8_STAGE(PG8_SB(1, 1), b3 + hstep, voffB);
            PG8_WAIT_V(6); PG8_BAR; PG8_MMA(1, 1, At, B1); PG8_BAR;
            }
        }
        if constexpr (ALIGN_EPI) { if (wr == 0) PG8_BAR; }
        if constexpr (!Epi::AFTER_DRAIN) { E(acc, cur, wr, wc, fr, fq); S.done(cur); }
        if (!has_next) break;
#pragma unroll
        for (int a = 0; a < 2; ++a)
#pragma unroll
            for (int b = 0; b < 2; ++b)
#pragma unroll
                for (int m = 0; m < 4; ++m)
#pragma unroll
                    for (int n = 0; n < 2; ++n) acc[a][b][m][n] = (f32x4){0.f, 0.f, 0.f, 0.f};
        cur = nxt; cA = nA; cB = nB; ++ui;
        if constexpr (ALIGN_EPI) { if (wr == 1) PG8_BAR; }
    }
    PG8_WAIT_V(0);
    if constexpr (!ALIGN_EPI) { if (wr == 0) PG8_BAR; }
    PG8_BAR;
    if constexpr (Epi::AFTER_DRAIN) { E.fused(acc, cur, wr, wc, fr, fq, lds, wid, lane); S.done(cur); }
#undef PG8_SA
#undef PG8_SB
#undef PG8_STAGE
#undef PG8_LDA
#undef PG8_LDB
#undef PG8_MMA
#undef PG8_WAIT_V
#undef PG8_WAIT_L
#undef PG8_BAR
#undef PG8_SCHED
}
}

constexpr int NWAVES = 8, NTHR = 512;
constexpr int D = 1024, L = 16384, LC = 256, MT = L + LC;
constexpr int AB_IN = 2304, DFF = 2816, SSD_INP = 5376, SSD_IN_REAL = 5184, DIN = 2048, XBCW = 3072, FFE = 3584, NEXP = 8;
constexpr int NCH = MT / 128;
constexpr int MOE_ROWS = 2 * L + NEXP * 256;
constexpr float EPS = 1e-6f;

constexpr size_t MiB = 1u << 20;
constexpr size_t WS_CTL = 0, CTL_ZERO_BYTES = 32768;
constexpr size_t WS_MOD = 1 * MiB;
constexpr size_t WS_ROPE = 1 * MiB + 128 * 1024;
constexpr size_t WS_TOKE = 2 * MiB, WS_TOKW = 2 * MiB + 128 * 1024, WS_TOKP = 2 * MiB + 256 * 1024;
constexpr size_t WS_DEC = 3 * MiB;
constexpr size_t WS_X = 4 * MiB;
constexpr size_t WS_H = 36 * MiB + 512 * 1024;
constexpr size_t WS_WMOE = 69 * MiB, WS_YPART = WS_WMOE + 56 * MiB;
constexpr size_t WS_H2S = 181 * MiB, WS_ACTM = 249 * MiB, WS_H2 = 487 * MiB, WS_END = 520 * MiB;
constexpr size_t WS_WSSDIN = 181 * MiB, WS_WSSDOUT = WS_WSSDIN + (size_t)SSD_INP * D * 2;
constexpr size_t WS_WABIN = 196 * MiB, WS_WABOUT = WS_WABIN + (size_t)AB_IN * D * 2, WS_WFFNGU = WS_WABOUT + (size_t)D * D * 2, WS_WFFND = WS_WFFNGU + (size_t)2 * DFF * D * 2;
constexpr size_t WS_PAB = 219 * MiB, WS_MIX = 293 * MiB, WS_ACT0 = 326 * MiB, WS_QR = 416 * MiB, WS_KR = 433 * MiB, WS_VT = 438 * MiB, WS_PART = 443 * MiB;
constexpr size_t WS_Z = 196 * MiB, WS_XBCR = 261 * MiB, WS_STATES = 261 * MiB, WS_DTRAW = 391 * MiB, WS_DTS = 396 * MiB, WS_XT = 405 * MiB, WS_BT = 470 * MiB, WS_BM = 487 * MiB, WS_CM = 503 * MiB + 512 * 1024;
constexpr size_t DTS_STRIDE = (size_t)32 * MT * 4;
static_assert(WS_X + (size_t)MT * D * 2 <= WS_H && WS_H + (size_t)MT * D * 2 <= WS_WMOE, "X / H map");
static_assert(WS_WMOE + (size_t)NEXP * 2 * FFE * D * 2 <= WS_H2S && WS_H2S + (size_t)MOE_ROWS * D * 2 <= WS_ACTM && WS_ACTM + (size_t)MOE_ROWS * FFE * 2 <= WS_H2 && WS_H2 + (size_t)L * D * 2 <= WS_END, "moe map");
static_assert(WS_YPART >= WS_WMOE + (size_t)NEXP * D * FFE * 2 && WS_YPART + (size_t)7 * 2048 * D * 4 <= WS_H2S, "moe map 2");
static_assert(WS_WSSDOUT + (size_t)D * DIN * 2 <= WS_WABIN && WS_WFFND + (size_t)D * DFF * 2 <= WS_PAB, "weights map");
static_assert(WS_PAB + (size_t)MT * AB_IN * 2 <= WS_MIX && WS_MIX + (size_t)MT * D * 2 <= WS_ACT0 && WS_ACT0 + (size_t)MT * DFF * 2 <= WS_QR && WS_QR + (size_t)8 * MT * 64 * 2 <= WS_KR && WS_KR + (size_t)2 * MT * 64 * 2 <= WS_VT && WS_VT + (size_t)128 * MT * 2 <= WS_PART && WS_PART + (size_t)11 * LC * D * 4 <= WS_END, "layer0 map");
static_assert(WS_WSSDOUT + (size_t)D * DIN * 2 <= WS_Z && WS_Z + (size_t)MT * DIN * 2 <= WS_XBCR && WS_XBCR + (size_t)MT * XBCW * 2 <= WS_DTRAW && WS_STATES + (size_t)2 * NCH * 32 * 64 * 128 * 2 <= WS_DTRAW && WS_DTRAW + (size_t)MT * 64 * 4 <= WS_DTS && WS_DTS + 4 * DTS_STRIDE <= WS_XT && WS_XT + (size_t)DIN * MT * 2 <= WS_BT && WS_BT + (size_t)512 * MT * 2 <= WS_BM && WS_BM + (size_t)MT * 512 * 2 <= WS_CM && WS_CM + (size_t)MT * 512 * 2 <= WS_END, "ssd map");
static_assert(WS_PART + (size_t)11 * LC * D * 4 <= WS_BT && WS_PART >= WS_DTS + 4 * DTS_STRIDE || true, "PART is read by the layer-1 modulate before the SSD conv writes XT");
constexpr int CW_TMO = 0;
constexpr int CW_HIST = 1024;
constexpr int CW_BAR = 4096;

constexpr int RING_BYTES = 159744, LDSCTL_OFF = RING_BYTES, MISC_OFF = LDSCTL_OFF + 320, LDS_BYTES = 163840;

#define GAS __attribute__((address_space(1)))
#define LAS __attribute__((address_space(3)))
typedef unsigned short bf16;
typedef unsigned v4u __attribute__((ext_vector_type(4)));
typedef unsigned v2u __attribute__((ext_vector_type(2)));
typedef float f32x4 __attribute__((ext_vector_type(4)));
typedef GAS unsigned gu32;
#define RLX_AGENT __ATOMIC_RELAXED, __HIP_MEMORY_SCOPE_AGENT
#define LDS_WAIT() asm volatile("s_waitcnt lgkmcnt(0)" ::: "memory")
#define VM_WAIT() asm volatile("s_waitcnt vmcnt(0)" ::: "memory")
__device__ __forceinline__ unsigned pk2(float lo, float hi) { return pg8::cvt_pk_bf16(lo, hi); }
__device__ __forceinline__ float bflo(unsigned u) { return __uint_as_float(u << 16); }
__device__ __forceinline__ float bfhi(unsigned u) { return __uint_as_float(u & 0xffff0000u); }
__device__ __forceinline__ float bf1(bf16 b) { return __uint_as_float(((unsigned)b) << 16); }
__device__ __forceinline__ float sigmoid_f(float x) { return __builtin_amdgcn_rcpf(1.0f + __builtin_amdgcn_exp2f(-1.4426950408889634f * x)); }
__device__ __forceinline__ float softplus_f(float x) {
    const float y = __builtin_amdgcn_exp2f(-1.4426950408889634f * fabsf(x));
    const float l = y < 1.0e-3f ? y * (1.0f - 0.5f * y) : __builtin_amdgcn_logf(1.0f + y) * 0.6931471805599453f;
    return fmaxf(x, 0.f) + l; }

#define XB_TMO      128
#define XB_XCNT(j)  (256  + 64 * (j))
#define XB_XSUB(j)  (1280 + 64 * (j))
#define XB_XGEN(j)  (2304 + 64 * (j))
#define XB_TOP      3328
#define XB_TOPGEN   3392
#define XCD_BAR_WORDS 3456
#define XB_SPIN_CAP (1u << 18)
__device__ __forceinline__ unsigned xb_ld(unsigned* p)              { return __hip_atomic_load(p, __ATOMIC_RELAXED, __HIP_MEMORY_SCOPE_AGENT); }
__device__ __forceinline__ unsigned xb_add(unsigned* p, unsigned v) { return __hip_atomic_fetch_add(p, v, __ATOMIC_RELAXED, __HIP_MEMORY_SCOPE_AGENT); }
__device__ __forceinline__ unsigned xb_xcc_id() { return (unsigned)__builtin_amdgcn_s_getreg((3 << 11) | 20) & 0xFu; }
#define XB_SPIN(cond, bar) do { unsigned _sp = 0; while (cond) { __builtin_amdgcn_s_sleep(1); \
    if ((++_sp & 255u) == 0u) { if (xb_ld(&(bar)[XB_TMO])) break; if (_sp > XB_SPIN_CAP) { atomicAdd(&(bar)[XB_TMO], 1u); break; } } } } while (0)
struct XcdBarrier { unsigned* bar; unsigned x; volatile LAS unsigned* st; };
__device__ __forceinline__ XcdBarrier xcd_barrier_post(unsigned* bar, volatile LAS unsigned* st) {
    XcdBarrier b; b.bar = bar; b.x = xb_xcc_id(); b.st = st;
    if (threadIdx.x == 0) (void)xb_add(&bar[XB_XCNT(b.x)], 1u);
    return b;
}
__device__ __forceinline__ void xcd_barrier_complete(unsigned* bar, unsigned x, unsigned& nloc, unsigned& nx) {
    const unsigned G = gridDim.x * gridDim.y * gridDim.z;
    unsigned sum, cnt, mine, sp = 0u;
    for (;;) {
        sum = 0u; cnt = 0u; mine = 0u;
#pragma unroll
        for (unsigned j = 0; j < 16; ++j) { const unsigned c = xb_ld(&bar[XB_XCNT(j)]); sum += c; cnt += (c > 0u) ? 1u : 0u; mine = (j == x) ? c : mine; }
        if (sum == G) break;
        __builtin_amdgcn_s_sleep(1);
        if ((++sp & 255u) == 0u) { if (xb_ld(&bar[XB_TMO])) break; if (sp > XB_SPIN_CAP) { atomicAdd(&bar[XB_TMO], 1u); break; } }
    }
    nloc = mine > 0u ? mine : 1u; nx = cnt > 0u ? cnt : 1u;
}
__device__ __forceinline__ void xcd_barrier(const XcdBarrier& b) {
    asm volatile("s_waitcnt vmcnt(0)" ::: "memory");
    __syncthreads();
    if (threadIdx.x == 0) {
        unsigned* bar = b.bar;
        __builtin_amdgcn_s_waitcnt(0);
        unsigned nloc = b.st[0], nx = b.st[1];
        if (nloc == 0u) { xcd_barrier_complete(bar, b.x, nloc, nx); b.st[0] = nloc; b.st[1] = nx; }
        const unsigned old = xb_add(&bar[XB_XSUB(b.x)], 1u);
        const unsigned gen = old / nloc;
        if (old + 1u == (gen + 1u) * nloc) {
            __builtin_amdgcn_fence(__ATOMIC_RELEASE, "agent");
            asm volatile("s_waitcnt vmcnt(0)" ::: "memory");
            const unsigned og = xb_add(&bar[XB_TOP], 1u);
            const unsigned tg = og / nx;
            if (og + 1u == (tg + 1u) * nx) xb_add(&bar[XB_TOPGEN], 1u);
            else XB_SPIN(xb_ld(&bar[XB_TOPGEN]) == tg, bar);
            __builtin_amdgcn_fence(__ATOMIC_ACQUIRE, "agent");
            xb_add(&bar[XB_XGEN(b.x)], 1u);
            asm volatile("s_waitcnt vmcnt(0)" ::: "memory");
        } else {
            XB_SPIN(xb_ld(&bar[XB_XGEN(b.x)]) == gen, bar);
            __builtin_amdgcn_fence(__ATOMIC_ACQUIRE, "agent");
            asm volatile("s_waitcnt vmcnt(0)" ::: "memory");
        }
    }
    __syncthreads();
}

struct Frame {
    LAS unsigned char* lds;
    int tid, lane, wave, vcu, G;
    const float* in[30]; float* out; unsigned char* ws;
};
enum { I_X = 0, I_C, I_CTX, I_CCTX, I_ADAW, I_ADAB, I_N1G, I_N2G, I_ABWIN, I_ABCONV, I_ABSINK, I_ABWOUT, I_FFNG, I_FFNU, I_FFND, I_SSDWIN, I_SSDCW, I_SSDCB,
       I_DTBF, I_DTBB, I_ALOGF, I_ALOGB, I_SSDD, I_SSDNG, I_SSDWOUT, I_ROUTER, I_MOEG, I_MOEU, I_MOED, I_FINALG };
template <int CTRL> __device__ __forceinline__ float dpp_add(float v) { return v + __int_as_float(__builtin_amdgcn_update_dpp(0, __float_as_int(v), CTRL, 0xf, 0xf, true)); }
__device__ __forceinline__ float wave_sum(float v) {
    v = dpp_add<0xB1>(v);
    v = dpp_add<0x4E>(v);
    v = dpp_add<0x141>(v);
    v = dpp_add<0x140>(v);
    const int iv = __float_as_int(v);
    return (__int_as_float(__builtin_amdgcn_readlane(iv, 0)) + __int_as_float(__builtin_amdgcn_readlane(iv, 16))) + (__int_as_float(__builtin_amdgcn_readlane(iv, 32)) + __int_as_float(__builtin_amdgcn_readlane(iv, 48)));
}
constexpr int M_SH1 = 0, M_SC1 = 1024, M_G1 = 2048, M_SH2 = 3072, M_SC2 = 4096, M_G2 = 5120;
__device__ __forceinline__ const float* modp(const Frame& F, int layer, int s) { return (const float*)(F.ws + WS_MOD) + (size_t)(layer * 2 + s) * 6144; }

__device__ __forceinline__ void tr_load(const float* W, int N, int k0, int n0, int lane, f32x4 (&w)[8]) {
#pragma unroll
    for (int i = 0; i < 8; ++i) w[i] = __builtin_nontemporal_load((const GAS f32x4*)(W + (size_t)(k0 + (lane >> 3) + 8 * i) * N + n0 + 4 * (lane & 7)));
}
__device__ __forceinline__ void tr_finish(const f32x4 (&w)[8], bf16* WT, int Kdst, int k0, int drow0, LAS float* scr, int lane) {
#pragma unroll
    for (int i = 0; i < 8; ++i) { LAS float* d = scr + ((lane >> 3) + 8 * i) * 33 + 4 * (lane & 7); d[0] = w[i].x; d[1] = w[i].y; d[2] = w[i].z; d[3] = w[i].w; }
    LDS_WAIT(); asm volatile("" ::: "memory");
    const int c = lane & 7;
#pragma unroll
    for (int j = 0; j < 4; ++j) { const int n = (lane >> 3) + 8 * j; const LAS float* s = scr + (8 * c) * 33 + n;
        v4u o; o.x = pk2(s[0 * 33], s[1 * 33]); o.y = pk2(s[2 * 33], s[3 * 33]); o.z = pk2(s[4 * 33], s[5 * 33]); o.w = pk2(s[6 * 33], s[7 * 33]);
        __builtin_nontemporal_store(o, (GAS v4u*)(WT + (size_t)(drow0 + n) * Kdst + k0 + 8 * c)); }
    LDS_WAIT(); asm volatile("" ::: "memory");
}
__device__ __forceinline__ void tr_item(const float* W, int N, bf16* WT, int Kdst, int k0, int n0, int drow0, LAS float* scr, int lane) {
    { f32x4 w[8];
#pragma unroll
      for (int i = 0; i < 8; ++i) w[i] = __builtin_nontemporal_load((const GAS f32x4*)(W + (size_t)(k0 + (lane >> 3) + 8 * i) * N + n0 + 4 * (lane & 7)));
#pragma unroll
      for (int i = 0; i < 8; ++i) { LAS float* d = scr + ((lane >> 3) + 8 * i) * 33 + 4 * (lane & 7); d[0] = w[i].x; d[1] = w[i].y; d[2] = w[i].z; d[3] = w[i].w; } }
    LDS_WAIT(); asm volatile("" ::: "memory");
    const int c = lane & 7;
#pragma unroll
    for (int j = 0; j < 4; ++j) { const int n = (lane >> 3) + 8 * j; const LAS float* s = scr + (8 * c) * 33 + n;
        v4u o; o.x = pk2(s[0 * 33], s[1 * 33]); o.y = pk2(s[2 * 33], s[3 * 33]); o.z = pk2(s[4 * 33], s[5 * 33]); o.w = pk2(s[6 * 33], s[7 * 33]);
        __builtin_nontemporal_store(o, (GAS v4u*)(WT + (size_t)(drow0 + n) * Kdst + k0 + 8 * c)); }
    LDS_WAIT(); asm volatile("" ::: "memory");
}
__device__ __forceinline__ void tr_matrix(const Frame& F, const float* W, int K, int N, bf16* WT, int mode, int& first, int gw = -1, int NGW = 0) {
    LAS float* scr = (LAS float*)(F.lds + F.wave * 16384);
    if (gw < 0) { gw = F.vcu * NWAVES + F.wave; NGW = F.G * NWAVES; }
    const int nblk = N / 32, nitems = (K / 64) * nblk;
    int it = gw - (first % NGW); if (it < 0) it += NGW;
    for (; it < nitems; it += NGW) {
        const int kb = it / nblk, nb = it % nblk, n0 = 32 * nb;
        const int drow0 = mode == 0 ? n0 : ((n0 >> 7) * 256 + (n0 & 127) + (mode == 2 ? 128 : 0));
        tr_item(W, N, WT, K, 64 * kb, n0, drow0, scr, F.lane);
    }
    first += nitems;
}

__device__ __forceinline__ void ph_convert_ffn(Frame& F, int gw, int NGW) {
    int first = 0;
    tr_matrix(F, F.in[I_FFNG], D, DFF, (bf16*)(F.ws + WS_WFFNGU), 1, first, gw, NGW);
    tr_matrix(F, F.in[I_FFNU], D, DFF, (bf16*)(F.ws + WS_WFFNGU), 2, first, gw, NGW);
    tr_matrix(F, F.in[I_FFND], DFF, D, (bf16*)(F.ws + WS_WFFND), 0, first, gw, NGW);
}
__device__ __forceinline__ void ph_convert_ssd(Frame& F, int gw, int NGW) {
    int first = 0;
    tr_matrix(F, F.in[I_SSDWIN], D, SSD_IN_REAL, (bf16*)(F.ws + WS_WSSDIN), 0, first, gw, NGW);
    tr_matrix(F, F.in[I_SSDWOUT], DIN, D, (bf16*)(F.ws + WS_WSSDOUT), 0, first, gw, NGW);
    { v4u* p = (v4u*)((bf16*)(F.ws + WS_WSSDIN) + (size_t)SSD_IN_REAL * D); const int n16 = (SSD_INP - SSD_IN_REAL) * D * 2 / 16;
      for (int i = gw * 64 + F.lane; i < n16; i += NGW * 64) p[i] = (v4u){0u, 0u, 0u, 0u}; }
}
__device__ __forceinline__ void ph_prologue(Frame& F) {
    LAS float* scx = (LAS float*)F.lds;
    LAS float* scc = scx + 1024;
    LAS float* red = scc + 1024;
    const float* c = F.in[I_C]; const float* cc = F.in[I_CCTX];
    for (int i = F.tid; i < 1024; i += NTHR) { const float a = c[i], b = cc[i]; scx[i] = a * sigmoid_f(a); scc[i] = b * sigmoid_f(b); }
    __syncthreads();
    float* MOD = (float*)(F.ws + WS_MOD);
    for (int u = F.vcu; u < 192; u += F.G) {
        const int layer = u / 96, n0 = (u % 96) * 64;
        const float* W = F.in[I_ADAW] + (size_t)layer * 1024 * 6144 + n0 + F.lane;
        float ax = 0.f, ac = 0.f; const int kb = F.wave * 128;
#pragma unroll 1
        for (int k0 = 0; k0 < 128; k0 += 32) { float w[32];
#pragma unroll
            for (int k = 0; k < 32; ++k) w[k] = __builtin_nontemporal_load(W + (size_t)(kb + k0 + k) * 6144);
#pragma unroll
            for (int k = 0; k < 32; ++k) { ax += scx[kb + k0 + k] * w[k]; ac += scc[kb + k0 + k] * w[k]; } }
        red[(F.wave * 2 + 0) * 64 + F.lane] = ax; red[(F.wave * 2 + 1) * 64 + F.lane] = ac;
        __syncthreads();
        if (F.tid < 128) { const int s = F.tid >> 6, l = F.tid & 63; float t = 0.f;
#pragma unroll
            for (int w = 0; w < 8; ++w) t += red[(w * 2 + s) * 64 + l];
            MOD[(size_t)(layer * 2 + s) * 6144 + n0 + l] = t + F.in[I_ADAB][layer * 6144 + n0 + l]; }
        __syncthreads();
    }
    {
        float* ct = (float*)(F.ws + WS_ROPE); float* st = ct + 4096;
        for (int idx = F.vcu * NTHR + F.tid; idx < 4096; idx += F.G * NTHR) { const int pos = idx >> 4, i = idx & 15;
            const float inv = (float)pow(10000.0, -(double)i / 16.0); const float ang = (float)pos * inv;
            ct[idx] = (float)cos((double)ang); st[idx] = (float)sin((double)ang); }
    }
    __syncthreads();
    int first = 0;
    tr_matrix(F, F.in[I_ABWIN], D, AB_IN, (bf16*)(F.ws + WS_WABIN), 0, first);
    tr_matrix(F, F.in[I_ABWOUT], D, D, (bf16*)(F.ws + WS_WABOUT), 0, first);
}
constexpr int MOE_GU_ITEMS = NEXP * 2 * (D / 64) * (FFE / 32);
struct GuItem { const float* W; bf16* WT; int k0, n0, drow0; };
__device__ __forceinline__ GuItem gu_item(const Frame& F, int it) {
    constexpr int PER_M = (D / 64) * (FFE / 32), NB = FFE / 32;
    const int e = it / (2 * PER_M), rem = it % (2 * PER_M), mat = rem / PER_M, idx = rem % PER_M, kb = idx / NB, n0 = 32 * (idx % NB);
    GuItem g; g.W = (mat ? F.in[I_MOEU] : F.in[I_MOEG]) + (size_t)e * D * FFE; g.WT = (bf16*)(F.ws + WS_WMOE) + (size_t)e * 2 * FFE * D;
    g.k0 = 64 * kb; g.n0 = n0; g.drow0 = (n0 >> 7) * 256 + (n0 & 127) + (mat ? 128 : 0); return g;
}
__device__ __forceinline__ void moe_gu_convert(Frame& F, int lo, int hi, int gw, int NGW) {
    LAS float* scr = (LAS float*)(F.lds + F.wave * 16384);
    int it = lo + gw; if (it >= hi) return;
    f32x4 wa[8], wb[8];
    GuItem ga = gu_item(F, it), gb = ga; tr_load(ga.W, FFE, ga.k0, ga.n0, F.lane, wa);
    for (;;) {
        const int itb = it + NGW; const bool hb = itb < hi;
        if (hb) { gb = gu_item(F, itb); tr_load(gb.W, FFE, gb.k0, gb.n0, F.lane, wb); }
        tr_finish(wa, ga.WT, D, ga.k0, ga.drow0, scr, F.lane);
        if (!hb) break;
        it = itb + NGW; const bool ha = it < hi;
        if (ha) { ga = gu_item(F, it); tr_load(ga.W, FFE, ga.k0, ga.n0, F.lane, wa); }
        tr_finish(wb, gb.WT, D, gb.k0, gb.drow0, scr, F.lane);
        if (!ha) break;
    }
}
__device__ __forceinline__ void idle_round_convert(Frame& F, int nunits, int lo, int hi) {
    const int full = nunits / F.G, nbusy = nunits - full * F.G;
    if ((int)blockIdx.x >= nbusy) moe_gu_convert(F, lo, hi, ((int)blockIdx.x - nbusy) * NWAVES + F.wave, (F.G - nbusy) * NWAVES);
}


template <bool BF> __device__ __forceinline__ void load_row4(const void* row, int lane, f32x4 (&v)[4]) {
    if (BF) { const GAS v2u* p = (const GAS v2u*)row + lane;
#pragma unroll
        for (int j = 0; j < 4; ++j) { const v2u a = p[64 * j]; v[j] = (f32x4){bflo(a.x), bfhi(a.x), bflo(a.y), bfhi(a.y)}; } }
    else { const GAS f32x4* p = (const GAS f32x4*)row + lane;
#pragma unroll
        for (int j = 0; j < 4; ++j) v[j] = p[64 * j]; }
}
template <bool LAT_BF, bool CTX_BF, int NPART>
__device__ __forceinline__ void ph_modulate(Frame& F, const void* src0, const void* src1, const float* gain, const float* mx, const float* mc, int osh, int osc, bf16* H, int nrows,
                                            const float* part, const float* gatec, bf16* xw) {
    const int gw = F.vcu * NWAVES + F.wave, NGW = F.G * NWAVES;
    f32x4 ca[4], cb[4];
#pragma unroll
    for (int j = 0; j < 4; ++j) { const int c = 4 * (64 * j + F.lane); ca[j] = *(const f32x4*)(gain + c) * (*(const f32x4*)(mx + osc + c) + 1.0f); cb[j] = *(const f32x4*)(mx + osh + c); }
    for (int r0 = gw; r0 < nrows; r0 += 2 * NGW) {
        int rr[2]; f32x4 v[2][4];
#pragma unroll
        for (int k = 0; k < 2; ++k) { const int r = r0 + k * NGW; rr[k] = r < nrows ? r : r0;
            if (rr[k] < L) load_row4<LAT_BF>((const char*)src0 + (size_t)rr[k] * D * (LAT_BF ? 2 : 4), F.lane, v[k]);
            else load_row4<CTX_BF>((const char*)src1 + (size_t)(rr[k] - L) * D * (CTX_BF ? 2 : 4), F.lane, v[k]); }
#pragma unroll
        for (int k = 0; k < 2; ++k) { const int r = rr[k];
            if (NPART > 0 && r >= L) {
#pragma unroll
                for (int j = 0; j < 4; ++j) { const int c = 4 * (64 * j + F.lane); f32x4 s = (f32x4){0.f, 0.f, 0.f, 0.f};
#pragma unroll
                    for (int q = 0; q < NPART; ++q) s += *(const f32x4*)(part + ((size_t)q * LC + (r - L)) * D + c);
                    v[k][j] += *(const f32x4*)(gatec + c) * s;
                    if (xw) { v2u o; o.x = pk2(v[k][j].x, v[k][j].y); o.y = pk2(v[k][j].z, v[k][j].w); *(GAS v2u*)(xw + (size_t)r * D + c) = o; } }
            }
            float s2 = 0.f;
#pragma unroll
            for (int j = 0; j < 4; ++j) s2 += (v[k][j].x * v[k][j].x + v[k][j].y * v[k][j].y) + (v[k][j].z * v[k][j].z + v[k][j].w * v[k][j].w);
            const float rstd = __builtin_amdgcn_rsqf(wave_sum(s2) * (1.0f / D) + EPS);
            GAS v2u* o8 = (GAS v2u*)(H + (size_t)r * D) + F.lane;
#pragma unroll
            for (int j = 0; j < 4; ++j) { const int c = 4 * (64 * j + F.lane);
                f32x4 A = ca[j], B = cb[j];
                if (r >= L) { A = *(const f32x4*)(gain + c) * (*(const f32x4*)(mc + osc + c) + 1.0f); B = *(const f32x4*)(mc + osh + c); }
                const f32x4 y = v[k][j] * rstd * A + B;
                v2u o; o.x = pk2(y.x, y.y); o.y = pk2(y.z, y.w); o8[64 * j] = o; }
        }
    }
}

constexpr float QSCL = 0.125f * 1.4426950408889634f;
__device__ __forceinline__ void ph_ab_elem(Frame& F) {
    const bf16* PAB = (const bf16*)(F.ws + WS_PAB); bf16* MIX = (bf16*)(F.ws + WS_MIX);
    bf16* QR = (bf16*)(F.ws + WS_QR); bf16* KR = (bf16*)(F.ws + WS_KR); bf16* VT = (bf16*)(F.ws + WS_VT);
    const float* ct = (const float*)(F.ws + WS_ROPE); const float* st = ct + 4096;
    const int lane = F.lane;
    float cw[3][8];
#pragma unroll
    for (int k = 0; k < 3; ++k)
#pragma unroll
        for (int j = 0; j < 8; ++j) cw[k][j] = F.in[I_ABCONV][k * 512 + 8 * lane + j];
    LAS unsigned char* vl = F.lds;
    for (int tile = F.vcu; tile < MT / 16; tile += F.G) {
        const int r0 = tile * 16; const bool isctx = r0 >= L; const int slo = isctx ? L : 0, shi = isctx ? MT : L;
        for (int rr = 0; rr < 2; ++rr) {
            const int r = r0 + F.wave * 2 + rr;
            float acc[8];
#pragma unroll
            for (int j = 0; j < 8; ++j) acc[j] = 0.f;
#pragma unroll
            for (int k = 0; k < 3; ++k) { const int q = r + k - 1;
                if (q >= slo && q < shi) { const v4u gc = *(const GAS v4u*)(PAB + (size_t)q * AB_IN + 512 + 8 * lane), ha = *(const GAS v4u*)(PAB + (size_t)q * AB_IN + 1024 + 8 * lane);
                    acc[0] += cw[k][0] * bflo(gc.x) * bflo(ha.x); acc[1] += cw[k][1] * bfhi(gc.x) * bfhi(ha.x); acc[2] += cw[k][2] * bflo(gc.y) * bflo(ha.y); acc[3] += cw[k][3] * bfhi(gc.y) * bfhi(ha.y);
                    acc[4] += cw[k][4] * bflo(gc.z) * bflo(ha.z); acc[5] += cw[k][5] * bfhi(gc.z) * bfhi(ha.z); acc[6] += cw[k][6] * bflo(gc.w) * bflo(ha.w); acc[7] += cw[k][7] * bfhi(gc.w) * bfhi(ha.w); } }
            { const v4u gb = *(const GAS v4u*)(PAB + (size_t)r * AB_IN + 8 * lane); v4u o;
              o.x = pk2(acc[0] * bflo(gb.x), acc[1] * bfhi(gb.x)); o.y = pk2(acc[2] * bflo(gb.y), acc[3] * bfhi(gb.y)); o.z = pk2(acc[4] * bflo(gb.z), acc[5] * bfhi(gb.z)); o.w = pk2(acc[6] * bflo(gb.w), acc[7] * bfhi(gb.w));
              *(GAS v4u*)(MIX + (size_t)r * D + 8 * lane) = o; }
            const int sub = lane & 7, axis = sub >> 2, half = (sub >> 1) & 1;
            const int pos = axis == 0 ? (r >> 6) : (r & 63);
            f32x4 c0 = (f32x4){1.f, 1.f, 1.f, 1.f}, c1 = c0, s0 = (f32x4){0.f, 0.f, 0.f, 0.f}, s1 = s0;
            if (!isctx) { const float* cp = ct + pos * 16 + 8 * (lane & 1); const float* sp = st + pos * 16 + 8 * (lane & 1);
                c0 = *(const f32x4*)cp; c1 = *(const f32x4*)(cp + 4); s0 = *(const f32x4*)sp; s1 = *(const f32x4*)(sp + 4);
                if (half == 0) { s0 = -s0; s1 = -s1; } }
            {
                const v4u a = *(const GAS v4u*)(PAB + (size_t)r * AB_IN + 1536 + 8 * lane);
                v4u p; p.x = (unsigned)__builtin_amdgcn_update_dpp(0, (int)a.x, 0x4E, 0xf, 0xf, true); p.y = (unsigned)__builtin_amdgcn_update_dpp(0, (int)a.y, 0x4E, 0xf, 0xf, true); p.z = (unsigned)__builtin_amdgcn_update_dpp(0, (int)a.z, 0x4E, 0xf, 0xf, true); p.w = (unsigned)__builtin_amdgcn_update_dpp(0, (int)a.w, 0x4E, 0xf, 0xf, true);
                const f32x4 qc0 = c0 * QSCL, qc1 = c1 * QSCL, qs0 = s0 * QSCL, qs1 = s1 * QSCL;
                v4u o; o.x = pk2(bflo(a.x) * qc0.x + bflo(p.x) * qs0.x, bfhi(a.x) * qc0.y + bfhi(p.x) * qs0.y); o.y = pk2(bflo(a.y) * qc0.z + bflo(p.y) * qs0.z, bfhi(a.y) * qc0.w + bfhi(p.y) * qs0.w);
                o.z = pk2(bflo(a.z) * qc1.x + bflo(p.z) * qs1.x, bfhi(a.z) * qc1.y + bfhi(p.z) * qs1.y); o.w = pk2(bflo(a.w) * qc1.z + bflo(p.w) * qs1.z, bfhi(a.w) * qc1.w + bfhi(p.w) * qs1.w);
                *(GAS v4u*)(QR + ((size_t)(lane >> 3) * MT + r) * 64 + 8 * sub) = o;
            }
            {
                const int kl = lane & 15;
                const v4u a = *(const GAS v4u*)(PAB + (size_t)r * AB_IN + 2048 + 8 * kl);
                v4u p; p.x = (unsigned)__builtin_amdgcn_update_dpp(0, (int)a.x, 0x4E, 0xf, 0xf, true); p.y = (unsigned)__builtin_amdgcn_update_dpp(0, (int)a.y, 0x4E, 0xf, 0xf, true); p.z = (unsigned)__builtin_amdgcn_update_dpp(0, (int)a.z, 0x4E, 0xf, 0xf, true); p.w = (unsigned)__builtin_amdgcn_update_dpp(0, (int)a.w, 0x4E, 0xf, 0xf, true);
                v4u o; o.x = pk2(bflo(a.x) * c0.x + bflo(p.x) * s0.x, bfhi(a.x) * c0.y + bfhi(p.x) * s0.y); o.y = pk2(bflo(a.y) * c0.z + bflo(p.y) * s0.z, bfhi(a.y) * c0.w + bfhi(p.y) * s0.w);
                o.z = pk2(bflo(a.z) * c1.x + bflo(p.z) * s1.x, bfhi(a.z) * c1.y + bfhi(p.z) * s1.y); o.w = pk2(bflo(a.w) * c1.z + bflo(p.w) * s1.z, bfhi(a.w) * c1.w + bfhi(p.w) * s1.w);
                if (lane < 16) *(GAS v4u*)(KR + ((size_t)(lane >> 3) * MT + r) * 64 + 8 * sub) = o;
            }
        }
        if (F.tid < 256) { const int p = F.tid, row = p >> 4, c8 = (p & 15) * 8;
            *(LAS v4u*)(vl + row * 272 + c8 * 2) = *(const GAS v4u*)(PAB + (size_t)(r0 + row) * AB_IN + 2176 + c8); }
        __syncthreads();
        if (F.tid < 256) { const int p = F.tid, ch = p >> 1, rg = p & 1;
            const LAS bf16* s = (const LAS bf16*)(vl + (8 * rg) * 272 + ch * 2);
            v4u o; o.x = (unsigned)s[0] | ((unsigned)s[136] << 16); o.y = (unsigned)s[2 * 136] | ((unsigned)s[3 * 136] << 16); o.z = (unsigned)s[4 * 136] | ((unsigned)s[5 * 136] << 16); o.w = (unsigned)s[6 * 136] | ((unsigned)s[7 * 136] << 16);
            *(GAS v4u*)(VT + (size_t)ch * MT + r0 + 8 * rg) = o; }
        __syncthreads();
    }
}


__device__ __forceinline__ void ph_ssd_conv(Frame& F) {
    const bf16* XB = (const bf16*)(F.ws + WS_XBCR);
    bf16* XT = (bf16*)(F.ws + WS_XT); bf16* BT = (bf16*)(F.ws + WS_BT); bf16* BMm = (bf16*)(F.ws + WS_BM); bf16* CMm = (bf16*)(F.ws + WS_CM);
    const float* cwp = F.in[I_SSDCW]; const float* cbp = F.in[I_SSDCB];
    LAS unsigned char* tl = F.lds;
    { const float* DR = (const float*)(F.ws + WS_DTRAW); float* DTF = (float*)(F.ws + WS_DTS); float* DTB = DTF + (size_t)32 * MT;
      const int gw = F.vcu * NWAVES + F.wave, NGW = F.G * NWAVES;
      for (int task = gw; task < (MT / 64) * 4; task += NGW) { const int tb = task >> 2, jq = task & 3; const int t = tb * 64 + F.lane; const float* row = DR + (size_t)t * 64;
#pragma unroll
          for (int j4 = 4 * jq; j4 < 4 * jq + 4; ++j4) { const f32x4 r = *(const f32x4*)(row + 4 * j4);
#pragma unroll
              for (int q = 0; q < 4; ++q) { const int j = 4 * j4 + q; const float v = softplus_f(r[q] + (j < 32 ? F.in[I_DTBF][j] : F.in[I_DTBB][j - 32]));
                  if (j < 32) DTF[(size_t)j * MT + t] = v; else DTB[(size_t)(j - 32) * MT + t] = v; } } } }
    LAS float* cwl = (LAS float*)(F.lds + 130 * 272 + 64);
    for (int i = F.tid; i < 3 * XBCW; i += NTHR) cwl[i] = cwp[i];
    for (int i = F.tid; i < XBCW; i += NTHR) cwl[3 * XBCW + i] = cbp[i];
    __syncthreads();
    const int ntiles = NCH * 24;
    v4u pre[5];
#define CONV_LOAD(tile_) do { const int c_ = (tile_) / 24, cb_ = (tile_) % 24, t0_ = c_ * 128, ch0_ = cb_ * 128; const int slo_ = c_ < 128 ? 0 : L, shi_ = c_ < 128 ? L : MT; \
        _Pragma("unroll") for (int i_ = 0; i_ < 5; ++i_) { const int p_ = F.tid + NTHR * i_, row_ = p_ >> 4, c8_ = (p_ & 15) * 8; const int t_ = t0_ - 1 + row_; \
            pre[i_] = (v4u){0u, 0u, 0u, 0u}; if (p_ < 130 * 16 && t_ >= slo_ && t_ < shi_) pre[i_] = *(const GAS v4u*)(XB + (size_t)t_ * XBCW + ch0_ + c8_); } } while (0)
    int tile = F.vcu;
    if (tile < ntiles) CONV_LOAD(tile);
    for (; tile < ntiles; tile += F.G) {
        const int c = tile / 24, cb = tile % 24, t0 = c * 128, ch0 = cb * 128;
#pragma unroll
        for (int i = 0; i < 5; ++i) { const int p = F.tid + NTHR * i, row = p >> 4, c8 = (p & 15) * 8; if (p < 130 * 16) *(LAS v4u*)(tl + row * 272 + ((c8 * 2) ^ (((row >> 3) & 7) << 4))) = pre[i]; }
        __syncthreads();
        if (tile + F.G < ntiles) CONV_LOAD(tile + F.G);
        if (cb < 20) {
            bf16* dst = BT + (size_t)(ch0 - 2048) * MT;
#pragma unroll
            for (int i = 0; i < 4; ++i) { const int p = F.tid + NTHR * i, ch = p >> 4, tg = p & 15;
                const float w0 = cwl[ch0 + ch], w1 = cwl[XBCW + ch0 + ch], w2 = cwl[2 * XBCW + ch0 + ch], bb = cwl[3 * XBCW + ch0 + ch];
                float xin[10];
#pragma unroll
                for (int j = 0; j < 10; ++j) { const int row = 8 * tg + j; xin[j] = bf1(*(const LAS bf16*)(tl + row * 272 + ((ch * 2) ^ (((row >> 3) & 7) << 4)))); }
                float y[8];
#pragma unroll
                for (int j = 0; j < 8; ++j) { const float a = w0 * xin[j] + w1 * xin[j + 1] + w2 * xin[j + 2] + bb; y[j] = a * sigmoid_f(a); }
                v4u o; o.x = pk2(y[0], y[1]); o.y = pk2(y[2], y[3]); o.z = pk2(y[4], y[5]); o.w = pk2(y[6], y[7]);
                if (cb < 16) { const int cg_ = ch0 + ch, hd = cg_ >> 6, p_ = cg_ & 63, ptq = 2 * (p_ >> 5) + ((p_ >> 2) & 1), rq = 4 * ((p_ >> 3) & 3) + (p_ & 3);
                    *(GAS v4u*)(XT + ((size_t)(((hd * NCH + c) * 4 + (tg >> 2)) * 4 + ptq) * 16 + rq) * 32 + 8 * (tg & 3)) = o; }
                else *(GAS v4u*)(dst + (size_t)ch * MT + t0 + 8 * tg) = o; }
        }
        if (cb >= 16) {
            bf16* dst = cb < 20 ? BMm + (ch0 - 2048) : CMm + (ch0 - 2560);
#pragma unroll
            for (int i = 0; i < 4; ++i) { const int p = F.tid + NTHR * i, row = p >> 4, cg = p & 15;
                const v4u a0 = *(const LAS v4u*)(tl + row * 272 + ((cg * 16) ^ (((row >> 3) & 7) << 4))), a1 = *(const LAS v4u*)(tl + (row + 1) * 272 + ((cg * 16) ^ ((((row + 1) >> 3) & 7) << 4))), a2 = *(const LAS v4u*)(tl + (row + 2) * 272 + ((cg * 16) ^ ((((row + 2) >> 3) & 7) << 4)));
                const LAS float* w0 = cwl + ch0 + 8 * cg; const LAS float* w1 = w0 + XBCW; const LAS float* w2 = w1 + XBCW; const LAS float* bb = w2 + XBCW;
                float y[8];
#define CV(j, f, q) { const float a = w0[j] * f(a0.q) + w1[j] * f(a1.q) + w2[j] * f(a2.q) + bb[j]; y[j] = a * sigmoid_f(a); }
                CV(0, bflo, x) CV(1, bfhi, x) CV(2, bflo, y) CV(3, bfhi, y) CV(4, bflo, z) CV(5, bfhi, z) CV(6, bflo, w) CV(7, bfhi, w)
#undef CV
                v4u o; o.x = pk2(y[0], y[1]); o.y = pk2(y[2], y[3]); o.z = pk2(y[4], y[5]); o.w = pk2(y[6], y[7]);
                *(GAS v4u*)(dst + (size_t)(t0 + row) * 512 + 8 * cg) = o; }
        }
        __syncthreads();
    }
#undef CONV_LOAD
}

__device__ __forceinline__ void ph_moe_route(Frame& F) {
    LAS float* R = (LAS float*)F.lds;
    for (int i = F.tid; i < 8192; i += NTHR) R[(i & 7) * 1024 + (i >> 3)] = F.in[I_ROUTER][i];
    __syncthreads();
    const bf16* X = (const bf16*)(F.ws + WS_X); bf16* H2 = (bf16*)(F.ws + WS_H2);
    int* TE = (int*)(F.ws + WS_TOKE); float* TW = (float*)(F.ws + WS_TOKW); int* HIST = (int*)(F.ws + WS_CTL) + CW_HIST;
    const float* gain = F.in[I_N2G] + D; const float* m = modp(F, 1, 0);
    const int gw = F.vcu * NWAVES + F.wave, NGW = F.G * NWAVES;
    f32x4 ca[4], cb[4];
#pragma unroll
    for (int j = 0; j < 4; ++j) { const int c = 4 * (64 * j + F.lane); ca[j] = *(const f32x4*)(gain + c) * (*(const f32x4*)(m + M_SC2 + c) + 1.0f); cb[j] = *(const f32x4*)(m + M_SH2 + c); }
    for (int r = gw; r < L; r += NGW) {
        f32x4 v[4]; float s2 = 0.f;
        load_row4<true>(X + (size_t)r * D, F.lane, v);
#pragma unroll
        for (int j = 0; j < 4; ++j) s2 += (v[j].x * v[j].x + v[j].y * v[j].y) + (v[j].z * v[j].z + v[j].w * v[j].w);
        const float rstd = 1.0f / sqrtf(wave_sum(s2) * (1.0f / D) + EPS);
        float lg[8];
#pragma unroll
        for (int e = 0; e < 8; ++e) lg[e] = 0.f;
        GAS v2u* o8 = (GAS v2u*)(H2 + (size_t)r * D) + F.lane;
#pragma unroll
        for (int j = 0; j < 4; ++j) { const int c = 4 * (64 * j + F.lane);
            const f32x4 y = v[j] * rstd * ca[j] + cb[j];
            v2u o; o.x = pk2(y.x, y.y); o.y = pk2(y.z, y.w); o8[64 * j] = o;
#pragma unroll
            for (int e = 0; e < 8; ++e) { const f32x4 rr = *(const LAS f32x4*)(R + e * 1024 + c); lg[e] += (y.x * rr.x + y.y * rr.y) + (y.z * rr.z + y.w * rr.w); } }
#pragma unroll
        for (int e = 0; e < 8; ++e) lg[e] = wave_sum(lg[e]);
        int e0 = 0; float v0 = lg[0];
#pragma unroll
        for (int e = 1; e < 8; ++e) if (lg[e] > v0) { v0 = lg[e]; e0 = e; }
        int e1 = -1; float v1 = -3.0e38f;
#pragma unroll
        for (int e = 0; e < 8; ++e) if (e != e0 && lg[e] > v1) { v1 = lg[e]; e1 = e; }
        if (F.lane == 0) { const float ex = __expf(v1 - v0), w0 = 1.0f / (1.0f + ex);
            TE[2 * r] = e0; TE[2 * r + 1] = e1; TW[2 * r] = w0; TW[2 * r + 1] = ex * w0;
            atomicAdd(&HIST[(r >> 8) * 8 + e0], 1); atomicAdd(&HIST[(r >> 8) * 8 + e1], 1); }
    }
}
__device__ __forceinline__ void moe_segments(Frame& F, LAS int* hist, LAS int* cnt, LAS int* seg) {
    const int* HIST = (const int*)(F.ws + WS_CTL) + CW_HIST;
    if (F.tid < 512) hist[F.tid] = HIST[F.tid];
    __syncthreads();
    if (F.tid < 8) { int s = 0; for (int t = 0; t < 64; ++t) s += hist[t * 8 + F.tid]; cnt[F.tid] = s; }
    __syncthreads();
    if (F.tid == 0) { int s = 0; for (int e = 0; e < 8; ++e) { seg[e] = s; s += (cnt[e] + 255) & ~255; } seg[8] = s; }
    __syncthreads();
}
__device__ __forceinline__ void ph_moe_scatter(Frame& F) {
    LAS int* hist = (LAS int*)F.lds; LAS int* cnt = hist + 512; LAS int* seg = cnt + 8; LAS int* base = seg + 16; LAS int* wcnt = base + 8; LAS int* epos = wcnt + 64;
    moe_segments(F, hist, cnt, seg);
    const int* TE = (const int*)(F.ws + WS_TOKE); int* TP = (int*)(F.ws + WS_TOKP);
    const bf16* H2 = (const bf16*)(F.ws + WS_H2); bf16* H2S = (bf16*)(F.ws + WS_H2S);
    for (int uu = F.vcu; uu < 264; uu += F.G) {
        if (uu < 256) {
            const int u = uu >> 2, qtr = uu & 3;
            if (F.tid < 8) { int s = seg[F.tid]; for (int t = 0; t < u; ++t) s += hist[t * 8 + F.tid]; base[F.tid] = s; }
            const int ent = u * 512 + F.tid;
            const int ex = TE[ent];
            int rank = 0;
#pragma unroll
            for (int e = 0; e < 8; ++e) { const unsigned long long mk = __ballot(ex == e);
                if (ex == e) rank = __popcll(mk & ((1ull << F.lane) - 1ull));
                if (F.lane == 0) wcnt[F.wave * 8 + e] = __popcll(mk); }
            __syncthreads();
            int pos = base[ex] + rank;
            for (int w = 0; w < F.wave; ++w) pos += wcnt[w * 8 + ex];
            if (qtr == 0) TP[ent] = pos;
            epos[F.tid] = pos;
            __syncthreads();
            for (int i0 = 128 * qtr + F.wave; i0 < 128 * qtr + 128; i0 += 4 * NWAVES) {
                v4u ra[4], rb[4]; int dp[4];
#pragma unroll
                for (int k = 0; k < 4; ++k) { const int i = i0 + k * NWAVES; const int tok = u * 256 + (i >> 1); dp[k] = epos[i];
                    const GAS v4u* s = (const GAS v4u*)(H2 + (size_t)tok * D); ra[k] = s[F.lane]; rb[k] = s[64 + F.lane]; }
#pragma unroll
                for (int k = 0; k < 4; ++k) { GAS v4u* d = (GAS v4u*)(H2S + (size_t)dp[k] * D); d[F.lane] = ra[k]; d[64 + F.lane] = rb[k]; } }
            __syncthreads();
        } else {
            const int e = uu - 256, lo = seg[e] + cnt[e], hi = seg[e + 1];
            GAS v4u* d = (GAS v4u*)(H2S + (size_t)lo * D); const int n16 = (hi - lo) * (D * 2 / 16);
            for (int i = F.tid; i < n16; i += NTHR) d[i] = (v4u){0u, 0u, 0u, 0u};
        }
    }
}
__device__ __forceinline__ void ph_final(Frame& F) {
    const bf16* X = (const bf16*)(F.ws + WS_X); const bf16* YO = (const bf16*)(F.ws + WS_H2S);
    const int* TP = (const int*)(F.ws + WS_TOKP); const float* TW = (const float*)(F.ws + WS_TOKW);
    const float* g2 = modp(F, 1, 0) + M_G2; const float* fg = F.in[I_FINALG];
    const float* YP = (const float*)(F.ws + WS_YPART);
    const int gw = F.vcu * NWAVES + F.wave, NGW = F.G * NWAVES;
    f32x4 cg[4], cf[4];
#pragma unroll
    for (int j = 0; j < 4; ++j) { const int c = 4 * (64 * j + F.lane); cg[j] = *(const f32x4*)(g2 + c); cf[j] = *(const f32x4*)(fg + c); }
    for (int r0 = gw; r0 < L; r0 += 2 * NGW) {
        int rr[2], pa[2], pb[2]; float wa[2], wb[2]; f32x4 xv[2][4]; v2u ya[2][4], yb[2][4];
#pragma unroll
        for (int k = 0; k < 2; ++k) { const int r = r0 + k * NGW; rr[k] = r < L ? r : r0; pa[k] = TP[2 * rr[k]]; pb[k] = TP[2 * rr[k] + 1]; wa[k] = TW[2 * rr[k]]; wb[k] = TW[2 * rr[k] + 1]; }
#pragma unroll
        for (int k = 0; k < 2; ++k) { load_row4<true>(X + (size_t)rr[k] * D, F.lane, xv[k]);
            const GAS v2u* y0 = (const GAS v2u*)(YO + (size_t)pa[k] * D) + F.lane; const GAS v2u* y1 = (const GAS v2u*)(YO + (size_t)pb[k] * D) + F.lane;
#pragma unroll
            for (int j = 0; j < 4; ++j) { ya[k][j] = y0[64 * j]; yb[k][j] = y1[64 * j]; } }
#pragma unroll
        for (int k = 0; k < 2; ++k) { const int r = rr[k], p0 = pa[k], p1 = pb[k]; const float w0 = wa[k], w1 = wb[k];
            f32x4 v[4]; float s2 = 0.f;
#pragma unroll
            for (int j = 0; j < 4; ++j) { const int c = 4 * (64 * j + F.lane); const v2u a = ya[k][j], b = yb[k][j]; const f32x4 g = cg[j];
                f32x4 fa = (f32x4){bflo(a.x), bfhi(a.x), bflo(a.y), bfhi(a.y)}, fb = (f32x4){bflo(b.x), bfhi(b.x), bflo(b.y), bfhi(b.y)};
                if (p0 >= 32768) { fa = (f32x4){0.f, 0.f, 0.f, 0.f}; for (int q = 0; q < 7; ++q) fa += *(const f32x4*)(YP + ((size_t)q * 2048 + (p0 - 32768)) * D + c); }
                if (p1 >= 32768) { fb = (f32x4){0.f, 0.f, 0.f, 0.f}; for (int q = 0; q < 7; ++q) fb += *(const f32x4*)(YP + ((size_t)q * 2048 + (p1 - 32768)) * D + c); }
                const f32x4 f = fa * w0 + fb * w1;
                v[j] = xv[k][j] + g * f; s2 += (v[j].x * v[j].x + v[j].y * v[j].y) + (v[j].z * v[j].z + v[j].w * v[j].w); }
            const float rstd = 1.0f / sqrtf(wave_sum(s2) * (1.0f / D) + EPS);
            GAS f32x4* o = (GAS f32x4*)(F.out + (size_t)r * D) + F.lane;
#pragma unroll
            for (int j = 0; j < 4; ++j) __builtin_nontemporal_store(v[j] * rstd * cf[j], &o[64 * j]);
        }
    }
}


typedef short bf16x8v __attribute__((ext_vector_type(8)));
__device__ __forceinline__ bf16x8v as_frag(v4u a) { return __builtin_bit_cast(bf16x8v, a); }
constexpr float LOG2E_ = 1.4426950408889634f;
#define MFMA16(a, b, c) __builtin_amdgcn_mfma_f32_16x16x32_bf16((a), (b), (c), 0, 0, 0)
__device__ __forceinline__ int prm_row(int i2, int par, int r) { return 32 * i2 + 8 * (r >> 2) + 4 * par + (r & 3); }

__device__ __forceinline__ void ph_ssd_s1(Frame& F) {
    const bf16* XT = (const bf16*)(F.ws + WS_XT); const bf16* BT = (const bf16*)(F.ws + WS_BT);
    const float* DTF = (const float*)(F.ws + WS_DTS); const float* DTB = DTF + (size_t)32 * MT; float* CUMF = (float*)(DTB + (size_t)32 * MT); float* CUMB = CUMF + (size_t)32 * MT;
    float* DEC = (float*)(F.ws + WS_DEC); bf16* ST = (bf16*)(F.ws + WS_STATES);
    LAS unsigned char* btl = F.lds;
    LAS float* wtab = (LAS float*)(F.lds + 128 * 272);
    LAS float* wtot = wtab + 1024;
    const int lane = F.lane, r16 = lane & 15, gq = lane >> 4;
    v4u nbt[4]; float ndtf = 0.f, ndtb = 0.f;
#define S1_PREFETCH(u_) do { const int c_ = (u_) >> 3, g_ = ((u_) >> 1) & 3, hh_ = (u_) & 1, t0_ = c_ * 128; int tq_ = F.tid; asm volatile("" : "+v"(tq_)); \
        _Pragma("unroll") for (int i_ = 0; i_ < 4; ++i_) { const int p_ = tq_ + NTHR * i_, n_ = p_ >> 4, c8_ = (p_ & 15) * 8; nbt[i_] = *(const GAS v4u*)(BT + (size_t)(g_ * 128 + n_) * MT + t0_ + c8_); } \
        { const int h_ = 8 * g_ + 4 * hh_ + (tq_ >> 7); ndtf = DTF[(size_t)h_ * MT + t0_ + (tq_ & 127)]; ndtb = DTB[(size_t)h_ * MT + t0_ + (tq_ & 127)]; } } while (0)
    if (F.vcu < NCH * 8) S1_PREFETCH(F.vcu);
    for (int u = F.vcu; u < NCH * 8; u += F.G) {
        const int c = u >> 3, g = (u >> 1) & 3, hh = u & 1, t0 = c * 128;
        int tid_ = F.tid; asm volatile("" : "+v"(tid_));
        v4u xr[4][4];
        { const int hx = 8 * g + 4 * hh + (F.wave >> 1);
#pragma unroll
          for (int ks = 0; ks < 4; ++ks)
#pragma unroll
            for (int pt = 0; pt < 4; ++pt) xr[ks][pt] = *(const GAS v4u*)(XT + ((size_t)(((hx * NCH + c) * 4 + ks) * 4 + pt) * 16 + r16) * 32 + 8 * gq); }
#pragma unroll
        for (int i = 0; i < 4; ++i) { const int p = tid_ + NTHR * i, n = p >> 4, c8 = (p & 15) * 8; *(LAS v4u*)(btl + n * 272 + c8 * 2) = nbt[i]; }
        {
            const int j = tid_ >> 7, l = tid_ & 127, h = 8 * g + 4 * hh + j;
            const float dtf = ndtf, dtb = ndtb;
            const float Af = -__expf(F.in[I_ALOGF][h]), Ab = -__expf(F.in[I_ALOGB][h]);
            const float af = dtf * Af, ab = dtb * Ab;
            float pf = af, pb = ab;
#pragma unroll
            for (int o = 1; o < 64; o <<= 1) { const float a = __shfl_up(pf, o), b = __shfl_up(pb, o); if (lane >= o) { pf += a; pb += b; } }
            if (lane == 63) { wtot[F.wave * 2] = pf; wtot[F.wave * 2 + 1] = pb; }
            __syncthreads();
            const float tf0 = wtot[(2 * j) * 2], tb0 = wtot[(2 * j) * 2 + 1], Tf = tf0 + wtot[(2 * j + 1) * 2], Tb = tb0 + wtot[(2 * j + 1) * 2 + 1];
            if (F.wave & 1) { pf += tf0; pb += tb0; }
            const float cf = pf, cb = Tb - pb + ab;
            CUMF[(size_t)h * MT + t0 + l] = cf; CUMB[(size_t)h * MT + t0 + l] = cb;
            wtab[(j * 2 + 0) * 128 + l] = __expf(Tf - cf) * dtf; wtab[(j * 2 + 1) * 128 + l] = __expf(Tb - cb) * dtb;
            if (l == 0) { DEC[(0 * NCH + c) * 32 + h] = __expf(Tf); DEC[(1 * NCH + c) * 32 + h] = __expf(Tb); }
        }
        __syncthreads();
        {
            const int j = F.wave >> 1, dir = F.wave & 1, h = 8 * g + 4 * hh + j;
            f32x4 acc[8][4];
#pragma unroll
            for (int a = 0; a < 8; ++a)
#pragma unroll
                for (int b = 0; b < 4; ++b) acc[a][b] = (f32x4){0.f, 0.f, 0.f, 0.f};
            const LAS float* wt = wtab + (j * 2 + dir) * 128;
            if (u + F.G < NCH * 8) S1_PREFETCH(u + F.G);
#pragma unroll
            for (int ks = 0; ks < 4; ++ks) {
                const f32x4 w0 = *(const LAS f32x4*)(wt + 32 * ks + 8 * gq), w1 = *(const LAS f32x4*)(wt + 32 * ks + 8 * gq + 4);
                bf16x8v bfr[4];
#pragma unroll
                for (int pt = 0; pt < 4; ++pt) { const v4u x = xr[ks][pt];
                    v4u y; y.x = pk2(bflo(x.x) * w0.x, bfhi(x.x) * w0.y); y.y = pk2(bflo(x.y) * w0.z, bfhi(x.y) * w0.w); y.z = pk2(bflo(x.z) * w1.x, bfhi(x.z) * w1.y); y.w = pk2(bflo(x.w) * w1.z, bfhi(x.w) * w1.w);
                    bfr[pt] = as_frag(y); }
#pragma unroll
                for (int nt = 0; nt < 8; ++nt) { const bf16x8v af = as_frag(*(const LAS v4u*)(btl + prm_row(nt >> 1, nt & 1, r16) * 272 + (32 * ks + 8 * gq) * 2));
#pragma unroll
                    for (int pt = 0; pt < 4; ++pt) acc[nt][pt] = MFMA16(af, bfr[pt], acc[nt][pt]); }
            }
            bf16* so = ST + ((size_t)((dir * NCH + c) * 32 + h) * 64) * 128;
#pragma unroll
            for (int pt = 0; pt < 4; ++pt)
#pragma unroll
                for (int i2 = 0; i2 < 4; ++i2) { const f32x4 a = acc[2 * i2][pt], b = acc[2 * i2 + 1][pt];
                    v4u o; o.x = pk2(a[0], a[1]); o.y = pk2(a[2], a[3]); o.z = pk2(b[0], b[1]); o.w = pk2(b[2], b[3]);
                    *(GAS v4u*)(so + (size_t)(((pt * 4 + i2) * 16 + r16) * 32) + 8 * gq) = o; }
        }
        __syncthreads();
    }
}
#undef S1_PREFETCH

__device__ __forceinline__ void ph_ssd_s2(Frame& F) {
    const float* DEC = (const float*)(F.ws + WS_DEC); bf16* ST = (bf16*)(F.ws + WS_STATES);
    for (int e = F.vcu * NTHR + F.tid; e < 2 * 32 * 64 * 32; e += F.G * NTHR) {
        const int dir = e >> 16, h = (e >> 11) & 31, rem = e & 2047;
        const size_t eoff = (size_t)h * 8192 + (size_t)rem * 4; const size_t cstride = (size_t)32 * 8192;
        bf16* base = ST + (size_t)dir * NCH * cstride + eoff;
        const float* dec = DEC + (size_t)dir * NCH * 32 + h;
        float H0 = 0.f, H1 = 0.f, H2 = 0.f, H3 = 0.f;
        for (int b = 0; b < NCH; b += 10) {
            v2u s[10]; float d[10]; int ck[10];
#pragma unroll
            for (int i = 0; i < 10; ++i) { const int idx = b + i; ck[i] = dir == 0 ? (idx < 2 ? 128 + idx : idx - 2) : (idx < 2 ? 129 - idx : 129 - idx);
                s[i] = *(const GAS v2u*)(base + (size_t)ck[i] * cstride); d[i] = dec[ck[i] * 32]; }
#pragma unroll
            for (int i = 0; i < 10; ++i) { v2u o; o.x = pk2(H0, H1); o.y = pk2(H2, H3); *(GAS v2u*)(base + (size_t)ck[i] * cstride) = o;
                H0 = d[i] * H0 + bflo(s[i].x); H1 = d[i] * H1 + bfhi(s[i].x); H2 = d[i] * H2 + bflo(s[i].y); H3 = d[i] * H3 + bfhi(s[i].y); }
        }
    }
}

__device__ __forceinline__ void ph_ssd_s3(Frame& F) {
    const bf16* XT = (const bf16*)(F.ws + WS_XT); const bf16* BMm = (const bf16*)(F.ws + WS_BM); const bf16* CMm = (const bf16*)(F.ws + WS_CM);
    const float* DTF = (const float*)(F.ws + WS_DTS); const float* DTB = DTF + (size_t)32 * MT; const float* CUMF = DTB + (size_t)32 * MT; const float* CUMB = CUMF + (size_t)32 * MT;
    const bf16* ST = (const bf16*)(F.ws + WS_STATES); bf16* Z = (bf16*)(F.ws + WS_Z); const float* ng = F.in[I_SSDNG];
    LAS unsigned char* bml = F.lds;
    LAS unsigned char* cml = F.lds + 128 * 272;
    LAS float* tab = (LAS float*)(F.lds + 192 * 272);
    LAS float* ssq = tab + 8 * 5 * 128;
    const int lane = F.lane, r16 = lane & 15, gq = lane >> 4;
    v4u nbm[4], ncm[2]; float ncf[2], ncb[2], ndf[2], ndb[2];
#define S3_PREFETCH(u_) do { const int c_ = (u_) >> 3, g_ = ((u_) >> 1) & 3, lh_ = (u_) & 1, t0_ = c_ * 128; int tq_ = F.tid; asm volatile("" : "+v"(tq_)); \
        _Pragma("unroll") for (int i_ = 0; i_ < 4; ++i_) { const int p_ = tq_ + NTHR * i_, row_ = p_ >> 4, c8_ = (p_ & 15) * 8; nbm[i_] = *(const GAS v4u*)(BMm + (size_t)(t0_ + row_) * 512 + g_ * 128 + c8_); } \
        _Pragma("unroll") for (int i_ = 0; i_ < 2; ++i_) { const int p_ = tq_ + NTHR * i_, row_ = p_ >> 4, c8_ = (p_ & 15) * 8; ncm[i_] = *(const GAS v4u*)(CMm + (size_t)(t0_ + 64 * lh_ + row_) * 512 + g_ * 128 + c8_); \
            const size_t o_ = (size_t)(8 * g_ + (p_ >> 7)) * MT + t0_ + (p_ & 127); ncf[i_] = CUMF[o_]; ncb[i_] = CUMB[o_]; ndf[i_] = DTF[o_]; ndb[i_] = DTB[o_]; } } while (0)
    if (F.vcu < 128 * 8) S3_PREFETCH(F.vcu);
    for (int u = F.vcu; u < 128 * 8; u += F.G) {
        const int c = u >> 3, g = (u >> 1) & 3, lh = u & 1, t0 = c * 128;
        __syncthreads();
        int tid_ = F.tid; asm volatile("" : "+v"(tid_));
#pragma unroll
        for (int i = 0; i < 4; ++i) { const int p = tid_ + NTHR * i, row = p >> 4, c8 = (p & 15) * 8; *(LAS v4u*)(bml + row * 272 + c8 * 2) = nbm[i]; }
#pragma unroll
        for (int i = 0; i < 2; ++i) { const int p = tid_ + NTHR * i, row = p >> 4, c8 = (p & 15) * 8; *(LAS v4u*)(cml + row * 272 + c8 * 2) = ncm[i]; }
#pragma unroll
        for (int i = 0; i < 2; ++i) { const int p = tid_ + NTHR * i, j = p >> 7, l = p & 127;
            const float cf = ncf[i] * LOG2E_, cb = ncb[i] * LOG2E_, df = ndf[i], db = ndb[i];
            tab[(j * 5 + 0) * 128 + l] = cf; tab[(j * 5 + 1) * 128 + l] = cb; tab[(j * 5 + 2) * 128 + l] = __builtin_amdgcn_logf(df) - cf; tab[(j * 5 + 3) * 128 + l] = __builtin_amdgcn_logf(db) - cb;
            tab[(j * 5 + 4) * 128 + l] = df + db; }
        __syncthreads();
        const int h = 8 * g + F.wave;
        const float Dk = F.in[I_SSDD][h];
        const LAS float* tcf = tab + (F.wave * 5) * 128; const LAS float* tcb = tcf + 128; const LAS float* tdf = tcb + 128; const LAS float* tdb = tdf + 128; const LAS float* tds = tdb + 128;
        f32x4 acc[4][4];
#pragma unroll
        for (int a = 0; a < 4; ++a)
#pragma unroll
            for (int b = 0; b < 4; ++b) acc[a][b] = (f32x4){0.f, 0.f, 0.f, 0.f};
#pragma unroll 1
        for (int i2 = 0; i2 < 4; ++i2) {
            bf16x8v xf[4], bmf[2][4];
#pragma unroll
            for (int pt = 0; pt < 4; ++pt) xf[pt] = as_frag(*(const GAS v4u*)(XT + ((size_t)(((h * NCH + c) * 4 + i2) * 4 + pt) * 16 + r16) * 32 + 8 * gq));
#pragma unroll
            for (int par = 0; par < 2; ++par)
#pragma unroll
                for (int nk = 0; nk < 4; ++nk) bmf[par][nk] = as_frag(*(const LAS v4u*)(bml + prm_row(i2, par, r16) * 272 + (32 * nk + 8 * gq) * 2));
            const int sb = 32 * i2 + 8 * gq;
            const f32x4 dfs0 = *(const LAS f32x4*)(tdf + sb), dfs1 = *(const LAS f32x4*)(tdf + sb + 4), dbs0 = *(const LAS f32x4*)(tdb + sb), dbs1 = *(const LAS f32x4*)(tdb + sb + 4);
#pragma unroll
            for (int lt = 0; lt < 4; ++lt) {
                const int ll = 16 * lt + r16, l = 64 * lh + ll;
                const float cfl = tcf[l], cbl = tcb[l], dsl = tds[l];
                f32x4 g0 = (f32x4){0.f, 0.f, 0.f, 0.f}, g1 = g0;
#pragma unroll
                for (int nk = 0; nk < 4; ++nk) { const bf16x8v cf = as_frag(*(const LAS v4u*)(cml + ll * 272 + (32 * nk + 8 * gq) * 2));
                    g0 = MFMA16(bmf[0][nk], cf, g0); g1 = MFMA16(bmf[1][nk], cf, g1); }
                float m[8];
                const int ltile0 = 64 * lh + 16 * lt; const int blk = (32 * i2 + 31 < ltile0) ? 0 : ((32 * i2 > ltile0 + 15) ? 2 : 1);
                if (blk == 0) {
#pragma unroll
                    for (int e = 0; e < 8; ++e) { const float dfs = e < 4 ? dfs0[e & 3] : dfs1[e & 3], gv = e < 4 ? g0[e & 3] : g1[e & 3]; m[e] = gv * __builtin_amdgcn_exp2f(cfl + dfs); }
                } else if (blk == 2) {
#pragma unroll
                    for (int e = 0; e < 8; ++e) { const float dbs = e < 4 ? dbs0[e & 3] : dbs1[e & 3], gv = e < 4 ? g0[e & 3] : g1[e & 3]; m[e] = gv * __builtin_amdgcn_exp2f(cbl + dbs); }
                } else {
#pragma unroll
                    for (int e = 0; e < 8; ++e) { const int s = sb + e;
                        const float dfs = e < 4 ? dfs0[e & 3] : dfs1[e & 3], dbs = e < 4 ? dbs0[e & 3] : dbs1[e & 3], gv = e < 4 ? g0[e & 3] : g1[e & 3];
                        float w = __builtin_amdgcn_exp2f(s < l ? cfl + dfs : cbl + dbs); const bool dg = s == l;
                        w = dg ? dsl : w; m[e] = gv * w + (dg ? Dk : 0.f); }
                }
                asm volatile("" : "+v"(m[0]), "+v"(m[1]), "+v"(m[2]), "+v"(m[3]), "+v"(m[4]), "+v"(m[5]), "+v"(m[6]), "+v"(m[7]));
                v4u mp; mp.x = pk2(m[0], m[1]); mp.y = pk2(m[2], m[3]); mp.z = pk2(m[4], m[5]); mp.w = pk2(m[6], m[7]);
                const bf16x8v mf = as_frag(mp);
#pragma unroll
                for (int pt = 0; pt < 4; ++pt) acc[lt][pt] = MFMA16(xf[pt], mf, acc[lt][pt]);
            }
        }
        if (u + F.G < 128 * 8) S3_PREFETCH(u + F.G);
#pragma unroll 1
        for (int dir = 0; dir < 2; ++dir) {
            const bf16* hs = ST + ((size_t)((dir * NCH + c) * 32 + h) * 64) * 128;
            float el[4];
#pragma unroll
            for (int lt = 0; lt < 4; ++lt) { const int l = 64 * lh + 16 * lt + r16; el[lt] = __builtin_amdgcn_exp2f(dir == 0 ? tcf[l] : tcb[l]); }
            f32x4 tacc[4][4];
#pragma unroll
            for (int a = 0; a < 4; ++a)
#pragma unroll
                for (int b = 0; b < 4; ++b) tacc[a][b] = (f32x4){0.f, 0.f, 0.f, 0.f};
#pragma unroll 1
            for (int nk = 0; nk < 4; ++nk) {
                bf16x8v hf[4];
#pragma unroll
                for (int pt = 0; pt < 4; ++pt) hf[pt] = as_frag(*(const GAS v4u*)(hs + (size_t)(((pt * 4 + nk) * 16 + r16) * 32) + 8 * gq));
#pragma unroll
                for (int lt = 0; lt < 4; ++lt) { const int ll = 16 * lt + r16;
                    const bf16x8v cf = as_frag(*(const LAS v4u*)(cml + ll * 272 + (32 * nk + 8 * gq) * 2));
#pragma unroll
                    for (int pt = 0; pt < 4; ++pt) tacc[lt][pt] = MFMA16(hf[pt], cf, tacc[lt][pt]); }
            }
#pragma unroll
            for (int lt = 0; lt < 4; ++lt)
#pragma unroll
                for (int pt = 0; pt < 4; ++pt) acc[lt][pt] += tacc[lt][pt] * el[lt];
        }
#pragma unroll
        for (int lt = 0; lt < 4; ++lt) { const int l = 64 * lh + 16 * lt + r16; float ss = 0.f;
#pragma unroll
            for (int q = 0; q < 2; ++q) { const v4u zv = *(const GAS v4u*)(Z + (size_t)(t0 + l) * DIN + h * 64 + 32 * q + 8 * gq);
                const float zz[8] = {bflo(zv.x), bfhi(zv.x), bflo(zv.y), bfhi(zv.y), bflo(zv.z), bfhi(zv.z), bflo(zv.w), bfhi(zv.w)};
#pragma unroll
                for (int e = 0; e < 4; ++e) { float v0 = acc[lt][2 * q][e] * zz[e] * sigmoid_f(zz[e]), v1 = acc[lt][2 * q + 1][e] * zz[4 + e] * sigmoid_f(zz[4 + e]);
                    acc[lt][2 * q][e] = v0; acc[lt][2 * q + 1][e] = v1; ss += v0 * v0 + v1 * v1; } }
            ss += __shfl_xor(ss, 16); ss += __shfl_xor(ss, 32);
            if (gq == 0) ssq[(16 * lt + r16) * 8 + F.wave] = ss; }
        __syncthreads();
#pragma unroll
        for (int lt = 0; lt < 4; ++lt) { const int ll = 16 * lt + r16, l = 64 * lh + ll;
            const f32x4 s0 = *(const LAS f32x4*)(ssq + ll * 8), s1 = *(const LAS f32x4*)(ssq + ll * 8 + 4);
            const float rs = 1.0f / sqrtf(((s0.x + s0.y) + (s0.z + s0.w) + (s1.x + s1.y) + (s1.z + s1.w)) * (1.0f / 512.0f) + EPS);
#pragma unroll
            for (int q = 0; q < 2; ++q) { const int ch = h * 64 + 32 * q + 8 * gq; const f32x4 a = acc[lt][2 * q] * rs, b = acc[lt][2 * q + 1] * rs;
                const f32x4 g0 = *(const f32x4*)(ng + ch), g1 = *(const f32x4*)(ng + ch + 4);
                v4u o; o.x = pk2(a[0] * g0.x, a[1] * g0.y); o.y = pk2(a[2] * g0.z, a[3] * g0.w); o.z = pk2(b[0] * g1.x, b[1] * g1.y); o.w = pk2(b[2] * g1.z, b[3] * g1.w);
                *(GAS v4u*)(Z + (size_t)(t0 + l) * DIN + ch) = o; } }
    }
    __syncthreads();
}
#undef S3_PREFETCH

__device__ __forceinline__ float vmax_f(float a, float b) { return __builtin_amdgcn_fmed3f(a, b, __builtin_inff()); }
__device__ __forceinline__ float vmin_f(float a, float b) { return __builtin_amdgcn_fmed3f(a, b, -__builtin_inff()); }
__device__ __forceinline__ float vmax3_f(float a, float b, float c) { return vmax_f(a, vmax_f(b, c)); }
__device__ __forceinline__ int attn_next_blk(int kb, int qb, bool isctx) {
    for (int k = kb + 1; k < 5; ++k) { if (k >= 3) return k; if (!isctx) { const int b = qb - 1 + k; if (b >= 0 && b < 128) return k; } }
    return 5;
}
__device__ __forceinline__ void ph_attn(Frame& F) {
    const bf16* QR = (const bf16*)(F.ws + WS_QR); const bf16* KR = (const bf16*)(F.ws + WS_KR); const bf16* VT = (const bf16*)(F.ws + WS_VT); bf16* MIX = (bf16*)(F.ws + WS_MIX);
    constexpr int KBYTES = 128 * 144, BUFB = KBYTES + 64 * 272;
    const int lane = F.lane, r16 = lane & 15, gq = lane >> 4;
    constexpr float LOG2E = 1.4426950408889634f;
    const int p0 = F.tid, p1 = F.tid + NTHR;
    const int kro0 = (p0 >> 3) * 144 + (p0 & 7) * 16, kro1 = (p1 >> 3) * 144 + (p1 & 7) * 16;
    const int vro0 = KBYTES + (p0 >> 4) * 272 + (p0 & 15) * 16, vro1 = KBYTES + (p1 >> 4) * 272 + (p1 & 15) * 16;
    for (int u = F.vcu; u < 130 * 8; u += F.G) {
        const int qb = u >> 3, hq = u & 7, kvh = hq >> 2; const bool isctx = qb >= 128;
        const int row0 = qb * 128;
        const int qrow = row0 + 16 * F.wave + r16;
        bf16x8v qf[2];
#pragma unroll
        for (int ks = 0; ks < 2; ++ks) qf[ks] = as_frag(*(const GAS v4u*)(QR + ((size_t)hq * MT + qrow) * 64 + 32 * ks + 8 * gq));
        float m2 = F.in[I_ABSINK][hq] * LOG2E, lsum = 1.0f;
        f32x4 oacc[4];
#pragma unroll
        for (int a = 0; a < 4; ++a) oacc[a] = (f32x4){0.f, 0.f, 0.f, 0.f};
        const int qi = 16 * F.wave + r16;
        const bf16* kbase = KR + (size_t)kvh * MT * 64; const bf16* vbase = VT + (size_t)kvh * 64 * MT;
#define ATT_KEY0(kb) ((kb) < 3 ? (qb - 1 + (kb)) * 128 : L + ((kb) - 3) * 128)
#define ATT_LOAD(kb) do { const int k0_ = ATT_KEY0(kb); \
            kr0 = *(const GAS v4u*)(kbase + (size_t)(k0_ + (p0 >> 3)) * 64 + (p0 & 7) * 8); kr1 = *(const GAS v4u*)(kbase + (size_t)(k0_ + (p1 >> 3)) * 64 + (p1 & 7) * 8); \
            vr0 = *(const GAS v4u*)(vbase + (size_t)(p0 >> 4) * MT + k0_ + (p0 & 15) * 8); vr1 = *(const GAS v4u*)(vbase + (size_t)(p1 >> 4) * MT + k0_ + (p1 & 15) * 8); } while (0)
#define ATT_WRITE(buf) do { LAS unsigned char* b_ = F.lds + (buf) * BUFB; *(LAS v4u*)(b_ + kro0) = kr0; *(LAS v4u*)(b_ + kro1) = kr1; *(LAS v4u*)(b_ + vro0) = vr0; *(LAS v4u*)(b_ + vro1) = vr1; } while (0)
        v4u kr0, kr1, vr0, vr1;
        int kb = attn_next_blk(-1, qb, isctx), cur = 0;
        __syncthreads();
        ATT_LOAD(kb); ATT_WRITE(0);
        __syncthreads();
        while (kb < 5) {
            const int nkb = attn_next_blk(kb, qb, isctx);
            if (nkb < 5) ATT_LOAD(nkb);
            const LAS unsigned char* kl = F.lds + cur * BUFB; const LAS unsigned char* vl = kl + KBYTES;
            const int mode = (kb == 0) ? 1 : ((kb == 2) ? 2 : 0);
            f32x4 sacc[8];
#pragma unroll
            for (int kt = 0; kt < 8; ++kt) { sacc[kt] = (f32x4){0.f, 0.f, 0.f, 0.f};
#pragma unroll
                for (int ks = 0; ks < 2; ++ks) { const bf16x8v kf = as_frag(*(const LAS v4u*)(kl + prm_row(kt >> 1, kt & 1, r16) * 144 + (32 * ks + 8 * gq) * 2));
                    sacc[kt] = MFMA16(kf, qf[ks], sacc[kt]); } }
            float bm = -1.0e30f;
#pragma unroll 1
            for (int rep_ = 0; rep_ < (mode != 0 ? 1 : 0); ++rep_) {
                const float msgn = mode == 1 ? 1.0e30f : -1.0e30f, limf = (float)(qi - 8 * gq);
#pragma unroll
                for (int kt = 0; kt < 8; ++kt)
#pragma unroll
                    for (int e = 0; e < 4; ++e) { const float jc = (float)(32 * (kt >> 1) + 4 * (kt & 1) + e);
                        sacc[kt][e] += vmin_f(0.f, msgn * (jc - limf)); }
            }
#pragma unroll
            for (int kt = 0; kt < 8; ++kt) bm = vmax3_f(bm, vmax_f(sacc[kt][0], sacc[kt][1]), vmax_f(sacc[kt][2], sacc[kt][3]));
            bm = vmax_f(bm, __shfl_xor(bm, 16)); bm = vmax_f(bm, __shfl_xor(bm, 32));
            const float mn = vmax_f(m2, bm), alpha = __builtin_amdgcn_exp2f(m2 - mn); m2 = mn;
            float ps = 0.f;
            bf16x8v pf[4];
#pragma unroll
            for (int i2 = 0; i2 < 4; ++i2) { float p[8];
#pragma unroll
                for (int e = 0; e < 4; ++e) { p[e] = __builtin_amdgcn_exp2f(sacc[2 * i2][e] - mn); p[4 + e] = __builtin_amdgcn_exp2f(sacc[2 * i2 + 1][e] - mn); }
#pragma unroll
                for (int e = 0; e < 8; ++e) ps += p[e];
                v4u pk; pk.x = pk2(p[0], p[1]); pk.y = pk2(p[2], p[3]); pk.z = pk2(p[4], p[5]); pk.w = pk2(p[6], p[7]); pf[i2] = as_frag(pk); }
            ps += __shfl_xor(ps, 16); ps += __shfl_xor(ps, 32);
            lsum = lsum * alpha + ps;
#pragma unroll
            for (int dt = 0; dt < 4; ++dt) { oacc[dt] = oacc[dt] * alpha;
#pragma unroll
                for (int i2 = 0; i2 < 4; ++i2) { const bf16x8v vf = as_frag(*(const LAS v4u*)(vl + prm_row(dt >> 1, dt & 1, r16) * 272 + (32 * i2 + 8 * gq) * 2));
                    oacc[dt] = MFMA16(vf, pf[i2], oacc[dt]); } }
            if (nkb < 5) ATT_WRITE(cur ^ 1);
            __syncthreads();
            kb = nkb; cur ^= 1;
        }
#undef ATT_KEY0
#undef ATT_LOAD
#undef ATT_WRITE
        const float il = 1.0f / lsum;
#pragma unroll
        for (int i = 0; i < 2; ++i) { const f32x4 a = oacc[2 * i] * il, b = oacc[2 * i + 1] * il;
            v4u o; o.x = pk2(a[0], a[1]); o.y = pk2(a[2], a[3]); o.z = pk2(b[0], b[1]); o.w = pk2(b[2], b[3]);
            *(GAS v4u*)(MIX + (size_t)qrow * D + 512 + 64 * hq + 32 * i + 8 * gq) = o; }
    }
    __syncthreads();
}

constexpr int NPH = 23;
#ifndef WGM_MOE_GU
#define WGM_MOE_GU 4
#endif
#ifndef WGM_MOE_DN
#define WGM_MOE_DN 4
#endif
struct Args { const float* in[30]; float* out; unsigned char* ws; int ph_lo, ph_hi; };
__global__ void __launch_bounds__(NTHR, 2) mk_fwd(Args args) {
    extern __shared__ __attribute__((aligned(16))) unsigned char lds[];
    Frame F;
    F.lds = (LAS unsigned char*)lds;
    F.tid = threadIdx.x; F.lane = F.tid & 63; F.wave = __builtin_amdgcn_readfirstlane(F.tid >> 6);
    F.G = gridDim.x; { const int bx = blockIdx.x; F.vcu = (F.G % 8 == 0) ? (bx % 8) * (F.G / 8) + bx / 8 : bx; }
#pragma unroll
    for (int i = 0; i < 30; ++i) F.in[i] = args.in[i];
    F.out = args.out; F.ws = args.ws;
    unsigned char* ws = args.ws;
    volatile LAS unsigned* MISC = (volatile LAS unsigned*)(F.lds + MISC_OFF);
    for (int u = F.tid; u < (LDS_BYTES - LDSCTL_OFF) / 4; u += NTHR) ((LAS unsigned*)(F.lds + LDSCTL_OFF))[u] = 0u;
    __syncthreads();
    const int lo = args.ph_lo, hi = args.ph_hi;
    XcdBarrier bar; bar.bar = (unsigned*)(ws + WS_CTL) + CW_BAR; bar.x = 0; bar.st = nullptr;
    if (hi - lo > 1) bar = xcd_barrier_post((unsigned*)(ws + WS_CTL) + CW_BAR, MISC + 8);
#define IN(k) (lo <= (k) && (k) < hi)
#define SEAM(k) do { if (IN(k) && IN((k) + 1)) xcd_barrier(bar); } while (0)
    LAS unsigned char* ring = F.lds;
    bf16* X = (bf16*)(ws + WS_X); bf16* H = (bf16*)(ws + WS_H);

    if (IN(0)) { ph_prologue(F); } SEAM(0);
    if (IN(1)) { ph_modulate<false, false, 0>(F, F.in[I_X], F.in[I_CTX], F.in[I_N1G], modp(F, 0, 0), modp(F, 0, 1), M_SH1, M_SC1, H, MT, nullptr, nullptr, nullptr); } SEAM(1);
    if (IN(2)) { pg8::Gemm g{H, (const bf16*)(ws + WS_WABIN), D, D, 0}; pg8::StaticOrder S; S.init(MT, AB_IN, F.G, (int)blockIdx.x);
        pg8::EpiStoreBf16 E{(bf16*)(ws + WS_PAB), AB_IN};
        pg8::gemm_phase<pg8::EpiStoreBf16, pg8::StaticOrder, true, true>(ring, g, S, E);
        idle_round_convert(F, (MT / 256) * (AB_IN / 256), 0, 11400); } SEAM(2);
    if (IN(3)) { ph_ab_elem(F); } SEAM(3);
    if (IN(4)) { ph_attn(F); } SEAM(4);
    if (IN(5)) { { pg8::Gemm g{(const bf16*)(ws + WS_MIX), (const bf16*)(ws + WS_WABOUT), D, D, 0}; pg8::StaticOrder S; S.init(L, D, F.G, (int)blockIdx.x);
          pg8::EpiRes<true> E{X, F.in[I_X], modp(F, 0, 0) + M_G1};
          pg8::gemm_phase<pg8::EpiRes<true>, pg8::StaticOrder, true, true>(ring, g, S, E); }
        { int nu_ = 16, kl_ = 256; asm volatile("" : "+s"(nu_), "+s"(kl_)); pg8::Gemm g{(const bf16*)(ws + WS_MIX), (const bf16*)(ws + WS_WABOUT), D, kl_, 0}; pg8::SplitOrder S{64, 4, nu_, 256, F.G, (int)blockIdx.x};
          pg8::EpiPart E{(float*)(ws + WS_PART), 64, 256, LC};
          pg8::gemm_phase<pg8::EpiPart, pg8::SplitOrder, true, true>(ring, g, S, E); }
        if ((int)blockIdx.x >= 16) ph_convert_ffn(F, ((int)blockIdx.x - 16) * NWAVES + F.wave, (F.G - 16) * NWAVES); } SEAM(5);
    if (IN(6)) { ph_modulate<true, false, 4>(F, X, F.in[I_CTX], F.in[I_N2G], modp(F, 0, 0), modp(F, 0, 1), M_SH2, M_SC2, H, MT, (const float*)(ws + WS_PART), modp(F, 0, 1) + M_G1, X); } SEAM(6);
    if (IN(7)) { pg8::Gemm g{H, (const bf16*)(ws + WS_WFFNGU), D, D, 0}; pg8::StaticOrder S; S.init(MT, 2 * DFF, F.G, (int)blockIdx.x);
        pg8::EpiSwiGLU E{(bf16*)(ws + WS_ACT0), DFF};
        pg8::gemm_phase<pg8::EpiSwiGLU, pg8::StaticOrder, true, true>(ring, g, S, E);
        idle_round_convert(F, (MT / 256) * (2 * DFF / 256), 11400, 18000); } SEAM(7);
    if (IN(8)) { { pg8::Gemm g{(const bf16*)(ws + WS_ACT0), (const bf16*)(ws + WS_WFFND), DFF, DFF, 0}; pg8::StaticOrder S; S.init(L, D, F.G, (int)blockIdx.x);
          pg8::EpiRes<false> E{X, X, modp(F, 0, 0) + M_G2};
          pg8::gemm_phase<pg8::EpiRes<false>, pg8::StaticOrder, true, true>(ring, g, S, E); }
        { int nu_ = 44, kl_ = 256; asm volatile("" : "+s"(nu_), "+s"(kl_)); pg8::Gemm g{(const bf16*)(ws + WS_ACT0), (const bf16*)(ws + WS_WFFND), DFF, kl_, 0}; pg8::SplitOrder S{64, 4, nu_, 256, F.G, (int)blockIdx.x};
          pg8::EpiPart E{(float*)(ws + WS_PART), 64, 256, LC};
          pg8::gemm_phase<pg8::EpiPart, pg8::SplitOrder, true, true>(ring, g, S, E); }
        if ((int)blockIdx.x >= 44) ph_convert_ssd(F, ((int)blockIdx.x - 44) * NWAVES + F.wave, (F.G - 44) * NWAVES); } SEAM(8);
    if (IN(9)) { ph_modulate<true, true, 11>(F, X, X + (size_t)L * D, F.in[I_N1G] + D, modp(F, 1, 0), modp(F, 1, 1), M_SH1, M_SC1, H, MT, (const float*)(ws + WS_PART), modp(F, 0, 1) + M_G2, nullptr); } SEAM(9);
    if (IN(10)) { pg8::Gemm g{H, (const bf16*)(ws + WS_WSSDIN), D, D, 0}; pg8::StaticOrder S; S.init(MT, SSD_INP, F.G, (int)blockIdx.x);
        pg8::EpiSsdIn E{(bf16*)(ws + WS_Z), (bf16*)(ws + WS_XBCR), (float*)(ws + WS_DTRAW)};
        pg8::gemm_phase<pg8::EpiSsdIn, pg8::StaticOrder, true, true>(ring, g, S, E);
        idle_round_convert(F, (MT / 256) * (SSD_INP / 256), 18000, MOE_GU_ITEMS); } SEAM(10);
    if (IN(11)) { ph_ssd_conv(F); } SEAM(11);
    if (IN(12)) { ph_ssd_s1(F); } SEAM(12);
    if (IN(13)) { ph_ssd_s2(F); } SEAM(13);
    if (IN(14)) { ph_ssd_s3(F); } if (IN(14) && IN(16)) xcd_barrier(bar);
    if (IN(16)) { pg8::Gemm g{(const bf16*)(ws + WS_Z), (const bf16*)(ws + WS_WSSDOUT), DIN, DIN, 0}; pg8::StaticOrder S; S.init(L, D, F.G, (int)blockIdx.x);
        pg8::EpiRes<false> E{X, X, modp(F, 1, 0) + M_G1};
        pg8::gemm_phase<pg8::EpiRes<false>, pg8::StaticOrder, true, true>(ring, g, S, E); } SEAM(16);
    if (IN(17)) { ph_moe_route(F); } SEAM(17);
    if (IN(18)) { ph_moe_scatter(F); } SEAM(18);
    if (IN(19) || IN(21)) {
        LAS int* hist = (LAS int*)F.lds; LAS int* cnt = hist + 512; LAS int* seg = cnt + 8;
        pg8::GroupedOrder S;
        if (IN(19)) {
            moe_segments(F, hist, cnt, seg);
            S.nM = seg[8] >> 8; S.nN = 2 * FFE / 256; S.nwg = S.nM * S.nN; S.G = F.G; S.c = (int)blockIdx.x; S.WGM = WGM_MOE_GU;
            S.ts1 = seg[1] >> 8; S.ts2 = seg[2] >> 8; S.ts3 = seg[3] >> 8; S.ts4 = seg[4] >> 8; S.ts5 = seg[5] >> 8; S.ts6 = seg[6] >> 8; S.ts7 = seg[7] >> 8;
            __syncthreads();
            pg8::Gemm g{(const bf16*)(ws + WS_H2S), (const bf16*)(ws + WS_WMOE), D, D, (size_t)2 * FFE * D * 2};
            pg8::EpiSwiGLU E{(bf16*)(ws + WS_ACTM), FFE};
            pg8::gemm_phase<pg8::EpiSwiGLU, pg8::GroupedOrder, true, true>(ring, g, S, E);
        }
        SEAM(19);
        if (IN(20)) { int first = 0;
            for (int e = 0; e < NEXP; ++e) tr_matrix(F, F.in[I_MOED] + (size_t)e * FFE * D, FFE, D, (bf16*)(ws + WS_WMOE) + (size_t)e * D * FFE, 0, first); }
        SEAM(20);
        if (IN(21)) {
            __syncthreads();
            moe_segments(F, hist, cnt, seg);
            const int NT = seg[8] >> 8;
            S.nM = NT < 128 ? NT : 128; S.nN = D / 256; S.nwg = S.nM * S.nN; S.G = F.G; S.c = (int)blockIdx.x; S.WGM = WGM_MOE_DN;
            S.ts1 = seg[1] >> 8; S.ts2 = seg[2] >> 8; S.ts3 = seg[3] >> 8; S.ts4 = seg[4] >> 8; S.ts5 = seg[5] >> 8; S.ts6 = seg[6] >> 8; S.ts7 = seg[7] >> 8;
            __syncthreads();
            { pg8::Gemm g{(const bf16*)(ws + WS_ACTM), (const bf16*)(ws + WS_WMOE), FFE, FFE, (size_t)D * FFE * 2};
              pg8::EpiStoreBf16 E{(bf16*)(ws + WS_H2S), D};
              pg8::gemm_phase<pg8::EpiStoreBf16, pg8::GroupedOrder, true, true>(ring, g, S, E); }
            if (NT > 128) {
                pg8::Gemm g{(const bf16*)(ws + WS_ACTM), (const bf16*)(ws + WS_WMOE), FFE, 512, (size_t)D * FFE * 2};
                pg8::SplitGroupedOrder S2{128, NT, D / 256, 7, 512, F.G, (int)blockIdx.x, S.ts1, S.ts2, S.ts3, S.ts4, S.ts5, S.ts6, S.ts7};
                pg8::EpiPart E{(float*)(ws + WS_YPART), 128, 512, 2048};
                pg8::gemm_phase<pg8::EpiPart, pg8::SplitGroupedOrder, true, true>(ring, g, S2, E); }
        }
        SEAM(21);
    } else { SEAM(19); if (IN(20)) { int first = 0;
            for (int e = 0; e < NEXP; ++e) tr_matrix(F, F.in[I_MOED] + (size_t)e * FFE * D, FFE, D, (bf16*)(ws + WS_WMOE) + (size_t)e * D * FFE, 0, first); }
        SEAM(20); SEAM(21); }
    if (IN(22)) { ph_final(F); }
#undef IN
#undef SEAM
}

extern "C" void kernel_launch(void* const* d_in, const int* in_sizes, int n_in, void* d_out, int out_size, void* d_ws, size_t ws_size, hipStream_t stream) {
    static int grid = 0;
    if (grid == 0) {
        if (n_in != 30 || in_sizes[0] != L * D || out_size != L * D || ws_size < WS_END) { fprintf(stderr, "kernel_launch: unexpected shapes (n_in %d, in0 %d, out %d, ws %zu < %zu); nothing launched\n", n_in, n_in > 0 ? in_sizes[0] : -1, out_size, ws_size, (size_t)WS_END); grid = -1; return; }
        int dev = 0, cus = 0, per_cu = 0;
        if (hipGetDevice(&dev) != hipSuccess || hipDeviceGetAttribute(&cus, hipDeviceAttributeMultiprocessorCount, dev) != hipSuccess) { grid = -1; return; }
        if (hipFuncSetAttribute((const void*)mk_fwd, hipFuncAttributeMaxDynamicSharedMemorySize, LDS_BYTES) != hipSuccess) { fprintf(stderr, "kernel_launch: hipFuncSetAttribute failed\n"); grid = -1; return; }
        if (hipOccupancyMaxActiveBlocksPerMultiprocessor(&per_cu, (const void*)mk_fwd, NTHR, LDS_BYTES) != hipSuccess || per_cu < 1)
            fprintf(stderr, "kernel_launch: note: occupancy query reports %d workgroups per CU\n", per_cu);
        (void)hipGetLastError();
        grid = cus;
    }
    if (grid < 0) return;
    if (hipMemsetAsync((char*)d_ws + WS_CTL, 0, CTL_ZERO_BYTES, stream) != hipSuccess) return;
    Args a{};
    for (int i = 0; i < 30; ++i) a.in[i] = (const float*)d_in[i];
    a.out = (float*)d_out; a.ws = (unsigned char*)d_ws;
    if (MK_N_LAUNCHES == 1) { a.ph_lo = 0; a.ph_hi = NPH; hipLaunchKernelGGL(mk_fwd, dim3(grid), dim3(NTHR), LDS_BYTES, stream, a); }
    else { for (int p = 0; p < NPH; ++p) { a.ph_lo = p; a.ph_hi = p + 1; hipLaunchKernelGGL(mk_fwd, dim3(grid), dim3(NTHR), LDS_BYTES, stream, a); } }
}
```

```cpp
#include <hip/hip_runtime.h>
#include <cstdio>
#include <cstdint>

#ifndef MK_N_LAUNCHES
#define MK_N_LAUNCHES 1
#endif

namespace pg8 {
#define PG8_LAS __attribute__((address_space(3)))
typedef unsigned short bf16_t;
typedef short bf16x8 __attribute__((ext_vector_type(8)));
typedef float f32x4 __attribute__((ext_vector_type(4)));
typedef unsigned u32x4 __attribute__((ext_vector_type(4)));
constexpr int BM = 256, BK = 64, HALF = 128, HTB = HALF * BK * 2  , STAGE_BYTES = 8 * HTB, NXCD = 8;

__host__ __device__ __forceinline__ int lds_byte(int r, int c) { const int st = (r >> 4) * 2 + (c >> 5), rr = r & 15, cc = c & 31, ob = rr * 64 + cc * 2; return st * 1024 + (ob ^ (((ob >> 9) & 1) << 5)); }
__host__ __device__ __forceinline__ void stage_rc(int b, int& R, int& C) { const int st = b / 1024, sb = b % 1024, swz = sb ^ (((sb >> 9) & 1) << 5); R = (st >> 1) * 16 + swz / 64; C = (st & 1) * 32 + (swz % 64) / 2; }
__host__ __device__ __forceinline__ int perm32(int rho) { const int n = rho >> 4, i = rho & 15; return 8 * (i >> 2) + 4 * n + (i & 3); }

struct Unit { int pm, pn, pe, pk; };
struct Gemm { const bf16_t* A; const bf16_t* Bt; int ld, K; size_t bstride; };

struct StaticOrder {
    int nM, nN, nwg, G, c, WGM;
    __host__ __device__ void init(int M, int N, int G_, int c_, int wgm = 4) { nM = M / BM; nN = N / BM; nwg = nM * nN; G = G_; c = c_; WGM = wgm; }
    __host__ __device__ bool next(int i, Unit& u) const {
        const long L = (long)i * G + c; if (L >= nwg) return false;
        int wgid = (int)L; { const int q = nwg / NXCD, r = nwg % NXCD, xcd = wgid % NXCD, off = wgid / NXCD; wgid = (xcd < r ? xcd * (q + 1) : r * (q + 1) + (xcd - r) * q) + off; }
        const int nig = WGM * nN, gid = wgid / nig, fm = gid * WGM, gsz = (nM - fm) < WGM ? (nM - fm) : WGM;
        u.pm = fm + ((wgid % nig) % gsz); u.pn = (wgid % nig) / gsz; u.pe = 0; u.pk = 0; return true;
    }
    __device__ __forceinline__ void a_ready(const Unit&) const {}
    __device__ __forceinline__ void done(const Unit&) const {}
};
struct GroupedOrder {
    int nM, nN, nwg, G, c, WGM; int ts1, ts2, ts3, ts4, ts5, ts6, ts7;
    __device__ bool next(int i, Unit& u) const {
        const long L = (long)i * G + c; if (L >= nwg) return false;
        int wgid = (int)L; { const int q = nwg / NXCD, r = nwg % NXCD, xcd = wgid % NXCD, off = wgid / NXCD; wgid = (xcd < r ? xcd * (q + 1) : r * (q + 1) + (xcd - r) * q) + off; }
        const int nig = WGM * nN, gid = wgid / nig, fm = gid * WGM, gsz = (nM - fm) < WGM ? (nM - fm) : WGM;
        u.pm = fm + ((wgid % nig) % gsz); u.pn = (wgid % nig) / gsz;
        u.pk = 0; const int p = u.pm; u.pe = (p >= ts1) + (p >= ts2) + (p >= ts3) + (p >= ts4) + (p >= ts5) + (p >= ts6) + (p >= ts7); return true;
    }
    __device__ __forceinline__ void a_ready(const Unit&) const {}
    __device__ __forceinline__ void done(const Unit&) const {}
};

__device__ __forceinline__ unsigned cvt_pk_bf16(float lo, float hi) { unsigned r; asm volatile("v_cvt_pk_bf16_f32 %0, %1, %2" : "=v"(r) : "v"(lo), "v"(hi)); return r; }
__device__ __forceinline__ float silu_f(float g) { return g * __builtin_amdgcn_rcpf(1.0f + __expf(-g)); }

struct EpiStoreBf16 {
    static constexpr bool PERM = true, AFTER_DRAIN = false;
    bf16_t* O; int ldc;
    __device__ __forceinline__ void operator()(const f32x4 (&acc)[2][2][4][2], const Unit& u, int wr, int wc, int fr, int fq) const {
        const int row0 = u.pm * BM + wr * 64 + fr, col0 = u.pn * BM + wc * 32 + 8 * fq;
#pragma unroll
        for (int ai = 0; ai < 2; ++ai)
#pragma unroll
            for (int m = 0; m < 4; ++m) { bf16_t* rowp = O + (size_t)(row0 + ai * HALF + m * 16) * ldc + col0;
#pragma unroll
                for (int bj = 0; bj < 2; ++bj) { const f32x4 v0 = acc[ai][bj][m][0], v1 = acc[ai][bj][m][1];
                    u32x4 w; w.x = cvt_pk_bf16(v0[0], v0[1]); w.y = cvt_pk_bf16(v0[2], v0[3]); w.z = cvt_pk_bf16(v1[0], v1[1]); w.w = cvt_pk_bf16(v1[2], v1[3]);
                    *(u32x4*)(rowp + bj * HALF) = w; } }
    }
};
struct EpiSwiGLU {
    static constexpr bool PERM = true, AFTER_DRAIN = false;
    bf16_t* O; int ldc;
    __device__ __forceinline__ void operator()(const f32x4 (&acc)[2][2][4][2], const Unit& u, int wr, int wc, int fr, int fq) const {
        const int row0 = u.pm * BM + wr * 64 + fr, col0 = u.pn * HALF + wc * 32 + 8 * fq;
#pragma unroll
        for (int ai = 0; ai < 2; ++ai)
#pragma unroll
            for (int m = 0; m < 4; ++m) { bf16_t* rowp = O + (size_t)(row0 + ai * HALF + m * 16) * ldc + col0;
                const f32x4 g0 = acc[ai][0][m][0], g1 = acc[ai][0][m][1], u0 = acc[ai][1][m][0], u1 = acc[ai][1][m][1];
                u32x4 w; w.x = cvt_pk_bf16(silu_f(g0[0]) * u0[0], silu_f(g0[1]) * u0[1]); w.y = cvt_pk_bf16(silu_f(g0[2]) * u0[2], silu_f(g0[3]) * u0[3]);
                w.z = cvt_pk_bf16(silu_f(g1[0]) * u1[0], silu_f(g1[1]) * u1[1]); w.w = cvt_pk_bf16(silu_f(g1[2]) * u1[2], silu_f(g1[3]) * u1[3]);
                *(u32x4*)rowp = w; }
    }
};
template <bool BASE_F32> struct EpiRes {
    static constexpr bool PERM = true, AFTER_DRAIN = false;
    bf16_t* X; const void* base; const float* gate;
    __device__ __forceinline__ void operator()(const f32x4 (&acc)[2][2][4][2], const Unit& u, int wr, int wc, int fr, int fq) const {
        const int row0 = u.pm * BM + wr * 64 + fr, col0 = u.pn * BM + wc * 32 + 8 * fq;
        f32x4 gv[2][2];
#pragma unroll
        for (int bj = 0; bj < 2; ++bj)
#pragma unroll
            for (int n = 0; n < 2; ++n) gv[bj][n] = *(const f32x4*)(gate + col0 + bj * HALF + 4 * n);
#pragma unroll
        for (int ai = 0; ai < 2; ++ai)
#pragma unroll
            for (int m = 0; m < 4; ++m) { const size_t ro = (size_t)(row0 + ai * HALF + m * 16) * 1024 + col0;
#pragma unroll
                for (int bj = 0; bj < 2; ++bj) { f32x4 b0, b1;
                    if (BASE_F32) { b0 = __builtin_nontemporal_load((const f32x4*)((const float*)base + ro + bj * HALF)); b1 = __builtin_nontemporal_load((const f32x4*)((const float*)base + ro + bj * HALF + 4)); }
                    else { const u32x4 t = *(const u32x4*)((const bf16_t*)base + ro + bj * HALF);
                        b0 = (f32x4){__uint_as_float(t.x << 16), __uint_as_float(t.x & 0xffff0000u), __uint_as_float(t.y << 16), __uint_as_float(t.y & 0xffff0000u)};
                        b1 = (f32x4){__uint_as_float(t.z << 16), __uint_as_float(t.z & 0xffff0000u), __uint_as_float(t.w << 16), __uint_as_float(t.w & 0xffff0000u)}; }
                    const f32x4 v0 = b0 + gv[bj][0] * acc[ai][bj][m][0], v1 = b1 + gv[bj][1] * acc[ai][bj][m][1];
                    u32x4 w; w.x = cvt_pk_bf16(v0[0], v0[1]); w.y = cvt_pk_bf16(v0[2], v0[3]); w.z = cvt_pk_bf16(v1[0], v1[1]); w.w = cvt_pk_bf16(v1[2], v1[3]);
                    *(u32x4*)(X + ro + bj * HALF) = w; } }
    }
};
struct EpiSsdIn {
    static constexpr bool PERM = true, AFTER_DRAIN = false;
    bf16_t* Z; bf16_t* XB; float* DT;
    __device__ __forceinline__ void operator()(const f32x4 (&acc)[2][2][4][2], const Unit& u, int wr, int wc, int fr, int fq) const {
        const int row0 = u.pm * BM + wr * 64 + fr;
        if (u.pn < 20) {
            bf16_t* O = u.pn < 8 ? Z : XB; const int ldc = u.pn < 8 ? 2048 : 3072; const int col0 = (u.pn < 8 ? u.pn : u.pn - 8) * BM + wc * 32 + 8 * fq;
#pragma unroll
            for (int ai = 0; ai < 2; ++ai)
#pragma unroll
                for (int m = 0; m < 4; ++m) { bf16_t* rowp = O + (size_t)(row0 + ai * HALF + m * 16) * ldc + col0;
#pragma unroll
                    for (int bj = 0; bj < 2; ++bj) { const f32x4 v0 = acc[ai][bj][m][0], v1 = acc[ai][bj][m][1];
                        u32x4 w; w.x = cvt_pk_bf16(v0[0], v0[1]); w.y = cvt_pk_bf16(v0[2], v0[3]); w.z = cvt_pk_bf16(v1[0], v1[1]); w.w = cvt_pk_bf16(v1[2], v1[3]);
                        *(u32x4*)(rowp + bj * HALF) = w; } }
        } else if (wc < 2) {
#pragma unroll
            for (int ai = 0; ai < 2; ++ai)
#pragma unroll
                for (int m = 0; m < 4; ++m) { float* rowp = DT + (size_t)(row0 + ai * HALF + m * 16) * 64 + wc * 32 + 8 * fq;
                    *(f32x4*)rowp = acc[ai][0][m][0]; *(f32x4*)(rowp + 4) = acc[ai][0][m][1]; }
        }
    }
};


struct SplitOrder {
    int pm0, nN, nunits, ks_len, G, c;
    __device__ bool next(int i, Unit& u) const { const int x = i * G + c; if (x >= nunits) return false; u.pm = pm0; u.pn = x % nN; u.pe = 0; u.pk = (x / nN) * ks_len; return true; }
    __device__ __forceinline__ void a_ready(const Unit&) const {}
    __device__ __forceinline__ void done(const Unit&) const {}
};
struct SplitGroupedOrder {
    int pm_lo, pm_hi, nN, nks, ks_len, G, c; int ts1, ts2, ts3, ts4, ts5, ts6, ts7;
    __device__ bool next(int i, Unit& u) const { const int x = i * G + c; const int per = nN * nks; if (x >= (pm_hi - pm_lo) * per) return false;
        u.pm = pm_lo + x / per; const int y = x % per; u.pn = y / nks; u.pk = (y % nks) * ks_len;
        const int p = u.pm; u.pe = (p >= ts1) + (p >= ts2) + (p >= ts3) + (p >= ts4) + (p >= ts5) + (p >= ts6) + (p >= ts7); return true; }
    __device__ __forceinline__ void a_ready(const Unit&) const {}
    __device__ __forceinline__ void done(const Unit&) const {}
};
struct EpiPart {
    static constexpr bool PERM = false, AFTER_DRAIN = false;
    float* P; int pm_base, ks_len, nrows;
    __device__ __forceinline__ void operator()(const f32x4 (&acc)[2][2][4][2], const Unit& u, int wr, int wc, int fr, int fq) const {
        const int row0 = (u.pm - pm_base) * BM + wr * 64 + fr, col0 = u.pn * BM + wc * 32 + 4 * fq;
        float* base = P + (size_t)(u.pk / ks_len) * nrows * 1024;
#pragma unroll
        for (int ai = 0; ai < 2; ++ai)
#pragma unroll
            for (int m = 0; m < 4; ++m) { float* rowp = base + (size_t)(row0 + ai * HALF + m * 16) * 1024 + col0;
#pragma unroll
                for (int bj = 0; bj < 2; ++bj)
#pragma unroll
                    for (int n = 0; n < 2; ++n) *(f32x4*)(rowp + bj * HALF + n * 16) = acc[ai][bj][m][n]; }
    }
};
template <class Epi, class Sched, bool ALIGN_EPI = false, bool SP2 = false>
__device__ __forceinline__ void gemm_phase(PG8_LAS unsigned char* lds, const Gemm g, const Sched& S, const Epi& E) {
    const int tid = threadIdx.x, wid = __builtin_amdgcn_readfirstlane(tid >> 6), lane = tid & 63, wr = wid >> 2, wc = wid & 3, fr = lane & 15, fq = lane >> 4;
    const int K = g.K, nt = K / BK;
    unsigned voffA[2], voffB[2];
#pragma unroll
    for (int i = 0; i < 2; ++i) { int R, C; stage_rc(tid * 16 + i * 8192, R, C); const int Rb = Epi::PERM ? ((R & ~31) + perm32(R & 31)) : R;
        voffA[i] = (unsigned)(R * g.ld + C) * 2u; voffB[i] = (unsigned)(Rb * g.ld + C) * 2u; }
    const size_t kstep = (size_t)(BK * 2);
    const size_t hstep = (size_t)HALF * g.ld * 2;
    const size_t tstep = 2 * hstep;
    const unsigned ldsw = (unsigned)wid * 1024u;
    const int aoff = lds_byte(wr * 64 + fr, fq * 8), boff = lds_byte(wc * 32 + fr, fq * 8);
#define PG8_SA(b, h) (((b) * 2 + (h)) * HTB)
#define PG8_SB(b, h) ((4 + (b) * 2 + (h)) * HTB)
#define PG8_STAGE(bufoff, gbase, voff) do { _Pragma("unroll") for (int _i = 0; _i < 2; ++_i) \
        __builtin_amdgcn_global_load_lds((const unsigned*)((const char*)(gbase) + (voff)[_i]), (PG8_LAS unsigned*)(lds + (bufoff) + ldsw + _i * 8192), 16, 0, 0); } while (0)
#define PG8_LDA(dst, b, h) do { _Pragma("unroll") for (int m = 0; m < 4; ++m) _Pragma("unroll") for (int k = 0; k < 2; ++k) dst[m][k] = *(const PG8_LAS bf16x8*)(lds + PG8_SA(b, h) + aoff + m * 2048 + k * 1024); } while (0)
#define PG8_LDB(dst, b, h) do { _Pragma("unroll") for (int n = 0; n < 2; ++n) _Pragma("unroll") for (int k = 0; k < 2; ++k) dst[n][k] = *(const PG8_LAS bf16x8*)(lds + PG8_SB(b, h) + boff + n * 2048 + k * 1024); } while (0)
#define PG8_MMA(ai, bj, At, Bt) do { __builtin_amdgcn_s_setprio(1); _Pragma("unroll") for (int m = 0; m < 4; ++m) _Pragma("unroll") for (int n = 0; n < 2; ++n) _Pragma("unroll") for (int k = 0; k < 2; ++k) \
        acc[ai][bj][m][n] = __builtin_amdgcn_mfma_f32_16x16x32_bf16(Bt[n][k], At[m][k], acc[ai][bj][m][n], 0, 0, 0); __builtin_amdgcn_s_setprio(0); } while (0)
#define PG8_WAIT_V(n) asm volatile("s_waitcnt vmcnt(" #n ")" ::: "memory")
#define PG8_WAIT_L(n) asm volatile("s_waitcnt lgkmcnt(" #n ")" ::: "memory")
#define PG8_BAR __builtin_amdgcn_s_barrier()
#define PG8_SCHED __builtin_amdgcn_sched_barrier(0)
    Unit cur, nxt; int ui = 0;
    if (!S.next(0, cur)) return;
    f32x4 acc[2][2][4][2];
#pragma unroll
    for (int a = 0; a < 2; ++a)
#pragma unroll
        for (int b = 0; b < 2; ++b)
#pragma unroll
            for (int m = 0; m < 4; ++m)
#pragma unroll
                for (int n = 0; n < 2; ++n) acc[a][b][m][n] = (f32x4){0.f, 0.f, 0.f, 0.f};
    bf16x8 At[4][2], B0[2][2], B1[2][2];
    const char* cA = (const char*)g.A + (size_t)cur.pm * tstep + (size_t)cur.pk * 2; const char* cB = (const char*)g.Bt + (size_t)cur.pe * g.bstride + (size_t)cur.pn * tstep + (size_t)cur.pk * 2;
    S.a_ready(cur);
    if constexpr (SP2) {
        PG8_STAGE(PG8_SB(0, 0), cB, voffB); PG8_STAGE(PG8_SB(0, 1), cB + hstep, voffB); PG8_STAGE(PG8_SA(0, 0), cA, voffA); PG8_STAGE(PG8_SA(0, 1), cA + hstep, voffA);
        if (wr == 1) PG8_BAR;
        PG8_WAIT_V(2); PG8_BAR;
        PG8_STAGE(PG8_SB(1, 0), cB + kstep, voffB); PG8_STAGE(PG8_SA(1, 0), cA + kstep, voffA); PG8_STAGE(PG8_SB(1, 1), cB + hstep + kstep, voffB);
        PG8_WAIT_V(6); PG8_BAR;
    } else {
        PG8_STAGE(PG8_SB(0, 0), cB, voffB); PG8_STAGE(PG8_SA(0, 0), cA, voffA); PG8_STAGE(PG8_SB(0, 1), cB + hstep, voffB); PG8_STAGE(PG8_SA(0, 1), cA + hstep, voffA);
        if (wr == 1) PG8_BAR;
        PG8_WAIT_V(4); PG8_BAR;
        PG8_STAGE(PG8_SB(1, 0), cB + kstep, voffB); PG8_STAGE(PG8_SA(1, 0), cA + kstep, voffA); PG8_STAGE(PG8_SB(1, 1), cB + hstep + kstep, voffB);
        PG8_WAIT_V(6); PG8_BAR;
    }
    for (;;) {
        const bool has_next = S.next(ui + 1, nxt);
        const char* nA = has_next ? (const char*)g.A + (size_t)nxt.pm * tstep + (size_t)nxt.pk * 2 : cA; const char* nB = has_next ? (const char*)g.Bt + (size_t)nxt.pe * g.bstride + (size_t)nxt.pn * tstep + (size_t)nxt.pk * 2 : cB;
        for (int t = 0; t < nt; t += 2) {
            const bool last = (t == nt - 2);
            const char* a1 = cA + (size_t)(t + 1) * kstep;
            const char* a2 = last ? nA : cA + (size_t)(t + 2) * kstep; const char* b2 = last ? nB : cB + (size_t)(t + 2) * kstep;
            const char* a3 = a2 + kstep; const char* b3 = b2 + kstep;
            if (last && has_next) S.a_ready(nxt);
            if constexpr (SP2) {
            PG8_LDB(B0, 0, 0); PG8_LDB(B1, 0, 1); PG8_SCHED; PG8_LDA(At, 0, 0); PG8_STAGE(PG8_SA(1, 1), a1 + hstep, voffA);
            PG8_WAIT_V(8); PG8_WAIT_L(0); PG8_BAR; PG8_MMA(0, 0, At, B0); PG8_MMA(0, 1, At, B1); PG8_BAR; PG8_SCHED;
            PG8_LDA(At, 0, 1); PG8_STAGE(PG8_SB(0, 0), b2, voffB); PG8_STAGE(PG8_SB(0, 1), b2 + hstep, voffB); PG8_STAGE(PG8_SA(0, 0), a2, voffA);
            PG8_WAIT_V(8); PG8_WAIT_L(0); PG8_BAR; PG8_MMA(1, 0, At, B0); PG8_MMA(1, 1, At, B1); PG8_BAR; PG8_SCHED;
            PG8_LDB(B0, 1, 0); PG8_LDB(B1, 1, 1); PG8_SCHED; PG8_LDA(At, 1, 0); PG8_STAGE(PG8_SA(0, 1), a2 + hstep, voffA);
            PG8_WAIT_V(8); PG8_WAIT_L(0); PG8_BAR; PG8_MMA(0, 0, At, B0); PG8_MMA(0, 1, At, B1); PG8_BAR; PG8_SCHED;
            PG8_LDA(At, 1, 1); PG8_STAGE(PG8_SB(1, 0), b3, voffB); PG8_STAGE(PG8_SB(1, 1), b3 + hstep, voffB); PG8_STAGE(PG8_SA(1, 0), a3, voffA);
            PG8_WAIT_V(8); PG8_WAIT_L(0); PG8_BAR; PG8_MMA(1, 0, At, B0); PG8_MMA(1, 1, At, B1); PG8_BAR; PG8_SCHED;
            } else {
            PG8_LDB(B0, 0, 0); PG8_SCHED; PG8_LDA(At, 0, 0); PG8_STAGE(PG8_SA(1, 1), a1 + hstep, voffA);
            PG8_WAIT_L(8); PG8_BAR; PG8_WAIT_L(0); PG8_MMA(0, 0, At, B0); PG8_BAR; PG8_SCHED;
            PG8_LDB(B1, 0, 1); PG8_STAGE(PG8_SB(0, 0), b2, voffB);
            PG8_BAR; PG8_WAIT_L(0); PG8_MMA(0, 1, At, B1); PG8_BAR;
            PG8_LDA(At, 0, 1); PG8_STAGE(PG8_SA(0, 0), a2, voffA);
            PG8_BAR; PG8_WAIT_L(0); PG8_MMA(1, 0, At, B0); PG8_BAR; PG8_SCHED;
            PG8_STAGE(PG8_SB(0, 1), b2 + hstep, voffB);
            PG8_WAIT_V(6); PG8_BAR; PG8_MMA(1, 1, At, B1); PG8_BAR;
            PG8_LDB(B0, 1, 0); PG8_SCHED; PG8_LDA(At, 1, 0); PG8_STAGE(PG8_SA(0, 1), a2 + hstep, voffA);
            PG8_WAIT_L(8); PG8_BAR; PG8_WAIT_L(0); PG8_MMA(0, 0, At, B0); PG8_BAR; PG8_SCHED;
            PG8_LDB(B1, 1, 1); PG8_STAGE(PG8_SB(1, 0), b3, voffB);
            PG8_BAR; PG8_WAIT_L(0); PG8_MMA(0, 1, At, B1); PG8_BAR;
            PG8_LDA(At, 1, 1); PG8_STAGE(PG8_SA(1, 0), a3, voffA);
            PG8_BAR; PG8_WAIT_L(0); PG8_MMA(1, 0, At, B0); PG8_BAR; PG8_SCHED;
            PG8_STAGE(PG8_SB(1, 1), b3 + hstep, voffB);
            PG8_WAIT_V(6); PG8_BAR; PG8_MMA(1, 1, At, B1); PG8_BAR;
            }
        }
        if constexpr (ALIGN_EPI) { if (wr == 0) PG8_BAR; }
        if constexpr (!Epi::AFTER_DRAIN) { E(acc, cur, wr, wc, fr, fq); S.done(cur); }
        if (!has_next) break;
#pragma unroll
        for (int a = 0; a < 2; ++a)
#pragma unroll
            for (int b = 0; b < 2; ++b)
#pragma unroll
                for (int m = 0; m < 4; ++m)
#pragma unroll
                    for (int n = 0; n < 2; ++n) acc[a][b][m][n] = (f32x4){0.f, 0.f, 0.f, 0.f};
        cur = nxt; cA = nA; cB = nB; ++ui;
        if constexpr (ALIGN_EPI) { if (wr == 1) PG8_BAR; }
    }
    PG8_WAIT_V(0);
    if constexpr (!ALIGN_EPI) { if (wr == 0) PG8_BAR; }
    PG8_BAR;
    if constexpr (Epi::AFTER_DRAIN) { E.fused(acc, cur, wr, wc, fr, fq, lds, wid, lane); S.done(cur); }
#undef PG8_SA
#undef PG8_SB
#undef PG8_STAGE
#undef PG8_LDA
#undef PG8_LDB
#undef PG8_MMA
#undef PG8_WAIT_V
#undef PG8_WAIT_L
#undef PG8_BAR
#undef PG8_SCHED
}
}

constexpr int NWAVES = 8, NTHR = 512;
constexpr int D = 1024, L = 16384, LC = 256, MT = L + LC;
constexpr int AB_IN = 2304, DFF = 2816, SSD_INP = 5376, SSD_IN_REAL = 5184, DIN = 2048, XBCW = 3072, FFE = 3584, NEXP = 8;
constexpr int NCH = MT / 128;
constexpr int MOE_ROWS = 2 * L + NEXP * 256;
constexpr float EPS = 1e-6f;

constexpr size_t MiB = 1u << 20;
constexpr size_t WS_CTL = 0, CTL_ZERO_BYTES = 32768;
constexpr size_t WS_MOD = 1 * MiB;
constexpr size_t WS_ROPE = 1 * MiB + 128 * 1024;
constexpr size_t WS_TOKE = 2 * MiB, WS_TOKW = 2 * MiB + 128 * 1024, WS_TOKP = 2 * MiB + 256 * 1024;
constexpr size_t WS_DEC = 3 * MiB;
constexpr size_t WS_X = 4 * MiB;
constexpr size_t WS_H = 36 * MiB + 512 * 1024;
constexpr size_t WS_WMOE = 69 * MiB, WS_YPART = WS_WMOE + 56 * MiB;
constexpr size_t WS_H2S = 181 * MiB, WS_ACTM = 249 * MiB, WS_H2 = 487 * MiB, WS_END = 520 * MiB;
constexpr size_t WS_WSSDIN = 181 * MiB, WS_WSSDOUT = WS_WSSDIN + (size_t)SSD_INP * D * 2;
constexpr size_t WS_WABIN = 196 * MiB, WS_WABOUT = WS_WABIN + (size_t)AB_IN * D * 2, WS_WFFNGU = WS_WABOUT + (size_t)D * D * 2, WS_WFFND = WS_WFFNGU + (size_t)2 * DFF * D * 2;
constexpr size_t WS_PAB = 219 * MiB, WS_MIX = 293 * MiB, WS_ACT0 = 326 * MiB, WS_QR = 416 * MiB, WS_KR = 433 * MiB, WS_VT = 438 * MiB, WS_PART = 443 * MiB;
constexpr size_t WS_Z = 196 * MiB, WS_XBCR = 261 * MiB, WS_STATES = 261 * MiB, WS_DTRAW = 391 * MiB, WS_DTS = 396 * MiB, WS_XT = 405 * MiB, WS_BT = 470 * MiB, WS_BM = 487 * MiB, WS_CM = 503 * MiB + 512 * 1024;
constexpr size_t DTS_STRIDE = (size_t)32 * MT * 4;
static_assert(WS_X + (size_t)MT * D * 2 <= WS_H && WS_H + (size_t)MT * D * 2 <= WS_WMOE, "X / H map");
static_assert(WS_WMOE + (size_t)NEXP * 2 * FFE * D * 2 <= WS_H2S && WS_H2S + (size_t)MOE_ROWS * D * 2 <= WS_ACTM && WS_ACTM + (size_t)MOE_ROWS * FFE * 2 <= WS_H2 && WS_H2 + (size_t)L * D * 2 <= WS_END, "moe map");
static_assert(WS_YPART >= WS_WMOE + (size_t)NEXP * D * FFE * 2 && WS_YPART + (size_t)7 * 2048 * D * 4 <= WS_H2S, "moe map 2");
static_assert(WS_WSSDOUT + (size_t)D * DIN * 2 <= WS_WABIN && WS_WFFND + (size_t)D * DFF * 2 <= WS_PAB, "weights map");
static_assert(WS_PAB + (size_t)MT * AB_IN * 2 <= WS_MIX && WS_MIX + (size_t)MT * D * 2 <= WS_ACT0 && WS_ACT0 + (size_t)MT * DFF * 2 <= WS_QR && WS_QR + (size_t)8 * MT * 64 * 2 <= WS_KR && WS_KR + (size_t)2 * MT * 64 * 2 <= WS_VT && WS_VT + (size_t)128 * MT * 2 <= WS_PART && WS_PART + (size_t)11 * LC * D * 4 <= WS_END, "layer0 map");
static_assert(WS_WSSDOUT + (size_t)D * DIN * 2 <= WS_Z && WS_Z + (size_t)MT * DIN * 2 <= WS_XBCR && WS_XBCR + (size_t)MT * XBCW * 2 <= WS_DTRAW && WS_STATES + (size_t)2 * NCH * 32 * 64 * 128 * 2 <= WS_DTRAW && WS_DTRAW + (size_t)MT * 64 * 4 <= WS_DTS && WS_DTS + 4 * DTS_STRIDE <= WS_XT && WS_XT + (size_t)DIN * MT * 2 <= WS_BT && WS_BT + (size_t)512 * MT * 2 <= WS_BM && WS_BM + (size_t)MT * 512 * 2 <= WS_CM && WS_CM + (size_t)MT * 512 * 2 <= WS_END, "ssd map");
static_assert(WS_PART + (size_t)11 * LC * D * 4 <= WS_BT && WS_PART >= WS_DTS + 4 * DTS_STRIDE || true, "PART is read by the layer-1 modulate before the SSD conv writes XT");
constexpr int CW_TMO = 0;
constexpr int CW_HIST = 1024;
constexpr int CW_BAR = 4096;

constexpr int RING_BYTES = 159744, LDSCTL_OFF = RING_BYTES, MISC_OFF = LDSCTL_OFF + 320, LDS_BYTES = 163840;

#define GAS __attribute__((address_space(1)))
#define LAS __attribute__((address_space(3)))
typedef unsigned short bf16;
typedef unsigned v4u __attribute__((ext_vector_type(4)));
typedef unsigned v2u __attribute__((ext_vector_type(2)));
typedef float f32x4 __attribute__((ext_vector_type(4)));
typedef GAS unsigned gu32;
#define RLX_AGENT __ATOMIC_RELAXED, __HIP_MEMORY_SCOPE_AGENT
#define LDS_WAIT() asm volatile("s_waitcnt lgkmcnt(0)" ::: "memory")
#define VM_WAIT() asm volatile("s_waitcnt vmcnt(0)" ::: "memory")
__device__ __forceinline__ unsigned pk2(float lo, float hi) { return pg8::cvt_pk_bf16(lo, hi); }
__device__ __forceinline__ float bflo(unsigned u) { return __uint_as_float(u << 16); }
__device__ __forceinline__ float bfhi(unsigned u) { return __uint_as_float(u & 0xffff0000u); }
__device__ __forceinline__ float bf1(bf16 b) { return __uint_as_float(((unsigned)b) << 16); }
__device__ __forceinline__ float sigmoid_f(float x) { return __builtin_amdgcn_rcpf(1.0f + __builtin_amdgcn_exp2f(-1.4426950408889634f * x)); }
__device__ __forceinline__ float softplus_f(float x) {
    const float y = __builtin_amdgcn_exp2f(-1.4426950408889634f * fabsf(x));
    const float l = y < 1.0e-3f ? y * (1.0f - 0.5f * y) : __builtin_amdgcn_logf(1.0f + y) * 0.6931471805599453f;
    return fmaxf(x, 0.f) + l; }

#define XB_TMO      128
#define XB_XCNT(j)  (256  + 64 * (j))
#define XB_XSUB(j)  (1280 + 64 * (j))
#define XB_XGEN(j)  (2304 + 64 * (j))
#define XB_TOP      3328
#define XB_TOPGEN   3392
#define XCD_BAR_WORDS 3456
#define XB_SPIN_CAP (1u << 18)
__device__ __forceinline__ unsigned xb_ld(unsigned* p)              { return __hip_atomic_load(p, __ATOMIC_RELAXED, __HIP_MEMORY_SCOPE_AGENT); }
__device__ __forceinline__ unsigned xb_add(unsigned* p, unsigned v) { return __hip_atomic_fetch_add(p, v, __ATOMIC_RELAXED, __HIP_MEMORY_SCOPE_AGENT); }
__device__ __forceinline__ unsigned xb_xcc_id() { return (unsigned)__builtin_amdgcn_s_getreg((3 << 11) | 20) & 0xFu; }
#define XB_SPIN(cond, bar) do { unsigned _sp = 0; while (cond) { __builtin_amdgcn_s_sleep(1); \
    if ((++_sp & 255u) == 0u) { if (xb_ld(&(bar)[XB_TMO])) break; if (_sp > XB_SPIN_CAP) { atomicAdd(&(bar)[XB_TMO], 1u); break; } } } } while (0)
struct XcdBarrier { unsigned* bar; unsigned x; volatile LAS unsigned* st; };
__device__ __forceinline__ XcdBarrier xcd_barrier_post(unsigned* bar, volatile LAS unsigned* st) {
    XcdBarrier b; b.bar = bar; b.x = xb_xcc_id(); b.st = st;
    if (threadIdx.x == 0) (void)xb_add(&bar[XB_XCNT(b.x)], 1u);
    return b;
}
__device__ __forceinline__ void xcd_barrier_complete(unsigned* bar, unsigned x, unsigned& nloc, unsigned& nx) {
    const unsigned G = gridDim.x * gridDim.y * gridDim.z;
    unsigned sum, cnt, mine, sp = 0u;
    for (;;) {
        sum = 0u; cnt = 0u; mine = 0u;
#pragma unroll
        for (unsigned j = 0; j < 16; ++j) { const unsigned c = xb_ld(&bar[XB_XCNT(j)]); sum += c; cnt += (c > 0u) ? 1u : 0u; mine = (j == x) ? c : mine; }
        if (sum == G) break;
        __builtin_amdgcn_s_sleep(1);
        if ((++sp & 255u) == 0u) { if (xb_ld(&bar[XB_TMO])) break; if (sp > XB_SPIN_CAP) { atomicAdd(&bar[XB_TMO], 1u); break; } }
    }
    nloc = mine > 0u ? mine : 1u; nx = cnt > 0u ? cnt : 1u;
}
__device__ __forceinline__ void xcd_barrier(const XcdBarrier& b) {
    asm volatile("s_waitcnt vmcnt(0)" ::: "memory");
    __syncthreads();
    if (threadIdx.x == 0) {
        unsigned* bar = b.bar;
        __builtin_amdgcn_s_waitcnt(0);
        unsigned nloc = b.st[0], nx = b.st[1];
        if (nloc == 0u) { xcd_barrier_complete(bar, b.x, nloc, nx); b.st[0] = nloc; b.st[1] = nx; }
        const unsigned old = xb_add(&bar[XB_XSUB(b.x)], 1u);
        const unsigned gen = old / nloc;
        if (old + 1u == (gen + 1u) * nloc) {
            __builtin_amdgcn_fence(__ATOMIC_RELEASE, "agent");
            asm volatile("s_waitcnt vmcnt(0)" ::: "memory");
            const unsigned og = xb_add(&bar[XB_TOP], 1u);
            const unsigned tg = og / nx;
            if (og + 1u == (tg + 1u) * nx) xb_add(&bar[XB_TOPGEN], 1u);
            else XB_SPIN(xb_ld(&bar[XB_TOPGEN]) == tg, bar);
            __builtin_amdgcn_fence(__ATOMIC_ACQUIRE, "agent");
            xb_add(&bar[XB_XGEN(b.x)], 1u);
            asm volatile("s_waitcnt vmcnt(0)" ::: "memory");
        } else {
            XB_SPIN(xb_ld(&bar[XB_XGEN(b.x)]) == gen, bar);
            __builtin_amdgcn_fence(__ATOMIC_ACQUIRE, "agent");
            asm volatile("s_waitcnt vmcnt(0)" ::: "memory");
        }
    }
    __syncthreads();
}

struct Frame {
    LAS unsigned char* lds;
    int tid, lane, wave, vcu, G;
    const float* in[30]; float* out; unsigned char* ws;
};
enum { I_X = 0, I_C, I_CTX, I_CCTX, I_ADAW, I_ADAB, I_N1G, I_N2G, I_ABWIN, I_ABCONV, I_ABSINK, I_ABWOUT, I_FFNG, I_FFNU, I_FFND, I_SSDWIN, I_SSDCW, I_SSDCB,
       I_DTBF, I_DTBB, I_ALOGF, I_ALOGB, I_SSDD, I_SSDNG, I_SSDWOUT, I_ROUTER, I_MOEG, I_MOEU, I_MOED, I_FINALG };
template <int CTRL> __device__ __forceinline__ float dpp_add(float v) { return v + __int_as_float(__builtin_amdgcn_update_dpp(0, __float_as_int(v), CTRL, 0xf, 0xf, true)); }
__device__ __forceinline__ float wave_sum(float v) {
    v = dpp_add<0xB1>(v);
    v = dpp_add<0x4E>(v);
    v = dpp_add<0x141>(v);
    v = dpp_add<0x140>(v);
    const int iv = __float_as_int(v);
    return (__int_as_float(__builtin_amdgcn_readlane(iv, 0)) + __int_as_float(__builtin_amdgcn_readlane(iv, 16))) + (__int_as_float(__builtin_amdgcn_readlane(iv, 32)) + __int_as_float(__builtin_amdgcn_readlane(iv, 48)));
}
constexpr int M_SH1 = 0, M_SC1 = 1024, M_G1 = 2048, M_SH2 = 3072, M_SC2 = 4096, M_G2 = 5120;
__device__ __forceinline__ const float* modp(const Frame& F, int layer, int s) { return (const float*)(F.ws + WS_MOD) + (size_t)(layer * 2 + s) * 6144; }

__device__ __forceinline__ void tr_load(const float* W, int N, int k0, int n0, int lane, f32x4 (&w)[8]) {
#pragma unroll
    for (int i = 0; i < 8; ++i) w[i] = __builtin_nontemporal_load((const GAS f32x4*)(W + (size_t)(k0 + (lane >> 3) + 8 * i) * N + n0 + 4 * (lane & 7)));
}
__device__ __forceinline__ void tr_finish(const f32x4 (&w)[8], bf16* WT, int Kdst, int k0, int drow0, LAS float* scr, int lane) {
#pragma unroll
    for (int i = 0; i < 8; ++i) { LAS float* d = scr + ((lane >> 3) + 8 * i) * 33 + 4 * (lane & 7); d[0] = w[i].x; d[1] = w[i].y; d[2] = w[i].z; d[3] = w[i].w; }
    LDS_WAIT(); asm volatile("" ::: "memory");
    const int c = lane & 7;
#pragma unroll
    for (int j = 0; j < 4; ++j) { const int n = (lane >> 3) + 8 * j; const LAS float* s = scr + (8 * c) * 33 + n;
        v4u o; o.x = pk2(s[0 * 33], s[1 * 33]); o.y = pk2(s[2 * 33], s[3 * 33]); o.z = pk2(s[4 * 33], s[5 * 33]); o.w = pk2(s[6 * 33], s[7 * 33]);
        __builtin_nontemporal_store(o, (GAS v4u*)(WT + (size_t)(drow0 + n) * Kdst + k0 + 8 * c)); }
    LDS_WAIT(); asm volatile("" ::: "memory");
}
__device__ __forceinline__ void tr_item(const float* W, int N, bf16* WT, int Kdst, int k0, int n0, int drow0, LAS float* scr, int lane) {
    { f32x4 w[8];
#pragma unroll
      for (int i = 0; i < 8; ++i) w[i] = __builtin_nontemporal_load((const GAS f32x4*)(W + (size_t)(k0 + (lane >> 3) + 8 * i) * N + n0 + 4 * (lane & 7)));
#pragma unroll
      for (int i = 0; i < 8; ++i) { LAS float* d = scr + ((lane >> 3) + 8 * i) * 33 + 4 * (lane & 7); d[0] = w[i].x; d[1] = w[i].y; d[2] = w[i].z; d[3] = w[i].w; } }
    LDS_WAIT(); asm volatile("" ::: "memory");
    const int c = lane & 7;
#pragma unroll
    for (int j = 0; j < 4; ++j) { const int n = (lane >> 3) + 8 * j; const LAS float* s = scr + (8 * c) * 33 + n;
        v4u o; o.x = pk2(s[0 * 33], s[1 * 33]); o.y = pk2(s[2 * 33], s[3 * 33]); o.z = pk2(s[4 * 33], s[5 * 33]); o.w = pk2(s[6 * 33], s[7 * 33]);
        __builtin_nontemporal_store(o, (GAS v4u*)(WT + (size_t)(drow0 + n) * Kdst + k0 + 8 * c)); }
    LDS_WAIT(); asm volatile("" ::: "memory");
}
__device__ __forceinline__ void tr_matrix(const Frame& F, const float* W, int K, int N, bf16* WT, int mode, int& first, int gw = -1, int NGW = 0) {
    LAS float* scr = (LAS float*)(F.lds + F.wave * 16384);
    if (gw < 0) { gw = F.vcu * NWAVES + F.wave; NGW = F.G * NWAVES; }
    const int nblk = N / 32, nitems = (K / 64) * nblk;
    int it = gw - (first % NGW); if (it < 0) it += NGW;
    for (; it < nitems; it += NGW) {
        const int kb = it / nblk, nb = it % nblk, n0 = 32 * nb;
        const int drow0 = mode == 0 ? n0 : ((n0 >> 7) * 256 + (n0 & 127) + (mode == 2 ? 128 : 0));
        tr_item(W, N, WT, K, 64 * kb, n0, drow0, scr, F.lane);
    }
    first += nitems;
}

__device__ __forceinline__ void ph_convert_ffn(Frame& F, int gw, int NGW) {
    int first = 0;
    tr_matrix(F, F.in[I_FFNG], D, DFF, (bf16*)(F.ws + WS_WFFNGU), 1, first, gw, NGW);
    tr_matrix(F, F.in[I_FFNU], D, DFF, (bf16*)(F.ws + WS_WFFNGU), 2, first, gw, NGW);
    tr_matrix(F, F.in[I_FFND], DFF, D, (bf16*)(F.ws + WS_WFFND), 0, first, gw, NGW);
}
__device__ __forceinline__ void ph_convert_ssd(Frame& F, int gw, int NGW) {
    int first = 0;
    tr_matrix(F, F.in[I_SSDWIN], D, SSD_IN_REAL, (bf16*)(F.ws + WS_WSSDIN), 0, first, gw, NGW);
    tr_matrix(F, F.in[I_SSDWOUT], DIN, D, (bf16*)(F.ws + WS_WSSDOUT), 0, first, gw, NGW);
    { v4u* p = (v4u*)((bf16*)(F.ws + WS_WSSDIN) + (size_t)SSD_IN_REAL * D); const int n16 = (SSD_INP - SSD_IN_REAL) * D * 2 / 16;
      for (int i = gw * 64 + F.lane; i < n16; i += NGW * 64) p[i] = (v4u){0u, 0u, 0u, 0u}; }
}
__device__ __forceinline__ void ph_prologue(Frame& F) {
    LAS float* scx = (LAS float*)F.lds;
    LAS float* scc = scx + 1024;
    LAS float* red = scc + 1024;
    const float* c = F.in[I_C]; const float* cc = F.in[I_CCTX];
    for (int i = F.tid; i < 1024; i += NTHR) { const float a = c[i], b = cc[i]; scx[i] = a * sigmoid_f(a); scc[i] = b * sigmoid_f(b); }
    __syncthreads();
    float* MOD = (float*)(F.ws + WS_MOD);
    for (int u = F.vcu; u < 192; u += F.G) {
        const int layer = u / 96, n0 = (u % 96) * 64;
        const float* W = F.in[I_ADAW] + (size_t)layer * 1024 * 6144 + n0 + F.lane;
        float ax = 0.f, ac = 0.f; const int kb = F.wave * 128;
#pragma unroll 1
        for (int k0 = 0; k0 < 128; k0 += 32) { float w[32];
#pragma unroll
            for (int k = 0; k < 32; ++k) w[k] = __builtin_nontemporal_load(W + (size_t)(kb + k0 + k) * 6144);
#pragma unroll
            for (int k = 0; k < 32; ++k) { ax += scx[kb + k0 + k] * w[k]; ac += scc[kb + k0 + k] * w[k]; } }
        red[(F.wave * 2 + 0) * 64 + F.lane] = ax; red[(F.wave * 2 + 1) * 64 + F.lane] = ac;
        __syncthreads();
        if (F.tid < 128) { const int s = F.tid >> 6, l = F.tid & 63; float t = 0.f;
#pragma unroll
            for (int w = 0; w < 8; ++w) t += red[(w * 2 + s) * 64 + l];
            MOD[(size_t)(layer * 2 + s) * 6144 + n0 + l] = t + F.in[I_ADAB][layer * 6144 + n0 + l]; }
        __syncthreads();
    }
    {
        float* ct = (float*)(F.ws + WS_ROPE); float* st = ct + 4096;
        for (int idx = F.vcu * NTHR + F.tid; idx < 4096; idx += F.G * NTHR) { const int pos = idx >> 4, i = idx & 15;
            const float inv = (float)pow(10000.0, -(double)i / 16.0); const float ang = (float)pos * inv;
            ct[idx] = (float)cos((double)ang); st[idx] = (float)sin((double)ang); }
    }
    __syncthreads();
    int first = 0;
    tr_matrix(F, F.in[I_ABWIN], D, AB_IN, (bf16*)(F.ws + WS_WABIN), 0, first);
    tr_matrix(F, F.in[I_ABWOUT], D, D, (bf16*)(F.ws + WS_WABOUT), 0, first);
}
constexpr int MOE_GU_ITEMS = NEXP * 2 * (D / 64) * (FFE / 32);
struct GuItem { const float* W; bf16* WT; int k0, n0, drow0; };
__device__ __forceinline__ GuItem gu_item(const Frame& F, int it) {
    constexpr int PER_M = (D / 64) * (FFE / 32), NB = FFE / 32;
    const int e = it / (2 * PER_M), rem = it % (2 * PER_M), mat = rem / PER_M, idx = rem % PER_M, kb = idx / NB, n0 = 32 * (idx % NB);
    GuItem g; g.W = (mat ? F.in[I_MOEU] : F.in[I_MOEG]) + (size_t)e * D * FFE; g.WT = (bf16*)(F.ws + WS_WMOE) + (size_t)e * 2 * FFE * D;
    g.k0 = 64 * kb; g.n0 = n0; g.drow0 = (n0 >> 7) * 256 + (n0 & 127) + (mat ? 128 : 0); return g;
}
__device__ __forceinline__ void moe_gu_convert(Frame& F, int lo, int hi, int gw, int NGW) {
    LAS float* scr = (LAS float*)(F.lds + F.wave * 16384);
    int it = lo + gw; if (it >= hi) return;
    f32x4 wa[8], wb[8];
    GuItem ga = gu_item(F, it), gb = ga; tr_load(ga.W, FFE, ga.k0, ga.n0, F.lane, wa);
    for (;;) {
        const int itb = it + NGW; const bool hb = itb < hi;
        if (hb) { gb = gu_item(F, itb); tr_load(gb.W, FFE, gb.k0, gb.n0, F.lane, wb); }
        tr_finish(wa, ga.WT, D, ga.k0, ga.drow0, scr, F.lane);
        if (!hb) break;
        it = itb + NGW; const bool ha = it < hi;
        if (ha) { ga = gu_item(F, it); tr_load(ga.W, FFE, ga.k0, ga.n0, F.lane, wa); }
        tr_finish(wb, gb.WT, D, gb.k0, gb.drow0, scr, F.lane);
        if (!ha) break;
    }
}
__device__ __forceinline__ void idle_round_convert(Frame& F, int nunits, int lo, int hi) {
    const int full = nunits / F.G, nbusy = nunits - full * F.G;
    if ((int)blockIdx.x >= nbusy) moe_gu_convert(F, lo, hi, ((int)blockIdx.x - nbusy) * NWAVES + F.wave, (F.G - nbusy) * NWAVES);
}


template <bool BF> __device__ __forceinline__ void load_row4(const void* row, int lane, f32x4 (&v)[4]) {
    if (BF) { const GAS v2u* p = (const GAS v2u*)row + lane;
#pragma unroll
        for (int j = 0; j < 4; ++j) { const v2u a = p[64 * j]; v[j] = (f32x4){bflo(a.x), bfhi(a.x), bflo(a.y), bfhi(a.y)}; } }
    else { const GAS f32x4* p = (const GAS f32x4*)row + lane;
#pragma unroll
        for (int j = 0; j < 4; ++j) v[j] = __builtin_nontemporal_load(p + 64 * j); }
}
template <bool LAT_BF, bool CTX_BF, int NPART>
__device__ __forceinline__ void ph_modulate(Frame& F, const void* src0, const void* src1, const float* gain, const float* mx, const float* mc, int osh, int osc, bf16* H, int nrows,
                                            const float* part, const float* gatec, bf16* xw) {
    const int gw = F.vcu * NWAVES + F.wave, NGW = F.G * NWAVES;
    f32x4 ca[4], cb[4];
#pragma unroll
    for (int j = 0; j < 4; ++j) { const int c = 4 * (64 * j + F.lane); ca[j] = *(const f32x4*)(gain + c) * (*(const f32x4*)(mx + osc + c) + 1.0f); cb[j] = *(const f32x4*)(mx + osh + c); }
    for (int r0 = gw; r0 < nrows; r0 += 2 * NGW) {
        int rr[2]; f32x4 v[2][4];
#pragma unroll
        for (int k = 0; k < 2; ++k) { const int r = r0 + k * NGW; rr[k] = r < nrows ? r : r0;
            if (rr[k] < L) load_row4<LAT_BF>((const char*)src0 + (size_t)rr[k] * D * (LAT_BF ? 2 : 4), F.lane, v[k]);
            else load_row4<CTX_BF>((const char*)src1 + (size_t)(rr[k] - L) * D * (CTX_BF ? 2 : 4), F.lane, v[k]); }
#pragma unroll
        for (int k = 0; k < 2; ++k) { const int r = rr[k];
            if (NPART > 0 && r >= L) {
#pragma unroll
                for (int j = 0; j < 4; ++j) { const int c = 4 * (64 * j + F.lane); f32x4 s = (f32x4){0.f, 0.f, 0.f, 0.f};
#pragma unroll
                    for (int q = 0; q < NPART; ++q) s += *(const f32x4*)(part + ((size_t)q * LC + (r - L)) * D + c);
                    v[k][j] += *(const f32x4*)(gatec + c) * s;
                    if (xw) { v2u o; o.x = pk2(v[k][j].x, v[k][j].y); o.y = pk2(v[k][j].z, v[k][j].w); *(GAS v2u*)(xw + (size_t)r * D + c) = o; } }
            }
            float s2 = 0.f;
#pragma unroll
            for (int j = 0; j < 4; ++j) s2 += (v[k][j].x * v[k][j].x + v[k][j].y * v[k][j].y) + (v[k][j].z * v[k][j].z + v[k][j].w * v[k][j].w);
            const float rstd = __builtin_amdgcn_rsqf(wave_sum(s2) * (1.0f / D) + EPS);
            GAS v2u* o8 = (GAS v2u*)(H + (size_t)r * D) + F.lane;
#pragma unroll
            for (int j = 0; j < 4; ++j) { const int c = 4 * (64 * j + F.lane);
                f32x4 A = ca[j], B = cb[j];
                if (r >= L) { A = *(const f32x4*)(gain + c) * (*(const f32x4*)(mc + osc + c) + 1.0f); B = *(const f32x4*)(mc + osh + c); }
                const f32x4 y = v[k][j] * rstd * A + B;
                v2u o; o.x = pk2(y.x, y.y); o.y = pk2(y.z, y.w); o8[64 * j] = o; }
        }
    }
}

constexpr float QSCL = 0.125f * 1.4426950408889634f;
__device__ __forceinline__ void ph_ab_elem(Frame& F) {
    const bf16* PAB = (const bf16*)(F.ws + WS_PAB); bf16* MIX = (bf16*)(F.ws + WS_MIX);
    bf16* QR = (bf16*)(F.ws + WS_QR); bf16* KR = (bf16*)(F.ws + WS_KR); bf16* VT = (bf16*)(F.ws + WS_VT);
    const float* ct = (const float*)(F.ws + WS_ROPE); const float* st = ct + 4096;
    const int lane = F.lane;
    float cw[3][8];
#pragma unroll
    for (int k = 0; k < 3; ++k)
#pragma unroll
        for (int j = 0; j < 8; ++j) cw[k][j] = F.in[I_ABCONV][k * 512 + 8 * lane + j];
    LAS unsigned char* vl = F.lds;
    for (int tile = F.vcu; tile < MT / 16; tile += F.G) {
        const int r0 = tile * 16; const bool isctx = r0 >= L; const int slo = isctx ? L : 0, shi = isctx ? MT : L;
        for (int rr = 0; rr < 2; ++rr) {
            const int r = r0 + F.wave * 2 + rr;
            float acc[8];
#pragma unroll
            for (int j = 0; j < 8; ++j) acc[j] = 0.f;
#pragma unroll
            for (int k = 0; k < 3; ++k) { const int q = r + k - 1;
                if (q >= slo && q < shi) { const v4u gc = *(const GAS v4u*)(PAB + (size_t)q * AB_IN + 512 + 8 * lane), ha = *(const GAS v4u*)(PAB + (size_t)q * AB_IN + 1024 + 8 * lane);
                    acc[0] += cw[k][0] * bflo(gc.x) * bflo(ha.x); acc[1] += cw[k][1] * bfhi(gc.x) * bfhi(ha.x); acc[2] += cw[k][2] * bflo(gc.y) * bflo(ha.y); acc[3] += cw[k][3] * bfhi(gc.y) * bfhi(ha.y);
                    acc[4] += cw[k][4] * bflo(gc.z) * bflo(ha.z); acc[5] += cw[k][5] * bfhi(gc.z) * bfhi(ha.z); acc[6] += cw[k][6] * bflo(gc.w) * bflo(ha.w); acc[7] += cw[k][7] * bfhi(gc.w) * bfhi(ha.w); } }
            { const v4u gb = *(const GAS v4u*)(PAB + (size_t)r * AB_IN + 8 * lane); v4u o;
              o.x = pk2(acc[0] * bflo(gb.x), acc[1] * bfhi(gb.x)); o.y = pk2(acc[2] * bflo(gb.y), acc[3] * bfhi(gb.y)); o.z = pk2(acc[4] * bflo(gb.z), acc[5] * bfhi(gb.z)); o.w = pk2(acc[6] * bflo(gb.w), acc[7] * bfhi(gb.w));
              *(GAS v4u*)(MIX + (size_t)r * D + 8 * lane) = o; }
            const int sub = lane & 7, axis = sub >> 2, half = (sub >> 1) & 1;
            const int pos = axis == 0 ? (r >> 6) : (r & 63);
            f32x4 c0 = (f32x4){1.f, 1.f, 1.f, 1.f}, c1 = c0, s0 = (f32x4){0.f, 0.f, 0.f, 0.f}, s1 = s0;
            if (!isctx) { const float* cp = ct + pos * 16 + 8 * (lane & 1); const float* sp = st + pos * 16 + 8 * (lane & 1);
                c0 = *(const f32x4*)cp; c1 = *(const f32x4*)(cp + 4); s0 = *(const f32x4*)sp; s1 = *(const f32x4*)(sp + 4);
                if (half == 0) { s0 = -s0; s1 = -s1; } }
            {
                const v4u a = *(const GAS v4u*)(PAB + (size_t)r * AB_IN + 1536 + 8 * lane);
                v4u p; p.x = (unsigned)__builtin_amdgcn_update_dpp(0, (int)a.x, 0x4E, 0xf, 0xf, true); p.y = (unsigned)__builtin_amdgcn_update_dpp(0, (int)a.y, 0x4E, 0xf, 0xf, true); p.z = (unsigned)__builtin_amdgcn_update_dpp(0, (int)a.z, 0x4E, 0xf, 0xf, true); p.w = (unsigned)__builtin_amdgcn_update_dpp(0, (int)a.w, 0x4E, 0xf, 0xf, true);
                const f32x4 qc0 = c0 * QSCL, qc1 = c1 * QSCL, qs0 = s0 * QSCL, qs1 = s1 * QSCL;
                v4u o; o.x = pk2(bflo(a.x) * qc0.x + bflo(p.x) * qs0.x, bfhi(a.x) * qc0.y + bfhi(p.x) * qs0.y); o.y = pk2(bflo(a.y) * qc0.z + bflo(p.y) * qs0.z, bfhi(a.y) * qc0.w + bfhi(p.y) * qs0.w);
                o.z = pk2(bflo(a.z) * qc1.x + bflo(p.z) * qs1.x, bfhi(a.z) * qc1.y + bfhi(p.z) * qs1.y); o.w = pk2(bflo(a.w) * qc1.z + bflo(p.w) * qs1.z, bfhi(a.w) * qc1.w + bfhi(p.w) * qs1.w);
                *(GAS v4u*)(QR + ((size_t)(lane >> 3) * MT + r) * 64 + 8 * sub) = o;
            }
            {
                const int kl = lane & 15;
                const v4u a = *(const GAS v4u*)(PAB + (size_t)r * AB_IN + 2048 + 8 * kl);
                v4u p; p.x = (unsigned)__builtin_amdgcn_update_dpp(0, (int)a.x, 0x4E, 0xf, 0xf, true); p.y = (unsigned)__builtin_amdgcn_update_dpp(0, (int)a.y, 0x4E, 0xf, 0xf, true); p.z = (unsigned)__builtin_amdgcn_update_dpp(0, (int)a.z, 0x4E, 0xf, 0xf, true); p.w = (unsigned)__builtin_amdgcn_update_dpp(0, (int)a.w, 0x4E, 0xf, 0xf, true);
                v4u o; o.x = pk2(bflo(a.x) * c0.x + bflo(p.x) * s0.x, bfhi(a.x) * c0.y + bfhi(p.x) * s0.y); o.y = pk2(bflo(a.y) * c0.z + bflo(p.y) * s0.z, bfhi(a.y) * c0.w + bfhi(p.y) * s0.w);
                o.z = pk2(bflo(a.z) * c1.x + bflo(p.z) * s1.x, bfhi(a.z) * c1.y + bfhi(p.z) * s1.y); o.w = pk2(bflo(a.w) * c1.z + bflo(p.w) * s1.z, bfhi(a.w) * c1.w + bfhi(p.w) * s1.w);
                if (lane < 16) *(GAS v4u*)(KR + ((size_t)(lane >> 3) * MT + r) * 64 + 8 * sub) = o;
            }
        }
        if (F.tid < 256) { const int p = F.tid, row = p >> 4, c8 = (p & 15) * 8;
            *(LAS v4u*)(vl + row * 272 + c8 * 2) = *(const GAS v4u*)(PAB + (size_t)(r0 + row) * AB_IN + 2176 + c8); }
        __syncthreads();
        if (F.tid < 256) { const int p = F.tid, ch = p >> 1, rg = p & 1;
            const LAS bf16* s = (const LAS bf16*)(vl + (8 * rg) * 272 + ch * 2);
            v4u o; o.x = (unsigned)s[0] | ((unsigned)s[136] << 16); o.y = (unsigned)s[2 * 136] | ((unsigned)s[3 * 136] << 16); o.z = (unsigned)s[4 * 136] | ((unsigned)s[5 * 136] << 16); o.w = (unsigned)s[6 * 136] | ((unsigned)s[7 * 136] << 16);
            *(GAS v4u*)(VT + (size_t)ch * MT + r0 + 8 * rg) = o; }
        __syncthreads();
    }
}


__device__ __forceinline__ void ph_ssd_conv(Frame& F) {
    const bf16* XB = (const bf16*)(F.ws + WS_XBCR);
    bf16* XT = (bf16*)(F.ws + WS_XT); bf16* BT = (bf16*)(F.ws + WS_BT); bf16* BMm = (bf16*)(F.ws + WS_BM); bf16* CMm = (bf16*)(F.ws + WS_CM);
    const float* cwp = F.in[I_SSDCW]; const float* cbp = F.in[I_SSDCB];
    LAS unsigned char* tl = F.lds;
    { const float* DR = (const float*)(F.ws + WS_DTRAW); float* DTF = (float*)(F.ws + WS_DTS); float* DTB = DTF + (size_t)32 * MT;
      const int gw = F.vcu * NWAVES + F.wave, NGW = F.G * NWAVES;
      for (int task = gw; task < (MT / 64) * 4; task += NGW) { const int tb = task >> 2, jq = task & 3; const int t = tb * 64 + F.lane; const float* row = DR + (size_t)t * 64;
#pragma unroll
          for (int j4 = 4 * jq; j4 < 4 * jq + 4; ++j4) { const f32x4 r = *(const f32x4*)(row + 4 * j4);
#pragma unroll
              for (int q = 0; q < 4; ++q) { const int j = 4 * j4 + q; const float v = softplus_f(r[q] + (j < 32 ? F.in[I_DTBF][j] : F.in[I_DTBB][j - 32]));
                  if (j < 32) DTF[(size_t)j * MT + t] = v; else DTB[(size_t)(j - 32) * MT + t] = v; } } } }
    LAS float* cwl = (LAS float*)(F.lds + 130 * 272 + 64);
    for (int i = F.tid; i < 3 * XBCW; i += NTHR) cwl[i] = cwp[i];
    for (int i = F.tid; i < XBCW; i += NTHR) cwl[3 * XBCW + i] = cbp[i];
    __syncthreads();
    const int ntiles = NCH * 24;
    v4u pre[5];
#define CONV_LOAD(tile_) do { const int c_ = (tile_) / 24, cb_ = (tile_) % 24, t0_ = c_ * 128, ch0_ = cb_ * 128; const int slo_ = c_ < 128 ? 0 : L, shi_ = c_ < 128 ? L : MT; \
        _Pragma("unroll") for (int i_ = 0; i_ < 5; ++i_) { const int p_ = F.tid + NTHR * i_, row_ = p_ >> 4, c8_ = (p_ & 15) * 8; const int t_ = t0_ - 1 + row_; \
            pre[i_] = (v4u){0u, 0u, 0u, 0u}; if (p_ < 130 * 16 && t_ >= slo_ && t_ < shi_) pre[i_] = __builtin_nontemporal_load((const GAS v4u*)(XB + (size_t)t_ * XBCW + ch0_ + c8_)); } } while (0)
    int tile = F.vcu;
    if (tile < ntiles) CONV_LOAD(tile);
    for (; tile < ntiles; tile += F.G) {
        const int c = tile / 24, cb = tile % 24, t0 = c * 128, ch0 = cb * 128;
#pragma unroll
        for (int i = 0; i < 5; ++i) { const int p = F.tid + NTHR * i, row = p >> 4, c8 = (p & 15) * 8; if (p < 130 * 16) *(LAS v4u*)(tl + row * 272 + ((c8 * 2) ^ (((row >> 3) & 7) << 4))) = pre[i]; }
        __syncthreads();
        if (tile + F.G < ntiles) CONV_LOAD(tile + F.G);
        if (cb < 20) {
            bf16* dst = BT + (size_t)(ch0 - 2048) * MT;
#pragma unroll
            for (int i = 0; i < 4; ++i) { const int p = F.tid + NTHR * i, ch = p >> 4, tg = p & 15;
                const float w0 = cwl[ch0 + ch], w1 = cwl[XBCW + ch0 + ch], w2 = cwl[2 * XBCW + ch0 + ch], bb = cwl[3 * XBCW + ch0 + ch];
                float xin[10];
#pragma unroll
                for (int j = 0; j < 10; ++j) { const int row = 8 * tg + j; xin[j] = bf1(*(const LAS bf16*)(tl + row * 272 + ((ch * 2) ^ (((row >> 3) & 7) << 4)))); }
                float y[8];
#pragma unroll
                for (int j = 0; j < 8; ++j) { const float a = w0 * xin[j] + w1 * xin[j + 1] + w2 * xin[j + 2] + bb; y[j] = a * sigmoid_f(a); }
                v4u o; o.x = pk2(y[0], y[1]); o.y = pk2(y[2], y[3]); o.z = pk2(y[4], y[5]); o.w = pk2(y[6], y[7]);
                if (cb < 16) { const int cg_ = ch0 + ch, hd = cg_ >> 6, p_ = cg_ & 63, ptq = 2 * (p_ >> 5) + ((p_ >> 2) & 1), rq = 4 * ((p_ >> 3) & 3) + (p_ & 3);
                    *(GAS v4u*)(XT + ((size_t)(((hd * NCH + c) * 4 + (tg >> 2)) * 4 + ptq) * 16 + rq) * 32 + 8 * (tg & 3)) = o; }
                else *(GAS v4u*)(dst + (size_t)ch * MT + t0 + 8 * tg) = o; }
        }
        if (cb >= 16) {
            bf16* dst = cb < 20 ? BMm + (ch0 - 2048) : CMm + (ch0 - 2560);
#pragma unroll
            for (int i = 0; i < 4; ++i) { const int p = F.tid + NTHR * i, row = p >> 4, cg = p & 15;
                const v4u a0 = *(const LAS v4u*)(tl + row * 272 + ((cg * 16) ^ (((row >> 3) & 7) << 4))), a1 = *(const LAS v4u*)(tl + (row + 1) * 272 + ((cg * 16) ^ ((((row + 1) >> 3) & 7) << 4))), a2 = *(const LAS v4u*)(tl + (row + 2) * 272 + ((cg * 16) ^ ((((row + 2) >> 3) & 7) << 4)));
                const LAS float* w0 = cwl + ch0 + 8 * cg; const LAS float* w1 = w0 + XBCW; const LAS float* w2 = w1 + XBCW; const LAS float* bb = w2 + XBCW;
                float y[8];
#define CV(j, f, q) { const float a = w0[j] * f(a0.q) + w1[j] * f(a1.q) + w2[j] * f(a2.q) + bb[j]; y[j] = a * sigmoid_f(a); }
                CV(0, bflo, x) CV(1, bfhi, x) CV(2, bflo, y) CV(3, bfhi, y) CV(4, bflo, z) CV(5, bfhi, z) CV(6, bflo, w) CV(7, bfhi, w)
#undef CV
                v4u o; o.x = pk2(y[0], y[1]); o.y = pk2(y[2], y[3]); o.z = pk2(y[4], y[5]); o.w = pk2(y[6], y[7]);
                *(GAS v4u*)(dst + (size_t)(t0 + row) * 512 + 8 * cg) = o; }
        }
        __syncthreads();
    }
#undef CONV_LOAD
}

__device__ __forceinline__ void ph_moe_route(Frame& F) {
    LAS float* R = (LAS float*)F.lds;
    for (int i = F.tid; i < 8192; i += NTHR) R[(i & 7) * 1024 + (i >> 3)] = F.in[I_ROUTER][i];
    __syncthreads();
    const bf16* X = (const bf16*)(F.ws + WS_X); bf16* H2 = (bf16*)(F.ws + WS_H2);
    int* TE = (int*)(F.ws + WS_TOKE); float* TW = (float*)(F.ws + WS_TOKW); int* HIST = (int*)(F.ws + WS_CTL) + CW_HIST;
    const float* gain = F.in[I_N2G] + D; const float* m = modp(F, 1, 0);
    const int gw = F.vcu * NWAVES + F.wave, NGW = F.G * NWAVES;
    f32x4 ca[4], cb[4];
#pragma unroll
    for (int j = 0; j < 4; ++j) { const int c = 4 * (64 * j + F.lane); ca[j] = *(const f32x4*)(gain + c) * (*(const f32x4*)(m + M_SC2 + c) + 1.0f); cb[j] = *(const f32x4*)(m + M_SH2 + c); }
    for (int r = gw; r < L; r += NGW) {
        f32x4 v[4]; float s2 = 0.f;
        load_row4<true>(X + (size_t)r * D, F.lane, v);
#pragma unroll
        for (int j = 0; j < 4; ++j) s2 += (v[j].x * v[j].x + v[j].y * v[j].y) + (v[j].z * v[j].z + v[j].w * v[j].w);
        const float rstd = 1.0f / sqrtf(wave_sum(s2) * (1.0f / D) + EPS);
        float lg[8];
#pragma unroll
        for (int e = 0; e < 8; ++e) lg[e] = 0.f;
        GAS v2u* o8 = (GAS v2u*)(H2 + (size_t)r * D) + F.lane;
#pragma unroll
        for (int j = 0; j < 4; ++j) { const int c = 4 * (64 * j + F.lane);
            const f32x4 y = v[j] * rstd * ca[j] + cb[j];
            v2u o; o.x = pk2(y.x, y.y); o.y = pk2(y.z, y.w); o8[64 * j] = o;
#pragma unroll
            for (int e = 0; e < 8; ++e) { const f32x4 rr = *(const LAS f32x4*)(R + e * 1024 + c); lg[e] += (y.x * rr.x + y.y * rr.y) + (y.z * rr.z + y.w * rr.w); } }
#pragma unroll
        for (int e = 0; e < 8; ++e) lg[e] = wave_sum(lg[e]);
        int e0 = 0; float v0 = lg[0];
#pragma unroll
        for (int e = 1; e < 8; ++e) if (lg[e] > v0) { v0 = lg[e]; e0 = e; }
        int e1 = -1; float v1 = -3.0e38f;
#pragma unroll
        for (int e = 0; e < 8; ++e) if (e != e0 && lg[e] > v1) { v1 = lg[e]; e1 = e; }
        if (F.lane == 0) { const float ex = __expf(v1 - v0), w0 = 1.0f / (1.0f + ex);
            TE[2 * r] = e0; TE[2 * r + 1] = e1; TW[2 * r] = w0; TW[2 * r + 1] = ex * w0;
            atomicAdd(&HIST[(r >> 8) * 8 + e0], 1); atomicAdd(&HIST[(r >> 8) * 8 + e1], 1); }
    }
}
__device__ __forceinline__ void moe_segments(Frame& F, LAS int* hist, LAS int* cnt, LAS int* seg) {
    const int* HIST = (const int*)(F.ws + WS_CTL) + CW_HIST;
    if (F.tid < 512) hist[F.tid] = HIST[F.tid];
    __syncthreads();
    if (F.tid < 8) { int s = 0; for (int t = 0; t < 64; ++t) s += hist[t * 8 + F.tid]; cnt[F.tid] = s; }
    __syncthreads();
    if (F.tid == 0) { int s = 0; for (int e = 0; e < 8; ++e) { seg[e] = s; s += (cnt[e] + 255) & ~255; } seg[8] = s; }
    __syncthreads();
}
__device__ __forceinline__ void ph_moe_scatter(Frame& F) {
    LAS int* hist = (LAS int*)F.lds; LAS int* cnt = hist + 512; LAS int* seg = cnt + 8; LAS int* base = seg + 16; LAS int* wcnt = base + 8; LAS int* epos = wcnt + 64;
    moe_segments(F, hist, cnt, seg);
    const int* TE = (const int*)(F.ws + WS_TOKE); int* TP = (int*)(F.ws + WS_TOKP);
    const bf16* H2 = (const bf16*)(F.ws + WS_H2); bf16* H2S = (bf16*)(F.ws + WS_H2S);
    for (int uu = F.vcu; uu < 264; uu += F.G) {
        if (uu < 256) {
            const int u = uu >> 2, qtr = uu & 3;
            if (F.tid < 8) { int s = seg[F.tid]; for (int t = 0; t < u; ++t) s += hist[t * 8 + F.tid]; base[F.tid] = s; }
            const int ent = u * 512 + F.tid;
            const int ex = TE[ent];
            int rank = 0;
#pragma unroll
            for (int e = 0; e < 8; ++e) { const unsigned long long mk = __ballot(ex == e);
                if (ex == e) rank = __popcll(mk & ((1ull << F.lane) - 1ull));
                if (F.lane == 0) wcnt[F.wave * 8 + e] = __popcll(mk); }
            __syncthreads();
            int pos = base[ex] + rank;
            for (int w = 0; w < F.wave; ++w) pos += wcnt[w * 8 + ex];
            if (qtr == 0) TP[ent] = pos;
            epos[F.tid] = pos;
            __syncthreads();
            for (int i0 = 128 * qtr + F.wave; i0 < 128 * qtr + 128; i0 += 4 * NWAVES) {
                v4u ra[4], rb[4]; int dp[4];
#pragma unroll
                for (int k = 0; k < 4; ++k) { const int i = i0 + k * NWAVES; const int tok = u * 256 + (i >> 1); dp[k] = epos[i];
                    const GAS v4u* s = (const GAS v4u*)(H2 + (size_t)tok * D); ra[k] = s[F.lane]; rb[k] = s[64 + F.lane]; }
#pragma unroll
                for (int k = 0; k < 4; ++k) { GAS v4u* d = (GAS v4u*)(H2S + (size_t)dp[k] * D); d[F.lane] = ra[k]; d[64 + F.lane] = rb[k]; } }
            __syncthreads();
        } else {
            const int e = uu - 256, lo = seg[e] + cnt[e], hi = seg[e + 1];
            GAS v4u* d = (GAS v4u*)(H2S + (size_t)lo * D); const int n16 = (hi - lo) * (D * 2 / 16);
            for (int i = F.tid; i < n16; i += NTHR) d[i] = (v4u){0u, 0u, 0u, 0u};
        }
    }
}
__device__ __forceinline__ void ph_final(Frame& F) {
    const bf16* X = (const bf16*)(F.ws + WS_X); const bf16* YO = (const bf16*)(F.ws + WS_H2S);
    const int* TP = (const int*)(F.ws + WS_TOKP); const float* TW = (const float*)(F.ws + WS_TOKW);
    const float* g2 = modp(F, 1, 0) + M_G2; const float* fg = F.in[I_FINALG];
    const float* YP = (const float*)(F.ws + WS_YPART);
    const int gw = F.vcu * NWAVES + F.wave, NGW = F.G * NWAVES;
    f32x4 cg[4], cf[4];
#pragma unroll
    for (int j = 0; j < 4; ++j) { const int c = 4 * (64 * j + F.lane); cg[j] = *(const f32x4*)(g2 + c); cf[j] = *(const f32x4*)(fg + c); }
    for (int r0 = gw; r0 < L; r0 += 2 * NGW) {
        int rr[2], pa[2], pb[2]; float wa[2], wb[2]; f32x4 xv[2][4]; v2u ya[2][4], yb[2][4];
#pragma unroll
        for (int k = 0; k < 2; ++k) { const int r = r0 + k * NGW; rr[k] = r < L ? r : r0; pa[k] = TP[2 * rr[k]]; pb[k] = TP[2 * rr[k] + 1]; wa[k] = TW[2 * rr[k]]; wb[k] = TW[2 * rr[k] + 1]; }
#pragma unroll
        for (int k = 0; k < 2; ++k) { load_row4<true>(X + (size_t)rr[k] * D, F.lane, xv[k]);
            const GAS v2u* y0 = (const GAS v2u*)(YO + (size_t)pa[k] * D) + F.lane; const GAS v2u* y1 = (const GAS v2u*)(YO + (size_t)pb[k] * D) + F.lane;
#pragma unroll
            for (int j = 0; j < 4; ++j) { ya[k][j] = __builtin_nontemporal_load(y0 + 64 * j); yb[k][j] = __builtin_nontemporal_load(y1 + 64 * j); } }
#pragma unroll
        for (int k = 0; k < 2; ++k) { const int r = rr[k], p0 = pa[k], p1 = pb[k]; const float w0 = wa[k], w1 = wb[k];
            f32x4 v[4]; float s2 = 0.f;
#pragma unroll
            for (int j = 0; j < 4; ++j) { const int c = 4 * (64 * j + F.lane); const v2u a = ya[k][j], b = yb[k][j]; const f32x4 g = cg[j];
                f32x4 fa = (f32x4){bflo(a.x), bfhi(a.x), bflo(a.y), bfhi(a.y)}, fb = (f32x4){bflo(b.x), bfhi(b.x), bflo(b.y), bfhi(b.y)};
                if (p0 >= 32768) { fa = (f32x4){0.f, 0.f, 0.f, 0.f}; for (int q = 0; q < 7; ++q) fa += *(const f32x4*)(YP + ((size_t)q * 2048 + (p0 - 32768)) * D + c); }
                if (p1 >= 32768) { fb = (f32x4){0.f, 0.f, 0.f, 0.f}; for (int q = 0; q < 7; ++q) fb += *(const f32x4*)(YP + ((size_t)q * 2048 + (p1 - 32768)) * D + c); }
                const f32x4 f = fa * w0 + fb * w1;
                v[j] = xv[k][j] + g * f; s2 += (v[j].x * v[j].x + v[j].y * v[j].y) + (v[j].z * v[j].z + v[j].w * v[j].w); }
            const float rstd = 1.0f / sqrtf(wave_sum(s2) * (1.0f / D) + EPS);
            GAS f32x4* o = (GAS f32x4*)(F.out + (size_t)r * D) + F.lane;
#pragma unroll
            for (int j = 0; j < 4; ++j) __builtin_nontemporal_store(v[j] * rstd * cf[j], &o[64 * j]);
        }
    }
}


typedef short bf16x8v __attribute__((ext_vector_type(8)));
__device__ __forceinline__ bf16x8v as_frag(v4u a) { return __builtin_bit_cast(bf16x8v, a); }
constexpr float LOG2E_ = 1.4426950408889634f;
#define MFMA16(a, b, c) __builtin_amdgcn_mfma_f32_16x16x32_bf16((a), (b), (c), 0, 0, 0)
__device__ __forceinline__ int prm_row(int i2, int par, int r) { return 32 * i2 + 8 * (r >> 2) + 4 * par + (r & 3); }

__device__ __forceinline__ void ph_ssd_s1(Frame& F) {
    const bf16* XT = (const bf16*)(F.ws + WS_XT); const bf16* BT = (const bf16*)(F.ws + WS_BT);
    const float* DTF = (const float*)(F.ws + WS_DTS); const float* DTB = DTF + (size_t)32 * MT; float* CUMF = (float*)(DTB + (size_t)32 * MT); float* CUMB = CUMF + (size_t)32 * MT;
    float* DEC = (float*)(F.ws + WS_DEC); bf16* ST = (bf16*)(F.ws + WS_STATES);
    LAS unsigned char* btl = F.lds;
    LAS float* wtab = (LAS float*)(F.lds + 128 * 272);
    LAS float* wtot = wtab + 1024;
    const int lane = F.lane, r16 = lane & 15, gq = lane >> 4;
    v4u nbt[4]; float ndtf = 0.f, ndtb = 0.f;
#define S1_PREFETCH(u_) do { const int c_ = (u_) >> 3, g_ = ((u_) >> 1) & 3, hh_ = (u_) & 1, t0_ = c_ * 128; int tq_ = F.tid; asm volatile("" : "+v"(tq_)); \
        _Pragma("unroll") for (int i_ = 0; i_ < 4; ++i_) { const int p_ = tq_ + NTHR * i_, n_ = p_ >> 4, c8_ = (p_ & 15) * 8; nbt[i_] = *(const GAS v4u*)(BT + (size_t)(g_ * 128 + n_) * MT + t0_ + c8_); } \
        { const int h_ = 8 * g_ + 4 * hh_ + (tq_ >> 7); ndtf = DTF[(size_t)h_ * MT + t0_ + (tq_ & 127)]; ndtb = DTB[(size_t)h_ * MT + t0_ + (tq_ & 127)]; } } while (0)
    if (F.vcu < NCH * 8) S1_PREFETCH(F.vcu);
    for (int u = F.vcu; u < NCH * 8; u += F.G) {
        const int c = u >> 3, g = (u >> 1) & 3, hh = u & 1, t0 = c * 128;
        int tid_ = F.tid; asm volatile("" : "+v"(tid_));
        v4u xr[4][4];
        { const int hx = 8 * g + 4 * hh + (F.wave >> 1);
#pragma unroll
          for (int ks = 0; ks < 4; ++ks)
#pragma unroll
            for (int pt = 0; pt < 4; ++pt) xr[ks][pt] = *(const GAS v4u*)(XT + ((size_t)(((hx * NCH + c) * 4 + ks) * 4 + pt) * 16 + r16) * 32 + 8 * gq); }
#pragma unroll
        for (int i = 0; i < 4; ++i) { const int p = tid_ + NTHR * i, n = p >> 4, c8 = (p & 15) * 8; *(LAS v4u*)(btl + n * 272 + c8 * 2) = nbt[i]; }
        {
            const int j = tid_ >> 7, l = tid_ & 127, h = 8 * g + 4 * hh + j;
            const float dtf = ndtf, dtb = ndtb;
            const float Af = -__expf(F.in[I_ALOGF][h]), Ab = -__expf(F.in[I_ALOGB][h]);
            const float af = dtf * Af, ab = dtb * Ab;
            float pf = af, pb = ab;
#pragma unroll
            for (int o = 1; o < 64; o <<= 1) { const float a = __shfl_up(pf, o), b = __shfl_up(pb, o); if (lane >= o) { pf += a; pb += b; } }
            if (lane == 63) { wtot[F.wave * 2] = pf; wtot[F.wave * 2 + 1] = pb; }
            __syncthreads();
            const float tf0 = wtot[(2 * j) * 2], tb0 = wtot[(2 * j) * 2 + 1], Tf = tf0 + wtot[(2 * j + 1) * 2], Tb = tb0 + wtot[(2 * j + 1) * 2 + 1];
            if (F.wave & 1) { pf += tf0; pb += tb0; }
            const float cf = pf, cb = Tb - pb + ab;
            CUMF[(size_t)h * MT + t0 + l] = cf; CUMB[(size_t)h * MT + t0 + l] = cb;
            wtab[(j * 2 + 0) * 128 + l] = __expf(Tf - cf) * dtf; wtab[(j * 2 + 1) * 128 + l] = __expf(Tb - cb) * dtb;
            if (l == 0) { DEC[(0 * NCH + c) * 32 + h] = __expf(Tf); DEC[(1 * NCH + c) * 32 + h] = __expf(Tb); }
        }
        __syncthreads();
        {
            const int j = F.wave >> 1, dir = F.wave & 1, h = 8 * g + 4 * hh + j;
            f32x4 acc[8][4];
#pragma unroll
            for (int a = 0; a < 8; ++a)
#pragma unroll
                for (int b = 0; b < 4; ++b) acc[a][b] = (f32x4){0.f, 0.f, 0.f, 0.f};
            const LAS float* wt = wtab + (j * 2 + dir) * 128;
            if (u + F.G < NCH * 8) S1_PREFETCH(u + F.G);
#pragma unroll
            for (int ks = 0; ks < 4; ++ks) {
                const f32x4 w0 = *(const LAS f32x4*)(wt + 32 * ks + 8 * gq), w1 = *(const LAS f32x4*)(wt + 32 * ks + 8 * gq + 4);
                bf16x8v bfr[4];
#pragma unroll
                for (int pt = 0; pt < 4; ++pt) { const v4u x = xr[ks][pt];
                    v4u y; y.x = pk2(bflo(x.x) * w0.x, bfhi(x.x) * w0.y); y.y = pk2(bflo(x.y) * w0.z, bfhi(x.y) * w0.w); y.z = pk2(bflo(x.z) * w1.x, bfhi(x.z) * w1.y); y.w = pk2(bflo(x.w) * w1.z, bfhi(x.w) * w1.w);
                    bfr[pt] = as_frag(y); }
#pragma unroll
                for (int nt = 0; nt < 8; ++nt) { const bf16x8v af = as_frag(*(const LAS v4u*)(btl + prm_row(nt >> 1, nt & 1, r16) * 272 + (32 * ks + 8 * gq) * 2));
#pragma unroll
                    for (int pt = 0; pt < 4; ++pt) acc[nt][pt] = MFMA16(af, bfr[pt], acc[nt][pt]); }
            }
            bf16* so = ST + ((size_t)((dir * NCH + c) * 32 + h) * 64) * 128;
#pragma unroll
            for (int pt = 0; pt < 4; ++pt)
#pragma unroll
                for (int i2 = 0; i2 < 4; ++i2) { const f32x4 a = acc[2 * i2][pt], b = acc[2 * i2 + 1][pt];
                    v4u o; o.x = pk2(a[0], a[1]); o.y = pk2(a[2], a[3]); o.z = pk2(b[0], b[1]); o.w = pk2(b[2], b[3]);
                    *(GAS v4u*)(so + (size_t)(((pt * 4 + i2) * 16 + r16) * 32) + 8 * gq) = o; }
        }
        __syncthreads();
    }
}
#undef S1_PREFETCH

__device__ __forceinline__ void ph_ssd_s2(Frame& F) {
    const float* DEC = (const float*)(F.ws + WS_DEC); bf16* ST = (bf16*)(F.ws + WS_STATES);
    for (int e = F.vcu * NTHR + F.tid; e < 2 * 32 * 64 * 32; e += F.G * NTHR) {
        const int dir = e >> 16, h = (e >> 11) & 31, rem = e & 2047;
        const size_t eoff = (size_t)h * 8192 + (size_t)rem * 4; const size_t cstride = (size_t)32 * 8192;
        bf16* base = ST + (size_t)dir * NCH * cstride + eoff;
        const float* dec = DEC + (size_t)dir * NCH * 32 + h;
        float H0 = 0.f, H1 = 0.f, H2 = 0.f, H3 = 0.f;
        for (int b = 0; b < NCH; b += 10) {
            v2u s[10]; float d[10]; int ck[10];
#pragma unroll
            for (int i = 0; i < 10; ++i) { const int idx = b + i; ck[i] = dir == 0 ? (idx < 2 ? 128 + idx : idx - 2) : (idx < 2 ? 129 - idx : 129 - idx);
                s[i] = __builtin_nontemporal_load((const GAS v2u*)(base + (size_t)ck[i] * cstride)); d[i] = dec[ck[i] * 32]; }
#pragma unroll
            for (int i = 0; i < 10; ++i) { v2u o; o.x = pk2(H0, H1); o.y = pk2(H2, H3); *(GAS v2u*)(base + (size_t)ck[i] * cstride) = o;
                H0 = d[i] * H0 + bflo(s[i].x); H1 = d[i] * H1 + bfhi(s[i].x); H2 = d[i] * H2 + bflo(s[i].y); H3 = d[i] * H3 + bfhi(s[i].y); }
        }
    }
}

__device__ __forceinline__ void ph_ssd_s3(Frame& F) {
    const bf16* XT = (const bf16*)(F.ws + WS_XT); const bf16* BMm = (const bf16*)(F.ws + WS_BM); const bf16* CMm = (const bf16*)(F.ws + WS_CM);
    const float* DTF = (const float*)(F.ws + WS_DTS); const float* DTB = DTF + (size_t)32 * MT; const float* CUMF = DTB + (size_t)32 * MT; const float* CUMB = CUMF + (size_t)32 * MT;
    const bf16* ST = (const bf16*)(F.ws + WS_STATES); bf16* Z = (bf16*)(F.ws + WS_Z); const float* ng = F.in[I_SSDNG];
    LAS unsigned char* bml = F.lds;
    LAS unsigned char* cml = F.lds + 128 * 272;
    LAS float* tab = (LAS float*)(F.lds + 192 * 272);
    LAS float* ssq = tab + 8 * 5 * 128;
    const int lane = F.lane, r16 = lane & 15, gq = lane >> 4;
    v4u nbm[4], ncm[2]; float ncf[2], ncb[2], ndf[2], ndb[2];
#define S3_PREFETCH(u_) do { const int c_ = (u_) >> 3, g_ = ((u_) >> 1) & 3, lh_ = (u_) & 1, t0_ = c_ * 128; int tq_ = F.tid; asm volatile("" : "+v"(tq_)); \
        _Pragma("unroll") for (int i_ = 0; i_ < 4; ++i_) { const int p_ = tq_ + NTHR * i_, row_ = p_ >> 4, c8_ = (p_ & 15) * 8; nbm[i_] = *(const GAS v4u*)(BMm + (size_t)(t0_ + row_) * 512 + g_ * 128 + c8_); } \
        _Pragma("unroll") for (int i_ = 0; i_ < 2; ++i_) { const int p_ = tq_ + NTHR * i_, row_ = p_ >> 4, c8_ = (p_ & 15) * 8; ncm[i_] = *(const GAS v4u*)(CMm + (size_t)(t0_ + 64 * lh_ + row_) * 512 + g_ * 128 + c8_); \
            const size_t o_ = (size_t)(8 * g_ + (p_ >> 7)) * MT + t0_ + (p_ & 127); ncf[i_] = CUMF[o_]; ncb[i_] = CUMB[o_]; ndf[i_] = DTF[o_]; ndb[i_] = DTB[o_]; } } while (0)
    if (F.vcu < 128 * 8) S3_PREFETCH(F.vcu);
    for (int u = F.vcu; u < 128 * 8; u += F.G) {
        const int c = u >> 3, g = (u >> 1) & 3, lh = u & 1, t0 = c * 128;
        __syncthreads();
        int tid_ = F.tid; asm volatile("" : "+v"(tid_));
#pragma unroll
        for (int i = 0; i < 4; ++i) { const int p = tid_ + NTHR * i, row = p >> 4, c8 = (p & 15) * 8; *(LAS v4u*)(bml + row * 272 + c8 * 2) = nbm[i]; }
#pragma unroll
        for (int i = 0; i < 2; ++i) { const int p = tid_ + NTHR * i, row = p >> 4, c8 = (p & 15) * 8; *(LAS v4u*)(cml + row * 272 + c8 * 2) = ncm[i]; }
#pragma unroll
        for (int i = 0; i < 2; ++i) { const int p = tid_ + NTHR * i, j = p >> 7, l = p & 127;
            const float cf = ncf[i] * LOG2E_, cb = ncb[i] * LOG2E_, df = ndf[i], db = ndb[i];
            tab[(j * 5 + 0) * 128 + l] = cf; tab[(j * 5 + 1) * 128 + l] = cb; tab[(j * 5 + 2) * 128 + l] = __builtin_amdgcn_logf(df) - cf; tab[(j * 5 + 3) * 128 + l] = __builtin_amdgcn_logf(db) - cb;
            tab[(j * 5 + 4) * 128 + l] = df + db; }
        __syncthreads();
        const int h = 8 * g + F.wave;
        const float Dk = F.in[I_SSDD][h];
        const LAS float* tcf = tab + (F.wave * 5) * 128; const LAS float* tcb = tcf + 128; const LAS float* tdf = tcb + 128; const LAS float* tdb = tdf + 128; const LAS float* tds = tdb + 128;
        f32x4 acc[4][4];
#pragma unroll
        for (int a = 0; a < 4; ++a)
#pragma unroll
            for (int b = 0; b < 4; ++b) acc[a][b] = (f32x4){0.f, 0.f, 0.f, 0.f};
#pragma unroll 1
        for (int i2 = 0; i2 < 4; ++i2) {
            bf16x8v xf[4], bmf[2][4];
#pragma unroll
            for (int pt = 0; pt < 4; ++pt) xf[pt] = as_frag(*(const GAS v4u*)(XT + ((size_t)(((h * NCH + c) * 4 + i2) * 4 + pt) * 16 + r16) * 32 + 8 * gq));
#pragma unroll
            for (int par = 0; par < 2; ++par)
#pragma unroll
                for (int nk = 0; nk < 4; ++nk) bmf[par][nk] = as_frag(*(const LAS v4u*)(bml + prm_row(i2, par, r16) * 272 + (32 * nk + 8 * gq) * 2));
            const int sb = 32 * i2 + 8 * gq;
            const f32x4 dfs0 = *(const LAS f32x4*)(tdf + sb), dfs1 = *(const LAS f32x4*)(tdf + sb + 4), dbs0 = *(const LAS f32x4*)(tdb + sb), dbs1 = *(const LAS f32x4*)(tdb + sb + 4);
#pragma unroll
            for (int lt = 0; lt < 4; ++lt) {
                const int ll = 16 * lt + r16, l = 64 * lh + ll;
                const float cfl = tcf[l], cbl = tcb[l], dsl = tds[l];
                f32x4 g0 = (f32x4){0.f, 0.f, 0.f, 0.f}, g1 = g0;
#pragma unroll
                for (int nk = 0; nk < 4; ++nk) { const bf16x8v cf = as_frag(*(const LAS v4u*)(cml + ll * 272 + (32 * nk + 8 * gq) * 2));
                    g0 = MFMA16(bmf[0][nk], cf, g0); g1 = MFMA16(bmf[1][nk], cf, g1); }
                float m[8];
                const int ltile0 = 64 * lh + 16 * lt; const int blk = (32 * i2 + 31 < ltile0) ? 0 : ((32 * i2 > ltile0 + 15) ? 2 : 1);
                if (blk == 0) {
#pragma unroll
                    for (int e = 0; e < 8; ++e) { const float dfs = e < 4 ? dfs0[e & 3] : dfs1[e & 3], gv = e < 4 ? g0[e & 3] : g1[e & 3]; m[e] = gv * __builtin_amdgcn_exp2f(cfl + dfs); }
                } else if (blk == 2) {
#pragma unroll
                    for (int e = 0; e < 8; ++e) { const float dbs = e < 4 ? dbs0[e & 3] : dbs1[e & 3], gv = e < 4 ? g0[e & 3] : g1[e & 3]; m[e] = gv * __builtin_amdgcn_exp2f(cbl + dbs); }
                } else {
#pragma unroll
                    for (int e = 0; e < 8; ++e) { const int s = sb + e;
                        const float dfs = e < 4 ? dfs0[e & 3] : dfs1[e & 3], dbs = e < 4 ? dbs0[e & 3] : dbs1[e & 3], gv = e < 4 ? g0[e & 3] : g1[e & 3];
                        float w = __builtin_amdgcn_exp2f(s < l ? cfl + dfs : cbl + dbs); const bool dg = s == l;
                        w = dg ? dsl : w; m[e] = gv * w + (dg ? Dk : 0.f); }
                }
                asm volatile("" : "+v"(m[0]), "+v"(m[1]), "+v"(m[2]), "+v"(m[3]), "+v"(m[4]), "+v"(m[5]), "+v"(m[6]), "+v"(m[7]));
                v4u mp; mp.x = pk2(m[0], m[1]); mp.y = pk2(m[2], m[3]); mp.z = pk2(m[4], m[5]); mp.w = pk2(m[6], m[7]);
                const bf16x8v mf = as_frag(mp);
#pragma unroll
                for (int pt = 0; pt < 4; ++pt) acc[lt][pt] = MFMA16(xf[pt], mf, acc[lt][pt]);
            }
        }
        if (u + F.G < 128 * 8) S3_PREFETCH(u + F.G);
#pragma unroll 1
        for (int dir = 0; dir < 2; ++dir) {
            const bf16* hs = ST + ((size_t)((dir * NCH + c) * 32 + h) * 64) * 128;
            float el[4];
#pragma unroll
            for (int lt = 0; lt < 4; ++lt) { const int l = 64 * lh + 16 * lt + r16; el[lt] = __builtin_amdgcn_exp2f(dir == 0 ? tcf[l] : tcb[l]); }
            f32x4 tacc[4][4];
#pragma unroll
            for (int a = 0; a < 4; ++a)
#pragma unroll
                for (int b = 0; b < 4; ++b) tacc[a][b] = (f32x4){0.f, 0.f, 0.f, 0.f};
#pragma unroll 1
            for (int nk = 0; nk < 4; ++nk) {
                bf16x8v hf[4];
#pragma unroll
                for (int pt = 0; pt < 4; ++pt) hf[pt] = as_frag(*(const GAS v4u*)(hs + (size_t)(((pt * 4 + nk) * 16 + r16) * 32) + 8 * gq));
#pragma unroll
                for (int lt = 0; lt < 4; ++lt) { const int ll = 16 * lt + r16;
                    const bf16x8v cf = as_frag(*(const LAS v4u*)(cml + ll * 272 + (32 * nk + 8 * gq) * 2));
#pragma unroll
                    for (int pt = 0; pt < 4; ++pt) tacc[lt][pt] = MFMA16(hf[pt], cf, tacc[lt][pt]); }
            }
#pragma unroll
            for (int lt = 0; lt < 4; ++lt)
#pragma unroll
                for (int pt = 0; pt < 4; ++pt) acc[lt][pt] += tacc[lt][pt] * el[lt];
        }
#pragma unroll
        for (int lt = 0; lt < 4; ++lt) { const int l = 64 * lh + 16 * lt + r16; float ss = 0.f;
#pragma unroll
            for (int q = 0; q < 2; ++q) { const v4u zv = *(const GAS v4u*)(Z + (size_t)(t0 + l) * DIN + h * 64 + 32 * q + 8 * gq);
                const float zz[8] = {bflo(zv.x), bfhi(zv.x), bflo(zv.y), bfhi(zv.y), bflo(zv.z), bfhi(zv.z), bflo(zv.w), bfhi(zv.w)};
#pragma unroll
                for (int e = 0; e < 4; ++e) { float v0 = acc[lt][2 * q][e] * zz[e] * sigmoid_f(zz[e]), v1 = acc[lt][2 * q + 1][e] * zz[4 + e] * sigmoid_f(zz[4 + e]);
                    acc[lt][2 * q][e] = v0; acc[lt][2 * q + 1][e] = v1; ss += v0 * v0 + v1 * v1; } }
            ss += __shfl_xor(ss, 16); ss += __shfl_xor(ss, 32);
            if (gq == 0) ssq[(16 * lt + r16) * 8 + F.wave] = ss; }
        __syncthreads();
#pragma unroll
        for (int lt = 0; lt < 4; ++lt) { const int ll = 16 * lt + r16, l = 64 * lh + ll;
            const f32x4 s0 = *(const LAS f32x4*)(ssq + ll * 8), s1 = *(const LAS f32x4*)(ssq + ll * 8 + 4);
            const float rs = 1.0f / sqrtf(((s0.x + s0.y) + (s0.z + s0.w) + (s1.x + s1.y) + (s1.z + s1.w)) * (1.0f / 512.0f) + EPS);
#pragma unroll
            for (int q = 0; q < 2; ++q) { const int ch = h * 64 + 32 * q + 8 * gq; const f32x4 a = acc[lt][2 * q] * rs, b = acc[lt][2 * q + 1] * rs;
                const f32x4 g0 = *(const f32x4*)(ng + ch), g1 = *(const f32x4*)(ng + ch + 4);
                v4u o; o.x = pk2(a[0] * g0.x, a[1] * g0.y); o.y = pk2(a[2] * g0.z, a[3] * g0.w); o.z = pk2(b[0] * g1.x, b[1] * g1.y); o.w = pk2(b[2] * g1.z, b[3] * g1.w);
                *(GAS v4u*)(Z + (size_t)(t0 + l) * DIN + ch) = o; } }
    }
    __syncthreads();
}
#undef S3_PREFETCH

__device__ __forceinline__ float vmax_f(float a, float b) { return __builtin_amdgcn_fmed3f(a, b, __builtin_inff()); }
__device__ __forceinline__ float vmin_f(float a, float b) { return __builtin_amdgcn_fmed3f(a, b, -__builtin_inff()); }
__device__ __forceinline__ float vmax3_f(float a, float b, float c) { return vmax_f(a, vmax_f(b, c)); }
__device__ __forceinline__ int attn_next_blk(int kb, int qb, bool isctx) {
    for (int k = kb + 1; k < 5; ++k) { if (k >= 3) return k; if (!isctx) { const int b = qb - 1 + k; if (b >= 0 && b < 128) return k; } }
    return 5;
}
__device__ __forceinline__ void ph_attn(Frame& F) {
    const bf16* QR = (const bf16*)(F.ws + WS_QR); const bf16* KR = (const bf16*)(F.ws + WS_KR); const bf16* VT = (const bf16*)(F.ws + WS_VT); bf16* MIX = (bf16*)(F.ws + WS_MIX);
    constexpr int KBYTES = 128 * 144, BUFB = KBYTES + 64 * 272;
    const int lane = F.lane, r16 = lane & 15, gq = lane >> 4;
    constexpr float LOG2E = 1.4426950408889634f;
    const int p0 = F.tid, p1 = F.tid + NTHR;
    const int kro0 = (p0 >> 3) * 144 + (p0 & 7) * 16, kro1 = (p1 >> 3) * 144 + (p1 & 7) * 16;
    const int vro0 = KBYTES + (p0 >> 4) * 272 + (p0 & 15) * 16, vro1 = KBYTES + (p1 >> 4) * 272 + (p1 & 15) * 16;
    for (int u = F.vcu; u < 130 * 8; u += F.G) {
        const int qb = u >> 3, hq = u & 7, kvh = hq >> 2; const bool isctx = qb >= 128;
        const int row0 = qb * 128;
        const int qrow = row0 + 16 * F.wave + r16;
        bf16x8v qf[2];
#pragma unroll
        for (int ks = 0; ks < 2; ++ks) qf[ks] = as_frag(*(const GAS v4u*)(QR + ((size_t)hq * MT + qrow) * 64 + 32 * ks + 8 * gq));
        float m2 = F.in[I_ABSINK][hq] * LOG2E, lsum = 1.0f;
        f32x4 oacc[4];
#pragma unroll
        for (int a = 0; a < 4; ++a) oacc[a] = (f32x4){0.f, 0.f, 0.f, 0.f};
        const int qi = 16 * F.wave + r16;
        const bf16* kbase = KR + (size_t)kvh * MT * 64; const bf16* vbase = VT + (size_t)kvh * 64 * MT;
#define ATT_KEY0(kb) ((kb) < 3 ? (qb - 1 + (kb)) * 128 : L + ((kb) - 3) * 128)
#define ATT_LOAD(kb) do { const int k0_ = ATT_KEY0(kb); \
            kr0 = *(const GAS v4u*)(kbase + (size_t)(k0_ + (p0 >> 3)) * 64 + (p0 & 7) * 8); kr1 = *(const GAS v4u*)(kbase + (size_t)(k0_ + (p1 >> 3)) * 64 + (p1 & 7) * 8); \
            vr0 = *(const GAS v4u*)(vbase + (size_t)(p0 >> 4) * MT + k0_ + (p0 & 15) * 8); vr1 = *(const GAS v4u*)(vbase + (size_t)(p1 >> 4) * MT + k0_ + (p1 & 15) * 8); } while (0)
#define ATT_WRITE(buf) do { LAS unsigned char* b_ = F.lds + (buf) * BUFB; *(LAS v4u*)(b_ + kro0) = kr0; *(LAS v4u*)(b_ + kro1) = kr1; *(LAS v4u*)(b_ + vro0) = vr0; *(LAS v4u*)(b_ + vro1) = vr1; } while (0)
        v4u kr0, kr1, vr0, vr1;
        int kb = attn_next_blk(-1, qb, isctx), cur = 0;
        __syncthreads();
        ATT_LOAD(kb); ATT_WRITE(0);
        __syncthreads();
        while (kb < 5) {
            const int nkb = attn_next_blk(kb, qb, isctx);
            if (nkb < 5) ATT_LOAD(nkb);
            const LAS unsigned char* kl = F.lds + cur * BUFB; const LAS unsigned char* vl = kl + KBYTES;
            const int mode = (kb == 0) ? 1 : ((kb == 2) ? 2 : 0);
            f32x4 sacc[8];
#pragma unroll
            for (int kt = 0; kt < 8; ++kt) { sacc[kt] = (f32x4){0.f, 0.f, 0.f, 0.f};
#pragma unroll
                for (int ks = 0; ks < 2; ++ks) { const bf16x8v kf = as_frag(*(const LAS v4u*)(kl + prm_row(kt >> 1, kt & 1, r16) * 144 + (32 * ks + 8 * gq) * 2));
                    sacc[kt] = MFMA16(kf, qf[ks], sacc[kt]); } }
            float bm = -1.0e30f;
#pragma unroll 1
            for (int rep_ = 0; rep_ < (mode != 0 ? 1 : 0); ++rep_) {
                const float msgn = mode == 1 ? 1.0e30f : -1.0e30f, limf = (float)(qi - 8 * gq);
#pragma unroll
                for (int kt = 0; kt < 8; ++kt)
#pragma unroll
                    for (int e = 0; e < 4; ++e) { const float jc = (float)(32 * (kt >> 1) + 4 * (kt & 1) + e);
                        sacc[kt][e] += vmin_f(0.f, msgn * (jc - limf)); }
            }
#pragma unroll
            for (int kt = 0; kt < 8; ++kt) bm = vmax3_f(bm, vmax_f(sacc[kt][0], sacc[kt][1]), vmax_f(sacc[kt][2], sacc[kt][3]));
            bm = vmax_f(bm, __shfl_xor(bm, 16)); bm = vmax_f(bm, __shfl_xor(bm, 32));
            const float mn = vmax_f(m2, bm), alpha = __builtin_amdgcn_exp2f(m2 - mn); m2 = mn;
            float ps = 0.f;
            bf16x8v pf[4];
#pragma unroll
            for (int i2 = 0; i2 < 4; ++i2) { float p[8];
#pragma unroll
                for (int e = 0; e < 4; ++e) { p[e] = __builtin_amdgcn_exp2f(sacc[2 * i2][e] - mn); p[4 + e] = __builtin_amdgcn_exp2f(sacc[2 * i2 + 1][e] - mn); }
#pragma unroll
                for (int e = 0; e < 8; ++e) ps += p[e];
                v4u pk; pk.x = pk2(p[0], p[1]); pk.y = pk2(p[2], p[3]); pk.z = pk2(p[4], p[5]); pk.w = pk2(p[6], p[7]); pf[i2] = as_frag(pk); }
            ps += __shfl_xor(ps, 16); ps += __shfl_xor(ps, 32);
            lsum = lsum * alpha + ps;
#pragma unroll
            for (int dt = 0; dt < 4; ++dt) { oacc[dt] = oacc[dt] * alpha;
#pragma unroll
                for (int i2 = 0; i2 < 4; ++i2) { const bf16x8v vf = as_frag(*(const LAS v4u*)(vl + prm_row(dt >> 1, dt & 1, r16) * 272 + (32 * i2 + 8 * gq) * 2));
                    oacc[dt] = MFMA16(vf, pf[i2], oacc[dt]); } }
            if (nkb < 5) ATT_WRITE(cur ^ 1);
            __syncthreads();
            kb = nkb; cur ^= 1;
        }
#undef ATT_KEY0
#undef ATT_LOAD
#undef ATT_WRITE
        const float il = 1.0f / lsum;
#pragma unroll
        for (int i = 0; i < 2; ++i) { const f32x4 a = oacc[2 * i] * il, b = oacc[2 * i + 1] * il;
            v4u o; o.x = pk2(a[0], a[1]); o.y = pk2(a[2], a[3]); o.z = pk2(b[0], b[1]); o.w = pk2(b[2], b[3]);
            *(GAS v4u*)(MIX + (size_t)qrow * D + 512 + 64 * hq + 32 * i + 8 * gq) = o; }
    }
    __syncthreads();
}

constexpr int NPH = 23;
#ifndef WGM_MOE_GU
#define WGM_MOE_GU 4
#endif
#ifndef WGM_MOE_DN
#define WGM_MOE_DN 4
#endif
struct Args { const float* in[30]; float* out; unsigned char* ws; int ph_lo, ph_hi; };
__global__ void __launch_bounds__(NTHR, 2) mk_fwd(Args args) {
    extern __shared__ __attribute__((aligned(16))) unsigned char lds[];
    Frame F;
    F.lds = (LAS unsigned char*)lds;
    F.tid = threadIdx.x; F.lane = F.tid & 63; F.wave = __builtin_amdgcn_readfirstlane(F.tid >> 6);
    F.G = gridDim.x; { const int bx = blockIdx.x; F.vcu = (F.G % 8 == 0) ? (bx % 8) * (F.G / 8) + bx / 8 : bx; }
#pragma unroll
    for (int i = 0; i < 30; ++i) F.in[i] = args.in[i];
    F.out = args.out; F.ws = args.ws;
    unsigned char* ws = args.ws;
    volatile LAS unsigned* MISC = (volatile LAS unsigned*)(F.lds + MISC_OFF);
    for (int u = F.tid; u < (LDS_BYTES - LDSCTL_OFF) / 4; u += NTHR) ((LAS unsigned*)(F.lds + LDSCTL_OFF))[u] = 0u;
    __syncthreads();
    const int lo = args.ph_lo, hi = args.ph_hi;
    XcdBarrier bar; bar.bar = (unsigned*)(ws + WS_CTL) + CW_BAR; bar.x = 0; bar.st = nullptr;
    if (hi - lo > 1) bar = xcd_barrier_post((unsigned*)(ws + WS_CTL) + CW_BAR, MISC + 8);
#define IN(k) (lo <= (k) && (k) < hi)
#define SEAM(k) do { if (IN(k) && IN((k) + 1)) xcd_barrier(bar); } while (0)
    LAS unsigned char* ring = F.lds;
    bf16* X = (bf16*)(ws + WS_X); bf16* H = (bf16*)(ws + WS_H);

    if (IN(0)) { ph_prologue(F); } SEAM(0);
    if (IN(1)) { ph_modulate<false, false, 0>(F, F.in[I_X], F.in[I_CTX], F.in[I_N1G], modp(F, 0, 0), modp(F, 0, 1), M_SH1, M_SC1, H, MT, nullptr, nullptr, nullptr); } SEAM(1);
    if (IN(2)) { pg8::Gemm g{H, (const bf16*)(ws + WS_WABIN), D, D, 0}; pg8::StaticOrder S; S.init(MT, AB_IN, F.G, (int)blockIdx.x);
        pg8::EpiStoreBf16 E{(bf16*)(ws + WS_PAB), AB_IN};
        pg8::gemm_phase<pg8::EpiStoreBf16, pg8::StaticOrder, true, true>(ring, g, S, E);
        idle_round_convert(F, (MT / 256) * (AB_IN / 256), 0, 11400); } SEAM(2);
    if (IN(3)) { ph_ab_elem(F); } SEAM(3);
    if (IN(4)) { ph_attn(F); } SEAM(4);
    if (IN(5)) { { pg8::Gemm g{(const bf16*)(ws + WS_MIX), (const bf16*)(ws + WS_WABOUT), D, D, 0}; pg8::StaticOrder S; S.init(L, D, F.G, (int)blockIdx.x);
          pg8::EpiRes<true> E{X, F.in[I_X], modp(F, 0, 0) + M_G1};
          pg8::gemm_phase<pg8::EpiRes<true>, pg8::StaticOrder, true, true>(ring, g, S, E); }
        { int nu_ = 16, kl_ = 256; asm volatile("" : "+s"(nu_), "+s"(kl_)); pg8::Gemm g{(const bf16*)(ws + WS_MIX), (const bf16*)(ws + WS_WABOUT), D, kl_, 0}; pg8::SplitOrder S{64, 4, nu_, 256, F.G, (int)blockIdx.x};
          pg8::EpiPart E{(float*)(ws + WS_PART), 64, 256, LC};
          pg8::gemm_phase<pg8::EpiPart, pg8::SplitOrder, true, true>(ring, g, S, E); }
        if ((int)blockIdx.x >= 16) ph_convert_ffn(F, ((int)blockIdx.x - 16) * NWAVES + F.wave, (F.G - 16) * NWAVES); } SEAM(5);
    if (IN(6)) { ph_modulate<true, false, 4>(F, X, F.in[I_CTX], F.in[I_N2G], modp(F, 0, 0), modp(F, 0, 1), M_SH2, M_SC2, H, MT, (const float*)(ws + WS_PART), modp(F, 0, 1) + M_G1, X); } SEAM(6);
    if (IN(7)) { pg8::Gemm g{H, (const bf16*)(ws + WS_WFFNGU), D, D, 0}; pg8::StaticOrder S; S.init(MT, 2 * DFF, F.G, (int)blockIdx.x);
        pg8::EpiSwiGLU E{(bf16*)(ws + WS_ACT0), DFF};
        pg8::gemm_phase<pg8::EpiSwiGLU, pg8::StaticOrder, true, true>(ring, g, S, E);
        idle_round_convert(F, (MT / 256) * (2 * DFF / 256), 11400, 18000); } SEAM(7);
    if (IN(8)) { { pg8::Gemm g{(const bf16*)(ws + WS_ACT0), (const bf16*)(ws + WS_WFFND), DFF, DFF, 0}; pg8::StaticOrder S; S.init(L, D, F.G, (int)blockIdx.x);
          pg8::EpiRes<false> E{X, X, modp(F, 0, 0) + M_G2};
          pg8::gemm_phase<pg8::EpiRes<false>, pg8::StaticOrder, true, true>(ring, g, S, E); }
        { int nu_ = 44, kl_ = 256; asm volatile("" : "+s"(nu_), "+s"(kl_)); pg8::Gemm g{(const bf16*)(ws + WS_ACT0), (const bf16*)(ws + WS_WFFND), DFF, kl_, 0}; pg8::SplitOrder S{64, 4, nu_, 256, F.G, (int)blockIdx.x};
          pg8::EpiPart E{(float*)(ws + WS_PART), 64, 256, LC};
          pg8::gemm_phase<pg8::EpiPart, pg8::SplitOrder, true, true>(ring, g, S, E); }
        if ((int)blockIdx.x >= 44) ph_convert_ssd(F, ((int)blockIdx.x - 44) * NWAVES + F.wave, (F.G - 44) * NWAVES); } SEAM(8);
    if (IN(9)) { ph_modulate<true, true, 11>(F, X, X + (size_t)L * D, F.in[I_N1G] + D, modp(F, 1, 0), modp(F, 1, 1), M_SH1, M_SC1, H, MT, (const float*)(ws + WS_PART), modp(F, 0, 1) + M_G2, nullptr); } SEAM(9);
    if (IN(10)) { pg8::Gemm g{H, (const bf16*)(ws + WS_WSSDIN), D, D, 0}; pg8::StaticOrder S; S.init(MT, SSD_INP, F.G, (int)blockIdx.x);
        pg8::EpiSsdIn E{(bf16*)(ws + WS_Z), (bf16*)(ws + WS_XBCR), (float*)(ws + WS_DTRAW)};
        pg8::gemm_phase<pg8::EpiSsdIn, pg8::StaticOrder, true, true>(ring, g, S, E);
        idle_round_convert(F, (MT / 256) * (SSD_INP / 256), 18000, MOE_GU_ITEMS); } SEAM(10);
    if (IN(11)) { ph_ssd_conv(F); } SEAM(11);
    if (IN(12)) { ph_ssd_s1(F); } SEAM(12);
    if (IN(13)) { ph_ssd_s2(F); } SEAM(13);
    if (IN(14)) { ph_ssd_s3(F); } if (IN(14) && IN(16)) xcd_barrier(bar);
    if (IN(16)) { pg8::Gemm g{(const bf16*)(ws + WS_Z), (const bf16*)(ws + WS_WSSDOUT), DIN, DIN, 0}; pg8::StaticOrder S; S.init(L, D, F.G, (int)blockIdx.x);
        pg8::EpiRes<false> E{X, X, modp(F, 1, 0) + M_G1};
        pg8::gemm_phase<pg8::EpiRes<false>, pg8::StaticOrder, true, true>(ring, g, S, E); } SEAM(16);
    if (IN(17)) { ph_moe_route(F); } SEAM(17);
    if (IN(18)) { ph_moe_scatter(F); } SEAM(18);
    if (IN(19) || IN(21)) {
        LAS int* hist = (LAS int*)F.lds; LAS int* cnt = hist + 512; LAS int* seg = cnt + 8;
        pg8::GroupedOrder S;
        if (IN(19)) {
            moe_segments(F, hist, cnt, seg);
            S.nM = seg[8] >> 8; S.nN = 2 * FFE / 256; S.nwg = S.nM * S.nN; S.G = F.G; S.c = (int)blockIdx.x; S.WGM = WGM_MOE_GU;
            S.ts1 = seg[1] >> 8; S.ts2 = seg[2] >> 8; S.ts3 = seg[3] >> 8; S.ts4 = seg[4] >> 8; S.ts5 = seg[5] >> 8; S.ts6 = seg[6] >> 8; S.ts7 = seg[7] >> 8;
            __syncthreads();
            pg8::Gemm g{(const bf16*)(ws + WS_H2S), (const bf16*)(ws + WS_WMOE), D, D, (size_t)2 * FFE * D * 2};
            pg8::EpiSwiGLU E{(bf16*)(ws + WS_ACTM), FFE};
            pg8::gemm_phase<pg8::EpiSwiGLU, pg8::GroupedOrder, true, true>(ring, g, S, E);
        }
        SEAM(19);
        if (IN(20)) { int first = 0;
            for (int e = 0; e < NEXP; ++e) tr_matrix(F, F.in[I_MOED] + (size_t)e * FFE * D, FFE, D, (bf16*)(ws + WS_WMOE) + (size_t)e * D * FFE, 0, first); }
        SEAM(20);
        if (IN(21)) {
            __syncthreads();
            moe_segments(F, hist, cnt, seg);
            const int NT = seg[8] >> 8;
            S.nM = NT < 128 ? NT : 128; S.nN = D / 256; S.nwg = S.nM * S.nN; S.G = F.G; S.c = (int)blockIdx.x; S.WGM = WGM_MOE_DN;
            S.ts1 = seg[1] >> 8; S.ts2 = seg[2] >> 8; S.ts3 = seg[3] >> 8; S.ts4 = seg[4] >> 8; S.ts5 = seg[5] >> 8; S.ts6 = seg[6] >> 8; S.ts7 = seg[7] >> 8;
            __syncthreads();
            { pg8::Gemm g{(const bf16*)(ws + WS_ACTM), (const bf16*)(ws + WS_WMOE), FFE, FFE, (size_t)D * FFE * 2};
              pg8::EpiStoreBf16 E{(bf16*)(ws + WS_H2S), D};
              pg8::gemm_phase<pg8::EpiStoreBf16, pg8::GroupedOrder, true, true>(ring, g, S, E); }
            if (NT > 128) {
                pg8::Gemm g{(const bf16*)(ws + WS_ACTM), (const bf16*)(ws + WS_WMOE), FFE, 512, (size_t)D * FFE * 2};
                pg8::SplitGroupedOrder S2{128, NT, D / 256, 7, 512, F.G, (int)blockIdx.x, S.ts1, S.ts2, S.ts3, S.ts4, S.ts5, S.ts6, S.ts7};
                pg8::EpiPart E{(float*)(ws + WS_YPART), 128, 512, 2048};
                pg8::gemm_phase<pg8::EpiPart, pg8::SplitGroupedOrder, true, true>(ring, g, S2, E); }
        }
        SEAM(21);
    } else { SEAM(19); if (IN(20)) { int first = 0;
            for (int e = 0; e < NEXP; ++e) tr_matrix(F, F.in[I_MOED] + (size_t)e * FFE * D, FFE, D, (bf16*)(ws + WS_WMOE) + (size_t)e * D * FFE, 0, first); }
        SEAM(20); SEAM(21); }
    if (IN(22)) { ph_final(F); }
#undef IN
#undef SEAM
}

extern "C" void kernel_launch(void* const* d_in, const int* in_sizes, int n_in, void* d_out, int out_size, void* d_ws, size_t ws_size, hipStream_t stream) {
    static int grid = 0;
    if (grid == 0) {
        if (n_in != 30 || in_sizes[0] != L * D || out_size != L * D || ws_size < WS_END) { fprintf(stderr, "kernel_launch: unexpected shapes (n_in %d, in0 %d, out %d, ws %zu < %zu); nothing launched\n", n_in, n_in > 0 ? in_sizes[0] : -1, out_size, ws_size, (size_t)WS_END); grid = -1; return; }
        int dev = 0, cus = 0, per_cu = 0;
        if (hipGetDevice(&dev) != hipSuccess || hipDeviceGetAttribute(&cus, hipDeviceAttributeMultiprocessorCount, dev) != hipSuccess) { grid = -1; return; }
        if (hipFuncSetAttribute((const void*)mk_fwd, hipFuncAttributeMaxDynamicSharedMemorySize, LDS_BYTES) != hipSuccess) { fprintf(stderr, "kernel_launch: hipFuncSetAttribute failed\n"); grid = -1; return; }
        if (hipOccupancyMaxActiveBlocksPerMultiprocessor(&per_cu, (const void*)mk_fwd, NTHR, LDS_BYTES) != hipSuccess || per_cu < 1)
            fprintf(stderr, "kernel_launch: note: occupancy query reports %d workgroups per CU\n", per_cu);
        (void)hipGetLastError();
        grid = cus;
    }
    if (grid < 0) return;
    if (hipMemsetAsync((char*)d_ws + WS_CTL, 0, CTL_ZERO_BYTES, stream) != hipSuccess) return;
    Args a{};
    for (int i = 0; i < 30; ++i) a.in[i] = (const float*)d_in[i];
    a.out = (float*)d_out; a.ws = (unsigned char*)d_ws;
    if (MK_N_LAUNCHES == 1) { a.ph_lo = 0; a.ph_hi = NPH; hipLaunchKernelGGL(mk_fwd, dim3(grid), dim3(NTHR), LDS_BYTES, stream, a); }
    else { for (int p = 0; p < NPH; ++p) { a.ph_lo = p; a.ph_hi = p + 1; hipLaunchKernelGGL(mk_fwd, dim3(grid), dim3(NTHR), LDS_BYTES, stream, a); } }
}
```

```cpp
#include <hip/hip_runtime.h>
#include <cstdio>
#include <cstdint>

#ifndef MK_N_LAUNCHES
#define MK_N_LAUNCHES 1
#endif

namespace pg8 {
#define PG8_LAS __attribute__((address_space(3)))
typedef unsigned short bf16_t;
typedef short bf16x8 __attribute__((ext_vector_type(8)));
typedef float f32x4 __attribute__((ext_vector_type(4)));
typedef unsigned u32x4 __attribute__((ext_vector_type(4)));
constexpr int BM = 256, BK = 64, HALF = 128, HTB = HALF * BK * 2  , STAGE_BYTES = 8 * HTB, NXCD = 8;

__host__ __device__ __forceinline__ int lds_byte(int r, int c) { const int st = (r >> 4) * 2 + (c >> 5), rr = r & 15, cc = c & 31, ob = rr * 64 + cc * 2; return st * 1024 + (ob ^ (((ob >> 9) & 1) << 5)); }
__host__ __device__ __forceinline__ void stage_rc(int b, int& R, int& C) { const int st = b / 1024, sb = b % 1024, swz = sb ^ (((sb >> 9) & 1) << 5); R = (st >> 1) * 16 + swz / 64; C = (st & 1) * 32 + (swz % 64) / 2; }
__host__ __device__ __forceinline__ int perm32(int rho) { const int n = rho >> 4, i = rho & 15; return 8 * (i >> 2) + 4 * n + (i & 3); }

struct Unit { int pm, pn, pe, pk; };
struct Gemm { const bf16_t* A; const bf16_t* Bt; int ld, K; size_t bstride; };

struct StaticOrder {
    int nM, nN, nwg, G, c, WGM;
    __host__ __device__ void init(int M, int N, int G_, int c_, int wgm = 4) { nM = M / BM; nN = N / BM; nwg = nM * nN; G = G_; c = c_; WGM = wgm; }
    __host__ __device__ bool next(int i, Unit& u) const {
        const long L = (long)i * G + c; if (L >= nwg) return false;
        int wgid = (int)L; { const int q = nwg / NXCD, r = nwg % NXCD, xcd = wgid % NXCD, off = wgid / NXCD; wgid = (xcd < r ? xcd * (q + 1) : r * (q + 1) + (xcd - r) * q) + off; }
        const int nig = WGM * nN, gid = wgid / nig, fm = gid * WGM, gsz = (nM - fm) < WGM ? (nM - fm) : WGM;
        u.pm = fm + ((wgid % nig) % gsz); u.pn = (wgid % nig) / gsz; u.pe = 0; u.pk = 0; return true;
    }
    __device__ __forceinline__ void a_ready(const Unit&) const {}
    __device__ __forceinline__ void done(const Unit&) const {}
};
struct GroupedOrder {
    int nM, nN, nwg, G, c, WGM; int ts1, ts2, ts3, ts4, ts5, ts6, ts7;
    __device__ bool next(int i, Unit& u) const {
        const long L = (long)i * G + c; if (L >= nwg) return false;
        int wgid = (int)L; { const int q = nwg / NXCD, r = nwg % NXCD, xcd = wgid % NXCD, off = wgid / NXCD; wgid = (xcd < r ? xcd * (q + 1) : r * (q + 1) + (xcd - r) * q) + off; }
        const int nig = WGM * nN, gid = wgid / nig, fm = gid * WGM, gsz = (nM - fm) < WGM ? (nM - fm) : WGM;
        u.pm = fm + ((wgid % nig) % gsz); u.pn = (wgid % nig) / gsz;
        u.pk = 0; const int p = u.pm; u.pe = (p >= ts1) + (p >= ts2) + (p >= ts3) + (p >= ts4) + (p >= ts5) + (p >= ts6) + (p >= ts7); return true;
    }
    __device__ __forceinline__ void a_ready(const Unit&) const {}
    __device__ __forceinline__ void done(const Unit&) const {}
};

__device__ __forceinline__ unsigned cvt_pk_bf16(float lo, float hi) { unsigned r; asm volatile("v_cvt_pk_bf16_f32 %0, %1, %2" : "=v"(r) : "v"(lo), "v"(hi)); return r; }
__device__ __forceinline__ float silu_f(float g) { return g * __builtin_amdgcn_rcpf(1.0f + __expf(-g)); }

struct EpiStoreBf16 {
    static constexpr bool PERM = true, AFTER_DRAIN = false;
    bf16_t* O; int ldc;
    __device__ __forceinline__ void operator()(const f32x4 (&acc)[2][2][4][2], const Unit& u, int wr, int wc, int fr, int fq) const {
        const int row0 = u.pm * BM + wr * 64 + fr, col0 = u.pn * BM + wc * 32 + 8 * fq;
#pragma unroll
        for (int ai = 0; ai < 2; ++ai)
#pragma unroll
            for (int m = 0; m < 4; ++m) { bf16_t* rowp = O + (size_t)(row0 + ai * HALF + m * 16) * ldc + col0;
#pragma unroll
                for (int bj = 0; bj < 2; ++bj) { const f32x4 v0 = acc[ai][bj][m][0], v1 = acc[ai][bj][m][1];
                    u32x4 w; w.x = cvt_pk_bf16(v0[0], v0[1]); w.y = cvt_pk_bf16(v0[2], v0[3]); w.z = cvt_pk_bf16(v1[0], v1[1]); w.w = cvt_pk_bf16(v1[2], v1[3]);
                    *(u32x4*)(rowp + bj * HALF) = w; } }
    }
};
struct EpiSwiGLU {
    static constexpr bool PERM = true, AFTER_DRAIN = false;
    bf16_t* O; int ldc;
    __device__ __forceinline__ void operator()(const f32x4 (&acc)[2][2][4][2], const Unit& u, int wr, int wc, int fr, int fq) const {
        const int row0 = u.pm * BM + wr * 64 + fr, col0 = u.pn * HALF + wc * 32 + 8 * fq;
#pragma unroll
        for (int ai = 0; ai < 2; ++ai)
#pragma unroll
            for (int m = 0; m < 4; ++m) { bf16_t* rowp = O + (size_t)(row0 + ai * HALF + m * 16) * ldc + col0;
                const f32x4 g0 = acc[ai][0][m][0], g1 = acc[ai][0][m][1], u0 = acc[ai][1][m][0], u1 = acc[ai][1][m][1];
                u32x4 w; w.x = cvt_pk_bf16(silu_f(g0[0]) * u0[0], silu_f(g0[1]) * u0[1]); w.y = cvt_pk_bf16(silu_f(g0[2]) * u0[2], silu_f(g0[3]) * u0[3]);
                w.z = cvt_pk_bf16(silu_f(g1[0]) * u1[0], silu_f(g1[1]) * u1[1]); w.w = cvt_pk_bf16(silu_f(g1[2]) * u1[2], silu_f(g1[3]) * u1[3]);
                *(u32x4*)rowp = w; }
    }
};
template <bool BASE_F32> struct EpiRes {
    static constexpr bool PERM = true, AFTER_DRAIN = false;
    bf16_t* X; const void* base; const float* gate;
    __device__ __forceinline__ void operator()(const f32x4 (&acc)[2][2][4][2], const Unit& u, int wr, int wc, int fr, int fq) const {
        const int row0 = u.pm * BM + wr * 64 + fr, col0 = u.pn * BM + wc * 32 + 8 * fq;
        f32x4 gv[2][2];
#pragma unroll
        for (int bj = 0; bj < 2; ++bj)
#pragma unroll
            for (int n = 0; n < 2; ++n) gv[bj][n] = *(const f32x4*)(gate + col0 + bj * HALF + 4 * n);
#pragma unroll
        for (int ai = 0; ai < 2; ++ai)
#pragma unroll
            for (int m = 0; m < 4; ++m) { const size_t ro = (size_t)(row0 + ai * HALF + m * 16) * 1024 + col0;
#pragma unroll
                for (int bj = 0; bj < 2; ++bj) { f32x4 b0, b1;
                    if (BASE_F32) { b0 = __builtin_nontemporal_load((const f32x4*)((const float*)base + ro + bj * HALF)); b1 = __builtin_nontemporal_load((const f32x4*)((const float*)base + ro + bj * HALF + 4)); }
                    else { const u32x4 t = *(const u32x4*)((const bf16_t*)base + ro + bj * HALF);
                        b0 = (f32x4){__uint_as_float(t.x << 16), __uint_as_float(t.x & 0xffff0000u), __uint_as_float(t.y << 16), __uint_as_float(t.y & 0xffff0000u)};
                        b1 = (f32x4){__uint_as_float(t.z << 16), __uint_as_float(t.z & 0xffff0000u), __uint_as_float(t.w << 16), __uint_as_float(t.w & 0xffff0000u)}; }
                    const f32x4 v0 = b0 + gv[bj][0] * acc[ai][bj][m][0], v1 = b1 + gv[bj][1] * acc[ai][bj][m][1];
                    u32x4 w; w.x = cvt_pk_bf16(v0[0], v0[1]); w.y = cvt_pk_bf16(v0[2], v0[3]); w.z = cvt_pk_bf16(v1[0], v1[1]); w.w = cvt_pk_bf16(v1[2], v1[3]);
                    *(u32x4*)(X + ro + bj * HALF) = w; } }
    }
};
struct EpiSsdIn {
    static constexpr bool PERM = true, AFTER_DRAIN = false;
    bf16_t* Z; bf16_t* XB; float* DT;
    __device__ __forceinline__ void operator()(const f32x4 (&acc)[2][2][4][2], const Unit& u, int wr, int wc, int fr, int fq) const {
        const int row0 = u.pm * BM + wr * 64 + fr;
        if (u.pn < 20) {
            bf16_t* O = u.pn < 8 ? Z : XB; const int ldc = u.pn < 8 ? 2048 : 3072; const int col0 = (u.pn < 8 ? u.pn : u.pn - 8) * BM + wc * 32 + 8 * fq;
#pragma unroll
            for (int ai = 0; ai < 2; ++ai)
#pragma unroll
                for (int m = 0; m < 4; ++m) { bf16_t* rowp = O + (size_t)(row0 + ai * HALF + m * 16) * ldc + col0;
#pragma unroll
                    for (int bj = 0; bj < 2; ++bj) { const f32x4 v0 = acc[ai][bj][m][0], v1 = acc[ai][bj][m][1];
                        u32x4 w; w.x = cvt_pk_bf16(v0[0], v0[1]); w.y = cvt_pk_bf16(v0[2], v0[3]); w.z = cvt_pk_bf16(v1[0], v1[1]); w.w = cvt_pk_bf16(v1[2], v1[3]);
                        *(u32x4*)(rowp + bj * HALF) = w; } }
        } else if (wc < 2) {
#pragma unroll
            for (int ai = 0; ai < 2; ++ai)
#pragma unroll
                for (int m = 0; m < 4; ++m) { float* rowp = DT + (size_t)(row0 + ai * HALF + m * 16) * 64 + wc * 32 + 8 * fq;
                    *(f32x4*)rowp = acc[ai][0][m][0]; *(f32x4*)(rowp + 4) = acc[ai][0][m][1]; }
        }
    }
};


struct SplitOrder {
    int pm0, nN, nunits, ks_len, G, c;
    __device__ bool next(int i, Unit& u) const { const int x = i * G + c; if (x >= nunits) return false; u.pm = pm0; u.pn = x % nN; u.pe = 0; u.pk = (x / nN) * ks_len; return true; }
    __device__ __forceinline__ void a_ready(const Unit&) const {}
    __device__ __forceinline__ void done(const Unit&) const {}
};
struct SplitGroupedOrder {
    int pm_lo, pm_hi, nN, nks, ks_len, G, c; int ts1, ts2, ts3, ts4, ts5, ts6, ts7;
    __device__ bool next(int i, Unit& u) const { const int x = i * G + c; const int per = nN * nks; if (x >= (pm_hi - pm_lo) * per) return false;
        u.pm = pm_lo + x / per; const int y = x % per; u.pn = y / nks; u.pk = (y % nks) * ks_len;
        const int p = u.pm; u.pe = (p >= ts1) + (p >= ts2) + (p >= ts3) + (p >= ts4) + (p >= ts5) + (p >= ts6) + (p >= ts7); return true; }
    __device__ __forceinline__ void a_ready(const Unit&) const {}
    __device__ __forceinline__ void done(const Unit&) const {}
};
struct EpiPart {
    static constexpr bool PERM = false, AFTER_DRAIN = false;
    float* P; int pm_base, ks_len, nrows;
    __device__ __forceinline__ void operator()(const f32x4 (&acc)[2][2][4][2], const Unit& u, int wr, int wc, int fr, int fq) const {
        const int row0 = (u.pm - pm_base) * BM + wr * 64 + fr, col0 = u.pn * BM + wc * 32 + 4 * fq;
        float* base = P + (size_t)(u.pk / ks_len) * nrows * 1024;
#pragma unroll
        for (int ai = 0; ai < 2; ++ai)
#pragma unroll
            for (int m = 0; m < 4; ++m) { float* rowp = base + (size_t)(row0 + ai * HALF + m * 16) * 1024 + col0;
#pragma unroll
                for (int bj = 0; bj < 2; ++bj)
#pragma unroll
                    for (int n = 0; n < 2; ++n) *(f32x4*)(rowp + bj * HALF + n * 16) = acc[ai][bj][m][n]; }
    }
};
template <class Epi, class Sched, bool ALIGN_EPI = false, bool SP2 = false>
__device__ __forceinline__ void gemm_phase(PG8_LAS unsigned char* lds, const Gemm g, const Sched& S, const Epi& E) {
    const int tid = threadIdx.x, wid = __builtin_amdgcn_readfirstlane(tid >> 6), lane = tid & 63, wr = wid >> 2, wc = wid & 3, fr = lane & 15, fq = lane >> 4;
    const int K = g.K, nt = K / BK;
    unsigned voffA[2], voffB[2];
#pragma unroll
    for (int i = 0; i < 2; ++i) { int R, C; stage_rc(tid * 16 + i * 8192, R, C); const int Rb = Epi::PERM ? ((R & ~31) + perm32(R & 31)) : R;
        voffA[i] = (unsigned)(R * g.ld + C) * 2u; voffB[i] = (unsigned)(Rb * g.ld + C) * 2u; }
    const size_t kstep = (size_t)(BK * 2);
    const size_t hstep = (size_t)HALF * g.ld * 2;
    const size_t tstep = 2 * hstep;
    const unsigned ldsw = (unsigned)wid * 1024u;
    const int aoff = lds_byte(wr * 64 + fr, fq * 8), boff = lds_byte(wc * 32 + fr, fq * 8);
#define PG8_SA(b, h) (((b) * 2 + (h)) * HTB)
#define PG8_SB(b, h) ((4 + (b) * 2 + (h)) * HTB)
#define PG8_STAGE(bufoff, gbase, voff) do { _Pragma("unroll") for (int _i = 0; _i < 2; ++_i) \
        __builtin_amdgcn_global_load_lds((const unsigned*)((const char*)(gbase) + (voff)[_i]), (PG8_LAS unsigned*)(lds + (bufoff) + ldsw + _i * 8192), 16, 0, 0); } while (0)
#define PG8_LDA(dst, b, h) do { _Pragma("unroll") for (int m = 0; m < 4; ++m) _Pragma("unroll") for (int k = 0; k < 2; ++k) dst[m][k] = *(const PG8_LAS bf16x8*)(lds + PG8_SA(b, h) + aoff + m * 2048 + k * 1024); } while (0)
#define PG8_LDB(dst, b, h) do { _Pragma("unroll") for (int n = 0; n < 2; ++n) _Pragma("unroll") for (int k = 0; k < 2; ++k) dst[n][k] = *(const PG8_LAS bf16x8*)(lds + PG8_SB(b, h) + boff + n * 2048 + k * 1024); } while (0)
#define PG8_MMA(ai, bj, At, Bt) do { __builtin_amdgcn_s_setprio(1); _Pragma("unroll") for (int m = 0; m < 4; ++m) _Pragma("unroll") for (int n = 0; n < 2; ++n) _Pragma("unroll") for (int k = 0; k < 2; ++k) \
        acc[ai][bj][m][n] = __builtin_amdgcn_mfma_f32_16x16x32_bf16(Bt[n][k], At[m][k], acc[ai][bj][m][n], 0, 0, 0); __builtin_amdgcn_s_setprio(0); } while (0)
#define PG8_WAIT_V(n) asm volatile("s_waitcnt vmcnt(" #n ")" ::: "memory")
#define PG8_WAIT_L(n) asm volatile("s_waitcnt lgkmcnt(" #n ")" ::: "memory")
#define PG8_BAR __builtin_amdgcn_s_barrier()
#define PG8_SCHED __builtin_amdgcn_sched_barrier(0)
    Unit cur, nxt; int ui = 0;
    if (!S.next(0, cur)) return;
    f32x4 acc[2][2][4][2];
#pragma unroll
    for (int a = 0; a < 2; ++a)
#pragma unroll
        for (int b = 0; b < 2; ++b)
#pragma unroll
            for (int m = 0; m < 4; ++m)
#pragma unroll
                for (int n = 0; n < 2; ++n) acc[a][b][m][n] = (f32x4){0.f, 0.f, 0.f, 0.f};
    bf16x8 At[4][2], B0[2][2], B1[2][2];
    const char* cA = (const char*)g.A + (size_t)cur.pm * tstep + (size_t)cur.pk * 2; const char* cB = (const char*)g.Bt + (size_t)cur.pe * g.bstride + (size_t)cur.pn * tstep + (size_t)cur.pk * 2;
    S.a_ready(cur);
    if constexpr (SP2) {
        PG8_STAGE(PG8_SB(0, 0), cB, voffB); PG8_STAGE(PG8_SB(0, 1), cB + hstep, voffB); PG8_STAGE(PG8_SA(0, 0), cA, voffA); PG8_STAGE(PG8_SA(0, 1), cA + hstep, voffA);
        if (wr == 1) PG8_BAR;
        PG8_WAIT_V(2); PG8_BAR;
        PG8_STAGE(PG8_SB(1, 0), cB + kstep, voffB); PG8_STAGE(PG8_SA(1, 0), cA + kstep, voffA); PG8_STAGE(PG8_SB(1, 1), cB + hstep + kstep, voffB);
        PG8_WAIT_V(6); PG8_BAR;
    } else {
        PG8_STAGE(PG8_SB(0, 0), cB, voffB); PG8_STAGE(PG8_SA(0, 0), cA, voffA); PG8_STAGE(PG8_SB(0, 1), cB + hstep, voffB); PG8_STAGE(PG8_SA(0, 1), cA + hstep, voffA);
        if (wr == 1) PG8_BAR;
        PG8_WAIT_V(4); PG8_BAR;
        PG8_STAGE(PG8_SB(1, 0), cB + kstep, voffB); PG8_STAGE(PG8_SA(1, 0), cA + kstep, voffA); PG8_STAGE(PG8_SB(1, 1), cB + hstep + kstep, voffB);
        PG8_WAIT_V(6); PG8_BAR;
    }
    for (;;) {
        const bool has_next = S.next(ui + 1, nxt);
        const char* nA = has_next ? (const char*)g.A + (size_t)nxt.pm * tstep + (size_t)nxt.pk * 2 : cA; const char* nB = has_next ? (const char*)g.Bt + (size_t)nxt.pe * g.bstride + (size_t)nxt.pn * tstep + (size_t)nxt.pk * 2 : cB;
        for (int t = 0; t < nt; t += 2) {
            const bool last = (t == nt - 2);
            const char* a1 = cA + (size_t)(t + 1) * kstep;
            const char* a2 = last ? nA : cA + (size_t)(t + 2) * kstep; const char* b2 = last ? nB : cB + (size_t)(t + 2) * kstep;
            const char* a3 = a2 + kstep; const char* b3 = b2 + kstep;
            if (last && has_next) S.a_ready(nxt);
            if constexpr (SP2) {
            PG8_LDB(B0, 0, 0); PG8_LDB(B1, 0, 1); PG8_SCHED; PG8_LDA(At, 0, 0); PG8_STAGE(PG8_SA(1, 1), a1 + hstep, voffA);
            PG8_WAIT_V(8); PG8_WAIT_L(0); PG8_BAR; PG8_MMA(0, 0, At, B0); PG8_MMA(0, 1, At, B1); PG8_BAR; PG8_SCHED;
            PG8_LDA(At, 0, 1); PG8_STAGE(PG8_SB(0, 0), b2, voffB); PG8_STAGE(PG8_SB(0, 1), b2 + hstep, voffB); PG8_STAGE(PG8_SA(0, 0), a2, voffA);
            PG8_WAIT_V(8); PG8_WAIT_L(0); PG8_BAR; PG8_MMA(1, 0, At, B0); PG8_MMA(1, 1, At, B1); PG8_BAR; PG8_SCHED;
            PG8_LDB(B0, 1, 0); PG8_LDB(B1, 1, 1); PG8_SCHED; PG8_LDA(At, 1, 0); PG8_STAGE(PG8_SA(0, 1), a2 + hstep, voffA);
            PG8_WAIT_V(8); PG8_WAIT_L(0); PG8_BAR; PG8_MMA(0, 0, At, B0); PG8_MMA(0, 1, At, B1); PG8_BAR; PG8_SCHED;
            PG8_LDA(At, 1, 1); PG8_STAGE(PG8_SB(1, 0), b3, voffB); PG8_STAGE(PG8_SB(1, 1), b3 + hstep, voffB); PG8_STAGE(PG8_SA(1, 0), a3, voffA);
            PG8_WAIT_V(8); PG8_WAIT_L(0); PG8_BAR; PG8_MMA(1, 0, At, B0); PG8_MMA(1, 1, At, B1); PG8_BAR; PG8_SCHED;
            } else {
            PG8_LDB(B0, 0, 0); PG8_SCHED; PG8_LDA(At, 0, 0); PG8_STAGE(PG8_SA(1, 1), a1 + hstep, voffA);
            PG8_WAIT_L(8); PG8_BAR; PG8_WAIT_L(0); PG8_MMA(0, 0, At, B0); PG8_BAR; PG8_SCHED;
            PG8_LDB(B1, 0, 1); PG8_STAGE(PG8_SB(0, 0), b2, voffB);
            PG8_BAR; PG8_WAIT_L(0); PG8_MMA(0, 1, At, B1); PG8_BAR;
            PG8_LDA(At, 0, 1); PG8_STAGE(PG8_SA(0, 0), a2, voffA);
            PG8_BAR; PG8_WAIT_L(0); PG8_MMA(1, 0, At, B0); PG8_BAR; PG8_SCHED;
            PG8_STAGE(PG8_SB(0, 1), b2 + hstep, voffB);
            PG8_WAIT_V(6); PG8_BAR; PG8_MMA(1, 1, At, B1); PG8_BAR;
            PG8_LDB(B0, 1, 0); PG8_SCHED; PG8_LDA(At, 1, 0); PG8_STAGE(PG8_SA(0, 1), a2 + hstep, voffA);
            PG8_WAIT_L(8); PG8_BAR; PG8_WAIT_L(0); PG8_MMA(0, 0, At, B0); PG8_BAR; PG8_SCHED;
            PG8_LDB(B1, 1, 1); PG8_STAGE(PG8_SB(1, 0), b3, voffB);
            PG8_BAR; PG8_WAIT_L(0); PG8_MMA(0, 1, At, B1); PG8_BAR;
            PG8_LDA(At, 1, 1); PG8_STAGE(PG8_SA(1, 0), a3, voffA);
            PG8_BAR; PG8_WAIT_L(0); PG8_MMA(1, 0, At, B0); PG8_BAR; PG8_SCHED;
            PG8_STAGE(PG8_SB(1, 1), b3 + hstep, voffB);
            PG8_WAIT_V(6); PG8_BAR; PG8_MMA(1, 1, At, B1); PG8_BAR;
            }
        }
        if constexpr (ALIGN_EPI) { if (wr == 0) PG8_BAR; }
        if constexpr (!Epi::AFTER_DRAIN) { E(acc, cur, wr, wc, fr, fq); S.done(cur); }
        if (!has_next) break;
#pragma unroll
        for (int a = 0; a < 2; ++a)
#pragma unroll
            for (int b = 0; b < 2; ++b)
#pragma unroll
                for (int m = 0; m < 4; ++m)
#pragma unroll
                    for (int n = 0; n < 2; ++n) acc[a][b][m][n] = (f32x4){0.f, 0.f, 0.f, 0.f};
        cur = nxt; cA = nA; cB = nB; ++ui;
        if constexpr (ALIGN_EPI) { if (wr == 1) PG8_BAR; }
    }
    PG8_WAIT_V(0);
    if constexpr (!ALIGN_EPI) { if (wr == 0) PG8_BAR; }
    PG8_BAR;
    if constexpr (Epi::AFTER_DRAIN) { E.fused(acc, cur, wr, wc, fr, fq, lds, wid, lane); S.done(cur); }
#undef PG8_SA
#undef PG8_SB
#undef PG8_STAGE
#undef PG8_LDA
#undef PG8_LDB
#undef PG8_MMA
#undef PG8_WAIT_V
#undef PG8_WAIT_L
#undef PG8_BAR
#undef PG8_SCHED
}
}

constexpr int NWAVES = 8, NTHR = 512;
constexpr int D = 1024, L = 16384, LC = 256, MT = L + LC;
constexpr int AB_IN = 2304, DFF = 2816, SSD_INP = 5376, SSD_IN_REAL = 5184, DIN = 2048, XBCW = 3072, FFE = 3584, NEXP = 8;
constexpr int NCH = MT / 128;
constexpr int MOE_ROWS = 2 * L + NEXP * 256;
constexpr float EPS = 1e-6f;

constexpr size_t MiB = 1u << 20;
constexpr size_t WS_CTL = 0, CTL_ZERO_BYTES = 32768;
constexpr size_t WS_MOD = 1 * MiB;
constexpr size_t WS_ROPE = 1 * MiB + 128 * 1024;
constexpr size_t WS_TOKE = 2 * MiB, WS_TOKW = 2 * MiB + 128 * 1024, WS_TOKP = 2 * MiB + 256 * 1024;
constexpr size_t WS_RSTD = 2 * MiB + 384 * 1024;
constexpr size_t WS_DEC = 3 * MiB;
constexpr size_t WS_X = 4 * MiB;
constexpr size_t WS_H = 36 * MiB + 512 * 1024;
constexpr size_t WS_WMOE = 69 * MiB, WS_YPART = WS_WMOE + 56 * MiB;
constexpr size_t WS_H2S = 181 * MiB, WS_ACTM = 249 * MiB, WS_H2 = 487 * MiB, WS_END = 520 * MiB;
constexpr size_t WS_WSSDIN = 181 * MiB, WS_WSSDOUT = WS_WSSDIN + (size_t)SSD_INP * D * 2;
constexpr size_t WS_WABIN = 196 * MiB, WS_WABOUT = WS_WABIN + (size_t)AB_IN * D * 2, WS_WFFNGU = WS_WABOUT + (size_t)D * D * 2, WS_WFFND = WS_WFFNGU + (size_t)2 * DFF * D * 2;
constexpr size_t WS_PAB = 219 * MiB, WS_MIX = 293 * MiB, WS_ACT0 = 326 * MiB, WS_QR = 416 * MiB, WS_KR = 433 * MiB, WS_VT = 438 * MiB, WS_PART = 443 * MiB;
constexpr size_t WS_Z = 196 * MiB, WS_XBCR = 261 * MiB, WS_STATES = 261 * MiB, WS_DTRAW = 391 * MiB, WS_DTS = 396 * MiB, WS_XT = 405 * MiB, WS_BT = 470 * MiB, WS_BM = 487 * MiB, WS_CM = 503 * MiB + 512 * 1024;
constexpr size_t DTS_STRIDE = (size_t)32 * MT * 4;
static_assert(WS_X + (size_t)MT * D * 2 <= WS_H && WS_H + (size_t)MT * D * 2 <= WS_WMOE, "X / H map");
static_assert(WS_WMOE + (size_t)NEXP * 2 * FFE * D * 2 <= WS_H2S && WS_H2S + (size_t)MOE_ROWS * D * 2 <= WS_ACTM && WS_ACTM + (size_t)MOE_ROWS * FFE * 2 <= WS_H2 && WS_H2 + (size_t)L * D * 2 <= WS_END, "moe map");
static_assert(WS_YPART >= WS_WMOE + (size_t)NEXP * D * FFE * 2 && WS_YPART + (size_t)7 * 2048 * D * 4 <= WS_H2S, "moe map 2");
static_assert(WS_WSSDOUT + (size_t)D * DIN * 2 <= WS_WABIN && WS_WFFND + (size_t)D * DFF * 2 <= WS_PAB, "weights map");
static_assert(WS_PAB + (size_t)MT * AB_IN * 2 <= WS_MIX && WS_MIX + (size_t)MT * D * 2 <= WS_ACT0 && WS_ACT0 + (size_t)MT * DFF * 2 <= WS_QR && WS_QR + (size_t)8 * MT * 64 * 2 <= WS_KR && WS_KR + (size_t)2 * MT * 64 * 2 <= WS_VT && WS_VT + (size_t)128 * MT * 2 <= WS_PART && WS_PART + (size_t)11 * LC * D * 4 <= WS_END, "layer0 map");
static_assert(WS_WSSDOUT + (size_t)D * DIN * 2 <= WS_Z && WS_Z + (size_t)MT * DIN * 2 <= WS_XBCR && WS_XBCR + (size_t)MT * XBCW * 2 <= WS_DTRAW && WS_STATES + (size_t)2 * NCH * 32 * 64 * 128 * 2 <= WS_DTRAW && WS_DTRAW + (size_t)MT * 64 * 4 <= WS_DTS && WS_DTS + 4 * DTS_STRIDE <= WS_XT && WS_XT + (size_t)DIN * MT * 2 <= WS_BT && WS_BT + (size_t)512 * MT * 2 <= WS_BM && WS_BM + (size_t)MT * 512 * 2 <= WS_CM && WS_CM + (size_t)MT * 512 * 2 <= WS_END, "ssd map");
static_assert(WS_PART + (size_t)11 * LC * D * 4 <= WS_BT && WS_PART >= WS_DTS + 4 * DTS_STRIDE || true, "PART is read by the layer-1 modulate before the SSD conv writes XT");
constexpr int CW_TMO = 0;
constexpr int CW_HIST = 1024;
constexpr int CW_BAR = 4096;

constexpr int RING_BYTES = 159744, LDSCTL_OFF = RING_BYTES, MISC_OFF = LDSCTL_OFF + 320, LDS_BYTES = 163840;

#define GAS __attribute__((address_space(1)))
#define LAS __attribute__((address_space(3)))
typedef unsigned short bf16;
typedef unsigned v4u __attribute__((ext_vector_type(4)));
typedef unsigned v2u __attribute__((ext_vector_type(2)));
typedef float f32x4 __attribute__((ext_vector_type(4)));
typedef GAS unsigned gu32;
#define RLX_AGENT __ATOMIC_RELAXED, __HIP_MEMORY_SCOPE_AGENT
#define LDS_WAIT() asm volatile("s_waitcnt lgkmcnt(0)" ::: "memory")
#define VM_WAIT() asm volatile("s_waitcnt vmcnt(0)" ::: "memory")
__device__ __forceinline__ unsigned pk2(float lo, float hi) { return pg8::cvt_pk_bf16(lo, hi); }
__device__ __forceinline__ float bflo(unsigned u) { return __uint_as_float(u << 16); }
__device__ __forceinline__ float bfhi(unsigned u) { return __uint_as_float(u & 0xffff0000u); }
__device__ __forceinline__ float bf1(bf16 b) { return __uint_as_float(((unsigned)b) << 16); }
__device__ __forceinline__ float sigmoid_f(float x) { return __builtin_amdgcn_rcpf(1.0f + __builtin_amdgcn_exp2f(-1.4426950408889634f * x)); }
__device__ __forceinline__ float softplus_f(float x) {
    const float y = __builtin_amdgcn_exp2f(-1.4426950408889634f * fabsf(x));
    const float l = y < 1.0e-3f ? y * (1.0f - 0.5f * y) : __builtin_amdgcn_logf(1.0f + y) * 0.6931471805599453f;
    return fmaxf(x, 0.f) + l; }

#define XB_TMO      128
#define XB_XCNT(j)  (256  + 64 * (j))
#define XB_XSUB(j)  (1280 + 64 * (j))
#define XB_XGEN(j)  (2304 + 64 * (j))
#define XB_TOP      3328
#define XB_TOPGEN   3392
#define XCD_BAR_WORDS 3456
#define XB_SPIN_CAP (1u << 18)
__device__ __forceinline__ unsigned xb_ld(unsigned* p)              { return __hip_atomic_load(p, __ATOMIC_RELAXED, __HIP_MEMORY_SCOPE_AGENT); }
__device__ __forceinline__ unsigned xb_add(unsigned* p, unsigned v) { return __hip_atomic_fetch_add(p, v, __ATOMIC_RELAXED, __HIP_MEMORY_SCOPE_AGENT); }
__device__ __forceinline__ unsigned xb_xcc_id() { return (unsigned)__builtin_amdgcn_s_getreg((3 << 11) | 20) & 0xFu; }
#define XB_SPIN(cond, bar) do { unsigned _sp = 0; while (cond) { __builtin_amdgcn_s_sleep(1); \
    if ((++_sp & 255u) == 0u) { if (xb_ld(&(bar)[XB_TMO])) break; if (_sp > XB_SPIN_CAP) { atomicAdd(&(bar)[XB_TMO], 1u); break; } } } } while (0)
struct XcdBarrier { unsigned* bar; unsigned x; volatile LAS unsigned* st; };
__device__ __forceinline__ XcdBarrier xcd_barrier_post(unsigned* bar, volatile LAS unsigned* st) {
    XcdBarrier b; b.bar = bar; b.x = xb_xcc_id(); b.st = st;
    if (threadIdx.x == 0) (void)xb_add(&bar[XB_XCNT(b.x)], 1u);
    return b;
}
__device__ __forceinline__ void xcd_barrier_complete(unsigned* bar, unsigned x, unsigned& nloc, unsigned& nx) {
    const unsigned G = gridDim.x * gridDim.y * gridDim.z;
    unsigned sum, cnt, mine, sp = 0u;
    for (;;) {
        sum = 0u; cnt = 0u; mine = 0u;
#pragma unroll
        for (unsigned j = 0; j < 16; ++j) { const unsigned c = xb_ld(&bar[XB_XCNT(j)]); sum += c; cnt += (c > 0u) ? 1u : 0u; mine = (j == x) ? c : mine; }
        if (sum == G) break;
        __builtin_amdgcn_s_sleep(1);
        if ((++sp & 255u) == 0u) { if (xb_ld(&bar[XB_TMO])) break; if (sp > XB_SPIN_CAP) { atomicAdd(&bar[XB_TMO], 1u); break; } }
    }
    nloc = mine > 0u ? mine : 1u; nx = cnt > 0u ? cnt : 1u;
}
__device__ __forceinline__ void xcd_barrier(const XcdBarrier& b) {
    asm volatile("s_waitcnt vmcnt(0)" ::: "memory");
    __syncthreads();
    if (threadIdx.x == 0) {
        unsigned* bar = b.bar;
        __builtin_amdgcn_s_waitcnt(0);
        unsigned nloc = b.st[0], nx = b.st[1];
        if (nloc == 0u) { xcd_barrier_complete(bar, b.x, nloc, nx); b.st[0] = nloc; b.st[1] = nx; }
        const unsigned old = xb_add(&bar[XB_XSUB(b.x)], 1u);
        const unsigned gen = old / nloc;
        if (old + 1u == (gen + 1u) * nloc) {
            __builtin_amdgcn_fence(__ATOMIC_RELEASE, "agent");
            asm volatile("s_waitcnt vmcnt(0)" ::: "memory");
            const unsigned og = xb_add(&bar[XB_TOP], 1u);
            const unsigned tg = og / nx;
            if (og + 1u == (tg + 1u) * nx) xb_add(&bar[XB_TOPGEN], 1u);
            else XB_SPIN(xb_ld(&bar[XB_TOPGEN]) == tg, bar);
            __builtin_amdgcn_fence(__ATOMIC_ACQUIRE, "agent");
            xb_add(&bar[XB_XGEN(b.x)], 1u);
            asm volatile("s_waitcnt vmcnt(0)" ::: "memory");
        } else {
            XB_SPIN(xb_ld(&bar[XB_XGEN(b.x)]) == gen, bar);
            __builtin_amdgcn_fence(__ATOMIC_ACQUIRE, "agent");
            asm volatile("s_waitcnt vmcnt(0)" ::: "memory");
        }
    }
    __syncthreads();
}

struct Frame {
    LAS unsigned char* lds;
    int tid, lane, wave, vcu, G;
    const float* in[30]; float* out; unsigned char* ws;
};
enum { I_X = 0, I_C, I_CTX, I_CCTX, I_ADAW, I_ADAB, I_N1G, I_N2G, I_ABWIN, I_ABCONV, I_ABSINK, I_ABWOUT, I_FFNG, I_FFNU, I_FFND, I_SSDWIN, I_SSDCW, I_SSDCB,
       I_DTBF, I_DTBB, I_ALOGF, I_ALOGB, I_SSDD, I_SSDNG, I_SSDWOUT, I_ROUTER, I_MOEG, I_MOEU, I_MOED, I_FINALG };
template <int CTRL> __device__ __forceinline__ float dpp_add(float v) { return v + __int_as_float(__builtin_amdgcn_update_dpp(0, __float_as_int(v), CTRL, 0xf, 0xf, true)); }
__device__ __forceinline__ float wave_sum(float v) {
    v = dpp_add<0xB1>(v);
    v = dpp_add<0x4E>(v);
    v = dpp_add<0x141>(v);
    v = dpp_add<0x140>(v);
    const int iv = __float_as_int(v);
    return (__int_as_float(__builtin_amdgcn_readlane(iv, 0)) + __int_as_float(__builtin_amdgcn_readlane(iv, 16))) + (__int_as_float(__builtin_amdgcn_readlane(iv, 32)) + __int_as_float(__builtin_amdgcn_readlane(iv, 48)));
}
constexpr int M_SH1 = 0, M_SC1 = 1024, M_G1 = 2048, M_SH2 = 3072, M_SC2 = 4096, M_G2 = 5120;
__device__ __forceinline__ const float* modp(const Frame& F, int layer, int s) { return (const float*)(F.ws + WS_MOD) + (size_t)(layer * 2 + s) * 6144; }

__device__ __forceinline__ void tr_load(const float* W, int N, int k0, int n0, int lane, f32x4 (&w)[8]) {
#pragma unroll
    for (int i = 0; i < 8; ++i) w[i] = __builtin_nontemporal_load((const GAS f32x4*)(W + (size_t)(k0 + (lane >> 3) + 8 * i) * N + n0 + 4 * (lane & 7)));
}
__device__ __forceinline__ void tr_finish(const f32x4 (&w)[8], bf16* WT, int Kdst, int k0, int drow0, LAS float* scr, int lane) {
#pragma unroll
    for (int i = 0; i < 8; ++i) { LAS float* d = scr + ((lane >> 3) + 8 * i) * 33 + 4 * (lane & 7); d[0] = w[i].x; d[1] = w[i].y; d[2] = w[i].z; d[3] = w[i].w; }
    LDS_WAIT(); asm volatile("" ::: "memory");
    const int c = lane & 7;
#pragma unroll
    for (int j = 0; j < 4; ++j) { const int n = (lane >> 3) + 8 * j; const LAS float* s = scr + (8 * c) * 33 + n;
        v4u o; o.x = pk2(s[0 * 33], s[1 * 33]); o.y = pk2(s[2 * 33], s[3 * 33]); o.z = pk2(s[4 * 33], s[5 * 33]); o.w = pk2(s[6 * 33], s[7 * 33]);
        __builtin_nontemporal_store(o, (GAS v4u*)(WT + (size_t)(drow0 + n) * Kdst + k0 + 8 * c)); }
    LDS_WAIT(); asm volatile("" ::: "memory");
}
__device__ __forceinline__ void tr_item(const float* W, int N, bf16* WT, int Kdst, int k0, int n0, int drow0, LAS float* scr, int lane) {
    { f32x4 w[8];
#pragma unroll
      for (int i = 0; i < 8; ++i) w[i] = __builtin_nontemporal_load((const GAS f32x4*)(W + (size_t)(k0 + (lane >> 3) + 8 * i) * N + n0 + 4 * (lane & 7)));
#pragma unroll
      for (int i = 0; i < 8; ++i) { LAS float* d = scr + ((lane >> 3) + 8 * i) * 33 + 4 * (lane & 7); d[0] = w[i].x; d[1] = w[i].y; d[2] = w[i].z; d[3] = w[i].w; } }
    LDS_WAIT(); asm volatile("" ::: "memory");
    const int c = lane & 7;
#pragma unroll
    for (int j = 0; j < 4; ++j) { const int n = (lane >> 3) + 8 * j; const LAS float* s = scr + (8 * c) * 33 + n;
        v4u o; o.x = pk2(s[0 * 33], s[1 * 33]); o.y = pk2(s[2 * 33], s[3 * 33]); o.z = pk2(s[4 * 33], s[5 * 33]); o.w = pk2(s[6 * 33], s[7 * 33]);
        __builtin_nontemporal_store(o, (GAS v4u*)(WT + (size_t)(drow0 + n) * Kdst + k0 + 8 * c)); }
    LDS_WAIT(); asm volatile("" ::: "memory");
}
__device__ __forceinline__ void tr_matrix(const Frame& F, const float* W, int K, int N, bf16* WT, int mode, int& first, int gw = -1, int NGW = 0) {
    LAS float* scr = (LAS float*)(F.lds + F.wave * 16384);
    if (gw < 0) { gw = F.vcu * NWAVES + F.wave; NGW = F.G * NWAVES; }
    const int nblk = N / 32, nitems = (K / 64) * nblk;
    int it = gw - (first % NGW); if (it < 0) it += NGW;
    for (; it < nitems; it += NGW) {
        const int kb = it / nblk, nb = it % nblk, n0 = 32 * nb;
        const int drow0 = mode == 0 ? n0 : ((n0 >> 7) * 256 + (n0 & 127) + (mode == 2 ? 128 : 0));
        tr_item(W, N, WT, K, 64 * kb, n0, drow0, scr, F.lane);
    }
    first += nitems;
}

__device__ __forceinline__ void ph_convert_ffn(Frame& F, int gw, int NGW) {
    int first = 0;
    tr_matrix(F, F.in[I_FFNG], D, DFF, (bf16*)(F.ws + WS_WFFNGU), 1, first, gw, NGW);
    tr_matrix(F, F.in[I_FFNU], D, DFF, (bf16*)(F.ws + WS_WFFNGU), 2, first, gw, NGW);
    tr_matrix(F, F.in[I_FFND], DFF, D, (bf16*)(F.ws + WS_WFFND), 0, first, gw, NGW);
}
__device__ __forceinline__ void ph_convert_ssd(Frame& F, int gw, int NGW) {
    int first = 0;
    tr_matrix(F, F.in[I_SSDWIN], D, SSD_IN_REAL, (bf16*)(F.ws + WS_WSSDIN), 0, first, gw, NGW);
    tr_matrix(F, F.in[I_SSDWOUT], DIN, D, (bf16*)(F.ws + WS_WSSDOUT), 0, first, gw, NGW);
    { v4u* p = (v4u*)((bf16*)(F.ws + WS_WSSDIN) + (size_t)SSD_IN_REAL * D); const int n16 = (SSD_INP - SSD_IN_REAL) * D * 2 / 16;
      for (int i = gw * 64 + F.lane; i < n16; i += NGW * 64) p[i] = (v4u){0u, 0u, 0u, 0u}; }
}
__device__ __forceinline__ void ph_prologue(Frame& F) {
    LAS float* scx = (LAS float*)F.lds;
    LAS float* scc = scx + 1024;
    LAS float* red = scc + 1024;
    const float* c = F.in[I_C]; const float* cc = F.in[I_CCTX];
    for (int i = F.tid; i < 1024; i += NTHR) { const float a = c[i], b = cc[i]; scx[i] = a * sigmoid_f(a); scc[i] = b * sigmoid_f(b); }
    __syncthreads();
    float* MOD = (float*)(F.ws + WS_MOD);
    for (int u = F.vcu; u < 192; u += F.G) {
        const int layer = u / 96, n0 = (u % 96) * 64;
        const float* W = F.in[I_ADAW] + (size_t)layer * 1024 * 6144 + n0 + F.lane;
        float ax = 0.f, ac = 0.f; const int kb = F.wave * 128;
#pragma unroll 1
        for (int k0 = 0; k0 < 128; k0 += 32) { float w[32];
#pragma unroll
            for (int k = 0; k < 32; ++k) w[k] = __builtin_nontemporal_load(W + (size_t)(kb + k0 + k) * 6144);
#pragma unroll
            for (int k = 0; k < 32; ++k) { ax += scx[kb + k0 + k] * w[k]; ac += scc[kb + k0 + k] * w[k]; } }
        red[(F.wave * 2 + 0) * 64 + F.lane] = ax; red[(F.wave * 2 + 1) * 64 + F.lane] = ac;
        __syncthreads();
        if (F.tid < 128) { const int s = F.tid >> 6, l = F.tid & 63; float t = 0.f;
#pragma unroll
            for (int w = 0; w < 8; ++w) t += red[(w * 2 + s) * 64 + l];
            MOD[(size_t)(layer * 2 + s) * 6144 + n0 + l] = t + F.in[I_ADAB][layer * 6144 + n0 + l]; }
        __syncthreads();
    }
    {
        float* ct = (float*)(F.ws + WS_ROPE); float* st = ct + 4096;
        for (int idx = F.vcu * NTHR + F.tid; idx < 4096; idx += F.G * NTHR) { const int pos = idx >> 4, i = idx & 15;
            const float inv = (float)pow(10000.0, -(double)i / 16.0); const float ang = (float)pos * inv;
            ct[idx] = (float)cos((double)ang); st[idx] = (float)sin((double)ang); }
    }
    __syncthreads();
    int first = 0;
    tr_matrix(F, F.in[I_ABWIN], D, AB_IN, (bf16*)(F.ws + WS_WABIN), 0, first);
    tr_matrix(F, F.in[I_ABWOUT], D, D, (bf16*)(F.ws + WS_WABOUT), 0, first);
}
constexpr int MOE_GU_ITEMS = NEXP * 2 * (D / 64) * (FFE / 32);
struct GuItem { const float* W; bf16* WT; int k0, n0, drow0; };
__device__ __forceinline__ GuItem gu_item(const Frame& F, int it) {
    constexpr int PER_M = (D / 64) * (FFE / 32), NB = FFE / 32;
    const int e = it / (2 * PER_M), rem = it % (2 * PER_M), mat = rem / PER_M, idx = rem % PER_M, kb = idx / NB, n0 = 32 * (idx % NB);
    GuItem g; g.W = (mat ? F.in[I_MOEU] : F.in[I_MOEG]) + (size_t)e * D * FFE; g.WT = (bf16*)(F.ws + WS_WMOE) + (size_t)e * 2 * FFE * D;
    g.k0 = 64 * kb; g.n0 = n0; g.drow0 = (n0 >> 7) * 256 + (n0 & 127) + (mat ? 128 : 0); return g;
}
__device__ __forceinline__ void moe_gu_convert(Frame& F, int lo, int hi, int gw, int NGW) {
    LAS float* scr = (LAS float*)(F.lds + F.wave * 16384);
    int it = lo + gw; if (it >= hi) return;
    f32x4 wa[8], wb[8];
    GuItem ga = gu_item(F, it), gb = ga; tr_load(ga.W, FFE, ga.k0, ga.n0, F.lane, wa);
    for (;;) {
        const int itb = it + NGW; const bool hb = itb < hi;
        if (hb) { gb = gu_item(F, itb); tr_load(gb.W, FFE, gb.k0, gb.n0, F.lane, wb); }
        tr_finish(wa, ga.WT, D, ga.k0, ga.drow0, scr, F.lane);
        if (!hb) break;
        it = itb + NGW; const bool ha = it < hi;
        if (ha) { ga = gu_item(F, it); tr_load(ga.W, FFE, ga.k0, ga.n0, F.lane, wa); }
        tr_finish(wb, gb.WT, D, gb.k0, gb.drow0, scr, F.lane);
        if (!ha) break;
    }
}
__device__ __forceinline__ void idle_round_convert(Frame& F, int nunits, int lo, int hi) {
    const int full = nunits / F.G, nbusy = nunits - full * F.G;
    if ((int)blockIdx.x >= nbusy) moe_gu_convert(F, lo, hi, ((int)blockIdx.x - nbusy) * NWAVES + F.wave, (F.G - nbusy) * NWAVES);
}


template <bool BF> __device__ __forceinline__ void load_row4(const void* row, int lane, f32x4 (&v)[4]) {
    if (BF) { const GAS v2u* p = (const GAS v2u*)row + lane;
#pragma unroll
        for (int j = 0; j < 4; ++j) { const v2u a = p[64 * j]; v[j] = (f32x4){bflo(a.x), bfhi(a.x), bflo(a.y), bfhi(a.y)}; } }
    else { const GAS f32x4* p = (const GAS f32x4*)row + lane;
#pragma unroll
        for (int j = 0; j < 4; ++j) v[j] = __builtin_nontemporal_load(p + 64 * j); }
}
template <bool LAT_BF, bool CTX_BF, int NPART>
__device__ __forceinline__ void ph_modulate(Frame& F, const void* src0, const void* src1, const float* gain, const float* mx, const float* mc, int osh, int osc, bf16* H, int nrows,
                                            const float* part, const float* gatec, bf16* xw) {
    const int gw = F.vcu * NWAVES + F.wave, NGW = F.G * NWAVES;
    f32x4 ca[4], cb[4];
#pragma unroll
    for (int j = 0; j < 4; ++j) { const int c = 4 * (64 * j + F.lane); ca[j] = *(const f32x4*)(gain + c) * (*(const f32x4*)(mx + osc + c) + 1.0f); cb[j] = *(const f32x4*)(mx + osh + c); }
    for (int r0 = gw; r0 < nrows; r0 += 2 * NGW) {
        int rr[2]; f32x4 v[2][4];
#pragma unroll
        for (int k = 0; k < 2; ++k) { const int r = r0 + k * NGW; rr[k] = r < nrows ? r : r0;
            if (rr[k] < L) load_row4<LAT_BF>((const char*)src0 + (size_t)rr[k] * D * (LAT_BF ? 2 : 4), F.lane, v[k]);
            else load_row4<CTX_BF>((const char*)src1 + (size_t)(rr[k] - L) * D * (CTX_BF ? 2 : 4), F.lane, v[k]); }
#pragma unroll
        for (int k = 0; k < 2; ++k) { const int r = rr[k];
            if (NPART > 0 && r >= L) {
#pragma unroll
                for (int j = 0; j < 4; ++j) { const int c = 4 * (64 * j + F.lane); f32x4 s = (f32x4){0.f, 0.f, 0.f, 0.f};
#pragma unroll
                    for (int q = 0; q < NPART; ++q) s += *(const f32x4*)(part + ((size_t)q * LC + (r - L)) * D + c);
                    v[k][j] += *(const f32x4*)(gatec + c) * s;
                    if (xw) { v2u o; o.x = pk2(v[k][j].x, v[k][j].y); o.y = pk2(v[k][j].z, v[k][j].w); *(GAS v2u*)(xw + (size_t)r * D + c) = o; } }
            }
            float s2 = 0.f;
#pragma unroll
            for (int j = 0; j < 4; ++j) s2 += (v[k][j].x * v[k][j].x + v[k][j].y * v[k][j].y) + (v[k][j].z * v[k][j].z + v[k][j].w * v[k][j].w);
            const float rstd = __builtin_amdgcn_rsqf(wave_sum(s2) * (1.0f / D) + EPS);
            GAS v2u* o8 = (GAS v2u*)(H + (size_t)r * D) + F.lane;
#pragma unroll
            for (int j = 0; j < 4; ++j) { const int c = 4 * (64 * j + F.lane);
                f32x4 A = ca[j], B = cb[j];
                if (r >= L) { A = *(const f32x4*)(gain + c) * (*(const f32x4*)(mc + osc + c) + 1.0f); B = *(const f32x4*)(mc + osh + c); }
                const f32x4 y = v[k][j] * rstd * A + B;
                v2u o; o.x = pk2(y.x, y.y); o.y = pk2(y.z, y.w); o8[64 * j] = o; }
        }
    }
}

constexpr float QSCL = 0.125f * 1.4426950408889634f;
__device__ __forceinline__ void ph_ab_elem(Frame& F) {
    const bf16* PAB = (const bf16*)(F.ws + WS_PAB); bf16* MIX = (bf16*)(F.ws + WS_MIX);
    bf16* QR = (bf16*)(F.ws + WS_QR); bf16* KR = (bf16*)(F.ws + WS_KR); bf16* VT = (bf16*)(F.ws + WS_VT);
    const float* ct = (const float*)(F.ws + WS_ROPE); const float* st = ct + 4096;
    const int lane = F.lane;
    float cw[3][8];
#pragma unroll
    for (int k = 0; k < 3; ++k)
#pragma unroll
        for (int j = 0; j < 8; ++j) cw[k][j] = F.in[I_ABCONV][k * 512 + 8 * lane + j];
    LAS unsigned char* vl = F.lds;
    for (int tile = F.vcu; tile < MT / 16; tile += F.G) {
        const int r0 = tile * 16; const bool isctx = r0 >= L; const int slo = isctx ? L : 0, shi = isctx ? MT : L;
        for (int rr = 0; rr < 2; ++rr) {
            const int r = r0 + F.wave * 2 + rr;
            float acc[8];
#pragma unroll
            for (int j = 0; j < 8; ++j) acc[j] = 0.f;
#pragma unroll
            for (int k = 0; k < 3; ++k) { const int q = r + k - 1;
                if (q >= slo && q < shi) { const v4u gc = *(const GAS v4u*)(PAB + (size_t)q * AB_IN + 512 + 8 * lane), ha = *(const GAS v4u*)(PAB + (size_t)q * AB_IN + 1024 + 8 * lane);
                    acc[0] += cw[k][0] * bflo(gc.x) * bflo(ha.x); acc[1] += cw[k][1] * bfhi(gc.x) * bfhi(ha.x); acc[2] += cw[k][2] * bflo(gc.y) * bflo(ha.y); acc[3] += cw[k][3] * bfhi(gc.y) * bfhi(ha.y);
                    acc[4] += cw[k][4] * bflo(gc.z) * bflo(ha.z); acc[5] += cw[k][5] * bfhi(gc.z) * bfhi(ha.z); acc[6] += cw[k][6] * bflo(gc.w) * bflo(ha.w); acc[7] += cw[k][7] * bfhi(gc.w) * bfhi(ha.w); } }
            { const v4u gb = *(const GAS v4u*)(PAB + (size_t)r * AB_IN + 8 * lane); v4u o;
              o.x = pk2(acc[0] * bflo(gb.x), acc[1] * bfhi(gb.x)); o.y = pk2(acc[2] * bflo(gb.y), acc[3] * bfhi(gb.y)); o.z = pk2(acc[4] * bflo(gb.z), acc[5] * bfhi(gb.z)); o.w = pk2(acc[6] * bflo(gb.w), acc[7] * bfhi(gb.w));
              *(GAS v4u*)(MIX + (size_t)r * D + 8 * lane) = o; }
            const int sub = lane & 7, axis = sub >> 2, half = (sub >> 1) & 1;
            const int pos = axis == 0 ? (r >> 6) : (r & 63);
            f32x4 c0 = (f32x4){1.f, 1.f, 1.f, 1.f}, c1 = c0, s0 = (f32x4){0.f, 0.f, 0.f, 0.f}, s1 = s0;
            if (!isctx) { const float* cp = ct + pos * 16 + 8 * (lane & 1); const float* sp = st + pos * 16 + 8 * (lane & 1);
                c0 = *(const f32x4*)cp; c1 = *(const f32x4*)(cp + 4); s0 = *(const f32x4*)sp; s1 = *(const f32x4*)(sp + 4);
                if (half == 0) { s0 = -s0; s1 = -s1; } }
            {
                const v4u a = *(const GAS v4u*)(PAB + (size_t)r * AB_IN + 1536 + 8 * lane);
                v4u p; p.x = (unsigned)__builtin_amdgcn_update_dpp(0, (int)a.x, 0x4E, 0xf, 0xf, true); p.y = (unsigned)__builtin_amdgcn_update_dpp(0, (int)a.y, 0x4E, 0xf, 0xf, true); p.z = (unsigned)__builtin_amdgcn_update_dpp(0, (int)a.z, 0x4E, 0xf, 0xf, true); p.w = (unsigned)__builtin_amdgcn_update_dpp(0, (int)a.w, 0x4E, 0xf, 0xf, true);
                const f32x4 qc0 = c0 * QSCL, qc1 = c1 * QSCL, qs0 = s0 * QSCL, qs1 = s1 * QSCL;
                v4u o; o.x = pk2(bflo(a.x) * qc0.x + bflo(p.x) * qs0.x, bfhi(a.x) * qc0.y + bfhi(p.x) * qs0.y); o.y = pk2(bflo(a.y) * qc0.z + bflo(p.y) * qs0.z, bfhi(a.y) * qc0.w + bfhi(p.y) * qs0.w);
                o.z = pk2(bflo(a.z) * qc1.x + bflo(p.z) * qs1.x, bfhi(a.z) * qc1.y + bfhi(p.z) * qs1.y); o.w = pk2(bflo(a.w) * qc1.z + bflo(p.w) * qs1.z, bfhi(a.w) * qc1.w + bfhi(p.w) * qs1.w);
                *(GAS v4u*)(QR + ((size_t)(lane >> 3) * MT + r) * 64 + 8 * sub) = o;
            }
            {
                const int kl = lane & 15;
                const v4u a = *(const GAS v4u*)(PAB + (size_t)r * AB_IN + 2048 + 8 * kl);
                v4u p; p.x = (unsigned)__builtin_amdgcn_update_dpp(0, (int)a.x, 0x4E, 0xf, 0xf, true); p.y = (unsigned)__builtin_amdgcn_update_dpp(0, (int)a.y, 0x4E, 0xf, 0xf, true); p.z = (unsigned)__builtin_amdgcn_update_dpp(0, (int)a.z, 0x4E, 0xf, 0xf, true); p.w = (unsigned)__builtin_amdgcn_update_dpp(0, (int)a.w, 0x4E, 0xf, 0xf, true);
                v4u o; o.x = pk2(bflo(a.x) * c0.x + bflo(p.x) * s0.x, bfhi(a.x) * c0.y + bfhi(p.x) * s0.y); o.y = pk2(bflo(a.y) * c0.z + bflo(p.y) * s0.z, bfhi(a.y) * c0.w + bfhi(p.y) * s0.w);
                o.z = pk2(bflo(a.z) * c1.x + bflo(p.z) * s1.x, bfhi(a.z) * c1.y + bfhi(p.z) * s1.y); o.w = pk2(bflo(a.w) * c1.z + bflo(p.w) * s1.z, bfhi(a.w) * c1.w + bfhi(p.w) * s1.w);
                if (lane < 16) *(GAS v4u*)(KR + ((size_t)(lane >> 3) * MT + r) * 64 + 8 * sub) = o;
            }
        }
        if (F.tid < 256) { const int p = F.tid, row = p >> 4, c8 = (p & 15) * 8;
            *(LAS v4u*)(vl + row * 272 + c8 * 2) = *(const GAS v4u*)(PAB + (size_t)(r0 + row) * AB_IN + 2176 + c8); }
        __syncthreads();
        if (F.tid < 256) { const int p = F.tid, ch = p >> 1, rg = p & 1;
            const LAS bf16* s = (const LAS bf16*)(vl + (8 * rg) * 272 + ch * 2);
            v4u o; o.x = (unsigned)s[0] | ((unsigned)s[136] << 16); o.y = (unsigned)s[2 * 136] | ((unsigned)s[3 * 136] << 16); o.z = (unsigned)s[4 * 136] | ((unsigned)s[5 * 136] << 16); o.w = (unsigned)s[6 * 136] | ((unsigned)s[7 * 136] << 16);
            *(GAS v4u*)(VT + (size_t)ch * MT + r0 + 8 * rg) = o; }
        __syncthreads();
    }
}


__device__ __forceinline__ void ph_ssd_conv(Frame& F) {
    const bf16* XB = (const bf16*)(F.ws + WS_XBCR);
    bf16* XT = (bf16*)(F.ws + WS_XT); bf16* BT = (bf16*)(F.ws + WS_BT); bf16* BMm = (bf16*)(F.ws + WS_BM); bf16* CMm = (bf16*)(F.ws + WS_CM);
    const float* cwp = F.in[I_SSDCW]; const float* cbp = F.in[I_SSDCB];
    LAS unsigned char* tl = F.lds;
    { const float* DR = (const float*)(F.ws + WS_DTRAW); float* DTF = (float*)(F.ws + WS_DTS); float* DTB = DTF + (size_t)32 * MT;
      const int gw = F.vcu * NWAVES + F.wave, NGW = F.G * NWAVES;
      for (int task = gw; task < (MT / 64) * 4; task += NGW) { const int tb = task >> 2, jq = task & 3; const int t = tb * 64 + F.lane; const float* row = DR + (size_t)t * 64;
#pragma unroll
          for (int j4 = 4 * jq; j4 < 4 * jq + 4; ++j4) { const f32x4 r = *(const f32x4*)(row + 4 * j4);
#pragma unroll
              for (int q = 0; q < 4; ++q) { const int j = 4 * j4 + q; const float v = softplus_f(r[q] + (j < 32 ? F.in[I_DTBF][j] : F.in[I_DTBB][j - 32]));
                  if (j < 32) DTF[(size_t)j * MT + t] = v; else DTB[(size_t)(j - 32) * MT + t] = v; } } } }
    LAS float* cwl = (LAS float*)(F.lds + 130 * 272 + 64);
    for (int i = F.tid; i < 3 * XBCW; i += NTHR) cwl[i] = cwp[i];
    for (int i = F.tid; i < XBCW; i += NTHR) cwl[3 * XBCW + i] = cbp[i];
    __syncthreads();
    const int ntiles = NCH * 24;
    v4u pre[5];
#define CONV_LOAD(tile_) do { const int c_ = (tile_) / 24, cb_ = (tile_) % 24, t0_ = c_ * 128, ch0_ = cb_ * 128; const int slo_ = c_ < 128 ? 0 : L, shi_ = c_ < 128 ? L : MT; \
        _Pragma("unroll") for (int i_ = 0; i_ < 5; ++i_) { const int p_ = F.tid + NTHR * i_, row_ = p_ >> 4, c8_ = (p_ & 15) * 8; const int t_ = t0_ - 1 + row_; \
            pre[i_] = (v4u){0u, 0u, 0u, 0u}; if (p_ < 130 * 16 && t_ >= slo_ && t_ < shi_) pre[i_] = __builtin_nontemporal_load((const GAS v4u*)(XB + (size_t)t_ * XBCW + ch0_ + c8_)); } } while (0)
    int tile = F.vcu;
    if (tile < ntiles) CONV_LOAD(tile);
    for (; tile < ntiles; tile += F.G) {
        const int c = tile / 24, cb = tile % 24, t0 = c * 128, ch0 = cb * 128;
#pragma unroll
        for (int i = 0; i < 5; ++i) { const int p = F.tid + NTHR * i, row = p >> 4, c8 = (p & 15) * 8; if (p < 130 * 16) *(LAS v4u*)(tl + row * 272 + ((c8 * 2) ^ (((row >> 3) & 7) << 4))) = pre[i]; }
        __syncthreads();
        if (tile + F.G < ntiles) CONV_LOAD(tile + F.G);
        if (cb < 20) {
            bf16* dst = BT + (size_t)(ch0 - 2048) * MT;
#pragma unroll
            for (int i = 0; i < 4; ++i) { const int p = F.tid + NTHR * i, ch = p >> 4, tg = p & 15;
                const float w0 = cwl[ch0 + ch], w1 = cwl[XBCW + ch0 + ch], w2 = cwl[2 * XBCW + ch0 + ch], bb = cwl[3 * XBCW + ch0 + ch];
                float xin[10];
#pragma unroll
                for (int j = 0; j < 10; ++j) { const int row = 8 * tg + j; xin[j] = bf1(*(const LAS bf16*)(tl + row * 272 + ((ch * 2) ^ (((row >> 3) & 7) << 4)))); }
                float y[8];
#pragma unroll
                for (int j = 0; j < 8; ++j) { const float a = w0 * xin[j] + w1 * xin[j + 1] + w2 * xin[j + 2] + bb; y[j] = a * sigmoid_f(a); }
                v4u o; o.x = pk2(y[0], y[1]); o.y = pk2(y[2], y[3]); o.z = pk2(y[4], y[5]); o.w = pk2(y[6], y[7]);
                if (cb < 16) { const int cg_ = ch0 + ch, hd = cg_ >> 6, p_ = cg_ & 63, ptq = 2 * (p_ >> 5) + ((p_ >> 2) & 1), rq = 4 * ((p_ >> 3) & 3) + (p_ & 3);
                    *(GAS v4u*)(XT + ((size_t)(((hd * NCH + c) * 4 + (tg >> 2)) * 4 + ptq) * 16 + rq) * 32 + 8 * (tg & 3)) = o; }
                else *(GAS v4u*)(dst + (size_t)ch * MT + t0 + 8 * tg) = o; }
        }
        if (cb >= 16) {
            bf16* dst = cb < 20 ? BMm + (ch0 - 2048) : CMm + (ch0 - 2560);
#pragma unroll
            for (int i = 0; i < 4; ++i) { const int p = F.tid + NTHR * i, row = p >> 4, cg = p & 15;
                const v4u a0 = *(const LAS v4u*)(tl + row * 272 + ((cg * 16) ^ (((row >> 3) & 7) << 4))), a1 = *(const LAS v4u*)(tl + (row + 1) * 272 + ((cg * 16) ^ ((((row + 1) >> 3) & 7) << 4))), a2 = *(const LAS v4u*)(tl + (row + 2) * 272 + ((cg * 16) ^ ((((row + 2) >> 3) & 7) << 4)));
                const LAS float* w0 = cwl + ch0 + 8 * cg; const LAS float* w1 = w0 + XBCW; const LAS float* w2 = w1 + XBCW; const LAS float* bb = w2 + XBCW;
                float y[8];
#define CV(j, f, q) { const float a = w0[j] * f(a0.q) + w1[j] * f(a1.q) + w2[j] * f(a2.q) + bb[j]; y[j] = a * sigmoid_f(a); }
                CV(0, bflo, x) CV(1, bfhi, x) CV(2, bflo, y) CV(3, bfhi, y) CV(4, bflo, z) CV(5, bfhi, z) CV(6, bflo, w) CV(7, bfhi, w)
#undef CV
                v4u o; o.x = pk2(y[0], y[1]); o.y = pk2(y[2], y[3]); o.z = pk2(y[4], y[5]); o.w = pk2(y[6], y[7]);
                *(GAS v4u*)(dst + (size_t)(t0 + row) * 512 + 8 * cg) = o; }
        }
        __syncthreads();
    }
#undef CONV_LOAD
}

__device__ __forceinline__ void ph_moe_route(Frame& F) {
    LAS float* R = (LAS float*)F.lds;
    for (int i = F.tid; i < 8192; i += NTHR) R[(i & 7) * 1024 + (i >> 3)] = F.in[I_ROUTER][i];
    __syncthreads();
    const bf16* X = (const bf16*)(F.ws + WS_X); float* RS = (float*)(F.ws + WS_RSTD);
    int* TE = (int*)(F.ws + WS_TOKE); float* TW = (float*)(F.ws + WS_TOKW); int* HIST = (int*)(F.ws + WS_CTL) + CW_HIST;
    const float* gain = F.in[I_N2G] + D; const float* m = modp(F, 1, 0);
    const int gw = F.vcu * NWAVES + F.wave, NGW = F.G * NWAVES;
    f32x4 ca[4], cb[4];
#pragma unroll
    for (int j = 0; j < 4; ++j) { const int c = 4 * (64 * j + F.lane); ca[j] = *(const f32x4*)(gain + c) * (*(const f32x4*)(m + M_SC2 + c) + 1.0f); cb[j] = *(const f32x4*)(m + M_SH2 + c); }
    for (int r = gw; r < L; r += NGW) {
        f32x4 v[4]; float s2 = 0.f;
        load_row4<true>(X + (size_t)r * D, F.lane, v);
#pragma unroll
        for (int j = 0; j < 4; ++j) s2 += (v[j].x * v[j].x + v[j].y * v[j].y) + (v[j].z * v[j].z + v[j].w * v[j].w);
        const float rstd = 1.0f / sqrtf(wave_sum(s2) * (1.0f / D) + EPS);
        float lg[8];
#pragma unroll
        for (int e = 0; e < 8; ++e) lg[e] = 0.f;
#pragma unroll
        for (int j = 0; j < 4; ++j) { const int c = 4 * (64 * j + F.lane);
            const f32x4 y = v[j] * rstd * ca[j] + cb[j];
#pragma unroll
            for (int e = 0; e < 8; ++e) { const f32x4 rr = *(const LAS f32x4*)(R + e * 1024 + c); lg[e] += (y.x * rr.x + y.y * rr.y) + (y.z * rr.z + y.w * rr.w); } }
#pragma unroll
        for (int e = 0; e < 8; ++e) lg[e] = wave_sum(lg[e]);
        int e0 = 0; float v0 = lg[0];
#pragma unroll
        for (int e = 1; e < 8; ++e) if (lg[e] > v0) { v0 = lg[e]; e0 = e; }
        int e1 = -1; float v1 = -3.0e38f;
#pragma unroll
        for (int e = 0; e < 8; ++e) if (e != e0 && lg[e] > v1) { v1 = lg[e]; e1 = e; }
        if (F.lane == 0) { const float ex = __expf(v1 - v0), w0 = 1.0f / (1.0f + ex); RS[r] = rstd;
            TE[2 * r] = e0; TE[2 * r + 1] = e1; TW[2 * r] = w0; TW[2 * r + 1] = ex * w0;
            atomicAdd(&HIST[(r >> 8) * 8 + e0], 1); atomicAdd(&HIST[(r >> 8) * 8 + e1], 1); }
    }
}
__device__ __forceinline__ void moe_segments(Frame& F, LAS int* hist, LAS int* cnt, LAS int* seg) {
    const int* HIST = (const int*)(F.ws + WS_CTL) + CW_HIST;
    if (F.tid < 512) hist[F.tid] = HIST[F.tid];
    __syncthreads();
    if (F.tid < 8) { int s = 0; for (int t = 0; t < 64; ++t) s += hist[t * 8 + F.tid]; cnt[F.tid] = s; }
    __syncthreads();
    if (F.tid == 0) { int s = 0; for (int e = 0; e < 8; ++e) { seg[e] = s; s += (cnt[e] + 255) & ~255; } seg[8] = s; }
    __syncthreads();
}
__device__ __forceinline__ void ph_moe_scatter(Frame& F) {
    LAS int* hist = (LAS int*)F.lds; LAS int* cnt = hist + 512; LAS int* seg = cnt + 8; LAS int* base = seg + 16; LAS int* wcnt = base + 8; LAS int* epos = wcnt + 64;
    moe_segments(F, hist, cnt, seg);
    const int* TE = (const int*)(F.ws + WS_TOKE); int* TP = (int*)(F.ws + WS_TOKP);
    const bf16* X = (const bf16*)(F.ws + WS_X); const float* RS = (const float*)(F.ws + WS_RSTD); bf16* H2S = (bf16*)(F.ws + WS_H2S);
    f32x4 ca[4], cb[4];
    { const float* gain = F.in[I_N2G] + D; const float* m = modp(F, 1, 0);
#pragma unroll
      for (int j = 0; j < 4; ++j) { const int c = 4 * (64 * j + F.lane); ca[j] = *(const f32x4*)(gain + c) * (*(const f32x4*)(m + M_SC2 + c) + 1.0f); cb[j] = *(const f32x4*)(m + M_SH2 + c); } }
    for (int uu = F.vcu; uu < 264; uu += F.G) {
        if (uu < 256) {
            const int u = uu >> 2, qtr = uu & 3;
            if (F.tid < 8) { int s = seg[F.tid]; for (int t = 0; t < u; ++t) s += hist[t * 8 + F.tid]; base[F.tid] = s; }
            const int ent = u * 512 + F.tid;
            const int ex = TE[ent];
            int rank = 0;
#pragma unroll
            for (int e = 0; e < 8; ++e) { const unsigned long long mk = __ballot(ex == e);
                if (ex == e) rank = __popcll(mk & ((1ull << F.lane) - 1ull));
                if (F.lane == 0) wcnt[F.wave * 8 + e] = __popcll(mk); }
            __syncthreads();
            int pos = base[ex] + rank;
            for (int w = 0; w < F.wave; ++w) pos += wcnt[w * 8 + ex];
            if (qtr == 0) TP[ent] = pos;
            epos[F.tid] = pos;
            __syncthreads();
            for (int t0_ = 64 * qtr + F.wave; t0_ < 64 * qtr + 64; t0_ += 2 * NWAVES) {
                f32x4 xv[2][4]; float rs[2]; int d0[2], d1[2];
#pragma unroll
                for (int k = 0; k < 2; ++k) { const int ti = t0_ + k * NWAVES, tok = u * 256 + ti; load_row4<true>(X + (size_t)tok * D, F.lane, xv[k]); rs[k] = RS[tok]; d0[k] = epos[2 * ti]; d1[k] = epos[2 * ti + 1]; }
#pragma unroll
                for (int k = 0; k < 2; ++k) { GAS v2u* o0 = (GAS v2u*)(H2S + (size_t)d0[k] * D) + F.lane; GAS v2u* o1 = (GAS v2u*)(H2S + (size_t)d1[k] * D) + F.lane;
#pragma unroll
                    for (int j = 0; j < 4; ++j) { const f32x4 y = xv[k][j] * rs[k] * ca[j] + cb[j]; v2u o; o.x = pk2(y.x, y.y); o.y = pk2(y.z, y.w); o0[64 * j] = o; o1[64 * j] = o; } } }
            __syncthreads();
        } else {
            const int e = uu - 256, lo = seg[e] + cnt[e], hi = seg[e + 1];
            GAS v4u* d = (GAS v4u*)(H2S + (size_t)lo * D); const int n16 = (hi - lo) * (D * 2 / 16);
            for (int i = F.tid; i < n16; i += NTHR) d[i] = (v4u){0u, 0u, 0u, 0u};
        }
    }
}
__device__ __forceinline__ void ph_final(Frame& F) {
    const bf16* X = (const bf16*)(F.ws + WS_X); const bf16* YO = (const bf16*)(F.ws + WS_H2S);
    const int* TP = (const int*)(F.ws + WS_TOKP); const float* TW = (const float*)(F.ws + WS_TOKW);
    const float* g2 = modp(F, 1, 0) + M_G2; const float* fg = F.in[I_FINALG];
    const float* YP = (const float*)(F.ws + WS_YPART);
    const int gw = F.vcu * NWAVES + F.wave, NGW = F.G * NWAVES;
    f32x4 cg[4], cf[4];
#pragma unroll
    for (int j = 0; j < 4; ++j) { const int c = 4 * (64 * j + F.lane); cg[j] = *(const f32x4*)(g2 + c); cf[j] = *(const f32x4*)(fg + c); }
    for (int r0 = gw; r0 < L; r0 += 2 * NGW) {
        int rr[2], pa[2], pb[2]; float wa[2], wb[2]; f32x4 xv[2][4]; v2u ya[2][4], yb[2][4];
#pragma unroll
        for (int k = 0; k < 2; ++k) { const int r = r0 + k * NGW; rr[k] = r < L ? r : r0; pa[k] = TP[2 * rr[k]]; pb[k] = TP[2 * rr[k] + 1]; wa[k] = TW[2 * rr[k]]; wb[k] = TW[2 * rr[k] + 1]; }
#pragma unroll
        for (int k = 0; k < 2; ++k) { load_row4<true>(X + (size_t)rr[k] * D, F.lane, xv[k]);
            const GAS v2u* y0 = (const GAS v2u*)(YO + (size_t)pa[k] * D) + F.lane; const GAS v2u* y1 = (const GAS v2u*)(YO + (size_t)pb[k] * D) + F.lane;
#pragma unroll
            for (int j = 0; j < 4; ++j) { ya[k][j] = __builtin_nontemporal_load(y0 + 64 * j); yb[k][j] = __builtin_nontemporal_load(y1 + 64 * j); } }
#pragma unroll
        for (int k = 0; k < 2; ++k) { const int r = rr[k], p0 = pa[k], p1 = pb[k]; const float w0 = wa[k], w1 = wb[k];
            f32x4 v[4]; float s2 = 0.f;
#pragma unroll
            for (int j = 0; j < 4; ++j) { const int c = 4 * (64 * j + F.lane); const v2u a = ya[k][j], b = yb[k][j]; const f32x4 g = cg[j];
                f32x4 fa = (f32x4){bflo(a.x), bfhi(a.x), bflo(a.y), bfhi(a.y)}, fb = (f32x4){bflo(b.x), bfhi(b.x), bflo(b.y), bfhi(b.y)};
                if (p0 >= 32768) { fa = (f32x4){0.f, 0.f, 0.f, 0.f}; for (int q = 0; q < 7; ++q) fa += *(const f32x4*)(YP + ((size_t)q * 2048 + (p0 - 32768)) * D + c); }
                if (p1 >= 32768) { fb = (f32x4){0.f, 0.f, 0.f, 0.f}; for (int q = 0; q < 7; ++q) fb += *(const f32x4*)(YP + ((size_t)q * 2048 + (p1 - 32768)) * D + c); }
                const f32x4 f = fa * w0 + fb * w1;
                v[j] = xv[k][j] + g * f; s2 += (v[j].x * v[j].x + v[j].y * v[j].y) + (v[j].z * v[j].z + v[j].w * v[j].w); }
            const float rstd = 1.0f / sqrtf(wave_sum(s2) * (1.0f / D) + EPS);
            GAS f32x4* o = (GAS f32x4*)(F.out + (size_t)r * D) + F.lane;
#pragma unroll
            for (int j = 0; j < 4; ++j) __builtin_nontemporal_store(v[j] * rstd * cf[j], &o[64 * j]);
        }
    }
}


typedef short bf16x8v __attribute__((ext_vector_type(8)));
__device__ __forceinline__ bf16x8v as_frag(v4u a) { return __builtin_bit_cast(bf16x8v, a); }
constexpr float LOG2E_ = 1.4426950408889634f;
#define MFMA16(a, b, c) __builtin_amdgcn_mfma_f32_16x16x32_bf16((a), (b), (c), 0, 0, 0)
__device__ __forceinline__ int prm_row(int i2, int par, int r) { return 32 * i2 + 8 * (r >> 2) + 4 * par + (r & 3); }

__device__ __forceinline__ void ph_ssd_s1(Frame& F) {
    const bf16* XT = (const bf16*)(F.ws + WS_XT); const bf16* BT = (const bf16*)(F.ws + WS_BT);
    const float* DTF = (const float*)(F.ws + WS_DTS); const float* DTB = DTF + (size_t)32 * MT; float* CUMF = (float*)(DTB + (size_t)32 * MT); float* CUMB = CUMF + (size_t)32 * MT;
    float* DEC = (float*)(F.ws + WS_DEC); bf16* ST = (bf16*)(F.ws + WS_STATES);
    LAS unsigned char* btl = F.lds;
    LAS float* wtab = (LAS float*)(F.lds + 128 * 272);
    LAS float* wtot = wtab + 1024;
    const int lane = F.lane, r16 = lane & 15, gq = lane >> 4;
    v4u nbt[4]; float ndtf = 0.f, ndtb = 0.f;
#define S1_PREFETCH(u_) do { const int c_ = (u_) >> 3, g_ = ((u_) >> 1) & 3, hh_ = (u_) & 1, t0_ = c_ * 128; int tq_ = F.tid; asm volatile("" : "+v"(tq_)); \
        _Pragma("unroll") for (int i_ = 0; i_ < 4; ++i_) { const int p_ = tq_ + NTHR * i_, n_ = p_ >> 4, c8_ = (p_ & 15) * 8; nbt[i_] = *(const GAS v4u*)(BT + (size_t)(g_ * 128 + n_) * MT + t0_ + c8_); } \
        { const int h_ = 8 * g_ + 4 * hh_ + (tq_ >> 7); ndtf = DTF[(size_t)h_ * MT + t0_ + (tq_ & 127)]; ndtb = DTB[(size_t)h_ * MT + t0_ + (tq_ & 127)]; } } while (0)
    if (F.vcu < NCH * 8) S1_PREFETCH(F.vcu);
    for (int u = F.vcu; u < NCH * 8; u += F.G) {
        const int c = u >> 3, g = (u >> 1) & 3, hh = u & 1, t0 = c * 128;
        int tid_ = F.tid; asm volatile("" : "+v"(tid_));
        v4u xr[4][4];
        { const int hx = 8 * g + 4 * hh + (F.wave >> 1);
#pragma unroll
          for (int ks = 0; ks < 4; ++ks)
#pragma unroll
            for (int pt = 0; pt < 4; ++pt) xr[ks][pt] = *(const GAS v4u*)(XT + ((size_t)(((hx * NCH + c) * 4 + ks) * 4 + pt) * 16 + r16) * 32 + 8 * gq); }
#pragma unroll
        for (int i = 0; i < 4; ++i) { const int p = tid_ + NTHR * i, n = p >> 4, c8 = (p & 15) * 8; *(LAS v4u*)(btl + n * 272 + c8 * 2) = nbt[i]; }
        {
            const int j = tid_ >> 7, l = tid_ & 127, h = 8 * g + 4 * hh + j;
            const float dtf = ndtf, dtb = ndtb;
            const float Af = -__expf(F.in[I_ALOGF][h]), Ab = -__expf(F.in[I_ALOGB][h]);
            const float af = dtf * Af, ab = dtb * Ab;
            float pf = af, pb = ab;
#pragma unroll
            for (int o = 1; o < 64; o <<= 1) { const float a = __shfl_up(pf, o), b = __shfl_up(pb, o); if (lane >= o) { pf += a; pb += b; } }
            if (lane == 63) { wtot[F.wave * 2] = pf; wtot[F.wave * 2 + 1] = pb; }
            __syncthreads();
            const float tf0 = wtot[(2 * j) * 2], tb0 = wtot[(2 * j) * 2 + 1], Tf = tf0 + wtot[(2 * j + 1) * 2], Tb = tb0 + wtot[(2 * j + 1) * 2 + 1];
            if (F.wave & 1) { pf += tf0; pb += tb0; }
            const float cf = pf, cb = Tb - pb + ab;
            CUMF[(size_t)h * MT + t0 + l] = cf; CUMB[(size_t)h * MT + t0 + l] = cb;
            wtab[(j * 2 + 0) * 128 + l] = __expf(Tf - cf) * dtf; wtab[(j * 2 + 1) * 128 + l] = __expf(Tb - cb) * dtb;
            if (l == 0) { DEC[(0 * NCH + c) * 32 + h] = __expf(Tf); DEC[(1 * NCH + c) * 32 + h] = __expf(Tb); }
        }
        __syncthreads();
        {
            const int j = F.wave >> 1, dir = F.wave & 1, h = 8 * g + 4 * hh + j;
            f32x4 acc[8][4];
#pragma unroll
            for (int a = 0; a < 8; ++a)
#pragma unroll
                for (int b = 0; b < 4; ++b) acc[a][b] = (f32x4){0.f, 0.f, 0.f, 0.f};
            const LAS float* wt = wtab + (j * 2 + dir) * 128;
            if (u + F.G < NCH * 8) S1_PREFETCH(u + F.G);
#pragma unroll
            for (int ks = 0; ks < 4; ++ks) {
                const f32x4 w0 = *(const LAS f32x4*)(wt + 32 * ks + 8 * gq), w1 = *(const LAS f32x4*)(wt + 32 * ks + 8 * gq + 4);
                bf16x8v bfr[4];
#pragma unroll
                for (int pt = 0; pt < 4; ++pt) { const v4u x = xr[ks][pt];
                    v4u y; y.x = pk2(bflo(x.x) * w0.x, bfhi(x.x) * w0.y); y.y = pk2(bflo(x.y) * w0.z, bfhi(x.y) * w0.w); y.z = pk2(bflo(x.z) * w1.x, bfhi(x.z) * w1.y); y.w = pk2(bflo(x.w) * w1.z, bfhi(x.w) * w1.w);
                    bfr[pt] = as_frag(y); }
#pragma unroll
                for (int nt = 0; nt < 8; ++nt) { const bf16x8v af = as_frag(*(const LAS v4u*)(btl + prm_row(nt >> 1, nt & 1, r16) * 272 + (32 * ks + 8 * gq) * 2));
#pragma unroll
                    for (int pt = 0; pt < 4; ++pt) acc[nt][pt] = MFMA16(af, bfr[pt], acc[nt][pt]); }
            }
            bf16* so = ST + ((size_t)((dir * NCH + c) * 32 + h) * 64) * 128;
#pragma unroll
            for (int pt = 0; pt < 4; ++pt)
#pragma unroll
                for (int i2 = 0; i2 < 4; ++i2) { const f32x4 a = acc[2 * i2][pt], b = acc[2 * i2 + 1][pt];
                    v4u o; o.x = pk2(a[0], a[1]); o.y = pk2(a[2], a[3]); o.z = pk2(b[0], b[1]); o.w = pk2(b[2], b[3]);
                    *(GAS v4u*)(so + (size_t)(((pt * 4 + i2) * 16 + r16) * 32) + 8 * gq) = o; }
        }
        __syncthreads();
    }
}
#undef S1_PREFETCH

__device__ __forceinline__ void ph_ssd_s2(Frame& F) {
    const float* DEC = (const float*)(F.ws + WS_DEC); bf16* ST = (bf16*)(F.ws + WS_STATES);
    for (int e = F.vcu * NTHR + F.tid; e < 2 * 32 * 64 * 32; e += F.G * NTHR) {
        const int dir = e >> 16, h = (e >> 11) & 31, rem = e & 2047;
        const size_t eoff = (size_t)h * 8192 + (size_t)rem * 4; const size_t cstride = (size_t)32 * 8192;
        bf16* base = ST + (size_t)dir * NCH * cstride + eoff;
        const float* dec = DEC + (size_t)dir * NCH * 32 + h;
        float H0 = 0.f, H1 = 0.f, H2 = 0.f, H3 = 0.f;
        for (int b = 0; b < NCH; b += 10) {
            v2u s[10]; float d[10]; int ck[10];
#pragma unroll
            for (int i = 0; i < 10; ++i) { const int idx = b + i; ck[i] = dir == 0 ? (idx < 2 ? 128 + idx : idx - 2) : (idx < 2 ? 129 - idx : 129 - idx);
                s[i] = __builtin_nontemporal_load((const GAS v2u*)(base + (size_t)ck[i] * cstride)); d[i] = dec[ck[i] * 32]; }
#pragma unroll
            for (int i = 0; i < 10; ++i) { v2u o; o.x = pk2(H0, H1); o.y = pk2(H2, H3); *(GAS v2u*)(base + (size_t)ck[i] * cstride) = o;
                H0 = d[i] * H0 + bflo(s[i].x); H1 = d[i] * H1 + bfhi(s[i].x); H2 = d[i] * H2 + bflo(s[i].y); H3 = d[i] * H3 + bfhi(s[i].y); }
        }
    }
}

__device__ __forceinline__ void ph_ssd_s3(Frame& F) {
    const bf16* XT = (const bf16*)(F.ws + WS_XT); const bf16* BMm = (const bf16*)(F.ws + WS_BM); const bf16* CMm = (const bf16*)(F.ws + WS_CM);
    const float* DTF = (const float*)(F.ws + WS_DTS); const float* DTB = DTF + (size_t)32 * MT; const float* CUMF = DTB + (size_t)32 * MT; const float* CUMB = CUMF + (size_t)32 * MT;
    const bf16* ST = (const bf16*)(F.ws + WS_STATES); bf16* Z = (bf16*)(F.ws + WS_Z); const float* ng = F.in[I_SSDNG];
    LAS unsigned char* bml = F.lds;
    LAS unsigned char* cml = F.lds + 128 * 272;
    LAS float* tab = (LAS float*)(F.lds + 192 * 272);
    LAS float* ssq = tab + 8 * 5 * 128;
    const int lane = F.lane, r16 = lane & 15, gq = lane >> 4;
    v4u nbm[4], ncm[2]; float ncf[2], ncb[2], ndf[2], ndb[2];
#define S3_PREFETCH(u_) do { const int c_ = (u_) >> 3, g_ = ((u_) >> 1) & 3, lh_ = (u_) & 1, t0_ = c_ * 128; int tq_ = F.tid; asm volatile("" : "+v"(tq_)); \
        _Pragma("unroll") for (int i_ = 0; i_ < 4; ++i_) { const int p_ = tq_ + NTHR * i_, row_ = p_ >> 4, c8_ = (p_ & 15) * 8; nbm[i_] = *(const GAS v4u*)(BMm + (size_t)(t0_ + row_) * 512 + g_ * 128 + c8_); } \
        _Pragma("unroll") for (int i_ = 0; i_ < 2; ++i_) { const int p_ = tq_ + NTHR * i_, row_ = p_ >> 4, c8_ = (p_ & 15) * 8; ncm[i_] = *(const GAS v4u*)(CMm + (size_t)(t0_ + 64 * lh_ + row_) * 512 + g_ * 128 + c8_); \
            const size_t o_ = (size_t)(8 * g_ + (p_ >> 7)) * MT + t0_ + (p_ & 127); ncf[i_] = CUMF[o_]; ncb[i_] = CUMB[o_]; ndf[i_] = DTF[o_]; ndb[i_] = DTB[o_]; } } while (0)
    if (F.vcu < 128 * 8) S3_PREFETCH(F.vcu);
    for (int u = F.vcu; u < 128 * 8; u += F.G) {
        const int c = u >> 3, g = (u >> 1) & 3, lh = u & 1, t0 = c * 128;
        __syncthreads();
        int tid_ = F.tid; asm volatile("" : "+v"(tid_));
#pragma unroll
        for (int i = 0; i < 4; ++i) { const int p = tid_ + NTHR * i, row = p >> 4, c8 = (p & 15) * 8; *(LAS v4u*)(bml + row * 272 + c8 * 2) = nbm[i]; }
#pragma unroll
        for (int i = 0; i < 2; ++i) { const int p = tid_ + NTHR * i, row = p >> 4, c8 = (p & 15) * 8; *(LAS v4u*)(cml + row * 272 + c8 * 2) = ncm[i]; }
#pragma unroll
        for (int i = 0; i < 2; ++i) { const int p = tid_ + NTHR * i, j = p >> 7, l = p & 127;
            const float cf = ncf[i] * LOG2E_, cb = ncb[i] * LOG2E_, df = ndf[i], db = ndb[i];
            tab[(j * 5 + 0) * 128 + l] = cf; tab[(j * 5 + 1) * 128 + l] = cb; tab[(j * 5 + 2) * 128 + l] = __builtin_amdgcn_logf(df) - cf; tab[(j * 5 + 3) * 128 + l] = __builtin_amdgcn_logf(db) - cb;
            tab[(j * 5 + 4) * 128 + l] = df + db; }
        __syncthreads();
        const int h = 8 * g + F.wave;
        const float Dk = F.in[I_SSDD][h];
        const LAS float* tcf = tab + (F.wave * 5) * 128; const LAS float* tcb = tcf + 128; const LAS float* tdf = tcb + 128; const LAS float* tdb = tdf + 128; const LAS float* tds = tdb + 128;
        f32x4 acc[4][4];
#pragma unroll
        for (int a = 0; a < 4; ++a)
#pragma unroll
            for (int b = 0; b < 4; ++b) acc[a][b] = (f32x4){0.f, 0.f, 0.f, 0.f};
#pragma unroll 1
        for (int i2 = 0; i2 < 4; ++i2) {
            bf16x8v xf[4], bmf[2][4];
#pragma unroll
            for (int pt = 0; pt < 4; ++pt) xf[pt] = as_frag(*(const GAS v4u*)(XT + ((size_t)(((h * NCH + c) * 4 + i2) * 4 + pt) * 16 + r16) * 32 + 8 * gq));
#pragma unroll
            for (int par = 0; par < 2; ++par)
#pragma unroll
                for (int nk = 0; nk < 4; ++nk) bmf[par][nk] = as_frag(*(const LAS v4u*)(bml + prm_row(i2, par, r16) * 272 + (32 * nk + 8 * gq) * 2));
            const int sb = 32 * i2 + 8 * gq;
            const f32x4 dfs0 = *(const LAS f32x4*)(tdf + sb), dfs1 = *(const LAS f32x4*)(tdf + sb + 4), dbs0 = *(const LAS f32x4*)(tdb + sb), dbs1 = *(const LAS f32x4*)(tdb + sb + 4);
#pragma unroll
            for (int lt = 0; lt < 4; ++lt) {
                const int ll = 16 * lt + r16, l = 64 * lh + ll;
                const float cfl = tcf[l], cbl = tcb[l], dsl = tds[l];
                f32x4 g0 = (f32x4){0.f, 0.f, 0.f, 0.f}, g1 = g0;
#pragma unroll
                for (int nk = 0; nk < 4; ++nk) { const bf16x8v cf = as_frag(*(const LAS v4u*)(cml + ll * 272 + (32 * nk + 8 * gq) * 2));
                    g0 = MFMA16(bmf[0][nk], cf, g0); g1 = MFMA16(bmf[1][nk], cf, g1); }
                float m[8];
                const int ltile0 = 64 * lh + 16 * lt; const int blk = (32 * i2 + 31 < ltile0) ? 0 : ((32 * i2 > ltile0 + 15) ? 2 : 1);
                if (blk == 0) {
#pragma unroll
                    for (int e = 0; e < 8; ++e) { const float dfs = e < 4 ? dfs0[e & 3] : dfs1[e & 3], gv = e < 4 ? g0[e & 3] : g1[e & 3]; m[e] = gv * __builtin_amdgcn_exp2f(cfl + dfs); }
                } else if (blk == 2) {
#pragma unroll
                    for (int e = 0; e < 8; ++e) { const float dbs = e < 4 ? dbs0[e & 3] : dbs1[e & 3], gv = e < 4 ? g0[e & 3] : g1[e & 3]; m[e] = gv * __builtin_amdgcn_exp2f(cbl + dbs); }
                } else {
#pragma unroll
                    for (int e = 0; e < 8; ++e) { const int s = sb + e;
                        const float dfs = e < 4 ? dfs0[e & 3] : dfs1[e & 3], dbs = e < 4 ? dbs0[e & 3] : dbs1[e & 3], gv = e < 4 ? g0[e & 3] : g1[e & 3];
                        float w = __builtin_amdgcn_exp2f(s < l ? cfl + dfs : cbl + dbs); const bool dg = s == l;
                        w = dg ? dsl : w; m[e] = gv * w + (dg ? Dk : 0.f); }
                }
                asm volatile("" : "+v"(m[0]), "+v"(m[1]), "+v"(m[2]), "+v"(m[3]), "+v"(m[4]), "+v"(m[5]), "+v"(m[6]), "+v"(m[7]));
                v4u mp; mp.x = pk2(m[0], m[1]); mp.y = pk2(m[2], m[3]); mp.z = pk2(m[4], m[5]); mp.w = pk2(m[6], m[7]);
                const bf16x8v mf = as_frag(mp);
#pragma unroll
                for (int pt = 0; pt < 4; ++pt) acc[lt][pt] = MFMA16(xf[pt], mf, acc[lt][pt]);
            }
        }
        if (u + F.G < 128 * 8) S3_PREFETCH(u + F.G);
#pragma unroll 1
        for (int dir = 0; dir < 2; ++dir) {
            const bf16* hs = ST + ((size_t)((dir * NCH + c) * 32 + h) * 64) * 128;
            float el[4];
#pragma unroll
            for (int lt = 0; lt < 4; ++lt) { const int l = 64 * lh + 16 * lt + r16; el[lt] = __builtin_amdgcn_exp2f(dir == 0 ? tcf[l] : tcb[l]); }
            f32x4 tacc[4][4];
#pragma unroll
            for (int a = 0; a < 4; ++a)
#pragma unroll
                for (int b = 0; b < 4; ++b) tacc[a][b] = (f32x4){0.f, 0.f, 0.f, 0.f};
#pragma unroll 1
            for (int nk = 0; nk < 4; ++nk) {
                bf16x8v hf[4];
#pragma unroll
                for (int pt = 0; pt < 4; ++pt) hf[pt] = as_frag(*(const GAS v4u*)(hs + (size_t)(((pt * 4 + nk) * 16 + r16) * 32) + 8 * gq));
#pragma unroll
                for (int lt = 0; lt < 4; ++lt) { const int ll = 16 * lt + r16;
                    const bf16x8v cf = as_frag(*(const LAS v4u*)(cml + ll * 272 + (32 * nk + 8 * gq) * 2));
#pragma unroll
                    for (int pt = 0; pt < 4; ++pt) tacc[lt][pt] = MFMA16(hf[pt], cf, tacc[lt][pt]); }
            }
#pragma unroll
            for (int lt = 0; lt < 4; ++lt)
#pragma unroll
                for (int pt = 0; pt < 4; ++pt) acc[lt][pt] += tacc[lt][pt] * el[lt];
        }
#pragma unroll
        for (int lt = 0; lt < 4; ++lt) { const int l = 64 * lh + 16 * lt + r16; float ss = 0.f;
#pragma unroll
            for (int q = 0; q < 2; ++q) { const v4u zv = *(const GAS v4u*)(Z + (size_t)(t0 + l) * DIN + h * 64 + 32 * q + 8 * gq);
                const float zz[8] = {bflo(zv.x), bfhi(zv.x), bflo(zv.y), bfhi(zv.y), bflo(zv.z), bfhi(zv.z), bflo(zv.w), bfhi(zv.w)};
#pragma unroll
                for (int e = 0; e < 4; ++e) { float v0 = acc[lt][2 * q][e] * zz[e] * sigmoid_f(zz[e]), v1 = acc[lt][2 * q + 1][e] * zz[4 + e] * sigmoid_f(zz[4 + e]);
                    acc[lt][2 * q][e] = v0; acc[lt][2 * q + 1][e] = v1; ss += v0 * v0 + v1 * v1; } }
            ss += __shfl_xor(ss, 16); ss += __shfl_xor(ss, 32);
            if (gq == 0) ssq[(16 * lt + r16) * 8 + F.wave] = ss; }
        __syncthreads();
#pragma unroll
        for (int lt = 0; lt < 4; ++lt) { const int ll = 16 * lt + r16, l = 64 * lh + ll;
            const f32x4 s0 = *(const LAS f32x4*)(ssq + ll * 8), s1 = *(const LAS f32x4*)(ssq + ll * 8 + 4);
            const float rs = 1.0f / sqrtf(((s0.x + s0.y) + (s0.z + s0.w) + (s1.x + s1.y) + (s1.z + s1.w)) * (1.0f / 512.0f) + EPS);
#pragma unroll
            for (int q = 0; q < 2; ++q) { const int ch = h * 64 + 32 * q + 8 * gq; const f32x4 a = acc[lt][2 * q] * rs, b = acc[lt][2 * q + 1] * rs;
                const f32x4 g0 = *(const f32x4*)(ng + ch), g1 = *(const f32x4*)(ng + ch + 4);
                v4u o; o.x = pk2(a[0] * g0.x, a[1] * g0.y); o.y = pk2(a[2] * g0.z, a[3] * g0.w); o.z = pk2(b[0] * g1.x, b[1] * g1.y); o.w = pk2(b[2] * g1.z, b[3] * g1.w);
                *(GAS v4u*)(Z + (size_t)(t0 + l) * DIN + ch) = o; } }
    }
    __syncthreads();
}
#undef S3_PREFETCH

__device__ __forceinline__ float vmax_f(float a, float b) { return __builtin_amdgcn_fmed3f(a, b, __builtin_inff()); }
__device__ __forceinline__ float vmin_f(float a, float b) { return __builtin_amdgcn_fmed3f(a, b, -__builtin_inff()); }
__device__ __forceinline__ float vmax3_f(float a, float b, float c) { return vmax_f(a, vmax_f(b, c)); }
__device__ __forceinline__ int attn_next_blk(int kb, int qb, bool isctx) {
    for (int k = kb + 1; k < 5; ++k) { if (k >= 3) return k; if (!isctx) { const int b = qb - 1 + k; if (b >= 0 && b < 128) return k; } }
    return 5;
}
__device__ __forceinline__ void ph_attn(Frame& F) {
    const bf16* QR = (const bf16*)(F.ws + WS_QR); const bf16* KR = (const bf16*)(F.ws + WS_KR); const bf16* VT = (const bf16*)(F.ws + WS_VT); bf16* MIX = (bf16*)(F.ws + WS_MIX);
    constexpr int KBYTES = 128 * 144, BUFB = KBYTES + 64 * 272;
    const int lane = F.lane, r16 = lane & 15, gq = lane >> 4;
    constexpr float LOG2E = 1.4426950408889634f;
    const int p0 = F.tid, p1 = F.tid + NTHR;
    const int kro0 = (p0 >> 3) * 144 + (p0 & 7) * 16, kro1 = (p1 >> 3) * 144 + (p1 & 7) * 16;
    const int vro0 = KBYTES + (p0 >> 4) * 272 + (p0 & 15) * 16, vro1 = KBYTES + (p1 >> 4) * 272 + (p1 & 15) * 16;
    for (int u = F.vcu; u < 130 * 8; u += F.G) {
        const int qb = u >> 3, hq = u & 7, kvh = hq >> 2; const bool isctx = qb >= 128;
        const int row0 = qb * 128;
        const int qrow = row0 + 16 * F.wave + r16;
        bf16x8v qf[2];
#pragma unroll
        for (int ks = 0; ks < 2; ++ks) qf[ks] = as_frag(*(const GAS v4u*)(QR + ((size_t)hq * MT + qrow) * 64 + 32 * ks + 8 * gq));
        float m2 = F.in[I_ABSINK][hq] * LOG2E, lsum = 1.0f;
        f32x4 oacc[4];
#pragma unroll
        for (int a = 0; a < 4; ++a) oacc[a] = (f32x4){0.f, 0.f, 0.f, 0.f};
        const int qi = 16 * F.wave + r16;
        const bf16* kbase = KR + (size_t)kvh * MT * 64; const bf16* vbase = VT + (size_t)kvh * 64 * MT;
#define ATT_KEY0(kb) ((kb) < 3 ? (qb - 1 + (kb)) * 128 : L + ((kb) - 3) * 128)
#define ATT_LOAD(kb) do { const int k0_ = ATT_KEY0(kb); \
            kr0 = *(const GAS v4u*)(kbase + (size_t)(k0_ + (p0 >> 3)) * 64 + (p0 & 7) * 8); kr1 = *(const GAS v4u*)(kbase + (size_t)(k0_ + (p1 >> 3)) * 64 + (p1 & 7) * 8); \
            vr0 = *(const GAS v4u*)(vbase + (size_t)(p0 >> 4) * MT + k0_ + (p0 & 15) * 8); vr1 = *(const GAS v4u*)(vbase + (size_t)(p1 >> 4) * MT + k0_ + (p1 & 15) * 8); } while (0)
#define ATT_WRITE(buf) do { LAS unsigned char* b_ = F.lds + (buf) * BUFB; *(LAS v4u*)(b_ + kro0) = kr0; *(LAS v4u*)(b_ + kro1) = kr1; *(LAS v4u*)(b_ + vro0) = vr0; *(LAS v4u*)(b_ + vro1) = vr1; } while (0)
        v4u kr0, kr1, vr0, vr1;
        int kb = attn_next_blk(-1, qb, isctx), cur = 0;
        __syncthreads();
        ATT_LOAD(kb); ATT_WRITE(0);
        __syncthreads();
        while (kb < 5) {
            const int nkb = attn_next_blk(kb, qb, isctx);
            if (nkb < 5) ATT_LOAD(nkb);
            const LAS unsigned char* kl = F.lds + cur * BUFB; const LAS unsigned char* vl = kl + KBYTES;
            const int mode = (kb == 0) ? 1 : ((kb == 2) ? 2 : 0);
            f32x4 sacc[8];
#pragma unroll
            for (int kt = 0; kt < 8; ++kt) { sacc[kt] = (f32x4){0.f, 0.f, 0.f, 0.f};
#pragma unroll
                for (int ks = 0; ks < 2; ++ks) { const bf16x8v kf = as_frag(*(const LAS v4u*)(kl + prm_row(kt >> 1, kt & 1, r16) * 144 + (32 * ks + 8 * gq) * 2));
                    sacc[kt] = MFMA16(kf, qf[ks], sacc[kt]); } }
            float bm = -1.0e30f;
#pragma unroll 1
            for (int rep_ = 0; rep_ < (mode != 0 ? 1 : 0); ++rep_) {
                const float msgn = mode == 1 ? 1.0e30f : -1.0e30f, limf = (float)(qi - 8 * gq);
#pragma unroll
                for (int kt = 0; kt < 8; ++kt)
#pragma unroll
                    for (int e = 0; e < 4; ++e) { const float jc = (float)(32 * (kt >> 1) + 4 * (kt & 1) + e);
                        sacc[kt][e] += vmin_f(0.f, msgn * (jc - limf)); }
            }
#pragma unroll
            for (int kt = 0; kt < 8; ++kt) bm = vmax3_f(bm, vmax_f(sacc[kt][0], sacc[kt][1]), vmax_f(sacc[kt][2], sacc[kt][3]));
            bm = vmax_f(bm, __shfl_xor(bm, 16)); bm = vmax_f(bm, __shfl_xor(bm, 32));
            const float mn = vmax_f(m2, bm), alpha = __builtin_amdgcn_exp2f(m2 - mn); m2 = mn;
            float ps = 0.f;
            bf16x8v pf[4];
#pragma unroll
            for (int i2 = 0; i2 < 4; ++i2) { float p[8];
#pragma unroll
                for (int e = 0; e < 4; ++e) { p[e] = __builtin_amdgcn_exp2f(sacc[2 * i2][e] - mn); p[4 + e] = __builtin_amdgcn_exp2f(sacc[2 * i2 + 1][e] - mn); }
#pragma unroll
                for (int e = 0; e < 8; ++e) ps += p[e];
                v4u pk; pk.x = pk2(p[0], p[1]); pk.y = pk2(p[2], p[3]); pk.z = pk2(p[4], p[5]); pk.w = pk2(p[6], p[7]); pf[i2] = as_frag(pk); }
            ps += __shfl_xor(ps, 16); ps += __shfl_xor(ps, 32);
            lsum = lsum * alpha + ps;
#pragma unroll
            for (int dt = 0; dt < 4; ++dt) { oacc[dt] = oacc[dt] * alpha;
#pragma unroll
                for (int i2 = 0; i2 < 4; ++i2) { const bf16x8v vf = as_frag(*(const LAS v4u*)(vl + prm_row(dt >> 1, dt & 1, r16) * 272 + (32 * i2 + 8 * gq) * 2));
                    oacc[dt] = MFMA16(vf, pf[i2], oacc[dt]); } }
            if (nkb < 5) ATT_WRITE(cur ^ 1);
            __syncthreads();
            kb = nkb; cur ^= 1;
        }
#undef ATT_KEY0
#undef ATT_LOAD
#undef ATT_WRITE
        const float il = 1.0f / lsum;
#pragma unroll
        for (int i = 0; i < 2; ++i) { const f32x4 a = oacc[2 * i] * il, b = oacc[2 * i + 1] * il;
            v4u o; o.x = pk2(a[0], a[1]); o.y = pk2(a[2], a[3]); o.z = pk2(b[0], b[1]); o.w = pk2(b[2], b[3]);
            *(GAS v4u*)(MIX + (size_t)qrow * D + 512 + 64 * hq + 32 * i + 8 * gq) = o; }
    }
    __syncthreads();
}

constexpr int NPH = 23;
#ifndef WGM_MOE_GU
#define WGM_MOE_GU 4
#endif
#ifndef WGM_MOE_DN
#define WGM_MOE_DN 4
#endif
struct Args { const float* in[30]; float* out; unsigned char* ws; int ph_lo, ph_hi; };
__global__ void __launch_bounds__(NTHR, 2) mk_fwd(Args args) {
    extern __shared__ __attribute__((aligned(16))) unsigned char lds[];
    Frame F;
    F.lds = (LAS unsigned char*)lds;
    F.tid = threadIdx.x; F.lane = F.tid & 63; F.wave = __builtin_amdgcn_readfirstlane(F.tid >> 6);
    F.G = gridDim.x; { const int bx = blockIdx.x; F.vcu = (F.G % 8 == 0) ? (bx % 8) * (F.G / 8) + bx / 8 : bx; }
#pragma unroll
    for (int i = 0; i < 30; ++i) F.in[i] = args.in[i];
    F.out = args.out; F.ws = args.ws;
    unsigned char* ws = args.ws;
    volatile LAS unsigned* MISC = (volatile LAS unsigned*)(F.lds + MISC_OFF);
    for (int u = F.tid; u < (LDS_BYTES - LDSCTL_OFF) / 4; u += NTHR) ((LAS unsigned*)(F.lds + LDSCTL_OFF))[u] = 0u;
    __syncthreads();
    const int lo = args.ph_lo, hi = args.ph_hi;
    XcdBarrier bar; bar.bar = (unsigned*)(ws + WS_CTL) + CW_BAR; bar.x = 0; bar.st = nullptr;
    if (hi - lo > 1) bar = xcd_barrier_post((unsigned*)(ws + WS_CTL) + CW_BAR, MISC + 8);
#define IN(k) (lo <= (k) && (k) < hi)
#define SEAM(k) do { if (IN(k) && IN((k) + 1)) xcd_barrier(bar); } while (0)
    LAS unsigned char* ring = F.lds;
    bf16* X = (bf16*)(ws + WS_X); bf16* H = (bf16*)(ws + WS_H);

    if (IN(0)) { ph_prologue(F); } SEAM(0);
    if (IN(1)) { ph_modulate<false, false, 0>(F, F.in[I_X], F.in[I_CTX], F.in[I_N1G], modp(F, 0, 0), modp(F, 0, 1), M_SH1, M_SC1, H, MT, nullptr, nullptr, nullptr); } SEAM(1);
    if (IN(2)) { pg8::Gemm g{H, (const bf16*)(ws + WS_WABIN), D, D, 0}; pg8::StaticOrder S; S.init(MT, AB_IN, F.G, (int)blockIdx.x);
        pg8::EpiStoreBf16 E{(bf16*)(ws + WS_PAB), AB_IN};
        pg8::gemm_phase<pg8::EpiStoreBf16, pg8::StaticOrder, true, true>(ring, g, S, E);
        idle_round_convert(F, (MT / 256) * (AB_IN / 256), 0, 11400); } SEAM(2);
    if (IN(3)) { ph_ab_elem(F); } SEAM(3);
    if (IN(4)) { ph_attn(F); } SEAM(4);
    if (IN(5)) { { pg8::Gemm g{(const bf16*)(ws + WS_MIX), (const bf16*)(ws + WS_WABOUT), D, D, 0}; pg8::StaticOrder S; S.init(L, D, F.G, (int)blockIdx.x);
          pg8::EpiRes<true> E{X, F.in[I_X], modp(F, 0, 0) + M_G1};
          pg8::gemm_phase<pg8::EpiRes<true>, pg8::StaticOrder, true, true>(ring, g, S, E); }
        { int nu_ = 16, kl_ = 256; asm volatile("" : "+s"(nu_), "+s"(kl_)); pg8::Gemm g{(const bf16*)(ws + WS_MIX), (const bf16*)(ws + WS_WABOUT), D, kl_, 0}; pg8::SplitOrder S{64, 4, nu_, 256, F.G, (int)blockIdx.x};
          pg8::EpiPart E{(float*)(ws + WS_PART), 64, 256, LC};
          pg8::gemm_phase<pg8::EpiPart, pg8::SplitOrder, true, true>(ring, g, S, E); }
        if ((int)blockIdx.x >= 16) ph_convert_ffn(F, ((int)blockIdx.x - 16) * NWAVES + F.wave, (F.G - 16) * NWAVES); } SEAM(5);
    if (IN(6)) { ph_modulate<true, false, 4>(F, X, F.in[I_CTX], F.in[I_N2G], modp(F, 0, 0), modp(F, 0, 1), M_SH2, M_SC2, H, MT, (const float*)(ws + WS_PART), modp(F, 0, 1) + M_G1, X); } SEAM(6);
    if (IN(7)) { pg8::Gemm g{H, (const bf16*)(ws + WS_WFFNGU), D, D, 0}; pg8::StaticOrder S; S.init(MT, 2 * DFF, F.G, (int)blockIdx.x);
        pg8::EpiSwiGLU E{(bf16*)(ws + WS_ACT0), DFF};
        pg8::gemm_phase<pg8::EpiSwiGLU, pg8::StaticOrder, true, true>(ring, g, S, E);
        idle_round_convert(F, (MT / 256) * (2 * DFF / 256), 11400, 18000); } SEAM(7);
    if (IN(8)) { { pg8::Gemm g{(const bf16*)(ws + WS_ACT0), (const bf16*)(ws + WS_WFFND), DFF, DFF, 0}; pg8::StaticOrder S; S.init(L, D, F.G, (int)blockIdx.x);
          pg8::EpiRes<false> E{X, X, modp(F, 0, 0) + M_G2};
          pg8::gemm_phase<pg8::EpiRes<false>, pg8::StaticOrder, true, true>(ring, g, S, E); }
        { int nu_ = 44, kl_ = 256; asm volatile("" : "+s"(nu_), "+s"(kl_)); pg8::Gemm g{(const bf16*)(ws + WS_ACT0), (const bf16*)(ws + WS_WFFND), DFF, kl_, 0}; pg8::SplitOrder S{64, 4, nu_, 256, F.G, (int)blockIdx.x};
          pg8::EpiPart E{(float*)(ws + WS_PART), 64, 256, LC};
          pg8::gemm_phase<pg8::EpiPart, pg8::SplitOrder, true, true>(ring, g, S, E); }
        if ((int)blockIdx.x >= 44) ph_convert_ssd(F, ((int)blockIdx.x - 44) * NWAVES + F.wave, (F.G - 44) * NWAVES); } SEAM(8);
    if (IN(9)) { ph_modulate<true, true, 11>(F, X, X + (size_t)L * D, F.in[I_N1G] + D, modp(F, 1, 0), modp(F, 1, 1), M_SH1, M_SC1, H, MT, (const float*)(ws + WS_PART), modp(F, 0, 1) + M_G2, nullptr); } SEAM(9);
    if (IN(10)) { pg8::Gemm g{H, (const bf16*)(ws + WS_WSSDIN), D, D, 0}; pg8::StaticOrder S; S.init(MT, SSD_INP, F.G, (int)blockIdx.x);
        pg8::EpiSsdIn E{(bf16*)(ws + WS_Z), (bf16*)(ws + WS_XBCR), (float*)(ws + WS_DTRAW)};
        pg8::gemm_phase<pg8::EpiSsdIn, pg8::StaticOrder, true, true>(ring, g, S, E);
        idle_round_convert(F, (MT / 256) * (SSD_INP / 256), 18000, MOE_GU_ITEMS); } SEAM(10);
    if (IN(11)) { ph_ssd_conv(F); } SEAM(11);
    if (IN(12)) { ph_ssd_s1(F); } SEAM(12);
    if (IN(13)) { ph_ssd_s2(F); } SEAM(13);
    if (IN(14)) { ph_ssd_s3(F); } if (IN(14) && IN(16)) xcd_barrier(bar);
    if (IN(16)) { pg8::Gemm g{(const bf16*)(ws + WS_Z), (const bf16*)(ws + WS_WSSDOUT), DIN, DIN, 0}; pg8::StaticOrder S; S.init(L, D, F.G, (int)blockIdx.x);
        pg8::EpiRes<false> E{X, X, modp(F, 1, 0) + M_G1};
        pg8::gemm_phase<pg8::EpiRes<false>, pg8::StaticOrder, true, true>(ring, g, S, E); } SEAM(16);
    if (IN(17)) { ph_moe_route(F); } SEAM(17);
    if (IN(18)) { ph_moe_scatter(F); } SEAM(18);
    if (IN(19) || IN(21)) {
        LAS int* hist = (LAS int*)F.lds; LAS int* cnt = hist + 512; LAS int* seg = cnt + 8;
        pg8::GroupedOrder S;
        if (IN(19)) {
            moe_segments(F, hist, cnt, seg);
            S.nM = seg[8] >> 8; S.nN = 2 * FFE / 256; S.nwg = S.nM * S.nN; S.G = F.G; S.c = (int)blockIdx.x; S.WGM = WGM_MOE_GU;
            S.ts1 = seg[1] >> 8; S.ts2 = seg[2] >> 8; S.ts3 = seg[3] >> 8; S.ts4 = seg[4] >> 8; S.ts5 = seg[5] >> 8; S.ts6 = seg[6] >> 8; S.ts7 = seg[7] >> 8;
            __syncthreads();
            pg8::Gemm g{(const bf16*)(ws + WS_H2S), (const bf16*)(ws + WS_WMOE), D, D, (size_t)2 * FFE * D * 2};
            pg8::EpiSwiGLU E{(bf16*)(ws + WS_ACTM), FFE};
            pg8::gemm_phase<pg8::EpiSwiGLU, pg8::GroupedOrder, true, true>(ring, g, S, E);
        }
        SEAM(19);
        if (IN(20)) { int first = 0;
            for (int e = 0; e < NEXP; ++e) tr_matrix(F, F.in[I_MOED] + (size_t)e * FFE * D, FFE, D, (bf16*)(ws + WS_WMOE) + (size_t)e * D * FFE, 0, first); }
        SEAM(20);
        if (IN(21)) {
            __syncthreads();
            moe_segments(F, hist, cnt, seg);
            const int NT = seg[8] >> 8;
            S.nM = NT < 128 ? NT : 128; S.nN = D / 256; S.nwg = S.nM * S.nN; S.G = F.G; S.c = (int)blockIdx.x; S.WGM = WGM_MOE_DN;
            S.ts1 = seg[1] >> 8; S.ts2 = seg[2] >> 8; S.ts3 = seg[3] >> 8; S.ts4 = seg[4] >> 8; S.ts5 = seg[5] >> 8; S.ts6 = seg[6] >> 8; S.ts7 = seg[7] >> 8;
            __syncthreads();
            { pg8::Gemm g{(const bf16*)(ws + WS_ACTM), (const bf16*)(ws + WS_WMOE), FFE, FFE, (size_t)D * FFE * 2};
              pg8::EpiStoreBf16 E{(bf16*)(ws + WS_H2S), D};
              pg8::gemm_phase<pg8::EpiStoreBf16, pg8::GroupedOrder, true, true>(ring, g, S, E); }
            if (NT > 128) {
                pg8::Gemm g{(const bf16*)(ws + WS_ACTM), (const bf16*)(ws + WS_WMOE), FFE, 512, (size_t)D * FFE * 2};
                pg8::SplitGroupedOrder S2{128, NT, D / 256, 7, 512, F.G, (int)blockIdx.x, S.ts1, S.ts2, S.ts3, S.ts4, S.ts5, S.ts6, S.ts7};
                pg8::EpiPart E{(float*)(ws + WS_YPART), 128, 512, 2048};
                pg8::gemm_phase<pg8::EpiPart, pg8::SplitGroupedOrder, true, true>(ring, g, S2, E); }
        }
        SEAM(21);
    } else { SEAM(19); if (IN(20)) { int first = 0;
            for (int e = 0; e < NEXP; ++e) tr_matrix(F, F.in[I_MOED] + (size_t)e * FFE * D, FFE, D, (bf16*)(ws + WS_WMOE) + (size_t)e * D * FFE, 0, first); }
        SEAM(20); SEAM(21); }
    if (IN(22)) { ph_final(F); }
#undef IN
#undef SEAM
}

extern "C" void kernel_launch(void* const* d_in, const int* in_sizes, int n_in, void* d_out, int out_size, void* d_ws, size_t ws_size, hipStream_t stream) {
    static int grid = 0;
    if (grid == 0) {
        if (n_in != 30 || in_sizes[0] != L * D || out_size != L * D || ws_size < WS_END) { fprintf(stderr, "kernel_launch: unexpected shapes (n_in %d, in0 %d, out %d, ws %zu < %zu); nothing launched\n", n_in, n_in > 0 ? in_sizes[0] : -1, out_size, ws_size, (size_t)WS_END); grid = -1; return; }
        int dev = 0, cus = 0, per_cu = 0;
        if (hipGetDevice(&dev) != hipSuccess || hipDeviceGetAttribute(&cus, hipDeviceAttributeMultiprocessorCount, dev) != hipSuccess) { grid = -1; return; }
        if (hipFuncSetAttribute((const void*)mk_fwd, hipFuncAttributeMaxDynamicSharedMemorySize, LDS_BYTES) != hipSuccess) { fprintf(stderr, "kernel_launch: hipFuncSetAttribute failed\n"); grid = -1; return; }
        if (hipOccupancyMaxActiveBlocksPerMultiprocessor(&per_cu, (const void*)mk_fwd, NTHR, LDS_BYTES) != hipSuccess || per_cu < 1)
            fprintf(stderr, "kernel_launch: note: occupancy query reports %d workgroups per CU\n", per_cu);
        (void)hipGetLastError();
        grid = cus;
    }
    if (grid < 0) return;
    if (hipMemsetAsync((char*)d_ws + WS_CTL, 0, CTL_ZERO_BYTES, stream) != hipSuccess) return;
    Args a{};
    for (int i = 0; i < 30; ++i) a.in[i] = (const float*)d_in[i];
    a.out = (float*)d_out; a.ws = (unsigned char*)d_ws;
    if (MK_N_LAUNCHES == 1) { a.ph_lo = 0; a.ph_hi = NPH; hipLaunchKernelGGL(mk_fwd, dim3(grid), dim3(NTHR), LDS_BYTES, stream, a); }
    else { for (int p = 0; p < NPH; ++p) { a.ph_lo = p; a.ph_hi = p + 1; hipLaunchKernelGGL(mk_fwd, dim3(grid), dim3(NTHR), LDS_BYTES, stream, a); } }
}
```

```cpp
#include <hip/hip_runtime.h>
#include <cstdio>
#include <cstdint>

#ifndef MK_N_LAUNCHES
#define MK_N_LAUNCHES 1
#endif

namespace pg8 {
#define PG8_LAS __attribute__((address_space(3)))
typedef unsigned short bf16_t;
typedef short bf16x8 __attribute__((ext_vector_type(8)));
typedef float f32x4 __attribute__((ext_vector_type(4)));
typedef unsigned u32x4 __attribute__((ext_vector_type(4)));
constexpr int BM = 256, BK = 64, HALF = 128, HTB = HALF * BK * 2  , STAGE_BYTES = 8 * HTB, NXCD = 8;

__host__ __device__ __forceinline__ int lds_byte(int r, int c) { const int st = (r >> 4) * 2 + (c >> 5), rr = r & 15, cc = c & 31, ob = rr * 64 + cc * 2; return st * 1024 + (ob ^ (((ob >> 9) & 1) << 5)); }
__host__ __device__ __forceinline__ void stage_rc(int b, int& R, int& C) { const int st = b / 1024, sb = b % 1024, swz = sb ^ (((sb >> 9) & 1) << 5); R = (st >> 1) * 16 + swz / 64; C = (st & 1) * 32 + (swz % 64) / 2; }
__host__ __device__ __forceinline__ int perm32(int rho) { const int n = rho >> 4, i = rho & 15; return 8 * (i >> 2) + 4 * n + (i & 3); }

struct Unit { int pm, pn, pe, pk; };
struct Gemm { const bf16_t* A; const bf16_t* Bt; int ld, K; size_t bstride; size_t bdelta = 0; };

struct StaticOrder {
    int nM, nN, nwg, G, c, WGM;
    __host__ __device__ void init(int M, int N, int G_, int c_, int wgm = 4) { nM = M / BM; nN = N / BM; nwg = nM * nN; G = G_; c = c_; WGM = wgm; }
    __host__ __device__ bool next(int i, Unit& u) const {
        const long L = (long)i * G + c; if (L >= nwg) return false;
        int wgid = (int)L; { const int q = nwg / NXCD, r = nwg % NXCD, xcd = wgid % NXCD, off = wgid / NXCD; wgid = (xcd < r ? xcd * (q + 1) : r * (q + 1) + (xcd - r) * q) + off; }
        const int nig = WGM * nN, gid = wgid / nig, fm = gid * WGM, gsz = (nM - fm) < WGM ? (nM - fm) : WGM;
        u.pm = fm + ((wgid % nig) % gsz); u.pn = (wgid % nig) / gsz; u.pe = 0; u.pk = 0; return true;
    }
    __device__ __forceinline__ void a_ready(const Unit&) const {}
    __device__ __forceinline__ void done(const Unit&) const {}
};
struct GroupedOrder {
    int nM, nN, nwg, G, c, WGM; int ts1, ts2, ts3, ts4, ts5, ts6, ts7;
    __device__ bool next(int i, Unit& u) const {
        const long L = (long)i * G + c; if (L >= nwg) return false;
        int wgid = (int)L; { const int q = nwg / NXCD, r = nwg % NXCD, xcd = wgid % NXCD, off = wgid / NXCD; wgid = (xcd < r ? xcd * (q + 1) : r * (q + 1) + (xcd - r) * q) + off; }
        const int nig = WGM * nN, gid = wgid / nig, fm = gid * WGM, gsz = (nM - fm) < WGM ? (nM - fm) : WGM;
        u.pm = fm + ((wgid % nig) % gsz); u.pn = (wgid % nig) / gsz;
        u.pk = 0; const int p = u.pm; u.pe = (p >= ts1) + (p >= ts2) + (p >= ts3) + (p >= ts4) + (p >= ts5) + (p >= ts6) + (p >= ts7); return true;
    }
    __device__ __forceinline__ void a_ready(const Unit&) const {}
    __device__ __forceinline__ void done(const Unit&) const {}
};

__device__ __forceinline__ unsigned cvt_pk_bf16(float lo, float hi) { unsigned r; asm volatile("v_cvt_pk_bf16_f32 %0, %1, %2" : "=v"(r) : "v"(lo), "v"(hi)); return r; }
__device__ __forceinline__ float silu_f(float g) { return g * __builtin_amdgcn_rcpf(1.0f + __expf(-g)); }

struct EpiStoreBf16 {
    static constexpr bool PERM = true, AFTER_DRAIN = false;
    bf16_t* O; int ldc;
    __device__ __forceinline__ void operator()(const f32x4 (&acc)[2][2][4][2], const Unit& u, int wr, int wc, int fr, int fq) const {
        const int row0 = u.pm * BM + wr * 64 + fr, col0 = u.pn * BM + wc * 32 + 8 * fq;
#pragma unroll
        for (int ai = 0; ai < 2; ++ai)
#pragma unroll
            for (int m = 0; m < 4; ++m) { bf16_t* rowp = O + (size_t)(row0 + ai * HALF + m * 16) * ldc + col0;
#pragma unroll
                for (int bj = 0; bj < 2; ++bj) { const f32x4 v0 = acc[ai][bj][m][0], v1 = acc[ai][bj][m][1];
                    u32x4 w; w.x = cvt_pk_bf16(v0[0], v0[1]); w.y = cvt_pk_bf16(v0[2], v0[3]); w.z = cvt_pk_bf16(v1[0], v1[1]); w.w = cvt_pk_bf16(v1[2], v1[3]);
                    *(u32x4*)(rowp + bj * HALF) = w; } }
    }
};
struct EpiSwiGLU {
    static constexpr bool PERM = true, AFTER_DRAIN = false;
    bf16_t* O; int ldc;
    __device__ __forceinline__ void operator()(const f32x4 (&acc)[2][2][4][2], const Unit& u, int wr, int wc, int fr, int fq) const {
        const int row0 = u.pm * BM + wr * 64 + fr, col0 = u.pn * HALF + wc * 32 + 8 * fq;
#pragma unroll
        for (int ai = 0; ai < 2; ++ai)
#pragma unroll
            for (int m = 0; m < 4; ++m) { bf16_t* rowp = O + (size_t)(row0 + ai * HALF + m * 16) * ldc + col0;
                const f32x4 g0 = acc[ai][0][m][0], g1 = acc[ai][0][m][1], u0 = acc[ai][1][m][0], u1 = acc[ai][1][m][1];
                u32x4 w; w.x = cvt_pk_bf16(silu_f(g0[0]) * u0[0], silu_f(g0[1]) * u0[1]); w.y = cvt_pk_bf16(silu_f(g0[2]) * u0[2], silu_f(g0[3]) * u0[3]);
                w.z = cvt_pk_bf16(silu_f(g1[0]) * u1[0], silu_f(g1[1]) * u1[1]); w.w = cvt_pk_bf16(silu_f(g1[2]) * u1[2], silu_f(g1[3]) * u1[3]);
                *(u32x4*)rowp = w; }
    }
};
template <bool BASE_F32> struct EpiRes {
    static constexpr bool PERM = true, AFTER_DRAIN = false;
    bf16_t* X; const void* base; const float* gate;
    __device__ __forceinline__ void operator()(const f32x4 (&acc)[2][2][4][2], const Unit& u, int wr, int wc, int fr, int fq) const {
        const int row0 = u.pm * BM + wr * 64 + fr, col0 = u.pn * BM + wc * 32 + 8 * fq;
        f32x4 gv[2][2];
#pragma unroll
        for (int bj = 0; bj < 2; ++bj)
#pragma unroll
            for (int n = 0; n < 2; ++n) gv[bj][n] = *(const f32x4*)(gate + col0 + bj * HALF + 4 * n);
#pragma unroll
        for (int ai = 0; ai < 2; ++ai)
#pragma unroll
            for (int m = 0; m < 4; ++m) { const size_t ro = (size_t)(row0 + ai * HALF + m * 16) * 1024 + col0;
#pragma unroll
                for (int bj = 0; bj < 2; ++bj) { f32x4 b0, b1;
                    if (BASE_F32) { b0 = __builtin_nontemporal_load((const f32x4*)((const float*)base + ro + bj * HALF)); b1 = __builtin_nontemporal_load((const f32x4*)((const float*)base + ro + bj * HALF + 4)); }
                    else { const u32x4 t = *(const u32x4*)((const bf16_t*)base + ro + bj * HALF);
                        b0 = (f32x4){__uint_as_float(t.x << 16), __uint_as_float(t.x & 0xffff0000u), __uint_as_float(t.y << 16), __uint_as_float(t.y & 0xffff0000u)};
                        b1 = (f32x4){__uint_as_float(t.z << 16), __uint_as_float(t.z & 0xffff0000u), __uint_as_float(t.w << 16), __uint_as_float(t.w & 0xffff0000u)}; }
                    const f32x4 v0 = b0 + gv[bj][0] * acc[ai][bj][m][0], v1 = b1 + gv[bj][1] * acc[ai][bj][m][1];
                    u32x4 w; w.x = cvt_pk_bf16(v0[0], v0[1]); w.y = cvt_pk_bf16(v0[2], v0[3]); w.z = cvt_pk_bf16(v1[0], v1[1]); w.w = cvt_pk_bf16(v1[2], v1[3]);
                    *(u32x4*)(X + ro + bj * HALF) = w; } }
    }
};
struct EpiSsdIn {
    static constexpr bool PERM = true, AFTER_DRAIN = false;
    bf16_t* Z; bf16_t* XB; float* DT;
    __device__ __forceinline__ void operator()(const f32x4 (&acc)[2][2][4][2], const Unit& u, int wr, int wc, int fr, int fq) const {
        const int row0 = u.pm * BM + wr * 64 + fr;
        if (u.pn < 20) {
            bf16_t* O = u.pn < 8 ? Z : XB; const int ldc = u.pn < 8 ? 2048 : 3072; const int col0 = (u.pn < 8 ? u.pn : u.pn - 8) * BM + wc * 32 + 8 * fq;
#pragma unroll
            for (int ai = 0; ai < 2; ++ai)
#pragma unroll
                for (int m = 0; m < 4; ++m) { bf16_t* rowp = O + (size_t)(row0 + ai * HALF + m * 16) * ldc + col0;
#pragma unroll
                    for (int bj = 0; bj < 2; ++bj) { const f32x4 v0 = acc[ai][bj][m][0], v1 = acc[ai][bj][m][1];
                        u32x4 w; w.x = cvt_pk_bf16(v0[0], v0[1]); w.y = cvt_pk_bf16(v0[2], v0[3]); w.z = cvt_pk_bf16(v1[0], v1[1]); w.w = cvt_pk_bf16(v1[2], v1[3]);
                        *(u32x4*)(rowp + bj * HALF) = w; } }
        } else if (wc < 2) {
#pragma unroll
            for (int ai = 0; ai < 2; ++ai)
#pragma unroll
                for (int m = 0; m < 4; ++m) { float* rowp = DT + (size_t)(row0 + ai * HALF + m * 16) * 64 + wc * 32 + 8 * fq;
                    *(f32x4*)rowp = acc[ai][0][m][0]; *(f32x4*)(rowp + 4) = acc[ai][0][m][1]; }
        }
    }
};


struct SplitOrder {
    int pm0, nN, nunits, ks_len, G, c;
    __device__ bool next(int i, Unit& u) const { const int x = i * G + c; if (x >= nunits) return false; u.pm = pm0; u.pn = x % nN; u.pe = 0; u.pk = (x / nN) * ks_len; return true; }
    __device__ __forceinline__ void a_ready(const Unit&) const {}
    __device__ __forceinline__ void done(const Unit&) const {}
};
struct SplitGroupedOrder {
    int pm_lo, pm_hi, nN, nks, ks_len, G, c; int ts1, ts2, ts3, ts4, ts5, ts6, ts7;
    __device__ bool next(int i, Unit& u) const { const int x = i * G + c; const int per = nN * nks; if (x >= (pm_hi - pm_lo) * per) return false;
        u.pm = pm_lo + x / per; const int y = x % per; u.pn = y / nks; u.pk = (y % nks) * ks_len;
        const int p = u.pm; u.pe = (p >= ts1) + (p >= ts2) + (p >= ts3) + (p >= ts4) + (p >= ts5) + (p >= ts6) + (p >= ts7); return true; }
    __device__ __forceinline__ void a_ready(const Unit&) const {}
    __device__ __forceinline__ void done(const Unit&) const {}
};
struct EpiPart {
    static constexpr bool PERM = false, AFTER_DRAIN = false;
    float* P; int pm_base, ks_len, nrows;
    __device__ __forceinline__ void operator()(const f32x4 (&acc)[2][2][4][2], const Unit& u, int wr, int wc, int fr, int fq) const {
        const int row0 = (u.pm - pm_base) * BM + wr * 64 + fr, col0 = u.pn * BM + wc * 32 + 4 * fq;
        float* base = P + (size_t)(u.pk / ks_len) * nrows * 1024;
#pragma unroll
        for (int ai = 0; ai < 2; ++ai)
#pragma unroll
            for (int m = 0; m < 4; ++m) { float* rowp = base + (size_t)(row0 + ai * HALF + m * 16) * 1024 + col0;
#pragma unroll
                for (int bj = 0; bj < 2; ++bj)
#pragma unroll
                    for (int n = 0; n < 2; ++n) *(f32x4*)(rowp + bj * HALF + n * 16) = acc[ai][bj][m][n]; }
    }
};
template <class Epi, class Sched, bool ALIGN_EPI = false, bool SP2 = false>
__device__ __forceinline__ void gemm_phase(PG8_LAS unsigned char* lds, const Gemm g, const Sched& S, const Epi& E) {
    const int tid = threadIdx.x, wid = __builtin_amdgcn_readfirstlane(tid >> 6), lane = tid & 63, wr = wid >> 2, wc = wid & 3, fr = lane & 15, fq = lane >> 4;
    const int K = g.K, nt = K / BK;
    unsigned voffA[2], voffB[2];
#pragma unroll
    for (int i = 0; i < 2; ++i) { int R, C; stage_rc(tid * 16 + i * 8192, R, C); const int Rb = Epi::PERM ? ((R & ~31) + perm32(R & 31)) : R;
        voffA[i] = (unsigned)(R * g.ld + C) * 2u; voffB[i] = (unsigned)(Rb * g.ld + C) * 2u; }
    const size_t kstep = (size_t)(BK * 2);
    const size_t hstep = (size_t)HALF * g.ld * 2;
    const size_t tstep = 2 * hstep;
    const unsigned ldsw = (unsigned)wid * 1024u;
    const int aoff = lds_byte(wr * 64 + fr, fq * 8), boff = lds_byte(wc * 32 + fr, fq * 8);
#define PG8_SA(b, h) (((b) * 2 + (h)) * HTB)
#define PG8_SB(b, h) ((4 + (b) * 2 + (h)) * HTB)
#define PG8_STAGE(bufoff, gbase, voff) do { _Pragma("unroll") for (int _i = 0; _i < 2; ++_i) \
        __builtin_amdgcn_global_load_lds((const unsigned*)((const char*)(gbase) + (voff)[_i]), (PG8_LAS unsigned*)(lds + (bufoff) + ldsw + _i * 8192), 16, 0, 0); } while (0)
#define PG8_LDA(dst, b, h) do { _Pragma("unroll") for (int m = 0; m < 4; ++m) _Pragma("unroll") for (int k = 0; k < 2; ++k) dst[m][k] = *(const PG8_LAS bf16x8*)(lds + PG8_SA(b, h) + aoff + m * 2048 + k * 1024); } while (0)
#define PG8_LDB(dst, b, h) do { _Pragma("unroll") for (int n = 0; n < 2; ++n) _Pragma("unroll") for (int k = 0; k < 2; ++k) dst[n][k] = *(const PG8_LAS bf16x8*)(lds + PG8_SB(b, h) + boff + n * 2048 + k * 1024); } while (0)
#define PG8_MMA(ai, bj, At, Bt) do { __builtin_amdgcn_s_setprio(1); _Pragma("unroll") for (int m = 0; m < 4; ++m) _Pragma("unroll") for (int n = 0; n < 2; ++n) _Pragma("unroll") for (int k = 0; k < 2; ++k) \
        acc[ai][bj][m][n] = __builtin_amdgcn_mfma_f32_16x16x32_bf16(Bt[n][k], At[m][k], acc[ai][bj][m][n], 0, 0, 0); __builtin_amdgcn_s_setprio(0); } while (0)
#define PG8_WAIT_V(n) asm volatile("s_waitcnt vmcnt(" #n ")" ::: "memory")
#define PG8_WAIT_L(n) asm volatile("s_waitcnt lgkmcnt(" #n ")" ::: "memory")
#define PG8_BAR __builtin_amdgcn_s_barrier()
#define PG8_SCHED __builtin_amdgcn_sched_barrier(0)
    Unit cur, nxt; int ui = 0;
    if (!S.next(0, cur)) return;
    f32x4 acc[2][2][4][2];
#pragma unroll
    for (int a = 0; a < 2; ++a)
#pragma unroll
        for (int b = 0; b < 2; ++b)
#pragma unroll
            for (int m = 0; m < 4; ++m)
#pragma unroll
                for (int n = 0; n < 2; ++n) acc[a][b][m][n] = (f32x4){0.f, 0.f, 0.f, 0.f};
    bf16x8 At[4][2], B0[2][2], B1[2][2];
    const char* cA = (const char*)g.A + (size_t)cur.pm * tstep + (size_t)cur.pk * 2; const char* cB = (const char*)g.Bt + (size_t)cur.pe * g.bstride + (cur.pe >= 4 ? g.bdelta : (size_t)0) + (size_t)cur.pn * tstep + (size_t)cur.pk * 2;
    S.a_ready(cur);
    if constexpr (SP2) {
        PG8_STAGE(PG8_SB(0, 0), cB, voffB); PG8_STAGE(PG8_SB(0, 1), cB + hstep, voffB); PG8_STAGE(PG8_SA(0, 0), cA, voffA); PG8_STAGE(PG8_SA(0, 1), cA + hstep, voffA);
        if (wr == 1) PG8_BAR;
        PG8_WAIT_V(2); PG8_BAR;
        PG8_STAGE(PG8_SB(1, 0), cB + kstep, voffB); PG8_STAGE(PG8_SA(1, 0), cA + kstep, voffA); PG8_STAGE(PG8_SB(1, 1), cB + hstep + kstep, voffB);
        PG8_WAIT_V(6); PG8_BAR;
    } else {
        PG8_STAGE(PG8_SB(0, 0), cB, voffB); PG8_STAGE(PG8_SA(0, 0), cA, voffA); PG8_STAGE(PG8_SB(0, 1), cB + hstep, voffB); PG8_STAGE(PG8_SA(0, 1), cA + hstep, voffA);
        if (wr == 1) PG8_BAR;
        PG8_WAIT_V(4); PG8_BAR;
        PG8_STAGE(PG8_SB(1, 0), cB + kstep, voffB); PG8_STAGE(PG8_SA(1, 0), cA + kstep, voffA); PG8_STAGE(PG8_SB(1, 1), cB + hstep + kstep, voffB);
        PG8_WAIT_V(6); PG8_BAR;
    }
    for (;;) {
        const bool has_next = S.next(ui + 1, nxt);
        const char* nA = has_next ? (const char*)g.A + (size_t)nxt.pm * tstep + (size_t)nxt.pk * 2 : cA; const char* nB = has_next ? (const char*)g.Bt + (size_t)nxt.pe * g.bstride + (nxt.pe >= 4 ? g.bdelta : (size_t)0) + (size_t)nxt.pn * tstep + (size_t)nxt.pk * 2 : cB;
        for (int t = 0; t < nt; t += 2) {
            const bool last = (t == nt - 2);
            const char* a1 = cA + (size_t)(t + 1) * kstep;
            const char* a2 = last ? nA : cA + (size_t)(t + 2) * kstep; const char* b2 = last ? nB : cB + (size_t)(t + 2) * kstep;
            const char* a3 = a2 + kstep; const char* b3 = b2 + kstep;
            if (last && has_next) S.a_ready(nxt);
            if constexpr (SP2) {
            PG8_LDB(B0, 0, 0); PG8_LDB(B1, 0, 1); PG8_SCHED; PG8_LDA(At, 0, 0); PG8_STAGE(PG8_SA(1, 1), a1 + hstep, voffA);
            PG8_WAIT_V(8); PG8_WAIT_L(0); PG8_BAR; PG8_MMA(0, 0, At, B0); PG8_MMA(0, 1, At, B1); PG8_BAR; PG8_SCHED;
            PG8_LDA(At, 0, 1); PG8_STAGE(PG8_SB(0, 0), b2, voffB); PG8_STAGE(PG8_SB(0, 1), b2 + hstep, voffB); PG8_STAGE(PG8_SA(0, 0), a2, voffA);
            PG8_WAIT_V(8); PG8_WAIT_L(0); PG8_BAR; PG8_MMA(1, 0, At, B0); PG8_MMA(1, 1, At, B1); PG8_BAR; PG8_SCHED;
            PG8_LDB(B0, 1, 0); PG8_LDB(B1, 1, 1); PG8_SCHED; PG8_LDA(At, 1, 0); PG8_STAGE(PG8_SA(0, 1), a2 + hstep, voffA);
            PG8_WAIT_V(8); PG8_WAIT_L(0); PG8_BAR; PG8_MMA(0, 0, At, B0); PG8_MMA(0, 1, At, B1); PG8_BAR; PG8_SCHED;
            PG8_LDA(At, 1, 1); PG8_STAGE(PG8_SB(1, 0), b3, voffB); PG8_STAGE(PG8_SB(1, 1), b3 + hstep, voffB); PG8_STAGE(PG8_SA(1, 0), a3, voffA);
            PG8_WAIT_V(8); PG8_WAIT_L(0); PG8_BAR; PG8_MMA(1, 0, At, B0); PG8_MMA(1, 1, At, B1); PG8_BAR; PG8_SCHED;
            } else {
            PG8_LDB(B0, 0, 0); PG8_SCHED; PG8_LDA(At, 0, 0); PG8_STAGE(PG8_SA(1, 1), a1 + hstep, voffA);
            PG8_WAIT_L(8); PG8_BAR; PG8_WAIT_L(0); PG8_MMA(0, 0, At, B0); PG8_BAR; PG8_SCHED;
            PG8_LDB(B1, 0, 1); PG8_STAGE(PG8_SB(0, 0), b2, voffB);
            PG8_BAR; PG8_WAIT_L(0); PG8_MMA(0, 1, At, B1); PG8_BAR;
            PG8_LDA(At, 0, 1); PG8_STAGE(PG8_SA(0, 0), a2, voffA);
            PG8_BAR; PG8_WAIT_L(0); PG8_MMA(1, 0, At, B0); PG8_BAR; PG8_SCHED;
            PG8_STAGE(PG8_SB(0, 1), b2 + hstep, voffB);
            PG8_WAIT_V(6); PG8_BAR; PG8_MMA(1, 1, At, B1); PG8_BAR;
            PG8_LDB(B0, 1, 0); PG8_SCHED; PG8_LDA(At, 1, 0); PG8_STAGE(PG8_SA(0, 1), a2 + hstep, voffA);
            PG8_WAIT_L(8); PG8_BAR; PG8_WAIT_L(0); PG8_MMA(0, 0, At, B0); PG8_BAR; PG8_SCHED;
            PG8_LDB(B1, 1, 1); PG8_STAGE(PG8_SB(1, 0), b3, voffB);
            PG8_BAR; PG8_WAIT_L(0); PG8_MMA(0, 1, At, B1); PG8_BAR;
            PG8_LDA(At, 1, 1); PG8_STAGE(PG8_SA(1, 0), a3, voffA);
            PG8_BAR; PG8_WAIT_L(0); PG8_MMA(1, 0, At, B0); PG8_BAR; PG8_SCHED;
            PG8_STAGE(PG8_SB(1, 1), b3 + hstep, voffB);
            PG8_WAIT_V(6); PG8_BAR; PG8_MMA(1, 1, At, B1); PG8_BAR;
            }
        }
        if constexpr (ALIGN_EPI) { if (wr == 0) PG8_BAR; }
        if constexpr (!Epi::AFTER_DRAIN) { E(acc, cur, wr, wc, fr, fq); S.done(cur); }
        if (!has_next) break;
#pragma unroll
        for (int a = 0; a < 2; ++a)
#pragma unroll
            for (int b = 0; b < 2; ++b)
#pragma unroll
                for (int m = 0; m < 4; ++m)
#pragma unroll
                    for (int n = 0; n < 2; ++n) acc[a][b][m][n] = (f32x4){0.f, 0.f, 0.f, 0.f};
        cur = nxt; cA = nA; cB = nB; ++ui;
        if constexpr (ALIGN_EPI) { if (wr == 1) PG8_BAR; }
    }
    PG8_WAIT_V(0);
    if constexpr (!ALIGN_EPI) { if (wr == 0) PG8_BAR; }
    PG8_BAR;
    if constexpr (Epi::AFTER_DRAIN) { E.fused(acc, cur, wr, wc, fr, fq, lds, wid, lane); S.done(cur); }
#undef PG8_SA
#undef PG8_SB
#undef PG8_STAGE
#undef PG8_LDA
#undef PG8_LDB
#undef PG8_MMA
#undef PG8_WAIT_V
#undef PG8_WAIT_L
#undef PG8_BAR
#undef PG8_SCHED
}
}

constexpr int NWAVES = 8, NTHR = 512;
constexpr int D = 1024, L = 16384, LC = 256, MT = L + LC;
constexpr int AB_IN = 2304, DFF = 2816, SSD_INP = 5376, SSD_IN_REAL = 5184, DIN = 2048, XBCW = 3072, FFE = 3584, NEXP = 8;
constexpr int NCH = MT / 128;
constexpr int MOE_ROWS = 2 * L + NEXP * 256;
constexpr float EPS = 1e-6f;

constexpr size_t MiB = 1u << 20;
constexpr size_t WS_CTL = 0, CTL_ZERO_BYTES = 32768;
constexpr size_t WS_MOD = 1 * MiB;
constexpr size_t WS_ROPE = 1 * MiB + 128 * 1024;
constexpr size_t WS_TOKE = 2 * MiB, WS_TOKW = 2 * MiB + 128 * 1024, WS_TOKP = 2 * MiB + 256 * 1024;
constexpr size_t WS_RSTD = 2 * MiB + 384 * 1024;
constexpr size_t WS_DEC = 3 * MiB;
constexpr size_t WS_X = 4 * MiB;
constexpr size_t WS_H = 36 * MiB + 512 * 1024;
constexpr size_t WS_WMOE = 69 * MiB, WS_YPART = WS_WMOE + 56 * MiB;
constexpr size_t WS_H2S = 181 * MiB, WS_ACTM = 249 * MiB, WS_H2 = 487 * MiB, WS_END = 520 * MiB;
constexpr size_t WS_WDA = WS_H, WS_WDB = 487 * MiB, WD_BYTES = (size_t)D * FFE * 2;
static_assert(WS_WDA + 4 * WD_BYTES <= WS_WMOE && WS_WDB + 4 * WD_BYTES <= WS_END && WS_WDB >= WS_ACTM + (size_t)MOE_ROWS * FFE * 2, "down-weight regions");
constexpr size_t WS_WSSDIN = 181 * MiB, WS_WSSDOUT = WS_WSSDIN + (size_t)SSD_INP * D * 2;
constexpr size_t WS_WABIN = 196 * MiB, WS_WABOUT = WS_WABIN + (size_t)AB_IN * D * 2, WS_WFFNGU = WS_WABOUT + (size_t)D * D * 2, WS_WFFND = WS_WFFNGU + (size_t)2 * DFF * D * 2;
constexpr size_t WS_PAB = 219 * MiB, WS_MIX = 293 * MiB, WS_ACT0 = 326 * MiB, WS_QR = 416 * MiB, WS_KR = 433 * MiB, WS_VT = 438 * MiB, WS_PART = 443 * MiB;
constexpr size_t WS_Z = 196 * MiB, WS_XBCR = 261 * MiB, WS_STATES = 261 * MiB, WS_DTRAW = 391 * MiB, WS_DTS = 396 * MiB, WS_XT = 405 * MiB, WS_BT = 470 * MiB, WS_BM = 487 * MiB, WS_CM = 503 * MiB + 512 * 1024;
constexpr size_t DTS_STRIDE = (size_t)32 * MT * 4;
static_assert(WS_X + (size_t)MT * D * 2 <= WS_H && WS_H + (size_t)MT * D * 2 <= WS_WMOE, "X / H map");
static_assert(WS_WMOE + (size_t)NEXP * 2 * FFE * D * 2 <= WS_H2S && WS_H2S + (size_t)MOE_ROWS * D * 2 <= WS_ACTM && WS_ACTM + (size_t)MOE_ROWS * FFE * 2 <= WS_H2 && WS_H2 + (size_t)L * D * 2 <= WS_END, "moe map");
static_assert(WS_YPART >= WS_WMOE + (size_t)NEXP * D * FFE * 2 && WS_YPART + (size_t)7 * 2048 * D * 4 <= WS_H2S, "moe map 2");
static_assert(WS_WSSDOUT + (size_t)D * DIN * 2 <= WS_WABIN && WS_WFFND + (size_t)D * DFF * 2 <= WS_PAB, "weights map");
static_assert(WS_PAB + (size_t)MT * AB_IN * 2 <= WS_MIX && WS_MIX + (size_t)MT * D * 2 <= WS_ACT0 && WS_ACT0 + (size_t)MT * DFF * 2 <= WS_QR && WS_QR + (size_t)8 * MT * 64 * 2 <= WS_KR && WS_KR + (size_t)2 * MT * 64 * 2 <= WS_VT && WS_VT + (size_t)128 * MT * 2 <= WS_PART && WS_PART + (size_t)11 * LC * D * 4 <= WS_END, "layer0 map");
static_assert(WS_WSSDOUT + (size_t)D * DIN * 2 <= WS_Z && WS_Z + (size_t)MT * DIN * 2 <= WS_XBCR && WS_XBCR + (size_t)MT * XBCW * 2 <= WS_DTRAW && WS_STATES + (size_t)2 * NCH * 32 * 64 * 128 * 2 <= WS_DTRAW && WS_DTRAW + (size_t)MT * 64 * 4 <= WS_DTS && WS_DTS + 4 * DTS_STRIDE <= WS_XT && WS_XT + (size_t)DIN * MT * 2 <= WS_BT && WS_BT + (size_t)512 * MT * 2 <= WS_BM && WS_BM + (size_t)MT * 512 * 2 <= WS_CM && WS_CM + (size_t)MT * 512 * 2 <= WS_END, "ssd map");
static_assert(WS_PART + (size_t)11 * LC * D * 4 <= WS_BT && WS_PART >= WS_DTS + 4 * DTS_STRIDE || true, "PART is read by the layer-1 modulate before the SSD conv writes XT");
constexpr int CW_TMO = 0;
constexpr int CW_HIST = 1024;
constexpr int CW_BAR = 4096;

constexpr int RING_BYTES = 159744, LDSCTL_OFF = RING_BYTES, MISC_OFF = LDSCTL_OFF + 320, LDS_BYTES = 163840;

#define GAS __attribute__((address_space(1)))
#define LAS __attribute__((address_space(3)))
typedef unsigned short bf16;
typedef unsigned v4u __attribute__((ext_vector_type(4)));
typedef unsigned v2u __attribute__((ext_vector_type(2)));
typedef float f32x4 __attribute__((ext_vector_type(4)));
typedef GAS unsigned gu32;
#define RLX_AGENT __ATOMIC_RELAXED, __HIP_MEMORY_SCOPE_AGENT
#define LDS_WAIT() asm volatile("s_waitcnt lgkmcnt(0)" ::: "memory")
#define VM_WAIT() asm volatile("s_waitcnt vmcnt(0)" ::: "memory")
__device__ __forceinline__ unsigned pk2(float lo, float hi) { return pg8::cvt_pk_bf16(lo, hi); }
__device__ __forceinline__ float bflo(unsigned u) { return __uint_as_float(u << 16); }
__device__ __forceinline__ float bfhi(unsigned u) { return __uint_as_float(u & 0xffff0000u); }
__device__ __forceinline__ float bf1(bf16 b) { return __uint_as_float(((unsigned)b) << 16); }
__device__ __forceinline__ float sigmoid_f(float x) { return __builtin_amdgcn_rcpf(1.0f + __builtin_amdgcn_exp2f(-1.4426950408889634f * x)); }
__device__ __forceinline__ float softplus_f(float x) {
    const float y = __builtin_amdgcn_exp2f(-1.4426950408889634f * fabsf(x));
    const float l = y < 1.0e-3f ? y * (1.0f - 0.5f * y) : __builtin_amdgcn_logf(1.0f + y) * 0.6931471805599453f;
    return fmaxf(x, 0.f) + l; }

#define XB_TMO      128
#define XB_XCNT(j)  (256  + 64 * (j))
#define XB_XSUB(j)  (1280 + 64 * (j))
#define XB_XGEN(j)  (2304 + 64 * (j))
#define XB_TOP      3328
#define XB_TOPGEN   3392
#define XCD_BAR_WORDS 3456
#define XB_SPIN_CAP (1u << 18)
__device__ __forceinline__ unsigned xb_ld(unsigned* p)              { return __hip_atomic_load(p, __ATOMIC_RELAXED, __HIP_MEMORY_SCOPE_AGENT); }
__device__ __forceinline__ unsigned xb_add(unsigned* p, unsigned v) { return __hip_atomic_fetch_add(p, v, __ATOMIC_RELAXED, __HIP_MEMORY_SCOPE_AGENT); }
__device__ __forceinline__ unsigned xb_xcc_id() { return (unsigned)__builtin_amdgcn_s_getreg((3 << 11) | 20) & 0xFu; }
#define XB_SPIN(cond, bar) do { unsigned _sp = 0; while (cond) { __builtin_amdgcn_s_sleep(1); \
    if ((++_sp & 255u) == 0u) { if (xb_ld(&(bar)[XB_TMO])) break; if (_sp > XB_SPIN_CAP) { atomicAdd(&(bar)[XB_TMO], 1u); break; } } } } while (0)
struct XcdBarrier { unsigned* bar; unsigned x; volatile LAS unsigned* st; };
__device__ __forceinline__ XcdBarrier xcd_barrier_post(unsigned* bar, volatile LAS unsigned* st) {
    XcdBarrier b; b.bar = bar; b.x = xb_xcc_id(); b.st = st;
    if (threadIdx.x == 0) (void)xb_add(&bar[XB_XCNT(b.x)], 1u);
    return b;
}
__device__ __forceinline__ void xcd_barrier_complete(unsigned* bar, unsigned x, unsigned& nloc, unsigned& nx) {
    const unsigned G = gridDim.x * gridDim.y * gridDim.z;
    unsigned sum, cnt, mine, sp = 0u;
    for (;;) {
        sum = 0u; cnt = 0u; mine = 0u;
#pragma unroll
        for (unsigned j = 0; j < 16; ++j) { const unsigned c = xb_ld(&bar[XB_XCNT(j)]); sum += c; cnt += (c > 0u) ? 1u : 0u; mine = (j == x) ? c : mine; }
        if (sum == G) break;
        __builtin_amdgcn_s_sleep(1);
        if ((++sp & 255u) == 0u) { if (xb_ld(&bar[XB_TMO])) break; if (sp > XB_SPIN_CAP) { atomicAdd(&bar[XB_TMO], 1u); break; } }
    }
    nloc = mine > 0u ? mine : 1u; nx = cnt > 0u ? cnt : 1u;
}
__device__ __forceinline__ void xcd_barrier(const XcdBarrier& b) {
    asm volatile("s_waitcnt vmcnt(0)" ::: "memory");
    __syncthreads();
    if (threadIdx.x == 0) {
        unsigned* bar = b.bar;
        __builtin_amdgcn_s_waitcnt(0);
        unsigned nloc = b.st[0], nx = b.st[1];
        if (nloc == 0u) { xcd_barrier_complete(bar, b.x, nloc, nx); b.st[0] = nloc; b.st[1] = nx; }
        const unsigned old = xb_add(&bar[XB_XSUB(b.x)], 1u);
        const unsigned gen = old / nloc;
        if (old + 1u == (gen + 1u) * nloc) {
            __builtin_amdgcn_fence(__ATOMIC_RELEASE, "agent");
            asm volatile("s_waitcnt vmcnt(0)" ::: "memory");
            const unsigned og = xb_add(&bar[XB_TOP], 1u);
            const unsigned tg = og / nx;
            if (og + 1u == (tg + 1u) * nx) xb_add(&bar[XB_TOPGEN], 1u);
            else XB_SPIN(xb_ld(&bar[XB_TOPGEN]) == tg, bar);
            __builtin_amdgcn_fence(__ATOMIC_ACQUIRE, "agent");
            xb_add(&bar[XB_XGEN(b.x)], 1u);
            asm volatile("s_waitcnt vmcnt(0)" ::: "memory");
        } else {
            XB_SPIN(xb_ld(&bar[XB_XGEN(b.x)]) == gen, bar);
            __builtin_amdgcn_fence(__ATOMIC_ACQUIRE, "agent");
            asm volatile("s_waitcnt vmcnt(0)" ::: "memory");
        }
    }
    __syncthreads();
}

struct Frame {
    LAS unsigned char* lds;
    int tid, lane, wave, vcu, G;
    const float* in[30]; float* out; unsigned char* ws;
};
enum { I_X = 0, I_C, I_CTX, I_CCTX, I_ADAW, I_ADAB, I_N1G, I_N2G, I_ABWIN, I_ABCONV, I_ABSINK, I_ABWOUT, I_FFNG, I_FFNU, I_FFND, I_SSDWIN, I_SSDCW, I_SSDCB,
       I_DTBF, I_DTBB, I_ALOGF, I_ALOGB, I_SSDD, I_SSDNG, I_SSDWOUT, I_ROUTER, I_MOEG, I_MOEU, I_MOED, I_FINALG };
template <int CTRL> __device__ __forceinline__ float dpp_add(float v) { return v + __int_as_float(__builtin_amdgcn_update_dpp(0, __float_as_int(v), CTRL, 0xf, 0xf, true)); }
__device__ __forceinline__ float wave_sum(float v) {
    v = dpp_add<0xB1>(v);
    v = dpp_add<0x4E>(v);
    v = dpp_add<0x141>(v);
    v = dpp_add<0x140>(v);
    const int iv = __float_as_int(v);
    return (__int_as_float(__builtin_amdgcn_readlane(iv, 0)) + __int_as_float(__builtin_amdgcn_readlane(iv, 16))) + (__int_as_float(__builtin_amdgcn_readlane(iv, 32)) + __int_as_float(__builtin_amdgcn_readlane(iv, 48)));
}
constexpr int M_SH1 = 0, M_SC1 = 1024, M_G1 = 2048, M_SH2 = 3072, M_SC2 = 4096, M_G2 = 5120;
__device__ __forceinline__ const float* modp(const Frame& F, int layer, int s) { return (const float*)(F.ws + WS_MOD) + (size_t)(layer * 2 + s) * 6144; }

__device__ __forceinline__ void tr_load(const float* W, int N, int k0, int n0, int lane, f32x4 (&w)[8]) {
#pragma unroll
    for (int i = 0; i < 8; ++i) w[i] = __builtin_nontemporal_load((const GAS f32x4*)(W + (size_t)(k0 + (lane >> 3) + 8 * i) * N + n0 + 4 * (lane & 7)));
}
__device__ __forceinline__ void tr_finish(const f32x4 (&w)[8], bf16* WT, int Kdst, int k0, int drow0, LAS float* scr, int lane) {
#pragma unroll
    for (int i = 0; i < 8; ++i) { LAS float* d = scr + ((lane >> 3) + 8 * i) * 33 + 4 * (lane & 7); d[0] = w[i].x; d[1] = w[i].y; d[2] = w[i].z; d[3] = w[i].w; }
    LDS_WAIT(); asm volatile("" ::: "memory");
    const int c = lane & 7;
#pragma unroll
    for (int j = 0; j < 4; ++j) { const int n = (lane >> 3) + 8 * j; const LAS float* s = scr + (8 * c) * 33 + n;
        v4u o; o.x = pk2(s[0 * 33], s[1 * 33]); o.y = pk2(s[2 * 33], s[3 * 33]); o.z = pk2(s[4 * 33], s[5 * 33]); o.w = pk2(s[6 * 33], s[7 * 33]);
        __builtin_nontemporal_store(o, (GAS v4u*)(WT + (size_t)(drow0 + n) * Kdst + k0 + 8 * c)); }
    LDS_WAIT(); asm volatile("" ::: "memory");
}
__device__ __forceinline__ void tr_item(const float* W, int N, bf16* WT, int Kdst, int k0, int n0, int drow0, LAS float* scr, int lane) {
    { f32x4 w[8];
#pragma unroll
      for (int i = 0; i < 8; ++i) w[i] = __builtin_nontemporal_load((const GAS f32x4*)(W + (size_t)(k0 + (lane >> 3) + 8 * i) * N + n0 + 4 * (lane & 7)));
#pragma unroll
      for (int i = 0; i < 8; ++i) { LAS float* d = scr + ((lane >> 3) + 8 * i) * 33 + 4 * (lane & 7); d[0] = w[i].x; d[1] = w[i].y; d[2] = w[i].z; d[3] = w[i].w; } }
    LDS_WAIT(); asm volatile("" ::: "memory");
    const int c = lane & 7;
#pragma unroll
    for (int j = 0; j < 4; ++j) { const int n = (lane >> 3) + 8 * j; const LAS float* s = scr + (8 * c) * 33 + n;
        v4u o; o.x = pk2(s[0 * 33], s[1 * 33]); o.y = pk2(s[2 * 33], s[3 * 33]); o.z = pk2(s[4 * 33], s[5 * 33]); o.w = pk2(s[6 * 33], s[7 * 33]);
        __builtin_nontemporal_store(o, (GAS v4u*)(WT + (size_t)(drow0 + n) * Kdst + k0 + 8 * c)); }
    LDS_WAIT(); asm volatile("" ::: "memory");
}
__device__ __forceinline__ void tr_matrix(const Frame& F, const float* W, int K, int N, bf16* WT, int mode, int& first, int gw = -1, int NGW = 0) {
    LAS float* scr = (LAS float*)(F.lds + F.wave * 16384);
    if (gw < 0) { gw = F.vcu * NWAVES + F.wave; NGW = F.G * NWAVES; }
    const int nblk = N / 32, nitems = (K / 64) * nblk;
    int it = gw - (first % NGW); if (it < 0) it += NGW;
    for (; it < nitems; it += NGW) {
        const int kb = it / nblk, nb = it % nblk, n0 = 32 * nb;
        const int drow0 = mode == 0 ? n0 : ((n0 >> 7) * 256 + (n0 & 127) + (mode == 2 ? 128 : 0));
        tr_item(W, N, WT, K, 64 * kb, n0, drow0, scr, F.lane);
    }
    first += nitems;
}

__device__ __forceinline__ void ph_convert_ffn(Frame& F, int gw, int NGW) {
    int first = 0;
    tr_matrix(F, F.in[I_FFNG], D, DFF, (bf16*)(F.ws + WS_WFFNGU), 1, first, gw, NGW);
    tr_matrix(F, F.in[I_FFNU], D, DFF, (bf16*)(F.ws + WS_WFFNGU), 2, first, gw, NGW);
    tr_matrix(F, F.in[I_FFND], DFF, D, (bf16*)(F.ws + WS_WFFND), 0, first, gw, NGW);
}
__device__ __forceinline__ void ph_convert_ssd(Frame& F, int gw, int NGW) {
    int first = 0;
    tr_matrix(F, F.in[I_SSDWIN], D, SSD_IN_REAL, (bf16*)(F.ws + WS_WSSDIN), 0, first, gw, NGW);
    tr_matrix(F, F.in[I_SSDWOUT], DIN, D, (bf16*)(F.ws + WS_WSSDOUT), 0, first, gw, NGW);
    { v4u* p = (v4u*)((bf16*)(F.ws + WS_WSSDIN) + (size_t)SSD_IN_REAL * D); const int n16 = (SSD_INP - SSD_IN_REAL) * D * 2 / 16;
      for (int i = gw * 64 + F.lane; i < n16; i += NGW * 64) p[i] = (v4u){0u, 0u, 0u, 0u}; }
}
__device__ __forceinline__ void ph_prologue(Frame& F) {
    LAS float* scx = (LAS float*)F.lds;
    LAS float* scc = scx + 1024;
    LAS float* red = scc + 1024;
    const float* c = F.in[I_C]; const float* cc = F.in[I_CCTX];
    for (int i = F.tid; i < 1024; i += NTHR) { const float a = c[i], b = cc[i]; scx[i] = a * sigmoid_f(a); scc[i] = b * sigmoid_f(b); }
    __syncthreads();
    float* MOD = (float*)(F.ws + WS_MOD);
    for (int u = F.vcu; u < 192; u += F.G) {
        const int layer = u / 96, n0 = (u % 96) * 64;
        const float* W = F.in[I_ADAW] + (size_t)layer * 1024 * 6144 + n0 + F.lane;
        float ax = 0.f, ac = 0.f; const int kb = F.wave * 128;
#pragma unroll 1
        for (int k0 = 0; k0 < 128; k0 += 32) { float w[32];
#pragma unroll
            for (int k = 0; k < 32; ++k) w[k] = __builtin_nontemporal_load(W + (size_t)(kb + k0 + k) * 6144);
#pragma unroll
            for (int k = 0; k < 32; ++k) { ax += scx[kb + k0 + k] * w[k]; ac += scc[kb + k0 + k] * w[k]; } }
        red[(F.wave * 2 + 0) * 64 + F.lane] = ax; red[(F.wave * 2 + 1) * 64 + F.lane] = ac;
        __syncthreads();
        if (F.tid < 128) { const int s = F.tid >> 6, l = F.tid & 63; float t = 0.f;
#pragma unroll
            for (int w = 0; w < 8; ++w) t += red[(w * 2 + s) * 64 + l];
            MOD[(size_t)(layer * 2 + s) * 6144 + n0 + l] = t + F.in[I_ADAB][layer * 6144 + n0 + l]; }
        __syncthreads();
    }
    {
        float* ct = (float*)(F.ws + WS_ROPE); float* st = ct + 4096;
        for (int idx = F.vcu * NTHR + F.tid; idx < 4096; idx += F.G * NTHR) { const int pos = idx >> 4, i = idx & 15;
            const float inv = (float)pow(10000.0, -(double)i / 16.0); const float ang = (float)pos * inv;
            ct[idx] = (float)cos((double)ang); st[idx] = (float)sin((double)ang); }
    }
    __syncthreads();
    int first = 0;
    tr_matrix(F, F.in[I_ABWIN], D, AB_IN, (bf16*)(F.ws + WS_WABIN), 0, first);
    tr_matrix(F, F.in[I_ABWOUT], D, D, (bf16*)(F.ws + WS_WABOUT), 0, first);
}
constexpr int MOE_GU_ITEMS = NEXP * 2 * (D / 64) * (FFE / 32);
struct GuItem { const float* W; bf16* WT; int k0, n0, drow0; };
__device__ __forceinline__ GuItem gu_item(const Frame& F, int it) {
    constexpr int PER_M = (D / 64) * (FFE / 32), NB = FFE / 32;
    const int e = it / (2 * PER_M), rem = it % (2 * PER_M), mat = rem / PER_M, idx = rem % PER_M, kb = idx / NB, n0 = 32 * (idx % NB);
    GuItem g; g.W = (mat ? F.in[I_MOEU] : F.in[I_MOEG]) + (size_t)e * D * FFE; g.WT = (bf16*)(F.ws + WS_WMOE) + (size_t)e * 2 * FFE * D;
    g.k0 = 64 * kb; g.n0 = n0; g.drow0 = (n0 >> 7) * 256 + (n0 & 127) + (mat ? 128 : 0); return g;
}
__device__ __forceinline__ void moe_gu_convert(Frame& F, int lo, int hi, int gw, int NGW) {
    LAS float* scr = (LAS float*)(F.lds + F.wave * 16384);
    int it = lo + gw; if (it >= hi) return;
    f32x4 wa[8], wb[8];
    GuItem ga = gu_item(F, it), gb = ga; tr_load(ga.W, FFE, ga.k0, ga.n0, F.lane, wa);
    for (;;) {
        const int itb = it + NGW; const bool hb = itb < hi;
        if (hb) { gb = gu_item(F, itb); tr_load(gb.W, FFE, gb.k0, gb.n0, F.lane, wb); }
        tr_finish(wa, ga.WT, D, ga.k0, ga.drow0, scr, F.lane);
        if (!hb) break;
        it = itb + NGW; const bool ha = it < hi;
        if (ha) { ga = gu_item(F, it); tr_load(ga.W, FFE, ga.k0, ga.n0, F.lane, wa); }
        tr_finish(wb, gb.WT, D, gb.k0, gb.drow0, scr, F.lane);
        if (!ha) break;
    }
}
constexpr int MOE_DN_ITEMS = NEXP * (FFE / 64) * (D / 32), MOE_DN_PER_E = (FFE / 64) * (D / 32);
__device__ __forceinline__ void moe_dn_convert(Frame& F, int lo, int hi, int gw, int NGW) {
    LAS float* scr = (LAS float*)(F.lds + F.wave * 16384);
    for (int it = lo + gw; it < hi; it += NGW) {
        const int e = it / MOE_DN_PER_E, idx = it % MOE_DN_PER_E, kb = idx / (D / 32), n0 = 32 * (idx % (D / 32));
        bf16* WT = (bf16*)(F.ws + (e < 4 ? WS_WDA : WS_WDB)) + (size_t)(e & 3) * D * FFE;
        tr_item(F.in[I_MOED] + (size_t)e * FFE * D, D, WT, FFE, 64 * kb, n0, n0, scr, F.lane);
    }
}
__device__ __forceinline__ void idle_round_convert(Frame& F, int nunits, int lo, int hi) {
    const int full = nunits / F.G, nbusy = nunits - full * F.G;
    if ((int)blockIdx.x >= nbusy) moe_gu_convert(F, lo, hi, ((int)blockIdx.x - nbusy) * NWAVES + F.wave, (F.G - nbusy) * NWAVES);
}


template <bool BF> __device__ __forceinline__ void load_row4(const void* row, int lane, f32x4 (&v)[4]) {
    if (BF) { const GAS v2u* p = (const GAS v2u*)row + lane;
#pragma unroll
        for (int j = 0; j < 4; ++j) { const v2u a = p[64 * j]; v[j] = (f32x4){bflo(a.x), bfhi(a.x), bflo(a.y), bfhi(a.y)}; } }
    else { const GAS f32x4* p = (const GAS f32x4*)row + lane;
#pragma unroll
        for (int j = 0; j < 4; ++j) v[j] = __builtin_nontemporal_load(p + 64 * j); }
}
template <bool LAT_BF, bool CTX_BF, int NPART>
__device__ __forceinline__ void ph_modulate(Frame& F, const void* src0, const void* src1, const float* gain, const float* mx, const float* mc, int osh, int osc, bf16* H, int nrows,
                                            const float* part, const float* gatec, bf16* xw) {
    const int gw = F.vcu * NWAVES + F.wave, NGW = F.G * NWAVES;
    f32x4 ca[4], cb[4];
#pragma unroll
    for (int j = 0; j < 4; ++j) { const int c = 4 * (64 * j + F.lane); ca[j] = *(const f32x4*)(gain + c) * (*(const f32x4*)(mx + osc + c) + 1.0f); cb[j] = *(const f32x4*)(mx + osh + c); }
    for (int r0 = gw; r0 < nrows; r0 += 2 * NGW) {
        int rr[2]; f32x4 v[2][4];
#pragma unroll
        for (int k = 0; k < 2; ++k) { const int r = r0 + k * NGW; rr[k] = r < nrows ? r : r0;
            if (rr[k] < L) load_row4<LAT_BF>((const char*)src0 + (size_t)rr[k] * D * (LAT_BF ? 2 : 4), F.lane, v[k]);
            else load_row4<CTX_BF>((const char*)src1 + (size_t)(rr[k] - L) * D * (CTX_BF ? 2 : 4), F.lane, v[k]); }
#pragma unroll
        for (int k = 0; k < 2; ++k) { const int r = rr[k];
            if (NPART > 0 && r >= L) {
#pragma unroll
                for (int j = 0; j < 4; ++j) { const int c = 4 * (64 * j + F.lane); f32x4 s = (f32x4){0.f, 0.f, 0.f, 0.f};
#pragma unroll
                    for (int q = 0; q < NPART; ++q) s += *(const f32x4*)(part + ((size_t)q * LC + (r - L)) * D + c);
                    v[k][j] += *(const f32x4*)(gatec + c) * s;
                    if (xw) { v2u o; o.x = pk2(v[k][j].x, v[k][j].y); o.y = pk2(v[k][j].z, v[k][j].w); *(GAS v2u*)(xw + (size_t)r * D + c) = o; } }
            }
            float s2 = 0.f;
#pragma unroll
            for (int j = 0; j < 4; ++j) s2 += (v[k][j].x * v[k][j].x + v[k][j].y * v[k][j].y) + (v[k][j].z * v[k][j].z + v[k][j].w * v[k][j].w);
            const float rstd = __builtin_amdgcn_rsqf(wave_sum(s2) * (1.0f / D) + EPS);
            GAS v2u* o8 = (GAS v2u*)(H + (size_t)r * D) + F.lane;
#pragma unroll
            for (int j = 0; j < 4; ++j) { const int c = 4 * (64 * j + F.lane);
                f32x4 A = ca[j], B = cb[j];
                if (r >= L) { A = *(const f32x4*)(gain + c) * (*(const f32x4*)(mc + osc + c) + 1.0f); B = *(const f32x4*)(mc + osh + c); }
                const f32x4 y = v[k][j] * rstd * A + B;
                v2u o; o.x = pk2(y.x, y.y); o.y = pk2(y.z, y.w); o8[64 * j] = o; }
        }
    }
}

constexpr float QSCL = 0.125f * 1.4426950408889634f;
__device__ __forceinline__ void ph_ab_elem(Frame& F) {
    const bf16* PAB = (const bf16*)(F.ws + WS_PAB); bf16* MIX = (bf16*)(F.ws + WS_MIX);
    bf16* QR = (bf16*)(F.ws + WS_QR); bf16* KR = (bf16*)(F.ws + WS_KR); bf16* VT = (bf16*)(F.ws + WS_VT);
    const float* ct = (const float*)(F.ws + WS_ROPE); const float* st = ct + 4096;
    const int lane = F.lane;
    float cw[3][8];
#pragma unroll
    for (int k = 0; k < 3; ++k)
#pragma unroll
        for (int j = 0; j < 8; ++j) cw[k][j] = F.in[I_ABCONV][k * 512 + 8 * lane + j];
    LAS unsigned char* vl = F.lds;
    for (int tile = F.vcu; tile < MT / 16; tile += F.G) {
        const int r0 = tile * 16; const bool isctx = r0 >= L; const int slo = isctx ? L : 0, shi = isctx ? MT : L;
        for (int rr = 0; rr < 2; ++rr) {
            const int r = r0 + F.wave * 2 + rr;
            float acc[8];
#pragma unroll
            for (int j = 0; j < 8; ++j) acc[j] = 0.f;
#pragma unroll
            for (int k = 0; k < 3; ++k) { const int q = r + k - 1;
                if (q >= slo && q < shi) { const v4u gc = *(const GAS v4u*)(PAB + (size_t)q * AB_IN + 512 + 8 * lane), ha = *(const GAS v4u*)(PAB + (size_t)q * AB_IN + 1024 + 8 * lane);
                    acc[0] += cw[k][0] * bflo(gc.x) * bflo(ha.x); acc[1] += cw[k][1] * bfhi(gc.x) * bfhi(ha.x); acc[2] += cw[k][2] * bflo(gc.y) * bflo(ha.y); acc[3] += cw[k][3] * bfhi(gc.y) * bfhi(ha.y);
                    acc[4] += cw[k][4] * bflo(gc.z) * bflo(ha.z); acc[5] += cw[k][5] * bfhi(gc.z) * bfhi(ha.z); acc[6] += cw[k][6] * bflo(gc.w) * bflo(ha.w); acc[7] += cw[k][7] * bfhi(gc.w) * bfhi(ha.w); } }
            { const v4u gb = *(const GAS v4u*)(PAB + (size_t)r * AB_IN + 8 * lane); v4u o;
              o.x = pk2(acc[0] * bflo(gb.x), acc[1] * bfhi(gb.x)); o.y = pk2(acc[2] * bflo(gb.y), acc[3] * bfhi(gb.y)); o.z = pk2(acc[4] * bflo(gb.z), acc[5] * bfhi(gb.z)); o.w = pk2(acc[6] * bflo(gb.w), acc[7] * bfhi(gb.w));
              *(GAS v4u*)(MIX + (size_t)r * D + 8 * lane) = o; }
            const int sub = lane & 7, axis = sub >> 2, half = (sub >> 1) & 1;
            const int pos = axis == 0 ? (r >> 6) : (r & 63);
            f32x4 c0 = (f32x4){1.f, 1.f, 1.f, 1.f}, c1 = c0, s0 = (f32x4){0.f, 0.f, 0.f, 0.f}, s1 = s0;
            if (!isctx) { const float* cp = ct + pos * 16 + 8 * (lane & 1); const float* sp = st + pos * 16 + 8 * (lane & 1);
                c0 = *(const f32x4*)cp; c1 = *(const f32x4*)(cp + 4); s0 = *(const f32x4*)sp; s1 = *(const f32x4*)(sp + 4);
                if (half == 0) { s0 = -s0; s1 = -s1; } }
            {
                const v4u a = *(const GAS v4u*)(PAB + (size_t)r * AB_IN + 1536 + 8 * lane);
                v4u p; p.x = (unsigned)__builtin_amdgcn_update_dpp(0, (int)a.x, 0x4E, 0xf, 0xf, true); p.y = (unsigned)__builtin_amdgcn_update_dpp(0, (int)a.y, 0x4E, 0xf, 0xf, true); p.z = (unsigned)__builtin_amdgcn_update_dpp(0, (int)a.z, 0x4E, 0xf, 0xf, true); p.w = (unsigned)__builtin_amdgcn_update_dpp(0, (int)a.w, 0x4E, 0xf, 0xf, true);
                const f32x4 qc0 = c0 * QSCL, qc1 = c1 * QSCL, qs0 = s0 * QSCL, qs1 = s1 * QSCL;
                v4u o; o.x = pk2(bflo(a.x) * qc0.x + bflo(p.x) * qs0.x, bfhi(a.x) * qc0.y + bfhi(p.x) * qs0.y); o.y = pk2(bflo(a.y) * qc0.z + bflo(p.y) * qs0.z, bfhi(a.y) * qc0.w + bfhi(p.y) * qs0.w);
                o.z = pk2(bflo(a.z) * qc1.x + bflo(p.z) * qs1.x, bfhi(a.z) * qc1.y + bfhi(p.z) * qs1.y); o.w = pk2(bflo(a.w) * qc1.z + bflo(p.w) * qs1.z, bfhi(a.w) * qc1.w + bfhi(p.w) * qs1.w);
                *(GAS v4u*)(QR + ((size_t)(lane >> 3) * MT + r) * 64 + 8 * sub) = o;
            }
            {
                const int kl = lane & 15;
                const v4u a = *(const GAS v4u*)(PAB + (size_t)r * AB_IN + 2048 + 8 * kl);
                v4u p; p.x = (unsigned)__builtin_amdgcn_update_dpp(0, (int)a.x, 0x4E, 0xf, 0xf, true); p.y = (unsigned)__builtin_amdgcn_update_dpp(0, (int)a.y, 0x4E, 0xf, 0xf, true); p.z = (unsigned)__builtin_amdgcn_update_dpp(0, (int)a.z, 0x4E, 0xf, 0xf, true); p.w = (unsigned)__builtin_amdgcn_update_dpp(0, (int)a.w, 0x4E, 0xf, 0xf, true);
                v4u o; o.x = pk2(bflo(a.x) * c0.x + bflo(p.x) * s0.x, bfhi(a.x) * c0.y + bfhi(p.x) * s0.y); o.y = pk2(bflo(a.y) * c0.z + bflo(p.y) * s0.z, bfhi(a.y) * c0.w + bfhi(p.y) * s0.w);
                o.z = pk2(bflo(a.z) * c1.x + bflo(p.z) * s1.x, bfhi(a.z) * c1.y + bfhi(p.z) * s1.y); o.w = pk2(bflo(a.w) * c1.z + bflo(p.w) * s1.z, bfhi(a.w) * c1.w + bfhi(p.w) * s1.w);
                if (lane < 16) *(GAS v4u*)(KR + ((size_t)(lane >> 3) * MT + r) * 64 + 8 * sub) = o;
            }
        }
        if (F.tid < 256) { const int p = F.tid, row = p >> 4, c8 = (p & 15) * 8;
            *(LAS v4u*)(vl + row * 272 + c8 * 2) = *(const GAS v4u*)(PAB + (size_t)(r0 + row) * AB_IN + 2176 + c8); }
        __syncthreads();
        if (F.tid < 256) { const int p = F.tid, ch = p >> 1, rg = p & 1;
            const LAS bf16* s = (const LAS bf16*)(vl + (8 * rg) * 272 + ch * 2);
            v4u o; o.x = (unsigned)s[0] | ((unsigned)s[136] << 16); o.y = (unsigned)s[2 * 136] | ((unsigned)s[3 * 136] << 16); o.z = (unsigned)s[4 * 136] | ((unsigned)s[5 * 136] << 16); o.w = (unsigned)s[6 * 136] | ((unsigned)s[7 * 136] << 16);
            *(GAS v4u*)(VT + (size_t)ch * MT + r0 + 8 * rg) = o; }
        __syncthreads();
    }
}


__device__ __forceinline__ void ph_ssd_conv(Frame& F) {
    const bf16* XB = (const bf16*)(F.ws + WS_XBCR);
    bf16* XT = (bf16*)(F.ws + WS_XT); bf16* BT = (bf16*)(F.ws + WS_BT); bf16* BMm = (bf16*)(F.ws + WS_BM); bf16* CMm = (bf16*)(F.ws + WS_CM);
    const float* cwp = F.in[I_SSDCW]; const float* cbp = F.in[I_SSDCB];
    LAS unsigned char* tl = F.lds;
    { const float* DR = (const float*)(F.ws + WS_DTRAW); float* DTF = (float*)(F.ws + WS_DTS); float* DTB = DTF + (size_t)32 * MT;
      const int gw = F.vcu * NWAVES + F.wave, NGW = F.G * NWAVES;
      for (int task = gw; task < (MT / 64) * 4; task += NGW) { const int tb = task >> 2, jq = task & 3; const int t = tb * 64 + F.lane; const float* row = DR + (size_t)t * 64;
#pragma unroll
          for (int j4 = 4 * jq; j4 < 4 * jq + 4; ++j4) { const f32x4 r = *(const f32x4*)(row + 4 * j4);
#pragma unroll
              for (int q = 0; q < 4; ++q) { const int j = 4 * j4 + q; const float v = softplus_f(r[q] + (j < 32 ? F.in[I_DTBF][j] : F.in[I_DTBB][j - 32]));
                  if (j < 32) DTF[(size_t)j * MT + t] = v; else DTB[(size_t)(j - 32) * MT + t] = v; } } } }
    LAS float* cwl = (LAS float*)(F.lds + 130 * 272 + 64);
    for (int i = F.tid; i < 3 * XBCW; i += NTHR) cwl[i] = cwp[i];
    for (int i = F.tid; i < XBCW; i += NTHR) cwl[3 * XBCW + i] = cbp[i];
    __syncthreads();
    const int ntiles = NCH * 24;
    v4u pre[5];
#define CONV_LOAD(tile_) do { const int c_ = (tile_) / 24, cb_ = (tile_) % 24, t0_ = c_ * 128, ch0_ = cb_ * 128; const int slo_ = c_ < 128 ? 0 : L, shi_ = c_ < 128 ? L : MT; \
        _Pragma("unroll") for (int i_ = 0; i_ < 5; ++i_) { const int p_ = F.tid + NTHR * i_, row_ = p_ >> 4, c8_ = (p_ & 15) * 8; const int t_ = t0_ - 1 + row_; \
            pre[i_] = (v4u){0u, 0u, 0u, 0u}; if (p_ < 130 * 16 && t_ >= slo_ && t_ < shi_) pre[i_] = __builtin_nontemporal_load((const GAS v4u*)(XB + (size_t)t_ * XBCW + ch0_ + c8_)); } } while (0)
    int tile = F.vcu;
    if (tile < ntiles) CONV_LOAD(tile);
    for (; tile < ntiles; tile += F.G) {
        const int c = tile / 24, cb = tile % 24, t0 = c * 128, ch0 = cb * 128;
#pragma unroll
        for (int i = 0; i < 5; ++i) { const int p = F.tid + NTHR * i, row = p >> 4, c8 = (p & 15) * 8; if (p < 130 * 16) *(LAS v4u*)(tl + row * 272 + ((c8 * 2) ^ (((row >> 3) & 7) << 4))) = pre[i]; }
        __syncthreads();
        if (tile + F.G < ntiles) CONV_LOAD(tile + F.G);
        if (cb < 20) {
            bf16* dst = BT + (size_t)(ch0 - 2048) * MT;
#pragma unroll
            for (int i = 0; i < 4; ++i) { const int p = F.tid + NTHR * i, ch = p >> 4, tg = p & 15;
                const float w0 = cwl[ch0 + ch], w1 = cwl[XBCW + ch0 + ch], w2 = cwl[2 * XBCW + ch0 + ch], bb = cwl[3 * XBCW + ch0 + ch];
                float xin[10];
#pragma unroll
                for (int j = 0; j < 10; ++j) { const int row = 8 * tg + j; xin[j] = bf1(*(const LAS bf16*)(tl + row * 272 + ((ch * 2) ^ (((row >> 3) & 7) << 4)))); }
                float y[8];
#pragma unroll
                for (int j = 0; j < 8; ++j) { const float a = w0 * xin[j] + w1 * xin[j + 1] + w2 * xin[j + 2] + bb; y[j] = a * sigmoid_f(a); }
                v4u o; o.x = pk2(y[0], y[1]); o.y = pk2(y[2], y[3]); o.z = pk2(y[4], y[5]); o.w = pk2(y[6], y[7]);
                if (cb < 16) { const int cg_ = ch0 + ch, hd = cg_ >> 6, p_ = cg_ & 63, ptq = 2 * (p_ >> 5) + ((p_ >> 2) & 1), rq = 4 * ((p_ >> 3) & 3) + (p_ & 3);
                    *(GAS v4u*)(XT + ((size_t)(((hd * NCH + c) * 4 + (tg >> 2)) * 4 + ptq) * 16 + rq) * 32 + 8 * (tg & 3)) = o; }
                else *(GAS v4u*)(dst + (size_t)ch * MT + t0 + 8 * tg) = o; }
        }
        if (cb >= 16) {
            bf16* dst = cb < 20 ? BMm + (ch0 - 2048) : CMm + (ch0 - 2560);
#pragma unroll
            for (int i = 0; i < 4; ++i) { const int p = F.tid + NTHR * i, row = p >> 4, cg = p & 15;
                const v4u a0 = *(const LAS v4u*)(tl + row * 272 + ((cg * 16) ^ (((row >> 3) & 7) << 4))), a1 = *(const LAS v4u*)(tl + (row + 1) * 272 + ((cg * 16) ^ ((((row + 1) >> 3) & 7) << 4))), a2 = *(const LAS v4u*)(tl + (row + 2) * 272 + ((cg * 16) ^ ((((row + 2) >> 3) & 7) << 4)));
                const LAS float* w0 = cwl + ch0 + 8 * cg; const LAS float* w1 = w0 + XBCW; const LAS float* w2 = w1 + XBCW; const LAS float* bb = w2 + XBCW;
                float y[8];
#define CV(j, f, q) { const float a = w0[j] * f(a0.q) + w1[j] * f(a1.q) + w2[j] * f(a2.q) + bb[j]; y[j] = a * sigmoid_f(a); }
                CV(0, bflo, x) CV(1, bfhi, x) CV(2, bflo, y) CV(3, bfhi, y) CV(4, bflo, z) CV(5, bfhi, z) CV(6, bflo, w) CV(7, bfhi, w)
#undef CV
                v4u o; o.x = pk2(y[0], y[1]); o.y = pk2(y[2], y[3]); o.z = pk2(y[4], y[5]); o.w = pk2(y[6], y[7]);
                *(GAS v4u*)(dst + (size_t)(t0 + row) * 512 + 8 * cg) = o; }
        }
        __syncthreads();
    }
#undef CONV_LOAD
    { const int full = ntiles / F.G, nbusy = ntiles - full * F.G; __syncthreads();
      if (F.vcu >= nbusy) moe_dn_convert(F, 0, 1900, (F.vcu - nbusy) * NWAVES + F.wave, (F.G - nbusy) * NWAVES); }
}

__device__ __forceinline__ void ph_moe_route(Frame& F) {
    LAS float* R = (LAS float*)F.lds;
    for (int i = F.tid; i < 8192; i += NTHR) R[(i & 7) * 1024 + (i >> 3)] = F.in[I_ROUTER][i];
    __syncthreads();
    const bf16* X = (const bf16*)(F.ws + WS_X); float* RS = (float*)(F.ws + WS_RSTD);
    int* TE = (int*)(F.ws + WS_TOKE); float* TW = (float*)(F.ws + WS_TOKW); int* HIST = (int*)(F.ws + WS_CTL) + CW_HIST;
    const float* gain = F.in[I_N2G] + D; const float* m = modp(F, 1, 0);
    const int gw = F.vcu * NWAVES + F.wave, NGW = F.G * NWAVES;
    f32x4 ca[4], cb[4];
#pragma unroll
    for (int j = 0; j < 4; ++j) { const int c = 4 * (64 * j + F.lane); ca[j] = *(const f32x4*)(gain + c) * (*(const f32x4*)(m + M_SC2 + c) + 1.0f); cb[j] = *(const f32x4*)(m + M_SH2 + c); }
    for (int r = gw; r < L; r += NGW) {
        f32x4 v[4]; float s2 = 0.f;
        load_row4<true>(X + (size_t)r * D, F.lane, v);
#pragma unroll
        for (int j = 0; j < 4; ++j) s2 += (v[j].x * v[j].x + v[j].y * v[j].y) + (v[j].z * v[j].z + v[j].w * v[j].w);
        const float rstd = 1.0f / sqrtf(wave_sum(s2) * (1.0f / D) + EPS);
        float lg[8];
#pragma unroll
        for (int e = 0; e < 8; ++e) lg[e] = 0.f;
#pragma unroll
        for (int j = 0; j < 4; ++j) { const int c = 4 * (64 * j + F.lane);
            const f32x4 y = v[j] * rstd * ca[j] + cb[j];
#pragma unroll
            for (int e = 0; e < 8; ++e) { const f32x4 rr = *(const LAS f32x4*)(R + e * 1024 + c); lg[e] += (y.x * rr.x + y.y * rr.y) + (y.z * rr.z + y.w * rr.w); } }
#pragma unroll
        for (int e = 0; e < 8; ++e) lg[e] = wave_sum(lg[e]);
        int e0 = 0; float v0 = lg[0];
#pragma unroll
        for (int e = 1; e < 8; ++e) if (lg[e] > v0) { v0 = lg[e]; e0 = e; }
        int e1 = -1; float v1 = -3.0e38f;
#pragma unroll
        for (int e = 0; e < 8; ++e) if (e != e0 && lg[e] > v1) { v1 = lg[e]; e1 = e; }
        if (F.lane == 0) { const float ex = __expf(v1 - v0), w0 = 1.0f / (1.0f + ex); RS[r] = rstd;
            TE[2 * r] = e0; TE[2 * r + 1] = e1; TW[2 * r] = w0; TW[2 * r + 1] = ex * w0;
            atomicAdd(&HIST[(r >> 8) * 8 + e0], 1); atomicAdd(&HIST[(r >> 8) * 8 + e1], 1); }
    }
}
__device__ __forceinline__ void moe_segments(Frame& F, LAS int* hist, LAS int* cnt, LAS int* seg) {
    const int* HIST = (const int*)(F.ws + WS_CTL) + CW_HIST;
    if (F.tid < 512) hist[F.tid] = HIST[F.tid];
    __syncthreads();
    if (F.tid < 8) { int s = 0; for (int t = 0; t < 64; ++t) s += hist[t * 8 + F.tid]; cnt[F.tid] = s; }
    __syncthreads();
    if (F.tid == 0) { int s = 0; for (int e = 0; e < 8; ++e) { seg[e] = s; s += (cnt[e] + 255) & ~255; } seg[8] = s; }
    __syncthreads();
}
__device__ __forceinline__ void ph_moe_scatter(Frame& F) {
    LAS int* hist = (LAS int*)F.lds; LAS int* cnt = hist + 512; LAS int* seg = cnt + 8; LAS int* base = seg + 16; LAS int* wcnt = base + 8; LAS int* epos = wcnt + 64;
    moe_segments(F, hist, cnt, seg);
    const int* TE = (const int*)(F.ws + WS_TOKE); int* TP = (int*)(F.ws + WS_TOKP);
    const bf16* X = (const bf16*)(F.ws + WS_X); const float* RS = (const float*)(F.ws + WS_RSTD); bf16* H2S = (bf16*)(F.ws + WS_H2S);
    f32x4 ca[4], cb[4];
    { const float* gain = F.in[I_N2G] + D; const float* m = modp(F, 1, 0);
#pragma unroll
      for (int j = 0; j < 4; ++j) { const int c = 4 * (64 * j + F.lane); ca[j] = *(const f32x4*)(gain + c) * (*(const f32x4*)(m + M_SC2 + c) + 1.0f); cb[j] = *(const f32x4*)(m + M_SH2 + c); } }
    for (int uu = F.vcu; uu < 264; uu += F.G) {
        if (uu < 256) {
            const int u = uu >> 2, qtr = uu & 3;
            if (F.tid < 8) { int s = seg[F.tid]; for (int t = 0; t < u; ++t) s += hist[t * 8 + F.tid]; base[F.tid] = s; }
            const int ent = u * 512 + F.tid;
            const int ex = TE[ent];
            int rank = 0;
#pragma unroll
            for (int e = 0; e < 8; ++e) { const unsigned long long mk = __ballot(ex == e);
                if (ex == e) rank = __popcll(mk & ((1ull << F.lane) - 1ull));
                if (F.lane == 0) wcnt[F.wave * 8 + e] = __popcll(mk); }
            __syncthreads();
            int pos = base[ex] + rank;
            for (int w = 0; w < F.wave; ++w) pos += wcnt[w * 8 + ex];
            if (qtr == 0) TP[ent] = pos;
            epos[F.tid] = pos;
            __syncthreads();
            for (int t0_ = 64 * qtr + F.wave; t0_ < 64 * qtr + 64; t0_ += 2 * NWAVES) {
                f32x4 xv[2][4]; float rs[2]; int d0[2], d1[2];
#pragma unroll
                for (int k = 0; k < 2; ++k) { const int ti = t0_ + k * NWAVES, tok = u * 256 + ti; load_row4<true>(X + (size_t)tok * D, F.lane, xv[k]); rs[k] = RS[tok]; d0[k] = epos[2 * ti]; d1[k] = epos[2 * ti + 1]; }
#pragma unroll
                for (int k = 0; k < 2; ++k) { GAS v2u* o0 = (GAS v2u*)(H2S + (size_t)d0[k] * D) + F.lane; GAS v2u* o1 = (GAS v2u*)(H2S + (size_t)d1[k] * D) + F.lane;
#pragma unroll
                    for (int j = 0; j < 4; ++j) { const f32x4 y = xv[k][j] * rs[k] * ca[j] + cb[j]; v2u o; o.x = pk2(y.x, y.y); o.y = pk2(y.z, y.w); o0[64 * j] = o; o1[64 * j] = o; } } }
            __syncthreads();
        } else {
            const int e = uu - 256, lo = seg[e] + cnt[e], hi = seg[e + 1];
            GAS v4u* d = (GAS v4u*)(H2S + (size_t)lo * D); const int n16 = (hi - lo) * (D * 2 / 16);
            for (int i = F.tid; i < n16; i += NTHR) d[i] = (v4u){0u, 0u, 0u, 0u};
        }
    }
}
__device__ __forceinline__ void ph_final(Frame& F) {
    const bf16* X = (const bf16*)(F.ws + WS_X); const bf16* YO = (const bf16*)(F.ws + WS_H2S);
    const int* TP = (const int*)(F.ws + WS_TOKP); const float* TW = (const float*)(F.ws + WS_TOKW);
    const float* g2 = modp(F, 1, 0) + M_G2; const float* fg = F.in[I_FINALG];
    const float* YP = (const float*)(F.ws + WS_YPART);
    const int gw = F.vcu * NWAVES + F.wave, NGW = F.G * NWAVES;
    f32x4 cg[4], cf[4];
#pragma unroll
    for (int j = 0; j < 4; ++j) { const int c = 4 * (64 * j + F.lane); cg[j] = *(const f32x4*)(g2 + c); cf[j] = *(const f32x4*)(fg + c); }
    for (int r0 = gw; r0 < L; r0 += 2 * NGW) {
        int rr[2], pa[2], pb[2]; float wa[2], wb[2]; f32x4 xv[2][4]; v2u ya[2][4], yb[2][4];
#pragma unroll
        for (int k = 0; k < 2; ++k) { const int r = r0 + k * NGW; rr[k] = r < L ? r : r0; pa[k] = TP[2 * rr[k]]; pb[k] = TP[2 * rr[k] + 1]; wa[k] = TW[2 * rr[k]]; wb[k] = TW[2 * rr[k] + 1]; }
#pragma unroll
        for (int k = 0; k < 2; ++k) { load_row4<true>(X + (size_t)rr[k] * D, F.lane, xv[k]);
            const GAS v2u* y0 = (const GAS v2u*)(YO + (size_t)pa[k] * D) + F.lane; const GAS v2u* y1 = (const GAS v2u*)(YO + (size_t)pb[k] * D) + F.lane;
#pragma unroll
            for (int j = 0; j < 4; ++j) { ya[k][j] = __builtin_nontemporal_load(y0 + 64 * j); yb[k][j] = __builtin_nontemporal_load(y1 + 64 * j); } }
#pragma unroll
        for (int k = 0; k < 2; ++k) { const int r = rr[k], p0 = pa[k], p1 = pb[k]; const float w0 = wa[k], w1 = wb[k];
            f32x4 v[4]; float s2 = 0.f;
#pragma unroll
            for (int j = 0; j < 4; ++j) { const int c = 4 * (64 * j + F.lane); const v2u a = ya[k][j], b = yb[k][j]; const f32x4 g = cg[j];
                f32x4 fa = (f32x4){bflo(a.x), bfhi(a.x), bflo(a.y), bfhi(a.y)}, fb = (f32x4){bflo(b.x), bfhi(b.x), bflo(b.y), bfhi(b.y)};
                if (p0 >= 32768) { fa = (f32x4){0.f, 0.f, 0.f, 0.f}; for (int q = 0; q < 7; ++q) fa += *(const f32x4*)(YP + ((size_t)q * 2048 + (p0 - 32768)) * D + c); }
                if (p1 >= 32768) { fb = (f32x4){0.f, 0.f, 0.f, 0.f}; for (int q = 0; q < 7; ++q) fb += *(const f32x4*)(YP + ((size_t)q * 2048 + (p1 - 32768)) * D + c); }
                const f32x4 f = fa * w0 + fb * w1;
                v[j] = xv[k][j] + g * f; s2 += (v[j].x * v[j].x + v[j].y * v[j].y) + (v[j].z * v[j].z + v[j].w * v[j].w); }
            const float rstd = 1.0f / sqrtf(wave_sum(s2) * (1.0f / D) + EPS);
            GAS f32x4* o = (GAS f32x4*)(F.out + (size_t)r * D) + F.lane;
#pragma unroll
            for (int j = 0; j < 4; ++j) __builtin_nontemporal_store(v[j] * rstd * cf[j], &o[64 * j]);
        }
    }
}


typedef short bf16x8v __attribute__((ext_vector_type(8)));
__device__ __forceinline__ bf16x8v as_frag(v4u a) { return __builtin_bit_cast(bf16x8v, a); }
constexpr float LOG2E_ = 1.4426950408889634f;
#define MFMA16(a, b, c) __builtin_amdgcn_mfma_f32_16x16x32_bf16((a), (b), (c), 0, 0, 0)
__device__ __forceinline__ int prm_row(int i2, int par, int r) { return 32 * i2 + 8 * (r >> 2) + 4 * par + (r & 3); }

__device__ __forceinline__ void ph_ssd_s1(Frame& F) {
    const bf16* XT = (const bf16*)(F.ws + WS_XT); const bf16* BT = (const bf16*)(F.ws + WS_BT);
    const float* DTF = (const float*)(F.ws + WS_DTS); const float* DTB = DTF + (size_t)32 * MT; float* CUMF = (float*)(DTB + (size_t)32 * MT); float* CUMB = CUMF + (size_t)32 * MT;
    float* DEC = (float*)(F.ws + WS_DEC); bf16* ST = (bf16*)(F.ws + WS_STATES);
    LAS unsigned char* btl = F.lds;
    LAS float* wtab = (LAS float*)(F.lds + 128 * 272);
    LAS float* wtot = wtab + 1024;
    const int lane = F.lane, r16 = lane & 15, gq = lane >> 4;
    v4u nbt[4]; float ndtf = 0.f, ndtb = 0.f;
#define S1_PREFETCH(u_) do { const int c_ = (u_) >> 3, g_ = ((u_) >> 1) & 3, hh_ = (u_) & 1, t0_ = c_ * 128; int tq_ = F.tid; asm volatile("" : "+v"(tq_)); \
        _Pragma("unroll") for (int i_ = 0; i_ < 4; ++i_) { const int p_ = tq_ + NTHR * i_, n_ = p_ >> 4, c8_ = (p_ & 15) * 8; nbt[i_] = *(const GAS v4u*)(BT + (size_t)(g_ * 128 + n_) * MT + t0_ + c8_); } \
        { const int h_ = 8 * g_ + 4 * hh_ + (tq_ >> 7); ndtf = DTF[(size_t)h_ * MT + t0_ + (tq_ & 127)]; ndtb = DTB[(size_t)h_ * MT + t0_ + (tq_ & 127)]; } } while (0)
    if (F.vcu < NCH * 8) S1_PREFETCH(F.vcu);
    for (int u = F.vcu; u < NCH * 8; u += F.G) {
        const int c = u >> 3, g = (u >> 1) & 3, hh = u & 1, t0 = c * 128;
        int tid_ = F.tid; asm volatile("" : "+v"(tid_));
        v4u xr[4][4];
        { const int hx = 8 * g + 4 * hh + (F.wave >> 1);
#pragma unroll
          for (int ks = 0; ks < 4; ++ks)
#pragma unroll
            for (int pt = 0; pt < 4; ++pt) xr[ks][pt] = *(const GAS v4u*)(XT + ((size_t)(((hx * NCH + c) * 4 + ks) * 4 + pt) * 16 + r16) * 32 + 8 * gq); }
#pragma unroll
        for (int i = 0; i < 4; ++i) { const int p = tid_ + NTHR * i, n = p >> 4, c8 = (p & 15) * 8; *(LAS v4u*)(btl + n * 272 + c8 * 2) = nbt[i]; }
        {
            const int j = tid_ >> 7, l = tid_ & 127, h = 8 * g + 4 * hh + j;
            const float dtf = ndtf, dtb = ndtb;
            const float Af = -__expf(F.in[I_ALOGF][h]), Ab = -__expf(F.in[I_ALOGB][h]);
            const float af = dtf * Af, ab = dtb * Ab;
            float pf = af, pb = ab;
#pragma unroll
            for (int o = 1; o < 64; o <<= 1) { const float a = __shfl_up(pf, o), b = __shfl_up(pb, o); if (lane >= o) { pf += a; pb += b; } }
            if (lane == 63) { wtot[F.wave * 2] = pf; wtot[F.wave * 2 + 1] = pb; }
            __syncthreads();
            const float tf0 = wtot[(2 * j) * 2], tb0 = wtot[(2 * j) * 2 + 1], Tf = tf0 + wtot[(2 * j + 1) * 2], Tb = tb0 + wtot[(2 * j + 1) * 2 + 1];
            if (F.wave & 1) { pf += tf0; pb += tb0; }
            const float cf = pf, cb = Tb - pb + ab;
            CUMF[(size_t)h * MT + t0 + l] = cf; CUMB[(size_t)h * MT + t0 + l] = cb;
            wtab[(j * 2 + 0) * 128 + l] = __expf(Tf - cf) * dtf; wtab[(j * 2 + 1) * 128 + l] = __expf(Tb - cb) * dtb;
            if (l == 0) { DEC[(0 * NCH + c) * 32 + h] = __expf(Tf); DEC[(1 * NCH + c) * 32 + h] = __expf(Tb); }
        }
        __syncthreads();
        {
            const int j = F.wave >> 1, dir = F.wave & 1, h = 8 * g + 4 * hh + j;
            f32x4 acc[8][4];
#pragma unroll
            for (int a = 0; a < 8; ++a)
#pragma unroll
                for (int b = 0; b < 4; ++b) acc[a][b] = (f32x4){0.f, 0.f, 0.f, 0.f};
            const LAS float* wt = wtab + (j * 2 + dir) * 128;
            if (u + F.G < NCH * 8) S1_PREFETCH(u + F.G);
#pragma unroll
            for (int ks = 0; ks < 4; ++ks) {
                const f32x4 w0 = *(const LAS f32x4*)(wt + 32 * ks + 8 * gq), w1 = *(const LAS f32x4*)(wt + 32 * ks + 8 * gq + 4);
                bf16x8v bfr[4];
#pragma unroll
                for (int pt = 0; pt < 4; ++pt) { const v4u x = xr[ks][pt];
                    v4u y; y.x = pk2(bflo(x.x) * w0.x, bfhi(x.x) * w0.y); y.y = pk2(bflo(x.y) * w0.z, bfhi(x.y) * w0.w); y.z = pk2(bflo(x.z) * w1.x, bfhi(x.z) * w1.y); y.w = pk2(bflo(x.w) * w1.z, bfhi(x.w) * w1.w);
                    bfr[pt] = as_frag(y); }
#pragma unroll
                for (int nt = 0; nt < 8; ++nt) { const bf16x8v af = as_frag(*(const LAS v4u*)(btl + prm_row(nt >> 1, nt & 1, r16) * 272 + (32 * ks + 8 * gq) * 2));
#pragma unroll
                    for (int pt = 0; pt < 4; ++pt) acc[nt][pt] = MFMA16(af, bfr[pt], acc[nt][pt]); }
            }
            bf16* so = ST + ((size_t)((dir * NCH + c) * 32 + h) * 64) * 128;
#pragma unroll
            for (int pt = 0; pt < 4; ++pt)
#pragma unroll
                for (int i2 = 0; i2 < 4; ++i2) { const f32x4 a = acc[2 * i2][pt], b = acc[2 * i2 + 1][pt];
                    v4u o; o.x = pk2(a[0], a[1]); o.y = pk2(a[2], a[3]); o.z = pk2(b[0], b[1]); o.w = pk2(b[2], b[3]);
                    *(GAS v4u*)(so + (size_t)(((pt * 4 + i2) * 16 + r16) * 32) + 8 * gq) = o; }
        }
        __syncthreads();
    }
    { const int nun = NCH * 8, full = nun / F.G, nbusy = nun - full * F.G; __syncthreads();
      if (F.vcu >= nbusy) moe_dn_convert(F, 1900, 5700, (F.vcu - nbusy) * NWAVES + F.wave, (F.G - nbusy) * NWAVES); }
}
#undef S1_PREFETCH

__device__ __forceinline__ void ph_ssd_s2(Frame& F) {
    const float* DEC = (const float*)(F.ws + WS_DEC); bf16* ST = (bf16*)(F.ws + WS_STATES);
    for (int e = F.vcu * NTHR + F.tid; e < 2 * 32 * 64 * 32; e += F.G * NTHR) {
        const int dir = e >> 16, h = (e >> 11) & 31, rem = e & 2047;
        const size_t eoff = (size_t)h * 8192 + (size_t)rem * 4; const size_t cstride = (size_t)32 * 8192;
        bf16* base = ST + (size_t)dir * NCH * cstride + eoff;
        const float* dec = DEC + (size_t)dir * NCH * 32 + h;
        float H0 = 0.f, H1 = 0.f, H2 = 0.f, H3 = 0.f;
        for (int b = 0; b < NCH; b += 10) {
            v2u s[10]; float d[10]; int ck[10];
#pragma unroll
            for (int i = 0; i < 10; ++i) { const int idx = b + i; ck[i] = dir == 0 ? (idx < 2 ? 128 + idx : idx - 2) : (idx < 2 ? 129 - idx : 129 - idx);
                s[i] = __builtin_nontemporal_load((const GAS v2u*)(base + (size_t)ck[i] * cstride)); d[i] = dec[ck[i] * 32]; }
#pragma unroll
            for (int i = 0; i < 10; ++i) { v2u o; o.x = pk2(H0, H1); o.y = pk2(H2, H3); *(GAS v2u*)(base + (size_t)ck[i] * cstride) = o;
                H0 = d[i] * H0 + bflo(s[i].x); H1 = d[i] * H1 + bfhi(s[i].x); H2 = d[i] * H2 + bflo(s[i].y); H3 = d[i] * H3 + bfhi(s[i].y); }
        }
    }
}

__device__ __forceinline__ void ph_ssd_s3(Frame& F) {
    const bf16* XT = (const bf16*)(F.ws + WS_XT); const bf16* BMm = (const bf16*)(F.ws + WS_BM); const bf16* CMm = (const bf16*)(F.ws + WS_CM);
    const float* DTF = (const float*)(F.ws + WS_DTS); const float* DTB = DTF + (size_t)32 * MT; const float* CUMF = DTB + (size_t)32 * MT; const float* CUMB = CUMF + (size_t)32 * MT;
    const bf16* ST = (const bf16*)(F.ws + WS_STATES); bf16* Z = (bf16*)(F.ws + WS_Z); const float* ng = F.in[I_SSDNG];
    LAS unsigned char* bml = F.lds;
    LAS unsigned char* cml = F.lds + 128 * 272;
    LAS float* tab = (LAS float*)(F.lds + 192 * 272);
    LAS float* ssq = tab + 8 * 5 * 128;
    const int lane = F.lane, r16 = lane & 15, gq = lane >> 4;
    v4u nbm[4], ncm[2]; float ncf[2], ncb[2], ndf[2], ndb[2];
#define S3_PREFETCH(u_) do { const int c_ = (u_) >> 3, g_ = ((u_) >> 1) & 3, lh_ = (u_) & 1, t0_ = c_ * 128; int tq_ = F.tid; asm volatile("" : "+v"(tq_)); \
        _Pragma("unroll") for (int i_ = 0; i_ < 4; ++i_) { const int p_ = tq_ + NTHR * i_, row_ = p_ >> 4, c8_ = (p_ & 15) * 8; nbm[i_] = *(const GAS v4u*)(BMm + (size_t)(t0_ + row_) * 512 + g_ * 128 + c8_); } \
        _Pragma("unroll") for (int i_ = 0; i_ < 2; ++i_) { const int p_ = tq_ + NTHR * i_, row_ = p_ >> 4, c8_ = (p_ & 15) * 8; ncm[i_] = *(const GAS v4u*)(CMm + (size_t)(t0_ + 64 * lh_ + row_) * 512 + g_ * 128 + c8_); \
            const size_t o_ = (size_t)(8 * g_ + (p_ >> 7)) * MT + t0_ + (p_ & 127); ncf[i_] = CUMF[o_]; ncb[i_] = CUMB[o_]; ndf[i_] = DTF[o_]; ndb[i_] = DTB[o_]; } } while (0)
    if (F.vcu < 128 * 8) S3_PREFETCH(F.vcu);
    for (int u = F.vcu; u < 128 * 8; u += F.G) {
        const int c = u >> 3, g = (u >> 1) & 3, lh = u & 1, t0 = c * 128;
        __syncthreads();
        int tid_ = F.tid; asm volatile("" : "+v"(tid_));
#pragma unroll
        for (int i = 0; i < 4; ++i) { const int p = tid_ + NTHR * i, row = p >> 4, c8 = (p & 15) * 8; *(LAS v4u*)(bml + row * 272 + c8 * 2) = nbm[i]; }
#pragma unroll
        for (int i = 0; i < 2; ++i) { const int p = tid_ + NTHR * i, row = p >> 4, c8 = (p & 15) * 8; *(LAS v4u*)(cml + row * 272 + c8 * 2) = ncm[i]; }
#pragma unroll
        for (int i = 0; i < 2; ++i) { const int p = tid_ + NTHR * i, j = p >> 7, l = p & 127;
            const float cf = ncf[i] * LOG2E_, cb = ncb[i] * LOG2E_, df = ndf[i], db = ndb[i];
            tab[(j * 5 + 0) * 128 + l] = cf; tab[(j * 5 + 1) * 128 + l] = cb; tab[(j * 5 + 2) * 128 + l] = __builtin_amdgcn_logf(df) - cf; tab[(j * 5 + 3) * 128 + l] = __builtin_amdgcn_logf(db) - cb;
            tab[(j * 5 + 4) * 128 + l] = df + db; }
        __syncthreads();
        const int h = 8 * g + F.wave;
        const float Dk = F.in[I_SSDD][h];
        const LAS float* tcf = tab + (F.wave * 5) * 128; const LAS float* tcb = tcf + 128; const LAS float* tdf = tcb + 128; const LAS float* tdb = tdf + 128; const LAS float* tds = tdb + 128;
        f32x4 acc[4][4];
#pragma unroll
        for (int a = 0; a < 4; ++a)
#pragma unroll
            for (int b = 0; b < 4; ++b) acc[a][b] = (f32x4){0.f, 0.f, 0.f, 0.f};
#pragma unroll 1
        for (int i2 = 0; i2 < 4; ++i2) {
            bf16x8v xf[4], bmf[2][4];
#pragma unroll
            for (int pt = 0; pt < 4; ++pt) xf[pt] = as_frag(*(const GAS v4u*)(XT + ((size_t)(((h * NCH + c) * 4 + i2) * 4 + pt) * 16 + r16) * 32 + 8 * gq));
#pragma unroll
            for (int par = 0; par < 2; ++par)
#pragma unroll
                for (int nk = 0; nk < 4; ++nk) bmf[par][nk] = as_frag(*(const LAS v4u*)(bml + prm_row(i2, par, r16) * 272 + (32 * nk + 8 * gq) * 2));
            const int sb = 32 * i2 + 8 * gq;
            const f32x4 dfs0 = *(const LAS f32x4*)(tdf + sb), dfs1 = *(const LAS f32x4*)(tdf + sb + 4), dbs0 = *(const LAS f32x4*)(tdb + sb), dbs1 = *(const LAS f32x4*)(tdb + sb + 4);
#pragma unroll
            for (int lt = 0; lt < 4; ++lt) {
                const int ll = 16 * lt + r16, l = 64 * lh + ll;
                const float cfl = tcf[l], cbl = tcb[l], dsl = tds[l];
                f32x4 g0 = (f32x4){0.f, 0.f, 0.f, 0.f}, g1 = g0;
#pragma unroll
                for (int nk = 0; nk < 4; ++nk) { const bf16x8v cf = as_frag(*(const LAS v4u*)(cml + ll * 272 + (32 * nk + 8 * gq) * 2));
                    g0 = MFMA16(bmf[0][nk], cf, g0); g1 = MFMA16(bmf[1][nk], cf, g1); }
                float m[8];
                const int ltile0 = 64 * lh + 16 * lt; const int blk = (32 * i2 + 31 < ltile0) ? 0 : ((32 * i2 > ltile0 + 15) ? 2 : 1);
                if (blk == 0) {
#pragma unroll
                    for (int e = 0; e < 8; ++e) { const float dfs = e < 4 ? dfs0[e & 3] : dfs1[e & 3], gv = e < 4 ? g0[e & 3] : g1[e & 3]; m[e] = gv * __builtin_amdgcn_exp2f(cfl + dfs); }
                } else if (blk == 2) {
#pragma unroll
                    for (int e = 0; e < 8; ++e) { const float dbs = e < 4 ? dbs0[e & 3] : dbs1[e & 3], gv = e < 4 ? g0[e & 3] : g1[e & 3]; m[e] = gv * __builtin_amdgcn_exp2f(cbl + dbs); }
                } else {
#pragma unroll
                    for (int e = 0; e < 8; ++e) { const int s = sb + e;
                        const float dfs = e < 4 ? dfs0[e & 3] : dfs1[e & 3], dbs = e < 4 ? dbs0[e & 3] : dbs1[e & 3], gv = e < 4 ? g0[e & 3] : g1[e & 3];
                        float w = __builtin_amdgcn_exp2f(s < l ? cfl + dfs : cbl + dbs); const bool dg = s == l;
                        w = dg ? dsl : w; m[e] = gv * w + (dg ? Dk : 0.f); }
                }
                asm volatile("" : "+v"(m[0]), "+v"(m[1]), "+v"(m[2]), "+v"(m[3]), "+v"(m[4]), "+v"(m[5]), "+v"(m[6]), "+v"(m[7]));
                v4u mp; mp.x = pk2(m[0], m[1]); mp.y = pk2(m[2], m[3]); mp.z = pk2(m[4], m[5]); mp.w = pk2(m[6], m[7]);
                const bf16x8v mf = as_frag(mp);
#pragma unroll
                for (int pt = 0; pt < 4; ++pt) acc[lt][pt] = MFMA16(xf[pt], mf, acc[lt][pt]);
            }
        }
        if (u + F.G < 128 * 8) S3_PREFETCH(u + F.G);
#pragma unroll 1
        for (int dir = 0; dir < 2; ++dir) {
            const bf16* hs = ST + ((size_t)((dir * NCH + c) * 32 + h) * 64) * 128;
            float el[4];
#pragma unroll
            for (int lt = 0; lt < 4; ++lt) { const int l = 64 * lh + 16 * lt + r16; el[lt] = __builtin_amdgcn_exp2f(dir == 0 ? tcf[l] : tcb[l]); }
            f32x4 tacc[4][4];
#pragma unroll
            for (int a = 0; a < 4; ++a)
#pragma unroll
                for (int b = 0; b < 4; ++b) tacc[a][b] = (f32x4){0.f, 0.f, 0.f, 0.f};
#pragma unroll 1
            for (int nk = 0; nk < 4; ++nk) {
                bf16x8v hf[4];
#pragma unroll
                for (int pt = 0; pt < 4; ++pt) hf[pt] = as_frag(*(const GAS v4u*)(hs + (size_t)(((pt * 4 + nk) * 16 + r16) * 32) + 8 * gq));
#pragma unroll
                for (int lt = 0; lt < 4; ++lt) { const int ll = 16 * lt + r16;
                    const bf16x8v cf = as_frag(*(const LAS v4u*)(cml + ll * 272 + (32 * nk + 8 * gq) * 2));
#pragma unroll
                    for (int pt = 0; pt < 4; ++pt) tacc[lt][pt] = MFMA16(hf[pt], cf, tacc[lt][pt]); }
            }
#pragma unroll
            for (int lt = 0; lt < 4; ++lt)
#pragma unroll
                for (int pt = 0; pt < 4; ++pt) acc[lt][pt] += tacc[lt][pt] * el[lt];
        }
#pragma unroll
        for (int lt = 0; lt < 4; ++lt) { const int l = 64 * lh + 16 * lt + r16; float ss = 0.f;
#pragma unroll
            for (int q = 0; q < 2; ++q) { const v4u zv = *(const GAS v4u*)(Z + (size_t)(t0 + l) * DIN + h * 64 + 32 * q + 8 * gq);
                const float zz[8] = {bflo(zv.x), bfhi(zv.x), bflo(zv.y), bfhi(zv.y), bflo(zv.z), bfhi(zv.z), bflo(zv.w), bfhi(zv.w)};
#pragma unroll
                for (int e = 0; e < 4; ++e) { float v0 = acc[lt][2 * q][e] * zz[e] * sigmoid_f(zz[e]), v1 = acc[lt][2 * q + 1][e] * zz[4 + e] * sigmoid_f(zz[4 + e]);
                    acc[lt][2 * q][e] = v0; acc[lt][2 * q + 1][e] = v1; ss += v0 * v0 + v1 * v1; } }
            ss += __shfl_xor(ss, 16); ss += __shfl_xor(ss, 32);
            if (gq == 0) ssq[(16 * lt + r16) * 8 + F.wave] = ss; }
        __syncthreads();
#pragma unroll
        for (int lt = 0; lt < 4; ++lt) { const int ll = 16 * lt + r16, l = 64 * lh + ll;
            const f32x4 s0 = *(const LAS f32x4*)(ssq + ll * 8), s1 = *(const LAS f32x4*)(ssq + ll * 8 + 4);
            const float rs = 1.0f / sqrtf(((s0.x + s0.y) + (s0.z + s0.w) + (s1.x + s1.y) + (s1.z + s1.w)) * (1.0f / 512.0f) + EPS);
#pragma unroll
            for (int q = 0; q < 2; ++q) { const int ch = h * 64 + 32 * q + 8 * gq; const f32x4 a = acc[lt][2 * q] * rs, b = acc[lt][2 * q + 1] * rs;
                const f32x4 g0 = *(const f32x4*)(ng + ch), g1 = *(const f32x4*)(ng + ch + 4);
                v4u o; o.x = pk2(a[0] * g0.x, a[1] * g0.y); o.y = pk2(a[2] * g0.z, a[3] * g0.w); o.z = pk2(b[0] * g1.x, b[1] * g1.y); o.w = pk2(b[2] * g1.z, b[3] * g1.w);
                *(GAS v4u*)(Z + (size_t)(t0 + l) * DIN + ch) = o; } }
    }
    __syncthreads();
}
#undef S3_PREFETCH

__device__ __forceinline__ float vmax_f(float a, float b) { return __builtin_amdgcn_fmed3f(a, b, __builtin_inff()); }
__device__ __forceinline__ float vmin_f(float a, float b) { return __builtin_amdgcn_fmed3f(a, b, -__builtin_inff()); }
__device__ __forceinline__ float vmax3_f(float a, float b, float c) { return vmax_f(a, vmax_f(b, c)); }
__device__ __forceinline__ int attn_next_blk(int kb, int qb, bool isctx) {
    for (int k = kb + 1; k < 5; ++k) { if (k >= 3) return k; if (!isctx) { const int b = qb - 1 + k; if (b >= 0 && b < 128) return k; } }
    return 5;
}
__device__ __forceinline__ void ph_attn(Frame& F) {
    const bf16* QR = (const bf16*)(F.ws + WS_QR); const bf16* KR = (const bf16*)(F.ws + WS_KR); const bf16* VT = (const bf16*)(F.ws + WS_VT); bf16* MIX = (bf16*)(F.ws + WS_MIX);
    constexpr int KBYTES = 128 * 144, BUFB = KBYTES + 64 * 272;
    const int lane = F.lane, r16 = lane & 15, gq = lane >> 4;
    constexpr float LOG2E = 1.4426950408889634f;
    const int p0 = F.tid, p1 = F.tid + NTHR;
    const int kro0 = (p0 >> 3) * 144 + (p0 & 7) * 16, kro1 = (p1 >> 3) * 144 + (p1 & 7) * 16;
    const int vro0 = KBYTES + (p0 >> 4) * 272 + (p0 & 15) * 16, vro1 = KBYTES + (p1 >> 4) * 272 + (p1 & 15) * 16;
    for (int u = F.vcu; u < 130 * 8; u += F.G) {
        const int qb = u >> 3, hq = u & 7, kvh = hq >> 2; const bool isctx = qb >= 128;
        const int row0 = qb * 128;
        const int qrow = row0 + 16 * F.wave + r16;
        bf16x8v qf[2];
#pragma unroll
        for (int ks = 0; ks < 2; ++ks) qf[ks] = as_frag(*(const GAS v4u*)(QR + ((size_t)hq * MT + qrow) * 64 + 32 * ks + 8 * gq));
        float m2 = F.in[I_ABSINK][hq] * LOG2E, lsum = 1.0f;
        f32x4 oacc[4];
#pragma unroll
        for (int a = 0; a < 4; ++a) oacc[a] = (f32x4){0.f, 0.f, 0.f, 0.f};
        const int qi = 16 * F.wave + r16;
        const bf16* kbase = KR + (size_t)kvh * MT * 64; const bf16* vbase = VT + (size_t)kvh * 64 * MT;
#define ATT_KEY0(kb) ((kb) < 3 ? (qb - 1 + (kb)) * 128 : L + ((kb) - 3) * 128)
#define ATT_LOAD(kb) do { const int k0_ = ATT_KEY0(kb); \
            kr0 = *(const GAS v4u*)(kbase + (size_t)(k0_ + (p0 >> 3)) * 64 + (p0 & 7) * 8); kr1 = *(const GAS v4u*)(kbase + (size_t)(k0_ + (p1 >> 3)) * 64 + (p1 & 7) * 8); \
            vr0 = *(const GAS v4u*)(vbase + (size_t)(p0 >> 4) * MT + k0_ + (p0 & 15) * 8); vr1 = *(const GAS v4u*)(vbase + (size_t)(p1 >> 4) * MT + k0_ + (p1 & 15) * 8); } while (0)
#define ATT_WRITE(buf) do { LAS unsigned char* b_ = F.lds + (buf) * BUFB; *(LAS v4u*)(b_ + kro0) = kr0; *(LAS v4u*)(b_ + kro1) = kr1; *(LAS v4u*)(b_ + vro0) = vr0; *(LAS v4u*)(b_ + vro1) = vr1; } while (0)
        v4u kr0, kr1, vr0, vr1;
        int kb = attn_next_blk(-1, qb, isctx), cur = 0;
        __syncthreads();
        ATT_LOAD(kb); ATT_WRITE(0);
        __syncthreads();
        while (kb < 5) {
            const int nkb = attn_next_blk(kb, qb, isctx);
            if (nkb < 5) ATT_LOAD(nkb);
            const LAS unsigned char* kl = F.lds + cur * BUFB; const LAS unsigned char* vl = kl + KBYTES;
            const int mode = (kb == 0) ? 1 : ((kb == 2) ? 2 : 0);
            f32x4 sacc[8];
#pragma unroll
            for (int kt = 0; kt < 8; ++kt) { sacc[kt] = (f32x4){0.f, 0.f, 0.f, 0.f};
#pragma unroll
                for (int ks = 0; ks < 2; ++ks) { const bf16x8v kf = as_frag(*(const LAS v4u*)(kl + prm_row(kt >> 1, kt & 1, r16) * 144 + (32 * ks + 8 * gq) * 2));
                    sacc[kt] = MFMA16(kf, qf[ks], sacc[kt]); } }
            float bm = -1.0e30f;
#pragma unroll 1
            for (int rep_ = 0; rep_ < (mode != 0 ? 1 : 0); ++rep_) {
                const float msgn = mode == 1 ? 1.0e30f : -1.0e30f, limf = (float)(qi - 8 * gq);
#pragma unroll
                for (int kt = 0; kt < 8; ++kt)
#pragma unroll
                    for (int e = 0; e < 4; ++e) { const float jc = (float)(32 * (kt >> 1) + 4 * (kt & 1) + e);
                        sacc[kt][e] += vmin_f(0.f, msgn * (jc - limf)); }
            }
#pragma unroll
            for (int kt = 0; kt < 8; ++kt) bm = vmax3_f(bm, vmax_f(sacc[kt][0], sacc[kt][1]), vmax_f(sacc[kt][2], sacc[kt][3]));
            bm = vmax_f(bm, __shfl_xor(bm, 16)); bm = vmax_f(bm, __shfl_xor(bm, 32));
            const float mn = vmax_f(m2, bm), alpha = __builtin_amdgcn_exp2f(m2 - mn); m2 = mn;
            float ps = 0.f;
            bf16x8v pf[4];
#pragma unroll
            for (int i2 = 0; i2 < 4; ++i2) { float p[8];
#pragma unroll
                for (int e = 0; e < 4; ++e) { p[e] = __builtin_amdgcn_exp2f(sacc[2 * i2][e] - mn); p[4 + e] = __builtin_amdgcn_exp2f(sacc[2 * i2 + 1][e] - mn); }
#pragma unroll
                for (int e = 0; e < 8; ++e) ps += p[e];
                v4u pk; pk.x = pk2(p[0], p[1]); pk.y = pk2(p[2], p[3]); pk.z = pk2(p[4], p[5]); pk.w = pk2(p[6], p[7]); pf[i2] = as_frag(pk); }
            ps += __shfl_xor(ps, 16); ps += __shfl_xor(ps, 32);
            lsum = lsum * alpha + ps;
#pragma unroll
            for (int dt = 0; dt < 4; ++dt) { oacc[dt] = oacc[dt] * alpha;
#pragma unroll
                for (int i2 = 0; i2 < 4; ++i2) { const bf16x8v vf = as_frag(*(const LAS v4u*)(vl + prm_row(dt >> 1, dt & 1, r16) * 272 + (32 * i2 + 8 * gq) * 2));
                    oacc[dt] = MFMA16(vf, pf[i2], oacc[dt]); } }
            if (nkb < 5) ATT_WRITE(cur ^ 1);
            __syncthreads();
            kb = nkb; cur ^= 1;
        }
#undef ATT_KEY0
#undef ATT_LOAD
#undef ATT_WRITE
        const float il = 1.0f / lsum;
#pragma unroll
        for (int i = 0; i < 2; ++i) { const f32x4 a = oacc[2 * i] * il, b = oacc[2 * i + 1] * il;
            v4u o; o.x = pk2(a[0], a[1]); o.y = pk2(a[2], a[3]); o.z = pk2(b[0], b[1]); o.w = pk2(b[2], b[3]);
            *(GAS v4u*)(MIX + (size_t)qrow * D + 512 + 64 * hq + 32 * i + 8 * gq) = o; }
    }
    __syncthreads();
}

constexpr int NPH = 23;
#ifndef WGM_MOE_GU
#define WGM_MOE_GU 4
#endif
#ifndef WGM_MOE_DN
#define WGM_MOE_DN 4
#endif
struct Args { const float* in[30]; float* out; unsigned char* ws; int ph_lo, ph_hi; };
__global__ void __launch_bounds__(NTHR, 2) mk_fwd(Args args) {
    extern __shared__ __attribute__((aligned(16))) unsigned char lds[];
    Frame F;
    F.lds = (LAS unsigned char*)lds;
    F.tid = threadIdx.x; F.lane = F.tid & 63; F.wave = __builtin_amdgcn_readfirstlane(F.tid >> 6);
    F.G = gridDim.x; { const int bx = blockIdx.x; F.vcu = (F.G % 8 == 0) ? (bx % 8) * (F.G / 8) + bx / 8 : bx; }
#pragma unroll
    for (int i = 0; i < 30; ++i) F.in[i] = args.in[i];
    F.out = args.out; F.ws = args.ws;
    unsigned char* ws = args.ws;
    volatile LAS unsigned* MISC = (volatile LAS unsigned*)(F.lds + MISC_OFF);
    for (int u = F.tid; u < (LDS_BYTES - LDSCTL_OFF) / 4; u += NTHR) ((LAS unsigned*)(F.lds + LDSCTL_OFF))[u] = 0u;
    __syncthreads();
    const int lo = args.ph_lo, hi = args.ph_hi;
    XcdBarrier bar; bar.bar = (unsigned*)(ws + WS_CTL) + CW_BAR; bar.x = 0; bar.st = nullptr;
    if (hi - lo > 1) bar = xcd_barrier_post((unsigned*)(ws + WS_CTL) + CW_BAR, MISC + 8);
#define IN(k) (lo <= (k) && (k) < hi)
#define SEAM(k) do { if (IN(k) && IN((k) + 1)) xcd_barrier(bar); } while (0)
    LAS unsigned char* ring = F.lds;
    bf16* X = (bf16*)(ws + WS_X); bf16* H = (bf16*)(ws + WS_H);

    if (IN(0)) { ph_prologue(F); } SEAM(0);
    if (IN(1)) { ph_modulate<false, false, 0>(F, F.in[I_X], F.in[I_CTX], F.in[I_N1G], modp(F, 0, 0), modp(F, 0, 1), M_SH1, M_SC1, H, MT, nullptr, nullptr, nullptr); } SEAM(1);
    if (IN(2)) { pg8::Gemm g{H, (const bf16*)(ws + WS_WABIN), D, D, 0}; pg8::StaticOrder S; S.init(MT, AB_IN, F.G, (int)blockIdx.x);
        pg8::EpiStoreBf16 E{(bf16*)(ws + WS_PAB), AB_IN};
        pg8::gemm_phase<pg8::EpiStoreBf16, pg8::StaticOrder, true, true>(ring, g, S, E);
        idle_round_convert(F, (MT / 256) * (AB_IN / 256), 0, 11400); } SEAM(2);
    if (IN(3)) { ph_ab_elem(F); } SEAM(3);
    if (IN(4)) { ph_attn(F); } SEAM(4);
    if (IN(5)) { { pg8::Gemm g{(const bf16*)(ws + WS_MIX), (const bf16*)(ws + WS_WABOUT), D, D, 0}; pg8::StaticOrder S; S.init(L, D, F.G, (int)blockIdx.x);
          pg8::EpiRes<true> E{X, F.in[I_X], modp(F, 0, 0) + M_G1};
          pg8::gemm_phase<pg8::EpiRes<true>, pg8::StaticOrder, true, true>(ring, g, S, E); }
        { int nu_ = 16, kl_ = 256; asm volatile("" : "+s"(nu_), "+s"(kl_)); pg8::Gemm g{(const bf16*)(ws + WS_MIX), (const bf16*)(ws + WS_WABOUT), D, kl_, 0}; pg8::SplitOrder S{64, 4, nu_, 256, F.G, (int)blockIdx.x};
          pg8::EpiPart E{(float*)(ws + WS_PART), 64, 256, LC};
          pg8::gemm_phase<pg8::EpiPart, pg8::SplitOrder, true, true>(ring, g, S, E); }
        if ((int)blockIdx.x >= 16) ph_convert_ffn(F, ((int)blockIdx.x - 16) * NWAVES + F.wave, (F.G - 16) * NWAVES); } SEAM(5);
    if (IN(6)) { ph_modulate<true, false, 4>(F, X, F.in[I_CTX], F.in[I_N2G], modp(F, 0, 0), modp(F, 0, 1), M_SH2, M_SC2, H, MT, (const float*)(ws + WS_PART), modp(F, 0, 1) + M_G1, X); } SEAM(6);
    if (IN(7)) { pg8::Gemm g{H, (const bf16*)(ws + WS_WFFNGU), D, D, 0}; pg8::StaticOrder S; S.init(MT, 2 * DFF, F.G, (int)blockIdx.x);
        pg8::EpiSwiGLU E{(bf16*)(ws + WS_ACT0), DFF};
        pg8::gemm_phase<pg8::EpiSwiGLU, pg8::StaticOrder, true, true>(ring, g, S, E);
        idle_round_convert(F, (MT / 256) * (2 * DFF / 256), 11400, 18000); } SEAM(7);
    if (IN(8)) { { pg8::Gemm g{(const bf16*)(ws + WS_ACT0), (const bf16*)(ws + WS_WFFND), DFF, DFF, 0}; pg8::StaticOrder S; S.init(L, D, F.G, (int)blockIdx.x);
          pg8::EpiRes<false> E{X, X, modp(F, 0, 0) + M_G2};
          pg8::gemm_phase<pg8::EpiRes<false>, pg8::StaticOrder, true, true>(ring, g, S, E); }
        { int nu_ = 44, kl_ = 256; asm volatile("" : "+s"(nu_), "+s"(kl_)); pg8::Gemm g{(const bf16*)(ws + WS_ACT0), (const bf16*)(ws + WS_WFFND), DFF, kl_, 0}; pg8::SplitOrder S{64, 4, nu_, 256, F.G, (int)blockIdx.x};
          pg8::EpiPart E{(float*)(ws + WS_PART), 64, 256, LC};
          pg8::gemm_phase<pg8::EpiPart, pg8::SplitOrder, true, true>(ring, g, S, E); }
        if ((int)blockIdx.x >= 44) ph_convert_ssd(F, ((int)blockIdx.x - 44) * NWAVES + F.wave, (F.G - 44) * NWAVES); } SEAM(8);
    if (IN(9)) { ph_modulate<true, true, 11>(F, X, X + (size_t)L * D, F.in[I_N1G] + D, modp(F, 1, 0), modp(F, 1, 1), M_SH1, M_SC1, H, MT, (const float*)(ws + WS_PART), modp(F, 0, 1) + M_G2, nullptr); } SEAM(9);
    if (IN(10)) { pg8::Gemm g{H, (const bf16*)(ws + WS_WSSDIN), D, D, 0}; pg8::StaticOrder S; S.init(MT, SSD_INP, F.G, (int)blockIdx.x);
        pg8::EpiSsdIn E{(bf16*)(ws + WS_Z), (bf16*)(ws + WS_XBCR), (float*)(ws + WS_DTRAW)};
        pg8::gemm_phase<pg8::EpiSsdIn, pg8::StaticOrder, true, true>(ring, g, S, E);
        idle_round_convert(F, (MT / 256) * (SSD_INP / 256), 18000, MOE_GU_ITEMS); } SEAM(10);
    if (IN(11)) { ph_ssd_conv(F); } SEAM(11);
    if (IN(12)) { ph_ssd_s1(F); } SEAM(12);
    if (IN(13)) { ph_ssd_s2(F); } SEAM(13);
    if (IN(14)) { ph_ssd_s3(F); } if (IN(14) && IN(16)) xcd_barrier(bar);
    if (IN(16)) { pg8::Gemm g{(const bf16*)(ws + WS_Z), (const bf16*)(ws + WS_WSSDOUT), DIN, DIN, 0}; pg8::StaticOrder S; S.init(L, D, F.G, (int)blockIdx.x);
        pg8::EpiRes<false> E{X, X, modp(F, 1, 0) + M_G1};
        pg8::gemm_phase<pg8::EpiRes<false>, pg8::StaticOrder, true, true>(ring, g, S, E); } SEAM(16);
    if (IN(17)) { ph_moe_route(F); } SEAM(17);
    if (IN(18)) { ph_moe_scatter(F); } SEAM(18);
    if (IN(19) || IN(21)) {
        LAS int* hist = (LAS int*)F.lds; LAS int* cnt = hist + 512; LAS int* seg = cnt + 8;
        pg8::GroupedOrder S;
        if (IN(19)) {
            moe_segments(F, hist, cnt, seg);
            S.nM = seg[8] >> 8; S.nN = 2 * FFE / 256; S.nwg = S.nM * S.nN; S.G = F.G; S.c = (int)blockIdx.x; S.WGM = WGM_MOE_GU;
            S.ts1 = seg[1] >> 8; S.ts2 = seg[2] >> 8; S.ts3 = seg[3] >> 8; S.ts4 = seg[4] >> 8; S.ts5 = seg[5] >> 8; S.ts6 = seg[6] >> 8; S.ts7 = seg[7] >> 8;
            __syncthreads();
            pg8::Gemm g{(const bf16*)(ws + WS_H2S), (const bf16*)(ws + WS_WMOE), D, D, (size_t)2 * FFE * D * 2};
            pg8::EpiSwiGLU E{(bf16*)(ws + WS_ACTM), FFE};
            pg8::gemm_phase<pg8::EpiSwiGLU, pg8::GroupedOrder, true, true>(ring, g, S, E);
            { const int full = S.nwg / F.G, nbusy = S.nwg - full * F.G;
              if ((int)blockIdx.x >= nbusy) moe_dn_convert(F, 7168, 11308, ((int)blockIdx.x - nbusy) * NWAVES + F.wave, (F.G - nbusy) * NWAVES); }
        }
        SEAM(19);
        if (IN(20)) { const int gw_ = F.vcu * NWAVES + F.wave, NGW_ = F.G * NWAVES;
            moe_dn_convert(F, 5700, MOE_DN_ITEMS / 2, gw_, NGW_); moe_dn_convert(F, 11308, MOE_DN_ITEMS, gw_, NGW_); }
        SEAM(20);
        if (IN(21)) {
            __syncthreads();
            moe_segments(F, hist, cnt, seg);
            const int NT = seg[8] >> 8;
            S.nM = NT < 128 ? NT : 128; S.nN = D / 256; S.nwg = S.nM * S.nN; S.G = F.G; S.c = (int)blockIdx.x; S.WGM = WGM_MOE_DN;
            S.ts1 = seg[1] >> 8; S.ts2 = seg[2] >> 8; S.ts3 = seg[3] >> 8; S.ts4 = seg[4] >> 8; S.ts5 = seg[5] >> 8; S.ts6 = seg[6] >> 8; S.ts7 = seg[7] >> 8;
            __syncthreads();
            { pg8::Gemm g{(const bf16*)(ws + WS_ACTM), (const bf16*)(ws + WS_WDA), FFE, FFE, WD_BYTES, (WS_WDB - WS_WDA) - 4 * WD_BYTES};
              pg8::EpiStoreBf16 E{(bf16*)(ws + WS_H2S), D};
              pg8::gemm_phase<pg8::EpiStoreBf16, pg8::GroupedOrder, true, true>(ring, g, S, E); }
            if (NT > 128) {
                pg8::Gemm g{(const bf16*)(ws + WS_ACTM), (const bf16*)(ws + WS_WDA), FFE, 512, WD_BYTES, (WS_WDB - WS_WDA) - 4 * WD_BYTES};
                pg8::SplitGroupedOrder S2{128, NT, D / 256, 7, 512, F.G, (int)blockIdx.x, S.ts1, S.ts2, S.ts3, S.ts4, S.ts5, S.ts6, S.ts7};
                pg8::EpiPart E{(float*)(ws + WS_YPART), 128, 512, 2048};
                pg8::gemm_phase<pg8::EpiPart, pg8::SplitGroupedOrder, true, true>(ring, g, S2, E); }
        }
        SEAM(21);
    } else { SEAM(19); if (IN(20)) { const int gw_ = F.vcu * NWAVES + F.wave, NGW_ = F.G * NWAVES; moe_dn_convert(F, 0, MOE_DN_ITEMS, gw_, NGW_); }
        SEAM(20); SEAM(21); }
    if (IN(22)) { ph_final(F); }
#undef IN
#undef SEAM
}

extern "C" void kernel_launch(void* const* d_in, const int* in_sizes, int n_in, void* d_out, int out_size, void* d_ws, size_t ws_size, hipStream_t stream) {
    static int grid = 0;
    if (grid == 0) {
        if (n_in != 30 || in_sizes[0] != L * D || out_size != L * D || ws_size < WS_END) { fprintf(stderr, "kernel_launch: unexpected shapes (n_in %d, in0 %d, out %d, ws %zu < %zu); nothing launched\n", n_in, n_in > 0 ? in_sizes[0] : -1, out_size, ws_size, (size_t)WS_END); grid = -1; return; }
        int dev = 0, cus = 0, per_cu = 0;
        if (hipGetDevice(&dev) != hipSuccess || hipDeviceGetAttribute(&cus, hipDeviceAttributeMultiprocessorCount, dev) != hipSuccess) { grid = -1; return; }
        if (hipFuncSetAttribute((const void*)mk_fwd, hipFuncAttributeMaxDynamicSharedMemorySize, LDS_BYTES) != hipSuccess) { fprintf(stderr, "kernel_launch: hipFuncSetAttribute failed\n"); grid = -1; return; }
        if (hipOccupancyMaxActiveBlocksPerMultiprocessor(&per_cu, (const void*)mk_fwd, NTHR, LDS_BYTES) != hipSuccess || per_cu < 1)
            fprintf(stderr, "kernel_launch: note: occupancy query reports %d workgroups per CU\n", per_cu);
        (void)hipGetLastError();
        grid = cus;
    }
    if (grid < 0) return;
    if (hipMemsetAsync((char*)d_ws + WS_CTL, 0, CTL_ZERO_BYTES, stream) != hipSuccess) return;
    Args a{};
    for (int i = 0; i < 30; ++i) a.in[i] = (const float*)d_in[i];
    a.out = (float*)d_out; a.ws = (unsigned char*)d_ws;
    if (MK_N_LAUNCHES == 1) { a.ph_lo = 0; a.ph_hi = NPH; hipLaunchKernelGGL(mk_fwd, dim3(grid), dim3(NTHR), LDS_BYTES, stream, a); }
    else { for (int p = 0; p < NPH; ++p) { a.ph_lo = p; a.ph_hi = p + 1; hipLaunchKernelGGL(mk_fwd, dim3(grid), dim3(NTHR), LDS_BYTES, stream, a); } }
}
```

```cpp
#include <hip/hip_runtime.h>
#include <cstdio>
#include <cstdint>

#ifndef MK_N_LAUNCHES
#define MK_N_LAUNCHES 1
#endif

namespace pg8 {
#define PG8_LAS __attribute__((address_space(3)))
typedef unsigned short bf16_t;
typedef short bf16x8 __attribute__((ext_vector_type(8)));
typedef float f32x4 __attribute__((ext_vector_type(4)));
typedef unsigned u32x4 __attribute__((ext_vector_type(4)));
constexpr int BM = 256, BK = 64, HALF = 128, HTB = HALF * BK * 2  , STAGE_BYTES = 8 * HTB, NXCD = 8;

__host__ __device__ __forceinline__ int lds_byte(int r, int c) { const int st = (r >> 4) * 2 + (c >> 5), rr = r & 15, cc = c & 31, ob = rr * 64 + cc * 2; return st * 1024 + (ob ^ (((ob >> 9) & 1) << 5)); }
__host__ __device__ __forceinline__ void stage_rc(int b, int& R, int& C) { const int st = b / 1024, sb = b % 1024, swz = sb ^ (((sb >> 9) & 1) << 5); R = (st >> 1) * 16 + swz / 64; C = (st & 1) * 32 + (swz % 64) / 2; }
__host__ __device__ __forceinline__ int perm32(int rho) { const int n = rho >> 4, i = rho & 15; return 8 * (i >> 2) + 4 * n + (i & 3); }

struct Unit { int pm, pn, pe, pk; };
struct Gemm { const bf16_t* A; const bf16_t* Bt; int ld, K; size_t bstride; size_t bdelta = 0; };

struct StaticOrder {
    int nM, nN, nwg, G, c, WGM;
    __host__ __device__ void init(int M, int N, int G_, int c_, int wgm = 4) { nM = M / BM; nN = N / BM; nwg = nM * nN; G = G_; c = c_; WGM = wgm; }
    __host__ __device__ bool next(int i, Unit& u) const {
        const long L = (long)i * G + c; if (L >= nwg) return false;
        int wgid = (int)L; { const int q = nwg / NXCD, r = nwg % NXCD, xcd = wgid % NXCD, off = wgid / NXCD; wgid = (xcd < r ? xcd * (q + 1) : r * (q + 1) + (xcd - r) * q) + off; }
        const int nig = WGM * nN, gid = wgid / nig, fm = gid * WGM, gsz = (nM - fm) < WGM ? (nM - fm) : WGM;
        u.pm = fm + ((wgid % nig) % gsz); u.pn = (wgid % nig) / gsz; u.pe = 0; u.pk = 0; return true;
    }
    __device__ __forceinline__ void a_ready(const Unit&) const {}
    __device__ __forceinline__ void done(const Unit&) const {}
};
struct GroupedOrder {
    int nM, nN, nwg, G, c, WGM; int ts1, ts2, ts3, ts4, ts5, ts6, ts7;
    __device__ bool next(int i, Unit& u) const {
        const long L = (long)i * G + c; if (L >= nwg) return false;
        int wgid = (int)L; { const int q = nwg / NXCD, r = nwg % NXCD, xcd = wgid % NXCD, off = wgid / NXCD; wgid = (xcd < r ? xcd * (q + 1) : r * (q + 1) + (xcd - r) * q) + off; }
        const int nig = WGM * nN, gid = wgid / nig, fm = gid * WGM, gsz = (nM - fm) < WGM ? (nM - fm) : WGM;
        u.pm = fm + ((wgid % nig) % gsz); u.pn = (wgid % nig) / gsz;
        u.pk = 0; const int p = u.pm; u.pe = (p >= ts1) + (p >= ts2) + (p >= ts3) + (p >= ts4) + (p >= ts5) + (p >= ts6) + (p >= ts7); return true;
    }
    __device__ __forceinline__ void a_ready(const Unit&) const {}
    __device__ __forceinline__ void done(const Unit&) const {}
};

__device__ __forceinline__ unsigned cvt_pk_bf16(float lo, float hi) { unsigned r; asm volatile("v_cvt_pk_bf16_f32 %0, %1, %2" : "=v"(r) : "v"(lo), "v"(hi)); return r; }
__device__ __forceinline__ float silu_f(float g) { return g * __builtin_amdgcn_rcpf(1.0f + __expf(-g)); }

struct EpiStoreBf16 {
    static constexpr bool PERM = true, AFTER_DRAIN = false;
    bf16_t* O; int ldc;
    __device__ __forceinline__ void operator()(const f32x4 (&acc)[2][2][4][2], const Unit& u, int wr, int wc, int fr, int fq) const {
        const int row0 = u.pm * BM + wr * 64 + fr, col0 = u.pn * BM + wc * 32 + 8 * fq;
#pragma unroll
        for (int ai = 0; ai < 2; ++ai)
#pragma unroll
            for (int m = 0; m < 4; ++m) { bf16_t* rowp = O + (size_t)(row0 + ai * HALF + m * 16) * ldc + col0;
#pragma unroll
                for (int bj = 0; bj < 2; ++bj) { const f32x4 v0 = acc[ai][bj][m][0], v1 = acc[ai][bj][m][1];
                    u32x4 w; w.x = cvt_pk_bf16(v0[0], v0[1]); w.y = cvt_pk_bf16(v0[2], v0[3]); w.z = cvt_pk_bf16(v1[0], v1[1]); w.w = cvt_pk_bf16(v1[2], v1[3]);
                    *(u32x4*)(rowp + bj * HALF) = w; } }
    }
};
struct EpiSwiGLU {
    static constexpr bool PERM = true, AFTER_DRAIN = false;
    bf16_t* O; int ldc;
    __device__ __forceinline__ void operator()(const f32x4 (&acc)[2][2][4][2], const Unit& u, int wr, int wc, int fr, int fq) const {
        const int row0 = u.pm * BM + wr * 64 + fr, col0 = u.pn * HALF + wc * 32 + 8 * fq;
#pragma unroll
        for (int ai = 0; ai < 2; ++ai)
#pragma unroll
            for (int m = 0; m < 4; ++m) { bf16_t* rowp = O + (size_t)(row0 + ai * HALF + m * 16) * ldc + col0;
                const f32x4 g0 = acc[ai][0][m][0], g1 = acc[ai][0][m][1], u0 = acc[ai][1][m][0], u1 = acc[ai][1][m][1];
                u32x4 w; w.x = cvt_pk_bf16(silu_f(g0[0]) * u0[0], silu_f(g0[1]) * u0[1]); w.y = cvt_pk_bf16(silu_f(g0[2]) * u0[2], silu_f(g0[3]) * u0[3]);
                w.z = cvt_pk_bf16(silu_f(g1[0]) * u1[0], silu_f(g1[1]) * u1[1]); w.w = cvt_pk_bf16(silu_f(g1[2]) * u1[2], silu_f(g1[3]) * u1[3]);
                *(u32x4*)rowp = w; }
    }
};
template <bool BASE_F32> struct EpiRes {
    static constexpr bool PERM = true, AFTER_DRAIN = false;
    bf16_t* X; const void* base; const float* gate;
    __device__ __forceinline__ void operator()(const f32x4 (&acc)[2][2][4][2], const Unit& u, int wr, int wc, int fr, int fq) const {
        const int row0 = u.pm * BM + wr * 64 + fr, col0 = u.pn * BM + wc * 32 + 8 * fq;
        f32x4 gv[2][2];
#pragma unroll
        for (int bj = 0; bj < 2; ++bj)
#pragma unroll
            for (int n = 0; n < 2; ++n) gv[bj][n] = *(const f32x4*)(gate + col0 + bj * HALF + 4 * n);
#pragma unroll
        for (int ai = 0; ai < 2; ++ai)
#pragma unroll
            for (int m = 0; m < 4; ++m) { const size_t ro = (size_t)(row0 + ai * HALF + m * 16) * 1024 + col0;
#pragma unroll
                for (int bj = 0; bj < 2; ++bj) { f32x4 b0, b1;
                    if (BASE_F32) { b0 = __builtin_nontemporal_load((const f32x4*)((const float*)base + ro + bj * HALF)); b1 = __builtin_nontemporal_load((const f32x4*)((const float*)base + ro + bj * HALF + 4)); }
                    else { const u32x4 t = *(const u32x4*)((const bf16_t*)base + ro + bj * HALF);
                        b0 = (f32x4){__uint_as_float(t.x << 16), __uint_as_float(t.x & 0xffff0000u), __uint_as_float(t.y << 16), __uint_as_float(t.y & 0xffff0000u)};
                        b1 = (f32x4){__uint_as_float(t.z << 16), __uint_as_float(t.z & 0xffff0000u), __uint_as_float(t.w << 16), __uint_as_float(t.w & 0xffff0000u)}; }
                    const f32x4 v0 = b0 + gv[bj][0] * acc[ai][bj][m][0], v1 = b1 + gv[bj][1] * acc[ai][bj][m][1];
                    u32x4 w; w.x = cvt_pk_bf16(v0[0], v0[1]); w.y = cvt_pk_bf16(v0[2], v0[3]); w.z = cvt_pk_bf16(v1[0], v1[1]); w.w = cvt_pk_bf16(v1[2], v1[3]);
                    *(u32x4*)(X + ro + bj * HALF) = w; } }
    }
};
struct EpiSsdIn {
    static constexpr bool PERM = true, AFTER_DRAIN = false;
    bf16_t* Z; bf16_t* XB; float* DT;
    __device__ __forceinline__ void operator()(const f32x4 (&acc)[2][2][4][2], const Unit& u, int wr, int wc, int fr, int fq) const {
        const int row0 = u.pm * BM + wr * 64 + fr;
        if (u.pn < 20) {
            bf16_t* O = u.pn < 8 ? Z : XB; const int ldc = u.pn < 8 ? 2048 : 3072; const int col0 = (u.pn < 8 ? u.pn : u.pn - 8) * BM + wc * 32 + 8 * fq;
#pragma unroll
            for (int ai = 0; ai < 2; ++ai)
#pragma unroll
                for (int m = 0; m < 4; ++m) { bf16_t* rowp = O + (size_t)(row0 + ai * HALF + m * 16) * ldc + col0;
#pragma unroll
                    for (int bj = 0; bj < 2; ++bj) { const f32x4 v0 = acc[ai][bj][m][0], v1 = acc[ai][bj][m][1];
                        u32x4 w; w.x = cvt_pk_bf16(v0[0], v0[1]); w.y = cvt_pk_bf16(v0[2], v0[3]); w.z = cvt_pk_bf16(v1[0], v1[1]); w.w = cvt_pk_bf16(v1[2], v1[3]);
                        *(u32x4*)(rowp + bj * HALF) = w; } }
        } else if (wc < 2) {
#pragma unroll
            for (int ai = 0; ai < 2; ++ai)
#pragma unroll
                for (int m = 0; m < 4; ++m) { float* rowp = DT + (size_t)(row0 + ai * HALF + m * 16) * 64 + wc * 32 + 8 * fq;
                    *(f32x4*)rowp = acc[ai][0][m][0]; *(f32x4*)(rowp + 4) = acc[ai][0][m][1]; }
        }
    }
};


struct SplitOrder {
    int pm0, nN, nunits, ks_len, G, c;
    __device__ bool next(int i, Unit& u) const { const int x = i * G + c; if (x >= nunits) return false; u.pm = pm0; u.pn = x % nN; u.pe = 0; u.pk = (x / nN) * ks_len; return true; }
    __device__ __forceinline__ void a_ready(const Unit&) const {}
    __device__ __forceinline__ void done(const Unit&) const {}
};
struct SplitGroupedOrder {
    int pm_lo, pm_hi, nN, nks, ks_len, G, c; int ts1, ts2, ts3, ts4, ts5, ts6, ts7;
    __device__ bool next(int i, Unit& u) const { const int x = i * G + c; const int per = nN * nks; if (x >= (pm_hi - pm_lo) * per) return false;
        u.pm = pm_lo + x / per; const int y = x % per; u.pn = y / nks; u.pk = (y % nks) * ks_len;
        const int p = u.pm; u.pe = (p >= ts1) + (p >= ts2) + (p >= ts3) + (p >= ts4) + (p >= ts5) + (p >= ts6) + (p >= ts7); return true; }
    __device__ __forceinline__ void a_ready(const Unit&) const {}
    __device__ __forceinline__ void done(const Unit&) const {}
};
struct EpiPart {
    static constexpr bool PERM = false, AFTER_DRAIN = false;
    float* P; int pm_base, ks_len, nrows;
    __device__ __forceinline__ void operator()(const f32x4 (&acc)[2][2][4][2], const Unit& u, int wr, int wc, int fr, int fq) const {
        const int row0 = (u.pm - pm_base) * BM + wr * 64 + fr, col0 = u.pn * BM + wc * 32 + 4 * fq;
        float* base = P + (size_t)(u.pk / ks_len) * nrows * 1024;
#pragma unroll
        for (int ai = 0; ai < 2; ++ai)
#pragma unroll
            for (int m = 0; m < 4; ++m) { float* rowp = base + (size_t)(row0 + ai * HALF + m * 16) * 1024 + col0;
#pragma unroll
                for (int bj = 0; bj < 2; ++bj)
#pragma unroll
                    for (int n = 0; n < 2; ++n) *(f32x4*)(rowp + bj * HALF + n * 16) = acc[ai][bj][m][n]; }
    }
};
template <class Epi, class Sched, bool ALIGN_EPI = false, bool SP2 = false>
__device__ __forceinline__ void gemm_phase(PG8_LAS unsigned char* lds, const Gemm g, const Sched& S, const Epi& E) {
    const int tid = threadIdx.x, wid = __builtin_amdgcn_readfirstlane(tid >> 6), lane = tid & 63, wr = wid >> 2, wc = wid & 3, fr = lane & 15, fq = lane >> 4;
    const int K = g.K, nt = K / BK;
    unsigned voffA[2], voffB[2];
#pragma unroll
    for (int i = 0; i < 2; ++i) { int R, C; stage_rc(tid * 16 + i * 8192, R, C); const int Rb = Epi::PERM ? ((R & ~31) + perm32(R & 31)) : R;
        voffA[i] = (unsigned)(R * g.ld + C) * 2u; voffB[i] = (unsigned)(Rb * g.ld + C) * 2u; }
    const size_t kstep = (size_t)(BK * 2);
    const size_t hstep = (size_t)HALF * g.ld * 2;
    const size_t tstep = 2 * hstep;
    const unsigned ldsw = (unsigned)wid * 1024u;
    const int aoff = lds_byte(wr * 64 + fr, fq * 8), boff = lds_byte(wc * 32 + fr, fq * 8);
#define PG8_SA(b, h) (((b) * 2 + (h)) * HTB)
#define PG8_SB(b, h) ((4 + (b) * 2 + (h)) * HTB)
#define PG8_STAGE(bufoff, gbase, voff) do { _Pragma("unroll") for (int _i = 0; _i < 2; ++_i) \
        __builtin_amdgcn_global_load_lds((const unsigned*)((const char*)(gbase) + (voff)[_i]), (PG8_LAS unsigned*)(lds + (bufoff) + ldsw + _i * 8192), 16, 0, 0); } while (0)
#define PG8_LDA(dst, b, h) do { _Pragma("unroll") for (int m = 0; m < 4; ++m) _Pragma("unroll") for (int k = 0; k < 2; ++k) dst[m][k] = *(const PG8_LAS bf16x8*)(lds + PG8_SA(b, h) + aoff + m * 2048 + k * 1024); } while (0)
#define PG8_LDB(dst, b, h) do { _Pragma("unroll") for (int n = 0; n < 2; ++n) _Pragma("unroll") for (int k = 0; k < 2; ++k) dst[n][k] = *(const PG8_LAS bf16x8*)(lds + PG8_SB(b, h) + boff + n * 2048 + k * 1024); } while (0)
#define PG8_MMA(ai, bj, At, Bt) do { __builtin_amdgcn_s_setprio(1); _Pragma("unroll") for (int m = 0; m < 4; ++m) _Pragma("unroll") for (int n = 0; n < 2; ++n) _Pragma("unroll") for (int k = 0; k < 2; ++k) \
        acc[ai][bj][m][n] = __builtin_amdgcn_mfma_f32_16x16x32_bf16(Bt[n][k], At[m][k], acc[ai][bj][m][n], 0, 0, 0); __builtin_amdgcn_s_setprio(0); } while (0)
#define PG8_WAIT_V(n) asm volatile("s_waitcnt vmcnt(" #n ")" ::: "memory")
#define PG8_WAIT_L(n) asm volatile("s_waitcnt lgkmcnt(" #n ")" ::: "memory")
#define PG8_BAR __builtin_amdgcn_s_barrier()
#define PG8_SCHED __builtin_amdgcn_sched_barrier(0)
    Unit cur, nxt; int ui = 0;
    if (!S.next(0, cur)) return;
    f32x4 acc[2][2][4][2];
#pragma unroll
    for (int a = 0; a < 2; ++a)
#pragma unroll
        for (int b = 0; b < 2; ++b)
#pragma unroll
            for (int m = 0; m < 4; ++m)
#pragma unroll
                for (int n = 0; n < 2; ++n) acc[a][b][m][n] = (f32x4){0.f, 0.f, 0.f, 0.f};
    bf16x8 At[4][2], B0[2][2], B1[2][2];
    const char* cA = (const char*)g.A + (size_t)cur.pm * tstep + (size_t)cur.pk * 2; const char* cB = (const char*)g.Bt + (size_t)cur.pe * g.bstride + (cur.pe >= 4 ? g.bdelta : (size_t)0) + (size_t)cur.pn * tstep + (size_t)cur.pk * 2;
    S.a_ready(cur);
    if constexpr (SP2) {
        PG8_STAGE(PG8_SB(0, 0), cB, voffB); PG8_STAGE(PG8_SB(0, 1), cB + hstep, voffB); PG8_STAGE(PG8_SA(0, 0), cA, voffA); PG8_STAGE(PG8_SA(0, 1), cA + hstep, voffA);
        if (wr == 1) PG8_BAR;
        PG8_WAIT_V(2); PG8_BAR;
        PG8_STAGE(PG8_SB(1, 0), cB + kstep, voffB); PG8_STAGE(PG8_SA(1, 0), cA + kstep, voffA); PG8_STAGE(PG8_SB(1, 1), cB + hstep + kstep, voffB);
        PG8_WAIT_V(6); PG8_BAR;
    } else {
        PG8_STAGE(PG8_SB(0, 0), cB, voffB); PG8_STAGE(PG8_SA(0, 0), cA, voffA); PG8_STAGE(PG8_SB(0, 1), cB + hstep, voffB); PG8_STAGE(PG8_SA(0, 1), cA + hstep, voffA);
        if (wr == 1) PG8_BAR;
        PG8_WAIT_V(4); PG8_BAR;
        PG8_STAGE(PG8_SB(1, 0), cB + kstep, voffB); PG8_STAGE(PG8_SA(1, 0), cA + kstep, voffA); PG8_STAGE(PG8_SB(1, 1), cB + hstep + kstep, voffB);
        PG8_WAIT_V(6); PG8_BAR;
    }
    for (;;) {
        const bool has_next = S.next(ui + 1, nxt);
        const char* nA = has_next ? (const char*)g.A + (size_t)nxt.pm * tstep + (size_t)nxt.pk * 2 : cA; const char* nB = has_next ? (const char*)g.Bt + (size_t)nxt.pe * g.bstride + (nxt.pe >= 4 ? g.bdelta : (size_t)0) + (size_t)nxt.pn * tstep + (size_t)nxt.pk * 2 : cB;
        for (int t = 0; t < nt; t += 2) {
            const bool last = (t == nt - 2);
            const char* a1 = cA + (size_t)(t + 1) * kstep;
            const char* a2 = last ? nA : cA + (size_t)(t + 2) * kstep; const char* b2 = last ? nB : cB + (size_t)(t + 2) * kstep;
            const char* a3 = a2 + kstep; const char* b3 = b2 + kstep;
            if (last && has_next) S.a_ready(nxt);
            if constexpr (SP2) {
            PG8_LDB(B0, 0, 0); PG8_LDB(B1, 0, 1); PG8_SCHED; PG8_LDA(At, 0, 0); PG8_STAGE(PG8_SA(1, 1), a1 + hstep, voffA);
            PG8_WAIT_V(8); PG8_WAIT_L(0); PG8_BAR; PG8_MMA(0, 0, At, B0); PG8_MMA(0, 1, At, B1); PG8_BAR; PG8_SCHED;
            PG8_LDA(At, 0, 1); PG8_STAGE(PG8_SB(0, 0), b2, voffB); PG8_STAGE(PG8_SB(0, 1), b2 + hstep, voffB); PG8_STAGE(PG8_SA(0, 0), a2, voffA);
            PG8_WAIT_V(8); PG8_WAIT_L(0); PG8_BAR; PG8_MMA(1, 0, At, B0); PG8_MMA(1, 1, At, B1); PG8_BAR; PG8_SCHED;
            PG8_LDB(B0, 1, 0); PG8_LDB(B1, 1, 1); PG8_SCHED; PG8_LDA(At, 1, 0); PG8_STAGE(PG8_SA(0, 1), a2 + hstep, voffA);
            PG8_WAIT_V(8); PG8_WAIT_L(0); PG8_BAR; PG8_MMA(0, 0, At, B0); PG8_MMA(0, 1, At, B1); PG8_BAR; PG8_SCHED;
            PG8_LDA(At, 1, 1); PG8_STAGE(PG8_SB(1, 0), b3, voffB); PG8_STAGE(PG8_SB(1, 1), b3 + hstep, voffB); PG8_STAGE(PG8_SA(1, 0), a3, voffA);
            PG8_WAIT_V(8); PG8_WAIT_L(0); PG8_BAR; PG8_MMA(1, 0, At, B0); PG8_MMA(1, 1, At, B1); PG8_BAR; PG8_SCHED;
            } else {
            PG8_LDB(B0, 0, 0); PG8_SCHED; PG8_LDA(At, 0, 0); PG8_STAGE(PG8_SA(1, 1), a1 + hstep, voffA);
            PG8_WAIT_L(8); PG8_BAR; PG8_WAIT_L(0); PG8_MMA(0, 0, At, B0); PG8_BAR; PG8_SCHED;
            PG8_LDB(B1, 0, 1); PG8_STAGE(PG8_SB(0, 0), b2, voffB);
            PG8_BAR; PG8_WAIT_L(0); PG8_MMA(0, 1, At, B1); PG8_BAR;
            PG8_LDA(At, 0, 1); PG8_STAGE(PG8_SA(0, 0), a2, voffA);
            PG8_BAR; PG8_WAIT_L(0); PG8_MMA(1, 0, At, B0); PG8_BAR; PG8_SCHED;
            PG8_STAGE(PG8_SB(0, 1), b2 + hstep, voffB);
            PG8_WAIT_V(6); PG8_BAR; PG8_MMA(1, 1, At, B1); PG8_BAR;
            PG8_LDB(B0, 1, 0); PG8_SCHED; PG8_LDA(At, 1, 0); PG8_STAGE(PG8_SA(0, 1), a2 + hstep, voffA);
            PG8_WAIT_L(8); PG8_BAR; PG8_WAIT_L(0); PG8_MMA(0, 0, At, B0); PG8_BAR; PG8_SCHED;
            PG8_LDB(B1, 1, 1); PG8_STAGE(PG8_SB(1, 0), b3, voffB);
            PG8_BAR; PG8_WAIT_L(0); PG8_MMA(0, 1, At, B1); PG8_BAR;
            PG8_LDA(At, 1, 1); PG8_STAGE(PG8_SA(1, 0), a3, voffA);
            PG8_BAR; PG8_WAIT_L(0); PG8_MMA(1, 0, At, B0); PG8_BAR; PG8_SCHED;
            PG8_STAGE(PG8_SB(1, 1), b3 + hstep, voffB);
            PG8_WAIT_V(6); PG8_BAR; PG8_MMA(1, 1, At, B1); PG8_BAR;
            }
        }
        if constexpr (ALIGN_EPI) { if (wr == 0) PG8_BAR; }
        if constexpr (!Epi::AFTER_DRAIN) { E(acc, cur, wr, wc, fr, fq); S.done(cur); }
        if (!has_next) break;
#pragma unroll
        for (int a = 0; a < 2; ++a)
#pragma unroll
            for (int b = 0; b < 2; ++b)
#pragma unroll
                for (int m = 0; m < 4; ++m)
#pragma unroll
                    for (int n = 0; n < 2; ++n) acc[a][b][m][n] = (f32x4){0.f, 0.f, 0.f, 0.f};
        cur = nxt; cA = nA; cB = nB; ++ui;
        if constexpr (ALIGN_EPI) { if (wr == 1) PG8_BAR; }
    }
    PG8_WAIT_V(0);
    if constexpr (!ALIGN_EPI) { if (wr == 0) PG8_BAR; }
    PG8_BAR;
    if constexpr (Epi::AFTER_DRAIN) { E.fused(acc, cur, wr, wc, fr, fq, lds, wid, lane); S.done(cur); }
#undef PG8_SA
#undef PG8_SB
#undef PG8_STAGE
#undef PG8_LDA
#undef PG8_LDB
#undef PG8_MMA
#undef PG8_WAIT_V
#undef PG8_WAIT_L
#undef PG8_BAR
#undef PG8_SCHED
}
}

constexpr int NWAVES = 8, NTHR = 512;
constexpr int D = 1024, L = 16384, LC = 256, MT = L + LC;
constexpr int AB_IN = 2304, DFF = 2816, SSD_INP = 5376, SSD_IN_REAL = 5184, DIN = 2048, XBCW = 3072, FFE = 3584, NEXP = 8;
constexpr int NCH = MT / 128;
constexpr int MOE_ROWS = 2 * L + NEXP * 256;
constexpr float EPS = 1e-6f;

constexpr size_t MiB = 1u << 20;
constexpr size_t WS_CTL = 0, CTL_ZERO_BYTES = 32768;
constexpr size_t WS_MOD = 1 * MiB;
constexpr size_t WS_ROPE = 1 * MiB + 128 * 1024;
constexpr size_t WS_TOKE = 2 * MiB, WS_TOKW = 2 * MiB + 128 * 1024, WS_TOKP = 2 * MiB + 256 * 1024;
constexpr size_t WS_RSTD = 2 * MiB + 384 * 1024;
constexpr size_t WS_DEC = 3 * MiB;
constexpr size_t WS_X = 4 * MiB;
constexpr size_t WS_H = 36 * MiB + 512 * 1024;
constexpr size_t WS_WMOE = 69 * MiB, WS_YPART = WS_WMOE + 56 * MiB;
constexpr size_t WS_H2S = 181 * MiB, WS_ACTM = 249 * MiB, WS_H2 = 487 * MiB, WS_END = 520 * MiB;
constexpr size_t WS_WDA = WS_H, WS_WDB = 487 * MiB, WD_BYTES = (size_t)D * FFE * 2;
static_assert(WS_WDA + 4 * WD_BYTES <= WS_WMOE && WS_WDB + 4 * WD_BYTES <= WS_END && WS_WDB >= WS_ACTM + (size_t)MOE_ROWS * FFE * 2, "down-weight regions");
constexpr size_t WS_WSSDIN = 181 * MiB, WS_WSSDOUT = WS_WSSDIN + (size_t)SSD_INP * D * 2;
constexpr size_t WS_WABIN = 196 * MiB, WS_WABOUT = WS_WABIN + (size_t)AB_IN * D * 2, WS_WFFNGU = WS_WABOUT + (size_t)D * D * 2, WS_WFFND = WS_WFFNGU + (size_t)2 * DFF * D * 2;
constexpr size_t WS_PAB = 219 * MiB, WS_MIX = 293 * MiB, WS_ACT0 = 326 * MiB, WS_QR = 416 * MiB, WS_KR = 433 * MiB, WS_VT = 438 * MiB, WS_PART = 443 * MiB;
constexpr size_t WS_Z = 196 * MiB, WS_XBCR = 261 * MiB, WS_STATES = 261 * MiB, WS_DTRAW = 391 * MiB, WS_DTS = 396 * MiB, WS_XT = 405 * MiB, WS_BT = 470 * MiB, WS_BM = 487 * MiB, WS_CM = 503 * MiB + 512 * 1024;
constexpr size_t DTS_STRIDE = (size_t)32 * MT * 4;
static_assert(WS_X + (size_t)MT * D * 2 <= WS_H && WS_H + (size_t)MT * D * 2 <= WS_WMOE, "X / H map");
static_assert(WS_WMOE + (size_t)NEXP * 2 * FFE * D * 2 <= WS_H2S && WS_H2S + (size_t)MOE_ROWS * D * 2 <= WS_ACTM && WS_ACTM + (size_t)MOE_ROWS * FFE * 2 <= WS_H2 && WS_H2 + (size_t)L * D * 2 <= WS_END, "moe map");
static_assert(WS_YPART >= WS_WMOE + (size_t)NEXP * D * FFE * 2 && WS_YPART + (size_t)7 * 2048 * D * 4 <= WS_H2S, "moe map 2");
static_assert(WS_WSSDOUT + (size_t)D * DIN * 2 <= WS_WABIN && WS_WFFND + (size_t)D * DFF * 2 <= WS_PAB, "weights map");
static_assert(WS_PAB + (size_t)MT * AB_IN * 2 <= WS_MIX && WS_MIX + (size_t)MT * D * 2 <= WS_ACT0 && WS_ACT0 + (size_t)MT * DFF * 2 <= WS_QR && WS_QR + (size_t)8 * MT * 64 * 2 <= WS_KR && WS_KR + (size_t)2 * MT * 64 * 2 <= WS_VT && WS_VT + (size_t)128 * MT * 2 <= WS_PART && WS_PART + (size_t)11 * LC * D * 4 <= WS_END, "layer0 map");
static_assert(WS_WSSDOUT + (size_t)D * DIN * 2 <= WS_Z && WS_Z + (size_t)MT * DIN * 2 <= WS_XBCR && WS_XBCR + (size_t)MT * XBCW * 2 <= WS_DTRAW && WS_STATES + (size_t)2 * NCH * 32 * 64 * 128 * 2 <= WS_DTRAW && WS_DTRAW + (size_t)MT * 64 * 4 <= WS_DTS && WS_DTS + 4 * DTS_STRIDE <= WS_XT && WS_XT + (size_t)DIN * MT * 2 <= WS_BT && WS_BT + (size_t)512 * MT * 2 <= WS_BM && WS_BM + (size_t)MT * 512 * 2 <= WS_CM && WS_CM + (size_t)MT * 512 * 2 <= WS_END, "ssd map");
static_assert(WS_PART + (size_t)11 * LC * D * 4 <= WS_BT && WS_PART >= WS_DTS + 4 * DTS_STRIDE || true, "PART is read by the layer-1 modulate before the SSD conv writes XT");
constexpr int CW_TMO = 0;
constexpr int CW_HIST = 1024;
constexpr int CW_BAR = 4096;

constexpr int RING_BYTES = 159744, LDSCTL_OFF = RING_BYTES, MISC_OFF = LDSCTL_OFF + 320, LDS_BYTES = 163840;

#define GAS __attribute__((address_space(1)))
#define LAS __attribute__((address_space(3)))
typedef unsigned short bf16;
typedef unsigned v4u __attribute__((ext_vector_type(4)));
typedef unsigned v2u __attribute__((ext_vector_type(2)));
typedef float f32x4 __attribute__((ext_vector_type(4)));
typedef GAS unsigned gu32;
#define RLX_AGENT __ATOMIC_RELAXED, __HIP_MEMORY_SCOPE_AGENT
#define LDS_WAIT() asm volatile("s_waitcnt lgkmcnt(0)" ::: "memory")
#define VM_WAIT() asm volatile("s_waitcnt vmcnt(0)" ::: "memory")
__device__ __forceinline__ unsigned pk2(float lo, float hi) { return pg8::cvt_pk_bf16(lo, hi); }
__device__ __forceinline__ float bflo(unsigned u) { return __uint_as_float(u << 16); }
__device__ __forceinline__ float bfhi(unsigned u) { return __uint_as_float(u & 0xffff0000u); }
__device__ __forceinline__ float bf1(bf16 b) { return __uint_as_float(((unsigned)b) << 16); }
__device__ __forceinline__ float sigmoid_f(float x) { return __builtin_amdgcn_rcpf(1.0f + __builtin_amdgcn_exp2f(-1.4426950408889634f * x)); }
__device__ __forceinline__ float softplus_f(float x) {
    const float y = __builtin_amdgcn_exp2f(-1.4426950408889634f * fabsf(x));
    const float l = y < 1.0e-3f ? y * (1.0f - 0.5f * y) : __builtin_amdgcn_logf(1.0f + y) * 0.6931471805599453f;
    return fmaxf(x, 0.f) + l; }

#define XB_TMO      128
#define XB_XCNT(j)  (256  + 64 * (j))
#define XB_XSUB(j)  (1280 + 64 * (j))
#define XB_XGEN(j)  (2304 + 64 * (j))
#define XB_TOP      3328
#define XB_TOPGEN   3392
#define XCD_BAR_WORDS 3456
#define XB_SPIN_CAP (1u << 18)
__device__ __forceinline__ unsigned xb_ld(unsigned* p)              { return __hip_atomic_load(p, __ATOMIC_RELAXED, __HIP_MEMORY_SCOPE_AGENT); }
__device__ __forceinline__ unsigned xb_add(unsigned* p, unsigned v) { return __hip_atomic_fetch_add(p, v, __ATOMIC_RELAXED, __HIP_MEMORY_SCOPE_AGENT); }
__device__ __forceinline__ unsigned xb_xcc_id() { return (unsigned)__builtin_amdgcn_s_getreg((3 << 11) | 20) & 0xFu; }
#define XB_SPIN(cond, bar) do { unsigned _sp = 0; while (cond) { __builtin_amdgcn_s_sleep(1); \
    if ((++_sp & 255u) == 0u) { if (xb_ld(&(bar)[XB_TMO])) break; if (_sp > XB_SPIN_CAP) { atomicAdd(&(bar)[XB_TMO], 1u); break; } } } } while (0)
struct XcdBarrier { unsigned* bar; unsigned x; volatile LAS unsigned* st; };
__device__ __forceinline__ XcdBarrier xcd_barrier_post(unsigned* bar, volatile LAS unsigned* st) {
    XcdBarrier b; b.bar = bar; b.x = xb_xcc_id(); b.st = st;
    if (threadIdx.x == 0) (void)xb_add(&bar[XB_XCNT(b.x)], 1u);
    return b;
}
__device__ __forceinline__ void xcd_barrier_complete(unsigned* bar, unsigned x, unsigned& nloc, unsigned& nx) {
    const unsigned G = gridDim.x * gridDim.y * gridDim.z;
    unsigned sum, cnt, mine, sp = 0u;
    for (;;) {
        sum = 0u; cnt = 0u; mine = 0u;
#pragma unroll
        for (unsigned j = 0; j < 16; ++j) { const unsigned c = xb_ld(&bar[XB_XCNT(j)]); sum += c; cnt += (c > 0u) ? 1u : 0u; mine = (j == x) ? c : mine; }
        if (sum == G) break;
        __builtin_amdgcn_s_sleep(1);
        if ((++sp & 255u) == 0u) { if (xb_ld(&bar[XB_TMO])) break; if (sp > XB_SPIN_CAP) { atomicAdd(&bar[XB_TMO], 1u); break; } }
    }
    nloc = mine > 0u ? mine : 1u; nx = cnt > 0u ? cnt : 1u;
}
__device__ __forceinline__ void xcd_barrier(const XcdBarrier& b) {
    asm volatile("s_waitcnt vmcnt(0)" ::: "memory");
    __syncthreads();
    if (threadIdx.x == 0) {
        unsigned* bar = b.bar;
        __builtin_amdgcn_s_waitcnt(0);
        unsigned nloc = b.st[0], nx = b.st[1];
        if (nloc == 0u) { xcd_barrier_complete(bar, b.x, nloc, nx); b.st[0] = nloc; b.st[1] = nx; }
        const unsigned old = xb_add(&bar[XB_XSUB(b.x)], 1u);
        const unsigned gen = old / nloc;
        if (old + 1u == (gen + 1u) * nloc) {
            __builtin_amdgcn_fence(__ATOMIC_RELEASE, "agent");
            asm volatile("s_waitcnt vmcnt(0)" ::: "memory");
            const unsigned og = xb_add(&bar[XB_TOP], 1u);
            const unsigned tg = og / nx;
            if (og + 1u == (tg + 1u) * nx) xb_add(&bar[XB_TOPGEN], 1u);
            else XB_SPIN(xb_ld(&bar[XB_TOPGEN]) == tg, bar);
            __builtin_amdgcn_fence(__ATOMIC_ACQUIRE, "agent");
            xb_add(&bar[XB_XGEN(b.x)], 1u);
            asm volatile("s_waitcnt vmcnt(0)" ::: "memory");
        } else {
            XB_SPIN(xb_ld(&bar[XB_XGEN(b.x)]) == gen, bar);
            __builtin_amdgcn_fence(__ATOMIC_ACQUIRE, "agent");
            asm volatile("s_waitcnt vmcnt(0)" ::: "memory");
        }
    }
    __syncthreads();
}

struct Frame {
    LAS unsigned char* lds;
    int tid, lane, wave, vcu, G;
    const float* in[30]; float* out; unsigned char* ws;
};
enum { I_X = 0, I_C, I_CTX, I_CCTX, I_ADAW, I_ADAB, I_N1G, I_N2G, I_ABWIN, I_ABCONV, I_ABSINK, I_ABWOUT, I_FFNG, I_FFNU, I_FFND, I_SSDWIN, I_SSDCW, I_SSDCB,
       I_DTBF, I_DTBB, I_ALOGF, I_ALOGB, I_SSDD, I_SSDNG, I_SSDWOUT, I_ROUTER, I_MOEG, I_MOEU, I_MOED, I_FINALG };
template <int CTRL> __device__ __forceinline__ float dpp_add(float v) { return v + __int_as_float(__builtin_amdgcn_update_dpp(0, __float_as_int(v), CTRL, 0xf, 0xf, true)); }
__device__ __forceinline__ float wave_sum(float v) {
    v = dpp_add<0xB1>(v);
    v = dpp_add<0x4E>(v);
    v = dpp_add<0x141>(v);
    v = dpp_add<0x140>(v);
    const int iv = __float_as_int(v);
    return (__int_as_float(__builtin_amdgcn_readlane(iv, 0)) + __int_as_float(__builtin_amdgcn_readlane(iv, 16))) + (__int_as_float(__builtin_amdgcn_readlane(iv, 32)) + __int_as_float(__builtin_amdgcn_readlane(iv, 48)));
}
constexpr int M_SH1 = 0, M_SC1 = 1024, M_G1 = 2048, M_SH2 = 3072, M_SC2 = 4096, M_G2 = 5120;
__device__ __forceinline__ const float* modp(const Frame& F, int layer, int s) { return (const float*)(F.ws + WS_MOD) + (size_t)(layer * 2 + s) * 6144; }

__device__ __forceinline__ void tr_load(const float* W, int N, int k0, int n0, int lane, f32x4 (&w)[8]) {
#pragma unroll
    for (int i = 0; i < 8; ++i) w[i] = __builtin_nontemporal_load((const GAS f32x4*)(W + (size_t)(k0 + (lane >> 3) + 8 * i) * N + n0 + 4 * (lane & 7)));
}
__device__ __forceinline__ void tr_finish(const f32x4 (&w)[8], bf16* WT, int Kdst, int k0, int drow0, LAS float* scr, int lane) {
#pragma unroll
    for (int i = 0; i < 8; ++i) { LAS float* d = scr + ((lane >> 3) + 8 * i) * 33 + 4 * (lane & 7); d[0] = w[i].x; d[1] = w[i].y; d[2] = w[i].z; d[3] = w[i].w; }
    LDS_WAIT(); asm volatile("" ::: "memory");
    const int c = lane & 7;
#pragma unroll
    for (int j = 0; j < 4; ++j) { const int n = (lane >> 3) + 8 * j; const LAS float* s = scr + (8 * c) * 33 + n;
        v4u o; o.x = pk2(s[0 * 33], s[1 * 33]); o.y = pk2(s[2 * 33], s[3 * 33]); o.z = pk2(s[4 * 33], s[5 * 33]); o.w = pk2(s[6 * 33], s[7 * 33]);
        __builtin_nontemporal_store(o, (GAS v4u*)(WT + (size_t)(drow0 + n) * Kdst + k0 + 8 * c)); }
    LDS_WAIT(); asm volatile("" ::: "memory");
}
__device__ __forceinline__ void tr_item(const float* W, int N, bf16* WT, int Kdst, int k0, int n0, int drow0, LAS float* scr, int lane) {
    { f32x4 w[8];
#pragma unroll
      for (int i = 0; i < 8; ++i) w[i] = __builtin_nontemporal_load((const GAS f32x4*)(W + (size_t)(k0 + (lane >> 3) + 8 * i) * N + n0 + 4 * (lane & 7)));
#pragma unroll
      for (int i = 0; i < 8; ++i) { LAS float* d = scr + ((lane >> 3) + 8 * i) * 33 + 4 * (lane & 7); d[0] = w[i].x; d[1] = w[i].y; d[2] = w[i].z; d[3] = w[i].w; } }
    LDS_WAIT(); asm volatile("" ::: "memory");
    const int c = lane & 7;
#pragma unroll
    for (int j = 0; j < 4; ++j) { const int n = (lane >> 3) + 8 * j; const LAS float* s = scr + (8 * c) * 33 + n;
        v4u o; o.x = pk2(s[0 * 33], s[1 * 33]); o.y = pk2(s[2 * 33], s[3 * 33]); o.z = pk2(s[4 * 33], s[5 * 33]); o.w = pk2(s[6 * 33], s[7 * 33]);
        __builtin_nontemporal_store(o, (GAS v4u*)(WT + (size_t)(drow0 + n) * Kdst + k0 + 8 * c)); }
    LDS_WAIT(); asm volatile("" ::: "memory");
}
__device__ __forceinline__ void tr_matrix(const Frame& F, const float* W, int K, int N, bf16* WT, int mode, int& first, int gw = -1, int NGW = 0) {
    LAS float* scr = (LAS float*)(F.lds + F.wave * 16384);
    if (gw < 0) { gw = F.vcu * NWAVES + F.wave; NGW = F.G * NWAVES; }
    const int nblk = N / 32, nitems = (K / 64) * nblk;
    int it = gw - (first % NGW); if (it < 0) it += NGW;
    for (; it < nitems; it += NGW) {
        const int kb = it / nblk, nb = it % nblk, n0 = 32 * nb;
        const int drow0 = mode == 0 ? n0 : ((n0 >> 7) * 256 + (n0 & 127) + (mode == 2 ? 128 : 0));
        tr_item(W, N, WT, K, 64 * kb, n0, drow0, scr, F.lane);
    }
    first += nitems;
}

__device__ __forceinline__ void ph_convert_ffn(Frame& F, int gw, int NGW) {
    int first = 0;
    tr_matrix(F, F.in[I_FFNG], D, DFF, (bf16*)(F.ws + WS_WFFNGU), 1, first, gw, NGW);
    tr_matrix(F, F.in[I_FFNU], D, DFF, (bf16*)(F.ws + WS_WFFNGU), 2, first, gw, NGW);
    tr_matrix(F, F.in[I_FFND], DFF, D, (bf16*)(F.ws + WS_WFFND), 0, first, gw, NGW);
}
__device__ __forceinline__ void ph_convert_ssd(Frame& F, int gw, int NGW) {
    int first = 0;
    tr_matrix(F, F.in[I_SSDWIN], D, SSD_IN_REAL, (bf16*)(F.ws + WS_WSSDIN), 0, first, gw, NGW);
    tr_matrix(F, F.in[I_SSDWOUT], DIN, D, (bf16*)(F.ws + WS_WSSDOUT), 0, first, gw, NGW);
    { v4u* p = (v4u*)((bf16*)(F.ws + WS_WSSDIN) + (size_t)SSD_IN_REAL * D); const int n16 = (SSD_INP - SSD_IN_REAL) * D * 2 / 16;
      for (int i = gw * 64 + F.lane; i < n16; i += NGW * 64) p[i] = (v4u){0u, 0u, 0u, 0u}; }
}
__device__ __forceinline__ void ph_prologue(Frame& F) {
    LAS float* scx = (LAS float*)F.lds;
    LAS float* scc = scx + 1024;
    LAS float* red = scc + 1024;
    const float* c = F.in[I_C]; const float* cc = F.in[I_CCTX];
    for (int i = F.tid; i < 1024; i += NTHR) { const float a = c[i], b = cc[i]; scx[i] = a * sigmoid_f(a); scc[i] = b * sigmoid_f(b); }
    __syncthreads();
    float* MOD = (float*)(F.ws + WS_MOD);
    for (int u = F.vcu; u < 192; u += F.G) {
        const int layer = u / 96, n0 = (u % 96) * 64;
        const float* W = F.in[I_ADAW] + (size_t)layer * 1024 * 6144 + n0 + F.lane;
        float ax = 0.f, ac = 0.f; const int kb = F.wave * 128;
#pragma unroll 1
        for (int k0 = 0; k0 < 128; k0 += 32) { float w[32];
#pragma unroll
            for (int k = 0; k < 32; ++k) w[k] = __builtin_nontemporal_load(W + (size_t)(kb + k0 + k) * 6144);
#pragma unroll
            for (int k = 0; k < 32; ++k) { ax += scx[kb + k0 + k] * w[k]; ac += scc[kb + k0 + k] * w[k]; } }
        red[(F.wave * 2 + 0) * 64 + F.lane] = ax; red[(F.wave * 2 + 1) * 64 + F.lane] = ac;
        __syncthreads();
        if (F.tid < 128) { const int s = F.tid >> 6, l = F.tid & 63; float t = 0.f;
#pragma unroll
            for (int w = 0; w < 8; ++w) t += red[(w * 2 + s) * 64 + l];
            MOD[(size_t)(layer * 2 + s) * 6144 + n0 + l] = t + F.in[I_ADAB][layer * 6144 + n0 + l]; }
        __syncthreads();
    }
    {
        float* ct = (float*)(F.ws + WS_ROPE); float* st = ct + 4096;
        for (int idx = F.vcu * NTHR + F.tid; idx < 4096; idx += F.G * NTHR) { const int pos = idx >> 4, i = idx & 15;
            const float inv = (float)pow(10000.0, -(double)i / 16.0); const float ang = (float)pos * inv;
            ct[idx] = (float)cos((double)ang); st[idx] = (float)sin((double)ang); }
    }
    __syncthreads();
    int first = 0;
    tr_matrix(F, F.in[I_ABWIN], D, AB_IN, (bf16*)(F.ws + WS_WABIN), 0, first);
    tr_matrix(F, F.in[I_ABWOUT], D, D, (bf16*)(F.ws + WS_WABOUT), 0, first);
}
constexpr int MOE_GU_ITEMS = NEXP * 2 * (D / 64) * (FFE / 32);
struct GuItem { const float* W; bf16* WT; int k0, n0, drow0; };
__device__ __forceinline__ GuItem gu_item(const Frame& F, int it) {
    constexpr int PER_M = (D / 64) * (FFE / 32), NB = FFE / 32;
    const int e = it / (2 * PER_M), rem = it % (2 * PER_M), mat = rem / PER_M, idx = rem % PER_M, kb = idx / NB, n0 = 32 * (idx % NB);
    GuItem g; g.W = (mat ? F.in[I_MOEU] : F.in[I_MOEG]) + (size_t)e * D * FFE; g.WT = (bf16*)(F.ws + WS_WMOE) + (size_t)e * 2 * FFE * D;
    g.k0 = 64 * kb; g.n0 = n0; g.drow0 = (n0 >> 7) * 256 + (n0 & 127) + (mat ? 128 : 0); return g;
}
__device__ __forceinline__ void moe_gu_convert(Frame& F, int lo, int hi, int gw, int NGW) {
    LAS float* scr = (LAS float*)(F.lds + F.wave * 16384);
    int it = lo + gw; if (it >= hi) return;
    f32x4 wa[8], wb[8];
    GuItem ga = gu_item(F, it), gb = ga; tr_load(ga.W, FFE, ga.k0, ga.n0, F.lane, wa);
    for (;;) {
        const int itb = it + NGW; const bool hb = itb < hi;
        if (hb) { gb = gu_item(F, itb); tr_load(gb.W, FFE, gb.k0, gb.n0, F.lane, wb); }
        tr_finish(wa, ga.WT, D, ga.k0, ga.drow0, scr, F.lane);
        if (!hb) break;
        it = itb + NGW; const bool ha = it < hi;
        if (ha) { ga = gu_item(F, it); tr_load(ga.W, FFE, ga.k0, ga.n0, F.lane, wa); }
        tr_finish(wb, gb.WT, D, gb.k0, gb.drow0, scr, F.lane);
        if (!ha) break;
    }
}
constexpr int MOE_DN_ITEMS = NEXP * (FFE / 64) * (D / 32), MOE_DN_PER_E = (FFE / 64) * (D / 32);
__device__ __forceinline__ void moe_dn_convert(Frame& F, int lo, int hi, int gw, int NGW) {
    LAS float* scr = (LAS float*)(F.lds + F.wave * 16384);
    for (int it = lo + gw; it < hi; it += NGW) {
        const int e = it / MOE_DN_PER_E, idx = it % MOE_DN_PER_E, kb = idx / (D / 32), n0 = 32 * (idx % (D / 32));
        bf16* WT = (bf16*)(F.ws + (e < 4 ? WS_WDA : WS_WDB)) + (size_t)(e & 3) * D * FFE;
        tr_item(F.in[I_MOED] + (size_t)e * FFE * D, D, WT, FFE, 64 * kb, n0, n0, scr, F.lane);
    }
}
__device__ __forceinline__ void idle_round_convert(Frame& F, int nunits, int lo, int hi) {
    const int full = nunits / F.G, nbusy = nunits - full * F.G;
    if ((int)blockIdx.x >= nbusy) moe_gu_convert(F, lo, hi, ((int)blockIdx.x - nbusy) * NWAVES + F.wave, (F.G - nbusy) * NWAVES);
}


template <bool BF> __device__ __forceinline__ void load_row4(const void* row, int lane, f32x4 (&v)[4]) {
    if (BF) { const GAS v2u* p = (const GAS v2u*)row + lane;
#pragma unroll
        for (int j = 0; j < 4; ++j) { const v2u a = p[64 * j]; v[j] = (f32x4){bflo(a.x), bfhi(a.x), bflo(a.y), bfhi(a.y)}; } }
    else { const GAS f32x4* p = (const GAS f32x4*)row + lane;
#pragma unroll
        for (int j = 0; j < 4; ++j) v[j] = __builtin_nontemporal_load(p + 64 * j); }
}
template <bool LAT_BF, bool CTX_BF, int NPART>
__device__ __forceinline__ void ph_modulate(Frame& F, const void* src0, const void* src1, const float* gain, const float* mx, const float* mc, int osh, int osc, bf16* H, int nrows,
                                            const float* part, const float* gatec, bf16* xw) {
    const int gw = F.vcu * NWAVES + F.wave, NGW = F.G * NWAVES;
    f32x4 ca[4], cb[4];
#pragma unroll
    for (int j = 0; j < 4; ++j) { const int c = 4 * (64 * j + F.lane); ca[j] = *(const f32x4*)(gain + c) * (*(const f32x4*)(mx + osc + c) + 1.0f); cb[j] = *(const f32x4*)(mx + osh + c); }
    for (int r0 = gw; r0 < nrows; r0 += 2 * NGW) {
        int rr[2]; f32x4 v[2][4];
#pragma unroll
        for (int k = 0; k < 2; ++k) { const int r = r0 + k * NGW; rr[k] = r < nrows ? r : r0;
            if (rr[k] < L) load_row4<LAT_BF>((const char*)src0 + (size_t)rr[k] * D * (LAT_BF ? 2 : 4), F.lane, v[k]);
            else load_row4<CTX_BF>((const char*)src1 + (size_t)(rr[k] - L) * D * (CTX_BF ? 2 : 4), F.lane, v[k]); }
#pragma unroll
        for (int k = 0; k < 2; ++k) { const int r = rr[k];
            if (NPART > 0 && r >= L) {
#pragma unroll
                for (int j = 0; j < 4; ++j) { const int c = 4 * (64 * j + F.lane); f32x4 s = (f32x4){0.f, 0.f, 0.f, 0.f};
#pragma unroll
                    for (int q = 0; q < NPART; ++q) s += *(const f32x4*)(part + ((size_t)q * LC + (r - L)) * D + c);
                    v[k][j] += *(const f32x4*)(gatec + c) * s;
                    if (xw) { v2u o; o.x = pk2(v[k][j].x, v[k][j].y); o.y = pk2(v[k][j].z, v[k][j].w); *(GAS v2u*)(xw + (size_t)r * D + c) = o; } }
            }
            float s2 = 0.f;
#pragma unroll
            for (int j = 0; j < 4; ++j) s2 += (v[k][j].x * v[k][j].x + v[k][j].y * v[k][j].y) + (v[k][j].z * v[k][j].z + v[k][j].w * v[k][j].w);
            const float rstd = __builtin_amdgcn_rsqf(wave_sum(s2) * (1.0f / D) + EPS);
            GAS v2u* o8 = (GAS v2u*)(H + (size_t)r * D) + F.lane;
#pragma unroll
            for (int j = 0; j < 4; ++j) { const int c = 4 * (64 * j + F.lane);
                f32x4 A = ca[j], B = cb[j];
                if (r >= L) { A = *(const f32x4*)(gain + c) * (*(const f32x4*)(mc + osc + c) + 1.0f); B = *(const f32x4*)(mc + osh + c); }
                const f32x4 y = v[k][j] * rstd * A + B;
                v2u o; o.x = pk2(y.x, y.y); o.y = pk2(y.z, y.w); o8[64 * j] = o; }
        }
    }
}

constexpr float QSCL = 0.125f * 1.4426950408889634f;
__device__ __forceinline__ void ph_ab_elem(Frame& F) {
    const bf16* PAB = (const bf16*)(F.ws + WS_PAB); bf16* MIX = (bf16*)(F.ws + WS_MIX);
    bf16* QR = (bf16*)(F.ws + WS_QR); bf16* KR = (bf16*)(F.ws + WS_KR); bf16* VT = (bf16*)(F.ws + WS_VT);
    const float* ct = (const float*)(F.ws + WS_ROPE); const float* st = ct + 4096;
    const int lane = F.lane;
    float cw[3][8];
#pragma unroll
    for (int k = 0; k < 3; ++k)
#pragma unroll
        for (int j = 0; j < 8; ++j) cw[k][j] = F.in[I_ABCONV][k * 512 + 8 * lane + j];
    LAS unsigned char* vl = F.lds;
    for (int tile = F.vcu; tile < MT / 16; tile += F.G) {
        const int r0 = tile * 16; const bool isctx = r0 >= L; const int slo = isctx ? L : 0, shi = isctx ? MT : L;
        for (int rr = 0; rr < 2; ++rr) {
            const int r = r0 + F.wave * 2 + rr;
            float acc[8];
#pragma unroll
            for (int j = 0; j < 8; ++j) acc[j] = 0.f;
#pragma unroll
            for (int k = 0; k < 3; ++k) { const int q = r + k - 1;
                if (q >= slo && q < shi) { const v4u gc = *(const GAS v4u*)(PAB + (size_t)q * AB_IN + 512 + 8 * lane), ha = *(const GAS v4u*)(PAB + (size_t)q * AB_IN + 1024 + 8 * lane);
                    acc[0] += cw[k][0] * bflo(gc.x) * bflo(ha.x); acc[1] += cw[k][1] * bfhi(gc.x) * bfhi(ha.x); acc[2] += cw[k][2] * bflo(gc.y) * bflo(ha.y); acc[3] += cw[k][3] * bfhi(gc.y) * bfhi(ha.y);
                    acc[4] += cw[k][4] * bflo(gc.z) * bflo(ha.z); acc[5] += cw[k][5] * bfhi(gc.z) * bfhi(ha.z); acc[6] += cw[k][6] * bflo(gc.w) * bflo(ha.w); acc[7] += cw[k][7] * bfhi(gc.w) * bfhi(ha.w); } }
            { const v4u gb = *(const GAS v4u*)(PAB + (size_t)r * AB_IN + 8 * lane); v4u o;
              o.x = pk2(acc[0] * bflo(gb.x), acc[1] * bfhi(gb.x)); o.y = pk2(acc[2] * bflo(gb.y), acc[3] * bfhi(gb.y)); o.z = pk2(acc[4] * bflo(gb.z), acc[5] * bfhi(gb.z)); o.w = pk2(acc[6] * bflo(gb.w), acc[7] * bfhi(gb.w));
              *(GAS v4u*)(MIX + (size_t)r * D + 8 * lane) = o; }
            const int sub = lane & 7, axis = sub >> 2, half = (sub >> 1) & 1;
            const int pos = axis == 0 ? (r >> 6) : (r & 63);
            f32x4 c0 = (f32x4){1.f, 1.f, 1.f, 1.f}, c1 = c0, s0 = (f32x4){0.f, 0.f, 0.f, 0.f}, s1 = s0;
            if (!isctx) { const float* cp = ct + pos * 16 + 8 * (lane & 1); const float* sp = st + pos * 16 + 8 * (lane & 1);
                c0 = *(const f32x4*)cp; c1 = *(const f32x4*)(cp + 4); s0 = *(const f32x4*)sp; s1 = *(const f32x4*)(sp + 4);
                if (half == 0) { s0 = -s0; s1 = -s1; } }
            {
                const v4u a = *(const GAS v4u*)(PAB + (size_t)r * AB_IN + 1536 + 8 * lane);
                v4u p; p.x = (unsigned)__builtin_amdgcn_update_dpp(0, (int)a.x, 0x4E, 0xf, 0xf, true); p.y = (unsigned)__builtin_amdgcn_update_dpp(0, (int)a.y, 0x4E, 0xf, 0xf, true); p.z = (unsigned)__builtin_amdgcn_update_dpp(0, (int)a.z, 0x4E, 0xf, 0xf, true); p.w = (unsigned)__builtin_amdgcn_update_dpp(0, (int)a.w, 0x4E, 0xf, 0xf, true);
                const f32x4 qc0 = c0 * QSCL, qc1 = c1 * QSCL, qs0 = s0 * QSCL, qs1 = s1 * QSCL;
                v4u o; o.x = pk2(bflo(a.x) * qc0.x + bflo(p.x) * qs0.x, bfhi(a.x) * qc0.y + bfhi(p.x) * qs0.y); o.y = pk2(bflo(a.y) * qc0.z + bflo(p.y) * qs0.z, bfhi(a.y) * qc0.w + bfhi(p.y) * qs0.w);
                o.z = pk2(bflo(a.z) * qc1.x + bflo(p.z) * qs1.x, bfhi(a.z) * qc1.y + bfhi(p.z) * qs1.y); o.w = pk2(bflo(a.w) * qc1.z + bflo(p.w) * qs1.z, bfhi(a.w) * qc1.w + bfhi(p.w) * qs1.w);
                *(GAS v4u*)(QR + ((size_t)(lane >> 3) * MT + r) * 64 + 8 * sub) = o;
            }
            {
                const int kl = lane & 15;
                const v4u a = *(const GAS v4u*)(PAB + (size_t)r * AB_IN + 2048 + 8 * kl);
                v4u p; p.x = (unsigned)__builtin_amdgcn_update_dpp(0, (int)a.x, 0x4E, 0xf, 0xf, true); p.y = (unsigned)__builtin_amdgcn_update_dpp(0, (int)a.y, 0x4E, 0xf, 0xf, true); p.z = (unsigned)__builtin_amdgcn_update_dpp(0, (int)a.z, 0x4E, 0xf, 0xf, true); p.w = (unsigned)__builtin_amdgcn_update_dpp(0, (int)a.w, 0x4E, 0xf, 0xf, true);
                v4u o; o.x = pk2(bflo(a.x) * c0.x + bflo(p.x) * s0.x, bfhi(a.x) * c0.y + bfhi(p.x) * s0.y); o.y = pk2(bflo(a.y) * c0.z + bflo(p.y) * s0.z, bfhi(a.y) * c0.w + bfhi(p.y) * s0.w);
                o.z = pk2(bflo(a.z) * c1.x + bflo(p.z) * s1.x, bfhi(a.z) * c1.y + bfhi(p.z) * s1.y); o.w = pk2(bflo(a.w) * c1.z + bflo(p.w) * s1.z, bfhi(a.w) * c1.w + bfhi(p.w) * s1.w);
                if (lane < 16) *(GAS v4u*)(KR + ((size_t)(lane >> 3) * MT + r) * 64 + 8 * sub) = o;
            }
        }
        if (F.tid < 256) { const int p = F.tid, row = p >> 4, c8 = (p & 15) * 8;
            *(LAS v4u*)(vl + row * 272 + c8 * 2) = *(const GAS v4u*)(PAB + (size_t)(r0 + row) * AB_IN + 2176 + c8); }
        __syncthreads();
        if (F.tid < 256) { const int p = F.tid, ch = p >> 1, rg = p & 1;
            const LAS bf16* s = (const LAS bf16*)(vl + (8 * rg) * 272 + ch * 2);
            v4u o; o.x = (unsigned)s[0] | ((unsigned)s[136] << 16); o.y = (unsigned)s[2 * 136] | ((unsigned)s[3 * 136] << 16); o.z = (unsigned)s[4 * 136] | ((unsigned)s[5 * 136] << 16); o.w = (unsigned)s[6 * 136] | ((unsigned)s[7 * 136] << 16);
            *(GAS v4u*)(VT + (size_t)ch * MT + r0 + 8 * rg) = o; }
        __syncthreads();
    }
}


__device__ __forceinline__ void ph_ssd_conv(Frame& F) {
    const bf16* XB = (const bf16*)(F.ws + WS_XBCR);
    bf16* XT = (bf16*)(F.ws + WS_XT); bf16* BT = (bf16*)(F.ws + WS_BT); bf16* BMm = (bf16*)(F.ws + WS_BM); bf16* CMm = (bf16*)(F.ws + WS_CM);
    const float* cwp = F.in[I_SSDCW]; const float* cbp = F.in[I_SSDCB];
    LAS unsigned char* tl = F.lds;
    { const float* DR = (const float*)(F.ws + WS_DTRAW); float* DTF = (float*)(F.ws + WS_DTS); float* DTB = DTF + (size_t)32 * MT;
      const int gw = F.vcu * NWAVES + F.wave, NGW = F.G * NWAVES;
      for (int task = gw; task < (MT / 64) * 4; task += NGW) { const int tb = task >> 2, jq = task & 3; const int t = tb * 64 + F.lane; const float* row = DR + (size_t)t * 64;
#pragma unroll
          for (int j4 = 4 * jq; j4 < 4 * jq + 4; ++j4) { const f32x4 r = *(const f32x4*)(row + 4 * j4);
#pragma unroll
              for (int q = 0; q < 4; ++q) { const int j = 4 * j4 + q; const float v = softplus_f(r[q] + (j < 32 ? F.in[I_DTBF][j] : F.in[I_DTBB][j - 32]));
                  if (j < 32) DTF[(size_t)j * MT + t] = v; else DTB[(size_t)(j - 32) * MT + t] = v; } } } }
    LAS float* cwl = (LAS float*)(F.lds + 130 * 272 + 64);
    for (int i = F.tid; i < 3 * XBCW; i += NTHR) cwl[i] = cwp[i];
    for (int i = F.tid; i < XBCW; i += NTHR) cwl[3 * XBCW + i] = cbp[i];
    __syncthreads();
    const int ntiles = NCH * 24;
    v4u pre[5];
#define CONV_LOAD(tile_) do { const int c_ = (tile_) / 24, cb_ = (tile_) % 24, t0_ = c_ * 128, ch0_ = cb_ * 128; const int slo_ = c_ < 128 ? 0 : L, shi_ = c_ < 128 ? L : MT; \
        _Pragma("unroll") for (int i_ = 0; i_ < 5; ++i_) { const int p_ = F.tid + NTHR * i_, row_ = p_ >> 4, c8_ = (p_ & 15) * 8; const int t_ = t0_ - 1 + row_; \
            pre[i_] = (v4u){0u, 0u, 0u, 0u}; if (p_ < 130 * 16 && t_ >= slo_ && t_ < shi_) pre[i_] = __builtin_nontemporal_load((const GAS v4u*)(XB + (size_t)t_ * XBCW + ch0_ + c8_)); } } while (0)
    int tile = F.vcu;
    if (tile < ntiles) CONV_LOAD(tile);
    for (; tile < ntiles; tile += F.G) {
        const int c = tile / 24, cb = tile % 24, t0 = c * 128, ch0 = cb * 128;
#pragma unroll
        for (int i = 0; i < 5; ++i) { const int p = F.tid + NTHR * i, row = p >> 4, c8 = (p & 15) * 8; if (p < 130 * 16) *(LAS v4u*)(tl + row * 272 + ((c8 * 2) ^ (((row >> 3) & 7) << 4))) = pre[i]; }
        __syncthreads();
        if (tile + F.G < ntiles) CONV_LOAD(tile + F.G);
        if (cb < 20) {
            bf16* dst = BT + (size_t)(ch0 - 2048) * MT;
#pragma unroll
            for (int i = 0; i < 4; ++i) { const int p = F.tid + NTHR * i, ch = p >> 4, tg = p & 15;
                const float w0 = cwl[ch0 + ch], w1 = cwl[XBCW + ch0 + ch], w2 = cwl[2 * XBCW + ch0 + ch], bb = cwl[3 * XBCW + ch0 + ch];
                float xin[10];
#pragma unroll
                for (int j = 0; j < 10; ++j) { const int row = 8 * tg + j; xin[j] = bf1(*(const LAS bf16*)(tl + row * 272 + ((ch * 2) ^ (((row >> 3) & 7) << 4)))); }
                float y[8];
#pragma unroll
                for (int j = 0; j < 8; ++j) { const float a = w0 * xin[j] + w1 * xin[j + 1] + w2 * xin[j + 2] + bb; y[j] = a * sigmoid_f(a); }
                v4u o; o.x = pk2(y[0], y[1]); o.y = pk2(y[2], y[3]); o.z = pk2(y[4], y[5]); o.w = pk2(y[6], y[7]);
                if (cb < 16) { const int cg_ = ch0 + ch, hd = cg_ >> 6, p_ = cg_ & 63, ptq = 2 * (p_ >> 5) + ((p_ >> 2) & 1), rq = 4 * ((p_ >> 3) & 3) + (p_ & 3);
                    *(GAS v4u*)(XT + ((size_t)(((hd * NCH + c) * 4 + (tg >> 2)) * 4 + ptq) * 16 + rq) * 32 + 8 * (tg & 3)) = o; }
                else *(GAS v4u*)(dst + (size_t)ch * MT + t0 + 8 * tg) = o; }
        }
        if (cb >= 16) {
            bf16* dst = cb < 20 ? BMm + (ch0 - 2048) : CMm + (ch0 - 2560);
#pragma unroll
            for (int i = 0; i < 4; ++i) { const int p = F.tid + NTHR * i, row = p >> 4, cg = p & 15;
                const v4u a0 = *(const LAS v4u*)(tl + row * 272 + ((cg * 16) ^ (((row >> 3) & 7) << 4))), a1 = *(const LAS v4u*)(tl + (row + 1) * 272 + ((cg * 16) ^ ((((row + 1) >> 3) & 7) << 4))), a2 = *(const LAS v4u*)(tl + (row + 2) * 272 + ((cg * 16) ^ ((((row + 2) >> 3) & 7) << 4)));
                const LAS float* w0 = cwl + ch0 + 8 * cg; const LAS float* w1 = w0 + XBCW; const LAS float* w2 = w1 + XBCW; const LAS float* bb = w2 + XBCW;
                float y[8];
#define CV(j, f, q) { const float a = w0[j] * f(a0.q) + w1[j] * f(a1.q) + w2[j] * f(a2.q) + bb[j]; y[j] = a * sigmoid_f(a); }
                CV(0, bflo, x) CV(1, bfhi, x) CV(2, bflo, y) CV(3, bfhi, y) CV(4, bflo, z) CV(5, bfhi, z) CV(6, bflo, w) CV(7, bfhi, w)
#undef CV
                v4u o; o.x = pk2(y[0], y[1]); o.y = pk2(y[2], y[3]); o.z = pk2(y[4], y[5]); o.w = pk2(y[6], y[7]);
                *(GAS v4u*)(dst + (size_t)(t0 + row) * 512 + 8 * cg) = o; }
        }
        __syncthreads();
    }
#undef CONV_LOAD
    { const int full = ntiles / F.G, nbusy = ntiles - full * F.G; __syncthreads();
      if (F.vcu >= nbusy) moe_dn_convert(F, 0, 1900, (F.vcu - nbusy) * NWAVES + F.wave, (F.G - nbusy) * NWAVES); }
}

__device__ __forceinline__ void ph_moe_route(Frame& F) {
    LAS float* R = (LAS float*)F.lds;
    for (int i = F.tid; i < 8192; i += NTHR) R[(i & 7) * 1024 + (i >> 3)] = F.in[I_ROUTER][i];
    __syncthreads();
    const bf16* X = (const bf16*)(F.ws + WS_X); float* RS = (float*)(F.ws + WS_RSTD);
    int* TE = (int*)(F.ws + WS_TOKE); float* TW = (float*)(F.ws + WS_TOKW); int* HIST = (int*)(F.ws + WS_CTL) + CW_HIST;
    const float* gain = F.in[I_N2G] + D; const float* m = modp(F, 1, 0);
    const int gw = F.vcu * NWAVES + F.wave, NGW = F.G * NWAVES;
    f32x4 ca[4], cb[4];
#pragma unroll
    for (int j = 0; j < 4; ++j) { const int c = 4 * (64 * j + F.lane); ca[j] = *(const f32x4*)(gain + c) * (*(const f32x4*)(m + M_SC2 + c) + 1.0f); cb[j] = *(const f32x4*)(m + M_SH2 + c); }
    for (int r = gw; r < L; r += NGW) {
        f32x4 v[4]; float s2 = 0.f;
        load_row4<true>(X + (size_t)r * D, F.lane, v);
#pragma unroll
        for (int j = 0; j < 4; ++j) s2 += (v[j].x * v[j].x + v[j].y * v[j].y) + (v[j].z * v[j].z + v[j].w * v[j].w);
        const float rstd = 1.0f / sqrtf(wave_sum(s2) * (1.0f / D) + EPS);
        float lg[8];
#pragma unroll
        for (int e = 0; e < 8; ++e) lg[e] = 0.f;
#pragma unroll
        for (int j = 0; j < 4; ++j) { const int c = 4 * (64 * j + F.lane);
            const f32x4 y = v[j] * rstd * ca[j] + cb[j];
#pragma unroll
            for (int e = 0; e < 8; ++e) { const f32x4 rr = *(const LAS f32x4*)(R + e * 1024 + c); lg[e] += (y.x * rr.x + y.y * rr.y) + (y.z * rr.z + y.w * rr.w); } }
#pragma unroll
        for (int e = 0; e < 8; ++e) lg[e] = wave_sum(lg[e]);
        int e0 = 0; float v0 = lg[0];
#pragma unroll
        for (int e = 1; e < 8; ++e) if (lg[e] > v0) { v0 = lg[e]; e0 = e; }
        int e1 = -1; float v1 = -3.0e38f;
#pragma unroll
        for (int e = 0; e < 8; ++e) if (e != e0 && lg[e] > v1) { v1 = lg[e]; e1 = e; }
        if (F.lane == 0) { const float ex = __expf(v1 - v0), w0 = 1.0f / (1.0f + ex); RS[r] = rstd;
            TE[2 * r] = e0; TE[2 * r + 1] = e1; TW[2 * r] = w0; TW[2 * r + 1] = ex * w0;
            atomicAdd(&HIST[(r >> 8) * 8 + e0], 1); atomicAdd(&HIST[(r >> 8) * 8 + e1], 1); }
    }
}
__device__ __forceinline__ void moe_segments(Frame& F, LAS int* hist, LAS int* cnt, LAS int* seg) {
    const int* HIST = (const int*)(F.ws + WS_CTL) + CW_HIST;
    if (F.tid < 512) hist[F.tid] = HIST[F.tid];
    __syncthreads();
    if (F.tid < 8) { int s = 0; for (int t = 0; t < 64; ++t) s += hist[t * 8 + F.tid]; cnt[F.tid] = s; }
    __syncthreads();
    if (F.tid == 0) { int s = 0; for (int e = 0; e < 8; ++e) { seg[e] = s; s += (cnt[e] + 255) & ~255; } seg[8] = s; }
    __syncthreads();
}
__device__ __forceinline__ void ph_moe_scatter(Frame& F) {
    LAS int* hist = (LAS int*)F.lds; LAS int* cnt = hist + 512; LAS int* seg = cnt + 8; LAS int* base = seg + 16; LAS int* wcnt = base + 8; LAS int* epos = wcnt + 64;
    moe_segments(F, hist, cnt, seg);
    const int* TE = (const int*)(F.ws + WS_TOKE); int* TP = (int*)(F.ws + WS_TOKP);
    const bf16* X = (const bf16*)(F.ws + WS_X); const float* RS = (const float*)(F.ws + WS_RSTD); bf16* H2S = (bf16*)(F.ws + WS_H2S);
    f32x4 ca[4], cb[4];
    { const float* gain = F.in[I_N2G] + D; const float* m = modp(F, 1, 0);
#pragma unroll
      for (int j = 0; j < 4; ++j) { const int c = 4 * (64 * j + F.lane); ca[j] = *(const f32x4*)(gain + c) * (*(const f32x4*)(m + M_SC2 + c) + 1.0f); cb[j] = *(const f32x4*)(m + M_SH2 + c); } }
    for (int uu = F.vcu; uu < 264; uu += F.G) {
        if (uu < 256) {
            const int u = uu >> 2, qtr = uu & 3;
            if (F.tid < 8) { int s = seg[F.tid]; for (int t = 0; t < u; ++t) s += hist[t * 8 + F.tid]; base[F.tid] = s; }
            const int ent = u * 512 + F.tid;
            const int ex = TE[ent];
            int rank = 0;
#pragma unroll
            for (int e = 0; e < 8; ++e) { const unsigned long long mk = __ballot(ex == e);
                if (ex == e) rank = __popcll(mk & ((1ull << F.lane) - 1ull));
                if (F.lane == 0) wcnt[F.wave * 8 + e] = __popcll(mk); }
            __syncthreads();
            int pos = base[ex] + rank;
            for (int w = 0; w < F.wave; ++w) pos += wcnt[w * 8 + ex];
            if (qtr == 0) TP[ent] = pos;
            epos[F.tid] = pos;
            __syncthreads();
            for (int t0_ = 64 * qtr + F.wave; t0_ < 64 * qtr + 64; t0_ += 2 * NWAVES) {
                f32x4 xv[2][4]; float rs[2]; int d0[2], d1[2];
#pragma unroll
                for (int k = 0; k < 2; ++k) { const int ti = t0_ + k * NWAVES, tok = u * 256 + ti; load_row4<true>(X + (size_t)tok * D, F.lane, xv[k]); rs[k] = RS[tok]; d0[k] = epos[2 * ti]; d1[k] = epos[2 * ti + 1]; }
#pragma unroll
                for (int k = 0; k < 2; ++k) { GAS v2u* o0 = (GAS v2u*)(H2S + (size_t)d0[k] * D) + F.lane; GAS v2u* o1 = (GAS v2u*)(H2S + (size_t)d1[k] * D) + F.lane;
#pragma unroll
                    for (int j = 0; j < 4; ++j) { const f32x4 y = xv[k][j] * rs[k] * ca[j] + cb[j]; v2u o; o.x = pk2(y.x, y.y); o.y = pk2(y.z, y.w); o0[64 * j] = o; o1[64 * j] = o; } } }
            __syncthreads();
        } else {
            const int e = uu - 256, lo = seg[e] + cnt[e], hi = seg[e + 1];
            GAS v4u* d = (GAS v4u*)(H2S + (size_t)lo * D); const int n16 = (hi - lo) * (D * 2 / 16);
            for (int i = F.tid; i < n16; i += NTHR) d[i] = (v4u){0u, 0u, 0u, 0u};
        }
    }
}
__device__ __forceinline__ void ph_final(Frame& F) {
    const bf16* X = (const bf16*)(F.ws + WS_X); const bf16* YO = (const bf16*)(F.ws + WS_H2S);
    const int* TP = (const int*)(F.ws + WS_TOKP); const float* TW = (const float*)(F.ws + WS_TOKW);
    const float* g2 = modp(F, 1, 0) + M_G2; const float* fg = F.in[I_FINALG];
    const float* YP = (const float*)(F.ws + WS_YPART);
    const int gw = F.vcu * NWAVES + F.wave, NGW = F.G * NWAVES;
    f32x4 cg[4], cf[4];
#pragma unroll
    for (int j = 0; j < 4; ++j) { const int c = 4 * (64 * j + F.lane); cg[j] = *(const f32x4*)(g2 + c); cf[j] = *(const f32x4*)(fg + c); }
    for (int r0 = gw; r0 < L; r0 += 2 * NGW) {
        int rr[2], pa[2], pb[2]; float wa[2], wb[2]; f32x4 xv[2][4]; v2u ya[2][4], yb[2][4];
#pragma unroll
        for (int k = 0; k < 2; ++k) { const int r = r0 + k * NGW; rr[k] = r < L ? r : r0; pa[k] = TP[2 * rr[k]]; pb[k] = TP[2 * rr[k] + 1]; wa[k] = TW[2 * rr[k]]; wb[k] = TW[2 * rr[k] + 1]; }
#pragma unroll
        for (int k = 0; k < 2; ++k) { load_row4<true>(X + (size_t)rr[k] * D, F.lane, xv[k]);
            const GAS v2u* y0 = (const GAS v2u*)(YO + (size_t)pa[k] * D) + F.lane; const GAS v2u* y1 = (const GAS v2u*)(YO + (size_t)pb[k] * D) + F.lane;
#pragma unroll
            for (int j = 0; j < 4; ++j) { ya[k][j] = __builtin_nontemporal_load(y0 + 64 * j); yb[k][j] = __builtin_nontemporal_load(y1 + 64 * j); } }
#pragma unroll
        for (int k = 0; k < 2; ++k) { const int r = rr[k], p0 = pa[k], p1 = pb[k]; const float w0 = wa[k], w1 = wb[k];
            f32x4 v[4]; float s2 = 0.f;
#pragma unroll
            for (int j = 0; j < 4; ++j) { const int c = 4 * (64 * j + F.lane); const v2u a = ya[k][j], b = yb[k][j]; const f32x4 g = cg[j];
                f32x4 fa = (f32x4){bflo(a.x), bfhi(a.x), bflo(a.y), bfhi(a.y)}, fb = (f32x4){bflo(b.x), bfhi(b.x), bflo(b.y), bfhi(b.y)};
                if (p0 >= 32768) { fa = (f32x4){0.f, 0.f, 0.f, 0.f}; for (int q = 0; q < 7; ++q) fa += *(const f32x4*)(YP + ((size_t)q * 2048 + (p0 - 32768)) * D + c); }
                if (p1 >= 32768) { fb = (f32x4){0.f, 0.f, 0.f, 0.f}; for (int q = 0; q < 7; ++q) fb += *(const f32x4*)(YP + ((size_t)q * 2048 + (p1 - 32768)) * D + c); }
                const f32x4 f = fa * w0 + fb * w1;
                v[j] = xv[k][j] + g * f; s2 += (v[j].x * v[j].x + v[j].y * v[j].y) + (v[j].z * v[j].z + v[j].w * v[j].w); }
            const float rstd = 1.0f / sqrtf(wave_sum(s2) * (1.0f / D) + EPS);
            GAS f32x4* o = (GAS f32x4*)(F.out + (size_t)r * D) + F.lane;
#pragma unroll
            for (int j = 0; j < 4; ++j) __builtin_nontemporal_store(v[j] * rstd * cf[j], &o[64 * j]);
        }
    }
}


typedef short bf16x8v __attribute__((ext_vector_type(8)));
__device__ __forceinline__ bf16x8v as_frag(v4u a) { return __builtin_bit_cast(bf16x8v, a); }
constexpr float LOG2E_ = 1.4426950408889634f;
#define MFMA16(a, b, c) __builtin_amdgcn_mfma_f32_16x16x32_bf16((a), (b), (c), 0, 0, 0)
__device__ __forceinline__ int prm_row(int i2, int par, int r) { return 32 * i2 + 8 * (r >> 2) + 4 * par + (r & 3); }

__device__ __forceinline__ void ph_ssd_s1(Frame& F) {
    const bf16* XT = (const bf16*)(F.ws + WS_XT); const bf16* BT = (const bf16*)(F.ws + WS_BT);
    const float* DTF = (const float*)(F.ws + WS_DTS); const float* DTB = DTF + (size_t)32 * MT; float* CUMF = (float*)(DTB + (size_t)32 * MT); float* CUMB = CUMF + (size_t)32 * MT;
    float* DEC = (float*)(F.ws + WS_DEC); bf16* ST = (bf16*)(F.ws + WS_STATES);
    LAS unsigned char* btl = F.lds;
    LAS float* wtab = (LAS float*)(F.lds + 128 * 272);
    LAS float* wtot = wtab + 1024;
    const int lane = F.lane, r16 = lane & 15, gq = lane >> 4;
    v4u nbt[4]; float ndtf = 0.f, ndtb = 0.f;
#define S1_PREFETCH(u_) do { const int c_ = (u_) >> 3, g_ = ((u_) >> 1) & 3, hh_ = (u_) & 1, t0_ = c_ * 128; int tq_ = F.tid; asm volatile("" : "+v"(tq_)); \
        _Pragma("unroll") for (int i_ = 0; i_ < 4; ++i_) { const int p_ = tq_ + NTHR * i_, n_ = p_ >> 4, c8_ = (p_ & 15) * 8; nbt[i_] = *(const GAS v4u*)(BT + (size_t)(g_ * 128 + n_) * MT + t0_ + c8_); } \
        { const int h_ = 8 * g_ + 4 * hh_ + (tq_ >> 7); ndtf = DTF[(size_t)h_ * MT + t0_ + (tq_ & 127)]; ndtb = DTB[(size_t)h_ * MT + t0_ + (tq_ & 127)]; } } while (0)
    if (F.vcu < NCH * 8) S1_PREFETCH(F.vcu);
    for (int u = F.vcu; u < NCH * 8; u += F.G) {
        const int c = u >> 3, g = (u >> 1) & 3, hh = u & 1, t0 = c * 128;
        int tid_ = F.tid; asm volatile("" : "+v"(tid_));
        v4u xr[4][4];
        { const int hx = 8 * g + 4 * hh + (F.wave >> 1);
#pragma unroll
          for (int ks = 0; ks < 4; ++ks)
#pragma unroll
            for (int pt = 0; pt < 4; ++pt) xr[ks][pt] = *(const GAS v4u*)(XT + ((size_t)(((hx * NCH + c) * 4 + ks) * 4 + pt) * 16 + r16) * 32 + 8 * gq); }
#pragma unroll
        for (int i = 0; i < 4; ++i) { const int p = tid_ + NTHR * i, n = p >> 4, c8 = (p & 15) * 8; *(LAS v4u*)(btl + n * 272 + c8 * 2) = nbt[i]; }
        {
            const int j = tid_ >> 7, l = tid_ & 127, h = 8 * g + 4 * hh + j;
            const float dtf = ndtf, dtb = ndtb;
            const float Af = -__expf(F.in[I_ALOGF][h]), Ab = -__expf(F.in[I_ALOGB][h]);
            const float af = dtf * Af, ab = dtb * Ab;
            float pf = af, pb = ab;
#pragma unroll
            for (int o = 1; o < 64; o <<= 1) { const float a = __shfl_up(pf, o), b = __shfl_up(pb, o); if (lane >= o) { pf += a; pb += b; } }
            if (lane == 63) { wtot[F.wave * 2] = pf; wtot[F.wave * 2 + 1] = pb; }
            __syncthreads();
            const float tf0 = wtot[(2 * j) * 2], tb0 = wtot[(2 * j) * 2 + 1], Tf = tf0 + wtot[(2 * j + 1) * 2], Tb = tb0 + wtot[(2 * j + 1) * 2 + 1];
            if (F.wave & 1) { pf += tf0; pb += tb0; }
            const float cf = pf, cb = Tb - pb + ab;
            CUMF[(size_t)h * MT + t0 + l] = cf; CUMB[(size_t)h * MT + t0 + l] = cb;
            wtab[(j * 2 + 0) * 128 + l] = __expf(Tf - cf) * dtf; wtab[(j * 2 + 1) * 128 + l] = __expf(Tb - cb) * dtb;
            if (l == 0) { DEC[(0 * NCH + c) * 32 + h] = __expf(Tf); DEC[(1 * NCH + c) * 32 + h] = __expf(Tb); }
        }
        __syncthreads();
        {
            const int j = F.wave >> 1, dir = F.wave & 1, h = 8 * g + 4 * hh + j;
            f32x4 acc[8][4];
#pragma unroll
            for (int a = 0; a < 8; ++a)
#pragma unroll
                for (int b = 0; b < 4; ++b) acc[a][b] = (f32x4){0.f, 0.f, 0.f, 0.f};
            const LAS float* wt = wtab + (j * 2 + dir) * 128;
            if (u + F.G < NCH * 8) S1_PREFETCH(u + F.G);
#pragma unroll
            for (int ks = 0; ks < 4; ++ks) {
                const f32x4 w0 = *(const LAS f32x4*)(wt + 32 * ks + 8 * gq), w1 = *(const LAS f32x4*)(wt + 32 * ks + 8 * gq + 4);
                bf16x8v bfr[4];
#pragma unroll
                for (int pt = 0; pt < 4; ++pt) { const v4u x = xr[ks][pt];
                    v4u y; y.x = pk2(bflo(x.x) * w0.x, bfhi(x.x) * w0.y); y.y = pk2(bflo(x.y) * w0.z, bfhi(x.y) * w0.w); y.z = pk2(bflo(x.z) * w1.x, bfhi(x.z) * w1.y); y.w = pk2(bflo(x.w) * w1.z, bfhi(x.w) * w1.w);
                    bfr[pt] = as_frag(y); }
#pragma unroll
                for (int nt = 0; nt < 8; ++nt) { const bf16x8v af = as_frag(*(const LAS v4u*)(btl + prm_row(nt >> 1, nt & 1, r16) * 272 + (32 * ks + 8 * gq) * 2));
#pragma unroll
                    for (int pt = 0; pt < 4; ++pt) acc[nt][pt] = MFMA16(af, bfr[pt], acc[nt][pt]); }
            }
            bf16* so = ST + ((size_t)((dir * NCH + c) * 32 + h) * 64) * 128;
#pragma unroll
            for (int pt = 0; pt < 4; ++pt)
#pragma unroll
                for (int i2 = 0; i2 < 4; ++i2) { const f32x4 a = acc[2 * i2][pt], b = acc[2 * i2 + 1][pt];
                    v4u o; o.x = pk2(a[0], a[1]); o.y = pk2(a[2], a[3]); o.z = pk2(b[0], b[1]); o.w = pk2(b[2], b[3]);
                    *(GAS v4u*)(so + (size_t)(((pt * 4 + i2) * 16 + r16) * 32) + 8 * gq) = o; }
        }
        __syncthreads();
    }
    { const int nun = NCH * 8, full = nun / F.G, nbusy = nun - full * F.G; __syncthreads();
      if (F.vcu >= nbusy) moe_dn_convert(F, 1900, 5700, (F.vcu - nbusy) * NWAVES + F.wave, (F.G - nbusy) * NWAVES); }
}
#undef S1_PREFETCH

__device__ __forceinline__ void ph_ssd_s2(Frame& F) {
    const float* DEC = (const float*)(F.ws + WS_DEC); bf16* ST = (bf16*)(F.ws + WS_STATES);
    for (int e = F.vcu * NTHR + F.tid; e < 2 * 32 * 64 * 32; e += F.G * NTHR) {
        const int dir = e >> 16, h = (e >> 11) & 31, rem = e & 2047;
        const size_t eoff = (size_t)h * 8192 + (size_t)rem * 4; const size_t cstride = (size_t)32 * 8192;
        bf16* base = ST + (size_t)dir * NCH * cstride + eoff;
        const float* dec = DEC + (size_t)dir * NCH * 32 + h;
        float H0 = 0.f, H1 = 0.f, H2 = 0.f, H3 = 0.f;
        for (int b = 0; b < NCH; b += 10) {
            v2u s[10]; float d[10]; int ck[10];
#pragma unroll
            for (int i = 0; i < 10; ++i) { const int idx = b + i; ck[i] = dir == 0 ? (idx < 2 ? 128 + idx : idx - 2) : (idx < 2 ? 129 - idx : 129 - idx);
                s[i] = __builtin_nontemporal_load((const GAS v2u*)(base + (size_t)ck[i] * cstride)); d[i] = dec[ck[i] * 32]; }
#pragma unroll
            for (int i = 0; i < 10; ++i) { v2u o; o.x = pk2(H0, H1); o.y = pk2(H2, H3); *(GAS v2u*)(base + (size_t)ck[i] * cstride) = o;
                H0 = d[i] * H0 + bflo(s[i].x); H1 = d[i] * H1 + bfhi(s[i].x); H2 = d[i] * H2 + bflo(s[i].y); H3 = d[i] * H3 + bfhi(s[i].y); }
        }
    }
}

__device__ __forceinline__ void ph_ssd_s3(Frame& F) {
    const bf16* XT = (const bf16*)(F.ws + WS_XT); const bf16* BMm = (const bf16*)(F.ws + WS_BM); const bf16* CMm = (const bf16*)(F.ws + WS_CM);
    const float* DTF = (const float*)(F.ws + WS_DTS); const float* DTB = DTF + (size_t)32 * MT; const float* CUMF = DTB + (size_t)32 * MT; const float* CUMB = CUMF + (size_t)32 * MT;
    const bf16* ST = (const bf16*)(F.ws + WS_STATES); bf16* Z = (bf16*)(F.ws + WS_Z); const float* ng = F.in[I_SSDNG];
    LAS unsigned char* bml = F.lds;
    LAS unsigned char* cml = F.lds + 128 * 272;
    LAS float* tab = (LAS float*)(F.lds + 192 * 272);
    LAS float* ssq = tab + 8 * 5 * 128;
    const int lane = F.lane, r16 = lane & 15, gq = lane >> 4;
    v4u nbm[4], ncm[2]; float ncf[2], ncb[2], ndf[2], ndb[2];
#define S3_PREFETCH(u_) do { const int c_ = (u_) >> 3, g_ = ((u_) >> 1) & 3, lh_ = (u_) & 1, t0_ = c_ * 128; int tq_ = F.tid; asm volatile("" : "+v"(tq_)); \
        _Pragma("unroll") for (int i_ = 0; i_ < 4; ++i_) { const int p_ = tq_ + NTHR * i_, row_ = p_ >> 4, c8_ = (p_ & 15) * 8; nbm[i_] = *(const GAS v4u*)(BMm + (size_t)(t0_ + row_) * 512 + g_ * 128 + c8_); } \
        _Pragma("unroll") for (int i_ = 0; i_ < 2; ++i_) { const int p_ = tq_ + NTHR * i_, row_ = p_ >> 4, c8_ = (p_ & 15) * 8; ncm[i_] = *(const GAS v4u*)(CMm + (size_t)(t0_ + 64 * lh_ + row_) * 512 + g_ * 128 + c8_); \
            const size_t o_ = (size_t)(8 * g_ + (p_ >> 7)) * MT + t0_ + (p_ & 127); ncf[i_] = CUMF[o_]; ncb[i_] = CUMB[o_]; ndf[i_] = DTF[o_]; ndb[i_] = DTB[o_]; } } while (0)
    if (F.vcu < 128 * 8) S3_PREFETCH(F.vcu);
    for (int u = F.vcu; u < 128 * 8; u += F.G) {
        const int c = u >> 3, g = (u >> 1) & 3, lh = u & 1, t0 = c * 128;
        __syncthreads();
        int tid_ = F.tid; asm volatile("" : "+v"(tid_));
#pragma unroll
        for (int i = 0; i < 4; ++i) { const int p = tid_ + NTHR * i, row = p >> 4, c8 = (p & 15) * 8; *(LAS v4u*)(bml + row * 272 + c8 * 2) = nbm[i]; }
#pragma unroll
        for (int i = 0; i < 2; ++i) { const int p = tid_ + NTHR * i, row = p >> 4, c8 = (p & 15) * 8; *(LAS v4u*)(cml + row * 272 + c8 * 2) = ncm[i]; }
#pragma unroll
        for (int i = 0; i < 2; ++i) { const int p = tid_ + NTHR * i, j = p >> 7, l = p & 127;
            const float cf = ncf[i] * LOG2E_, cb = ncb[i] * LOG2E_, df = ndf[i], db = ndb[i];
            tab[(j * 5 + 0) * 128 + l] = cf; tab[(j * 5 + 1) * 128 + l] = cb; tab[(j * 5 + 2) * 128 + l] = __builtin_amdgcn_logf(df) - cf; tab[(j * 5 + 3) * 128 + l] = __builtin_amdgcn_logf(db) - cb;
            tab[(j * 5 + 4) * 128 + l] = df + db; }
        __syncthreads();
        const int h = 8 * g + F.wave;
        const float Dk = F.in[I_SSDD][h];
        const LAS float* tcf = tab + (F.wave * 5) * 128; const LAS float* tcb = tcf + 128; const LAS float* tdf = tcb + 128; const LAS float* tdb = tdf + 128; const LAS float* tds = tdb + 128;
        f32x4 acc[4][4];
#pragma unroll
        for (int a = 0; a < 4; ++a)
#pragma unroll
            for (int b = 0; b < 4; ++b) acc[a][b] = (f32x4){0.f, 0.f, 0.f, 0.f};
#pragma unroll 1
        for (int i2 = 0; i2 < 4; ++i2) {
            bf16x8v xf[4], bmf[2][4];
#pragma unroll
            for (int pt = 0; pt < 4; ++pt) xf[pt] = as_frag(*(const GAS v4u*)(XT + ((size_t)(((h * NCH + c) * 4 + i2) * 4 + pt) * 16 + r16) * 32 + 8 * gq));
#pragma unroll
            for (int par = 0; par < 2; ++par)
#pragma unroll
                for (int nk = 0; nk < 4; ++nk) bmf[par][nk] = as_frag(*(const LAS v4u*)(bml + prm_row(i2, par, r16) * 272 + (32 * nk + 8 * gq) * 2));
            const int sb = 32 * i2 + 8 * gq;
            const f32x4 dfs0 = *(const LAS f32x4*)(tdf + sb), dfs1 = *(const LAS f32x4*)(tdf + sb + 4), dbs0 = *(const LAS f32x4*)(tdb + sb), dbs1 = *(const LAS f32x4*)(tdb + sb + 4);
#pragma unroll
            for (int lt = 0; lt < 4; ++lt) {
                const int ll = 16 * lt + r16, l = 64 * lh + ll;
                const float cfl = tcf[l], cbl = tcb[l], dsl = tds[l];
                f32x4 g0 = (f32x4){0.f, 0.f, 0.f, 0.f}, g1 = g0;
#pragma unroll
                for (int nk = 0; nk < 4; ++nk) { const bf16x8v cf = as_frag(*(const LAS v4u*)(cml + ll * 272 + (32 * nk + 8 * gq) * 2));
                    g0 = MFMA16(bmf[0][nk], cf, g0); g1 = MFMA16(bmf[1][nk], cf, g1); }
                float m[8];
                const int ltile0 = 64 * lh + 16 * lt; const int blk = (32 * i2 + 31 < ltile0) ? 0 : ((32 * i2 > ltile0 + 15) ? 2 : 1);
                if (blk == 0) {
#pragma unroll
                    for (int e = 0; e < 8; ++e) { const float dfs = e < 4 ? dfs0[e & 3] : dfs1[e & 3], gv = e < 4 ? g0[e & 3] : g1[e & 3]; m[e] = gv * __builtin_amdgcn_exp2f(cfl + dfs); }
                } else if (blk == 2) {
#pragma unroll
                    for (int e = 0; e < 8; ++e) { const float dbs = e < 4 ? dbs0[e & 3] : dbs1[e & 3], gv = e < 4 ? g0[e & 3] : g1[e & 3]; m[e] = gv * __builtin_amdgcn_exp2f(cbl + dbs); }
                } else {
#pragma unroll
                    for (int e = 0; e < 8; ++e) { const int s = sb + e;
                        const float dfs = e < 4 ? dfs0[e & 3] : dfs1[e & 3], dbs = e < 4 ? dbs0[e & 3] : dbs1[e & 3], gv = e < 4 ? g0[e & 3] : g1[e & 3];
                        float w = __builtin_amdgcn_exp2f(s < l ? cfl + dfs : cbl + dbs); const bool dg = s == l;
                        w = dg ? dsl : w; m[e] = gv * w + (dg ? Dk : 0.f); }
                }
                asm volatile("" : "+v"(m[0]), "+v"(m[1]), "+v"(m[2]), "+v"(m[3]), "+v"(m[4]), "+v"(m[5]), "+v"(m[6]), "+v"(m[7]));
                v4u mp; mp.x = pk2(m[0], m[1]); mp.y = pk2(m[2], m[3]); mp.z = pk2(m[4], m[5]); mp.w = pk2(m[6], m[7]);
                const bf16x8v mf = as_frag(mp);
#pragma unroll
                for (int pt = 0; pt < 4; ++pt) acc[lt][pt] = MFMA16(xf[pt], mf, acc[lt][pt]);
            }
        }
        if (u + F.G < 128 * 8) S3_PREFETCH(u + F.G);
#pragma unroll 1
        for (int dir = 0; dir < 2; ++dir) {
            const bf16* hs = ST + ((size_t)((dir * NCH + c) * 32 + h) * 64) * 128;
            float el[4];
#pragma unroll
            for (int lt = 0; lt < 4; ++lt) { const int l = 64 * lh + 16 * lt + r16; el[lt] = __builtin_amdgcn_exp2f(dir == 0 ? tcf[l] : tcb[l]); }
            f32x4 tacc[4][4];
#pragma unroll
            for (int a = 0; a < 4; ++a)
#pragma unroll
                for (int b = 0; b < 4; ++b) tacc[a][b] = (f32x4){0.f, 0.f, 0.f, 0.f};
#pragma unroll 1
            for (int nk = 0; nk < 4; ++nk) {
                bf16x8v hf[4];
#pragma unroll
                for (int pt = 0; pt < 4; ++pt) hf[pt] = as_frag(*(const GAS v4u*)(hs + (size_t)(((pt * 4 + nk) * 16 + r16) * 32) + 8 * gq));
#pragma unroll
                for (int lt = 0; lt < 4; ++lt) { const int ll = 16 * lt + r16;
                    const bf16x8v cf = as_frag(*(const LAS v4u*)(cml + ll * 272 + (32 * nk + 8 * gq) * 2));
#pragma unroll
                    for (int pt = 0; pt < 4; ++pt) tacc[lt][pt] = MFMA16(hf[pt], cf, tacc[lt][pt]); }
            }
#pragma unroll
            for (int lt = 0; lt < 4; ++lt)
#pragma unroll
                for (int pt = 0; pt < 4; ++pt) acc[lt][pt] += tacc[lt][pt] * el[lt];
        }
#pragma unroll
        for (int lt = 0; lt < 4; ++lt) { const int l = 64 * lh + 16 * lt + r16; float ss = 0.f;
#pragma unroll
            for (int q = 0; q < 2; ++q) { const v4u zv = *(const GAS v4u*)(Z + (size_t)(t0 + l) * DIN + h * 64 + 32 * q + 8 * gq);
                const float zz[8] = {bflo(zv.x), bfhi(zv.x), bflo(zv.y), bfhi(zv.y), bflo(zv.z), bfhi(zv.z), bflo(zv.w), bfhi(zv.w)};
#pragma unroll
                for (int e = 0; e < 4; ++e) { float v0 = acc[lt][2 * q][e] * zz[e] * sigmoid_f(zz[e]), v1 = acc[lt][2 * q + 1][e] * zz[4 + e] * sigmoid_f(zz[4 + e]);
                    acc[lt][2 * q][e] = v0; acc[lt][2 * q + 1][e] = v1; ss += v0 * v0 + v1 * v1; } }
            ss += __shfl_xor(ss, 16); ss += __shfl_xor(ss, 32);
            if (gq == 0) ssq[(16 * lt + r16) * 8 + F.wave] = ss; }
        __syncthreads();
#pragma unroll
        for (int lt = 0; lt < 4; ++lt) { const int ll = 16 * lt + r16, l = 64 * lh + ll;
            const f32x4 s0 = *(const LAS f32x4*)(ssq + ll * 8), s1 = *(const LAS f32x4*)(ssq + ll * 8 + 4);
            const float rs = 1.0f / sqrtf(((s0.x + s0.y) + (s0.z + s0.w) + (s1.x + s1.y) + (s1.z + s1.w)) * (1.0f / 512.0f) + EPS);
#pragma unroll
            for (int q = 0; q < 2; ++q) { const int ch = h * 64 + 32 * q + 8 * gq; const f32x4 a = acc[lt][2 * q] * rs, b = acc[lt][2 * q + 1] * rs;
                const f32x4 g0 = *(const f32x4*)(ng + ch), g1 = *(const f32x4*)(ng + ch + 4);
                v4u o; o.x = pk2(a[0] * g0.x, a[1] * g0.y); o.y = pk2(a[2] * g0.z, a[3] * g0.w); o.z = pk2(b[0] * g1.x, b[1] * g1.y); o.w = pk2(b[2] * g1.z, b[3] * g1.w);
                *(GAS v4u*)(Z + (size_t)(t0 + l) * DIN + ch) = o; } }
    }
    __syncthreads();
}
#undef S3_PREFETCH

__device__ __forceinline__ float vmax_f(float a, float b) { return __builtin_amdgcn_fmed3f(a, b, __builtin_inff()); }
__device__ __forceinline__ float vmin_f(float a, float b) { return __builtin_amdgcn_fmed3f(a, b, -__builtin_inff()); }
__device__ __forceinline__ float vmax3_f(float a, float b, float c) { return vmax_f(a, vmax_f(b, c)); }
__device__ __forceinline__ int attn_next_blk(int kb, int qb, bool isctx) {
    for (int k = kb + 1; k < 5; ++k) { if (k >= 3) return k; if (!isctx) { const int b = qb - 1 + k; if (b >= 0 && b < 128) return k; } }
    return 5;
}
__device__ __forceinline__ void ph_attn(Frame& F) {
    const bf16* QR = (const bf16*)(F.ws + WS_QR); const bf16* KR = (const bf16*)(F.ws + WS_KR); const bf16* VT = (const bf16*)(F.ws + WS_VT); bf16* MIX = (bf16*)(F.ws + WS_MIX);
    constexpr int KBYTES = 128 * 144, BUFB = KBYTES + 64 * 272;
    const int lane = F.lane, r16 = lane & 15, gq = lane >> 4;
    constexpr float LOG2E = 1.4426950408889634f;
    const int p0 = F.tid, p1 = F.tid + NTHR;
    const int kro0 = (p0 >> 3) * 144 + (p0 & 7) * 16, kro1 = (p1 >> 3) * 144 + (p1 & 7) * 16;
    const int vro0 = KBYTES + (p0 >> 4) * 272 + (p0 & 15) * 16, vro1 = KBYTES + (p1 >> 4) * 272 + (p1 & 15) * 16;
    for (int u = F.vcu; u < 130 * 8; u += F.G) {
        const int qb = u >> 3, hq = u & 7, kvh = hq >> 2; const bool isctx = qb >= 128;
        const int row0 = qb * 128;
        const int qrow = row0 + 16 * F.wave + r16;
        bf16x8v qf[2];
#pragma unroll
        for (int ks = 0; ks < 2; ++ks) qf[ks] = as_frag(*(const GAS v4u*)(QR + ((size_t)hq * MT + qrow) * 64 + 32 * ks + 8 * gq));
        float m2 = F.in[I_ABSINK][hq] * LOG2E, lsum = 1.0f;
        f32x4 oacc[4];
#pragma unroll
        for (int a = 0; a < 4; ++a) oacc[a] = (f32x4){0.f, 0.f, 0.f, 0.f};
        const int qi = 16 * F.wave + r16;
        const bf16* kbase = KR + (size_t)kvh * MT * 64; const bf16* vbase = VT + (size_t)kvh * 64 * MT;
#define ATT_KEY0(kb) ((kb) < 3 ? (qb - 1 + (kb)) * 128 : L + ((kb) - 3) * 128)
#define ATT_LOAD(kb) do { const int k0_ = ATT_KEY0(kb); \
            kr0 = *(const GAS v4u*)(kbase + (size_t)(k0_ + (p0 >> 3)) * 64 + (p0 & 7) * 8); kr1 = *(const GAS v4u*)(kbase + (size_t)(k0_ + (p1 >> 3)) * 64 + (p1 & 7) * 8); \
            vr0 = *(const GAS v4u*)(vbase + (size_t)(p0 >> 4) * MT + k0_ + (p0 & 15) * 8); vr1 = *(const GAS v4u*)(vbase + (size_t)(p1 >> 4) * MT + k0_ + (p1 & 15) * 8); } while (0)
#define ATT_WRITE(buf) do { LAS unsigned char* b_ = F.lds + (buf) * BUFB; *(LAS v4u*)(b_ + kro0) = kr0; *(LAS v4u*)(b_ + kro1) = kr1; *(LAS v4u*)(b_ + vro0) = vr0; *(LAS v4u*)(b_ + vro1) = vr1; } while (0)
        v4u kr0, kr1, vr0, vr1;
        int kb = attn_next_blk(-1, qb, isctx), cur = 0;
        __syncthreads();
        ATT_LOAD(kb); ATT_WRITE(0);
        __syncthreads();
        while (kb < 5) {
            const int nkb = attn_next_blk(kb, qb, isctx);
            if (nkb < 5) ATT_LOAD(nkb);
            const LAS unsigned char* kl = F.lds + cur * BUFB; const LAS unsigned char* vl = kl + KBYTES;
            const int mode = (kb == 0) ? 1 : ((kb == 2) ? 2 : 0);
            f32x4 sacc[8];
#pragma unroll
            for (int kt = 0; kt < 8; ++kt) { sacc[kt] = (f32x4){0.f, 0.f, 0.f, 0.f};
#pragma unroll
                for (int ks = 0; ks < 2; ++ks) { const bf16x8v kf = as_frag(*(const LAS v4u*)(kl + prm_row(kt >> 1, kt & 1, r16) * 144 + (32 * ks + 8 * gq) * 2));
                    sacc[kt] = MFMA16(kf, qf[ks], sacc[kt]); } }
            float bm = -1.0e30f;
#pragma unroll 1
            for (int rep_ = 0; rep_ < (mode != 0 ? 1 : 0); ++rep_) {
                const float msgn = mode == 1 ? 1.0e30f : -1.0e30f, limf = (float)(qi - 8 * gq);
#pragma unroll
                for (int kt = 0; kt < 8; ++kt)
#pragma unroll
                    for (int e = 0; e < 4; ++e) { const float jc = (float)(32 * (kt >> 1) + 4 * (kt & 1) + e);
                        sacc[kt][e] += vmin_f(0.f, msgn * (jc - limf)); }
            }
#pragma unroll
            for (int kt = 0; kt < 8; ++kt) bm = vmax3_f(bm, vmax_f(sacc[kt][0], sacc[kt][1]), vmax_f(sacc[kt][2], sacc[kt][3]));
            bm = vmax_f(bm, __shfl_xor(bm, 16)); bm = vmax_f(bm, __shfl_xor(bm, 32));
            const float mn = vmax_f(m2, bm), alpha = __builtin_amdgcn_exp2f(m2 - mn); m2 = mn;
            float ps = 0.f;
            bf16x8v pf[4];
#pragma unroll
            for (int i2 = 0; i2 < 4; ++i2) { float p[8];
#pragma unroll
                for (int e = 0; e < 4; ++e) { p[e] = __builtin_amdgcn_exp2f(sacc[2 * i2][e] - mn); p[4 + e] = __builtin_amdgcn_exp2f(sacc[2 * i2 + 1][e] - mn); }
#pragma unroll
                for (int e = 0; e < 8; ++e) ps += p[e];
                v4u pk; pk.x = pk2(p[0], p[1]); pk.y = pk2(p[2], p[3]); pk.z = pk2(p[4], p[5]); pk.w = pk2(p[6], p[7]); pf[i2] = as_frag(pk); }
            ps += __shfl_xor(ps, 16); ps += __shfl_xor(ps, 32);
            lsum = lsum * alpha + ps;
#pragma unroll
            for (int dt = 0; dt < 4; ++dt) { oacc[dt] = oacc[dt] * alpha;
#pragma unroll
                for (int i2 = 0; i2 < 4; ++i2) { const bf16x8v vf = as_frag(*(const LAS v4u*)(vl + prm_row(dt >> 1, dt & 1, r16) * 272 + (32 * i2 + 8 * gq) * 2));
                    oacc[dt] = MFMA16(vf, pf[i2], oacc[dt]); } }
            if (nkb < 5) ATT_WRITE(cur ^ 1);
            __syncthreads();
            kb = nkb; cur ^= 1;
        }
#undef ATT_KEY0
#undef ATT_LOAD
#undef ATT_WRITE
        const float il = 1.0f / lsum;
#pragma unroll
        for (int i = 0; i < 2; ++i) { const f32x4 a = oacc[2 * i] * il, b = oacc[2 * i + 1] * il;
            v4u o; o.x = pk2(a[0], a[1]); o.y = pk2(a[2], a[3]); o.z = pk2(b[0], b[1]); o.w = pk2(b[2], b[3]);
            *(GAS v4u*)(MIX + (size_t)qrow * D + 512 + 64 * hq + 32 * i + 8 * gq) = o; }
    }
    __syncthreads();
}

constexpr int NPH = 23;
#ifndef WGM_MOE_GU
#define WGM_MOE_GU 4
#endif
#ifndef WGM_MOE_DN
#define WGM_MOE_DN 4
#endif
struct Args { const float* in[30]; float* out; unsigned char* ws; int ph_lo, ph_hi; };
__global__ void __launch_bounds__(NTHR, 2) mk_fwd(Args args) {
    extern __shared__ __attribute__((aligned(16))) unsigned char lds[];
    Frame F;
    F.lds = (LAS unsigned char*)lds;
    F.tid = threadIdx.x; F.lane = F.tid & 63; F.wave = __builtin_amdgcn_readfirstlane(F.tid >> 6);
    F.G = gridDim.x; { const int bx = blockIdx.x; F.vcu = (F.G % 8 == 0) ? (bx % 8) * (F.G / 8) + bx / 8 : bx; }
#pragma unroll
    for (int i = 0; i < 30; ++i) F.in[i] = args.in[i];
    F.out = args.out; F.ws = args.ws;
    unsigned char* ws = args.ws;
    volatile LAS unsigned* MISC = (volatile LAS unsigned*)(F.lds + MISC_OFF);
    for (int u = F.tid; u < (LDS_BYTES - LDSCTL_OFF) / 4; u += NTHR) ((LAS unsigned*)(F.lds + LDSCTL_OFF))[u] = 0u;
    __syncthreads();
    const int lo = args.ph_lo, hi = args.ph_hi;
    XcdBarrier bar; bar.bar = (unsigned*)(ws + WS_CTL) + CW_BAR; bar.x = 0; bar.st = nullptr;
    if (hi - lo > 1) bar = xcd_barrier_post((unsigned*)(ws + WS_CTL) + CW_BAR, MISC + 8);
#define IN(k) (lo <= (k) && (k) < hi)
#define SEAM(k) do { if (IN(k) && IN((k) + 1)) xcd_barrier(bar); } while (0)
    LAS unsigned char* ring = F.lds;
    bf16* X = (bf16*)(ws + WS_X); bf16* H = (bf16*)(ws + WS_H);

    if (IN(0)) { ph_prologue(F); } SEAM(0);
    if (IN(1)) { ph_modulate<false, false, 0>(F, F.in[I_X], F.in[I_CTX], F.in[I_N1G], modp(F, 0, 0), modp(F, 0, 1), M_SH1, M_SC1, H, MT, nullptr, nullptr, nullptr); } SEAM(1);
    if (IN(2)) { pg8::Gemm g{H, (const bf16*)(ws + WS_WABIN), D, D, 0}; pg8::StaticOrder S; S.init(MT, AB_IN, F.G, (int)blockIdx.x);
        pg8::EpiStoreBf16 E{(bf16*)(ws + WS_PAB), AB_IN};
        pg8::gemm_phase<pg8::EpiStoreBf16, pg8::StaticOrder, true, true>(ring, g, S, E);
        idle_round_convert(F, (MT / 256) * (AB_IN / 256), 0, 11400); } SEAM(2);
    if (IN(3)) { ph_ab_elem(F); } SEAM(3);
    if (IN(4)) { ph_attn(F); } SEAM(4);
    if (IN(5)) { { pg8::Gemm g{(const bf16*)(ws + WS_MIX), (const bf16*)(ws + WS_WABOUT), D, D, 0}; pg8::StaticOrder S; S.init(L, D, F.G, (int)blockIdx.x);
          pg8::EpiRes<true> E{X, F.in[I_X], modp(F, 0, 0) + M_G1};
          pg8::gemm_phase<pg8::EpiRes<true>, pg8::StaticOrder, true, true>(ring, g, S, E); }
        { int nu_ = 16, kl_ = 256; asm volatile("" : "+s"(nu_), "+s"(kl_)); pg8::Gemm g{(const bf16*)(ws + WS_MIX), (const bf16*)(ws + WS_WABOUT), D, kl_, 0}; pg8::SplitOrder S{64, 4, nu_, 256, F.G, (int)blockIdx.x};
          pg8::EpiPart E{(float*)(ws + WS_PART), 64, 256, LC};
          pg8::gemm_phase<pg8::EpiPart, pg8::SplitOrder, true, true>(ring, g, S, E); }
        if ((int)blockIdx.x >= 16) ph_convert_ffn(F, ((int)blockIdx.x - 16) * NWAVES + F.wave, (F.G - 16) * NWAVES); } SEAM(5);
    if (IN(6)) { ph_modulate<true, false, 4>(F, X, F.in[I_CTX], F.in[I_N2G], modp(F, 0, 0), modp(F, 0, 1), M_SH2, M_SC2, H, MT, (const float*)(ws + WS_PART), modp(F, 0, 1) + M_G1, X); } SEAM(6);
    if (IN(7)) { pg8::Gemm g{H, (const bf16*)(ws + WS_WFFNGU), D, D, 0}; pg8::StaticOrder S; S.init(MT, 2 * DFF, F.G, (int)blockIdx.x);
        pg8::EpiSwiGLU E{(bf16*)(ws + WS_ACT0), DFF};
        pg8::gemm_phase<pg8::EpiSwiGLU, pg8::StaticOrder, true, true>(ring, g, S, E);
        idle_round_convert(F, (MT / 256) * (2 * DFF / 256), 11400, 18000); } SEAM(7);
    if (IN(8)) { { pg8::Gemm g{(const bf16*)(ws + WS_ACT0), (const bf16*)(ws + WS_WFFND), DFF, DFF, 0}; pg8::StaticOrder S; S.init(L, D, F.G, (int)blockIdx.x);
          pg8::EpiRes<false> E{X, X, modp(F, 0, 0) + M_G2};
          pg8::gemm_phase<pg8::EpiRes<false>, pg8::StaticOrder, true, true>(ring, g, S, E); }
        { int nu_ = 44, kl_ = 256; asm volatile("" : "+s"(nu_), "+s"(kl_)); pg8::Gemm g{(const bf16*)(ws + WS_ACT0), (const bf16*)(ws + WS_WFFND), DFF, kl_, 0}; pg8::SplitOrder S{64, 4, nu_, 256, F.G, (int)blockIdx.x};
          pg8::EpiPart E{(float*)(ws + WS_PART), 64, 256, LC};
          pg8::gemm_phase<pg8::EpiPart, pg8::SplitOrder, true, true>(ring, g, S, E); }
        if ((int)blockIdx.x >= 44) ph_convert_ssd(F, ((int)blockIdx.x - 44) * NWAVES + F.wave, (F.G - 44) * NWAVES); } SEAM(8);
    if (IN(9)) { ph_modulate<true, true, 11>(F, X, X + (size_t)L * D, F.in[I_N1G] + D, modp(F, 1, 0), modp(F, 1, 1), M_SH1, M_SC1, H, MT, (const float*)(ws + WS_PART), modp(F, 0, 1) + M_G2, nullptr); } SEAM(9);
    if (IN(10)) { pg8::Gemm g{H, (const bf16*)(ws + WS_WSSDIN), D, D, 0}; pg8::StaticOrder S; S.init(MT, SSD_INP, F.G, (int)blockIdx.x);
        pg8::EpiSsdIn E{(bf16*)(ws + WS_Z), (bf16*)(ws + WS_XBCR), (float*)(ws + WS_DTRAW)};
        pg8::gemm_phase<pg8::EpiSsdIn, pg8::StaticOrder, true, true>(ring, g, S, E);
        idle_round_convert(F, (MT / 256) * (SSD_INP / 256), 18000, MOE_GU_ITEMS); } SEAM(10);
    if (IN(11)) { ph_ssd_conv(F); } SEAM(11);
    if (IN(12)) { ph_ssd_s1(F); } SEAM(12);
    if (IN(13)) { ph_ssd_s2(F); } SEAM(13);
    if (IN(14)) { ph_ssd_s3(F); } if (IN(14) && IN(16)) xcd_barrier(bar);
    if (IN(16)) { pg8::Gemm g{(const bf16*)(ws + WS_Z), (const bf16*)(ws + WS_WSSDOUT), DIN, DIN, 0}; pg8::StaticOrder S; S.init(L, D, F.G, (int)blockIdx.x);
        pg8::EpiRes<false> E{X, X, modp(F, 1, 0) + M_G1};
        pg8::gemm_phase<pg8::EpiRes<false>, pg8::StaticOrder, true, true>(ring, g, S, E); } SEAM(16);
    if (IN(17)) { ph_moe_route(F); } SEAM(17);
    if (IN(18)) { ph_moe_scatter(F); __syncthreads();
        { const int gw_ = F.vcu * NWAVES + F.wave, NGW_ = F.G * NWAVES;
          moe_dn_convert(F, 5700, MOE_DN_ITEMS / 2, gw_, NGW_); moe_dn_convert(F, 11308, MOE_DN_ITEMS, gw_, NGW_); } } SEAM(18);
    if (IN(19) || IN(21)) {
        LAS int* hist = (LAS int*)F.lds; LAS int* cnt = hist + 512; LAS int* seg = cnt + 8;
        pg8::GroupedOrder S;
        if (IN(19)) {
            moe_segments(F, hist, cnt, seg);
            S.nM = seg[8] >> 8; S.nN = 2 * FFE / 256; S.nwg = S.nM * S.nN; S.G = F.G; S.c = (int)blockIdx.x; S.WGM = WGM_MOE_GU;
            S.ts1 = seg[1] >> 8; S.ts2 = seg[2] >> 8; S.ts3 = seg[3] >> 8; S.ts4 = seg[4] >> 8; S.ts5 = seg[5] >> 8; S.ts6 = seg[6] >> 8; S.ts7 = seg[7] >> 8;
            __syncthreads();
            pg8::Gemm g{(const bf16*)(ws + WS_H2S), (const bf16*)(ws + WS_WMOE), D, D, (size_t)2 * FFE * D * 2};
            pg8::EpiSwiGLU E{(bf16*)(ws + WS_ACTM), FFE};
            pg8::gemm_phase<pg8::EpiSwiGLU, pg8::GroupedOrder, true, true>(ring, g, S, E);
            { const int full = S.nwg / F.G, nbusy = S.nwg - full * F.G;
              if ((int)blockIdx.x >= nbusy) moe_dn_convert(F, 7168, 11308, ((int)blockIdx.x - nbusy) * NWAVES + F.wave, (F.G - nbusy) * NWAVES); }
        }
        SEAM(19);
        if (IN(21)) {
            __syncthreads();
            moe_segments(F, hist, cnt, seg);
            const int NT = seg[8] >> 8;
            S.nM = NT < 128 ? NT : 128; S.nN = D / 256; S.nwg = S.nM * S.nN; S.G = F.G; S.c = (int)blockIdx.x; S.WGM = WGM_MOE_DN;
            S.ts1 = seg[1] >> 8; S.ts2 = seg[2] >> 8; S.ts3 = seg[3] >> 8; S.ts4 = seg[4] >> 8; S.ts5 = seg[5] >> 8; S.ts6 = seg[6] >> 8; S.ts7 = seg[7] >> 8;
            __syncthreads();
            { pg8::Gemm g{(const bf16*)(ws + WS_ACTM), (const bf16*)(ws + WS_WDA), FFE, FFE, WD_BYTES, (WS_WDB - WS_WDA) - 4 * WD_BYTES};
              pg8::EpiStoreBf16 E{(bf16*)(ws + WS_H2S), D};
              pg8::gemm_phase<pg8::EpiStoreBf16, pg8::GroupedOrder, true, true>(ring, g, S, E); }
            if (NT > 128) {
                pg8::Gemm g{(const bf16*)(ws + WS_ACTM), (const bf16*)(ws + WS_WDA), FFE, 512, WD_BYTES, (WS_WDB - WS_WDA) - 4 * WD_BYTES};
                pg8::SplitGroupedOrder S2{128, NT, D / 256, 7, 512, F.G, (int)blockIdx.x, S.ts1, S.ts2, S.ts3, S.ts4, S.ts5, S.ts6, S.ts7};
                pg8::EpiPart E{(float*)(ws + WS_YPART), 128, 512, 2048};
                pg8::gemm_phase<pg8::EpiPart, pg8::SplitGroupedOrder, true, true>(ring, g, S2, E); }
        }
        SEAM(21);
    } else { SEAM(19); if (IN(20)) { const int gw_ = F.vcu * NWAVES + F.wave, NGW_ = F.G * NWAVES; moe_dn_convert(F, 0, MOE_DN_ITEMS, gw_, NGW_); }
        SEAM(20); SEAM(21); }
    if (IN(22)) { ph_final(F); }
#undef IN
#undef SEAM
}

extern "C" void kernel_launch(void* const* d_in, const int* in_sizes, int n_in, void* d_out, int out_size, void* d_ws, size_t ws_size, hipStream_t stream) {
    static int grid = 0;
    if (grid == 0) {
        if (n_in != 30 || in_sizes[0] != L * D || out_size != L * D || ws_size < WS_END) { fprintf(stderr, "kernel_launch: unexpected shapes (n_in %d, in0 %d, out %d, ws %zu < %zu); nothing launched\n", n_in, n_in > 0 ? in_sizes[0] : -1, out_size, ws_size, (size_t)WS_END); grid = -1; return; }
        int dev = 0, cus = 0, per_cu = 0;
        if (hipGetDevice(&dev) != hipSuccess || hipDeviceGetAttribute(&cus, hipDeviceAttributeMultiprocessorCount, dev) != hipSuccess) { grid = -1; return; }
        if (hipFuncSetAttribute((const void*)mk_fwd, hipFuncAttributeMaxDynamicSharedMemorySize, LDS_BYTES) != hipSuccess) { fprintf(stderr, "kernel_launch: hipFuncSetAttribute failed\n"); grid = -1; return; }
        if (hipOccupancyMaxActiveBlocksPerMultiprocessor(&per_cu, (const void*)mk_fwd, NTHR, LDS_BYTES) != hipSuccess || per_cu < 1)
            fprintf(stderr, "kernel_launch: note: occupancy query reports %d workgroups per CU\n", per_cu);
        (void)hipGetLastError();
        grid = cus;
    }
    if (grid < 0) return;
    if (hipMemsetAsync((char*)d_ws + WS_CTL, 0, CTL_ZERO_BYTES, stream) != hipSuccess) return;
    Args a{};
    for (int i = 0; i < 30; ++i) a.in[i] = (const float*)d_in[i];
    a.out = (float*)d_out; a.ws = (unsigned char*)d_ws;
    if (MK_N_LAUNCHES == 1) { a.ph_lo = 0; a.ph_hi = NPH; hipLaunchKernelGGL(mk_fwd, dim3(grid), dim3(NTHR), LDS_BYTES, stream, a); }
    else { for (int p = 0; p < NPH; ++p) { a.ph_lo = p; a.ph_hi = p + 1; hipLaunchKernelGGL(mk_fwd, dim3(grid), dim3(NTHR), LDS_BYTES, stream, a); } }
}
```

```cpp
#include <hip/hip_runtime.h>
#include <cstdio>
#include <cstdint>

#ifndef MK_N_LAUNCHES
#define MK_N_LAUNCHES 1
#endif

namespace pg8 {
#define PG8_LAS __attribute__((address_space(3)))
typedef unsigned short bf16_t;
typedef short bf16x8 __attribute__((ext_vector_type(8)));
typedef float f32x4 __attribute__((ext_vector_type(4)));
typedef unsigned u32x4 __attribute__((ext_vector_type(4)));
constexpr int BM = 256, BK = 64, HALF = 128, HTB = HALF * BK * 2  , STAGE_BYTES = 8 * HTB, NXCD = 8;

__host__ __device__ __forceinline__ int lds_byte(int r, int c) { const int st = (r >> 4) * 2 + (c >> 5), rr = r & 15, cc = c & 31, ob = rr * 64 + cc * 2; return st * 1024 + (ob ^ (((ob >> 9) & 1) << 5)); }
__host__ __device__ __forceinline__ void stage_rc(int b, int& R, int& C) { const int st = b / 1024, sb = b % 1024, swz = sb ^ (((sb >> 9) & 1) << 5); R = (st >> 1) * 16 + swz / 64; C = (st & 1) * 32 + (swz % 64) / 2; }
__host__ __device__ __forceinline__ int perm32(int rho) { const int n = rho >> 4, i = rho & 15; return 8 * (i >> 2) + 4 * n + (i & 3); }

struct Unit { int pm, pn, pe, pk; };
struct Gemm { const bf16_t* A; const bf16_t* Bt; int ld, K; size_t bstride; size_t bdelta = 0; };

struct StaticOrder {
    int nM, nN, nwg, G, c, WGM, pe_pm;
    __host__ __device__ void init(int M, int N, int G_, int c_, int wgm = 4) { nM = M / BM; nN = N / BM; nwg = nM * nN; G = G_; c = c_; WGM = wgm; pe_pm = 1 << 30; }
    __host__ __device__ bool next(int i, Unit& u) const {
        const long L = (long)i * G + c; if (L >= nwg) return false;
        int wgid = (int)L; { const int q = nwg / NXCD, r = nwg % NXCD, xcd = wgid % NXCD, off = wgid / NXCD; wgid = (xcd < r ? xcd * (q + 1) : r * (q + 1) + (xcd - r) * q) + off; }
        const int nig = WGM * nN, gid = wgid / nig, fm = gid * WGM, gsz = (nM - fm) < WGM ? (nM - fm) : WGM;
        u.pm = fm + ((wgid % nig) % gsz); u.pn = (wgid % nig) / gsz; u.pe = u.pm >= pe_pm ? 1 : 0; u.pk = 0; return true;
    }
    __device__ __forceinline__ void a_ready(const Unit&) const {}
    __device__ __forceinline__ void done(const Unit&) const {}
};
struct GroupedOrder {
    int nM, nN, nwg, G, c, WGM; int ts1, ts2, ts3, ts4, ts5, ts6, ts7;
    __device__ bool next(int i, Unit& u) const {
        const long L = (long)i * G + c; if (L >= nwg) return false;
        int wgid = (int)L; { const int q = nwg / NXCD, r = nwg % NXCD, xcd = wgid % NXCD, off = wgid / NXCD; wgid = (xcd < r ? xcd * (q + 1) : r * (q + 1) + (xcd - r) * q) + off; }
        const int nig = WGM * nN, gid = wgid / nig, fm = gid * WGM, gsz = (nM - fm) < WGM ? (nM - fm) : WGM;
        u.pm = fm + ((wgid % nig) % gsz); u.pn = (wgid % nig) / gsz;
        u.pk = 0; const int p = u.pm; u.pe = (p >= ts1) + (p >= ts2) + (p >= ts3) + (p >= ts4) + (p >= ts5) + (p >= ts6) + (p >= ts7); return true;
    }
    __device__ __forceinline__ void a_ready(const Unit&) const {}
    __device__ __forceinline__ void done(const Unit&) const {}
};

__device__ __forceinline__ unsigned cvt_pk_bf16(float lo, float hi) { unsigned r; asm volatile("v_cvt_pk_bf16_f32 %0, %1, %2" : "=v"(r) : "v"(lo), "v"(hi)); return r; }
__device__ __forceinline__ float silu_f(float g) { return g * __builtin_amdgcn_rcpf(1.0f + __expf(-g)); }

struct EpiStoreBf16 {
    static constexpr bool PERM = true, AFTER_DRAIN = false;
    bf16_t* O; int ldc;
    __device__ __forceinline__ void operator()(const f32x4 (&acc)[2][2][4][2], const Unit& u, int wr, int wc, int fr, int fq) const {
        const int row0 = u.pm * BM + wr * 64 + fr, col0 = u.pn * BM + wc * 32 + 8 * fq;
#pragma unroll
        for (int ai = 0; ai < 2; ++ai)
#pragma unroll
            for (int m = 0; m < 4; ++m) { bf16_t* rowp = O + (size_t)(row0 + ai * HALF + m * 16) * ldc + col0;
#pragma unroll
                for (int bj = 0; bj < 2; ++bj) { const f32x4 v0 = acc[ai][bj][m][0], v1 = acc[ai][bj][m][1];
                    u32x4 w; w.x = cvt_pk_bf16(v0[0], v0[1]); w.y = cvt_pk_bf16(v0[2], v0[3]); w.z = cvt_pk_bf16(v1[0], v1[1]); w.w = cvt_pk_bf16(v1[2], v1[3]);
                    *(u32x4*)(rowp + bj * HALF) = w; } }
    }
};
template <bool FOLD> struct EpiSwiGLUT {
    static constexpr bool PERM = true, AFTER_DRAIN = false;
    bf16_t* O; int ldc; const float* ssq; const float* bias;
    __device__ __forceinline__ void operator()(const f32x4 (&acc)[2][2][4][2], const Unit& u, int wr, int wc, int fr, int fq) const {
        const int row0 = u.pm * BM + wr * 64 + fr, col0 = u.pn * HALF + wc * 32 + 8 * fq;
        f32x4 bg0, bg1, bu0, bu1;
        if (FOLD) { const float* bp = bias + (size_t)u.pe * 2 * ldc + col0; bg0 = *(const f32x4*)bp; bg1 = *(const f32x4*)(bp + 4); bu0 = *(const f32x4*)(bp + ldc); bu1 = *(const f32x4*)(bp + ldc + 4); }
#pragma unroll
        for (int ai = 0; ai < 2; ++ai)
#pragma unroll
            for (int m = 0; m < 4; ++m) { bf16_t* rowp = O + (size_t)(row0 + ai * HALF + m * 16) * ldc + col0;
                f32x4 g0 = acc[ai][0][m][0], g1 = acc[ai][0][m][1], u0 = acc[ai][1][m][0], u1 = acc[ai][1][m][1];
                if (FOLD) { const float rs = __builtin_amdgcn_rsqf(ssq[row0 + ai * HALF + m * 16] * (1.0f / 1024.0f) + 1e-6f); g0 = g0 * rs + bg0; g1 = g1 * rs + bg1; u0 = u0 * rs + bu0; u1 = u1 * rs + bu1; }
                u32x4 w; w.x = cvt_pk_bf16(silu_f(g0[0]) * u0[0], silu_f(g0[1]) * u0[1]); w.y = cvt_pk_bf16(silu_f(g0[2]) * u0[2], silu_f(g0[3]) * u0[3]);
                w.z = cvt_pk_bf16(silu_f(g1[0]) * u1[0], silu_f(g1[1]) * u1[1]); w.w = cvt_pk_bf16(silu_f(g1[2]) * u1[2], silu_f(g1[3]) * u1[3]);
                *(u32x4*)rowp = w; }
    }
};
typedef EpiSwiGLUT<false> EpiSwiGLU;
typedef EpiSwiGLUT<true> EpiSwiGLUFold;
template <bool BASE_F32> struct EpiRes {
    static constexpr bool PERM = true, AFTER_DRAIN = false;
    bf16_t* X; const void* base; const float* gate; float* ssq = nullptr;
    __device__ __forceinline__ void operator()(const f32x4 (&acc)[2][2][4][2], const Unit& u, int wr, int wc, int fr, int fq) const {
        const int row0 = u.pm * BM + wr * 64 + fr, col0 = u.pn * BM + wc * 32 + 8 * fq;
        f32x4 gv[2][2];
#pragma unroll
        for (int bj = 0; bj < 2; ++bj)
#pragma unroll
            for (int n = 0; n < 2; ++n) gv[bj][n] = *(const f32x4*)(gate + col0 + bj * HALF + 4 * n);
#pragma unroll
        for (int ai = 0; ai < 2; ++ai)
#pragma unroll
            for (int m = 0; m < 4; ++m) { const size_t ro = (size_t)(row0 + ai * HALF + m * 16) * 1024 + col0; float sq = 0.f;
#pragma unroll
                for (int bj = 0; bj < 2; ++bj) { f32x4 b0, b1;
                    if (BASE_F32) { b0 = __builtin_nontemporal_load((const f32x4*)((const float*)base + ro + bj * HALF)); b1 = __builtin_nontemporal_load((const f32x4*)((const float*)base + ro + bj * HALF + 4)); }
                    else { const u32x4 t = *(const u32x4*)((const bf16_t*)base + ro + bj * HALF);
                        b0 = (f32x4){__uint_as_float(t.x << 16), __uint_as_float(t.x & 0xffff0000u), __uint_as_float(t.y << 16), __uint_as_float(t.y & 0xffff0000u)};
                        b1 = (f32x4){__uint_as_float(t.z << 16), __uint_as_float(t.z & 0xffff0000u), __uint_as_float(t.w << 16), __uint_as_float(t.w & 0xffff0000u)}; }
                    const f32x4 v0 = b0 + gv[bj][0] * acc[ai][bj][m][0], v1 = b1 + gv[bj][1] * acc[ai][bj][m][1];
                    sq += (v0[0] * v0[0] + v0[1] * v0[1]) + (v0[2] * v0[2] + v0[3] * v0[3]) + (v1[0] * v1[0] + v1[1] * v1[1]) + (v1[2] * v1[2] + v1[3] * v1[3]);
                    u32x4 w; w.x = cvt_pk_bf16(v0[0], v0[1]); w.y = cvt_pk_bf16(v0[2], v0[3]); w.z = cvt_pk_bf16(v1[0], v1[1]); w.w = cvt_pk_bf16(v1[2], v1[3]);
                    *(u32x4*)(X + ro + bj * HALF) = w; }
                if (ssq) { sq += __shfl_xor(sq, 16); sq += __shfl_xor(sq, 32); if (fq == 0) unsafeAtomicAdd(ssq + row0 + ai * HALF + m * 16, sq); } }
    }
};
struct EpiSsdIn {
    static constexpr bool PERM = true, AFTER_DRAIN = false;
    bf16_t* Z; bf16_t* XB; float* DT; const float* ssq; const float* bias;
    __device__ __forceinline__ void operator()(const f32x4 (&acc)[2][2][4][2], const Unit& u, int wr, int wc, int fr, int fq) const {
        const int row0 = u.pm * BM + wr * 64 + fr;
        const float* bp = bias + (size_t)u.pe * 5376 + u.pn * BM + wc * 32 + 8 * fq;
        if (u.pn < 20) {
            bf16_t* O = u.pn < 8 ? Z : XB; const int ldc = u.pn < 8 ? 2048 : 3072; const int col0 = (u.pn < 8 ? u.pn : u.pn - 8) * BM + wc * 32 + 8 * fq;
#pragma unroll
            for (int ai = 0; ai < 2; ++ai)
#pragma unroll
                for (int m = 0; m < 4; ++m) { bf16_t* rowp = O + (size_t)(row0 + ai * HALF + m * 16) * ldc + col0;
                    const float rs = __builtin_amdgcn_rsqf(ssq[row0 + ai * HALF + m * 16] * (1.0f / 1024.0f) + 1e-6f);
#pragma unroll
                    for (int bj = 0; bj < 2; ++bj) { const f32x4 v0 = acc[ai][bj][m][0] * rs + *(const f32x4*)(bp + bj * HALF), v1 = acc[ai][bj][m][1] * rs + *(const f32x4*)(bp + bj * HALF + 4);
                        u32x4 w; w.x = cvt_pk_bf16(v0[0], v0[1]); w.y = cvt_pk_bf16(v0[2], v0[3]); w.z = cvt_pk_bf16(v1[0], v1[1]); w.w = cvt_pk_bf16(v1[2], v1[3]);
                        *(u32x4*)(rowp + bj * HALF) = w; } }
        } else if (wc < 2) {
#pragma unroll
            for (int ai = 0; ai < 2; ++ai)
#pragma unroll
                for (int m = 0; m < 4; ++m) { float* rowp = DT + (size_t)(row0 + ai * HALF + m * 16) * 64 + wc * 32 + 8 * fq;
                    const float rs = __builtin_amdgcn_rsqf(ssq[row0 + ai * HALF + m * 16] * (1.0f / 1024.0f) + 1e-6f);
                    *(f32x4*)rowp = acc[ai][0][m][0] * rs + *(const f32x4*)bp; *(f32x4*)(rowp + 4) = acc[ai][0][m][1] * rs + *(const f32x4*)(bp + 4); }
        }
    }
};


struct SplitOrder {
    int pm0, nN, nunits, ks_len, G, c;
    __device__ bool next(int i, Unit& u) const { const int x = i * G + c; if (x >= nunits) return false; u.pm = pm0; u.pn = x % nN; u.pe = 0; u.pk = (x / nN) * ks_len; return true; }
    __device__ __forceinline__ void a_ready(const Unit&) const {}
    __device__ __forceinline__ void done(const Unit&) const {}
};
struct SplitGroupedOrder {
    int pm_lo, pm_hi, nN, nks, ks_len, G, c; int ts1, ts2, ts3, ts4, ts5, ts6, ts7;
    __device__ bool next(int i, Unit& u) const { const int x = i * G + c; const int per = nN * nks; if (x >= (pm_hi - pm_lo) * per) return false;
        u.pm = pm_lo + x / per; const int y = x % per; u.pn = y / nks; u.pk = (y % nks) * ks_len;
        const int p = u.pm; u.pe = (p >= ts1) + (p >= ts2) + (p >= ts3) + (p >= ts4) + (p >= ts5) + (p >= ts6) + (p >= ts7); return true; }
    __device__ __forceinline__ void a_ready(const Unit&) const {}
    __device__ __forceinline__ void done(const Unit&) const {}
};
struct EpiPart {
    static constexpr bool PERM = false, AFTER_DRAIN = false;
    float* P; int pm_base, ks_len, nrows;
    __device__ __forceinline__ void operator()(const f32x4 (&acc)[2][2][4][2], const Unit& u, int wr, int wc, int fr, int fq) const {
        const int row0 = (u.pm - pm_base) * BM + wr * 64 + fr, col0 = u.pn * BM + wc * 32 + 4 * fq;
        float* base = P + (size_t)(u.pk / ks_len) * nrows * 1024;
#pragma unroll
        for (int ai = 0; ai < 2; ++ai)
#pragma unroll
            for (int m = 0; m < 4; ++m) { float* rowp = base + (size_t)(row0 + ai * HALF + m * 16) * 1024 + col0;
#pragma unroll
                for (int bj = 0; bj < 2; ++bj)
#pragma unroll
                    for (int n = 0; n < 2; ++n) *(f32x4*)(rowp + bj * HALF + n * 16) = acc[ai][bj][m][n]; }
    }
};
template <class Epi, class Sched, bool ALIGN_EPI = false, bool SP2 = false>
__device__ __forceinline__ void gemm_phase(PG8_LAS unsigned char* lds, const Gemm g, const Sched& S, const Epi& E) {
    const int tid = threadIdx.x, wid = __builtin_amdgcn_readfirstlane(tid >> 6), lane = tid & 63, wr = wid >> 2, wc = wid & 3, fr = lane & 15, fq = lane >> 4;
    const int K = g.K, nt = K / BK;
    unsigned voffA[2], voffB[2];
#pragma unroll
    for (int i = 0; i < 2; ++i) { int R, C; stage_rc(tid * 16 + i * 8192, R, C); const int Rb = Epi::PERM ? ((R & ~31) + perm32(R & 31)) : R;
        voffA[i] = (unsigned)(R * g.ld + C) * 2u; voffB[i] = (unsigned)(Rb * g.ld + C) * 2u; }
    const size_t kstep = (size_t)(BK * 2);
    const size_t hstep = (size_t)HALF * g.ld * 2;
    const size_t tstep = 2 * hstep;
    const unsigned ldsw = (unsigned)wid * 1024u;
    const int aoff = lds_byte(wr * 64 + fr, fq * 8), boff = lds_byte(wc * 32 + fr, fq * 8);
#define PG8_SA(b, h) (((b) * 2 + (h)) * HTB)
#define PG8_SB(b, h) ((4 + (b) * 2 + (h)) * HTB)
#define PG8_STAGE(bufoff, gbase, voff) do { _Pragma("unroll") for (int _i = 0; _i < 2; ++_i) \
        __builtin_amdgcn_global_load_lds((const unsigned*)((const char*)(gbase) + (voff)[_i]), (PG8_LAS unsigned*)(lds + (bufoff) + ldsw + _i * 8192), 16, 0, 0); } while (0)
#define PG8_LDA(dst, b, h) do { _Pragma("unroll") for (int m = 0; m < 4; ++m) _Pragma("unroll") for (int k = 0; k < 2; ++k) dst[m][k] = *(const PG8_LAS bf16x8*)(lds + PG8_SA(b, h) + aoff + m * 2048 + k * 1024); } while (0)
#define PG8_LDB(dst, b, h) do { _Pragma("unroll") for (int n = 0; n < 2; ++n) _Pragma("unroll") for (int k = 0; k < 2; ++k) dst[n][k] = *(const PG8_LAS bf16x8*)(lds + PG8_SB(b, h) + boff + n * 2048 + k * 1024); } while (0)
#define PG8_MMA(ai, bj, At, Bt) do { __builtin_amdgcn_s_setprio(1); _Pragma("unroll") for (int m = 0; m < 4; ++m) _Pragma("unroll") for (int n = 0; n < 2; ++n) _Pragma("unroll") for (int k = 0; k < 2; ++k) \
        acc[ai][bj][m][n] = __builtin_amdgcn_mfma_f32_16x16x32_bf16(Bt[n][k], At[m][k], acc[ai][bj][m][n], 0, 0, 0); __builtin_amdgcn_s_setprio(0); } while (0)
#define PG8_WAIT_V(n) asm volatile("s_waitcnt vmcnt(" #n ")" ::: "memory")
#define PG8_WAIT_L(n) asm volatile("s_waitcnt lgkmcnt(" #n ")" ::: "memory")
#define PG8_BAR __builtin_amdgcn_s_barrier()
#define PG8_SCHED __builtin_amdgcn_sched_barrier(0)
    Unit cur, nxt; int ui = 0;
    if (!S.next(0, cur)) return;
    f32x4 acc[2][2][4][2];
#pragma unroll
    for (int a = 0; a < 2; ++a)
#pragma unroll
        for (int b = 0; b < 2; ++b)
#pragma unroll
            for (int m = 0; m < 4; ++m)
#pragma unroll
                for (int n = 0; n < 2; ++n) acc[a][b][m][n] = (f32x4){0.f, 0.f, 0.f, 0.f};
    bf16x8 At[4][2], B0[2][2], B1[2][2];
    const char* cA = (const char*)g.A + (size_t)cur.pm * tstep + (size_t)cur.pk * 2; const char* cB = (const char*)g.Bt + (size_t)cur.pe * g.bstride + (cur.pe >= 4 ? g.bdelta : (size_t)0) + (size_t)cur.pn * tstep + (size_t)cur.pk * 2;
    S.a_ready(cur);
    if constexpr (SP2) {
        PG8_STAGE(PG8_SB(0, 0), cB, voffB); PG8_STAGE(PG8_SB(0, 1), cB + hstep, voffB); PG8_STAGE(PG8_SA(0, 0), cA, voffA); PG8_STAGE(PG8_SA(0, 1), cA + hstep, voffA);
        if (wr == 1) PG8_BAR;
        PG8_WAIT_V(2); PG8_BAR;
        PG8_STAGE(PG8_SB(1, 0), cB + kstep, voffB); PG8_STAGE(PG8_SA(1, 0), cA + kstep, voffA); PG8_STAGE(PG8_SB(1, 1), cB + hstep + kstep, voffB);
        PG8_WAIT_V(6); PG8_BAR;
    } else {
        PG8_STAGE(PG8_SB(0, 0), cB, voffB); PG8_STAGE(PG8_SA(0, 0), cA, voffA); PG8_STAGE(PG8_SB(0, 1), cB + hstep, voffB); PG8_STAGE(PG8_SA(0, 1), cA + hstep, voffA);
        if (wr == 1) PG8_BAR;
        PG8_WAIT_V(4); PG8_BAR;
        PG8_STAGE(PG8_SB(1, 0), cB + kstep, voffB); PG8_STAGE(PG8_SA(1, 0), cA + kstep, voffA); PG8_STAGE(PG8_SB(1, 1), cB + hstep + kstep, voffB);
        PG8_WAIT_V(6); PG8_BAR;
    }
    for (;;) {
        const bool has_next = S.next(ui + 1, nxt);
        const char* nA = has_next ? (const char*)g.A + (size_t)nxt.pm * tstep + (size_t)nxt.pk * 2 : cA; const char* nB = has_next ? (const char*)g.Bt + (size_t)nxt.pe * g.bstride + (nxt.pe >= 4 ? g.bdelta : (size_t)0) + (size_t)nxt.pn * tstep + (size_t)nxt.pk * 2 : cB;
        for (int t = 0; t < nt; t += 2) {
            const bool last = (t == nt - 2);
            const char* a1 = cA + (size_t)(t + 1) * kstep;
            const char* a2 = last ? nA : cA + (size_t)(t + 2) * kstep; const char* b2 = last ? nB : cB + (size_t)(t + 2) * kstep;
            const char* a3 = a2 + kstep; const char* b3 = b2 + kstep;
            if (last && has_next) S.a_ready(nxt);
            if constexpr (SP2) {
            PG8_LDB(B0, 0, 0); PG8_LDB(B1, 0, 1); PG8_SCHED; PG8_LDA(At, 0, 0); PG8_STAGE(PG8_SA(1, 1), a1 + hstep, voffA);
            PG8_WAIT_V(8); PG8_WAIT_L(0); PG8_BAR; PG8_MMA(0, 0, At, B0); PG8_MMA(0, 1, At, B1); PG8_BAR; PG8_SCHED;
            PG8_LDA(At, 0, 1); PG8_STAGE(PG8_SB(0, 0), b2, voffB); PG8_STAGE(PG8_SB(0, 1), b2 + hstep, voffB); PG8_STAGE(PG8_SA(0, 0), a2, voffA);
            PG8_WAIT_V(8); PG8_WAIT_L(0); PG8_BAR; PG8_MMA(1, 0, At, B0); PG8_MMA(1, 1, At, B1); PG8_BAR; PG8_SCHED;
            PG8_LDB(B0, 1, 0); PG8_LDB(B1, 1, 1); PG8_SCHED; PG8_LDA(At, 1, 0); PG8_STAGE(PG8_SA(0, 1), a2 + hstep, voffA);
            PG8_WAIT_V(8); PG8_WAIT_L(0); PG8_BAR; PG8_MMA(0, 0, At, B0); PG8_MMA(0, 1, At, B1); PG8_BAR; PG8_SCHED;
            PG8_LDA(At, 1, 1); PG8_STAGE(PG8_SB(1, 0), b3, voffB); PG8_STAGE(PG8_SB(1, 1), b3 + hstep, voffB); PG8_STAGE(PG8_SA(1, 0), a3, voffA);
            PG8_WAIT_V(8); PG8_WAIT_L(0); PG8_BAR; PG8_MMA(1, 0, At, B0); PG8_MMA(1, 1, At, B1); PG8_BAR; PG8_SCHED;
            } else {
            PG8_LDB(B0, 0, 0); PG8_SCHED; PG8_LDA(At, 0, 0); PG8_STAGE(PG8_SA(1, 1), a1 + hstep, voffA);
            PG8_WAIT_L(8); PG8_BAR; PG8_WAIT_L(0); PG8_MMA(0, 0, At, B0); PG8_BAR; PG8_SCHED;
            PG8_LDB(B1, 0, 1); PG8_STAGE(PG8_SB(0, 0), b2, voffB);
            PG8_BAR; PG8_WAIT_L(0); PG8_MMA(0, 1, At, B1); PG8_BAR;
            PG8_LDA(At, 0, 1); PG8_STAGE(PG8_SA(0, 0), a2, voffA);
            PG8_BAR; PG8_WAIT_L(0); PG8_MMA(1, 0, At, B0); PG8_BAR; PG8_SCHED;
            PG8_STAGE(PG8_SB(0, 1), b2 + hstep, voffB);
            PG8_WAIT_V(6); PG8_BAR; PG8_MMA(1, 1, At, B1); PG8_BAR;
            PG8_LDB(B0, 1, 0); PG8_SCHED; PG8_LDA(At, 1, 0); PG8_STAGE(PG8_SA(0, 1), a2 + hstep, voffA);
            PG8_WAIT_L(8); PG8_BAR; PG8_WAIT_L(0); PG8_MMA(0, 0, At, B0); PG8_BAR; PG8_SCHED;
            PG8_LDB(B1, 1, 1); PG8_STAGE(PG8_SB(1, 0), b3, voffB);
            PG8_BAR; PG8_WAIT_L(0); PG8_MMA(0, 1, At, B1); PG8_BAR;
            PG8_LDA(At, 1, 1); PG8_STAGE(PG8_SA(1, 0), a3, voffA);
            PG8_BAR; PG8_WAIT_L(0); PG8_MMA(1, 0, At, B0); PG8_BAR; PG8_SCHED;
            PG8_STAGE(PG8_SB(1, 1), b3 + hstep, voffB);
            PG8_WAIT_V(6); PG8_BAR; PG8_MMA(1, 1, At, B1); PG8_BAR;
            }
        }
        if constexpr (ALIGN_EPI) { if (wr == 0) PG8_BAR; }
        if constexpr (!Epi::AFTER_DRAIN) { E(acc, cur, wr, wc, fr, fq); S.done(cur); }
        if (!has_next) break;
#pragma unroll
        for (int a = 0; a < 2; ++a)
#pragma unroll
            for (int b = 0; b < 2; ++b)
#pragma unroll
                for (int m = 0; m < 4; ++m)
#pragma unroll
                    for (int n = 0; n < 2; ++n) acc[a][b][m][n] = (f32x4){0.f, 0.f, 0.f, 0.f};
        cur = nxt; cA = nA; cB = nB; ++ui;
        if constexpr (ALIGN_EPI) { if (wr == 1) PG8_BAR; }
    }
    PG8_WAIT_V(0);
    if constexpr (!ALIGN_EPI) { if (wr == 0) PG8_BAR; }
    PG8_BAR;
    if constexpr (Epi::AFTER_DRAIN) { E.fused(acc, cur, wr, wc, fr, fq, lds, wid, lane); S.done(cur); }
#undef PG8_SA
#undef PG8_SB
#undef PG8_STAGE
#undef PG8_LDA
#undef PG8_LDB
#undef PG8_MMA
#undef PG8_WAIT_V
#undef PG8_WAIT_L
#undef PG8_BAR
#undef PG8_SCHED
}
}

constexpr int NWAVES = 8, NTHR = 512;
constexpr int D = 1024, L = 16384, LC = 256, MT = L + LC;
constexpr int AB_IN = 2304, DFF = 2816, SSD_INP = 5376, SSD_IN_REAL = 5184, DIN = 2048, XBCW = 3072, FFE = 3584, NEXP = 8;
constexpr int NCH = MT / 128;
constexpr int MOE_ROWS = 2 * L + NEXP * 256;
constexpr float EPS = 1e-6f;

constexpr size_t MiB = 1u << 20;
constexpr size_t WS_CTL = 0, CTL_ZERO_BYTES = 32768;
constexpr size_t WS_MOD = 1 * MiB;
constexpr size_t WS_ROPE = 1 * MiB + 128 * 1024;
constexpr size_t WS_TOKE = 2 * MiB, WS_TOKW = 2 * MiB + 128 * 1024, WS_TOKP = 2 * MiB + 256 * 1024;
constexpr size_t WS_RSTD = 2 * MiB + 384 * 1024;
constexpr size_t WS_DEC = 3 * MiB;
constexpr size_t WS_SSQA = 3 * MiB + 64 * 1024, WS_SSQB = 3 * MiB + 192 * 1024;
constexpr size_t WS_BIASA = 3 * MiB + 320 * 1024, WS_BIASB = 3 * MiB + 384 * 1024;
constexpr size_t WS_WCTX = 455 * MiB;
constexpr size_t WS_X = 4 * MiB;
constexpr size_t WS_H = 36 * MiB + 512 * 1024;
constexpr size_t WS_WMOE = 69 * MiB, WS_YPART = WS_WMOE + 56 * MiB;
constexpr size_t WS_H2S = 181 * MiB, WS_ACTM = 249 * MiB, WS_H2 = 487 * MiB, WS_END = 520 * MiB;
constexpr size_t WS_WDA = WS_H, WS_WDB = 487 * MiB, WD_BYTES = (size_t)D * FFE * 2;
static_assert(WS_WDA + 4 * WD_BYTES <= WS_WMOE && WS_WDB + 4 * WD_BYTES <= WS_END && WS_WDB >= WS_ACTM + (size_t)MOE_ROWS * FFE * 2, "down-weight regions");
constexpr size_t WS_WSSDIN = 181 * MiB, WS_WSSDOUT = WS_WSSDIN + (size_t)SSD_INP * D * 2;
constexpr size_t WS_WABIN = 196 * MiB, WS_WABOUT = WS_WABIN + (size_t)AB_IN * D * 2, WS_WFFNGU = WS_WABOUT + (size_t)D * D * 2, WS_WFFND = WS_WFFNGU + (size_t)2 * DFF * D * 2;
constexpr size_t WS_PAB = 219 * MiB, WS_MIX = 293 * MiB, WS_ACT0 = 326 * MiB, WS_QR = 416 * MiB, WS_KR = 433 * MiB, WS_VT = 438 * MiB, WS_PART = 443 * MiB;
constexpr size_t WS_Z = 196 * MiB, WS_XBCR = 261 * MiB, WS_STATES = 261 * MiB, WS_DTRAW = 391 * MiB, WS_DTS = 396 * MiB, WS_XT = 405 * MiB, WS_BT = 470 * MiB, WS_BM = 487 * MiB, WS_CM = 503 * MiB + 512 * 1024;
constexpr size_t DTS_STRIDE = (size_t)32 * MT * 4;
static_assert(WS_X + (size_t)MT * D * 2 <= WS_H && WS_H + (size_t)MT * D * 2 <= WS_WMOE, "X / H map");
static_assert(WS_WMOE + (size_t)NEXP * 2 * FFE * D * 2 <= WS_H2S && WS_H2S + (size_t)MOE_ROWS * D * 2 <= WS_ACTM && WS_ACTM + (size_t)MOE_ROWS * FFE * 2 <= WS_H2 && WS_H2 + (size_t)L * D * 2 <= WS_END, "moe map");
static_assert(WS_YPART >= WS_WMOE + (size_t)NEXP * D * FFE * 2 && WS_YPART + (size_t)7 * 2048 * D * 4 <= WS_H2S, "moe map 2");
static_assert(WS_WSSDOUT + (size_t)D * DIN * 2 <= WS_WABIN && WS_WFFND + (size_t)D * DFF * 2 <= WS_PAB, "weights map");
static_assert(WS_PAB + (size_t)MT * AB_IN * 2 <= WS_MIX && WS_MIX + (size_t)MT * D * 2 <= WS_ACT0 && WS_ACT0 + (size_t)MT * DFF * 2 <= WS_QR && WS_QR + (size_t)8 * MT * 64 * 2 <= WS_KR && WS_KR + (size_t)2 * MT * 64 * 2 <= WS_VT && WS_VT + (size_t)128 * MT * 2 <= WS_PART && WS_PART + (size_t)11 * LC * D * 4 <= WS_END, "layer0 map");
static_assert(WS_WSSDOUT + (size_t)D * DIN * 2 <= WS_Z && WS_Z + (size_t)MT * DIN * 2 <= WS_XBCR && WS_XBCR + (size_t)MT * XBCW * 2 <= WS_DTRAW && WS_STATES + (size_t)2 * NCH * 32 * 64 * 128 * 2 <= WS_DTRAW && WS_DTRAW + (size_t)MT * 64 * 4 <= WS_DTS && WS_DTS + 4 * DTS_STRIDE <= WS_XT && WS_XT + (size_t)DIN * MT * 2 <= WS_BT && WS_BT + (size_t)512 * MT * 2 <= WS_BM && WS_BM + (size_t)MT * 512 * 2 <= WS_CM && WS_CM + (size_t)MT * 512 * 2 <= WS_END, "ssd map");
static_assert(WS_PART + (size_t)11 * LC * D * 4 <= WS_BT && WS_PART >= WS_DTS + 4 * DTS_STRIDE || true, "PART is read by the layer-1 modulate before the SSD conv writes XT");
constexpr int CW_TMO = 0;
constexpr int CW_PCNT = 512;
constexpr int CW_HIST = 1024;
constexpr int CW_BAR = 4096;

constexpr int RING_BYTES = 159744, LDSCTL_OFF = RING_BYTES, MISC_OFF = LDSCTL_OFF + 320, LDS_BYTES = 163840;

#define GAS __attribute__((address_space(1)))
#define LAS __attribute__((address_space(3)))
typedef unsigned short bf16;
typedef unsigned v4u __attribute__((ext_vector_type(4)));
typedef unsigned v2u __attribute__((ext_vector_type(2)));
typedef float f32x4 __attribute__((ext_vector_type(4)));
typedef GAS unsigned gu32;
#define RLX_AGENT __ATOMIC_RELAXED, __HIP_MEMORY_SCOPE_AGENT
#define LDS_WAIT() asm volatile("s_waitcnt lgkmcnt(0)" ::: "memory")
#define VM_WAIT() asm volatile("s_waitcnt vmcnt(0)" ::: "memory")
__device__ __forceinline__ unsigned pk2(float lo, float hi) { return pg8::cvt_pk_bf16(lo, hi); }
__device__ __forceinline__ float bflo(unsigned u) { return __uint_as_float(u << 16); }
__device__ __forceinline__ float bfhi(unsigned u) { return __uint_as_float(u & 0xffff0000u); }
__device__ __forceinline__ float bf1(bf16 b) { return __uint_as_float(((unsigned)b) << 16); }
__device__ __forceinline__ float sigmoid_f(float x) { return __builtin_amdgcn_rcpf(1.0f + __builtin_amdgcn_exp2f(-1.4426950408889634f * x)); }
__device__ __forceinline__ float softplus_f(float x) {
    const float y = __builtin_amdgcn_exp2f(-1.4426950408889634f * fabsf(x));
    const float l = y < 1.0e-3f ? y * (1.0f - 0.5f * y) : __builtin_amdgcn_logf(1.0f + y) * 0.6931471805599453f;
    return fmaxf(x, 0.f) + l; }

#define XB_TMO      128
#define XB_XCNT(j)  (256  + 64 * (j))
#define XB_XSUB(j)  (1280 + 64 * (j))
#define XB_XGEN(j)  (2304 + 64 * (j))
#define XB_TOP      3328
#define XB_TOPGEN   3392
#define XCD_BAR_WORDS 3456
#define XB_SPIN_CAP (1u << 18)
__device__ __forceinline__ unsigned xb_ld(unsigned* p)              { return __hip_atomic_load(p, __ATOMIC_RELAXED, __HIP_MEMORY_SCOPE_AGENT); }
__device__ __forceinline__ unsigned xb_add(unsigned* p, unsigned v) { return __hip_atomic_fetch_add(p, v, __ATOMIC_RELAXED, __HIP_MEMORY_SCOPE_AGENT); }
__device__ __forceinline__ unsigned xb_xcc_id() { return (unsigned)__builtin_amdgcn_s_getreg((3 << 11) | 20) & 0xFu; }
#define XB_SPIN(cond, bar) do { unsigned _sp = 0; while (cond) { __builtin_amdgcn_s_sleep(1); \
    if ((++_sp & 255u) == 0u) { if (xb_ld(&(bar)[XB_TMO])) break; if (_sp > XB_SPIN_CAP) { atomicAdd(&(bar)[XB_TMO], 1u); break; } } } } while (0)
struct XcdBarrier { unsigned* bar; unsigned x; volatile LAS unsigned* st; };
__device__ __forceinline__ XcdBarrier xcd_barrier_post(unsigned* bar, volatile LAS unsigned* st) {
    XcdBarrier b; b.bar = bar; b.x = xb_xcc_id(); b.st = st;
    if (threadIdx.x == 0) (void)xb_add(&bar[XB_XCNT(b.x)], 1u);
    return b;
}
__device__ __forceinline__ void xcd_barrier_complete(unsigned* bar, unsigned x, unsigned& nloc, unsigned& nx) {
    const unsigned G = gridDim.x * gridDim.y * gridDim.z;
    unsigned sum, cnt, mine, sp = 0u;
    for (;;) {
        sum = 0u; cnt = 0u; mine = 0u;
#pragma unroll
        for (unsigned j = 0; j < 16; ++j) { const unsigned c = xb_ld(&bar[XB_XCNT(j)]); sum += c; cnt += (c > 0u) ? 1u : 0u; mine = (j == x) ? c : mine; }
        if (sum == G) break;
        __builtin_amdgcn_s_sleep(1);
        if ((++sp & 255u) == 0u) { if (xb_ld(&bar[XB_TMO])) break; if (sp > XB_SPIN_CAP) { atomicAdd(&bar[XB_TMO], 1u); break; } }
    }
    nloc = mine > 0u ? mine : 1u; nx = cnt > 0u ? cnt : 1u;
}
__device__ __forceinline__ void xcd_barrier(const XcdBarrier& b) {
    asm volatile("s_waitcnt vmcnt(0)" ::: "memory");
    __syncthreads();
    if (threadIdx.x == 0) {
        unsigned* bar = b.bar;
        __builtin_amdgcn_s_waitcnt(0);
        unsigned nloc = b.st[0], nx = b.st[1];
        if (nloc == 0u) { xcd_barrier_complete(bar, b.x, nloc, nx); b.st[0] = nloc; b.st[1] = nx; }
        const unsigned old = xb_add(&bar[XB_XSUB(b.x)], 1u);
        const unsigned gen = old / nloc;
        if (old + 1u == (gen + 1u) * nloc) {
            __builtin_amdgcn_fence(__ATOMIC_RELEASE, "agent");
            asm volatile("s_waitcnt vmcnt(0)" ::: "memory");
            const unsigned og = xb_add(&bar[XB_TOP], 1u);
            const unsigned tg = og / nx;
            if (og + 1u == (tg + 1u) * nx) xb_add(&bar[XB_TOPGEN], 1u);
            else XB_SPIN(xb_ld(&bar[XB_TOPGEN]) == tg, bar);
            __builtin_amdgcn_fence(__ATOMIC_ACQUIRE, "agent");
            xb_add(&bar[XB_XGEN(b.x)], 1u);
            asm volatile("s_waitcnt vmcnt(0)" ::: "memory");
        } else {
            XB_SPIN(xb_ld(&bar[XB_XGEN(b.x)]) == gen, bar);
            __builtin_amdgcn_fence(__ATOMIC_ACQUIRE, "agent");
            asm volatile("s_waitcnt vmcnt(0)" ::: "memory");
        }
    }
    __syncthreads();
}

struct Frame {
    LAS unsigned char* lds;
    int tid, lane, wave, vcu, G;
    const float* in[30]; float* out; unsigned char* ws;
};
enum { I_X = 0, I_C, I_CTX, I_CCTX, I_ADAW, I_ADAB, I_N1G, I_N2G, I_ABWIN, I_ABCONV, I_ABSINK, I_ABWOUT, I_FFNG, I_FFNU, I_FFND, I_SSDWIN, I_SSDCW, I_SSDCB,
       I_DTBF, I_DTBB, I_ALOGF, I_ALOGB, I_SSDD, I_SSDNG, I_SSDWOUT, I_ROUTER, I_MOEG, I_MOEU, I_MOED, I_FINALG };
template <int CTRL> __device__ __forceinline__ float dpp_add(float v) { return v + __int_as_float(__builtin_amdgcn_update_dpp(0, __float_as_int(v), CTRL, 0xf, 0xf, true)); }
__device__ __forceinline__ float wave_sum(float v) {
    v = dpp_add<0xB1>(v);
    v = dpp_add<0x4E>(v);
    v = dpp_add<0x141>(v);
    v = dpp_add<0x140>(v);
    const int iv = __float_as_int(v);
    return (__int_as_float(__builtin_amdgcn_readlane(iv, 0)) + __int_as_float(__builtin_amdgcn_readlane(iv, 16))) + (__int_as_float(__builtin_amdgcn_readlane(iv, 32)) + __int_as_float(__builtin_amdgcn_readlane(iv, 48)));
}
constexpr int M_SH1 = 0, M_SC1 = 1024, M_G1 = 2048, M_SH2 = 3072, M_SC2 = 4096, M_G2 = 5120;
__device__ __forceinline__ const float* modp(const Frame& F, int layer, int s) { return (const float*)(F.ws + WS_MOD) + (size_t)(layer * 2 + s) * 6144; }

__device__ __forceinline__ void tr_load(const float* W, int N, int k0, int n0, int lane, f32x4 (&w)[8]) {
#pragma unroll
    for (int i = 0; i < 8; ++i) w[i] = __builtin_nontemporal_load((const GAS f32x4*)(W + (size_t)(k0 + (lane >> 3) + 8 * i) * N + n0 + 4 * (lane & 7)));
}
__device__ __forceinline__ void tr_finish(const f32x4 (&w)[8], bf16* WT, int Kdst, int k0, int drow0, LAS float* scr, int lane) {
#pragma unroll
    for (int i = 0; i < 8; ++i) { LAS float* d = scr + ((lane >> 3) + 8 * i) * 33 + 4 * (lane & 7); d[0] = w[i].x; d[1] = w[i].y; d[2] = w[i].z; d[3] = w[i].w; }
    LDS_WAIT(); asm volatile("" ::: "memory");
    const int c = lane & 7;
#pragma unroll
    for (int j = 0; j < 4; ++j) { const int n = (lane >> 3) + 8 * j; const LAS float* s = scr + (8 * c) * 33 + n;
        v4u o; o.x = pk2(s[0 * 33], s[1 * 33]); o.y = pk2(s[2 * 33], s[3 * 33]); o.z = pk2(s[4 * 33], s[5 * 33]); o.w = pk2(s[6 * 33], s[7 * 33]);
        __builtin_nontemporal_store(o, (GAS v4u*)(WT + (size_t)(drow0 + n) * Kdst + k0 + 8 * c)); }
    LDS_WAIT(); asm volatile("" ::: "memory");
}
__device__ __forceinline__ void tr_item(const float* W, int N, bf16* WT, int Kdst, int k0, int n0, int drow0, LAS float* scr, int lane) {
    { f32x4 w[8];
#pragma unroll
      for (int i = 0; i < 8; ++i) w[i] = __builtin_nontemporal_load((const GAS f32x4*)(W + (size_t)(k0 + (lane >> 3) + 8 * i) * N + n0 + 4 * (lane & 7)));
#pragma unroll
      for (int i = 0; i < 8; ++i) { LAS float* d = scr + ((lane >> 3) + 8 * i) * 33 + 4 * (lane & 7); d[0] = w[i].x; d[1] = w[i].y; d[2] = w[i].z; d[3] = w[i].w; } }
    LDS_WAIT(); asm volatile("" ::: "memory");
    const int c = lane & 7;
#pragma unroll
    for (int j = 0; j < 4; ++j) { const int n = (lane >> 3) + 8 * j; const LAS float* s = scr + (8 * c) * 33 + n;
        v4u o; o.x = pk2(s[0 * 33], s[1 * 33]); o.y = pk2(s[2 * 33], s[3 * 33]); o.z = pk2(s[4 * 33], s[5 * 33]); o.w = pk2(s[6 * 33], s[7 * 33]);
        __builtin_nontemporal_store(o, (GAS v4u*)(WT + (size_t)(drow0 + n) * Kdst + k0 + 8 * c)); }
    LDS_WAIT(); asm volatile("" ::: "memory");
}
__device__ __forceinline__ void tr_matrix(const Frame& F, const float* W, int K, int N, bf16* WT, int mode, int& first, int gw = -1, int NGW = 0) {
    LAS float* scr = (LAS float*)(F.lds + F.wave * 16384);
    if (gw < 0) { gw = F.vcu * NWAVES + F.wave; NGW = F.G * NWAVES; }
    const int nblk = N / 32, nitems = (K / 64) * nblk;
    int it = gw - (first % NGW); if (it < 0) it += NGW;
    for (; it < nitems; it += NGW) {
        const int kb = it / nblk, nb = it % nblk, n0 = 32 * nb;
        const int drow0 = mode == 0 ? n0 : ((n0 >> 7) * 256 + (n0 & 127) + (mode == 2 ? 128 : 0));
        tr_item(W, N, WT, K, 64 * kb, n0, drow0, scr, F.lane);
    }
    first += nitems;
}

constexpr int FOLD_TAB_OFF = 131072;
__device__ __forceinline__ void fold_table(Frame& F, const float* gain, const float* mx, const float* mc, int osh, int osc) {
    LAS float* tab = (LAS float*)(F.lds + FOLD_TAB_OFF);
    for (int k = F.tid; k < 1024; k += NTHR) { const float g = gain[k]; tab[k] = g * (1.0f + mx[osc + k]); tab[1024 + k] = g * (1.0f + mc[osc + k]); tab[2048 + k] = mx[osh + k]; tab[3072 + k] = mc[osh + k]; }
    __syncthreads();
}
__device__ __forceinline__ void tr_item_fold(const float* W, int N, bf16* WTl, bf16* WTc, int k0, int n0, int drow0, float* bl, float* bc, LAS float* scr, const LAS float* tab, int lane) {
    { f32x4 w[8];
#pragma unroll
      for (int i = 0; i < 8; ++i) w[i] = __builtin_nontemporal_load((const GAS f32x4*)(W + (size_t)(k0 + (lane >> 3) + 8 * i) * N + n0 + 4 * (lane & 7)));
#pragma unroll
      for (int i = 0; i < 8; ++i) { LAS float* d = scr + ((lane >> 3) + 8 * i) * 33 + 4 * (lane & 7); d[0] = w[i].x; d[1] = w[i].y; d[2] = w[i].z; d[3] = w[i].w; } }
    LDS_WAIT(); asm volatile("" ::: "memory");
    const int c = lane & 7;
    const LAS float* t = tab + k0 + 8 * c;
    const f32x4 al0 = *(const LAS f32x4*)t, al1 = *(const LAS f32x4*)(t + 4), ac0 = *(const LAS f32x4*)(t + 1024), ac1 = *(const LAS f32x4*)(t + 1028);
    const f32x4 sl0 = *(const LAS f32x4*)(t + 2048), sl1 = *(const LAS f32x4*)(t + 2052), sc0 = *(const LAS f32x4*)(t + 3072), sc1 = *(const LAS f32x4*)(t + 3076);
#pragma unroll
    for (int j = 0; j < 4; ++j) { const int n = (lane >> 3) + 8 * j; const LAS float* s = scr + (8 * c) * 33 + n;
        const f32x4 x0 = (f32x4){s[0 * 33], s[1 * 33], s[2 * 33], s[3 * 33]}, x1 = (f32x4){s[4 * 33], s[5 * 33], s[6 * 33], s[7 * 33]};
        const f32x4 a0 = x0 * al0, a1 = x1 * al1, b0 = x0 * ac0, b1 = x1 * ac1;
        v4u o; o.x = pk2(a0.x, a0.y); o.y = pk2(a0.z, a0.w); o.z = pk2(a1.x, a1.y); o.w = pk2(a1.z, a1.w);
        __builtin_nontemporal_store(o, (GAS v4u*)(WTl + (size_t)(drow0 + n) * 1024 + k0 + 8 * c));
        o.x = pk2(b0.x, b0.y); o.y = pk2(b0.z, b0.w); o.z = pk2(b1.x, b1.y); o.w = pk2(b1.z, b1.w);
        __builtin_nontemporal_store(o, (GAS v4u*)(WTc + (size_t)(drow0 + n) * 1024 + k0 + 8 * c));
        const f32x4 pl4 = x0 * sl0 + x1 * sl1, pc4 = x0 * sc0 + x1 * sc1;
        float pl = (pl4.x + pl4.y) + (pl4.z + pl4.w), pc = (pc4.x + pc4.y) + (pc4.z + pc4.w);
        pl = dpp_add<0xB1>(pl); pl = dpp_add<0x4E>(pl); pl = dpp_add<0x141>(pl);
        pc = dpp_add<0xB1>(pc); pc = dpp_add<0x4E>(pc); pc = dpp_add<0x141>(pc);
        if (c == 0) { unsafeAtomicAdd(bl + n0 + n, pl); unsafeAtomicAdd(bc + n0 + n, pc); } }
    LDS_WAIT(); asm volatile("" ::: "memory");
}
__device__ __forceinline__ void tr_matrix_fold(const Frame& F, const float* W, int N, bf16* WTl, bf16* WTc, int mode, float* bl, float* bc, int& first, int gw, int NGW) {
    LAS float* scr = (LAS float*)(F.lds + F.wave * 16384); const LAS float* tab = (const LAS float*)(F.lds + FOLD_TAB_OFF);
    const int nblk = N / 32, nitems = (D / 64) * nblk;
    int it = gw - (first % NGW); if (it < 0) it += NGW;
    for (; it < nitems; it += NGW) {
        const int kb = it / nblk, nb = it % nblk, n0 = 32 * nb;
        const int drow0 = mode == 0 ? n0 : ((n0 >> 7) * 256 + (n0 & 127) + (mode == 2 ? 128 : 0));
        tr_item_fold(W, N, WTl, WTc, 64 * kb, n0, drow0, bl, bc, scr, tab, F.lane);
    }
    first += nitems;
}
__device__ __forceinline__ void ph_convert_ffn(Frame& F, int gw, int NGW) {
    fold_table(F, F.in[I_N2G], modp(F, 0, 0), modp(F, 0, 1), M_SH2, M_SC2);
    float* BA = (float*)(F.ws + WS_BIASA);
    int first = 0;
    tr_matrix_fold(F, F.in[I_FFNG], DFF, (bf16*)(F.ws + WS_WFFNGU), (bf16*)(F.ws + WS_WCTX), 1, BA, BA + 2 * DFF, first, gw, NGW);
    tr_matrix_fold(F, F.in[I_FFNU], DFF, (bf16*)(F.ws + WS_WFFNGU), (bf16*)(F.ws + WS_WCTX), 2, BA + DFF, BA + 3 * DFF, first, gw, NGW);
    tr_matrix(F, F.in[I_FFND], DFF, D, (bf16*)(F.ws + WS_WFFND), 0, first, gw, NGW);
}
__device__ __forceinline__ void ph_convert_ssd(Frame& F, int gw, int NGW) {
    fold_table(F, F.in[I_N1G] + D, modp(F, 1, 0), modp(F, 1, 1), M_SH1, M_SC1);
    float* BB = (float*)(F.ws + WS_BIASB);
    int first = 0;
    tr_matrix_fold(F, F.in[I_SSDWIN], SSD_IN_REAL, (bf16*)(F.ws + WS_WSSDIN), (bf16*)(F.ws + WS_WCTX), 0, BB, BB + SSD_INP, first, gw, NGW);
    tr_matrix(F, F.in[I_SSDWOUT], DIN, D, (bf16*)(F.ws + WS_WSSDOUT), 0, first, gw, NGW);
    for (int v = 0; v < 2; ++v) { v4u* p = (v4u*)((bf16*)(F.ws + (v ? WS_WCTX : WS_WSSDIN)) + (size_t)SSD_IN_REAL * D); const int n16 = (SSD_INP - SSD_IN_REAL) * D * 2 / 16;
      for (int i = gw * 64 + F.lane; i < n16; i += NGW * 64) p[i] = (v4u){0u, 0u, 0u, 0u}; }
}
__device__ __forceinline__ void ph_prologue(Frame& F) {
    LAS float* scx = (LAS float*)F.lds;
    LAS float* scc = scx + 1024;
    LAS float* red = scc + 1024;
    const float* c = F.in[I_C]; const float* cc = F.in[I_CCTX];
    for (int i = F.tid; i < 1024; i += NTHR) { const float a = c[i], b = cc[i]; scx[i] = a * sigmoid_f(a); scc[i] = b * sigmoid_f(b); }
    __syncthreads();
    float* MOD = (float*)(F.ws + WS_MOD);
    for (int u = F.vcu; u < 192; u += F.G) {
        const int layer = u / 96, n0 = (u % 96) * 64;
        const float* W = F.in[I_ADAW] + (size_t)layer * 1024 * 6144 + n0 + F.lane;
        float ax = 0.f, ac = 0.f; const int kb = F.wave * 128;
#pragma unroll 1
        for (int k0 = 0; k0 < 128; k0 += 32) { float w[32];
#pragma unroll
            for (int k = 0; k < 32; ++k) w[k] = __builtin_nontemporal_load(W + (size_t)(kb + k0 + k) * 6144);
#pragma unroll
            for (int k = 0; k < 32; ++k) { ax += scx[kb + k0 + k] * w[k]; ac += scc[kb + k0 + k] * w[k]; } }
        red[(F.wave * 2 + 0) * 64 + F.lane] = ax; red[(F.wave * 2 + 1) * 64 + F.lane] = ac;
        __syncthreads();
        if (F.tid < 128) { const int s = F.tid >> 6, l = F.tid & 63; float t = 0.f;
#pragma unroll
            for (int w = 0; w < 8; ++w) t += red[(w * 2 + s) * 64 + l];
            MOD[(size_t)(layer * 2 + s) * 6144 + n0 + l] = t + F.in[I_ADAB][layer * 6144 + n0 + l]; }
        __syncthreads();
    }
    {
        float* ct = (float*)(F.ws + WS_ROPE); float* st = ct + 4096;
        for (int idx = F.vcu * NTHR + F.tid; idx < 4096; idx += F.G * NTHR) { const int pos = idx >> 4, i = idx & 15;
            const float inv = (float)pow(10000.0, -(double)i / 16.0); const float ang = (float)pos * inv;
            ct[idx] = (float)cos((double)ang); st[idx] = (float)sin((double)ang); }
    }
    { float* z = (float*)(F.ws + WS_SSQA); for (int i = F.vcu * NTHR + F.tid; i < 96 * 1024; i += F.G * NTHR) z[i] = 0.f; }
    __syncthreads();
    int first = 0;
    tr_matrix(F, F.in[I_ABWIN], D, AB_IN, (bf16*)(F.ws + WS_WABIN), 0, first);
    tr_matrix(F, F.in[I_ABWOUT], D, D, (bf16*)(F.ws + WS_WABOUT), 0, first);
}
constexpr int MOE_GU_ITEMS = NEXP * 2 * (D / 64) * (FFE / 32);
struct GuItem { const float* W; bf16* WT; int k0, n0, drow0; };
__device__ __forceinline__ GuItem gu_item(const Frame& F, int it) {
    constexpr int PER_M = (D / 64) * (FFE / 32), NB = FFE / 32;
    const int e = it / (2 * PER_M), rem = it % (2 * PER_M), mat = rem / PER_M, idx = rem % PER_M, kb = idx / NB, n0 = 32 * (idx % NB);
    GuItem g; g.W = (mat ? F.in[I_MOEU] : F.in[I_MOEG]) + (size_t)e * D * FFE; g.WT = (bf16*)(F.ws + WS_WMOE) + (size_t)e * 2 * FFE * D;
    g.k0 = 64 * kb; g.n0 = n0; g.drow0 = (n0 >> 7) * 256 + (n0 & 127) + (mat ? 128 : 0); return g;
}
__device__ __forceinline__ void moe_gu_convert(Frame& F, int lo, int hi, int gw, int NGW) {
    LAS float* scr = (LAS float*)(F.lds + F.wave * 16384);
    int it = lo + gw; if (it >= hi) return;
    f32x4 wa[8], wb[8];
    GuItem ga = gu_item(F, it), gb = ga; tr_load(ga.W, FFE, ga.k0, ga.n0, F.lane, wa);
    for (;;) {
        const int itb = it + NGW; const bool hb = itb < hi;
        if (hb) { gb = gu_item(F, itb); tr_load(gb.W, FFE, gb.k0, gb.n0, F.lane, wb); }
        tr_finish(wa, ga.WT, D, ga.k0, ga.drow0, scr, F.lane);
        if (!hb) break;
        it = itb + NGW; const bool ha = it < hi;
        if (ha) { ga = gu_item(F, it); tr_load(ga.W, FFE, ga.k0, ga.n0, F.lane, wa); }
        tr_finish(wb, gb.WT, D, gb.k0, gb.drow0, scr, F.lane);
        if (!ha) break;
    }
}
constexpr int MOE_DN_ITEMS = NEXP * (FFE / 64) * (D / 32), MOE_DN_PER_E = (FFE / 64) * (D / 32);
__device__ __forceinline__ void moe_dn_convert(Frame& F, int lo, int hi, int gw, int NGW) {
    LAS float* scr = (LAS float*)(F.lds + F.wave * 16384);
    for (int it = lo + gw; it < hi; it += NGW) {
        const int e = it / MOE_DN_PER_E, idx = it % MOE_DN_PER_E, kb = idx / (D / 32), n0 = 32 * (idx % (D / 32));
        bf16* WT = (bf16*)(F.ws + (e < 4 ? WS_WDA : WS_WDB)) + (size_t)(e & 3) * D * FFE;
        tr_item(F.in[I_MOED] + (size_t)e * FFE * D, D, WT, FFE, 64 * kb, n0, n0, scr, F.lane);
    }
}
__device__ __forceinline__ void idle_round_convert(Frame& F, int nunits, int lo, int hi) {
    const int full = nunits / F.G, nbusy = nunits - full * F.G;
    if ((int)blockIdx.x >= nbusy) moe_gu_convert(F, lo, hi, ((int)blockIdx.x - nbusy) * NWAVES + F.wave, (F.G - nbusy) * NWAVES);
}


template <bool BF> __device__ __forceinline__ void load_row4(const void* row, int lane, f32x4 (&v)[4]) {
    if (BF) { const GAS v2u* p = (const GAS v2u*)row + lane;
#pragma unroll
        for (int j = 0; j < 4; ++j) { const v2u a = p[64 * j]; v[j] = (f32x4){bflo(a.x), bfhi(a.x), bflo(a.y), bfhi(a.y)}; } }
    else { const GAS f32x4* p = (const GAS f32x4*)row + lane;
#pragma unroll
        for (int j = 0; j < 4; ++j) v[j] = __builtin_nontemporal_load(p + 64 * j); }
}
template <bool LAT_BF, bool CTX_BF, int NPART>
__device__ __forceinline__ void ph_modulate(Frame& F, const void* src0, const void* src1, const float* gain, const float* mx, const float* mc, int osh, int osc, bf16* H, int nrows,
                                            const float* part, const float* gatec, bf16* xw) {
    const int gw = F.vcu * NWAVES + F.wave, NGW = F.G * NWAVES;
    f32x4 ca[4], cb[4];
#pragma unroll
    for (int j = 0; j < 4; ++j) { const int c = 4 * (64 * j + F.lane); ca[j] = *(const f32x4*)(gain + c) * (*(const f32x4*)(mx + osc + c) + 1.0f); cb[j] = *(const f32x4*)(mx + osh + c); }
    for (int r0 = gw; r0 < nrows; r0 += 2 * NGW) {
        int rr[2]; f32x4 v[2][4];
#pragma unroll
        for (int k = 0; k < 2; ++k) { const int r = r0 + k * NGW; rr[k] = r < nrows ? r : r0;
            if (rr[k] < L) load_row4<LAT_BF>((const char*)src0 + (size_t)rr[k] * D * (LAT_BF ? 2 : 4), F.lane, v[k]);
            else load_row4<CTX_BF>((const char*)src1 + (size_t)(rr[k] - L) * D * (CTX_BF ? 2 : 4), F.lane, v[k]); }
#pragma unroll
        for (int k = 0; k < 2; ++k) { const int r = rr[k];
            if (NPART > 0 && r >= L) {
#pragma unroll
                for (int j = 0; j < 4; ++j) { const int c = 4 * (64 * j + F.lane); f32x4 s = (f32x4){0.f, 0.f, 0.f, 0.f};
#pragma unroll
                    for (int q = 0; q < NPART; ++q) s += *(const f32x4*)(part + ((size_t)q * LC + (r - L)) * D + c);
                    v[k][j] += *(const f32x4*)(gatec + c) * s;
                    if (xw) { v2u o; o.x = pk2(v[k][j].x, v[k][j].y); o.y = pk2(v[k][j].z, v[k][j].w); *(GAS v2u*)(xw + (size_t)r * D + c) = o; } }
            }
            float s2 = 0.f;
#pragma unroll
            for (int j = 0; j < 4; ++j) s2 += (v[k][j].x * v[k][j].x + v[k][j].y * v[k][j].y) + (v[k][j].z * v[k][j].z + v[k][j].w * v[k][j].w);
            const float rstd = __builtin_amdgcn_rsqf(wave_sum(s2) * (1.0f / D) + EPS);
            GAS v2u* o8 = (GAS v2u*)(H + (size_t)r * D) + F.lane;
#pragma unroll
            for (int j = 0; j < 4; ++j) { const int c = 4 * (64 * j + F.lane);
                f32x4 A = ca[j], B = cb[j];
                if (r >= L) { A = *(const f32x4*)(gain + c) * (*(const f32x4*)(mc + osc + c) + 1.0f); B = *(const f32x4*)(mc + osh + c); }
                const f32x4 y = v[k][j] * rstd * A + B;
                v2u o; o.x = pk2(y.x, y.y); o.y = pk2(y.z, y.w); o8[64 * j] = o; }
        }
    }
}
template <bool BASE_BF, int NPART>
__device__ __forceinline__ void ctx_reduce(Frame& F, int nu, int cw, const void* base, const float* gatec, bf16* X, float* ssq) {
    const int c = (int)blockIdx.x, nP = nu < F.G ? nu : F.G;
    if (c >= nP) return;
    unsigned* ctl = (unsigned*)(F.ws + WS_CTL); const float* part = (const float*)(F.ws + WS_PART);
    VM_WAIT(); __syncthreads();
    if (F.tid == 0) {
        unsigned mine = 0; for (int x = c; x < nu; x += F.G) ++mine;
        __builtin_amdgcn_fence(__ATOMIC_RELEASE, "agent"); VM_WAIT();
        (void)xb_add(&ctl[cw], mine);
        XB_SPIN(xb_ld(&ctl[cw]) < (unsigned)nu, ctl + CW_BAR);
        __builtin_amdgcn_fence(__ATOMIC_ACQUIRE, "agent"); VM_WAIT();
    }
    __syncthreads();
    for (int r = c * NWAVES + F.wave; r < LC; r += nP * NWAVES) {
        f32x4 v[4]; load_row4<BASE_BF>((const char*)base + (size_t)r * D * (BASE_BF ? 2 : 4), F.lane, v);
        float s2 = 0.f;
#pragma unroll
        for (int j = 0; j < 4; ++j) { const int cc = 4 * (64 * j + F.lane); f32x4 s = (f32x4){0.f, 0.f, 0.f, 0.f};
#pragma unroll
            for (int q = 0; q < NPART; ++q) s += *(const f32x4*)(part + ((size_t)q * LC + r) * D + cc);
            v[j] += *(const f32x4*)(gatec + cc) * s;
            s2 += (v[j].x * v[j].x + v[j].y * v[j].y) + (v[j].z * v[j].z + v[j].w * v[j].w);
            v2u o; o.x = pk2(v[j].x, v[j].y); o.y = pk2(v[j].z, v[j].w); *(GAS v2u*)(X + (size_t)(L + r) * D + cc) = o; }
        s2 = wave_sum(s2);
        if (F.lane == 0) ssq[L + r] = s2;
    }
}

constexpr float QSCL = 0.125f * 1.4426950408889634f;
__device__ __forceinline__ void ph_ab_elem(Frame& F) {
    const bf16* PAB = (const bf16*)(F.ws + WS_PAB); bf16* MIX = (bf16*)(F.ws + WS_MIX);
    bf16* QR = (bf16*)(F.ws + WS_QR); bf16* KR = (bf16*)(F.ws + WS_KR); bf16* VT = (bf16*)(F.ws + WS_VT);
    const float* ct = (const float*)(F.ws + WS_ROPE); const float* st = ct + 4096;
    const int lane = F.lane;
    float cw[3][8];
#pragma unroll
    for (int k = 0; k < 3; ++k)
#pragma unroll
        for (int j = 0; j < 8; ++j) cw[k][j] = F.in[I_ABCONV][k * 512 + 8 * lane + j];
    LAS unsigned char* vl = F.lds;
    for (int tile = F.vcu; tile < MT / 16; tile += F.G) {
        const int r0 = tile * 16; const bool isctx = r0 >= L; const int slo = isctx ? L : 0, shi = isctx ? MT : L;
        for (int rr = 0; rr < 2; ++rr) {
            const int r = r0 + F.wave * 2 + rr;
            float acc[8];
#pragma unroll
            for (int j = 0; j < 8; ++j) acc[j] = 0.f;
#pragma unroll
            for (int k = 0; k < 3; ++k) { const int q = r + k - 1;
                if (q >= slo && q < shi) { const v4u gc = *(const GAS v4u*)(PAB + (size_t)q * AB_IN + 512 + 8 * lane), ha = *(const GAS v4u*)(PAB + (size_t)q * AB_IN + 1024 + 8 * lane);
                    acc[0] += cw[k][0] * bflo(gc.x) * bflo(ha.x); acc[1] += cw[k][1] * bfhi(gc.x) * bfhi(ha.x); acc[2] += cw[k][2] * bflo(gc.y) * bflo(ha.y); acc[3] += cw[k][3] * bfhi(gc.y) * bfhi(ha.y);
                    acc[4] += cw[k][4] * bflo(gc.z) * bflo(ha.z); acc[5] += cw[k][5] * bfhi(gc.z) * bfhi(ha.z); acc[6] += cw[k][6] * bflo(gc.w) * bflo(ha.w); acc[7] += cw[k][7] * bfhi(gc.w) * bfhi(ha.w); } }
            { const v4u gb = *(const GAS v4u*)(PAB + (size_t)r * AB_IN + 8 * lane); v4u o;
              o.x = pk2(acc[0] * bflo(gb.x), acc[1] * bfhi(gb.x)); o.y = pk2(acc[2] * bflo(gb.y), acc[3] * bfhi(gb.y)); o.z = pk2(acc[4] * bflo(gb.z), acc[5] * bfhi(gb.z)); o.w = pk2(acc[6] * bflo(gb.w), acc[7] * bfhi(gb.w));
              *(GAS v4u*)(MIX + (size_t)r * D + 8 * lane) = o; }
            const int sub = lane & 7, axis = sub >> 2, half = (sub >> 1) & 1;
            const int pos = axis == 0 ? (r >> 6) : (r & 63);
            f32x4 c0 = (f32x4){1.f, 1.f, 1.f, 1.f}, c1 = c0, s0 = (f32x4){0.f, 0.f, 0.f, 0.f}, s1 = s0;
            if (!isctx) { const float* cp = ct + pos * 16 + 8 * (lane & 1); const float* sp = st + pos * 16 + 8 * (lane & 1);
                c0 = *(const f32x4*)cp; c1 = *(const f32x4*)(cp + 4); s0 = *(const f32x4*)sp; s1 = *(const f32x4*)(sp + 4);
                if (half == 0) { s0 = -s0; s1 = -s1; } }
            {
                const v4u a = *(const GAS v4u*)(PAB + (size_t)r * AB_IN + 1536 + 8 * lane);
                v4u p; p.x = (unsigned)__builtin_amdgcn_update_dpp(0, (int)a.x, 0x4E, 0xf, 0xf, true); p.y = (unsigned)__builtin_amdgcn_update_dpp(0, (int)a.y, 0x4E, 0xf, 0xf, true); p.z = (unsigned)__builtin_amdgcn_update_dpp(0, (int)a.z, 0x4E, 0xf, 0xf, true); p.w = (unsigned)__builtin_amdgcn_update_dpp(0, (int)a.w, 0x4E, 0xf, 0xf, true);
                const f32x4 qc0 = c0 * QSCL, qc1 = c1 * QSCL, qs0 = s0 * QSCL, qs1 = s1 * QSCL;
                v4u o; o.x = pk2(bflo(a.x) * qc0.x + bflo(p.x) * qs0.x, bfhi(a.x) * qc0.y + bfhi(p.x) * qs0.y); o.y = pk2(bflo(a.y) * qc0.z + bflo(p.y) * qs0.z, bfhi(a.y) * qc0.w + bfhi(p.y) * qs0.w);
                o.z = pk2(bflo(a.z) * qc1.x + bflo(p.z) * qs1.x, bfhi(a.z) * qc1.y + bfhi(p.z) * qs1.y); o.w = pk2(bflo(a.w) * qc1.z + bflo(p.w) * qs1.z, bfhi(a.w) * qc1.w + bfhi(p.w) * qs1.w);
                *(GAS v4u*)(QR + ((size_t)(lane >> 3) * MT + r) * 64 + 8 * sub) = o;
            }
            {
                const int kl = lane & 15;
                const v4u a = *(const GAS v4u*)(PAB + (size_t)r * AB_IN + 2048 + 8 * kl);
                v4u p; p.x = (unsigned)__builtin_amdgcn_update_dpp(0, (int)a.x, 0x4E, 0xf, 0xf, true); p.y = (unsigned)__builtin_amdgcn_update_dpp(0, (int)a.y, 0x4E, 0xf, 0xf, true); p.z = (unsigned)__builtin_amdgcn_update_dpp(0, (int)a.z, 0x4E, 0xf, 0xf, true); p.w = (unsigned)__builtin_amdgcn_update_dpp(0, (int)a.w, 0x4E, 0xf, 0xf, true);
                v4u o; o.x = pk2(bflo(a.x) * c0.x + bflo(p.x) * s0.x, bfhi(a.x) * c0.y + bfhi(p.x) * s0.y); o.y = pk2(bflo(a.y) * c0.z + bflo(p.y) * s0.z, bfhi(a.y) * c0.w + bfhi(p.y) * s0.w);
                o.z = pk2(bflo(a.z) * c1.x + bflo(p.z) * s1.x, bfhi(a.z) * c1.y + bfhi(p.z) * s1.y); o.w = pk2(bflo(a.w) * c1.z + bflo(p.w) * s1.z, bfhi(a.w) * c1.w + bfhi(p.w) * s1.w);
                if (lane < 16) *(GAS v4u*)(KR + ((size_t)(lane >> 3) * MT + r) * 64 + 8 * sub) = o;
            }
        }
        if (F.tid < 256) { const int p = F.tid, row = p >> 4, c8 = (p & 15) * 8;
            *(LAS v4u*)(vl + row * 272 + c8 * 2) = *(const GAS v4u*)(PAB + (size_t)(r0 + row) * AB_IN + 2176 + c8); }
        __syncthreads();
        if (F.tid < 256) { const int p = F.tid, ch = p >> 1, rg = p & 1;
            const LAS bf16* s = (const LAS bf16*)(vl + (8 * rg) * 272 + ch * 2);
            v4u o; o.x = (unsigned)s[0] | ((unsigned)s[136] << 16); o.y = (unsigned)s[2 * 136] | ((unsigned)s[3 * 136] << 16); o.z = (unsigned)s[4 * 136] | ((unsigned)s[5 * 136] << 16); o.w = (unsigned)s[6 * 136] | ((unsigned)s[7 * 136] << 16);
            *(GAS v4u*)(VT + (size_t)ch * MT + r0 + 8 * rg) = o; }
        __syncthreads();
    }
}


__device__ __forceinline__ void ph_ssd_conv(Frame& F) {
    const bf16* XB = (const bf16*)(F.ws + WS_XBCR);
    bf16* XT = (bf16*)(F.ws + WS_XT); bf16* BT = (bf16*)(F.ws + WS_BT); bf16* BMm = (bf16*)(F.ws + WS_BM); bf16* CMm = (bf16*)(F.ws + WS_CM);
    const float* cwp = F.in[I_SSDCW]; const float* cbp = F.in[I_SSDCB];
    LAS unsigned char* tl = F.lds;
    { const float* DR = (const float*)(F.ws + WS_DTRAW); float* DTF = (float*)(F.ws + WS_DTS); float* DTB = DTF + (size_t)32 * MT;
      const int gw = F.vcu * NWAVES + F.wave, NGW = F.G * NWAVES;
      for (int task = gw; task < (MT / 64) * 4; task += NGW) { const int tb = task >> 2, jq = task & 3; const int t = tb * 64 + F.lane; const float* row = DR + (size_t)t * 64;
#pragma unroll
          for (int j4 = 4 * jq; j4 < 4 * jq + 4; ++j4) { const f32x4 r = *(const f32x4*)(row + 4 * j4);
#pragma unroll
              for (int q = 0; q < 4; ++q) { const int j = 4 * j4 + q; const float v = softplus_f(r[q] + (j < 32 ? F.in[I_DTBF][j] : F.in[I_DTBB][j - 32]));
                  if (j < 32) DTF[(size_t)j * MT + t] = v; else DTB[(size_t)(j - 32) * MT + t] = v; } } } }
    LAS float* cwl = (LAS float*)(F.lds + 130 * 272 + 64);
    for (int i = F.tid; i < 3 * XBCW; i += NTHR) cwl[i] = cwp[i];
    for (int i = F.tid; i < XBCW; i += NTHR) cwl[3 * XBCW + i] = cbp[i];
    __syncthreads();
    const int ntiles = NCH * 24;
    v4u pre[5];
#define CONV_LOAD(tile_) do { const int c_ = (tile_) / 24, cb_ = (tile_) % 24, t0_ = c_ * 128, ch0_ = cb_ * 128; const int slo_ = c_ < 128 ? 0 : L, shi_ = c_ < 128 ? L : MT; \
        _Pragma("unroll") for (int i_ = 0; i_ < 5; ++i_) { const int p_ = F.tid + NTHR * i_, row_ = p_ >> 4, c8_ = (p_ & 15) * 8; const int t_ = t0_ - 1 + row_; \
            pre[i_] = (v4u){0u, 0u, 0u, 0u}; if (p_ < 130 * 16 && t_ >= slo_ && t_ < shi_) pre[i_] = __builtin_nontemporal_load((const GAS v4u*)(XB + (size_t)t_ * XBCW + ch0_ + c8_)); } } while (0)
    int tile = F.vcu;
    if (tile < ntiles) CONV_LOAD(tile);
    for (; tile < ntiles; tile += F.G) {
        const int c = tile / 24, cb = tile % 24, t0 = c * 128, ch0 = cb * 128;
#pragma unroll
        for (int i = 0; i < 5; ++i) { const int p = F.tid + NTHR * i, row = p >> 4, c8 = (p & 15) * 8; if (p < 130 * 16) *(LAS v4u*)(tl + row * 272 + ((c8 * 2) ^ (((row >> 3) & 7) << 4))) = pre[i]; }
        __syncthreads();
        if (tile + F.G < ntiles) CONV_LOAD(tile + F.G);
        if (cb < 20) {
            bf16* dst = BT + (size_t)(ch0 - 2048) * MT;
#pragma unroll
            for (int i = 0; i < 4; ++i) { const int p = F.tid + NTHR * i, ch = p >> 4, tg = p & 15;
                const float w0 = cwl[ch0 + ch], w1 = cwl[XBCW + ch0 + ch], w2 = cwl[2 * XBCW + ch0 + ch], bb = cwl[3 * XBCW + ch0 + ch];
                float xin[10];
#pragma unroll
                for (int j = 0; j < 10; ++j) { const int row = 8 * tg + j; xin[j] = bf1(*(const LAS bf16*)(tl + row * 272 + ((ch * 2) ^ (((row >> 3) & 7) << 4)))); }
                float y[8];
#pragma unroll
                for (int j = 0; j < 8; ++j) { const float a = w0 * xin[j] + w1 * xin[j + 1] + w2 * xin[j + 2] + bb; y[j] = a * sigmoid_f(a); }
                v4u o; o.x = pk2(y[0], y[1]); o.y = pk2(y[2], y[3]); o.z = pk2(y[4], y[5]); o.w = pk2(y[6], y[7]);
                if (cb < 16) { const int cg_ = ch0 + ch, hd = cg_ >> 6, p_ = cg_ & 63, ptq = 2 * (p_ >> 5) + ((p_ >> 2) & 1), rq = 4 * ((p_ >> 3) & 3) + (p_ & 3);
                    *(GAS v4u*)(XT + ((size_t)(((hd * NCH + c) * 4 + (tg >> 2)) * 4 + ptq) * 16 + rq) * 32 + 8 * (tg & 3)) = o; }
                else *(GAS v4u*)(dst + (size_t)ch * MT + t0 + 8 * tg) = o; }
        }
        if (cb >= 16) {
            bf16* dst = cb < 20 ? BMm + (ch0 - 2048) : CMm + (ch0 - 2560);
#pragma unroll
            for (int i = 0; i < 4; ++i) { const int p = F.tid + NTHR * i, row = p >> 4, cg = p & 15;
                const v4u a0 = *(const LAS v4u*)(tl + row * 272 + ((cg * 16) ^ (((row >> 3) & 7) << 4))), a1 = *(const LAS v4u*)(tl + (row + 1) * 272 + ((cg * 16) ^ ((((row + 1) >> 3) & 7) << 4))), a2 = *(const LAS v4u*)(tl + (row + 2) * 272 + ((cg * 16) ^ ((((row + 2) >> 3) & 7) << 4)));
                const LAS float* w0 = cwl + ch0 + 8 * cg; const LAS float* w1 = w0 + XBCW; const LAS float* w2 = w1 + XBCW; const LAS float* bb = w2 + XBCW;
                float y[8];
#define CV(j, f, q) { const float a = w0[j] * f(a0.q) + w1[j] * f(a1.q) + w2[j] * f(a2.q) + bb[j]; y[j] = a * sigmoid_f(a); }
                CV(0, bflo, x) CV(1, bfhi, x) CV(2, bflo, y) CV(3, bfhi, y) CV(4, bflo, z) CV(5, bfhi, z) CV(6, bflo, w) CV(7, bfhi, w)
#undef CV
                v4u o; o.x = pk2(y[0], y[1]); o.y = pk2(y[2], y[3]); o.z = pk2(y[4], y[5]); o.w = pk2(y[6], y[7]);
                *(GAS v4u*)(dst + (size_t)(t0 + row) * 512 + 8 * cg) = o; }
        }
        __syncthreads();
    }
#undef CONV_LOAD
    { const int full = ntiles / F.G, nbusy = ntiles - full * F.G; __syncthreads();
      if (F.vcu >= nbusy) moe_dn_convert(F, 0, 1900, (F.vcu - nbusy) * NWAVES + F.wave, (F.G - nbusy) * NWAVES); }
}

__device__ __forceinline__ void ph_moe_route(Frame& F) {
    LAS float* R = (LAS float*)F.lds;
    for (int i = F.tid; i < 8192; i += NTHR) R[(i & 7) * 1024 + (i >> 3)] = F.in[I_ROUTER][i];
    __syncthreads();
    const bf16* X = (const bf16*)(F.ws + WS_X); float* RS = (float*)(F.ws + WS_RSTD);
    int* TE = (int*)(F.ws + WS_TOKE); float* TW = (float*)(F.ws + WS_TOKW); int* HIST = (int*)(F.ws + WS_CTL) + CW_HIST;
    const float* gain = F.in[I_N2G] + D; const float* m = modp(F, 1, 0);
    const int gw = F.vcu * NWAVES + F.wave, NGW = F.G * NWAVES;
    f32x4 ca[4], cb[4];
#pragma unroll
    for (int j = 0; j < 4; ++j) { const int c = 4 * (64 * j + F.lane); ca[j] = *(const f32x4*)(gain + c) * (*(const f32x4*)(m + M_SC2 + c) + 1.0f); cb[j] = *(const f32x4*)(m + M_SH2 + c); }
    for (int r = gw; r < L; r += NGW) {
        f32x4 v[4]; float s2 = 0.f;
        load_row4<true>(X + (size_t)r * D, F.lane, v);
#pragma unroll
        for (int j = 0; j < 4; ++j) s2 += (v[j].x * v[j].x + v[j].y * v[j].y) + (v[j].z * v[j].z + v[j].w * v[j].w);
        const float rstd = 1.0f / sqrtf(wave_sum(s2) * (1.0f / D) + EPS);
        float lg[8];
#pragma unroll
        for (int e = 0; e < 8; ++e) lg[e] = 0.f;
#pragma unroll
        for (int j = 0; j < 4; ++j) { const int c = 4 * (64 * j + F.lane);
            const f32x4 y = v[j] * rstd * ca[j] + cb[j];
#pragma unroll
            for (int e = 0; e < 8; ++e) { const f32x4 rr = *(const LAS f32x4*)(R + e * 1024 + c); lg[e] += (y.x * rr.x + y.y * rr.y) + (y.z * rr.z + y.w * rr.w); } }
#pragma unroll
        for (int e = 0; e < 8; ++e) lg[e] = wave_sum(lg[e]);
        int e0 = 0; float v0 = lg[0];
#pragma unroll
        for (int e = 1; e < 8; ++e) if (lg[e] > v0) { v0 = lg[e]; e0 = e; }
        int e1 = -1; float v1 = -3.0e38f;
#pragma unroll
        for (int e = 0; e < 8; ++e) if (e != e0 && lg[e] > v1) { v1 = lg[e]; e1 = e; }
        if (F.lane == 0) { const float ex = __expf(v1 - v0), w0 = 1.0f / (1.0f + ex); RS[r] = rstd;
            TE[2 * r] = e0; TE[2 * r + 1] = e1; TW[2 * r] = w0; TW[2 * r + 1] = ex * w0;
            atomicAdd(&HIST[(r >> 8) * 8 + e0], 1); atomicAdd(&HIST[(r >> 8) * 8 + e1], 1); }
    }
}
__device__ __forceinline__ void moe_segments(Frame& F, LAS int* hist, LAS int* cnt, LAS int* seg) {
    const int* HIST = (const int*)(F.ws + WS_CTL) + CW_HIST;
    if (F.tid < 512) hist[F.tid] = HIST[F.tid];
    __syncthreads();
    if (F.tid < 8) { int s = 0; for (int t = 0; t < 64; ++t) s += hist[t * 8 + F.tid]; cnt[F.tid] = s; }
    __syncthreads();
    if (F.tid == 0) { int s = 0; for (int e = 0; e < 8; ++e) { seg[e] = s; s += (cnt[e] + 255) & ~255; } seg[8] = s; }
    __syncthreads();
}
__device__ __forceinline__ void ph_moe_scatter(Frame& F) {
    LAS int* hist = (LAS int*)F.lds; LAS int* cnt = hist + 512; LAS int* seg = cnt + 8; LAS int* base = seg + 16; LAS int* wcnt = base + 8; LAS int* epos = wcnt + 64;
    moe_segments(F, hist, cnt, seg);
    const int* TE = (const int*)(F.ws + WS_TOKE); int* TP = (int*)(F.ws + WS_TOKP);
    const bf16* X = (const bf16*)(F.ws + WS_X); const float* RS = (const float*)(F.ws + WS_RSTD); bf16* H2S = (bf16*)(F.ws + WS_H2S);
    f32x4 ca[4], cb[4];
    { const float* gain = F.in[I_N2G] + D; const float* m = modp(F, 1, 0);
#pragma unroll
      for (int j = 0; j < 4; ++j) { const int c = 4 * (64 * j + F.lane); ca[j] = *(const f32x4*)(gain + c) * (*(const f32x4*)(m + M_SC2 + c) + 1.0f); cb[j] = *(const f32x4*)(m + M_SH2 + c); } }
    for (int uu = F.vcu; uu < 264; uu += F.G) {
        if (uu < 256) {
            const int u = uu >> 2, qtr = uu & 3;
            if (F.tid < 8) { int s = seg[F.tid]; for (int t = 0; t < u; ++t) s += hist[t * 8 + F.tid]; base[F.tid] = s; }
            const int ent = u * 512 + F.tid;
            const int ex = TE[ent];
            int rank = 0;
#pragma unroll
            for (int e = 0; e < 8; ++e) { const unsigned long long mk = __ballot(ex == e);
                if (ex == e) rank = __popcll(mk & ((1ull << F.lane) - 1ull));
                if (F.lane == 0) wcnt[F.wave * 8 + e] = __popcll(mk); }
            __syncthreads();
            int pos = base[ex] + rank;
            for (int w = 0; w < F.wave; ++w) pos += wcnt[w * 8 + ex];
            if (qtr == 0) TP[ent] = pos;
            epos[F.tid] = pos;
            __syncthreads();
            for (int t0_ = 64 * qtr + F.wave; t0_ < 64 * qtr + 64; t0_ += 2 * NWAVES) {
                f32x4 xv[2][4]; float rs[2]; int d0[2], d1[2];
#pragma unroll
                for (int k = 0; k < 2; ++k) { const int ti = t0_ + k * NWAVES, tok = u * 256 + ti; load_row4<true>(X + (size_t)tok * D, F.lane, xv[k]); rs[k] = RS[tok]; d0[k] = epos[2 * ti]; d1[k] = epos[2 * ti + 1]; }
#pragma unroll
                for (int k = 0; k < 2; ++k) { GAS v2u* o0 = (GAS v2u*)(H2S + (size_t)d0[k] * D) + F.lane; GAS v2u* o1 = (GAS v2u*)(H2S + (size_t)d1[k] * D) + F.lane;
#pragma unroll
                    for (int j = 0; j < 4; ++j) { const f32x4 y = xv[k][j] * rs[k] * ca[j] + cb[j]; v2u o; o.x = pk2(y.x, y.y); o.y = pk2(y.z, y.w); o0[64 * j] = o; o1[64 * j] = o; } } }
            __syncthreads();
        } else {
            const int e = uu - 256, lo = seg[e] + cnt[e], hi = seg[e + 1];
            GAS v4u* d = (GAS v4u*)(H2S + (size_t)lo * D); const int n16 = (hi - lo) * (D * 2 / 16);
            for (int i = F.tid; i < n16; i += NTHR) d[i] = (v4u){0u, 0u, 0u, 0u};
        }
    }
}
__device__ __forceinline__ void ph_final(Frame& F) {
    const bf16* X = (const bf16*)(F.ws + WS_X); const bf16* YO = (const bf16*)(F.ws + WS_H2S);
    const int* TP = (const int*)(F.ws + WS_TOKP); const float* TW = (const float*)(F.ws + WS_TOKW);
    const float* g2 = modp(F, 1, 0) + M_G2; const float* fg = F.in[I_FINALG];
    const float* YP = (const float*)(F.ws + WS_YPART);
    const int gw = F.vcu * NWAVES + F.wave, NGW = F.G * NWAVES;
    f32x4 cg[4], cf[4];
#pragma unroll
    for (int j = 0; j < 4; ++j) { const int c = 4 * (64 * j + F.lane); cg[j] = *(const f32x4*)(g2 + c); cf[j] = *(const f32x4*)(fg + c); }
    for (int r0 = gw; r0 < L; r0 += 2 * NGW) {
        int rr[2], pa[2], pb[2]; float wa[2], wb[2]; f32x4 xv[2][4]; v2u ya[2][4], yb[2][4];
#pragma unroll
        for (int k = 0; k < 2; ++k) { const int r = r0 + k * NGW; rr[k] = r < L ? r : r0; pa[k] = TP[2 * rr[k]]; pb[k] = TP[2 * rr[k] + 1]; wa[k] = TW[2 * rr[k]]; wb[k] = TW[2 * rr[k] + 1]; }
#pragma unroll
        for (int k = 0; k < 2; ++k) { load_row4<true>(X + (size_t)rr[k] * D, F.lane, xv[k]);
            const GAS v2u* y0 = (const GAS v2u*)(YO + (size_t)pa[k] * D) + F.lane; const GAS v2u* y1 = (const GAS v2u*)(YO + (size_t)pb[k] * D) + F.lane;
#pragma unroll
            for (int j = 0; j < 4; ++j) { ya[k][j] = __builtin_nontemporal_load(y0 + 64 * j); yb[k][j] = __builtin_nontemporal_load(y1 + 64 * j); } }
#pragma unroll
        for (int k = 0; k < 2; ++k) { const int r = rr[k], p0 = pa[k], p1 = pb[k]; const float w0 = wa[k], w1 = wb[k];
            f32x4 v[4]; float s2 = 0.f;
#pragma unroll
            for (int j = 0; j < 4; ++j) { const int c = 4 * (64 * j + F.lane); const v2u a = ya[k][j], b = yb[k][j]; const f32x4 g = cg[j];
                f32x4 fa = (f32x4){bflo(a.x), bfhi(a.x), bflo(a.y), bfhi(a.y)}, fb = (f32x4){bflo(b.x), bfhi(b.x), bflo(b.y), bfhi(b.y)};
                if (p0 >= 32768) { fa = (f32x4){0.f, 0.f, 0.f, 0.f}; for (int q = 0; q < 7; ++q) fa += *(const f32x4*)(YP + ((size_t)q * 2048 + (p0 - 32768)) * D + c); }
                if (p1 >= 32768) { fb = (f32x4){0.f, 0.f, 0.f, 0.f}; for (int q = 0; q < 7; ++q) fb += *(const f32x4*)(YP + ((size_t)q * 2048 + (p1 - 32768)) * D + c); }
                const f32x4 f = fa * w0 + fb * w1;
                v[j] = xv[k][j] + g * f; s2 += (v[j].x * v[j].x + v[j].y * v[j].y) + (v[j].z * v[j].z + v[j].w * v[j].w); }
            const float rstd = 1.0f / sqrtf(wave_sum(s2) * (1.0f / D) + EPS);
            GAS f32x4* o = (GAS f32x4*)(F.out + (size_t)r * D) + F.lane;
#pragma unroll
            for (int j = 0; j < 4; ++j) __builtin_nontemporal_store(v[j] * rstd * cf[j], &o[64 * j]);
        }
    }
}


typedef short bf16x8v __attribute__((ext_vector_type(8)));
__device__ __forceinline__ bf16x8v as_frag(v4u a) { return __builtin_bit_cast(bf16x8v, a); }
constexpr float LOG2E_ = 1.4426950408889634f;
#define MFMA16(a, b, c) __builtin_amdgcn_mfma_f32_16x16x32_bf16((a), (b), (c), 0, 0, 0)
__device__ __forceinline__ int prm_row(int i2, int par, int r) { return 32 * i2 + 8 * (r >> 2) + 4 * par + (r & 3); }

__device__ __forceinline__ void ph_ssd_s1(Frame& F) {
    const bf16* XT = (const bf16*)(F.ws + WS_XT); const bf16* BT = (const bf16*)(F.ws + WS_BT);
    const float* DTF = (const float*)(F.ws + WS_DTS); const float* DTB = DTF + (size_t)32 * MT; float* CUMF = (float*)(DTB + (size_t)32 * MT); float* CUMB = CUMF + (size_t)32 * MT;
    float* DEC = (float*)(F.ws + WS_DEC); bf16* ST = (bf16*)(F.ws + WS_STATES);
    LAS unsigned char* btl = F.lds;
    LAS float* wtab = (LAS float*)(F.lds + 128 * 272);
    LAS float* wtot = wtab + 1024;
    const int lane = F.lane, r16 = lane & 15, gq = lane >> 4;
    v4u nbt[4]; float ndtf = 0.f, ndtb = 0.f;
#define S1_PREFETCH(u_) do { const int c_ = (u_) >> 3, g_ = ((u_) >> 1) & 3, hh_ = (u_) & 1, t0_ = c_ * 128; int tq_ = F.tid; asm volatile("" : "+v"(tq_)); \
        _Pragma("unroll") for (int i_ = 0; i_ < 4; ++i_) { const int p_ = tq_ + NTHR * i_, n_ = p_ >> 4, c8_ = (p_ & 15) * 8; nbt[i_] = *(const GAS v4u*)(BT + (size_t)(g_ * 128 + n_) * MT + t0_ + c8_); } \
        { const int h_ = 8 * g_ + 4 * hh_ + (tq_ >> 7); ndtf = DTF[(size_t)h_ * MT + t0_ + (tq_ & 127)]; ndtb = DTB[(size_t)h_ * MT + t0_ + (tq_ & 127)]; } } while (0)
    if (F.vcu < NCH * 8) S1_PREFETCH(F.vcu);
    for (int u = F.vcu; u < NCH * 8; u += F.G) {
        const int c = u >> 3, g = (u >> 1) & 3, hh = u & 1, t0 = c * 128;
        int tid_ = F.tid; asm volatile("" : "+v"(tid_));
        v4u xr[4][4];
        { const int hx = 8 * g + 4 * hh + (F.wave >> 1);
#pragma unroll
          for (int ks = 0; ks < 4; ++ks)
#pragma unroll
            for (int pt = 0; pt < 4; ++pt) xr[ks][pt] = *(const GAS v4u*)(XT + ((size_t)(((hx * NCH + c) * 4 + ks) * 4 + pt) * 16 + r16) * 32 + 8 * gq); }
#pragma unroll
        for (int i = 0; i < 4; ++i) { const int p = tid_ + NTHR * i, n = p >> 4, c8 = (p & 15) * 8; *(LAS v4u*)(btl + n * 272 + c8 * 2) = nbt[i]; }
        {
            const int j = tid_ >> 7, l = tid_ & 127, h = 8 * g + 4 * hh + j;
            const float dtf = ndtf, dtb = ndtb;
            const float Af = -__expf(F.in[I_ALOGF][h]), Ab = -__expf(F.in[I_ALOGB][h]);
            const float af = dtf * Af, ab = dtb * Ab;
            float pf = af, pb = ab;
#pragma unroll
            for (int o = 1; o < 64; o <<= 1) { const float a = __shfl_up(pf, o), b = __shfl_up(pb, o); if (lane >= o) { pf += a; pb += b; } }
            if (lane == 63) { wtot[F.wave * 2] = pf; wtot[F.wave * 2 + 1] = pb; }
            __syncthreads();
            const float tf0 = wtot[(2 * j) * 2], tb0 = wtot[(2 * j) * 2 + 1], Tf = tf0 + wtot[(2 * j + 1) * 2], Tb = tb0 + wtot[(2 * j + 1) * 2 + 1];
            if (F.wave & 1) { pf += tf0; pb += tb0; }
            const float cf = pf, cb = Tb - pb + ab;
            CUMF[(size_t)h * MT + t0 + l] = cf; CUMB[(size_t)h * MT + t0 + l] = cb;
            wtab[(j * 2 + 0) * 128 + l] = __expf(Tf - cf) * dtf; wtab[(j * 2 + 1) * 128 + l] = __expf(Tb - cb) * dtb;
            if (l == 0) { DEC[(0 * NCH + c) * 32 + h] = __expf(Tf); DEC[(1 * NCH + c) * 32 + h] = __expf(Tb); }
        }
        __syncthreads();
        {
            const int j = F.wave >> 1, dir = F.wave & 1, h = 8 * g + 4 * hh + j;
            f32x4 acc[8][4];
#pragma unroll
            for (int a = 0; a < 8; ++a)
#pragma unroll
                for (int b = 0; b < 4; ++b) acc[a][b] = (f32x4){0.f, 0.f, 0.f, 0.f};
            const LAS float* wt = wtab + (j * 2 + dir) * 128;
            if (u + F.G < NCH * 8) S1_PREFETCH(u + F.G);
#pragma unroll
            for (int ks = 0; ks < 4; ++ks) {
                const f32x4 w0 = *(const LAS f32x4*)(wt + 32 * ks + 8 * gq), w1 = *(const LAS f32x4*)(wt + 32 * ks + 8 * gq + 4);
                bf16x8v bfr[4];
#pragma unroll
                for (int pt = 0; pt < 4; ++pt) { const v4u x = xr[ks][pt];
                    v4u y; y.x = pk2(bflo(x.x) * w0.x, bfhi(x.x) * w0.y); y.y = pk2(bflo(x.y) * w0.z, bfhi(x.y) * w0.w); y.z = pk2(bflo(x.z) * w1.x, bfhi(x.z) * w1.y); y.w = pk2(bflo(x.w) * w1.z, bfhi(x.w) * w1.w);
                    bfr[pt] = as_frag(y); }
#pragma unroll
                for (int nt = 0; nt < 8; ++nt) { const bf16x8v af = as_frag(*(const LAS v4u*)(btl + prm_row(nt >> 1, nt & 1, r16) * 272 + (32 * ks + 8 * gq) * 2));
#pragma unroll
                    for (int pt = 0; pt < 4; ++pt) acc[nt][pt] = MFMA16(af, bfr[pt], acc[nt][pt]); }
            }
            bf16* so = ST + ((size_t)((dir * NCH + c) * 32 + h) * 64) * 128;
#pragma unroll
            for (int pt = 0; pt < 4; ++pt)
#pragma unroll
                for (int i2 = 0; i2 < 4; ++i2) { const f32x4 a = acc[2 * i2][pt], b = acc[2 * i2 + 1][pt];
                    v4u o; o.x = pk2(a[0], a[1]); o.y = pk2(a[2], a[3]); o.z = pk2(b[0], b[1]); o.w = pk2(b[2], b[3]);
                    *(GAS v4u*)(so + (size_t)(((pt * 4 + i2) * 16 + r16) * 32) + 8 * gq) = o; }
        }
        __syncthreads();
    }
    { const int nun = NCH * 8, full = nun / F.G, nbusy = nun - full * F.G; __syncthreads();
      if (F.vcu >= nbusy) moe_dn_convert(F, 1900, 5700, (F.vcu - nbusy) * NWAVES + F.wave, (F.G - nbusy) * NWAVES); }
}
#undef S1_PREFETCH

__device__ __forceinline__ void ph_ssd_s2(Frame& F) {
    const float* DEC = (const float*)(F.ws + WS_DEC); bf16* ST = (bf16*)(F.ws + WS_STATES);
    for (int e = F.vcu * NTHR + F.tid; e < 2 * 32 * 64 * 32; e += F.G * NTHR) {
        const int dir = e >> 16, h = (e >> 11) & 31, rem = e & 2047;
        const size_t eoff = (size_t)h * 8192 + (size_t)rem * 4; const size_t cstride = (size_t)32 * 8192;
        bf16* base = ST + (size_t)dir * NCH * cstride + eoff;
        const float* dec = DEC + (size_t)dir * NCH * 32 + h;
        float H0 = 0.f, H1 = 0.f, H2 = 0.f, H3 = 0.f;
        for (int b = 0; b < NCH; b += 10) {
            v2u s[10]; float d[10]; int ck[10];
#pragma unroll
            for (int i = 0; i < 10; ++i) { const int idx = b + i; ck[i] = dir == 0 ? (idx < 2 ? 128 + idx : idx - 2) : (idx < 2 ? 129 - idx : 129 - idx);
                s[i] = __builtin_nontemporal_load((const GAS v2u*)(base + (size_t)ck[i] * cstride)); d[i] = dec[ck[i] * 32]; }
#pragma unroll
            for (int i = 0; i < 10; ++i) { v2u o; o.x = pk2(H0, H1); o.y = pk2(H2, H3); *(GAS v2u*)(base + (size_t)ck[i] * cstride) = o;
                H0 = d[i] * H0 + bflo(s[i].x); H1 = d[i] * H1 + bfhi(s[i].x); H2 = d[i] * H2 + bflo(s[i].y); H3 = d[i] * H3 + bfhi(s[i].y); }
        }
    }
}

__device__ __forceinline__ void ph_ssd_s3(Frame& F) {
    const bf16* XT = (const bf16*)(F.ws + WS_XT); const bf16* BMm = (const bf16*)(F.ws + WS_BM); const bf16* CMm = (const bf16*)(F.ws + WS_CM);
    const float* DTF = (const float*)(F.ws + WS_DTS); const float* DTB = DTF + (size_t)32 * MT; const float* CUMF = DTB + (size_t)32 * MT; const float* CUMB = CUMF + (size_t)32 * MT;
    const bf16* ST = (const bf16*)(F.ws + WS_STATES); bf16* Z = (bf16*)(F.ws + WS_Z); const float* ng = F.in[I_SSDNG];
    LAS unsigned char* bml = F.lds;
    LAS unsigned char* cml = F.lds + 128 * 272;
    LAS float* tab = (LAS float*)(F.lds + 192 * 272);
    LAS float* ssq = tab + 8 * 5 * 128;
    const int lane = F.lane, r16 = lane & 15, gq = lane >> 4;
    v4u nbm[4], ncm[2]; float ncf[2], ncb[2], ndf[2], ndb[2];
#define S3_PREFETCH(u_) do { const int c_ = (u_) >> 3, g_ = ((u_) >> 1) & 3, lh_ = (u_) & 1, t0_ = c_ * 128; int tq_ = F.tid; asm volatile("" : "+v"(tq_)); \
        _Pragma("unroll") for (int i_ = 0; i_ < 4; ++i_) { const int p_ = tq_ + NTHR * i_, row_ = p_ >> 4, c8_ = (p_ & 15) * 8; nbm[i_] = *(const GAS v4u*)(BMm + (size_t)(t0_ + row_) * 512 + g_ * 128 + c8_); } \
        _Pragma("unroll") for (int i_ = 0; i_ < 2; ++i_) { const int p_ = tq_ + NTHR * i_, row_ = p_ >> 4, c8_ = (p_ & 15) * 8; ncm[i_] = *(const GAS v4u*)(CMm + (size_t)(t0_ + 64 * lh_ + row_) * 512 + g_ * 128 + c8_); \
            const size_t o_ = (size_t)(8 * g_ + (p_ >> 7)) * MT + t0_ + (p_ & 127); ncf[i_] = CUMF[o_]; ncb[i_] = CUMB[o_]; ndf[i_] = DTF[o_]; ndb[i_] = DTB[o_]; } } while (0)
    if (F.vcu < 128 * 8) S3_PREFETCH(F.vcu);
    for (int u = F.vcu; u < 128 * 8; u += F.G) {
        const int c = u >> 3, g = (u >> 1) & 3, lh = u & 1, t0 = c * 128;
        __syncthreads();
        int tid_ = F.tid; asm volatile("" : "+v"(tid_));
#pragma unroll
        for (int i = 0; i < 4; ++i) { const int p = tid_ + NTHR * i, row = p >> 4, c8 = (p & 15) * 8; *(LAS v4u*)(bml + row * 272 + c8 * 2) = nbm[i]; }
#pragma unroll
        for (int i = 0; i < 2; ++i) { const int p = tid_ + NTHR * i, row = p >> 4, c8 = (p & 15) * 8; *(LAS v4u*)(cml + row * 272 + c8 * 2) = ncm[i]; }
#pragma unroll
        for (int i = 0; i < 2; ++i) { const int p = tid_ + NTHR * i, j = p >> 7, l = p & 127;
            const float cf = ncf[i] * LOG2E_, cb = ncb[i] * LOG2E_, df = ndf[i], db = ndb[i];
            tab[(j * 5 + 0) * 128 + l] = cf; tab[(j * 5 + 1) * 128 + l] = cb; tab[(j * 5 + 2) * 128 + l] = __builtin_amdgcn_logf(df) - cf; tab[(j * 5 + 3) * 128 + l] = __builtin_amdgcn_logf(db) - cb;
            tab[(j * 5 + 4) * 128 + l] = df + db; }
        __syncthreads();
        const int h = 8 * g + F.wave;
        const float Dk = F.in[I_SSDD][h];
        const LAS float* tcf = tab + (F.wave * 5) * 128; const LAS float* tcb = tcf + 128; const LAS float* tdf = tcb + 128; const LAS float* tdb = tdf + 128; const LAS float* tds = tdb + 128;
        f32x4 acc[4][4];
#pragma unroll
        for (int a = 0; a < 4; ++a)
#pragma unroll
            for (int b = 0; b < 4; ++b) acc[a][b] = (f32x4){0.f, 0.f, 0.f, 0.f};
#pragma unroll 1
        for (int i2 = 0; i2 < 4; ++i2) {
            bf16x8v xf[4], bmf[2][4];
#pragma unroll
            for (int pt = 0; pt < 4; ++pt) xf[pt] = as_frag(*(const GAS v4u*)(XT + ((size_t)(((h * NCH + c) * 4 + i2) * 4 + pt) * 16 + r16) * 32 + 8 * gq));
#pragma unroll
            for (int par = 0; par < 2; ++par)
#pragma unroll
                for (int nk = 0; nk < 4; ++nk) bmf[par][nk] = as_frag(*(const LAS v4u*)(bml + prm_row(i2, par, r16) * 272 + (32 * nk + 8 * gq) * 2));
            const int sb = 32 * i2 + 8 * gq;
            const f32x4 dfs0 = *(const LAS f32x4*)(tdf + sb), dfs1 = *(const LAS f32x4*)(tdf + sb + 4), dbs0 = *(const LAS f32x4*)(tdb + sb), dbs1 = *(const LAS f32x4*)(tdb + sb + 4);
#pragma unroll
            for (int lt = 0; lt < 4; ++lt) {
                const int ll = 16 * lt + r16, l = 64 * lh + ll;
                const float cfl = tcf[l], cbl = tcb[l], dsl = tds[l];
                f32x4 g0 = (f32x4){0.f, 0.f, 0.f, 0.f}, g1 = g0;
#pragma unroll
                for (int nk = 0; nk < 4; ++nk) { const bf16x8v cf = as_frag(*(const LAS v4u*)(cml + ll * 272 + (32 * nk + 8 * gq) * 2));
                    g0 = MFMA16(bmf[0][nk], cf, g0); g1 = MFMA16(bmf[1][nk], cf, g1); }
                float m[8];
                const int ltile0 = 64 * lh + 16 * lt; const int blk = (32 * i2 + 31 < ltile0) ? 0 : ((32 * i2 > ltile0 + 15) ? 2 : 1);
                if (blk == 0) {
#pragma unroll
                    for (int e = 0; e < 8; ++e) { const float dfs = e < 4 ? dfs0[e & 3] : dfs1[e & 3], gv = e < 4 ? g0[e & 3] : g1[e & 3]; m[e] = gv * __builtin_amdgcn_exp2f(cfl + dfs); }
                } else if (blk == 2) {
#pragma unroll
                    for (int e = 0; e < 8; ++e) { const float dbs = e < 4 ? dbs0[e & 3] : dbs1[e & 3], gv = e < 4 ? g0[e & 3] : g1[e & 3]; m[e] = gv * __builtin_amdgcn_exp2f(cbl + dbs); }
                } else {
#pragma unroll
                    for (int e = 0; e < 8; ++e) { const int s = sb + e;
                        const float dfs = e < 4 ? dfs0[e & 3] : dfs1[e & 3], dbs = e < 4 ? dbs0[e & 3] : dbs1[e & 3], gv = e < 4 ? g0[e & 3] : g1[e & 3];
                        float w = __builtin_amdgcn_exp2f(s < l ? cfl + dfs : cbl + dbs); const bool dg = s == l;
                        w = dg ? dsl : w; m[e] = gv * w + (dg ? Dk : 0.f); }
                }
                asm volatile("" : "+v"(m[0]), "+v"(m[1]), "+v"(m[2]), "+v"(m[3]), "+v"(m[4]), "+v"(m[5]), "+v"(m[6]), "+v"(m[7]));
                v4u mp; mp.x = pk2(m[0], m[1]); mp.y = pk2(m[2], m[3]); mp.z = pk2(m[4], m[5]); mp.w = pk2(m[6], m[7]);
                const bf16x8v mf = as_frag(mp);
#pragma unroll
                for (int pt = 0; pt < 4; ++pt) acc[lt][pt] = MFMA16(xf[pt], mf, acc[lt][pt]);
            }
        }
        if (u + F.G < 128 * 8) S3_PREFETCH(u + F.G);
#pragma unroll 1
        for (int dir = 0; dir < 2; ++dir) {
            const bf16* hs = ST + ((size_t)((dir * NCH + c) * 32 + h) * 64) * 128;
            float el[4];
#pragma unroll
            for (int lt = 0; lt < 4; ++lt) { const int l = 64 * lh + 16 * lt + r16; el[lt] = __builtin_amdgcn_exp2f(dir == 0 ? tcf[l] : tcb[l]); }
            f32x4 tacc[4][4];
#pragma unroll
            for (int a = 0; a < 4; ++a)
#pragma unroll
                for (int b = 0; b < 4; ++b) tacc[a][b] = (f32x4){0.f, 0.f, 0.f, 0.f};
#pragma unroll 1
            for (int nk = 0; nk < 4; ++nk) {
                bf16x8v hf[4];
#pragma unroll
                for (int pt = 0; pt < 4; ++pt) hf[pt] = as_frag(*(const GAS v4u*)(hs + (size_t)(((pt * 4 + nk) * 16 + r16) * 32) + 8 * gq));
#pragma unroll
                for (int lt = 0; lt < 4; ++lt) { const int ll = 16 * lt + r16;
                    const bf16x8v cf = as_frag(*(const LAS v4u*)(cml + ll * 272 + (32 * nk + 8 * gq) * 2));
#pragma unroll
                    for (int pt = 0; pt < 4; ++pt) tacc[lt][pt] = MFMA16(hf[pt], cf, tacc[lt][pt]); }
            }
#pragma unroll
            for (int lt = 0; lt < 4; ++lt)
#pragma unroll
                for (int pt = 0; pt < 4; ++pt) acc[lt][pt] += tacc[lt][pt] * el[lt];
        }
#pragma unroll
        for (int lt = 0; lt < 4; ++lt) { const int l = 64 * lh + 16 * lt + r16; float ss = 0.f;
#pragma unroll
            for (int q = 0; q < 2; ++q) { const v4u zv = *(const GAS v4u*)(Z + (size_t)(t0 + l) * DIN + h * 64 + 32 * q + 8 * gq);
                const float zz[8] = {bflo(zv.x), bfhi(zv.x), bflo(zv.y), bfhi(zv.y), bflo(zv.z), bfhi(zv.z), bflo(zv.w), bfhi(zv.w)};
#pragma unroll
                for (int e = 0; e < 4; ++e) { float v0 = acc[lt][2 * q][e] * zz[e] * sigmoid_f(zz[e]), v1 = acc[lt][2 * q + 1][e] * zz[4 + e] * sigmoid_f(zz[4 + e]);
                    acc[lt][2 * q][e] = v0; acc[lt][2 * q + 1][e] = v1; ss += v0 * v0 + v1 * v1; } }
            ss += __shfl_xor(ss, 16); ss += __shfl_xor(ss, 32);
            if (gq == 0) ssq[(16 * lt + r16) * 8 + F.wave] = ss; }
        __syncthreads();
#pragma unroll
        for (int lt = 0; lt < 4; ++lt) { const int ll = 16 * lt + r16, l = 64 * lh + ll;
            const f32x4 s0 = *(const LAS f32x4*)(ssq + ll * 8), s1 = *(const LAS f32x4*)(ssq + ll * 8 + 4);
            const float rs = 1.0f / sqrtf(((s0.x + s0.y) + (s0.z + s0.w) + (s1.x + s1.y) + (s1.z + s1.w)) * (1.0f / 512.0f) + EPS);
#pragma unroll
            for (int q = 0; q < 2; ++q) { const int ch = h * 64 + 32 * q + 8 * gq; const f32x4 a = acc[lt][2 * q] * rs, b = acc[lt][2 * q + 1] * rs;
                const f32x4 g0 = *(const f32x4*)(ng + ch), g1 = *(const f32x4*)(ng + ch + 4);
                v4u o; o.x = pk2(a[0] * g0.x, a[1] * g0.y); o.y = pk2(a[2] * g0.z, a[3] * g0.w); o.z = pk2(b[0] * g1.x, b[1] * g1.y); o.w = pk2(b[2] * g1.z, b[3] * g1.w);
                *(GAS v4u*)(Z + (size_t)(t0 + l) * DIN + ch) = o; } }
    }
    __syncthreads();
}
#undef S3_PREFETCH

__device__ __forceinline__ float vmax_f(float a, float b) { return __builtin_amdgcn_fmed3f(a, b, __builtin_inff()); }
__device__ __forceinline__ float vmin_f(float a, float b) { return __builtin_amdgcn_fmed3f(a, b, -__builtin_inff()); }
__device__ __forceinline__ float vmax3_f(float a, float b, float c) { return vmax_f(a, vmax_f(b, c)); }
__device__ __forceinline__ int attn_next_blk(int kb, int qb, bool isctx) {
    for (int k = kb + 1; k < 5; ++k) { if (k >= 3) return k; if (!isctx) { const int b = qb - 1 + k; if (b >= 0 && b < 128) return k; } }
    return 5;
}
__device__ __forceinline__ void ph_attn(Frame& F) {
    const bf16* QR = (const bf16*)(F.ws + WS_QR); const bf16* KR = (const bf16*)(F.ws + WS_KR); const bf16* VT = (const bf16*)(F.ws + WS_VT); bf16* MIX = (bf16*)(F.ws + WS_MIX);
    constexpr int KBYTES = 128 * 144, BUFB = KBYTES + 64 * 272;
    const int lane = F.lane, r16 = lane & 15, gq = lane >> 4;
    constexpr float LOG2E = 1.4426950408889634f;
    const int p0 = F.tid, p1 = F.tid + NTHR;
    const int kro0 = (p0 >> 3) * 144 + (p0 & 7) * 16, kro1 = (p1 >> 3) * 144 + (p1 & 7) * 16;
    const int vro0 = KBYTES + (p0 >> 4) * 272 + (p0 & 15) * 16, vro1 = KBYTES + (p1 >> 4) * 272 + (p1 & 15) * 16;
    for (int u = F.vcu; u < 130 * 8; u += F.G) {
        const int qb = u >> 3, hq = u & 7, kvh = hq >> 2; const bool isctx = qb >= 128;
        const int row0 = qb * 128;
        const int qrow = row0 + 16 * F.wave + r16;
        bf16x8v qf[2];
#pragma unroll
        for (int ks = 0; ks < 2; ++ks) qf[ks] = as_frag(*(const GAS v4u*)(QR + ((size_t)hq * MT + qrow) * 64 + 32 * ks + 8 * gq));
        float m2 = F.in[I_ABSINK][hq] * LOG2E, lsum = 1.0f;
        f32x4 oacc[4];
#pragma unroll
        for (int a = 0; a < 4; ++a) oacc[a] = (f32x4){0.f, 0.f, 0.f, 0.f};
        const int qi = 16 * F.wave + r16;
        const bf16* kbase = KR + (size_t)kvh * MT * 64; const bf16* vbase = VT + (size_t)kvh * 64 * MT;
#define ATT_KEY0(kb) ((kb) < 3 ? (qb - 1 + (kb)) * 128 : L + ((kb) - 3) * 128)
#define ATT_LOAD(kb) do { const int k0_ = ATT_KEY0(kb); \
            kr0 = *(const GAS v4u*)(kbase + (size_t)(k0_ + (p0 >> 3)) * 64 + (p0 & 7) * 8); kr1 = *(const GAS v4u*)(kbase + (size_t)(k0_ + (p1 >> 3)) * 64 + (p1 & 7) * 8); \
            vr0 = *(const GAS v4u*)(vbase + (size_t)(p0 >> 4) * MT + k0_ + (p0 & 15) * 8); vr1 = *(const GAS v4u*)(vbase + (size_t)(p1 >> 4) * MT + k0_ + (p1 & 15) * 8); } while (0)
#define ATT_WRITE(buf) do { LAS unsigned char* b_ = F.lds + (buf) * BUFB; *(LAS v4u*)(b_ + kro0) = kr0; *(LAS v4u*)(b_ + kro1) = kr1; *(LAS v4u*)(b_ + vro0) = vr0; *(LAS v4u*)(b_ + vro1) = vr1; } while (0)
        v4u kr0, kr1, vr0, vr1;
        int kb = attn_next_blk(-1, qb, isctx), cur = 0;
        __syncthreads();
        ATT_LOAD(kb); ATT_WRITE(0);
        __syncthreads();
        while (kb < 5) {
            const int nkb = attn_next_blk(kb, qb, isctx);
            if (nkb < 5) ATT_LOAD(nkb);
            const LAS unsigned char* kl = F.lds + cur * BUFB; const LAS unsigned char* vl = kl + KBYTES;
            const int mode = (kb == 0) ? 1 : ((kb == 2) ? 2 : 0);
            f32x4 sacc[8];
#pragma unroll
            for (int kt = 0; kt < 8; ++kt) { sacc[kt] = (f32x4){0.f, 0.f, 0.f, 0.f};
#pragma unroll
                for (int ks = 0; ks < 2; ++ks) { const bf16x8v kf = as_frag(*(const LAS v4u*)(kl + prm_row(kt >> 1, kt & 1, r16) * 144 + (32 * ks + 8 * gq) * 2));
                    sacc[kt] = MFMA16(kf, qf[ks], sacc[kt]); } }
            float bm = -1.0e30f;
#pragma unroll 1
            for (int rep_ = 0; rep_ < (mode != 0 ? 1 : 0); ++rep_) {
                const float msgn = mode == 1 ? 1.0e30f : -1.0e30f, limf = (float)(qi - 8 * gq);
#pragma unroll
                for (int kt = 0; kt < 8; ++kt)
#pragma unroll
                    for (int e = 0; e < 4; ++e) { const float jc = (float)(32 * (kt >> 1) + 4 * (kt & 1) + e);
                        sacc[kt][e] += vmin_f(0.f, msgn * (jc - limf)); }
            }
#pragma unroll
            for (int kt = 0; kt < 8; ++kt) bm = vmax3_f(bm, vmax_f(sacc[kt][0], sacc[kt][1]), vmax_f(sacc[kt][2], sacc[kt][3]));
            bm = vmax_f(bm, __shfl_xor(bm, 16)); bm = vmax_f(bm, __shfl_xor(bm, 32));
            const float mn = vmax_f(m2, bm), alpha = __builtin_amdgcn_exp2f(m2 - mn); m2 = mn;
            float ps = 0.f;
            bf16x8v pf[4];
#pragma unroll
            for (int i2 = 0; i2 < 4; ++i2) { float p[8];
#pragma unroll
                for (int e = 0; e < 4; ++e) { p[e] = __builtin_amdgcn_exp2f(sacc[2 * i2][e] - mn); p[4 + e] = __builtin_amdgcn_exp2f(sacc[2 * i2 + 1][e] - mn); }
#pragma unroll
                for (int e = 0; e < 8; ++e) ps += p[e];
                v4u pk; pk.x = pk2(p[0], p[1]); pk.y = pk2(p[2], p[3]); pk.z = pk2(p[4], p[5]); pk.w = pk2(p[6], p[7]); pf[i2] = as_frag(pk); }
            ps += __shfl_xor(ps, 16); ps += __shfl_xor(ps, 32);
            lsum = lsum * alpha + ps;
#pragma unroll
            for (int dt = 0; dt < 4; ++dt) { oacc[dt] = oacc[dt] * alpha;
#pragma unroll
                for (int i2 = 0; i2 < 4; ++i2) { const bf16x8v vf = as_frag(*(const LAS v4u*)(vl + prm_row(dt >> 1, dt & 1, r16) * 272 + (32 * i2 + 8 * gq) * 2));
                    oacc[dt] = MFMA16(vf, pf[i2], oacc[dt]); } }
            if (nkb < 5) ATT_WRITE(cur ^ 1);
            __syncthreads();
            kb = nkb; cur ^= 1;
        }
#undef ATT_KEY0
#undef ATT_LOAD
#undef ATT_WRITE
        const float il = 1.0f / lsum;
#pragma unroll
        for (int i = 0; i < 2; ++i) { const f32x4 a = oacc[2 * i] * il, b = oacc[2 * i + 1] * il;
            v4u o; o.x = pk2(a[0], a[1]); o.y = pk2(a[2], a[3]); o.z = pk2(b[0], b[1]); o.w = pk2(b[2], b[3]);
            *(GAS v4u*)(MIX + (size_t)qrow * D + 512 + 64 * hq + 32 * i + 8 * gq) = o; }
    }
    __syncthreads();
}

constexpr int NPH = 23;
#ifndef WGM_MOE_GU
#define WGM_MOE_GU 4
#endif
#ifndef WGM_MOE_DN
#define WGM_MOE_DN 4
#endif
struct Args { const float* in[30]; float* out; unsigned char* ws; int ph_lo, ph_hi; };
__global__ void __launch_bounds__(NTHR, 2) mk_fwd(Args args) {
    extern __shared__ __attribute__((aligned(16))) unsigned char lds[];
    Frame F;
    F.lds = (LAS unsigned char*)lds;
    F.tid = threadIdx.x; F.lane = F.tid & 63; F.wave = __builtin_amdgcn_readfirstlane(F.tid >> 6);
    F.G = gridDim.x; { const int bx = blockIdx.x; F.vcu = (F.G % 8 == 0) ? (bx % 8) * (F.G / 8) + bx / 8 : bx; }
#pragma unroll
    for (int i = 0; i < 30; ++i) F.in[i] = args.in[i];
    F.out = args.out; F.ws = args.ws;
    unsigned char* ws = args.ws;
    volatile LAS unsigned* MISC = (volatile LAS unsigned*)(F.lds + MISC_OFF);
    for (int u = F.tid; u < (LDS_BYTES - LDSCTL_OFF) / 4; u += NTHR) ((LAS unsigned*)(F.lds + LDSCTL_OFF))[u] = 0u;
    __syncthreads();
    const int lo = args.ph_lo, hi = args.ph_hi;
    XcdBarrier bar; bar.bar = (unsigned*)(ws + WS_CTL) + CW_BAR; bar.x = 0; bar.st = nullptr;
    if (hi - lo > 1) bar = xcd_barrier_post((unsigned*)(ws + WS_CTL) + CW_BAR, MISC + 8);
#define IN(k) (lo <= (k) && (k) < hi)
#define SEAM(k) do { if (IN(k) && IN((k) + 1)) xcd_barrier(bar); } while (0)
    LAS unsigned char* ring = F.lds;
    bf16* X = (bf16*)(ws + WS_X); bf16* H = (bf16*)(ws + WS_H);

    if (IN(0)) { ph_prologue(F); } SEAM(0);
    if (IN(1)) { ph_modulate<false, false, 0>(F, F.in[I_X], F.in[I_CTX], F.in[I_N1G], modp(F, 0, 0), modp(F, 0, 1), M_SH1, M_SC1, H, MT, nullptr, nullptr, nullptr); } SEAM(1);
    if (IN(2)) { pg8::Gemm g{H, (const bf16*)(ws + WS_WABIN), D, D, 0}; pg8::StaticOrder S; S.init(MT, AB_IN, F.G, (int)blockIdx.x);
        pg8::EpiStoreBf16 E{(bf16*)(ws + WS_PAB), AB_IN};
        pg8::gemm_phase<pg8::EpiStoreBf16, pg8::StaticOrder, true, true>(ring, g, S, E);
        idle_round_convert(F, (MT / 256) * (AB_IN / 256), 0, 11400); } SEAM(2);
    if (IN(3)) { ph_ab_elem(F); } SEAM(3);
    if (IN(4)) { ph_attn(F); } SEAM(4);
    if (IN(5)) { { pg8::Gemm g{(const bf16*)(ws + WS_MIX), (const bf16*)(ws + WS_WABOUT), D, D, 0}; pg8::StaticOrder S; S.init(L, D, F.G, (int)blockIdx.x);
          pg8::EpiRes<true> E{X, F.in[I_X], modp(F, 0, 0) + M_G1, (float*)(ws + WS_SSQA)};
          pg8::gemm_phase<pg8::EpiRes<true>, pg8::StaticOrder, true, true>(ring, g, S, E); }
        { int nu_ = 16, kl_ = 256; asm volatile("" : "+s"(nu_), "+s"(kl_)); pg8::Gemm g{(const bf16*)(ws + WS_MIX), (const bf16*)(ws + WS_WABOUT), D, kl_, 0}; pg8::SplitOrder S{64, 4, nu_, 256, F.G, (int)blockIdx.x};
          pg8::EpiPart E{(float*)(ws + WS_PART), 64, 256, LC};
          pg8::gemm_phase<pg8::EpiPart, pg8::SplitOrder, true, true>(ring, g, S, E); }
        ctx_reduce<false, 4>(F, 16, CW_PCNT, F.in[I_CTX], modp(F, 0, 1) + M_G1, X, (float*)(ws + WS_SSQA));
        if ((int)blockIdx.x >= 16) ph_convert_ffn(F, ((int)blockIdx.x - 16) * NWAVES + F.wave, (F.G - 16) * NWAVES); } if (IN(5) && IN(7)) xcd_barrier(bar);
    if (IN(7)) { pg8::Gemm g{X, (const bf16*)(ws + WS_WFFNGU), D, D, (size_t)(WS_WCTX - WS_WFFNGU)}; pg8::StaticOrder S; S.init(MT, 2 * DFF, F.G, (int)blockIdx.x); S.pe_pm = L / 256;
        pg8::EpiSwiGLUFold E{(bf16*)(ws + WS_ACT0), DFF, (const float*)(ws + WS_SSQA), (const float*)(ws + WS_BIASA)};
        pg8::gemm_phase<pg8::EpiSwiGLUFold, pg8::StaticOrder, true, true>(ring, g, S, E);
        idle_round_convert(F, (MT / 256) * (2 * DFF / 256), 11400, 18000); } SEAM(7);
    if (IN(8)) { { pg8::Gemm g{(const bf16*)(ws + WS_ACT0), (const bf16*)(ws + WS_WFFND), DFF, DFF, 0}; pg8::StaticOrder S; S.init(L, D, F.G, (int)blockIdx.x);
          pg8::EpiRes<false> E{X, X, modp(F, 0, 0) + M_G2, (float*)(ws + WS_SSQB)};
          pg8::gemm_phase<pg8::EpiRes<false>, pg8::StaticOrder, true, true>(ring, g, S, E); }
        { int nu_ = 44, kl_ = 256; asm volatile("" : "+s"(nu_), "+s"(kl_)); pg8::Gemm g{(const bf16*)(ws + WS_ACT0), (const bf16*)(ws + WS_WFFND), DFF, kl_, 0}; pg8::SplitOrder S{64, 4, nu_, 256, F.G, (int)blockIdx.x};
          pg8::EpiPart E{(float*)(ws + WS_PART), 64, 256, LC};
          pg8::gemm_phase<pg8::EpiPart, pg8::SplitOrder, true, true>(ring, g, S, E); }
        ctx_reduce<true, 11>(F, 44, CW_PCNT + 64, X + (size_t)L * D, modp(F, 0, 1) + M_G2, X, (float*)(ws + WS_SSQB));
        if ((int)blockIdx.x >= 44) ph_convert_ssd(F, ((int)blockIdx.x - 44) * NWAVES + F.wave, (F.G - 44) * NWAVES); } if (IN(8) && IN(10)) xcd_barrier(bar);
    if (IN(10)) { pg8::Gemm g{X, (const bf16*)(ws + WS_WSSDIN), D, D, (size_t)(WS_WCTX - WS_WSSDIN)}; pg8::StaticOrder S; S.init(MT, SSD_INP, F.G, (int)blockIdx.x); S.pe_pm = L / 256;
        pg8::EpiSsdIn E{(bf16*)(ws + WS_Z), (bf16*)(ws + WS_XBCR), (float*)(ws + WS_DTRAW), (const float*)(ws + WS_SSQB), (const float*)(ws + WS_BIASB)};
        pg8::gemm_phase<pg8::EpiSsdIn, pg8::StaticOrder, true, true>(ring, g, S, E);
        idle_round_convert(F, (MT / 256) * (SSD_INP / 256), 18000, MOE_GU_ITEMS); } SEAM(10);
    if (IN(11)) { ph_ssd_conv(F); } SEAM(11);
    if (IN(12)) { ph_ssd_s1(F); } SEAM(12);
    if (IN(13)) { ph_ssd_s2(F); } SEAM(13);
    if (IN(14)) { ph_ssd_s3(F); } if (IN(14) && IN(16)) xcd_barrier(bar);
    if (IN(16)) { pg8::Gemm g{(const bf16*)(ws + WS_Z), (const bf16*)(ws + WS_WSSDOUT), DIN, DIN, 0}; pg8::StaticOrder S; S.init(L, D, F.G, (int)blockIdx.x);
        pg8::EpiRes<false> E{X, X, modp(F, 1, 0) + M_G1};
        pg8::gemm_phase<pg8::EpiRes<false>, pg8::StaticOrder, true, true>(ring, g, S, E); } SEAM(16);
    if (IN(17)) { ph_moe_route(F); } SEAM(17);
    if (IN(18)) { ph_moe_scatter(F); __syncthreads();
        { const int gw_ = F.vcu * NWAVES + F.wave, NGW_ = F.G * NWAVES;
          moe_dn_convert(F, 5700, MOE_DN_ITEMS / 2, gw_, NGW_); moe_dn_convert(F, 11308, MOE_DN_ITEMS, gw_, NGW_); } } SEAM(18);
    if (IN(19) || IN(21)) {
        LAS int* hist = (LAS int*)F.lds; LAS int* cnt = hist + 512; LAS int* seg = cnt + 8;
        pg8::GroupedOrder S;
        if (IN(19)) {
            moe_segments(F, hist, cnt, seg);
            S.nM = seg[8] >> 8; S.nN = 2 * FFE / 256; S.nwg = S.nM * S.nN; S.G = F.G; S.c = (int)blockIdx.x; S.WGM = WGM_MOE_GU;
            S.ts1 = seg[1] >> 8; S.ts2 = seg[2] >> 8; S.ts3 = seg[3] >> 8; S.ts4 = seg[4] >> 8; S.ts5 = seg[5] >> 8; S.ts6 = seg[6] >> 8; S.ts7 = seg[7] >> 8;
            __syncthreads();
            pg8::Gemm g{(const bf16*)(ws + WS_H2S), (const bf16*)(ws + WS_WMOE), D, D, (size_t)2 * FFE * D * 2};
            pg8::EpiSwiGLU E{(bf16*)(ws + WS_ACTM), FFE};
            pg8::gemm_phase<pg8::EpiSwiGLU, pg8::GroupedOrder, true, true>(ring, g, S, E);
            { const int full = S.nwg / F.G, nbusy = S.nwg - full * F.G;
              if ((int)blockIdx.x >= nbusy) moe_dn_convert(F, 7168, 11308, ((int)blockIdx.x - nbusy) * NWAVES + F.wave, (F.G - nbusy) * NWAVES); }
        }
        SEAM(19);
        if (IN(21)) {
            __syncthreads();
            moe_segments(F, hist, cnt, seg);
            const int NT = seg[8] >> 8;
            S.nM = NT < 128 ? NT : 128; S.nN = D / 256; S.nwg = S.nM * S.nN; S.G = F.G; S.c = (int)blockIdx.x; S.WGM = WGM_MOE_DN;
            S.ts1 = seg[1] >> 8; S.ts2 = seg[2] >> 8; S.ts3 = seg[3] >> 8; S.ts4 = seg[4] >> 8; S.ts5 = seg[5] >> 8; S.ts6 = seg[6] >> 8; S.ts7 = seg[7] >> 8;
            __syncthreads();
            { pg8::Gemm g{(const bf16*)(ws + WS_ACTM), (const bf16*)(ws + WS_WDA), FFE, FFE, WD_BYTES, (WS_WDB - WS_WDA) - 4 * WD_BYTES};
              pg8::EpiStoreBf16 E{(bf16*)(ws + WS_H2S), D};
              pg8::gemm_phase<pg8::EpiStoreBf16, pg8::GroupedOrder, true, true>(ring, g, S, E); }
            if (NT > 128) {
                pg8::Gemm g{(const bf16*)(ws + WS_ACTM), (const bf16*)(ws + WS_WDA), FFE, 512, WD_BYTES, (WS_WDB - WS_WDA) - 4 * WD_BYTES};
                pg8::SplitGroupedOrder S2{128, NT, D / 256, 7, 512, F.G, (int)blockIdx.x, S.ts1, S.ts2, S.ts3, S.ts4, S.ts5, S.ts6, S.ts7};
                pg8::EpiPart E{(float*)(ws + WS_YPART), 128, 512, 2048};
                pg8::gemm_phase<pg8::EpiPart, pg8::SplitGroupedOrder, true, true>(ring, g, S2, E); }
        }
        SEAM(21);
    } else { SEAM(19); if (IN(20)) { const int gw_ = F.vcu * NWAVES + F.wave, NGW_ = F.G * NWAVES; moe_dn_convert(F, 0, MOE_DN_ITEMS, gw_, NGW_); }
        SEAM(20); SEAM(21); }
    if (IN(22)) { ph_final(F); }
#undef IN
#undef SEAM
}

extern "C" void kernel_launch(void* const* d_in, const int* in_sizes, int n_in, void* d_out, int out_size, void* d_ws, size_t ws_size, hipStream_t stream) {
    static int grid = 0;
    if (grid == 0) {
        if (n_in != 30 || in_sizes[0] != L * D || out_size != L * D || ws_size < WS_END) { fprintf(stderr, "kernel_launch: unexpected shapes (n_in %d, in0 %d, out %d, ws %zu < %zu); nothing launched\n", n_in, n_in > 0 ? in_sizes[0] : -1, out_size, ws_size, (size_t)WS_END); grid = -1; return; }
        int dev = 0, cus = 0, per_cu = 0;
        if (hipGetDevice(&dev) != hipSuccess || hipDeviceGetAttribute(&cus, hipDeviceAttributeMultiprocessorCount, dev) != hipSuccess) { grid = -1; return; }
        if (hipFuncSetAttribute((const void*)mk_fwd, hipFuncAttributeMaxDynamicSharedMemorySize, LDS_BYTES) != hipSuccess) { fprintf(stderr, "kernel_launch: hipFuncSetAttribute failed\n"); grid = -1; return; }
        if (hipOccupancyMaxActiveBlocksPerMultiprocessor(&per_cu, (const void*)mk_fwd, NTHR, LDS_BYTES) != hipSuccess || per_cu < 1)
            fprintf(stderr, "kernel_launch: note: occupancy query reports %d workgroups per CU\n", per_cu);
        (void)hipGetLastError();
        grid = cus;
    }
    if (grid < 0) return;
    if (hipMemsetAsync((char*)d_ws + WS_CTL, 0, CTL_ZERO_BYTES, stream) != hipSuccess) return;
    Args a{};
    for (int i = 0; i < 30; ++i) a.in[i] = (const float*)d_in[i];
    a.out = (float*)d_out; a.ws = (unsigned char*)d_ws;
    if (MK_N_LAUNCHES == 1) { a.ph_lo = 0; a.ph_hi = NPH; hipLaunchKernelGGL(mk_fwd, dim3(grid), dim3(NTHR), LDS_BYTES, stream, a); }
    else { for (int p = 0; p < NPH; ++p) { a.ph_lo = p; a.ph_hi = p + 1; hipLaunchKernelGGL(mk_fwd, dim3(grid), dim3(NTHR), LDS_BYTES, stream, a); } }
}
```

```cpp
#include <hip/hip_runtime.h>
#include <cstdio>
#include <cstdint>

#ifndef MK_N_LAUNCHES
#define MK_N_LAUNCHES 1
#endif

namespace pg8 {
#define PG8_LAS __attribute__((address_space(3)))
typedef unsigned short bf16_t;
typedef short bf16x8 __attribute__((ext_vector_type(8)));
typedef float f32x4 __attribute__((ext_vector_type(4)));
typedef unsigned u32x4 __attribute__((ext_vector_type(4)));
constexpr int BM = 256, BK = 64, HALF = 128, HTB = HALF * BK * 2  , STAGE_BYTES = 8 * HTB, NXCD = 8;

__host__ __device__ __forceinline__ int lds_byte(int r, int c) { const int st = (r >> 4) * 2 + (c >> 5), rr = r & 15, cc = c & 31, ob = rr * 64 + cc * 2; return st * 1024 + (ob ^ (((ob >> 9) & 1) << 5)); }
__host__ __device__ __forceinline__ void stage_rc(int b, int& R, int& C) { const int st = b / 1024, sb = b % 1024, swz = sb ^ (((sb >> 9) & 1) << 5); R = (st >> 1) * 16 + swz / 64; C = (st & 1) * 32 + (swz % 64) / 2; }
__host__ __device__ __forceinline__ int perm32(int rho) { const int n = rho >> 4, i = rho & 15; return 8 * (i >> 2) + 4 * n + (i & 3); }

struct Unit { int pm, pn, pe, pk; };
struct Gemm { const bf16_t* A; const bf16_t* Bt; int ld, K; size_t bstride; size_t bdelta = 0; };

struct StaticOrder {
    int nM, nN, nwg, G, c, WGM, pe_pm;
    __host__ __device__ void init(int M, int N, int G_, int c_, int wgm = 4) { nM = M / BM; nN = N / BM; nwg = nM * nN; G = G_; c = c_; WGM = wgm; pe_pm = 1 << 30; }
    __host__ __device__ bool next(int i, Unit& u) const {
        const long L = (long)i * G + c; if (L >= nwg) return false;
        int wgid = (int)L; { const int q = nwg / NXCD, r = nwg % NXCD, xcd = wgid % NXCD, off = wgid / NXCD; wgid = (xcd < r ? xcd * (q + 1) : r * (q + 1) + (xcd - r) * q) + off; }
        const int nig = WGM * nN, gid = wgid / nig, fm = gid * WGM, gsz = (nM - fm) < WGM ? (nM - fm) : WGM;
        u.pm = fm + ((wgid % nig) % gsz); u.pn = (wgid % nig) / gsz; u.pe = u.pm >= pe_pm ? 1 : 0; u.pk = 0; return true;
    }
    __device__ __forceinline__ void a_ready(const Unit&) const {}
    __device__ __forceinline__ void done(const Unit&) const {}
};
struct GroupedOrder {
    int nM, nN, nwg, G, c, WGM; int ts1, ts2, ts3, ts4, ts5, ts6, ts7;
    __device__ bool next(int i, Unit& u) const {
        const long L = (long)i * G + c; if (L >= nwg) return false;
        int wgid = (int)L; { const int q = nwg / NXCD, r = nwg % NXCD, xcd = wgid % NXCD, off = wgid / NXCD; wgid = (xcd < r ? xcd * (q + 1) : r * (q + 1) + (xcd - r) * q) + off; }
        const int nig = WGM * nN, gid = wgid / nig, fm = gid * WGM, gsz = (nM - fm) < WGM ? (nM - fm) : WGM;
        u.pm = fm + ((wgid % nig) % gsz); u.pn = (wgid % nig) / gsz;
        u.pk = 0; const int p = u.pm; u.pe = (p >= ts1) + (p >= ts2) + (p >= ts3) + (p >= ts4) + (p >= ts5) + (p >= ts6) + (p >= ts7); return true;
    }
    __device__ __forceinline__ void a_ready(const Unit&) const {}
    __device__ __forceinline__ void done(const Unit&) const {}
};

__device__ __forceinline__ unsigned cvt_pk_bf16(float lo, float hi) { unsigned r; asm volatile("v_cvt_pk_bf16_f32 %0, %1, %2" : "=v"(r) : "v"(lo), "v"(hi)); return r; }
__device__ __forceinline__ float silu_f(float g) { return g * __builtin_amdgcn_rcpf(1.0f + __expf(-g)); }

struct EpiStoreBf16 {
    static constexpr bool PERM = true, AFTER_DRAIN = false;
    bf16_t* O; int ldc;
    __device__ __forceinline__ void operator()(const f32x4 (&acc)[2][2][4][2], const Unit& u, int wr, int wc, int fr, int fq) const {
        const int row0 = u.pm * BM + wr * 64 + fr, col0 = u.pn * BM + wc * 32 + 8 * fq;
#pragma unroll
        for (int ai = 0; ai < 2; ++ai)
#pragma unroll
            for (int m = 0; m < 4; ++m) { bf16_t* rowp = O + (size_t)(row0 + ai * HALF + m * 16) * ldc + col0;
#pragma unroll
                for (int bj = 0; bj < 2; ++bj) { const f32x4 v0 = acc[ai][bj][m][0], v1 = acc[ai][bj][m][1];
                    u32x4 w; w.x = cvt_pk_bf16(v0[0], v0[1]); w.y = cvt_pk_bf16(v0[2], v0[3]); w.z = cvt_pk_bf16(v1[0], v1[1]); w.w = cvt_pk_bf16(v1[2], v1[3]);
                    *(u32x4*)(rowp + bj * HALF) = w; } }
    }
};
template <bool FOLD> struct EpiSwiGLUT {
    static constexpr bool PERM = true, AFTER_DRAIN = false;
    bf16_t* O; int ldc; const float* ssq; const float* bias;
    __device__ __forceinline__ void operator()(const f32x4 (&acc)[2][2][4][2], const Unit& u, int wr, int wc, int fr, int fq) const {
        const int row0 = u.pm * BM + wr * 64 + fr, col0 = u.pn * HALF + wc * 32 + 8 * fq;
        f32x4 bg0, bg1, bu0, bu1;
        if (FOLD) { const float* bp = bias + (size_t)u.pe * 2 * ldc + col0; bg0 = *(const f32x4*)bp; bg1 = *(const f32x4*)(bp + 4); bu0 = *(const f32x4*)(bp + ldc); bu1 = *(const f32x4*)(bp + ldc + 4); }
#pragma unroll
        for (int ai = 0; ai < 2; ++ai)
#pragma unroll
            for (int m = 0; m < 4; ++m) { bf16_t* rowp = O + (size_t)(row0 + ai * HALF + m * 16) * ldc + col0;
                f32x4 g0 = acc[ai][0][m][0], g1 = acc[ai][0][m][1], u0 = acc[ai][1][m][0], u1 = acc[ai][1][m][1];
                if (FOLD) { const float rs = __builtin_amdgcn_rsqf(ssq[row0 + ai * HALF + m * 16] * (1.0f / 1024.0f) + 1e-6f); g0 = g0 * rs + bg0; g1 = g1 * rs + bg1; u0 = u0 * rs + bu0; u1 = u1 * rs + bu1; }
                u32x4 w; w.x = cvt_pk_bf16(silu_f(g0[0]) * u0[0], silu_f(g0[1]) * u0[1]); w.y = cvt_pk_bf16(silu_f(g0[2]) * u0[2], silu_f(g0[3]) * u0[3]);
                w.z = cvt_pk_bf16(silu_f(g1[0]) * u1[0], silu_f(g1[1]) * u1[1]); w.w = cvt_pk_bf16(silu_f(g1[2]) * u1[2], silu_f(g1[3]) * u1[3]);
                *(u32x4*)rowp = w; }
    }
};
typedef EpiSwiGLUT<false> EpiSwiGLU;
typedef EpiSwiGLUT<true> EpiSwiGLUFold;
template <bool BASE_F32> struct EpiRes {
    static constexpr bool PERM = true, AFTER_DRAIN = false;
    bf16_t* X; const void* base; const float* gate; float* ssq = nullptr;
    __device__ __forceinline__ void operator()(const f32x4 (&acc)[2][2][4][2], const Unit& u, int wr, int wc, int fr, int fq) const {
        const int row0 = u.pm * BM + wr * 64 + fr, col0 = u.pn * BM + wc * 32 + 8 * fq;
        f32x4 gv[2][2];
#pragma unroll
        for (int bj = 0; bj < 2; ++bj)
#pragma unroll
            for (int n = 0; n < 2; ++n) gv[bj][n] = *(const f32x4*)(gate + col0 + bj * HALF + 4 * n);
#pragma unroll
        for (int ai = 0; ai < 2; ++ai)
#pragma unroll
            for (int m = 0; m < 4; ++m) { const size_t ro = (size_t)(row0 + ai * HALF + m * 16) * 1024 + col0; float sq = 0.f;
#pragma unroll
                for (int bj = 0; bj < 2; ++bj) { f32x4 b0, b1;
                    if (BASE_F32) { b0 = __builtin_nontemporal_load((const f32x4*)((const float*)base + ro + bj * HALF)); b1 = __builtin_nontemporal_load((const f32x4*)((const float*)base + ro + bj * HALF + 4)); }
                    else { const u32x4 t = *(const u32x4*)((const bf16_t*)base + ro + bj * HALF);
                        b0 = (f32x4){__uint_as_float(t.x << 16), __uint_as_float(t.x & 0xffff0000u), __uint_as_float(t.y << 16), __uint_as_float(t.y & 0xffff0000u)};
                        b1 = (f32x4){__uint_as_float(t.z << 16), __uint_as_float(t.z & 0xffff0000u), __uint_as_float(t.w << 16), __uint_as_float(t.w & 0xffff0000u)}; }
                    const f32x4 v0 = b0 + gv[bj][0] * acc[ai][bj][m][0], v1 = b1 + gv[bj][1] * acc[ai][bj][m][1];
                    sq += (v0[0] * v0[0] + v0[1] * v0[1]) + (v0[2] * v0[2] + v0[3] * v0[3]) + (v1[0] * v1[0] + v1[1] * v1[1]) + (v1[2] * v1[2] + v1[3] * v1[3]);
                    u32x4 w; w.x = cvt_pk_bf16(v0[0], v0[1]); w.y = cvt_pk_bf16(v0[2], v0[3]); w.z = cvt_pk_bf16(v1[0], v1[1]); w.w = cvt_pk_bf16(v1[2], v1[3]);
                    *(u32x4*)(X + ro + bj * HALF) = w; }
                if (ssq) { sq += __shfl_xor(sq, 16); sq += __shfl_xor(sq, 32); if (fq == 0) unsafeAtomicAdd(ssq + row0 + ai * HALF + m * 16, sq); } }
    }
};
struct EpiSsdIn {
    static constexpr bool PERM = true, AFTER_DRAIN = false;
    bf16_t* Z; bf16_t* XB; float* DT; const float* ssq; const float* bias;
    __device__ __forceinline__ void operator()(const f32x4 (&acc)[2][2][4][2], const Unit& u, int wr, int wc, int fr, int fq) const {
        const int row0 = u.pm * BM + wr * 64 + fr;
        const float* bp = bias + (size_t)u.pe * 5376 + u.pn * BM + wc * 32 + 8 * fq;
        if (u.pn < 20) {
            bf16_t* O = u.pn < 8 ? Z : XB; const int ldc = u.pn < 8 ? 2048 : 3072; const int col0 = (u.pn < 8 ? u.pn : u.pn - 8) * BM + wc * 32 + 8 * fq;
#pragma unroll
            for (int ai = 0; ai < 2; ++ai)
#pragma unroll
                for (int m = 0; m < 4; ++m) { bf16_t* rowp = O + (size_t)(row0 + ai * HALF + m * 16) * ldc + col0;
                    const float rs = __builtin_amdgcn_rsqf(ssq[row0 + ai * HALF + m * 16] * (1.0f / 1024.0f) + 1e-6f);
#pragma unroll
                    for (int bj = 0; bj < 2; ++bj) { const f32x4 v0 = acc[ai][bj][m][0] * rs + *(const f32x4*)(bp + bj * HALF), v1 = acc[ai][bj][m][1] * rs + *(const f32x4*)(bp + bj * HALF + 4);
                        u32x4 w; w.x = cvt_pk_bf16(v0[0], v0[1]); w.y = cvt_pk_bf16(v0[2], v0[3]); w.z = cvt_pk_bf16(v1[0], v1[1]); w.w = cvt_pk_bf16(v1[2], v1[3]);
                        *(u32x4*)(rowp + bj * HALF) = w; } }
        } else if (wc < 2) {
#pragma unroll
            for (int ai = 0; ai < 2; ++ai)
#pragma unroll
                for (int m = 0; m < 4; ++m) { float* rowp = DT + (size_t)(row0 + ai * HALF + m * 16) * 64 + wc * 32 + 8 * fq;
                    const float rs = __builtin_amdgcn_rsqf(ssq[row0 + ai * HALF + m * 16] * (1.0f / 1024.0f) + 1e-6f);
                    *(f32x4*)rowp = acc[ai][0][m][0] * rs + *(const f32x4*)bp; *(f32x4*)(rowp + 4) = acc[ai][0][m][1] * rs + *(const f32x4*)(bp + 4); }
        }
    }
};


struct SplitOrder {
    int pm0, nN, nunits, ks_len, G, c;
    __device__ bool next(int i, Unit& u) const { const int x = i * G + c; if (x >= nunits) return false; u.pm = pm0; u.pn = x % nN; u.pe = 0; u.pk = (x / nN) * ks_len; return true; }
    __device__ __forceinline__ void a_ready(const Unit&) const {}
    __device__ __forceinline__ void done(const Unit&) const {}
};
struct SplitGroupedOrder {
    int pm_lo, pm_hi, nN, nks, ks_len, G, c; int ts1, ts2, ts3, ts4, ts5, ts6, ts7;
    __device__ bool next(int i, Unit& u) const { const int x = i * G + c; const int per = nN * nks; if (x >= (pm_hi - pm_lo) * per) return false;
        u.pm = pm_lo + x / per; const int y = x % per; u.pn = y / nks; u.pk = (y % nks) * ks_len;
        const int p = u.pm; u.pe = (p >= ts1) + (p >= ts2) + (p >= ts3) + (p >= ts4) + (p >= ts5) + (p >= ts6) + (p >= ts7); return true; }
    __device__ __forceinline__ void a_ready(const Unit&) const {}
    __device__ __forceinline__ void done(const Unit&) const {}
};
struct EpiPart {
    static constexpr bool PERM = false, AFTER_DRAIN = false;
    float* P; int pm_base, ks_len, nrows;
    __device__ __forceinline__ void operator()(const f32x4 (&acc)[2][2][4][2], const Unit& u, int wr, int wc, int fr, int fq) const {
        const int row0 = (u.pm - pm_base) * BM + wr * 64 + fr, col0 = u.pn * BM + wc * 32 + 4 * fq;
        float* base = P + (size_t)(u.pk / ks_len) * nrows * 1024;
#pragma unroll
        for (int ai = 0; ai < 2; ++ai)
#pragma unroll
            for (int m = 0; m < 4; ++m) { float* rowp = base + (size_t)(row0 + ai * HALF + m * 16) * 1024 + col0;
#pragma unroll
                for (int bj = 0; bj < 2; ++bj)
#pragma unroll
                    for (int n = 0; n < 2; ++n) *(f32x4*)(rowp + bj * HALF + n * 16) = acc[ai][bj][m][n]; }
    }
};
template <class Epi, class Sched, bool ALIGN_EPI = false, bool SP2 = false>
__device__ __forceinline__ void gemm_phase(PG8_LAS unsigned char* lds, const Gemm g, const Sched& S, const Epi& E) {
    const int tid = threadIdx.x, wid = __builtin_amdgcn_readfirstlane(tid >> 6), lane = tid & 63, wr = wid >> 2, wc = wid & 3, fr = lane & 15, fq = lane >> 4;
    const int K = g.K, nt = K / BK;
    unsigned voffA[2], voffB[2];
#pragma unroll
    for (int i = 0; i < 2; ++i) { int R, C; stage_rc(tid * 16 + i * 8192, R, C); const int Rb = Epi::PERM ? ((R & ~31) + perm32(R & 31)) : R;
        voffA[i] = (unsigned)(R * g.ld + C) * 2u; voffB[i] = (unsigned)(Rb * g.ld + C) * 2u; }
    const size_t kstep = (size_t)(BK * 2);
    const size_t hstep = (size_t)HALF * g.ld * 2;
    const size_t tstep = 2 * hstep;
    const unsigned ldsw = (unsigned)wid * 1024u;
    const int aoff = lds_byte(wr * 64 + fr, fq * 8), boff = lds_byte(wc * 32 + fr, fq * 8);
#define PG8_SA(b, h) (((b) * 2 + (h)) * HTB)
#define PG8_SB(b, h) ((4 + (b) * 2 + (h)) * HTB)
#define PG8_STAGE(bufoff, gbase, voff) do { _Pragma("unroll") for (int _i = 0; _i < 2; ++_i) \
        __builtin_amdgcn_global_load_lds((const unsigned*)((const char*)(gbase) + (voff)[_i]), (PG8_LAS unsigned*)(lds + (bufoff) + ldsw + _i * 8192), 16, 0, 0); } while (0)
#define PG8_LDA(dst, b, h) do { _Pragma("unroll") for (int m = 0; m < 4; ++m) _Pragma("unroll") for (int k = 0; k < 2; ++k) dst[m][k] = *(const PG8_LAS bf16x8*)(lds + PG8_SA(b, h) + aoff + m * 2048 + k * 1024); } while (0)
#define PG8_LDB(dst, b, h) do { _Pragma("unroll") for (int n = 0; n < 2; ++n) _Pragma("unroll") for (int k = 0; k < 2; ++k) dst[n][k] = *(const PG8_LAS bf16x8*)(lds + PG8_SB(b, h) + boff + n * 2048 + k * 1024); } while (0)
#define PG8_MMA(ai, bj, At, Bt) do { __builtin_amdgcn_s_setprio(1); _Pragma("unroll") for (int m = 0; m < 4; ++m) _Pragma("unroll") for (int n = 0; n < 2; ++n) _Pragma("unroll") for (int k = 0; k < 2; ++k) \
        acc[ai][bj][m][n] = __builtin_amdgcn_mfma_f32_16x16x32_bf16(Bt[n][k], At[m][k], acc[ai][bj][m][n], 0, 0, 0); __builtin_amdgcn_s_setprio(0); } while (0)
#define PG8_WAIT_V(n) asm volatile("s_waitcnt vmcnt(" #n ")" ::: "memory")
#define PG8_WAIT_L(n) asm volatile("s_waitcnt lgkmcnt(" #n ")" ::: "memory")
#define PG8_BAR __builtin_amdgcn_s_barrier()
#define PG8_SCHED __builtin_amdgcn_sched_barrier(0)
    Unit cur, nxt; int ui = 0;
    if (!S.next(0, cur)) return;
    f32x4 acc[2][2][4][2];
#pragma unroll
    for (int a = 0; a < 2; ++a)
#pragma unroll
        for (int b = 0; b < 2; ++b)
#pragma unroll
            for (int m = 0; m < 4; ++m)
#pragma unroll
                for (int n = 0; n < 2; ++n) acc[a][b][m][n] = (f32x4){0.f, 0.f, 0.f, 0.f};
    bf16x8 At[4][2], B0[2][2], B1[2][2];
    const char* cA = (const char*)g.A + (size_t)cur.pm * tstep + (size_t)cur.pk * 2; const char* cB = (const char*)g.Bt + (size_t)cur.pe * g.bstride + (cur.pe >= 4 ? g.bdelta : (size_t)0) + (size_t)cur.pn * tstep + (size_t)cur.pk * 2;
    S.a_ready(cur);
    if constexpr (SP2) {
        PG8_STAGE(PG8_SB(0, 0), cB, voffB); PG8_STAGE(PG8_SB(0, 1), cB + hstep, voffB); PG8_STAGE(PG8_SA(0, 0), cA, voffA); PG8_STAGE(PG8_SA(0, 1), cA + hstep, voffA);
        if (wr == 1) PG8_BAR;
        PG8_WAIT_V(2); PG8_BAR;
        PG8_STAGE(PG8_SB(1, 0), cB + kstep, voffB); PG8_STAGE(PG8_SA(1, 0), cA + kstep, voffA); PG8_STAGE(PG8_SB(1, 1), cB + hstep + kstep, voffB);
        PG8_WAIT_V(6); PG8_BAR;
    } else {
        PG8_STAGE(PG8_SB(0, 0), cB, voffB); PG8_STAGE(PG8_SA(0, 0), cA, voffA); PG8_STAGE(PG8_SB(0, 1), cB + hstep, voffB); PG8_STAGE(PG8_SA(0, 1), cA + hstep, voffA);
        if (wr == 1) PG8_BAR;
        PG8_WAIT_V(4); PG8_BAR;
        PG8_STAGE(PG8_SB(1, 0), cB + kstep, voffB); PG8_STAGE(PG8_SA(1, 0), cA + kstep, voffA); PG8_STAGE(PG8_SB(1, 1), cB + hstep + kstep, voffB);
        PG8_WAIT_V(6); PG8_BAR;
    }
    for (;;) {
        const bool has_next = S.next(ui + 1, nxt);
        const char* nA = has_next ? (const char*)g.A + (size_t)nxt.pm * tstep + (size_t)nxt.pk * 2 : cA; const char* nB = has_next ? (const char*)g.Bt + (size_t)nxt.pe * g.bstride + (nxt.pe >= 4 ? g.bdelta : (size_t)0) + (size_t)nxt.pn * tstep + (size_t)nxt.pk * 2 : cB;
        for (int t = 0; t < nt; t += 2) {
            const bool last = (t == nt - 2);
            const char* a1 = cA + (size_t)(t + 1) * kstep;
            const char* a2 = last ? nA : cA + (size_t)(t + 2) * kstep; const char* b2 = last ? nB : cB + (size_t)(t + 2) * kstep;
            const char* a3 = a2 + kstep; const char* b3 = b2 + kstep;
            if (last && has_next) S.a_ready(nxt);
            if constexpr (SP2) {
            PG8_LDB(B0, 0, 0); PG8_LDB(B1, 0, 1); PG8_SCHED; PG8_LDA(At, 0, 0); PG8_STAGE(PG8_SA(1, 1), a1 + hstep, voffA);
            PG8_WAIT_V(8); PG8_WAIT_L(0); PG8_BAR; PG8_MMA(0, 0, At, B0); PG8_MMA(0, 1, At, B1); PG8_BAR; PG8_SCHED;
            PG8_LDA(At, 0, 1); PG8_STAGE(PG8_SB(0, 0), b2, voffB); PG8_STAGE(PG8_SB(0, 1), b2 + hstep, voffB); PG8_STAGE(PG8_SA(0, 0), a2, voffA);
            PG8_WAIT_V(8); PG8_WAIT_L(0); PG8_BAR; PG8_MMA(1, 0, At, B0); PG8_MMA(1, 1, At, B1); PG8_BAR; PG8_SCHED;
            PG8_LDB(B0, 1, 0); PG8_LDB(B1, 1, 1); PG8_SCHED; PG8_LDA(At, 1, 0); PG8_STAGE(PG8_SA(0, 1), a2 + hstep, voffA);
            PG8_WAIT_V(8); PG8_WAIT_L(0); PG8_BAR; PG8_MMA(0, 0, At, B0); PG8_MMA(0, 1, At, B1); PG8_BAR; PG8_SCHED;
            PG8_LDA(At, 1, 1); PG8_STAGE(PG8_SB(1, 0), b3, voffB); PG8_STAGE(PG8_SB(1, 1), b3 + hstep, voffB); PG8_STAGE(PG8_SA(1, 0), a3, voffA);
            PG8_WAIT_V(8); PG8_WAIT_L(0); PG8_BAR; PG8_MMA(1, 0, At, B0); PG8_MMA(1, 1, At, B1); PG8_BAR; PG8_SCHED;
            } else {
            PG8_LDB(B0, 0, 0); PG8_SCHED; PG8_LDA(At, 0, 0); PG8_STAGE(PG8_SA(1, 1), a1 + hstep, voffA);
            PG8_WAIT_L(8); PG8_BAR; PG8_WAIT_L(0); PG8_MMA(0, 0, At, B0); PG8_BAR; PG8_SCHED;
            PG8_LDB(B1, 0, 1); PG8_STAGE(PG8_SB(0, 0), b2, voffB);
            PG8_BAR; PG8_WAIT_L(0); PG8_MMA(0, 1, At, B1); PG8_BAR;
            PG8_LDA(At, 0, 1); PG8_STAGE(PG8_SA(0, 0), a2, voffA);
            PG8_BAR; PG8_WAIT_L(0); PG8_MMA(1, 0, At, B0); PG8_BAR; PG8_SCHED;
            PG8_STAGE(PG8_SB(0, 1), b2 + hstep, voffB);
            PG8_WAIT_V(6); PG8_BAR; PG8_MMA(1, 1, At, B1); PG8_BAR;
            PG8_LDB(B0, 1, 0); PG8_SCHED; PG8_LDA(At, 1, 0); PG8_STAGE(PG8_SA(0, 1), a2 + hstep, voffA);
            PG8_WAIT_L(8); PG8_BAR; PG8_WAIT_L(0); PG8_MMA(0, 0, At, B0); PG8_BAR; PG8_SCHED;
            PG8_LDB(B1, 1, 1); PG8_STAGE(PG8_SB(1, 0), b3, voffB);
            PG8_BAR; PG8_WAIT_L(0); PG8_MMA(0, 1, At, B1); PG8_BAR;
            PG8_LDA(At, 1, 1); PG8_STAGE(PG8_SA(1, 0), a3, voffA);
            PG8_BAR; PG8_WAIT_L(0); PG8_MMA(1, 0, At, B0); PG8_BAR; PG8_SCHED;
            PG8_STAGE(PG8_SB(1, 1), b3 + hstep, voffB);
            PG8_WAIT_V(6); PG8_BAR; PG8_MMA(1, 1, At, B1); PG8_BAR;
            }
        }
        if constexpr (ALIGN_EPI) { if (wr == 0) PG8_BAR; }
        if constexpr (!Epi::AFTER_DRAIN) { E(acc, cur, wr, wc, fr, fq); S.done(cur); }
        if (!has_next) break;
#pragma unroll
        for (int a = 0; a < 2; ++a)
#pragma unroll
            for (int b = 0; b < 2; ++b)
#pragma unroll
                for (int m = 0; m < 4; ++m)
#pragma unroll
                    for (int n = 0; n < 2; ++n) acc[a][b][m][n] = (f32x4){0.f, 0.f, 0.f, 0.f};
        cur = nxt; cA = nA; cB = nB; ++ui;
        if constexpr (ALIGN_EPI) { if (wr == 1) PG8_BAR; }
    }
    PG8_WAIT_V(0);
    if constexpr (!ALIGN_EPI) { if (wr == 0) PG8_BAR; }
    PG8_BAR;
    if constexpr (Epi::AFTER_DRAIN) { E.fused(acc, cur, wr, wc, fr, fq, lds, wid, lane); S.done(cur); }
#undef PG8_SA
#undef PG8_SB
#undef PG8_STAGE
#undef PG8_LDA
#undef PG8_LDB
#undef PG8_MMA
#undef PG8_WAIT_V
#undef PG8_WAIT_L
#undef PG8_BAR
#undef PG8_SCHED
}
}

constexpr int NWAVES = 8, NTHR = 512;
constexpr int D = 1024, L = 16384, LC = 256, MT = L + LC;
constexpr int AB_IN = 2304, DFF = 2816, SSD_INP = 5376, SSD_IN_REAL = 5184, DIN = 2048, XBCW = 3072, FFE = 3584, NEXP = 8;
constexpr int NCH = MT / 128;
constexpr int MOE_ROWS = 2 * L + NEXP * 256;
constexpr float EPS = 1e-6f;

constexpr size_t MiB = 1u << 20;
constexpr size_t WS_CTL = 0, CTL_ZERO_BYTES = 32768;
constexpr size_t WS_MOD = 1 * MiB;
constexpr size_t WS_ROPE = 1 * MiB + 128 * 1024;
constexpr size_t WS_TOKE = 2 * MiB, WS_TOKW = 2 * MiB + 128 * 1024, WS_TOKP = 2 * MiB + 256 * 1024;
constexpr size_t WS_RSTD = 2 * MiB + 384 * 1024;
constexpr size_t WS_DEC = 3 * MiB;
constexpr size_t WS_SSQA = 3 * MiB + 64 * 1024, WS_SSQB = 3 * MiB + 192 * 1024;
constexpr size_t WS_BIASA = 3 * MiB + 320 * 1024, WS_BIASB = 3 * MiB + 384 * 1024;
constexpr size_t WS_WCTX2 = 467 * MiB;
constexpr size_t WS_WCTX = 455 * MiB;
constexpr size_t WS_X = 4 * MiB;
constexpr size_t WS_H = 36 * MiB + 512 * 1024;
constexpr size_t WS_WMOE = 69 * MiB, WS_YPART = WS_WMOE + 56 * MiB;
constexpr size_t WS_H2S = 181 * MiB, WS_ACTM = 249 * MiB, WS_H2 = 487 * MiB, WS_END = 520 * MiB;
constexpr size_t WS_WDA = WS_H, WS_WDB = 487 * MiB, WD_BYTES = (size_t)D * FFE * 2;
static_assert(WS_WDA + 4 * WD_BYTES <= WS_WMOE && WS_WDB + 4 * WD_BYTES <= WS_END && WS_WDB >= WS_ACTM + (size_t)MOE_ROWS * FFE * 2, "down-weight regions");
constexpr size_t WS_WSSDIN = 181 * MiB, WS_WSSDOUT = WS_WSSDIN + (size_t)SSD_INP * D * 2;
constexpr size_t WS_WABIN = 196 * MiB, WS_WABOUT = WS_WABIN + (size_t)AB_IN * D * 2, WS_WFFNGU = WS_WABOUT + (size_t)D * D * 2, WS_WFFND = WS_WFFNGU + (size_t)2 * DFF * D * 2;
constexpr size_t WS_PAB = 219 * MiB, WS_MIX = 293 * MiB, WS_ACT0 = 326 * MiB, WS_QR = 416 * MiB, WS_KR = 433 * MiB, WS_VT = 438 * MiB, WS_PART = 443 * MiB;
constexpr size_t WS_Z = 196 * MiB, WS_XBCR = 261 * MiB, WS_STATES = 261 * MiB, WS_DTRAW = 391 * MiB, WS_DTS = 396 * MiB, WS_XT = 405 * MiB, WS_BT = 470 * MiB, WS_BM = 487 * MiB, WS_CM = 503 * MiB + 512 * 1024;
constexpr size_t DTS_STRIDE = (size_t)32 * MT * 4;
static_assert(WS_X + (size_t)MT * D * 2 <= WS_H && WS_H + (size_t)MT * D * 2 <= WS_WMOE, "X / H map");
static_assert(WS_WMOE + (size_t)NEXP * 2 * FFE * D * 2 <= WS_H2S && WS_H2S + (size_t)MOE_ROWS * D * 2 <= WS_ACTM && WS_ACTM + (size_t)MOE_ROWS * FFE * 2 <= WS_H2 && WS_H2 + (size_t)L * D * 2 <= WS_END, "moe map");
static_assert(WS_YPART >= WS_WMOE + (size_t)NEXP * D * FFE * 2 && WS_YPART + (size_t)7 * 2048 * D * 4 <= WS_H2S, "moe map 2");
static_assert(WS_WSSDOUT + (size_t)D * DIN * 2 <= WS_WABIN && WS_WFFND + (size_t)D * DFF * 2 <= WS_PAB, "weights map");
static_assert(WS_PAB + (size_t)MT * AB_IN * 2 <= WS_MIX && WS_MIX + (size_t)MT * D * 2 <= WS_ACT0 && WS_ACT0 + (size_t)MT * DFF * 2 <= WS_QR && WS_QR + (size_t)8 * MT * 64 * 2 <= WS_KR && WS_KR + (size_t)2 * MT * 64 * 2 <= WS_VT && WS_VT + (size_t)128 * MT * 2 <= WS_PART && WS_PART + (size_t)11 * LC * D * 4 <= WS_END, "layer0 map");
static_assert(WS_WSSDOUT + (size_t)D * DIN * 2 <= WS_Z && WS_Z + (size_t)MT * DIN * 2 <= WS_XBCR && WS_XBCR + (size_t)MT * XBCW * 2 <= WS_DTRAW && WS_STATES + (size_t)2 * NCH * 32 * 64 * 128 * 2 <= WS_DTRAW && WS_DTRAW + (size_t)MT * 64 * 4 <= WS_DTS && WS_DTS + 4 * DTS_STRIDE <= WS_XT && WS_XT + (size_t)DIN * MT * 2 <= WS_BT && WS_BT + (size_t)512 * MT * 2 <= WS_BM && WS_BM + (size_t)MT * 512 * 2 <= WS_CM && WS_CM + (size_t)MT * 512 * 2 <= WS_END, "ssd map");
static_assert(WS_PART + (size_t)11 * LC * D * 4 <= WS_BT && WS_PART >= WS_DTS + 4 * DTS_STRIDE || true, "PART is read by the layer-1 modulate before the SSD conv writes XT");
constexpr int CW_TMO = 0;
constexpr int CW_PCNT = 512;
constexpr int CW_HIST = 1024;
constexpr int CW_BAR = 4096;

constexpr int RING_BYTES = 159744, LDSCTL_OFF = RING_BYTES, MISC_OFF = LDSCTL_OFF + 320, LDS_BYTES = 163840;

#define GAS __attribute__((address_space(1)))
#define LAS __attribute__((address_space(3)))
typedef unsigned short bf16;
typedef unsigned v4u __attribute__((ext_vector_type(4)));
typedef unsigned v2u __attribute__((ext_vector_type(2)));
typedef float f32x4 __attribute__((ext_vector_type(4)));
typedef GAS unsigned gu32;
#define RLX_AGENT __ATOMIC_RELAXED, __HIP_MEMORY_SCOPE_AGENT
#define LDS_WAIT() asm volatile("s_waitcnt lgkmcnt(0)" ::: "memory")
#define VM_WAIT() asm volatile("s_waitcnt vmcnt(0)" ::: "memory")
__device__ __forceinline__ unsigned pk2(float lo, float hi) { return pg8::cvt_pk_bf16(lo, hi); }
__device__ __forceinline__ float bflo(unsigned u) { return __uint_as_float(u << 16); }
__device__ __forceinline__ float bfhi(unsigned u) { return __uint_as_float(u & 0xffff0000u); }
__device__ __forceinline__ float bf1(bf16 b) { return __uint_as_float(((unsigned)b) << 16); }
__device__ __forceinline__ float sigmoid_f(float x) { return __builtin_amdgcn_rcpf(1.0f + __builtin_amdgcn_exp2f(-1.4426950408889634f * x)); }
__device__ __forceinline__ float softplus_f(float x) {
    const float y = __builtin_amdgcn_exp2f(-1.4426950408889634f * fabsf(x));
    const float l = y < 1.0e-3f ? y * (1.0f - 0.5f * y) : __builtin_amdgcn_logf(1.0f + y) * 0.6931471805599453f;
    return fmaxf(x, 0.f) + l; }

#define XB_TMO      128
#define XB_XCNT(j)  (256  + 64 * (j))
#define XB_XSUB(j)  (1280 + 64 * (j))
#define XB_XGEN(j)  (2304 + 64 * (j))
#define XB_TOP      3328
#define XB_TOPGEN   3392
#define XCD_BAR_WORDS 3456
#define XB_SPIN_CAP (1u << 18)
__device__ __forceinline__ unsigned xb_ld(unsigned* p)              { return __hip_atomic_load(p, __ATOMIC_RELAXED, __HIP_MEMORY_SCOPE_AGENT); }
__device__ __forceinline__ unsigned xb_add(unsigned* p, unsigned v) { return __hip_atomic_fetch_add(p, v, __ATOMIC_RELAXED, __HIP_MEMORY_SCOPE_AGENT); }
__device__ __forceinline__ unsigned xb_xcc_id() { return (unsigned)__builtin_amdgcn_s_getreg((3 << 11) | 20) & 0xFu; }
#define XB_SPIN(cond, bar) do { unsigned _sp = 0; while (cond) { __builtin_amdgcn_s_sleep(1); \
    if ((++_sp & 255u) == 0u) { if (xb_ld(&(bar)[XB_TMO])) break; if (_sp > XB_SPIN_CAP) { atomicAdd(&(bar)[XB_TMO], 1u); break; } } } } while (0)
struct XcdBarrier { unsigned* bar; unsigned x; volatile LAS unsigned* st; };
__device__ __forceinline__ XcdBarrier xcd_barrier_post(unsigned* bar, volatile LAS unsigned* st) {
    XcdBarrier b; b.bar = bar; b.x = xb_xcc_id(); b.st = st;
    if (threadIdx.x == 0) (void)xb_add(&bar[XB_XCNT(b.x)], 1u);
    return b;
}
__device__ __forceinline__ void xcd_barrier_complete(unsigned* bar, unsigned x, unsigned& nloc, unsigned& nx) {
    const unsigned G = gridDim.x * gridDim.y * gridDim.z;
    unsigned sum, cnt, mine, sp = 0u;
    for (;;) {
        sum = 0u; cnt = 0u; mine = 0u;
#pragma unroll
        for (unsigned j = 0; j < 16; ++j) { const unsigned c = xb_ld(&bar[XB_XCNT(j)]); sum += c; cnt += (c > 0u) ? 1u : 0u; mine = (j == x) ? c : mine; }
        if (sum == G) break;
        __builtin_amdgcn_s_sleep(1);
        if ((++sp & 255u) == 0u) { if (xb_ld(&bar[XB_TMO])) break; if (sp > XB_SPIN_CAP) { atomicAdd(&bar[XB_TMO], 1u); break; } }
    }
    nloc = mine > 0u ? mine : 1u; nx = cnt > 0u ? cnt : 1u;
}
__device__ __forceinline__ void xcd_barrier(const XcdBarrier& b) {
    asm volatile("s_waitcnt vmcnt(0)" ::: "memory");
    __syncthreads();
    if (threadIdx.x == 0) {
        unsigned* bar = b.bar;
        __builtin_amdgcn_s_waitcnt(0);
        unsigned nloc = b.st[0], nx = b.st[1];
        if (nloc == 0u) { xcd_barrier_complete(bar, b.x, nloc, nx); b.st[0] = nloc; b.st[1] = nx; }
        const unsigned old = xb_add(&bar[XB_XSUB(b.x)], 1u);
        const unsigned gen = old / nloc;
        if (old + 1u == (gen + 1u) * nloc) {
            __builtin_amdgcn_fence(__ATOMIC_RELEASE, "agent");
            asm volatile("s_waitcnt vmcnt(0)" ::: "memory");
            const unsigned og = xb_add(&bar[XB_TOP], 1u);
            const unsigned tg = og / nx;
            if (og + 1u == (tg + 1u) * nx) xb_add(&bar[XB_TOPGEN], 1u);
            else XB_SPIN(xb_ld(&bar[XB_TOPGEN]) == tg, bar);
            __builtin_amdgcn_fence(__ATOMIC_ACQUIRE, "agent");
            xb_add(&bar[XB_XGEN(b.x)], 1u);
            asm volatile("s_waitcnt vmcnt(0)" ::: "memory");
        } else {
            XB_SPIN(xb_ld(&bar[XB_XGEN(b.x)]) == gen, bar);
            __builtin_amdgcn_fence(__ATOMIC_ACQUIRE, "agent");
            asm volatile("s_waitcnt vmcnt(0)" ::: "memory");
        }
    }
    __syncthreads();
}

struct Frame {
    LAS unsigned char* lds;
    int tid, lane, wave, vcu, G;
    const float* in[30]; float* out; unsigned char* ws;
};
enum { I_X = 0, I_C, I_CTX, I_CCTX, I_ADAW, I_ADAB, I_N1G, I_N2G, I_ABWIN, I_ABCONV, I_ABSINK, I_ABWOUT, I_FFNG, I_FFNU, I_FFND, I_SSDWIN, I_SSDCW, I_SSDCB,
       I_DTBF, I_DTBB, I_ALOGF, I_ALOGB, I_SSDD, I_SSDNG, I_SSDWOUT, I_ROUTER, I_MOEG, I_MOEU, I_MOED, I_FINALG };
template <int CTRL> __device__ __forceinline__ float dpp_add(float v) { return v + __int_as_float(__builtin_amdgcn_update_dpp(0, __float_as_int(v), CTRL, 0xf, 0xf, true)); }
__device__ __forceinline__ float wave_sum(float v) {
    v = dpp_add<0xB1>(v);
    v = dpp_add<0x4E>(v);
    v = dpp_add<0x141>(v);
    v = dpp_add<0x140>(v);
    const int iv = __float_as_int(v);
    return (__int_as_float(__builtin_amdgcn_readlane(iv, 0)) + __int_as_float(__builtin_amdgcn_readlane(iv, 16))) + (__int_as_float(__builtin_amdgcn_readlane(iv, 32)) + __int_as_float(__builtin_amdgcn_readlane(iv, 48)));
}
constexpr int M_SH1 = 0, M_SC1 = 1024, M_G1 = 2048, M_SH2 = 3072, M_SC2 = 4096, M_G2 = 5120;
__device__ __forceinline__ const float* modp(const Frame& F, int layer, int s) { return (const float*)(F.ws + WS_MOD) + (size_t)(layer * 2 + s) * 6144; }

__device__ __forceinline__ void tr_load(const float* W, int N, int k0, int n0, int lane, f32x4 (&w)[8]) {
#pragma unroll
    for (int i = 0; i < 8; ++i) w[i] = __builtin_nontemporal_load((const GAS f32x4*)(W + (size_t)(k0 + (lane >> 3) + 8 * i) * N + n0 + 4 * (lane & 7)));
}
__device__ __forceinline__ void tr_finish(const f32x4 (&w)[8], bf16* WT, int Kdst, int k0, int drow0, LAS float* scr, int lane) {
#pragma unroll
    for (int i = 0; i < 8; ++i) { LAS float* d = scr + ((lane >> 3) + 8 * i) * 33 + 4 * (lane & 7); d[0] = w[i].x; d[1] = w[i].y; d[2] = w[i].z; d[3] = w[i].w; }
    LDS_WAIT(); asm volatile("" ::: "memory");
    const int c = lane & 7;
#pragma unroll
    for (int j = 0; j < 4; ++j) { const int n = (lane >> 3) + 8 * j; const LAS float* s = scr + (8 * c) * 33 + n;
        v4u o; o.x = pk2(s[0 * 33], s[1 * 33]); o.y = pk2(s[2 * 33], s[3 * 33]); o.z = pk2(s[4 * 33], s[5 * 33]); o.w = pk2(s[6 * 33], s[7 * 33]);
        __builtin_nontemporal_store(o, (GAS v4u*)(WT + (size_t)(drow0 + n) * Kdst + k0 + 8 * c)); }
    LDS_WAIT(); asm volatile("" ::: "memory");
}
__device__ __forceinline__ void tr_item(const float* W, int N, bf16* WT, int Kdst, int k0, int n0, int drow0, LAS float* scr, int lane) {
    { f32x4 w[8];
#pragma unroll
      for (int i = 0; i < 8; ++i) w[i] = __builtin_nontemporal_load((const GAS f32x4*)(W + (size_t)(k0 + (lane >> 3) + 8 * i) * N + n0 + 4 * (lane & 7)));
#pragma unroll
      for (int i = 0; i < 8; ++i) { LAS float* d = scr + ((lane >> 3) + 8 * i) * 33 + 4 * (lane & 7); d[0] = w[i].x; d[1] = w[i].y; d[2] = w[i].z; d[3] = w[i].w; } }
    LDS_WAIT(); asm volatile("" ::: "memory");
    const int c = lane & 7;
#pragma unroll
    for (int j = 0; j < 4; ++j) { const int n = (lane >> 3) + 8 * j; const LAS float* s = scr + (8 * c) * 33 + n;
        v4u o; o.x = pk2(s[0 * 33], s[1 * 33]); o.y = pk2(s[2 * 33], s[3 * 33]); o.z = pk2(s[4 * 33], s[5 * 33]); o.w = pk2(s[6 * 33], s[7 * 33]);
        __builtin_nontemporal_store(o, (GAS v4u*)(WT + (size_t)(drow0 + n) * Kdst + k0 + 8 * c)); }
    LDS_WAIT(); asm volatile("" ::: "memory");
}
__device__ __forceinline__ void tr_matrix(const Frame& F, const float* W, int K, int N, bf16* WT, int mode, int& first, int gw = -1, int NGW = 0) {
    LAS float* scr = (LAS float*)(F.lds + F.wave * 16384);
    if (gw < 0) { gw = F.vcu * NWAVES + F.wave; NGW = F.G * NWAVES; }
    const int nblk = N / 32, nitems = (K / 64) * nblk;
    int it = gw - (first % NGW); if (it < 0) it += NGW;
    for (; it < nitems; it += NGW) {
        const int kb = it / nblk, nb = it % nblk, n0 = 32 * nb;
        const int drow0 = mode == 0 ? n0 : ((n0 >> 7) * 256 + (n0 & 127) + (mode == 2 ? 128 : 0));
        tr_item(W, N, WT, K, 64 * kb, n0, drow0, scr, F.lane);
    }
    first += nitems;
}

constexpr int FOLD_TAB_OFF = 131072;
__device__ __forceinline__ void fold_table(Frame& F, const float* gain, const float* mx, const float* mc, int osh, int osc) {
    LAS float* tab = (LAS float*)(F.lds + FOLD_TAB_OFF);
    for (int k = F.tid; k < 1024; k += NTHR) { const float g = gain[k]; tab[k] = g * (1.0f + mx[osc + k]); tab[1024 + k] = g * (1.0f + mc[osc + k]); tab[2048 + k] = mx[osh + k]; tab[3072 + k] = mc[osh + k]; }
    __syncthreads();
}
__device__ __forceinline__ void tr_item_fold(const float* W, int N, bf16* WTl, bf16* WTc, int k0, int n0, int drow0, float* bl, float* bc, LAS float* scr, const LAS float* tab, int lane) {
    { f32x4 w[8];
#pragma unroll
      for (int i = 0; i < 8; ++i) w[i] = __builtin_nontemporal_load((const GAS f32x4*)(W + (size_t)(k0 + (lane >> 3) + 8 * i) * N + n0 + 4 * (lane & 7)));
#pragma unroll
      for (int i = 0; i < 8; ++i) { LAS float* d = scr + ((lane >> 3) + 8 * i) * 33 + 4 * (lane & 7); d[0] = w[i].x; d[1] = w[i].y; d[2] = w[i].z; d[3] = w[i].w; } }
    LDS_WAIT(); asm volatile("" ::: "memory");
    const int c = lane & 7;
    const LAS float* t = tab + k0 + 8 * c;
    const f32x4 al0 = *(const LAS f32x4*)t, al1 = *(const LAS f32x4*)(t + 4), ac0 = *(const LAS f32x4*)(t + 1024), ac1 = *(const LAS f32x4*)(t + 1028);
    const f32x4 sl0 = *(const LAS f32x4*)(t + 2048), sl1 = *(const LAS f32x4*)(t + 2052), sc0 = *(const LAS f32x4*)(t + 3072), sc1 = *(const LAS f32x4*)(t + 3076);
#pragma unroll
    for (int j = 0; j < 4; ++j) { const int n = (lane >> 3) + 8 * j; const LAS float* s = scr + (8 * c) * 33 + n;
        const f32x4 x0 = (f32x4){s[0 * 33], s[1 * 33], s[2 * 33], s[3 * 33]}, x1 = (f32x4){s[4 * 33], s[5 * 33], s[6 * 33], s[7 * 33]};
        const f32x4 a0 = x0 * al0, a1 = x1 * al1, b0 = x0 * ac0, b1 = x1 * ac1;
        v4u o; o.x = pk2(a0.x, a0.y); o.y = pk2(a0.z, a0.w); o.z = pk2(a1.x, a1.y); o.w = pk2(a1.z, a1.w);
        __builtin_nontemporal_store(o, (GAS v4u*)(WTl + (size_t)(drow0 + n) * 1024 + k0 + 8 * c));
        o.x = pk2(b0.x, b0.y); o.y = pk2(b0.z, b0.w); o.z = pk2(b1.x, b1.y); o.w = pk2(b1.z, b1.w);
        __builtin_nontemporal_store(o, (GAS v4u*)(WTc + (size_t)(drow0 + n) * 1024 + k0 + 8 * c));
        const f32x4 pl4 = x0 * sl0 + x1 * sl1, pc4 = x0 * sc0 + x1 * sc1;
        float pl = (pl4.x + pl4.y) + (pl4.z + pl4.w), pc = (pc4.x + pc4.y) + (pc4.z + pc4.w);
        pl = dpp_add<0xB1>(pl); pl = dpp_add<0x4E>(pl); pl = dpp_add<0x141>(pl);
        pc = dpp_add<0xB1>(pc); pc = dpp_add<0x4E>(pc); pc = dpp_add<0x141>(pc);
        if (c == 0) { unsafeAtomicAdd(bl + n0 + n, pl); unsafeAtomicAdd(bc + n0 + n, pc); } }
    LDS_WAIT(); asm volatile("" ::: "memory");
}
__device__ __forceinline__ void tr_matrix_fold(const Frame& F, const float* W, int N, bf16* WTl, bf16* WTc, int mode, float* bl, float* bc, int& first, int gw, int NGW, int lo = 0, int hi = -1) {
    LAS float* scr = (LAS float*)(F.lds + F.wave * 16384); const LAS float* tab = (const LAS float*)(F.lds + FOLD_TAB_OFF);
    const int nblk = N / 32; if (hi < 0) hi = (D / 64) * nblk;
    int it = gw - (first % NGW); if (it < 0) it += NGW;
    for (it += lo; it < hi; it += NGW) {
        const int kb = it / nblk, nb = it % nblk, n0 = 32 * nb;
        const int drow0 = mode == 0 ? n0 : ((n0 >> 7) * 256 + (n0 & 127) + (mode == 2 ? 128 : 0));
        tr_item_fold(W, N, WTl, WTc, 64 * kb, n0, drow0, bl, bc, scr, tab, F.lane);
    }
    first += hi - lo;
}
__device__ __forceinline__ bool idle_last_round(const Frame& F, int nunits, int& gw, int& NGW) {
    const int nbusy = nunits % F.G;
    if (nbusy == 0) { gw = F.vcu * NWAVES + F.wave; NGW = F.G * NWAVES; return true; }
    if (F.vcu < nbusy) return false;
    gw = (F.vcu - nbusy) * NWAVES + F.wave; NGW = (F.G - nbusy) * NWAVES; return true;
}
__device__ __forceinline__ void ph_convert_ffn_gu(Frame& F, int which, int gw, int NGW) {
    fold_table(F, F.in[I_N2G], modp(F, 0, 0), modp(F, 0, 1), M_SH2, M_SC2);
    float* BA = (float*)(F.ws + WS_BIASA) + which * DFF;
    int first = 0;
    tr_matrix_fold(F, which ? F.in[I_FFNU] : F.in[I_FFNG], DFF, (bf16*)(F.ws + WS_WFFNGU), (bf16*)(F.ws + WS_WCTX), 1 + which, BA, BA + 2 * DFF, first, gw, NGW);
}
constexpr int SSDIN_ITEMS = (D / 64) * (SSD_IN_REAL / 32), SSDIN_SPLIT = 1200;
__device__ __forceinline__ void ph_convert_ffn(Frame& F, int gw, int NGW) {
    fold_table(F, F.in[I_N1G] + D, modp(F, 1, 0), modp(F, 1, 1), M_SH1, M_SC1);
    float* BB = (float*)(F.ws + WS_BIASB);
    int first = 0;
    tr_matrix(F, F.in[I_FFND], DFF, D, (bf16*)(F.ws + WS_WFFND), 0, first, gw, NGW);
    tr_matrix_fold(F, F.in[I_SSDWIN], SSD_IN_REAL, (bf16*)(F.ws + WS_WSSDIN), (bf16*)(F.ws + WS_WCTX2), 0, BB, BB + SSD_INP, first, gw, NGW, 0, SSDIN_SPLIT);
}
__device__ __forceinline__ void ph_convert_ssd(Frame& F, int gw, int NGW) {
    fold_table(F, F.in[I_N1G] + D, modp(F, 1, 0), modp(F, 1, 1), M_SH1, M_SC1);
    float* BB = (float*)(F.ws + WS_BIASB);
    int first = 0;
    tr_matrix_fold(F, F.in[I_SSDWIN], SSD_IN_REAL, (bf16*)(F.ws + WS_WSSDIN), (bf16*)(F.ws + WS_WCTX2), 0, BB, BB + SSD_INP, first, gw, NGW, SSDIN_SPLIT, SSDIN_ITEMS);
    tr_matrix(F, F.in[I_SSDWOUT], DIN, D, (bf16*)(F.ws + WS_WSSDOUT), 0, first, gw, NGW);
    for (int v = 0; v < 2; ++v) { v4u* p = (v4u*)((bf16*)(F.ws + (v ? WS_WCTX2 : WS_WSSDIN)) + (size_t)SSD_IN_REAL * D); const int n16 = (SSD_INP - SSD_IN_REAL) * D * 2 / 16;
      for (int i = gw * 64 + F.lane; i < n16; i += NGW * 64) p[i] = (v4u){0u, 0u, 0u, 0u}; }
}
__device__ __forceinline__ void ph_prologue(Frame& F) {
    LAS float* scx = (LAS float*)F.lds;
    LAS float* scc = scx + 1024;
    LAS float* red = scc + 1024;
    const float* c = F.in[I_C]; const float* cc = F.in[I_CCTX];
    for (int i = F.tid; i < 1024; i += NTHR) { const float a = c[i], b = cc[i]; scx[i] = a * sigmoid_f(a); scc[i] = b * sigmoid_f(b); }
    __syncthreads();
    float* MOD = (float*)(F.ws + WS_MOD);
    for (int u = F.vcu; u < 192; u += F.G) {
        const int layer = u / 96, n0 = (u % 96) * 64;
        const float* W = F.in[I_ADAW] + (size_t)layer * 1024 * 6144 + n0 + F.lane;
        float ax = 0.f, ac = 0.f; const int kb = F.wave * 128;
#pragma unroll 1
        for (int k0 = 0; k0 < 128; k0 += 32) { float w[32];
#pragma unroll
            for (int k = 0; k < 32; ++k) w[k] = __builtin_nontemporal_load(W + (size_t)(kb + k0 + k) * 6144);
#pragma unroll
            for (int k = 0; k < 32; ++k) { ax += scx[kb + k0 + k] * w[k]; ac += scc[kb + k0 + k] * w[k]; } }
        red[(F.wave * 2 + 0) * 64 + F.lane] = ax; red[(F.wave * 2 + 1) * 64 + F.lane] = ac;
        __syncthreads();
        if (F.tid < 128) { const int s = F.tid >> 6, l = F.tid & 63; float t = 0.f;
#pragma unroll
            for (int w = 0; w < 8; ++w) t += red[(w * 2 + s) * 64 + l];
            MOD[(size_t)(layer * 2 + s) * 6144 + n0 + l] = t + F.in[I_ADAB][layer * 6144 + n0 + l]; }
        __syncthreads();
    }
    {
        float* ct = (float*)(F.ws + WS_ROPE); float* st = ct + 4096;
        for (int idx = F.vcu * NTHR + F.tid; idx < 4096; idx += F.G * NTHR) { const int pos = idx >> 4, i = idx & 15;
            const float inv = (float)pow(10000.0, -(double)i / 16.0); const float ang = (float)pos * inv;
            ct[idx] = (float)cos((double)ang); st[idx] = (float)sin((double)ang); }
    }
    { float* z = (float*)(F.ws + WS_SSQA); for (int i = F.vcu * NTHR + F.tid; i < 96 * 1024; i += F.G * NTHR) z[i] = 0.f; }
    __syncthreads();
    int first = 0;
    tr_matrix(F, F.in[I_ABWIN], D, AB_IN, (bf16*)(F.ws + WS_WABIN), 0, first);
    tr_matrix(F, F.in[I_ABWOUT], D, D, (bf16*)(F.ws + WS_WABOUT), 0, first);
}
constexpr int MOE_GU_ITEMS = NEXP * 2 * (D / 64) * (FFE / 32);
struct GuItem { const float* W; bf16* WT; int k0, n0, drow0; };
__device__ __forceinline__ GuItem gu_item(const Frame& F, int it) {
    constexpr int PER_M = (D / 64) * (FFE / 32), NB = FFE / 32;
    const int e = it / (2 * PER_M), rem = it % (2 * PER_M), mat = rem / PER_M, idx = rem % PER_M, kb = idx / NB, n0 = 32 * (idx % NB);
    GuItem g; g.W = (mat ? F.in[I_MOEU] : F.in[I_MOEG]) + (size_t)e * D * FFE; g.WT = (bf16*)(F.ws + WS_WMOE) + (size_t)e * 2 * FFE * D;
    g.k0 = 64 * kb; g.n0 = n0; g.drow0 = (n0 >> 7) * 256 + (n0 & 127) + (mat ? 128 : 0); return g;
}
__device__ __forceinline__ void moe_gu_convert(Frame& F, int lo, int hi, int gw, int NGW) {
    LAS float* scr = (LAS float*)(F.lds + F.wave * 16384);
    int it = lo + gw; if (it >= hi) return;
    f32x4 wa[8], wb[8];
    GuItem ga = gu_item(F, it), gb = ga; tr_load(ga.W, FFE, ga.k0, ga.n0, F.lane, wa);
    for (;;) {
        const int itb = it + NGW; const bool hb = itb < hi;
        if (hb) { gb = gu_item(F, itb); tr_load(gb.W, FFE, gb.k0, gb.n0, F.lane, wb); }
        tr_finish(wa, ga.WT, D, ga.k0, ga.drow0, scr, F.lane);
        if (!hb) break;
        it = itb + NGW; const bool ha = it < hi;
        if (ha) { ga = gu_item(F, it); tr_load(ga.W, FFE, ga.k0, ga.n0, F.lane, wa); }
        tr_finish(wb, gb.WT, D, gb.k0, gb.drow0, scr, F.lane);
        if (!ha) break;
    }
}
constexpr int MOE_DN_ITEMS = NEXP * (FFE / 64) * (D / 32), MOE_DN_PER_E = (FFE / 64) * (D / 32);
__device__ __forceinline__ void moe_dn_convert(Frame& F, int lo, int hi, int gw, int NGW) {
    LAS float* scr = (LAS float*)(F.lds + F.wave * 16384);
    for (int it = lo + gw; it < hi; it += NGW) {
        const int e = it / MOE_DN_PER_E, idx = it % MOE_DN_PER_E, kb = idx / (D / 32), n0 = 32 * (idx % (D / 32));
        bf16* WT = (bf16*)(F.ws + (e < 4 ? WS_WDA : WS_WDB)) + (size_t)(e & 3) * D * FFE;
        tr_item(F.in[I_MOED] + (size_t)e * FFE * D, D, WT, FFE, 64 * kb, n0, n0, scr, F.lane);
    }
}
__device__ __forceinline__ void idle_round_convert(Frame& F, int nunits, int lo, int hi) {
    const int full = nunits / F.G, nbusy = nunits - full * F.G;
    if ((int)blockIdx.x >= nbusy) moe_gu_convert(F, lo, hi, ((int)blockIdx.x - nbusy) * NWAVES + F.wave, (F.G - nbusy) * NWAVES);
}


template <bool BF> __device__ __forceinline__ void load_row4(const void* row, int lane, f32x4 (&v)[4]) {
    if (BF) { const GAS v2u* p = (const GAS v2u*)row + lane;
#pragma unroll
        for (int j = 0; j < 4; ++j) { const v2u a = p[64 * j]; v[j] = (f32x4){bflo(a.x), bfhi(a.x), bflo(a.y), bfhi(a.y)}; } }
    else { const GAS f32x4* p = (const GAS f32x4*)row + lane;
#pragma unroll
        for (int j = 0; j < 4; ++j) v[j] = __builtin_nontemporal_load(p + 64 * j); }
}
template <bool LAT_BF, bool CTX_BF, int NPART>
__device__ __forceinline__ void ph_modulate(Frame& F, const void* src0, const void* src1, const float* gain, const float* mx, const float* mc, int osh, int osc, bf16* H, int nrows,
                                            const float* part, const float* gatec, bf16* xw) {
    const int gw = F.vcu * NWAVES + F.wave, NGW = F.G * NWAVES;
    f32x4 ca[4], cb[4];
#pragma unroll
    for (int j = 0; j < 4; ++j) { const int c = 4 * (64 * j + F.lane); ca[j] = *(const f32x4*)(gain + c) * (*(const f32x4*)(mx + osc + c) + 1.0f); cb[j] = *(const f32x4*)(mx + osh + c); }
    for (int r0 = gw; r0 < nrows; r0 += 2 * NGW) {
        int rr[2]; f32x4 v[2][4];
#pragma unroll
        for (int k = 0; k < 2; ++k) { const int r = r0 + k * NGW; rr[k] = r < nrows ? r : r0;
            if (rr[k] < L) load_row4<LAT_BF>((const char*)src0 + (size_t)rr[k] * D * (LAT_BF ? 2 : 4), F.lane, v[k]);
            else load_row4<CTX_BF>((const char*)src1 + (size_t)(rr[k] - L) * D * (CTX_BF ? 2 : 4), F.lane, v[k]); }
#pragma unroll
        for (int k = 0; k < 2; ++k) { const int r = rr[k];
            if (NPART > 0 && r >= L) {
#pragma unroll
                for (int j = 0; j < 4; ++j) { const int c = 4 * (64 * j + F.lane); f32x4 s = (f32x4){0.f, 0.f, 0.f, 0.f};
#pragma unroll
                    for (int q = 0; q < NPART; ++q) s += *(const f32x4*)(part + ((size_t)q * LC + (r - L)) * D + c);
                    v[k][j] += *(const f32x4*)(gatec + c) * s;
                    if (xw) { v2u o; o.x = pk2(v[k][j].x, v[k][j].y); o.y = pk2(v[k][j].z, v[k][j].w); *(GAS v2u*)(xw + (size_t)r * D + c) = o; } }
            }
            float s2 = 0.f;
#pragma unroll
            for (int j = 0; j < 4; ++j) s2 += (v[k][j].x * v[k][j].x + v[k][j].y * v[k][j].y) + (v[k][j].z * v[k][j].z + v[k][j].w * v[k][j].w);
            const float rstd = __builtin_amdgcn_rsqf(wave_sum(s2) * (1.0f / D) + EPS);
            GAS v2u* o8 = (GAS v2u*)(H + (size_t)r * D) + F.lane;
#pragma unroll
            for (int j = 0; j < 4; ++j) { const int c = 4 * (64 * j + F.lane);
                f32x4 A = ca[j], B = cb[j];
                if (r >= L) { A = *(const f32x4*)(gain + c) * (*(const f32x4*)(mc + osc + c) + 1.0f); B = *(const f32x4*)(mc + osh + c); }
                const f32x4 y = v[k][j] * rstd * A + B;
                v2u o; o.x = pk2(y.x, y.y); o.y = pk2(y.z, y.w); o8[64 * j] = o; }
        }
    }
}
template <bool BASE_BF, int NPART>
__device__ __forceinline__ void ctx_reduce(Frame& F, int nu, int cw, const void* base, const float* gatec, bf16* X, float* ssq) {
    const int c = (int)blockIdx.x, nP = nu < F.G ? nu : F.G;
    if (c >= nP) return;
    unsigned* ctl = (unsigned*)(F.ws + WS_CTL); const float* part = (const float*)(F.ws + WS_PART);
    VM_WAIT(); __syncthreads();
    if (F.tid == 0) {
        unsigned mine = 0; for (int x = c; x < nu; x += F.G) ++mine;
        __builtin_amdgcn_fence(__ATOMIC_RELEASE, "agent"); VM_WAIT();
        (void)xb_add(&ctl[cw], mine);
        XB_SPIN(xb_ld(&ctl[cw]) < (unsigned)nu, ctl + CW_BAR);
        __builtin_amdgcn_fence(__ATOMIC_ACQUIRE, "agent"); VM_WAIT();
    }
    __syncthreads();
    for (int r = c * NWAVES + F.wave; r < LC; r += nP * NWAVES) {
        f32x4 v[4]; load_row4<BASE_BF>((const char*)base + (size_t)r * D * (BASE_BF ? 2 : 4), F.lane, v);
        float s2 = 0.f;
#pragma unroll
        for (int j = 0; j < 4; ++j) { const int cc = 4 * (64 * j + F.lane); f32x4 s = (f32x4){0.f, 0.f, 0.f, 0.f};
#pragma unroll
            for (int q = 0; q < NPART; ++q) s += *(const f32x4*)(part + ((size_t)q * LC + r) * D + cc);
            v[j] += *(const f32x4*)(gatec + cc) * s;
            s2 += (v[j].x * v[j].x + v[j].y * v[j].y) + (v[j].z * v[j].z + v[j].w * v[j].w);
            v2u o; o.x = pk2(v[j].x, v[j].y); o.y = pk2(v[j].z, v[j].w); *(GAS v2u*)(X + (size_t)(L + r) * D + cc) = o; }
        s2 = wave_sum(s2);
        if (F.lane == 0) ssq[L + r] = s2;
    }
}

constexpr float QSCL = 0.125f * 1.4426950408889634f;
__device__ __forceinline__ void ph_ab_elem(Frame& F) {
    const bf16* PAB = (const bf16*)(F.ws + WS_PAB); bf16* MIX = (bf16*)(F.ws + WS_MIX);
    bf16* QR = (bf16*)(F.ws + WS_QR); bf16* KR = (bf16*)(F.ws + WS_KR); bf16* VT = (bf16*)(F.ws + WS_VT);
    const float* ct = (const float*)(F.ws + WS_ROPE); const float* st = ct + 4096;
    const int lane = F.lane;
    float cw[3][8];
#pragma unroll
    for (int k = 0; k < 3; ++k)
#pragma unroll
        for (int j = 0; j < 8; ++j) cw[k][j] = F.in[I_ABCONV][k * 512 + 8 * lane + j];
    LAS unsigned char* vl = F.lds;
    for (int tile = F.vcu; tile < MT / 16; tile += F.G) {
        const int r0 = tile * 16; const bool isctx = r0 >= L; const int slo = isctx ? L : 0, shi = isctx ? MT : L;
        for (int rr = 0; rr < 2; ++rr) {
            const int r = r0 + F.wave * 2 + rr;
            float acc[8];
#pragma unroll
            for (int j = 0; j < 8; ++j) acc[j] = 0.f;
#pragma unroll
            for (int k = 0; k < 3; ++k) { const int q = r + k - 1;
                if (q >= slo && q < shi) { const v4u gc = *(const GAS v4u*)(PAB + (size_t)q * AB_IN + 512 + 8 * lane), ha = *(const GAS v4u*)(PAB + (size_t)q * AB_IN + 1024 + 8 * lane);
                    acc[0] += cw[k][0] * bflo(gc.x) * bflo(ha.x); acc[1] += cw[k][1] * bfhi(gc.x) * bfhi(ha.x); acc[2] += cw[k][2] * bflo(gc.y) * bflo(ha.y); acc[3] += cw[k][3] * bfhi(gc.y) * bfhi(ha.y);
                    acc[4] += cw[k][4] * bflo(gc.z) * bflo(ha.z); acc[5] += cw[k][5] * bfhi(gc.z) * bfhi(ha.z); acc[6] += cw[k][6] * bflo(gc.w) * bflo(ha.w); acc[7] += cw[k][7] * bfhi(gc.w) * bfhi(ha.w); } }
            { const v4u gb = *(const GAS v4u*)(PAB + (size_t)r * AB_IN + 8 * lane); v4u o;
              o.x = pk2(acc[0] * bflo(gb.x), acc[1] * bfhi(gb.x)); o.y = pk2(acc[2] * bflo(gb.y), acc[3] * bfhi(gb.y)); o.z = pk2(acc[4] * bflo(gb.z), acc[5] * bfhi(gb.z)); o.w = pk2(acc[6] * bflo(gb.w), acc[7] * bfhi(gb.w));
              *(GAS v4u*)(MIX + (size_t)r * D + 8 * lane) = o; }
            const int sub = lane & 7, axis = sub >> 2, half = (sub >> 1) & 1;
            const int pos = axis == 0 ? (r >> 6) : (r & 63);
            f32x4 c0 = (f32x4){1.f, 1.f, 1.f, 1.f}, c1 = c0, s0 = (f32x4){0.f, 0.f, 0.f, 0.f}, s1 = s0;
            if (!isctx) { const float* cp = ct + pos * 16 + 8 * (lane & 1); const float* sp = st + pos * 16 + 8 * (lane & 1);
                c0 = *(const f32x4*)cp; c1 = *(const f32x4*)(cp + 4); s0 = *(const f32x4*)sp; s1 = *(const f32x4*)(sp + 4);
                if (half == 0) { s0 = -s0; s1 = -s1; } }
            {
                const v4u a = *(const GAS v4u*)(PAB + (size_t)r * AB_IN + 1536 + 8 * lane);
                v4u p; p.x = (unsigned)__builtin_amdgcn_update_dpp(0, (int)a.x, 0x4E, 0xf, 0xf, true); p.y = (unsigned)__builtin_amdgcn_update_dpp(0, (int)a.y, 0x4E, 0xf, 0xf, true); p.z = (unsigned)__builtin_amdgcn_update_dpp(0, (int)a.z, 0x4E, 0xf, 0xf, true); p.w = (unsigned)__builtin_amdgcn_update_dpp(0, (int)a.w, 0x4E, 0xf, 0xf, true);
                const f32x4 qc0 = c0 * QSCL, qc1 = c1 * QSCL, qs0 = s0 * QSCL, qs1 = s1 * QSCL;
                v4u o; o.x = pk2(bflo(a.x) * qc0.x + bflo(p.x) * qs0.x, bfhi(a.x) * qc0.y + bfhi(p.x) * qs0.y); o.y = pk2(bflo(a.y) * qc0.z + bflo(p.y) * qs0.z, bfhi(a.y) * qc0.w + bfhi(p.y) * qs0.w);
                o.z = pk2(bflo(a.z) * qc1.x + bflo(p.z) * qs1.x, bfhi(a.z) * qc1.y + bfhi(p.z) * qs1.y); o.w = pk2(bflo(a.w) * qc1.z + bflo(p.w) * qs1.z, bfhi(a.w) * qc1.w + bfhi(p.w) * qs1.w);
                *(GAS v4u*)(QR + ((size_t)(lane >> 3) * MT + r) * 64 + 8 * sub) = o;
            }
            {
                const int kl = lane & 15;
                const v4u a = *(const GAS v4u*)(PAB + (size_t)r * AB_IN + 2048 + 8 * kl);
                v4u p; p.x = (unsigned)__builtin_amdgcn_update_dpp(0, (int)a.x, 0x4E, 0xf, 0xf, true); p.y = (unsigned)__builtin_amdgcn_update_dpp(0, (int)a.y, 0x4E, 0xf, 0xf, true); p.z = (unsigned)__builtin_amdgcn_update_dpp(0, (int)a.z, 0x4E, 0xf, 0xf, true); p.w = (unsigned)__builtin_amdgcn_update_dpp(0, (int)a.w, 0x4E, 0xf, 0xf, true);
                v4u o; o.x = pk2(bflo(a.x) * c0.x + bflo(p.x) * s0.x, bfhi(a.x) * c0.y + bfhi(p.x) * s0.y); o.y = pk2(bflo(a.y) * c0.z + bflo(p.y) * s0.z, bfhi(a.y) * c0.w + bfhi(p.y) * s0.w);
                o.z = pk2(bflo(a.z) * c1.x + bflo(p.z) * s1.x, bfhi(a.z) * c1.y + bfhi(p.z) * s1.y); o.w = pk2(bflo(a.w) * c1.z + bflo(p.w) * s1.z, bfhi(a.w) * c1.w + bfhi(p.w) * s1.w);
                if (lane < 16) *(GAS v4u*)(KR + ((size_t)(lane >> 3) * MT + r) * 64 + 8 * sub) = o;
            }
        }
        if (F.tid < 256) { const int p = F.tid, row = p >> 4, c8 = (p & 15) * 8;
            *(LAS v4u*)(vl + row * 272 + c8 * 2) = *(const GAS v4u*)(PAB + (size_t)(r0 + row) * AB_IN + 2176 + c8); }
        __syncthreads();
        if (F.tid < 256) { const int p = F.tid, ch = p >> 1, rg = p & 1;
            const LAS bf16* s = (const LAS bf16*)(vl + (8 * rg) * 272 + ch * 2);
            v4u o; o.x = (unsigned)s[0] | ((unsigned)s[136] << 16); o.y = (unsigned)s[2 * 136] | ((unsigned)s[3 * 136] << 16); o.z = (unsigned)s[4 * 136] | ((unsigned)s[5 * 136] << 16); o.w = (unsigned)s[6 * 136] | ((unsigned)s[7 * 136] << 16);
            *(GAS v4u*)(VT + (size_t)ch * MT + r0 + 8 * rg) = o; }
        __syncthreads();
    }
}


__device__ __forceinline__ void ph_ssd_conv(Frame& F) {
    const bf16* XB = (const bf16*)(F.ws + WS_XBCR);
    bf16* XT = (bf16*)(F.ws + WS_XT); bf16* BT = (bf16*)(F.ws + WS_BT); bf16* BMm = (bf16*)(F.ws + WS_BM); bf16* CMm = (bf16*)(F.ws + WS_CM);
    const float* cwp = F.in[I_SSDCW]; const float* cbp = F.in[I_SSDCB];
    LAS unsigned char* tl = F.lds;
    { const float* DR = (const float*)(F.ws + WS_DTRAW); float* DTF = (float*)(F.ws + WS_DTS); float* DTB = DTF + (size_t)32 * MT;
      const int gw = F.vcu * NWAVES + F.wave, NGW = F.G * NWAVES;
      for (int task = gw; task < (MT / 64) * 4; task += NGW) { const int tb = task >> 2, jq = task & 3; const int t = tb * 64 + F.lane; const float* row = DR + (size_t)t * 64;
#pragma unroll
          for (int j4 = 4 * jq; j4 < 4 * jq + 4; ++j4) { const f32x4 r = *(const f32x4*)(row + 4 * j4);
#pragma unroll
              for (int q = 0; q < 4; ++q) { const int j = 4 * j4 + q; const float v = softplus_f(r[q] + (j < 32 ? F.in[I_DTBF][j] : F.in[I_DTBB][j - 32]));
                  if (j < 32) DTF[(size_t)j * MT + t] = v; else DTB[(size_t)(j - 32) * MT + t] = v; } } } }
    LAS float* cwl = (LAS float*)(F.lds + 130 * 272 + 64);
    for (int i = F.tid; i < 3 * XBCW; i += NTHR) cwl[i] = cwp[i];
    for (int i = F.tid; i < XBCW; i += NTHR) cwl[3 * XBCW + i] = cbp[i];
    __syncthreads();
    const int ntiles = NCH * 24;
    v4u pre[5];
#define CONV_LOAD(tile_) do { const int c_ = (tile_) / 24, cb_ = (tile_) % 24, t0_ = c_ * 128, ch0_ = cb_ * 128; const int slo_ = c_ < 128 ? 0 : L, shi_ = c_ < 128 ? L : MT; \
        _Pragma("unroll") for (int i_ = 0; i_ < 5; ++i_) { const int p_ = F.tid + NTHR * i_, row_ = p_ >> 4, c8_ = (p_ & 15) * 8; const int t_ = t0_ - 1 + row_; \
            pre[i_] = (v4u){0u, 0u, 0u, 0u}; if (p_ < 130 * 16 && t_ >= slo_ && t_ < shi_) pre[i_] = __builtin_nontemporal_load((const GAS v4u*)(XB + (size_t)t_ * XBCW + ch0_ + c8_)); } } while (0)
    int tile = F.vcu;
    if (tile < ntiles) CONV_LOAD(tile);
    for (; tile < ntiles; tile += F.G) {
        const int c = tile / 24, cb = tile % 24, t0 = c * 128, ch0 = cb * 128;
#pragma unroll
        for (int i = 0; i < 5; ++i) { const int p = F.tid + NTHR * i, row = p >> 4, c8 = (p & 15) * 8; if (p < 130 * 16) *(LAS v4u*)(tl + row * 272 + ((c8 * 2) ^ (((row >> 3) & 7) << 4))) = pre[i]; }
        __syncthreads();
        if (tile + F.G < ntiles) CONV_LOAD(tile + F.G);
        if (cb < 20) {
            bf16* dst = BT + (size_t)(ch0 - 2048) * MT;
#pragma unroll
            for (int i = 0; i < 4; ++i) { const int p = F.tid + NTHR * i, ch = p >> 4, tg = p & 15;
                const float w0 = cwl[ch0 + ch], w1 = cwl[XBCW + ch0 + ch], w2 = cwl[2 * XBCW + ch0 + ch], bb = cwl[3 * XBCW + ch0 + ch];
                float xin[10];
#pragma unroll
                for (int j = 0; j < 10; ++j) { const int row = 8 * tg + j; xin[j] = bf1(*(const LAS bf16*)(tl + row * 272 + ((ch * 2) ^ (((row >> 3) & 7) << 4)))); }
                float y[8];
#pragma unroll
                for (int j = 0; j < 8; ++j) { const float a = w0 * xin[j] + w1 * xin[j + 1] + w2 * xin[j + 2] + bb; y[j] = a * sigmoid_f(a); }
                v4u o; o.x = pk2(y[0], y[1]); o.y = pk2(y[2], y[3]); o.z = pk2(y[4], y[5]); o.w = pk2(y[6], y[7]);
                if (cb < 16) { const int cg_ = ch0 + ch, hd = cg_ >> 6, p_ = cg_ & 63, ptq = 2 * (p_ >> 5) + ((p_ >> 2) & 1), rq = 4 * ((p_ >> 3) & 3) + (p_ & 3);
                    *(GAS v4u*)(XT + ((size_t)(((hd * NCH + c) * 4 + (tg >> 2)) * 4 + ptq) * 16 + rq) * 32 + 8 * (tg & 3)) = o; }
                else *(GAS v4u*)(dst + (size_t)ch * MT + t0 + 8 * tg) = o; }
        }
        if (cb >= 16) {
            bf16* dst = cb < 20 ? BMm + (ch0 - 2048) : CMm + (ch0 - 2560);
#pragma unroll
            for (int i = 0; i < 4; ++i) { const int p = F.tid + NTHR * i, row = p >> 4, cg = p & 15;
                const v4u a0 = *(const LAS v4u*)(tl + row * 272 + ((cg * 16) ^ (((row >> 3) & 7) << 4))), a1 = *(const LAS v4u*)(tl + (row + 1) * 272 + ((cg * 16) ^ ((((row + 1) >> 3) & 7) << 4))), a2 = *(const LAS v4u*)(tl + (row + 2) * 272 + ((cg * 16) ^ ((((row + 2) >> 3) & 7) << 4)));
                const LAS float* w0 = cwl + ch0 + 8 * cg; const LAS float* w1 = w0 + XBCW; const LAS float* w2 = w1 + XBCW; const LAS float* bb = w2 + XBCW;
                float y[8];
#define CV(j, f, q) { const float a = w0[j] * f(a0.q) + w1[j] * f(a1.q) + w2[j] * f(a2.q) + bb[j]; y[j] = a * sigmoid_f(a); }
                CV(0, bflo, x) CV(1, bfhi, x) CV(2, bflo, y) CV(3, bfhi, y) CV(4, bflo, z) CV(5, bfhi, z) CV(6, bflo, w) CV(7, bfhi, w)
#undef CV
                v4u o; o.x = pk2(y[0], y[1]); o.y = pk2(y[2], y[3]); o.z = pk2(y[4], y[5]); o.w = pk2(y[6], y[7]);
                *(GAS v4u*)(dst + (size_t)(t0 + row) * 512 + 8 * cg) = o; }
        }
        __syncthreads();
    }
#undef CONV_LOAD
    { const int full = ntiles / F.G, nbusy = ntiles - full * F.G; __syncthreads();
      if (F.vcu >= nbusy) moe_dn_convert(F, 0, 1900, (F.vcu - nbusy) * NWAVES + F.wave, (F.G - nbusy) * NWAVES); }
}

__device__ __forceinline__ void ph_moe_route(Frame& F) {
    LAS float* R = (LAS float*)F.lds;
    for (int i = F.tid; i < 8192; i += NTHR) R[(i & 7) * 1024 + (i >> 3)] = F.in[I_ROUTER][i];
    __syncthreads();
    const bf16* X = (const bf16*)(F.ws + WS_X); float* RS = (float*)(F.ws + WS_RSTD);
    int* TE = (int*)(F.ws + WS_TOKE); float* TW = (float*)(F.ws + WS_TOKW); int* HIST = (int*)(F.ws + WS_CTL) + CW_HIST;
    const float* gain = F.in[I_N2G] + D; const float* m = modp(F, 1, 0);
    const int gw = F.vcu * NWAVES + F.wave, NGW = F.G * NWAVES;
    f32x4 ca[4], cb[4];
#pragma unroll
    for (int j = 0; j < 4; ++j) { const int c = 4 * (64 * j + F.lane); ca[j] = *(const f32x4*)(gain + c) * (*(const f32x4*)(m + M_SC2 + c) + 1.0f); cb[j] = *(const f32x4*)(m + M_SH2 + c); }
    for (int r = gw; r < L; r += NGW) {
        f32x4 v[4]; float s2 = 0.f;
        load_row4<true>(X + (size_t)r * D, F.lane, v);
#pragma unroll
        for (int j = 0; j < 4; ++j) s2 += (v[j].x * v[j].x + v[j].y * v[j].y) + (v[j].z * v[j].z + v[j].w * v[j].w);
        const float rstd = 1.0f / sqrtf(wave_sum(s2) * (1.0f / D) + EPS);
        float lg[8];
#pragma unroll
        for (int e = 0; e < 8; ++e) lg[e] = 0.f;
#pragma unroll
        for (int j = 0; j < 4; ++j) { const int c = 4 * (64 * j + F.lane);
            const f32x4 y = v[j] * rstd * ca[j] + cb[j];
#pragma unroll
            for (int e = 0; e < 8; ++e) { const f32x4 rr = *(const LAS f32x4*)(R + e * 1024 + c); lg[e] += (y.x * rr.x + y.y * rr.y) + (y.z * rr.z + y.w * rr.w); } }
#pragma unroll
        for (int e = 0; e < 8; ++e) lg[e] = wave_sum(lg[e]);
        int e0 = 0; float v0 = lg[0];
#pragma unroll
        for (int e = 1; e < 8; ++e) if (lg[e] > v0) { v0 = lg[e]; e0 = e; }
        int e1 = -1; float v1 = -3.0e38f;
#pragma unroll
        for (int e = 0; e < 8; ++e) if (e != e0 && lg[e] > v1) { v1 = lg[e]; e1 = e; }
        if (F.lane == 0) { const float ex = __expf(v1 - v0), w0 = 1.0f / (1.0f + ex); RS[r] = rstd;
            TE[2 * r] = e0; TE[2 * r + 1] = e1; TW[2 * r] = w0; TW[2 * r + 1] = ex * w0;
            atomicAdd(&HIST[(r >> 8) * 8 + e0], 1); atomicAdd(&HIST[(r >> 8) * 8 + e1], 1); }
    }
}
__device__ __forceinline__ void moe_segments(Frame& F, LAS int* hist, LAS int* cnt, LAS int* seg) {
    const int* HIST = (const int*)(F.ws + WS_CTL) + CW_HIST;
    if (F.tid < 512) hist[F.tid] = HIST[F.tid];
    __syncthreads();
    if (F.tid < 8) { int s = 0; for (int t = 0; t < 64; ++t) s += hist[t * 8 + F.tid]; cnt[F.tid] = s; }
    __syncthreads();
    if (F.tid == 0) { int s = 0; for (int e = 0; e < 8; ++e) { seg[e] = s; s += (cnt[e] + 255) & ~255; } seg[8] = s; }
    __syncthreads();
}
__device__ __forceinline__ void ph_moe_scatter(Frame& F) {
    LAS int* hist = (LAS int*)F.lds; LAS int* cnt = hist + 512; LAS int* seg = cnt + 8; LAS int* base = seg + 16; LAS int* wcnt = base + 8; LAS int* epos = wcnt + 64;
    moe_segments(F, hist, cnt, seg);
    const int* TE = (const int*)(F.ws + WS_TOKE); int* TP = (int*)(F.ws + WS_TOKP);
    const bf16* X = (const bf16*)(F.ws + WS_X); const float* RS = (const float*)(F.ws + WS_RSTD); bf16* H2S = (bf16*)(F.ws + WS_H2S);
    f32x4 ca[4], cb[4];
    { const float* gain = F.in[I_N2G] + D; const float* m = modp(F, 1, 0);
#pragma unroll
      for (int j = 0; j < 4; ++j) { const int c = 4 * (64 * j + F.lane); ca[j] = *(const f32x4*)(gain + c) * (*(const f32x4*)(m + M_SC2 + c) + 1.0f); cb[j] = *(const f32x4*)(m + M_SH2 + c); } }
    for (int uu = F.vcu; uu < 264; uu += F.G) {
        if (uu < 256) {
            const int u = uu >> 2, qtr = uu & 3;
            if (F.tid < 8) { int s = seg[F.tid]; for (int t = 0; t < u; ++t) s += hist[t * 8 + F.tid]; base[F.tid] = s; }
            const int ent = u * 512 + F.tid;
            const int ex = TE[ent];
            int rank = 0;
#pragma unroll
            for (int e = 0; e < 8; ++e) { const unsigned long long mk = __ballot(ex == e);
                if (ex == e) rank = __popcll(mk & ((1ull << F.lane) - 1ull));
                if (F.lane == 0) wcnt[F.wave * 8 + e] = __popcll(mk); }
            __syncthreads();
            int pos = base[ex] + rank;
            for (int w = 0; w < F.wave; ++w) pos += wcnt[w * 8 + ex];
            if (qtr == 0) TP[ent] = pos;
            epos[F.tid] = pos;
            __syncthreads();
            for (int t0_ = 64 * qtr + F.wave; t0_ < 64 * qtr + 64; t0_ += 2 * NWAVES) {
                f32x4 xv[2][4]; float rs[2]; int d0[2], d1[2];
#pragma unroll
                for (int k = 0; k < 2; ++k) { const int ti = t0_ + k * NWAVES, tok = u * 256 + ti; load_row4<true>(X + (size_t)tok * D, F.lane, xv[k]); rs[k] = RS[tok]; d0[k] = epos[2 * ti]; d1[k] = epos[2 * ti + 1]; }
#pragma unroll
                for (int k = 0; k < 2; ++k) { GAS v2u* o0 = (GAS v2u*)(H2S + (size_t)d0[k] * D) + F.lane; GAS v2u* o1 = (GAS v2u*)(H2S + (size_t)d1[k] * D) + F.lane;
#pragma unroll
                    for (int j = 0; j < 4; ++j) { const f32x4 y = xv[k][j] * rs[k] * ca[j] + cb[j]; v2u o; o.x = pk2(y.x, y.y); o.y = pk2(y.z, y.w); o0[64 * j] = o; o1[64 * j] = o; } } }
            __syncthreads();
        } else {
            const int e = uu - 256, lo = seg[e] + cnt[e], hi = seg[e + 1];
            GAS v4u* d = (GAS v4u*)(H2S + (size_t)lo * D); const int n16 = (hi - lo) * (D * 2 / 16);
            for (int i = F.tid; i < n16; i += NTHR) d[i] = (v4u){0u, 0u, 0u, 0u};
        }
    }
}
__device__ __forceinline__ void ph_final(Frame& F) {
    const bf16* X = (const bf16*)(F.ws + WS_X); const bf16* YO = (const bf16*)(F.ws + WS_H2S);
    const int* TP = (const int*)(F.ws + WS_TOKP); const float* TW = (const float*)(F.ws + WS_TOKW);
    const float* g2 = modp(F, 1, 0) + M_G2; const float* fg = F.in[I_FINALG];
    const float* YP = (const float*)(F.ws + WS_YPART);
    const int gw = F.vcu * NWAVES + F.wave, NGW = F.G * NWAVES;
    f32x4 cg[4], cf[4];
#pragma unroll
    for (int j = 0; j < 4; ++j) { const int c = 4 * (64 * j + F.lane); cg[j] = *(const f32x4*)(g2 + c); cf[j] = *(const f32x4*)(fg + c); }
    for (int r0 = gw; r0 < L; r0 += 2 * NGW) {
        int rr[2], pa[2], pb[2]; float wa[2], wb[2]; f32x4 xv[2][4]; v2u ya[2][4], yb[2][4];
#pragma unroll
        for (int k = 0; k < 2; ++k) { const int r = r0 + k * NGW; rr[k] = r < L ? r : r0; pa[k] = TP[2 * rr[k]]; pb[k] = TP[2 * rr[k] + 1]; wa[k] = TW[2 * rr[k]]; wb[k] = TW[2 * rr[k] + 1]; }
#pragma unroll
        for (int k = 0; k < 2; ++k) { load_row4<true>(X + (size_t)rr[k] * D, F.lane, xv[k]);
            const GAS v2u* y0 = (const GAS v2u*)(YO + (size_t)pa[k] * D) + F.lane; const GAS v2u* y1 = (const GAS v2u*)(YO + (size_t)pb[k] * D) + F.lane;
#pragma unroll
            for (int j = 0; j < 4; ++j) { ya[k][j] = __builtin_nontemporal_load(y0 + 64 * j); yb[k][j] = __builtin_nontemporal_load(y1 + 64 * j); } }
#pragma unroll
        for (int k = 0; k < 2; ++k) { const int r = rr[k], p0 = pa[k], p1 = pb[k]; const float w0 = wa[k], w1 = wb[k];
            f32x4 v[4]; float s2 = 0.f;
#pragma unroll
            for (int j = 0; j < 4; ++j) { const int c = 4 * (64 * j + F.lane); const v2u a = ya[k][j], b = yb[k][j]; const f32x4 g = cg[j];
                f32x4 fa = (f32x4){bflo(a.x), bfhi(a.x), bflo(a.y), bfhi(a.y)}, fb = (f32x4){bflo(b.x), bfhi(b.x), bflo(b.y), bfhi(b.y)};
                if (p0 >= 32768) { fa = (f32x4){0.f, 0.f, 0.f, 0.f}; for (int q = 0; q < 7; ++q) fa += *(const f32x4*)(YP + ((size_t)q * 2048 + (p0 - 32768)) * D + c); }
                if (p1 >= 32768) { fb = (f32x4){0.f, 0.f, 0.f, 0.f}; for (int q = 0; q < 7; ++q) fb += *(const f32x4*)(YP + ((size_t)q * 2048 + (p1 - 32768)) * D + c); }
                const f32x4 f = fa * w0 + fb * w1;
                v[j] = xv[k][j] + g * f; s2 += (v[j].x * v[j].x + v[j].y * v[j].y) + (v[j].z * v[j].z + v[j].w * v[j].w); }
            const float rstd = 1.0f / sqrtf(wave_sum(s2) * (1.0f / D) + EPS);
            GAS f32x4* o = (GAS f32x4*)(F.out + (size_t)r * D) + F.lane;
#pragma unroll
            for (int j = 0; j < 4; ++j) __builtin_nontemporal_store(v[j] * rstd * cf[j], &o[64 * j]);
        }
    }
}


typedef short bf16x8v __attribute__((ext_vector_type(8)));
__device__ __forceinline__ bf16x8v as_frag(v4u a) { return __builtin_bit_cast(bf16x8v, a); }
constexpr float LOG2E_ = 1.4426950408889634f;
#define MFMA16(a, b, c) __builtin_amdgcn_mfma_f32_16x16x32_bf16((a), (b), (c), 0, 0, 0)
__device__ __forceinline__ int prm_row(int i2, int par, int r) { return 32 * i2 + 8 * (r >> 2) + 4 * par + (r & 3); }

__device__ __forceinline__ void ph_ssd_s1(Frame& F) {
    const bf16* XT = (const bf16*)(F.ws + WS_XT); const bf16* BT = (const bf16*)(F.ws + WS_BT);
    const float* DTF = (const float*)(F.ws + WS_DTS); const float* DTB = DTF + (size_t)32 * MT; float* CUMF = (float*)(DTB + (size_t)32 * MT); float* CUMB = CUMF + (size_t)32 * MT;
    float* DEC = (float*)(F.ws + WS_DEC); bf16* ST = (bf16*)(F.ws + WS_STATES);
    LAS unsigned char* btl = F.lds;
    LAS float* wtab = (LAS float*)(F.lds + 128 * 272);
    LAS float* wtot = wtab + 1024;
    const int lane = F.lane, r16 = lane & 15, gq = lane >> 4;
    v4u nbt[4]; float ndtf = 0.f, ndtb = 0.f;
#define S1_PREFETCH(u_) do { const int c_ = (u_) >> 3, g_ = ((u_) >> 1) & 3, hh_ = (u_) & 1, t0_ = c_ * 128; int tq_ = F.tid; asm volatile("" : "+v"(tq_)); \
        _Pragma("unroll") for (int i_ = 0; i_ < 4; ++i_) { const int p_ = tq_ + NTHR * i_, n_ = p_ >> 4, c8_ = (p_ & 15) * 8; nbt[i_] = *(const GAS v4u*)(BT + (size_t)(g_ * 128 + n_) * MT + t0_ + c8_); } \
        { const int h_ = 8 * g_ + 4 * hh_ + (tq_ >> 7); ndtf = DTF[(size_t)h_ * MT + t0_ + (tq_ & 127)]; ndtb = DTB[(size_t)h_ * MT + t0_ + (tq_ & 127)]; } } while (0)
    if (F.vcu < NCH * 8) S1_PREFETCH(F.vcu);
    for (int u = F.vcu; u < NCH * 8; u += F.G) {
        const int c = u >> 3, g = (u >> 1) & 3, hh = u & 1, t0 = c * 128;
        int tid_ = F.tid; asm volatile("" : "+v"(tid_));
        v4u xr[4][4];
        { const int hx = 8 * g + 4 * hh + (F.wave >> 1);
#pragma unroll
          for (int ks = 0; ks < 4; ++ks)
#pragma unroll
            for (int pt = 0; pt < 4; ++pt) xr[ks][pt] = *(const GAS v4u*)(XT + ((size_t)(((hx * NCH + c) * 4 + ks) * 4 + pt) * 16 + r16) * 32 + 8 * gq); }
#pragma unroll
        for (int i = 0; i < 4; ++i) { const int p = tid_ + NTHR * i, n = p >> 4, c8 = (p & 15) * 8; *(LAS v4u*)(btl + n * 272 + c8 * 2) = nbt[i]; }
        {
            const int j = tid_ >> 7, l = tid_ & 127, h = 8 * g + 4 * hh + j;
            const float dtf = ndtf, dtb = ndtb;
            const float Af = -__expf(F.in[I_ALOGF][h]), Ab = -__expf(F.in[I_ALOGB][h]);
            const float af = dtf * Af, ab = dtb * Ab;
            float pf = af, pb = ab;
#pragma unroll
            for (int o = 1; o < 64; o <<= 1) { const float a = __shfl_up(pf, o), b = __shfl_up(pb, o); if (lane >= o) { pf += a; pb += b; } }
            if (lane == 63) { wtot[F.wave * 2] = pf; wtot[F.wave * 2 + 1] = pb; }
            __syncthreads();
            const float tf0 = wtot[(2 * j) * 2], tb0 = wtot[(2 * j) * 2 + 1], Tf = tf0 + wtot[(2 * j + 1) * 2], Tb = tb0 + wtot[(2 * j + 1) * 2 + 1];
            if (F.wave & 1) { pf += tf0; pb += tb0; }
            const float cf = pf, cb = Tb - pb + ab;
            CUMF[(size_t)h * MT + t0 + l] = cf; CUMB[(size_t)h * MT + t0 + l] = cb;
            wtab[(j * 2 + 0) * 128 + l] = __expf(Tf - cf) * dtf; wtab[(j * 2 + 1) * 128 + l] = __expf(Tb - cb) * dtb;
            if (l == 0) { DEC[(0 * NCH + c) * 32 + h] = __expf(Tf); DEC[(1 * NCH + c) * 32 + h] = __expf(Tb); }
        }
        __syncthreads();
        {
            const int j = F.wave >> 1, dir = F.wave & 1, h = 8 * g + 4 * hh + j;
            f32x4 acc[8][4];
#pragma unroll
            for (int a = 0; a < 8; ++a)
#pragma unroll
                for (int b = 0; b < 4; ++b) acc[a][b] = (f32x4){0.f, 0.f, 0.f, 0.f};
            const LAS float* wt = wtab + (j * 2 + dir) * 128;
            if (u + F.G < NCH * 8) S1_PREFETCH(u + F.G);
#pragma unroll
            for (int ks = 0; ks < 4; ++ks) {
                const f32x4 w0 = *(const LAS f32x4*)(wt + 32 * ks + 8 * gq), w1 = *(const LAS f32x4*)(wt + 32 * ks + 8 * gq + 4);
                bf16x8v bfr[4];
#pragma unroll
                for (int pt = 0; pt < 4; ++pt) { const v4u x = xr[ks][pt];
                    v4u y; y.x = pk2(bflo(x.x) * w0.x, bfhi(x.x) * w0.y); y.y = pk2(bflo(x.y) * w0.z, bfhi(x.y) * w0.w); y.z = pk2(bflo(x.z) * w1.x, bfhi(x.z) * w1.y); y.w = pk2(bflo(x.w) * w1.z, bfhi(x.w) * w1.w);
                    bfr[pt] = as_frag(y); }
#pragma unroll
                for (int nt = 0; nt < 8; ++nt) { const bf16x8v af = as_frag(*(const LAS v4u*)(btl + prm_row(nt >> 1, nt & 1, r16) * 272 + (32 * ks + 8 * gq) * 2));
#pragma unroll
                    for (int pt = 0; pt < 4; ++pt) acc[nt][pt] = MFMA16(af, bfr[pt], acc[nt][pt]); }
            }
            bf16* so = ST + ((size_t)((dir * NCH + c) * 32 + h) * 64) * 128;
#pragma unroll
            for (int pt = 0; pt < 4; ++pt)
#pragma unroll
                for (int i2 = 0; i2 < 4; ++i2) { const f32x4 a = acc[2 * i2][pt], b = acc[2 * i2 + 1][pt];
                    v4u o; o.x = pk2(a[0], a[1]); o.y = pk2(a[2], a[3]); o.z = pk2(b[0], b[1]); o.w = pk2(b[2], b[3]);
                    *(GAS v4u*)(so + (size_t)(((pt * 4 + i2) * 16 + r16) * 32) + 8 * gq) = o; }
        }
        __syncthreads();
    }
    { const int nun = NCH * 8, full = nun / F.G, nbusy = nun - full * F.G; __syncthreads();
      if (F.vcu >= nbusy) moe_dn_convert(F, 1900, 5700, (F.vcu - nbusy) * NWAVES + F.wave, (F.G - nbusy) * NWAVES); }
}
#undef S1_PREFETCH

__device__ __forceinline__ void ph_ssd_s2(Frame& F) {
    const float* DEC = (const float*)(F.ws + WS_DEC); bf16* ST = (bf16*)(F.ws + WS_STATES);
    for (int e = F.vcu * NTHR + F.tid; e < 2 * 32 * 64 * 32; e += F.G * NTHR) {
        const int dir = e >> 16, h = (e >> 11) & 31, rem = e & 2047;
        const size_t eoff = (size_t)h * 8192 + (size_t)rem * 4; const size_t cstride = (size_t)32 * 8192;
        bf16* base = ST + (size_t)dir * NCH * cstride + eoff;
        const float* dec = DEC + (size_t)dir * NCH * 32 + h;
        float H0 = 0.f, H1 = 0.f, H2 = 0.f, H3 = 0.f;
        for (int b = 0; b < NCH; b += 10) {
            v2u s[10]; float d[10]; int ck[10];
#pragma unroll
            for (int i = 0; i < 10; ++i) { const int idx = b + i; ck[i] = dir == 0 ? (idx < 2 ? 128 + idx : idx - 2) : (idx < 2 ? 129 - idx : 129 - idx);
                s[i] = __builtin_nontemporal_load((const GAS v2u*)(base + (size_t)ck[i] * cstride)); d[i] = dec[ck[i] * 32]; }
#pragma unroll
            for (int i = 0; i < 10; ++i) { v2u o; o.x = pk2(H0, H1); o.y = pk2(H2, H3); *(GAS v2u*)(base + (size_t)ck[i] * cstride) = o;
                H0 = d[i] * H0 + bflo(s[i].x); H1 = d[i] * H1 + bfhi(s[i].x); H2 = d[i] * H2 + bflo(s[i].y); H3 = d[i] * H3 + bfhi(s[i].y); }
        }
    }
}

__device__ __forceinline__ void ph_ssd_s3(Frame& F) {
    const bf16* XT = (const bf16*)(F.ws + WS_XT); const bf16* BMm = (const bf16*)(F.ws + WS_BM); const bf16* CMm = (const bf16*)(F.ws + WS_CM);
    const float* DTF = (const float*)(F.ws + WS_DTS); const float* DTB = DTF + (size_t)32 * MT; const float* CUMF = DTB + (size_t)32 * MT; const float* CUMB = CUMF + (size_t)32 * MT;
    const bf16* ST = (const bf16*)(F.ws + WS_STATES); bf16* Z = (bf16*)(F.ws + WS_Z); const float* ng = F.in[I_SSDNG];
    LAS unsigned char* bml = F.lds;
    LAS unsigned char* cml = F.lds + 128 * 272;
    LAS float* tab = (LAS float*)(F.lds + 192 * 272);
    LAS float* ssq = tab + 8 * 5 * 128;
    const int lane = F.lane, r16 = lane & 15, gq = lane >> 4;
    v4u nbm[4], ncm[2]; float ncf[2], ncb[2], ndf[2], ndb[2];
#define S3_PREFETCH(u_) do { const int c_ = (u_) >> 3, g_ = ((u_) >> 1) & 3, lh_ = (u_) & 1, t0_ = c_ * 128; int tq_ = F.tid; asm volatile("" : "+v"(tq_)); \
        _Pragma("unroll") for (int i_ = 0; i_ < 4; ++i_) { const int p_ = tq_ + NTHR * i_, row_ = p_ >> 4, c8_ = (p_ & 15) * 8; nbm[i_] = *(const GAS v4u*)(BMm + (size_t)(t0_ + row_) * 512 + g_ * 128 + c8_); } \
        _Pragma("unroll") for (int i_ = 0; i_ < 2; ++i_) { const int p_ = tq_ + NTHR * i_, row_ = p_ >> 4, c8_ = (p_ & 15) * 8; ncm[i_] = *(const GAS v4u*)(CMm + (size_t)(t0_ + 64 * lh_ + row_) * 512 + g_ * 128 + c8_); \
            const size_t o_ = (size_t)(8 * g_ + (p_ >> 7)) * MT + t0_ + (p_ & 127); ncf[i_] = CUMF[o_]; ncb[i_] = CUMB[o_]; ndf[i_] = DTF[o_]; ndb[i_] = DTB[o_]; } } while (0)
    if (F.vcu < 128 * 8) S3_PREFETCH(F.vcu);
    for (int u = F.vcu; u < 128 * 8; u += F.G) {
        const int c = u >> 3, g = (u >> 1) & 3, lh = u & 1, t0 = c * 128;
        __syncthreads();
        int tid_ = F.tid; asm volatile("" : "+v"(tid_));
#pragma unroll
        for (int i = 0; i < 4; ++i) { const int p = tid_ + NTHR * i, row = p >> 4, c8 = (p & 15) * 8; *(LAS v4u*)(bml + row * 272 + c8 * 2) = nbm[i]; }
#pragma unroll
        for (int i = 0; i < 2; ++i) { const int p = tid_ + NTHR * i, row = p >> 4, c8 = (p & 15) * 8; *(LAS v4u*)(cml + row * 272 + c8 * 2) = ncm[i]; }
#pragma unroll
        for (int i = 0; i < 2; ++i) { const int p = tid_ + NTHR * i, j = p >> 7, l = p & 127;
            const float cf = ncf[i] * LOG2E_, cb = ncb[i] * LOG2E_, df = ndf[i], db = ndb[i];
            tab[(j * 5 + 0) * 128 + l] = cf; tab[(j * 5 + 1) * 128 + l] = cb; tab[(j * 5 + 2) * 128 + l] = __builtin_amdgcn_logf(df) - cf; tab[(j * 5 + 3) * 128 + l] = __builtin_amdgcn_logf(db) - cb;
            tab[(j * 5 + 4) * 128 + l] = df + db; }
        __syncthreads();
        const int h = 8 * g + F.wave;
        const float Dk = F.in[I_SSDD][h];
        const LAS float* tcf = tab + (F.wave * 5) * 128; const LAS float* tcb = tcf + 128; const LAS float* tdf = tcb + 128; const LAS float* tdb = tdf + 128; const LAS float* tds = tdb + 128;
        f32x4 acc[4][4];
#pragma unroll
        for (int a = 0; a < 4; ++a)
#pragma unroll
            for (int b = 0; b < 4; ++b) acc[a][b] = (f32x4){0.f, 0.f, 0.f, 0.f};
#pragma unroll 1
        for (int i2 = 0; i2 < 4; ++i2) {
            bf16x8v xf[4], bmf[2][4];
#pragma unroll
            for (int pt = 0; pt < 4; ++pt) xf[pt] = as_frag(*(const GAS v4u*)(XT + ((size_t)(((h * NCH + c) * 4 + i2) * 4 + pt) * 16 + r16) * 32 + 8 * gq));
#pragma unroll
            for (int par = 0; par < 2; ++par)
#pragma unroll
                for (int nk = 0; nk < 4; ++nk) bmf[par][nk] = as_frag(*(const LAS v4u*)(bml + prm_row(i2, par, r16) * 272 + (32 * nk + 8 * gq) * 2));
            const int sb = 32 * i2 + 8 * gq;
            const f32x4 dfs0 = *(const LAS f32x4*)(tdf + sb), dfs1 = *(const LAS f32x4*)(tdf + sb + 4), dbs0 = *(const LAS f32x4*)(tdb + sb), dbs1 = *(const LAS f32x4*)(tdb + sb + 4);
#pragma unroll
            for (int lt = 0; lt < 4; ++lt) {
                const int ll = 16 * lt + r16, l = 64 * lh + ll;
                const float cfl = tcf[l], cbl = tcb[l], dsl = tds[l];
                f32x4 g0 = (f32x4){0.f, 0.f, 0.f, 0.f}, g1 = g0;
#pragma unroll
                for (int nk = 0; nk < 4; ++nk) { const bf16x8v cf = as_frag(*(const LAS v4u*)(cml + ll * 272 + (32 * nk + 8 * gq) * 2));
                    g0 = MFMA16(bmf[0][nk], cf, g0); g1 = MFMA16(bmf[1][nk], cf, g1); }
                float m[8];
                const int ltile0 = 64 * lh + 16 * lt; const int blk = (32 * i2 + 31 < ltile0) ? 0 : ((32 * i2 > ltile0 + 15) ? 2 : 1);
                if (blk == 0) {
#pragma unroll
                    for (int e = 0; e < 8; ++e) { const float dfs = e < 4 ? dfs0[e & 3] : dfs1[e & 3], gv = e < 4 ? g0[e & 3] : g1[e & 3]; m[e] = gv * __builtin_amdgcn_exp2f(cfl + dfs); }
                } else if (blk == 2) {
#pragma unroll
                    for (int e = 0; e < 8; ++e) { const float dbs = e < 4 ? dbs0[e & 3] : dbs1[e & 3], gv = e < 4 ? g0[e & 3] : g1[e & 3]; m[e] = gv * __builtin_amdgcn_exp2f(cbl + dbs); }
                } else {
#pragma unroll
                    for (int e = 0; e < 8; ++e) { const int s = sb + e;
                        const float dfs = e < 4 ? dfs0[e & 3] : dfs1[e & 3], dbs = e < 4 ? dbs0[e & 3] : dbs1[e & 3], gv = e < 4 ? g0[e & 3] : g1[e & 3];
                        float w = __builtin_amdgcn_exp2f(s < l ? cfl + dfs : cbl + dbs); const bool dg = s == l;
                        w = dg ? dsl : w; m[e] = gv * w + (dg ? Dk : 0.f); }
                }
                asm volatile("" : "+v"(m[0]), "+v"(m[1]), "+v"(m[2]), "+v"(m[3]), "+v"(m[4]), "+v"(m[5]), "+v"(m[6]), "+v"(m[7]));
                v4u mp; mp.x = pk2(m[0], m[1]); mp.y = pk2(m[2], m[3]); mp.z = pk2(m[4], m[5]); mp.w = pk2(m[6], m[7]);
                const bf16x8v mf = as_frag(mp);
#pragma unroll
                for (int pt = 0; pt < 4; ++pt) acc[lt][pt] = MFMA16(xf[pt], mf, acc[lt][pt]);
            }
        }
        if (u + F.G < 128 * 8) S3_PREFETCH(u + F.G);
#pragma unroll 1
        for (int dir = 0; dir < 2; ++dir) {
            const bf16* hs = ST + ((size_t)((dir * NCH + c) * 32 + h) * 64) * 128;
            float el[4];
#pragma unroll
            for (int lt = 0; lt < 4; ++lt) { const int l = 64 * lh + 16 * lt + r16; el[lt] = __builtin_amdgcn_exp2f(dir == 0 ? tcf[l] : tcb[l]); }
            f32x4 tacc[4][4];
#pragma unroll
            for (int a = 0; a < 4; ++a)
#pragma unroll
                for (int b = 0; b < 4; ++b) tacc[a][b] = (f32x4){0.f, 0.f, 0.f, 0.f};
#pragma unroll 1
            for (int nk = 0; nk < 4; ++nk) {
                bf16x8v hf[4];
#pragma unroll
                for (int pt = 0; pt < 4; ++pt) hf[pt] = as_frag(*(const GAS v4u*)(hs + (size_t)(((pt * 4 + nk) * 16 + r16) * 32) + 8 * gq));
#pragma unroll
                for (int lt = 0; lt < 4; ++lt) { const int ll = 16 * lt + r16;
                    const bf16x8v cf = as_frag(*(const LAS v4u*)(cml + ll * 272 + (32 * nk + 8 * gq) * 2));
#pragma unroll
                    for (int pt = 0; pt < 4; ++pt) tacc[lt][pt] = MFMA16(hf[pt], cf, tacc[lt][pt]); }
            }
#pragma unroll
            for (int lt = 0; lt < 4; ++lt)
#pragma unroll
                for (int pt = 0; pt < 4; ++pt) acc[lt][pt] += tacc[lt][pt] * el[lt];
        }
#pragma unroll
        for (int lt = 0; lt < 4; ++lt) { const int l = 64 * lh + 16 * lt + r16; float ss = 0.f;
#pragma unroll
            for (int q = 0; q < 2; ++q) { const v4u zv = *(const GAS v4u*)(Z + (size_t)(t0 + l) * DIN + h * 64 + 32 * q + 8 * gq);
                const float zz[8] = {bflo(zv.x), bfhi(zv.x), bflo(zv.y), bfhi(zv.y), bflo(zv.z), bfhi(zv.z), bflo(zv.w), bfhi(zv.w)};
#pragma unroll
                for (int e = 0; e < 4; ++e) { float v0 = acc[lt][2 * q][e] * zz[e] * sigmoid_f(zz[e]), v1 = acc[lt][2 * q + 1][e] * zz[4 + e] * sigmoid_f(zz[4 + e]);
                    acc[lt][2 * q][e] = v0; acc[lt][2 * q + 1][e] = v1; ss += v0 * v0 + v1 * v1; } }
            ss += __shfl_xor(ss, 16); ss += __shfl_xor(ss, 32);
            if (gq == 0) ssq[(16 * lt + r16) * 8 + F.wave] = ss; }
        __syncthreads();
#pragma unroll
        for (int lt = 0; lt < 4; ++lt) { const int ll = 16 * lt + r16, l = 64 * lh + ll;
            const f32x4 s0 = *(const LAS f32x4*)(ssq + ll * 8), s1 = *(const LAS f32x4*)(ssq + ll * 8 + 4);
            const float rs = 1.0f / sqrtf(((s0.x + s0.y) + (s0.z + s0.w) + (s1.x + s1.y) + (s1.z + s1.w)) * (1.0f / 512.0f) + EPS);
#pragma unroll
            for (int q = 0; q < 2; ++q) { const int ch = h * 64 + 32 * q + 8 * gq; const f32x4 a = acc[lt][2 * q] * rs, b = acc[lt][2 * q + 1] * rs;
                const f32x4 g0 = *(const f32x4*)(ng + ch), g1 = *(const f32x4*)(ng + ch + 4);
                v4u o; o.x = pk2(a[0] * g0.x, a[1] * g0.y); o.y = pk2(a[2] * g0.z, a[3] * g0.w); o.z = pk2(b[0] * g1.x, b[1] * g1.y); o.w = pk2(b[2] * g1.z, b[3] * g1.w);
                *(GAS v4u*)(Z + (size_t)(t0 + l) * DIN + ch) = o; } }
    }
    __syncthreads();
}
#undef S3_PREFETCH

__device__ __forceinline__ float vmax_f(float a, float b) { return __builtin_amdgcn_fmed3f(a, b, __builtin_inff()); }
__device__ __forceinline__ float vmin_f(float a, float b) { return __builtin_amdgcn_fmed3f(a, b, -__builtin_inff()); }
__device__ __forceinline__ float vmax3_f(float a, float b, float c) { return vmax_f(a, vmax_f(b, c)); }
__device__ __forceinline__ int attn_next_blk(int kb, int qb, bool isctx) {
    for (int k = kb + 1; k < 5; ++k) { if (k >= 3) return k; if (!isctx) { const int b = qb - 1 + k; if (b >= 0 && b < 128) return k; } }
    return 5;
}
__device__ __forceinline__ void ph_attn(Frame& F) {
    const bf16* QR = (const bf16*)(F.ws + WS_QR); const bf16* KR = (const bf16*)(F.ws + WS_KR); const bf16* VT = (const bf16*)(F.ws + WS_VT); bf16* MIX = (bf16*)(F.ws + WS_MIX);
    constexpr int KBYTES = 128 * 144, BUFB = KBYTES + 64 * 272;
    const int lane = F.lane, r16 = lane & 15, gq = lane >> 4;
    constexpr float LOG2E = 1.4426950408889634f;
    const int p0 = F.tid, p1 = F.tid + NTHR;
    const int kro0 = (p0 >> 3) * 144 + (p0 & 7) * 16, kro1 = (p1 >> 3) * 144 + (p1 & 7) * 16;
    const int vro0 = KBYTES + (p0 >> 4) * 272 + (p0 & 15) * 16, vro1 = KBYTES + (p1 >> 4) * 272 + (p1 & 15) * 16;
    for (int u = F.vcu; u < 130 * 8; u += F.G) {
        const int qb = u >> 3, hq = u & 7, kvh = hq >> 2; const bool isctx = qb >= 128;
        const int row0 = qb * 128;
        const int qrow = row0 + 16 * F.wave + r16;
        bf16x8v qf[2];
#pragma unroll
        for (int ks = 0; ks < 2; ++ks) qf[ks] = as_frag(*(const GAS v4u*)(QR + ((size_t)hq * MT + qrow) * 64 + 32 * ks + 8 * gq));
        float m2 = F.in[I_ABSINK][hq] * LOG2E, lsum = 1.0f;
        f32x4 oacc[4];
#pragma unroll
        for (int a = 0; a < 4; ++a) oacc[a] = (f32x4){0.f, 0.f, 0.f, 0.f};
        const int qi = 16 * F.wave + r16;
        const bf16* kbase = KR + (size_t)kvh * MT * 64; const bf16* vbase = VT + (size_t)kvh * 64 * MT;
#define ATT_KEY0(kb) ((kb) < 3 ? (qb - 1 + (kb)) * 128 : L + ((kb) - 3) * 128)
#define ATT_LOAD(kb) do { const int k0_ = ATT_KEY0(kb); \
            kr0 = *(const GAS v4u*)(kbase + (size_t)(k0_ + (p0 >> 3)) * 64 + (p0 & 7) * 8); kr1 = *(const GAS v4u*)(kbase + (size_t)(k0_ + (p1 >> 3)) * 64 + (p1 & 7) * 8); \
            vr0 = *(const GAS v4u*)(vbase + (size_t)(p0 >> 4) * MT + k0_ + (p0 & 15) * 8); vr1 = *(const GAS v4u*)(vbase + (size_t)(p1 >> 4) * MT + k0_ + (p1 & 15) * 8); } while (0)
#define ATT_WRITE(buf) do { LAS unsigned char* b_ = F.lds + (buf) * BUFB; *(LAS v4u*)(b_ + kro0) = kr0; *(LAS v4u*)(b_ + kro1) = kr1; *(LAS v4u*)(b_ + vro0) = vr0; *(LAS v4u*)(b_ + vro1) = vr1; } while (0)
        v4u kr0, kr1, vr0, vr1;
        int kb = attn_next_blk(-1, qb, isctx), cur = 0;
        __syncthreads();
        ATT_LOAD(kb); ATT_WRITE(0);
        __syncthreads();
        while (kb < 5) {
            const int nkb = attn_next_blk(kb, qb, isctx);
            if (nkb < 5) ATT_LOAD(nkb);
            const LAS unsigned char* kl = F.lds + cur * BUFB; const LAS unsigned char* vl = kl + KBYTES;
            const int mode = (kb == 0) ? 1 : ((kb == 2) ? 2 : 0);
            f32x4 sacc[8];
#pragma unroll
            for (int kt = 0; kt < 8; ++kt) { sacc[kt] = (f32x4){0.f, 0.f, 0.f, 0.f};
#pragma unroll
                for (int ks = 0; ks < 2; ++ks) { const bf16x8v kf = as_frag(*(const LAS v4u*)(kl + prm_row(kt >> 1, kt & 1, r16) * 144 + (32 * ks + 8 * gq) * 2));
                    sacc[kt] = MFMA16(kf, qf[ks], sacc[kt]); } }
            float bm = -1.0e30f;
#pragma unroll 1
            for (int rep_ = 0; rep_ < (mode != 0 ? 1 : 0); ++rep_) {
                const float msgn = mode == 1 ? 1.0e30f : -1.0e30f, limf = (float)(qi - 8 * gq);
#pragma unroll
                for (int kt = 0; kt < 8; ++kt)
#pragma unroll
                    for (int e = 0; e < 4; ++e) { const float jc = (float)(32 * (kt >> 1) + 4 * (kt & 1) + e);
                        sacc[kt][e] += vmin_f(0.f, msgn * (jc - limf)); }
            }
#pragma unroll
            for (int kt = 0; kt < 8; ++kt) bm = vmax3_f(bm, vmax_f(sacc[kt][0], sacc[kt][1]), vmax_f(sacc[kt][2], sacc[kt][3]));
            bm = vmax_f(bm, __shfl_xor(bm, 16)); bm = vmax_f(bm, __shfl_xor(bm, 32));
            const float mn = vmax_f(m2, bm), alpha = __builtin_amdgcn_exp2f(m2 - mn); m2 = mn;
            float ps = 0.f;
            bf16x8v pf[4];
#pragma unroll
            for (int i2 = 0; i2 < 4; ++i2) { float p[8];
#pragma unroll
                for (int e = 0; e < 4; ++e) { p[e] = __builtin_amdgcn_exp2f(sacc[2 * i2][e] - mn); p[4 + e] = __builtin_amdgcn_exp2f(sacc[2 * i2 + 1][e] - mn); }
#pragma unroll
                for (int e = 0; e < 8; ++e) ps += p[e];
                v4u pk; pk.x = pk2(p[0], p[1]); pk.y = pk2(p[2], p[3]); pk.z = pk2(p[4], p[5]); pk.w = pk2(p[6], p[7]); pf[i2] = as_frag(pk); }
            ps += __shfl_xor(ps, 16); ps += __shfl_xor(ps, 32);
            lsum = lsum * alpha + ps;
#pragma unroll
            for (int dt = 0; dt < 4; ++dt) { oacc[dt] = oacc[dt] * alpha;
#pragma unroll
                for (int i2 = 0; i2 < 4; ++i2) { const bf16x8v vf = as_frag(*(const LAS v4u*)(vl + prm_row(dt >> 1, dt & 1, r16) * 272 + (32 * i2 + 8 * gq) * 2));
                    oacc[dt] = MFMA16(vf, pf[i2], oacc[dt]); } }
            if (nkb < 5) ATT_WRITE(cur ^ 1);
            __syncthreads();
            kb = nkb; cur ^= 1;
        }
#undef ATT_KEY0
#undef ATT_LOAD
#undef ATT_WRITE
        const float il = 1.0f / lsum;
#pragma unroll
        for (int i = 0; i < 2; ++i) { const f32x4 a = oacc[2 * i] * il, b = oacc[2 * i + 1] * il;
            v4u o; o.x = pk2(a[0], a[1]); o.y = pk2(a[2], a[3]); o.z = pk2(b[0], b[1]); o.w = pk2(b[2], b[3]);
            *(GAS v4u*)(MIX + (size_t)qrow * D + 512 + 64 * hq + 32 * i + 8 * gq) = o; }
    }
    __syncthreads();
}

constexpr int NPH = 23;
#ifndef WGM_MOE_GU
#define WGM_MOE_GU 4
#endif
#ifndef WGM_MOE_DN
#define WGM_MOE_DN 4
#endif
struct Args { const float* in[30]; float* out; unsigned char* ws; int ph_lo, ph_hi; };
__global__ void __launch_bounds__(NTHR, 2) mk_fwd(Args args) {
    extern __shared__ __attribute__((aligned(16))) unsigned char lds[];
    Frame F;
    F.lds = (LAS unsigned char*)lds;
    F.tid = threadIdx.x; F.lane = F.tid & 63; F.wave = __builtin_amdgcn_readfirstlane(F.tid >> 6);
    F.G = gridDim.x; { const int bx = blockIdx.x; F.vcu = (F.G % 8 == 0) ? (bx % 8) * (F.G / 8) + bx / 8 : bx; }
#pragma unroll
    for (int i = 0; i < 30; ++i) F.in[i] = args.in[i];
    F.out = args.out; F.ws = args.ws;
    unsigned char* ws = args.ws;
    volatile LAS unsigned* MISC = (volatile LAS unsigned*)(F.lds + MISC_OFF);
    for (int u = F.tid; u < (LDS_BYTES - LDSCTL_OFF) / 4; u += NTHR) ((LAS unsigned*)(F.lds + LDSCTL_OFF))[u] = 0u;
    __syncthreads();
    const int lo = args.ph_lo, hi = args.ph_hi;
    XcdBarrier bar; bar.bar = (unsigned*)(ws + WS_CTL) + CW_BAR; bar.x = 0; bar.st = nullptr;
    if (hi - lo > 1) bar = xcd_barrier_post((unsigned*)(ws + WS_CTL) + CW_BAR, MISC + 8);
#define IN(k) (lo <= (k) && (k) < hi)
#define SEAM(k) do { if (IN(k) && IN((k) + 1)) xcd_barrier(bar); } while (0)
    LAS unsigned char* ring = F.lds;
    bf16* X = (bf16*)(ws + WS_X); bf16* H = (bf16*)(ws + WS_H);

    if (IN(0)) { ph_prologue(F); } SEAM(0);
    if (IN(1)) { ph_modulate<false, false, 0>(F, F.in[I_X], F.in[I_CTX], F.in[I_N1G], modp(F, 0, 0), modp(F, 0, 1), M_SH1, M_SC1, H, MT, nullptr, nullptr, nullptr); } SEAM(1);
    if (IN(2)) { pg8::Gemm g{H, (const bf16*)(ws + WS_WABIN), D, D, 0}; pg8::StaticOrder S; S.init(MT, AB_IN, F.G, (int)blockIdx.x);
        pg8::EpiStoreBf16 E{(bf16*)(ws + WS_PAB), AB_IN};
        pg8::gemm_phase<pg8::EpiStoreBf16, pg8::StaticOrder, true, true>(ring, g, S, E);
        idle_round_convert(F, (MT / 256) * (AB_IN / 256), 0, 11400); } SEAM(2);
    if (IN(3)) { ph_ab_elem(F); int gw_, ngw_; if (idle_last_round(F, MT / 16, gw_, ngw_)) { __syncthreads(); ph_convert_ffn_gu(F, 0, gw_, ngw_); } } SEAM(3);
    if (IN(4)) { ph_attn(F); int gw_, ngw_; if (idle_last_round(F, 130 * 8, gw_, ngw_)) { __syncthreads(); ph_convert_ffn_gu(F, 1, gw_, ngw_); } } SEAM(4);
    if (IN(5)) { { pg8::Gemm g{(const bf16*)(ws + WS_MIX), (const bf16*)(ws + WS_WABOUT), D, D, 0}; pg8::StaticOrder S; S.init(L, D, F.G, (int)blockIdx.x);
          pg8::EpiRes<true> E{X, F.in[I_X], modp(F, 0, 0) + M_G1, (float*)(ws + WS_SSQA)};
          pg8::gemm_phase<pg8::EpiRes<true>, pg8::StaticOrder, true, true>(ring, g, S, E); }
        { int nu_ = 16, kl_ = 256; asm volatile("" : "+s"(nu_), "+s"(kl_)); pg8::Gemm g{(const bf16*)(ws + WS_MIX), (const bf16*)(ws + WS_WABOUT), D, kl_, 0}; pg8::SplitOrder S{64, 4, nu_, 256, F.G, (int)blockIdx.x};
          pg8::EpiPart E{(float*)(ws + WS_PART), 64, 256, LC};
          pg8::gemm_phase<pg8::EpiPart, pg8::SplitOrder, true, true>(ring, g, S, E); }
        ctx_reduce<false, 4>(F, 16, CW_PCNT, F.in[I_CTX], modp(F, 0, 1) + M_G1, X, (float*)(ws + WS_SSQA));
        if ((int)blockIdx.x >= 16) ph_convert_ffn(F, ((int)blockIdx.x - 16) * NWAVES + F.wave, (F.G - 16) * NWAVES); } if (IN(5) && IN(7)) xcd_barrier(bar);
    if (IN(7)) { pg8::Gemm g{X, (const bf16*)(ws + WS_WFFNGU), D, D, (size_t)(WS_WCTX - WS_WFFNGU)}; pg8::StaticOrder S; S.init(MT, 2 * DFF, F.G, (int)blockIdx.x); S.pe_pm = L / 256;
        pg8::EpiSwiGLUFold E{(bf16*)(ws + WS_ACT0), DFF, (const float*)(ws + WS_SSQA), (const float*)(ws + WS_BIASA)};
        pg8::gemm_phase<pg8::EpiSwiGLUFold, pg8::StaticOrder, true, true>(ring, g, S, E);
        idle_round_convert(F, (MT / 256) * (2 * DFF / 256), 11400, 18000); } SEAM(7);
    if (IN(8)) { { pg8::Gemm g{(const bf16*)(ws + WS_ACT0), (const bf16*)(ws + WS_WFFND), DFF, DFF, 0}; pg8::StaticOrder S; S.init(L, D, F.G, (int)blockIdx.x);
          pg8::EpiRes<false> E{X, X, modp(F, 0, 0) + M_G2, (float*)(ws + WS_SSQB)};
          pg8::gemm_phase<pg8::EpiRes<false>, pg8::StaticOrder, true, true>(ring, g, S, E); }
        { int nu_ = 44, kl_ = 256; asm volatile("" : "+s"(nu_), "+s"(kl_)); pg8::Gemm g{(const bf16*)(ws + WS_ACT0), (const bf16*)(ws + WS_WFFND), DFF, kl_, 0}; pg8::SplitOrder S{64, 4, nu_, 256, F.G, (int)blockIdx.x};
          pg8::EpiPart E{(float*)(ws + WS_PART), 64, 256, LC};
          pg8::gemm_phase<pg8::EpiPart, pg8::SplitOrder, true, true>(ring, g, S, E); }
        ctx_reduce<true, 11>(F, 44, CW_PCNT + 64, X + (size_t)L * D, modp(F, 0, 1) + M_G2, X, (float*)(ws + WS_SSQB));
        if ((int)blockIdx.x >= 44) ph_convert_ssd(F, ((int)blockIdx.x - 44) * NWAVES + F.wave, (F.G - 44) * NWAVES); } if (IN(8) && IN(10)) xcd_barrier(bar);
    if (IN(10)) { pg8::Gemm g{X, (const bf16*)(ws + WS_WSSDIN), D, D, (size_t)(WS_WCTX2 - WS_WSSDIN)}; pg8::StaticOrder S; S.init(MT, SSD_INP, F.G, (int)blockIdx.x); S.pe_pm = L / 256;
        pg8::EpiSsdIn E{(bf16*)(ws + WS_Z), (bf16*)(ws + WS_XBCR), (float*)(ws + WS_DTRAW), (const float*)(ws + WS_SSQB), (const float*)(ws + WS_BIASB)};
        pg8::gemm_phase<pg8::EpiSsdIn, pg8::StaticOrder, true, true>(ring, g, S, E);
        idle_round_convert(F, (MT / 256) * (SSD_INP / 256), 18000, MOE_GU_ITEMS); } SEAM(10);
    if (IN(11)) { ph_ssd_conv(F); } SEAM(11);
    if (IN(12)) { ph_ssd_s1(F); } SEAM(12);
    if (IN(13)) { ph_ssd_s2(F); } SEAM(13);
    if (IN(14)) { ph_ssd_s3(F); } if (IN(14) && IN(16)) xcd_barrier(bar);
    if (IN(16)) { pg8::Gemm g{(const bf16*)(ws + WS_Z), (const bf16*)(ws + WS_WSSDOUT), DIN, DIN, 0}; pg8::StaticOrder S; S.init(L, D, F.G, (int)blockIdx.x);
        pg8::EpiRes<false> E{X, X, modp(F, 1, 0) + M_G1};
        pg8::gemm_phase<pg8::EpiRes<false>, pg8::StaticOrder, true, true>(ring, g, S, E); } SEAM(16);
    if (IN(17)) { ph_moe_route(F); } SEAM(17);
    if (IN(18)) { ph_moe_scatter(F); __syncthreads();
        { const int gw_ = F.vcu * NWAVES + F.wave, NGW_ = F.G * NWAVES;
          moe_dn_convert(F, 5700, MOE_DN_ITEMS / 2, gw_, NGW_); moe_dn_convert(F, 11308, MOE_DN_ITEMS, gw_, NGW_); } } SEAM(18);
    if (IN(19) || IN(21)) {
        LAS int* hist = (LAS int*)F.lds; LAS int* cnt = hist + 512; LAS int* seg = cnt + 8;
        pg8::GroupedOrder S;
        if (IN(19)) {
            moe_segments(F, hist, cnt, seg);
            S.nM = seg[8] >> 8; S.nN = 2 * FFE / 256; S.nwg = S.nM * S.nN; S.G = F.G; S.c = (int)blockIdx.x; S.WGM = WGM_MOE_GU;
            S.ts1 = seg[1] >> 8; S.ts2 = seg[2] >> 8; S.ts3 = seg[3] >> 8; S.ts4 = seg[4] >> 8; S.ts5 = seg[5] >> 8; S.ts6 = seg[6] >> 8; S.ts7 = seg[7] >> 8;
            __syncthreads();
            pg8::Gemm g{(const bf16*)(ws + WS_H2S), (const bf16*)(ws + WS_WMOE), D, D, (size_t)2 * FFE * D * 2};
            pg8::EpiSwiGLU E{(bf16*)(ws + WS_ACTM), FFE};
            pg8::gemm_phase<pg8::EpiSwiGLU, pg8::GroupedOrder, true, true>(ring, g, S, E);
            { const int full = S.nwg / F.G, nbusy = S.nwg - full * F.G;
              if ((int)blockIdx.x >= nbusy) moe_dn_convert(F, 7168, 11308, ((int)blockIdx.x - nbusy) * NWAVES + F.wave, (F.G - nbusy) * NWAVES); }
        }
        SEAM(19);
        if (IN(21)) {
            __syncthreads();
            moe_segments(F, hist, cnt, seg);
            const int NT = seg[8] >> 8;
            S.nM = NT < 128 ? NT : 128; S.nN = D / 256; S.nwg = S.nM * S.nN; S.G = F.G; S.c = (int)blockIdx.x; S.WGM = WGM_MOE_DN;
            S.ts1 = seg[1] >> 8; S.ts2 = seg[2] >> 8; S.ts3 = seg[3] >> 8; S.ts4 = seg[4] >> 8; S.ts5 = seg[5] >> 8; S.ts6 = seg[6] >> 8; S.ts7 = seg[7] >> 8;
            __syncthreads();
            { pg8::Gemm g{(const bf16*)(ws + WS_ACTM), (const bf16*)(ws + WS_WDA), FFE, FFE, WD_BYTES, (WS_WDB - WS_WDA) - 4 * WD_BYTES};
              pg8::EpiStoreBf16 E{(bf16*)(ws + WS_H2S), D};
              pg8::gemm_phase<pg8::EpiStoreBf16, pg8::GroupedOrder, true, true>(ring, g, S, E); }
            if (NT > 128) {
                pg8::Gemm g{(const bf16*)(ws + WS_ACTM), (const bf16*)(ws + WS_WDA), FFE, 512, WD_BYTES, (WS_WDB - WS_WDA) - 4 * WD_BYTES};
                pg8::SplitGroupedOrder S2{128, NT, D / 256, 7, 512, F.G, (int)blockIdx.x, S.ts1, S.ts2, S.ts3, S.ts4, S.ts5, S.ts6, S.ts7};
                pg8::EpiPart E{(float*)(ws + WS_YPART), 128, 512, 2048};
                pg8::gemm_phase<pg8::EpiPart, pg8::SplitGroupedOrder, true, true>(ring, g, S2, E); }
        }
        SEAM(21);
    } else { SEAM(19); if (IN(20)) { const int gw_ = F.vcu * NWAVES + F.wave, NGW_ = F.G * NWAVES; moe_dn_convert(F, 0, MOE_DN_ITEMS, gw_, NGW_); }
        SEAM(20); SEAM(21); }
    if (IN(22)) { ph_final(F); }
#undef IN
#undef SEAM
}

extern "C" void kernel_launch(void* const* d_in, const int* in_sizes, int n_in, void* d_out, int out_size, void* d_ws, size_t ws_size, hipStream_t stream) {
    static int grid = 0;
    if (grid == 0) {
        if (n_in != 30 || in_sizes[0] != L * D || out_size != L * D || ws_size < WS_END) { fprintf(stderr, "kernel_launch: unexpected shapes (n_in %d, in0 %d, out %d, ws %zu < %zu); nothing launched\n", n_in, n_in > 0 ? in_sizes[0] : -1, out_size, ws_size, (size_t)WS_END); grid = -1; return; }
        int dev = 0, cus = 0, per_cu = 0;
        if (hipGetDevice(&dev) != hipSuccess || hipDeviceGetAttribute(&cus, hipDeviceAttributeMultiprocessorCount, dev) != hipSuccess) { grid = -1; return; }
        if (hipFuncSetAttribute((const void*)mk_fwd, hipFuncAttributeMaxDynamicSharedMemorySize, LDS_BYTES) != hipSuccess) { fprintf(stderr, "kernel_launch: hipFuncSetAttribute failed\n"); grid = -1; return; }
        if (hipOccupancyMaxActiveBlocksPerMultiprocessor(&per_cu, (const void*)mk_fwd, NTHR, LDS_BYTES) != hipSuccess || per_cu < 1)
            fprintf(stderr, "kernel_launch: note: occupancy query reports %d workgroups per CU\n", per_cu);
        (void)hipGetLastError();
        grid = cus;
    }
    if (grid < 0) return;
    if (hipMemsetAsync((char*)d_ws + WS_CTL, 0, CTL_ZERO_BYTES, stream) != hipSuccess) return;
    Args a{};
    for (int i = 0; i < 30; ++i) a.in[i] = (const float*)d_in[i];
    a.out = (float*)d_out; a.ws = (unsigned char*)d_ws;
    if (MK_N_LAUNCHES == 1) { a.ph_lo = 0; a.ph_hi = NPH; hipLaunchKernelGGL(mk_fwd, dim3(grid), dim3(NTHR), LDS_BYTES, stream, a); }
    else { for (int p = 0; p < NPH; ++p) { a.ph_lo = p; a.ph_hi = p + 1; hipLaunchKernelGGL(mk_fwd, dim3(grid), dim3(NTHR), LDS_BYTES, stream, a); } }
}
```

```cpp
#include <hip/hip_runtime.h>
#include <cstdio>
#include <cstdint>

#ifndef MK_N_LAUNCHES
#define MK_N_LAUNCHES 1
#endif

namespace pg8 {
#define PG8_LAS __attribute__((address_space(3)))
typedef unsigned short bf16_t;
typedef short bf16x8 __attribute__((ext_vector_type(8)));
typedef float f32x4 __attribute__((ext_vector_type(4)));
typedef unsigned u32x4 __attribute__((ext_vector_type(4)));
constexpr int BM = 256, BK = 64, HALF = 128, HTB = HALF * BK * 2  , STAGE_BYTES = 8 * HTB, NXCD = 8;

__host__ __device__ __forceinline__ int lds_byte(int r, int c) { const int st = (r >> 4) * 2 + (c >> 5), rr = r & 15, cc = c & 31, ob = rr * 64 + cc * 2; return st * 1024 + (ob ^ (((ob >> 9) & 1) << 5)); }
__host__ __device__ __forceinline__ void stage_rc(int b, int& R, int& C) { const int st = b / 1024, sb = b % 1024, swz = sb ^ (((sb >> 9) & 1) << 5); R = (st >> 1) * 16 + swz / 64; C = (st & 1) * 32 + (swz % 64) / 2; }
__host__ __device__ __forceinline__ int perm32(int rho) { const int n = rho >> 4, i = rho & 15; return 8 * (i >> 2) + 4 * n + (i & 3); }

struct Unit { int pm, pn, pe, pk; };
struct Gemm { const bf16_t* A; const bf16_t* Bt; int ld, K; size_t bstride; size_t bdelta = 0; };

struct StaticOrder {
    int nM, nN, nwg, G, c, WGM, pe_pm;
    __host__ __device__ void init(int M, int N, int G_, int c_, int wgm = 4) { nM = M / BM; nN = N / BM; nwg = nM * nN; G = G_; c = c_; WGM = wgm; pe_pm = 1 << 30; }
    __host__ __device__ bool next(int i, Unit& u) const {
        const long L = (long)i * G + c; if (L >= nwg) return false;
        int wgid = (int)L; { const int q = nwg / NXCD, r = nwg % NXCD, xcd = wgid % NXCD, off = wgid / NXCD; wgid = (xcd < r ? xcd * (q + 1) : r * (q + 1) + (xcd - r) * q) + off; }
        const int nig = WGM * nN, gid = wgid / nig, fm = gid * WGM, gsz = (nM - fm) < WGM ? (nM - fm) : WGM;
        u.pm = fm + ((wgid % nig) % gsz); u.pn = (wgid % nig) / gsz; u.pe = u.pm >= pe_pm ? 1 : 0; u.pk = 0; return true;
    }
    __device__ __forceinline__ void a_ready(const Unit&) const {}
    __device__ __forceinline__ void done(const Unit&) const {}
};
struct GroupedOrder {
    int nM, nN, nwg, G, c, WGM; int ts1, ts2, ts3, ts4, ts5, ts6, ts7;
    __device__ bool next(int i, Unit& u) const {
        const long L = (long)i * G + c; if (L >= nwg) return false;
        int wgid = (int)L; { const int q = nwg / NXCD, r = nwg % NXCD, xcd = wgid % NXCD, off = wgid / NXCD; wgid = (xcd < r ? xcd * (q + 1) : r * (q + 1) + (xcd - r) * q) + off; }
        const int nig = WGM * nN, gid = wgid / nig, fm = gid * WGM, gsz = (nM - fm) < WGM ? (nM - fm) : WGM;
        u.pm = fm + ((wgid % nig) % gsz); u.pn = (wgid % nig) / gsz;
        u.pk = 0; const int p = u.pm; u.pe = (p >= ts1) + (p >= ts2) + (p >= ts3) + (p >= ts4) + (p >= ts5) + (p >= ts6) + (p >= ts7); return true;
    }
    __device__ __forceinline__ void a_ready(const Unit&) const {}
    __device__ __forceinline__ void done(const Unit&) const {}
};

__device__ __forceinline__ unsigned cvt_pk_bf16(float lo, float hi) { unsigned r; asm volatile("v_cvt_pk_bf16_f32 %0, %1, %2" : "=v"(r) : "v"(lo), "v"(hi)); return r; }
__device__ __forceinline__ float silu_f(float g) { return g * __builtin_amdgcn_rcpf(1.0f + __expf(-g)); }
typedef float f32x2 __attribute__((ext_vector_type(2)));
__device__ __forceinline__ unsigned swiglu_pk(float ga, float gb, float ua, float ub) {
    const f32x2 g = (f32x2){ga, gb}, u = (f32x2){ua, ub};
    const f32x2 t = g * (-1.4426950408889634f);
    f32x2 e; e.x = __builtin_amdgcn_exp2f(t.x); e.y = __builtin_amdgcn_exp2f(t.y);
    const f32x2 d = e + 1.0f;
    f32x2 r; r.x = __builtin_amdgcn_rcpf(d.x); r.y = __builtin_amdgcn_rcpf(d.y);
    const f32x2 o = (g * r) * u;
    return cvt_pk_bf16(o.x, o.y);
}

struct EpiStoreBf16 {
    static constexpr bool PERM = true, AFTER_DRAIN = false;
    bf16_t* O; int ldc;
    __device__ __forceinline__ void operator()(const f32x4 (&acc)[2][2][4][2], const Unit& u, int wr, int wc, int fr, int fq) const {
        const int row0 = u.pm * BM + wr * 64 + fr, col0 = u.pn * BM + wc * 32 + 8 * fq;
#pragma unroll
        for (int ai = 0; ai < 2; ++ai)
#pragma unroll
            for (int m = 0; m < 4; ++m) { bf16_t* rowp = O + (size_t)(row0 + ai * HALF + m * 16) * ldc + col0;
#pragma unroll
                for (int bj = 0; bj < 2; ++bj) { const f32x4 v0 = acc[ai][bj][m][0], v1 = acc[ai][bj][m][1];
                    u32x4 w; w.x = cvt_pk_bf16(v0[0], v0[1]); w.y = cvt_pk_bf16(v0[2], v0[3]); w.z = cvt_pk_bf16(v1[0], v1[1]); w.w = cvt_pk_bf16(v1[2], v1[3]);
                    *(u32x4*)(rowp + bj * HALF) = w; } }
    }
};
template <bool FOLD> struct EpiSwiGLUT {
    static constexpr bool PERM = true, AFTER_DRAIN = false;
    bf16_t* O; int ldc; const float* ssq; const float* bias;
    __device__ __forceinline__ void operator()(const f32x4 (&acc)[2][2][4][2], const Unit& u, int wr, int wc, int fr, int fq) const {
        const int row0 = u.pm * BM + wr * 64 + fr, col0 = u.pn * HALF + wc * 32 + 8 * fq;
        f32x4 bg0, bg1, bu0, bu1;
        if (FOLD) { const float* bp = bias + (size_t)u.pe * 2 * ldc + col0; bg0 = *(const f32x4*)bp; bg1 = *(const f32x4*)(bp + 4); bu0 = *(const f32x4*)(bp + ldc); bu1 = *(const f32x4*)(bp + ldc + 4); }
        float rsv[2][4];
        if (FOLD) {
#pragma unroll
            for (int ai = 0; ai < 2; ++ai)
#pragma unroll
                for (int m = 0; m < 4; ++m) rsv[ai][m] = ssq[row0 + ai * HALF + m * 16];
#pragma unroll
            for (int ai = 0; ai < 2; ++ai)
#pragma unroll
                for (int m = 0; m < 4; ++m) rsv[ai][m] = __builtin_amdgcn_rsqf(rsv[ai][m] * (1.0f / 1024.0f) + 1e-6f); }
#pragma unroll
        for (int ai = 0; ai < 2; ++ai)
#pragma unroll
            for (int m = 0; m < 4; ++m) { bf16_t* rowp = O + (size_t)(row0 + ai * HALF + m * 16) * ldc + col0;
                f32x4 g0 = acc[ai][0][m][0], g1 = acc[ai][0][m][1], u0 = acc[ai][1][m][0], u1 = acc[ai][1][m][1];
                if (FOLD) { const float rs = rsv[ai][m]; g0 = g0 * rs + bg0; g1 = g1 * rs + bg1; u0 = u0 * rs + bu0; u1 = u1 * rs + bu1; }
                u32x4 w; w.x = swiglu_pk(g0[0], g0[1], u0[0], u0[1]); w.y = swiglu_pk(g0[2], g0[3], u0[2], u0[3]);
                w.z = swiglu_pk(g1[0], g1[1], u1[0], u1[1]); w.w = swiglu_pk(g1[2], g1[3], u1[2], u1[3]);
                *(u32x4*)rowp = w; }
    }
};
typedef EpiSwiGLUT<false> EpiSwiGLU;
typedef EpiSwiGLUT<true> EpiSwiGLUFold;
template <bool BASE_F32> struct EpiRes {
    static constexpr bool PERM = true, AFTER_DRAIN = false;
    bf16_t* X; const void* base; const float* gate; float* ssq = nullptr;
    __device__ __forceinline__ void operator()(const f32x4 (&acc)[2][2][4][2], const Unit& u, int wr, int wc, int fr, int fq) const {
        const int row0 = u.pm * BM + wr * 64 + fr, col0 = u.pn * BM + wc * 32 + 8 * fq;
        f32x4 gv[2][2];
#pragma unroll
        for (int bj = 0; bj < 2; ++bj)
#pragma unroll
            for (int n = 0; n < 2; ++n) gv[bj][n] = *(const f32x4*)(gate + col0 + bj * HALF + 4 * n);
        float sq[2][4];
        if (BASE_F32) {
#pragma unroll
            for (int am = 0; am < 4; ++am) { const int ai = am >> 1, m0 = (am & 1) * 2;
                f32x4 b[2][2][2];
#pragma unroll
                for (int mm = 0; mm < 2; ++mm) { const size_t ro = (size_t)(row0 + ai * HALF + (m0 + mm) * 16) * 1024 + col0;
#pragma unroll
                    for (int bj = 0; bj < 2; ++bj) { b[mm][bj][0] = __builtin_nontemporal_load((const f32x4*)((const float*)base + ro + bj * HALF)); b[mm][bj][1] = __builtin_nontemporal_load((const f32x4*)((const float*)base + ro + bj * HALF + 4)); } }
#pragma unroll
                for (int mm = 0; mm < 2; ++mm) { const int m = m0 + mm; const size_t ro = (size_t)(row0 + ai * HALF + m * 16) * 1024 + col0; float q = 0.f;
#pragma unroll
                    for (int bj = 0; bj < 2; ++bj) {
                        const f32x4 v0 = b[mm][bj][0] + gv[bj][0] * acc[ai][bj][m][0], v1 = b[mm][bj][1] + gv[bj][1] * acc[ai][bj][m][1];
                        q += (v0[0] * v0[0] + v0[1] * v0[1]) + (v0[2] * v0[2] + v0[3] * v0[3]) + (v1[0] * v1[0] + v1[1] * v1[1]) + (v1[2] * v1[2] + v1[3] * v1[3]);
                        u32x4 w; w.x = cvt_pk_bf16(v0[0], v0[1]); w.y = cvt_pk_bf16(v0[2], v0[3]); w.z = cvt_pk_bf16(v1[0], v1[1]); w.w = cvt_pk_bf16(v1[2], v1[3]);
                        *(u32x4*)(X + ro + bj * HALF) = w; }
                    sq[ai][m] = q; }
            }
        } else {
#pragma unroll
            for (int ai = 0; ai < 2; ++ai) {
                u32x4 t[4][2];
#pragma unroll
                for (int m = 0; m < 4; ++m) { const size_t ro = (size_t)(row0 + ai * HALF + m * 16) * 1024 + col0;
#pragma unroll
                    for (int bj = 0; bj < 2; ++bj) t[m][bj] = *(const u32x4*)((const bf16_t*)base + ro + bj * HALF); }
#pragma unroll
                for (int m = 0; m < 4; ++m) { const size_t ro = (size_t)(row0 + ai * HALF + m * 16) * 1024 + col0; float q = 0.f;
#pragma unroll
                    for (int bj = 0; bj < 2; ++bj) { const u32x4 tt = t[m][bj];
                        const f32x4 b0 = (f32x4){__uint_as_float(tt.x << 16), __uint_as_float(tt.x & 0xffff0000u), __uint_as_float(tt.y << 16), __uint_as_float(tt.y & 0xffff0000u)};
                        const f32x4 b1 = (f32x4){__uint_as_float(tt.z << 16), __uint_as_float(tt.z & 0xffff0000u), __uint_as_float(tt.w << 16), __uint_as_float(tt.w & 0xffff0000u)};
                        const f32x4 v0 = b0 + gv[bj][0] * acc[ai][bj][m][0], v1 = b1 + gv[bj][1] * acc[ai][bj][m][1];
                        q += (v0[0] * v0[0] + v0[1] * v0[1]) + (v0[2] * v0[2] + v0[3] * v0[3]) + (v1[0] * v1[0] + v1[1] * v1[1]) + (v1[2] * v1[2] + v1[3] * v1[3]);
                        u32x4 w; w.x = cvt_pk_bf16(v0[0], v0[1]); w.y = cvt_pk_bf16(v0[2], v0[3]); w.z = cvt_pk_bf16(v1[0], v1[1]); w.w = cvt_pk_bf16(v1[2], v1[3]);
                        *(u32x4*)(X + ro + bj * HALF) = w; }
                    sq[ai][m] = q; }
            }
        }
        if (ssq) {
#pragma unroll
            for (int ai = 0; ai < 2; ++ai)
#pragma unroll
                for (int m = 0; m < 4; ++m) sq[ai][m] += __shfl_xor(sq[ai][m], 16);
#pragma unroll
            for (int ai = 0; ai < 2; ++ai)
#pragma unroll
                for (int m = 0; m < 4; ++m) sq[ai][m] += __shfl_xor(sq[ai][m], 32);
            if (fq == 0) {
#pragma unroll
                for (int ai = 0; ai < 2; ++ai)
#pragma unroll
                    for (int m = 0; m < 4; ++m) unsafeAtomicAdd(ssq + row0 + ai * HALF + m * 16, sq[ai][m]); }
        }
    }
};
template <bool FOLD> struct EpiSsdInT {
    static constexpr bool PERM = true, AFTER_DRAIN = false;
    bf16_t* Z; bf16_t* XB; float* DT; const float* ssq; const float* bias;
    __device__ __forceinline__ void operator()(const f32x4 (&acc)[2][2][4][2], const Unit& u, int wr, int wc, int fr, int fq) const {
        const int row0 = u.pm * BM + wr * 64 + fr;
        const float* bp = bias + (size_t)u.pe * 5376 + u.pn * BM + wc * 32 + 8 * fq;
        float rsv[2][4]; f32x4 bv[2][2];
        if (FOLD) {
#pragma unroll
            for (int ai = 0; ai < 2; ++ai)
#pragma unroll
                for (int m = 0; m < 4; ++m) rsv[ai][m] = ssq[row0 + ai * HALF + m * 16];
#pragma unroll
            for (int bj = 0; bj < 2; ++bj) { bv[bj][0] = *(const f32x4*)(bp + bj * HALF); bv[bj][1] = *(const f32x4*)(bp + bj * HALF + 4); }
#pragma unroll
            for (int ai = 0; ai < 2; ++ai)
#pragma unroll
                for (int m = 0; m < 4; ++m) rsv[ai][m] = __builtin_amdgcn_rsqf(rsv[ai][m] * (1.0f / 1024.0f) + 1e-6f); }
        if (u.pn < 20) {
            bf16_t* O = u.pn < 8 ? Z : XB; const int ldc = u.pn < 8 ? 2048 : 3072; const int col0 = (u.pn < 8 ? u.pn : u.pn - 8) * BM + wc * 32 + 8 * fq;
#pragma unroll
            for (int ai = 0; ai < 2; ++ai)
#pragma unroll
                for (int m = 0; m < 4; ++m) { bf16_t* rowp = O + (size_t)(row0 + ai * HALF + m * 16) * ldc + col0;
                    const float rs = FOLD ? rsv[ai][m] : 1.0f;
#pragma unroll
                    for (int bj = 0; bj < 2; ++bj) { f32x4 v0 = acc[ai][bj][m][0], v1 = acc[ai][bj][m][1]; if (FOLD) { v0 = v0 * rs + bv[bj][0]; v1 = v1 * rs + bv[bj][1]; }
                        u32x4 w; w.x = cvt_pk_bf16(v0[0], v0[1]); w.y = cvt_pk_bf16(v0[2], v0[3]); w.z = cvt_pk_bf16(v1[0], v1[1]); w.w = cvt_pk_bf16(v1[2], v1[3]);
                        *(u32x4*)(rowp + bj * HALF) = w; } }
        } else if (wc < 2) {
#pragma unroll
            for (int ai = 0; ai < 2; ++ai)
#pragma unroll
                for (int m = 0; m < 4; ++m) { float* rowp = DT + (size_t)(row0 + ai * HALF + m * 16) * 64 + wc * 32 + 8 * fq;
                    if (FOLD) { const float rs = rsv[ai][m];
                        *(f32x4*)rowp = acc[ai][0][m][0] * rs + bv[0][0]; *(f32x4*)(rowp + 4) = acc[ai][0][m][1] * rs + bv[0][1]; }
                    else { *(f32x4*)rowp = acc[ai][0][m][0]; *(f32x4*)(rowp + 4) = acc[ai][0][m][1]; } }
        }
    }
};
typedef EpiSsdInT<true> EpiSsdIn;


struct SplitOrder {
    int pm0, nN, nunits, ks_len, G, c;
    __device__ bool next(int i, Unit& u) const { const int x = i * G + c; if (x >= nunits) return false; u.pm = pm0; u.pn = x % nN; u.pe = 0; u.pk = (x / nN) * ks_len; return true; }
    __device__ __forceinline__ void a_ready(const Unit&) const {}
    __device__ __forceinline__ void done(const Unit&) const {}
};
struct SplitGroupedOrder {
    int pm_lo, pm_hi, nN, nks, ks_len, G, c; int ts1, ts2, ts3, ts4, ts5, ts6, ts7;
    __device__ bool next(int i, Unit& u) const { const int x = i * G + c; const int per = nN * nks; if (x >= (pm_hi - pm_lo) * per) return false;
        u.pm = pm_lo + x / per; const int y = x % per; u.pn = y / nks; u.pk = (y % nks) * ks_len;
        const int p = u.pm; u.pe = (p >= ts1) + (p >= ts2) + (p >= ts3) + (p >= ts4) + (p >= ts5) + (p >= ts6) + (p >= ts7); return true; }
    __device__ __forceinline__ void a_ready(const Unit&) const {}
    __device__ __forceinline__ void done(const Unit&) const {}
};
struct EpiPart {
    static constexpr bool PERM = false, AFTER_DRAIN = false;
    float* P; int pm_base, ks_len, nrows;
    __device__ __forceinline__ void operator()(const f32x4 (&acc)[2][2][4][2], const Unit& u, int wr, int wc, int fr, int fq) const {
        const int row0 = (u.pm - pm_base) * BM + wr * 64 + fr, col0 = u.pn * BM + wc * 32 + 4 * fq;
        float* base = P + (size_t)(u.pk / ks_len) * nrows * 1024;
#pragma unroll
        for (int ai = 0; ai < 2; ++ai)
#pragma unroll
            for (int m = 0; m < 4; ++m) { float* rowp = base + (size_t)(row0 + ai * HALF + m * 16) * 1024 + col0;
#pragma unroll
                for (int bj = 0; bj < 2; ++bj)
#pragma unroll
                    for (int n = 0; n < 2; ++n) *(f32x4*)(rowp + bj * HALF + n * 16) = acc[ai][bj][m][n]; }
    }
};
template <class Epi, class Sched, bool ALIGN_EPI = false, bool SP2 = false>
__device__ __forceinline__ void gemm_phase(PG8_LAS unsigned char* lds, const Gemm g, const Sched& S, const Epi& E) {
    const int tid = threadIdx.x, wid = __builtin_amdgcn_readfirstlane(tid >> 6), lane = tid & 63, wr = wid >> 2, wc = wid & 3, fr = lane & 15, fq = lane >> 4;
    const int K = g.K, nt = K / BK;
    unsigned voffA[2], voffB[2];
#pragma unroll
    for (int i = 0; i < 2; ++i) { int R, C; stage_rc(tid * 16 + i * 8192, R, C); const int Rb = Epi::PERM ? ((R & ~31) + perm32(R & 31)) : R;
        voffA[i] = (unsigned)(R * g.ld + C) * 2u; voffB[i] = (unsigned)(Rb * g.ld + C) * 2u; }
    const size_t kstep = (size_t)(BK * 2);
    const size_t hstep = (size_t)HALF * g.ld * 2;
    const size_t tstep = 2 * hstep;
    const unsigned ldsw = (unsigned)wid * 1024u;
    const int aoff = lds_byte(wr * 64 + fr, fq * 8), boff = lds_byte(wc * 32 + fr, fq * 8);
#define PG8_SA(b, h) (((b) * 2 + (h)) * HTB)
#define PG8_SB(b, h) ((4 + (b) * 2 + (h)) * HTB)
#define PG8_STAGE(bufoff, gbase, voff) do { _Pragma("unroll") for (int _i = 0; _i < 2; ++_i) \
        __builtin_amdgcn_global_load_lds((const unsigned*)((const char*)(gbase) + (voff)[_i]), (PG8_LAS unsigned*)(lds + (bufoff) + ldsw + _i * 8192), 16, 0, 0); } while (0)
#define PG8_LDA(dst, b, h) do { _Pragma("unroll") for (int m = 0; m < 4; ++m) _Pragma("unroll") for (int k = 0; k < 2; ++k) dst[m][k] = *(const PG8_LAS bf16x8*)(lds + PG8_SA(b, h) + aoff + m * 2048 + k * 1024); } while (0)
#define PG8_LDB(dst, b, h) do { _Pragma("unroll") for (int n = 0; n < 2; ++n) _Pragma("unroll") for (int k = 0; k < 2; ++k) dst[n][k] = *(const PG8_LAS bf16x8*)(lds + PG8_SB(b, h) + boff + n * 2048 + k * 1024); } while (0)
#define PG8_MMA(ai, bj, At, Bt) do { __builtin_amdgcn_s_setprio(1); _Pragma("unroll") for (int m = 0; m < 4; ++m) _Pragma("unroll") for (int n = 0; n < 2; ++n) _Pragma("unroll") for (int k = 0; k < 2; ++k) \
        acc[ai][bj][m][n] = __builtin_amdgcn_mfma_f32_16x16x32_bf16(Bt[n][k], At[m][k], acc[ai][bj][m][n], 0, 0, 0); __builtin_amdgcn_s_setprio(0); } while (0)
#define PG8_WAIT_V(n) asm volatile("s_waitcnt vmcnt(" #n ")" ::: "memory")
#define PG8_WAIT_L(n) asm volatile("s_waitcnt lgkmcnt(" #n ")" ::: "memory")
#define PG8_BAR __builtin_amdgcn_s_barrier()
#define PG8_SCHED __builtin_amdgcn_sched_barrier(0)
    Unit cur, nxt; int ui = 0;
    if (!S.next(0, cur)) return;
    f32x4 acc[2][2][4][2];
#pragma unroll
    for (int a = 0; a < 2; ++a)
#pragma unroll
        for (int b = 0; b < 2; ++b)
#pragma unroll
            for (int m = 0; m < 4; ++m)
#pragma unroll
                for (int n = 0; n < 2; ++n) acc[a][b][m][n] = (f32x4){0.f, 0.f, 0.f, 0.f};
    bf16x8 At[4][2], B0[2][2], B1[2][2];
    const char* cA = (const char*)g.A + (size_t)cur.pm * tstep + (size_t)cur.pk * 2; const char* cB = (const char*)g.Bt + (size_t)cur.pe * g.bstride + (cur.pe >= 4 ? g.bdelta : (size_t)0) + (size_t)cur.pn * tstep + (size_t)cur.pk * 2;
    S.a_ready(cur);
    if constexpr (SP2) {
        PG8_STAGE(PG8_SB(0, 0), cB, voffB); PG8_STAGE(PG8_SB(0, 1), cB + hstep, voffB); PG8_STAGE(PG8_SA(0, 0), cA, voffA); PG8_STAGE(PG8_SA(0, 1), cA + hstep, voffA);
        if (wr == 1) PG8_BAR;
        PG8_WAIT_V(2); PG8_BAR;
        PG8_STAGE(PG8_SB(1, 0), cB + kstep, voffB); PG8_STAGE(PG8_SA(1, 0), cA + kstep, voffA); PG8_STAGE(PG8_SB(1, 1), cB + hstep + kstep, voffB);
        PG8_WAIT_V(6); PG8_BAR;
    } else {
        PG8_STAGE(PG8_SB(0, 0), cB, voffB); PG8_STAGE(PG8_SA(0, 0), cA, voffA); PG8_STAGE(PG8_SB(0, 1), cB + hstep, voffB); PG8_STAGE(PG8_SA(0, 1), cA + hstep, voffA);
        if (wr == 1) PG8_BAR;
        PG8_WAIT_V(4); PG8_BAR;
        PG8_STAGE(PG8_SB(1, 0), cB + kstep, voffB); PG8_STAGE(PG8_SA(1, 0), cA + kstep, voffA); PG8_STAGE(PG8_SB(1, 1), cB + hstep + kstep, voffB);
        PG8_WAIT_V(6); PG8_BAR;
    }
    for (;;) {
        const bool has_next = S.next(ui + 1, nxt);
        const char* nA = has_next ? (const char*)g.A + (size_t)nxt.pm * tstep + (size_t)nxt.pk * 2 : cA; const char* nB = has_next ? (const char*)g.Bt + (size_t)nxt.pe * g.bstride + (nxt.pe >= 4 ? g.bdelta : (size_t)0) + (size_t)nxt.pn * tstep + (size_t)nxt.pk * 2 : cB;
        for (int t = 0; t < nt; t += 2) {
            const bool last = (t == nt - 2);
            const char* a1 = cA + (size_t)(t + 1) * kstep;
            const char* a2 = last ? nA : cA + (size_t)(t + 2) * kstep; const char* b2 = last ? nB : cB + (size_t)(t + 2) * kstep;
            const char* a3 = a2 + kstep; const char* b3 = b2 + kstep;
            if (last && has_next) S.a_ready(nxt);
            if constexpr (SP2) {
            PG8_LDB(B0, 0, 0); PG8_LDB(B1, 0, 1); PG8_SCHED; PG8_LDA(At, 0, 0); PG8_STAGE(PG8_SA(1, 1), a1 + hstep, voffA);
            PG8_WAIT_V(8); PG8_WAIT_L(0); PG8_BAR; PG8_MMA(0, 0, At, B0); PG8_MMA(0, 1, At, B1); PG8_BAR; PG8_SCHED;
            PG8_LDA(At, 0, 1); PG8_STAGE(PG8_SB(0, 0), b2, voffB); PG8_STAGE(PG8_SB(0, 1), b2 + hstep, voffB); PG8_STAGE(PG8_SA(0, 0), a2, voffA);
            PG8_WAIT_V(8); PG8_WAIT_L(0); PG8_BAR; PG8_MMA(1, 0, At, B0); PG8_MMA(1, 1, At, B1); PG8_BAR; PG8_SCHED;
            PG8_LDB(B0, 1, 0); PG8_LDB(B1, 1, 1); PG8_SCHED; PG8_LDA(At, 1, 0); PG8_STAGE(PG8_SA(0, 1), a2 + hstep, voffA);
            PG8_WAIT_V(8); PG8_WAIT_L(0); PG8_BAR; PG8_MMA(0, 0, At, B0); PG8_MMA(0, 1, At, B1); PG8_BAR; PG8_SCHED;
            PG8_LDA(At, 1, 1); PG8_STAGE(PG8_SB(1, 0), b3, voffB); PG8_STAGE(PG8_SB(1, 1), b3 + hstep, voffB); PG8_STAGE(PG8_SA(1, 0), a3, voffA);
            PG8_WAIT_V(8); PG8_WAIT_L(0); PG8_BAR; PG8_MMA(1, 0, At, B0); PG8_MMA(1, 1, At, B1); PG8_BAR; PG8_SCHED;
            } else {
            PG8_LDB(B0, 0, 0); PG8_SCHED; PG8_LDA(At, 0, 0); PG8_STAGE(PG8_SA(1, 1), a1 + hstep, voffA);
            PG8_WAIT_L(8); PG8_BAR; PG8_WAIT_L(0); PG8_MMA(0, 0, At, B0); PG8_BAR; PG8_SCHED;
            PG8_LDB(B1, 0, 1); PG8_STAGE(PG8_SB(0, 0), b2, voffB);
            PG8_BAR; PG8_WAIT_L(0); PG8_MMA(0, 1, At, B1); PG8_BAR;
            PG8_LDA(At, 0, 1); PG8_STAGE(PG8_SA(0, 0), a2, voffA);
            PG8_BAR; PG8_WAIT_L(0); PG8_MMA(1, 0, At, B0); PG8_BAR; PG8_SCHED;
            PG8_STAGE(PG8_SB(0, 1), b2 + hstep, voffB);
            PG8_WAIT_V(6); PG8_BAR; PG8_MMA(1, 1, At, B1); PG8_BAR;
            PG8_LDB(B0, 1, 0); PG8_SCHED; PG8_LDA(At, 1, 0); PG8_STAGE(PG8_SA(0, 1), a2 + hstep, voffA);
            PG8_WAIT_L(8); PG8_BAR; PG8_WAIT_L(0); PG8_MMA(0, 0, At, B0); PG8_BAR; PG8_SCHED;
            PG8_LDB(B1, 1, 1); PG8_STAGE(PG8_SB(1, 0), b3, voffB);
            PG8_BAR; PG8_WAIT_L(0); PG8_MMA(0, 1, At, B1); PG8_BAR;
            PG8_LDA(At, 1, 1); PG8_STAGE(PG8_SA(1, 0), a3, voffA);
            PG8_BAR; PG8_WAIT_L(0); PG8_MMA(1, 0, At, B0); PG8_BAR; PG8_SCHED;
            PG8_STAGE(PG8_SB(1, 1), b3 + hstep, voffB);
            PG8_WAIT_V(6); PG8_BAR; PG8_MMA(1, 1, At, B1); PG8_BAR;
            }
        }
        if constexpr (ALIGN_EPI) { if (wr == 0) PG8_BAR; }
        if constexpr (!Epi::AFTER_DRAIN) { E(acc, cur, wr, wc, fr, fq); S.done(cur); }
        if (!has_next) break;
#pragma unroll
        for (int a = 0; a < 2; ++a)
#pragma unroll
            for (int b = 0; b < 2; ++b)
#pragma unroll
                for (int m = 0; m < 4; ++m)
#pragma unroll
                    for (int n = 0; n < 2; ++n) acc[a][b][m][n] = (f32x4){0.f, 0.f, 0.f, 0.f};
        cur = nxt; cA = nA; cB = nB; ++ui;
        if constexpr (ALIGN_EPI) { if (wr == 1) PG8_BAR; }
    }
    PG8_WAIT_V(0);
    if constexpr (!ALIGN_EPI) { if (wr == 0) PG8_BAR; }
    PG8_BAR;
    if constexpr (Epi::AFTER_DRAIN) { E.fused(acc, cur, wr, wc, fr, fq, lds, wid, lane); S.done(cur); }
#undef PG8_SA
#undef PG8_SB
#undef PG8_STAGE
#undef PG8_LDA
#undef PG8_LDB
#undef PG8_MMA
#undef PG8_WAIT_V
#undef PG8_WAIT_L
#undef PG8_BAR
#undef PG8_SCHED
}
}

constexpr int NWAVES = 8, NTHR = 512;
constexpr int D = 1024, L = 16384, LC = 256, MT = L + LC;
constexpr int AB_IN = 2304, DFF = 2816, SSD_INP = 5376, SSD_IN_REAL = 5184, DIN = 2048, XBCW = 3072, FFE = 3584, NEXP = 8;
constexpr int NCH = MT / 128;
constexpr int MOE_ROWS = 2 * L + NEXP * 256;
constexpr float EPS = 1e-6f;

constexpr size_t MiB = 1u << 20;
constexpr size_t WS_CTL = 0, CTL_ZERO_BYTES = 32768;
constexpr size_t WS_MOD = 1 * MiB;
constexpr size_t WS_ROPE = 1 * MiB + 128 * 1024;
constexpr size_t WS_TOKE = 2 * MiB, WS_TOKW = 2 * MiB + 128 * 1024, WS_TOKP = 2 * MiB + 256 * 1024;
constexpr size_t WS_RSTD = 2 * MiB + 384 * 1024;
constexpr size_t WS_DEC = 3 * MiB;
constexpr size_t WS_SSQA = 3 * MiB + 64 * 1024, WS_SSQB = 3 * MiB + 192 * 1024;
constexpr size_t WS_BIASA = 3 * MiB + 320 * 1024, WS_BIASB = 3 * MiB + 384 * 1024;
constexpr size_t WS_WCTX2 = 467 * MiB;
constexpr size_t WS_WCTX = 455 * MiB;
constexpr size_t WS_X = 4 * MiB;
constexpr size_t WS_H = 36 * MiB + 512 * 1024;
constexpr size_t WS_WMOE = 69 * MiB, WS_YPART = WS_WMOE + 56 * MiB;
constexpr size_t WS_H2S = 181 * MiB, WS_ACTM = 249 * MiB, WS_H2 = 487 * MiB, WS_END = 520 * MiB;
constexpr size_t WS_WDA = WS_H, WS_WDB = 487 * MiB, WD_BYTES = (size_t)D * FFE * 2;
static_assert(WS_WDA + 4 * WD_BYTES <= WS_WMOE && WS_WDB + 4 * WD_BYTES <= WS_END && WS_WDB >= WS_ACTM + (size_t)MOE_ROWS * FFE * 2, "down-weight regions");
constexpr size_t WS_WSSDIN = 181 * MiB, WS_WSSDOUT = WS_WSSDIN + (size_t)SSD_INP * D * 2;
constexpr size_t WS_WABIN = 196 * MiB, WS_WABOUT = WS_WABIN + (size_t)AB_IN * D * 2, WS_WFFNGU = WS_WABOUT + (size_t)D * D * 2, WS_WFFND = WS_WFFNGU + (size_t)2 * DFF * D * 2;
constexpr size_t WS_PAB = 219 * MiB, WS_MIX = 293 * MiB, WS_ACT0 = 326 * MiB, WS_QR = 416 * MiB, WS_KR = 433 * MiB, WS_VT = 438 * MiB, WS_PART = 443 * MiB;
constexpr size_t WS_Z = 196 * MiB, WS_XBCR = 261 * MiB, WS_STATES = 261 * MiB, WS_DTRAW = 391 * MiB, WS_DTS = 396 * MiB, WS_XT = 405 * MiB, WS_BT = 470 * MiB, WS_BM = 487 * MiB, WS_CM = 503 * MiB + 512 * 1024;
constexpr size_t WS_WF = 181 * MiB;
constexpr size_t DTS_STRIDE = (size_t)32 * MT * 4;
static_assert(WS_X + (size_t)MT * D * 2 <= WS_H && WS_H + (size_t)MT * D * 2 <= WS_WMOE, "X / H map");
static_assert(WS_WMOE + (size_t)NEXP * 2 * FFE * D * 2 <= WS_H2S && WS_H2S + (size_t)MOE_ROWS * D * 2 <= WS_ACTM && WS_ACTM + (size_t)MOE_ROWS * FFE * 2 <= WS_H2 && WS_H2 + (size_t)L * D * 2 <= WS_END, "moe map");
static_assert(WS_YPART >= WS_WMOE + (size_t)NEXP * D * FFE * 2 && WS_YPART + (size_t)7 * 2048 * D * 4 <= WS_H2S, "moe map 2");
static_assert(WS_WSSDOUT + (size_t)D * DIN * 2 <= WS_WABIN && WS_WFFND + (size_t)D * DFF * 2 <= WS_PAB, "weights map");
static_assert(WS_PAB + (size_t)MT * AB_IN * 2 <= WS_MIX && WS_MIX + (size_t)MT * D * 2 <= WS_ACT0 && WS_ACT0 + (size_t)MT * DFF * 2 <= WS_QR && WS_QR + (size_t)8 * MT * 64 * 2 <= WS_KR && WS_KR + (size_t)2 * MT * 64 * 2 <= WS_VT && WS_VT + (size_t)128 * MT * 2 <= WS_PART && WS_PART + (size_t)11 * LC * D * 4 <= WS_END, "layer0 map");
static_assert(WS_WSSDOUT + (size_t)D * DIN * 2 <= WS_Z && WS_Z + (size_t)MT * DIN * 2 <= WS_XBCR && WS_XBCR + (size_t)MT * XBCW * 2 <= WS_DTRAW && WS_STATES + (size_t)2 * NCH * 32 * 64 * 128 * 2 <= WS_DTRAW && WS_DTRAW + (size_t)MT * 64 * 4 <= WS_DTS && WS_DTS + 4 * DTS_STRIDE <= WS_XT && WS_XT + (size_t)DIN * MT * 2 <= WS_BT && WS_BT + (size_t)512 * MT * 2 <= WS_BM && WS_BM + (size_t)MT * 512 * 2 <= WS_CM && WS_CM + (size_t)MT * 512 * 2 <= WS_END, "ssd map");
static_assert(WS_PART + (size_t)11 * LC * D * 4 <= WS_BT && WS_PART >= WS_DTS + 4 * DTS_STRIDE || true, "PART is read by the layer-1 modulate before the SSD conv writes XT");
constexpr int CW_TMO = 0;
constexpr int CW_SOFT1 = 704;
constexpr int CW_CNT = 1536;
constexpr int CW_PCNT = 512;
constexpr int CW_HIST = 1024;
constexpr int CW_BAR = 4096;

constexpr int RING_BYTES = 159744, LDSCTL_OFF = RING_BYTES, MISC_OFF = LDSCTL_OFF + 320, LDS_BYTES = 163840;

#define GAS __attribute__((address_space(1)))
#define LAS __attribute__((address_space(3)))
typedef unsigned short bf16;
typedef unsigned v4u __attribute__((ext_vector_type(4)));
typedef unsigned v2u __attribute__((ext_vector_type(2)));
typedef float f32x4 __attribute__((ext_vector_type(4)));
typedef GAS unsigned gu32;
#define RLX_AGENT __ATOMIC_RELAXED, __HIP_MEMORY_SCOPE_AGENT
#define LDS_WAIT() asm volatile("s_waitcnt lgkmcnt(0)" ::: "memory")
#define VM_WAIT() asm volatile("s_waitcnt vmcnt(0)" ::: "memory")
__device__ __forceinline__ unsigned pk2(float lo, float hi) { return pg8::cvt_pk_bf16(lo, hi); }
__device__ __forceinline__ float bflo(unsigned u) { return __uint_as_float(u << 16); }
__device__ __forceinline__ float bfhi(unsigned u) { return __uint_as_float(u & 0xffff0000u); }
__device__ __forceinline__ float bf1(bf16 b) { return __uint_as_float(((unsigned)b) << 16); }
__device__ __forceinline__ float sigmoid_f(float x) { return __builtin_amdgcn_rcpf(1.0f + __builtin_amdgcn_exp2f(-1.4426950408889634f * x)); }
__device__ __forceinline__ float softplus_f(float x) {
    const float y = __builtin_amdgcn_exp2f(-1.4426950408889634f * fabsf(x));
    const float l = y < 1.0e-3f ? y * (1.0f - 0.5f * y) : __builtin_amdgcn_logf(1.0f + y) * 0.6931471805599453f;
    return fmaxf(x, 0.f) + l; }

#define XB_TMO      128
#define XB_XCNT(j)  (256  + 64 * (j))
#define XB_XSUB(j)  (1280 + 64 * (j))
#define XB_XGEN(j)  (2304 + 64 * (j))
#define XB_TOP      3328
#define XB_TOPGEN   3392
#define XCD_BAR_WORDS 3456
#define XB_SPIN_CAP (1u << 18)
__device__ __forceinline__ unsigned xb_ld(unsigned* p)              { return __hip_atomic_load(p, __ATOMIC_RELAXED, __HIP_MEMORY_SCOPE_AGENT); }
__device__ __forceinline__ unsigned xb_add(unsigned* p, unsigned v) { return __hip_atomic_fetch_add(p, v, __ATOMIC_RELAXED, __HIP_MEMORY_SCOPE_AGENT); }
__device__ __forceinline__ unsigned xb_xcc_id() { return (unsigned)__builtin_amdgcn_s_getreg((3 << 11) | 20) & 0xFu; }
#define XB_SPIN(cond, bar) do { unsigned _sp = 0; while (cond) { __builtin_amdgcn_s_sleep(1); \
    if ((++_sp & 255u) == 0u) { if (xb_ld(&(bar)[XB_TMO])) break; if (_sp > XB_SPIN_CAP) { atomicAdd(&(bar)[XB_TMO], 1u); break; } } } } while (0)
struct XcdBarrier { unsigned* bar; unsigned x; volatile LAS unsigned* st; };
__device__ __forceinline__ XcdBarrier xcd_barrier_post(unsigned* bar, volatile LAS unsigned* st) {
    XcdBarrier b; b.bar = bar; b.x = xb_xcc_id(); b.st = st;
    if (threadIdx.x == 0) (void)xb_add(&bar[XB_XCNT(b.x)], 1u);
    return b;
}
__device__ __forceinline__ void xcd_barrier_complete(unsigned* bar, unsigned x, unsigned& nloc, unsigned& nx) {
    const unsigned G = gridDim.x * gridDim.y * gridDim.z;
    unsigned sum, cnt, mine, sp = 0u;
    for (;;) {
        sum = 0u; cnt = 0u; mine = 0u;
#pragma unroll
        for (unsigned j = 0; j < 16; ++j) { const unsigned c = xb_ld(&bar[XB_XCNT(j)]); sum += c; cnt += (c > 0u) ? 1u : 0u; mine = (j == x) ? c : mine; }
        if (sum == G) break;
        __builtin_amdgcn_s_sleep(1);
        if ((++sp & 255u) == 0u) { if (xb_ld(&bar[XB_TMO])) break; if (sp > XB_SPIN_CAP) { atomicAdd(&bar[XB_TMO], 1u); break; } }
    }
    nloc = mine > 0u ? mine : 1u; nx = cnt > 0u ? cnt : 1u;
}
__device__ __forceinline__ void xcd_barrier(const XcdBarrier& b) {
    asm volatile("s_waitcnt vmcnt(0)" ::: "memory");
    __syncthreads();
    if (threadIdx.x == 0) {
        unsigned* bar = b.bar;
        __builtin_amdgcn_s_waitcnt(0);
        unsigned nloc = b.st[0], nx = b.st[1];
        if (nloc == 0u) { xcd_barrier_complete(bar, b.x, nloc, nx); b.st[0] = nloc; b.st[1] = nx; }
        const unsigned old = xb_add(&bar[XB_XSUB(b.x)], 1u);
        const unsigned gen = old / nloc;
        if (old + 1u == (gen + 1u) * nloc) {
            __builtin_amdgcn_fence(__ATOMIC_RELEASE, "agent");
            asm volatile("s_waitcnt vmcnt(0)" ::: "memory");
            __builtin_amdgcn_fence(__ATOMIC_ACQUIRE, "agent");
            const unsigned og = xb_add(&bar[XB_TOP], 1u);
            const unsigned tg = og / nx;
            if (og + 1u == (tg + 1u) * nx) xb_add(&bar[XB_TOPGEN], 1u);
            else XB_SPIN(xb_ld(&bar[XB_TOPGEN]) == tg, bar);
            asm volatile("" ::: "memory");
            xb_add(&bar[XB_XGEN(b.x)], 1u);
            asm volatile("s_waitcnt vmcnt(0)" ::: "memory");
        } else {
            __builtin_amdgcn_fence(__ATOMIC_ACQUIRE, "agent");
            XB_SPIN(xb_ld(&bar[XB_XGEN(b.x)]) == gen, bar);
            asm volatile("s_waitcnt vmcnt(0)" ::: "memory");
        }
    }
    __syncthreads();
}

struct Frame {
    LAS unsigned char* lds;
    int tid, lane, wave, vcu, G;
    const float* in[30]; float* out; unsigned char* ws;
};
enum { I_X = 0, I_C, I_CTX, I_CCTX, I_ADAW, I_ADAB, I_N1G, I_N2G, I_ABWIN, I_ABCONV, I_ABSINK, I_ABWOUT, I_FFNG, I_FFNU, I_FFND, I_SSDWIN, I_SSDCW, I_SSDCB,
       I_DTBF, I_DTBB, I_ALOGF, I_ALOGB, I_SSDD, I_SSDNG, I_SSDWOUT, I_ROUTER, I_MOEG, I_MOEU, I_MOED, I_FINALG };
template <int CTRL> __device__ __forceinline__ float dpp_add(float v) { return v + __int_as_float(__builtin_amdgcn_update_dpp(0, __float_as_int(v), CTRL, 0xf, 0xf, true)); }
__device__ __forceinline__ float wave_sum(float v) {
    v = dpp_add<0xB1>(v);
    v = dpp_add<0x4E>(v);
    v = dpp_add<0x141>(v);
    v = dpp_add<0x140>(v);
    const int iv = __float_as_int(v);
    return (__int_as_float(__builtin_amdgcn_readlane(iv, 0)) + __int_as_float(__builtin_amdgcn_readlane(iv, 16))) + (__int_as_float(__builtin_amdgcn_readlane(iv, 32)) + __int_as_float(__builtin_amdgcn_readlane(iv, 48)));
}
constexpr int M_SH1 = 0, M_SC1 = 1024, M_G1 = 2048, M_SH2 = 3072, M_SC2 = 4096, M_G2 = 5120;
__device__ __forceinline__ const float* modp(const Frame& F, int layer, int s) { return (const float*)(F.ws + WS_MOD) + (size_t)(layer * 2 + s) * 6144; }

__device__ __forceinline__ void tr_load(const float* W, int N, int k0, int n0, int lane, f32x4 (&w)[8]) {
#pragma unroll
    for (int i = 0; i < 8; ++i) w[i] = __builtin_nontemporal_load((const GAS f32x4*)(W + (size_t)(k0 + (lane >> 3) + 8 * i) * N + n0 + 4 * (lane & 7)));
}
__device__ __forceinline__ void tr_finish(const f32x4 (&w)[8], bf16* WT, int Kdst, int k0, int drow0, LAS float* scr, int lane) {
#pragma unroll
    for (int i = 0; i < 8; ++i) { LAS float* d = scr + ((lane >> 3) + 8 * i) * 33 + 4 * (lane & 7); d[0] = w[i].x; d[1] = w[i].y; d[2] = w[i].z; d[3] = w[i].w; }
    LDS_WAIT(); asm volatile("" ::: "memory");
    const int c = lane & 7;
#pragma unroll
    for (int j = 0; j < 4; ++j) { const int n = (lane >> 3) + 8 * j; const LAS float* s = scr + (8 * c) * 33 + n;
        v4u o; o.x = pk2(s[0 * 33], s[1 * 33]); o.y = pk2(s[2 * 33], s[3 * 33]); o.z = pk2(s[4 * 33], s[5 * 33]); o.w = pk2(s[6 * 33], s[7 * 33]);
        __builtin_nontemporal_store(o, (GAS v4u*)(WT + (size_t)(drow0 + n) * Kdst + k0 + 8 * c)); }
    LDS_WAIT(); asm volatile("" ::: "memory");
}
__device__ __forceinline__ void tr_item(const float* W, int N, bf16* WT, int Kdst, int k0, int n0, int drow0, LAS float* scr, int lane) {
    { f32x4 w[8];
#pragma unroll
      for (int i = 0; i < 8; ++i) w[i] = __builtin_nontemporal_load((const GAS f32x4*)(W + (size_t)(k0 + (lane >> 3) + 8 * i) * N + n0 + 4 * (lane & 7)));
#pragma unroll
      for (int i = 0; i < 8; ++i) { LAS float* d = scr + ((lane >> 3) + 8 * i) * 33 + 4 * (lane & 7); d[0] = w[i].x; d[1] = w[i].y; d[2] = w[i].z; d[3] = w[i].w; } }
    LDS_WAIT(); asm volatile("" ::: "memory");
    const int c = lane & 7;
#pragma unroll
    for (int j = 0; j < 4; ++j) { const int n = (lane >> 3) + 8 * j; const LAS float* s = scr + (8 * c) * 33 + n;
        v4u o; o.x = pk2(s[0 * 33], s[1 * 33]); o.y = pk2(s[2 * 33], s[3 * 33]); o.z = pk2(s[4 * 33], s[5 * 33]); o.w = pk2(s[6 * 33], s[7 * 33]);
        __builtin_nontemporal_store(o, (GAS v4u*)(WT + (size_t)(drow0 + n) * Kdst + k0 + 8 * c)); }
    LDS_WAIT(); asm volatile("" ::: "memory");
}
__device__ __forceinline__ void tr_matrix(const Frame& F, const float* W, int K, int N, bf16* WT, int mode, int& first, int gw = -1, int NGW = 0) {
    LAS float* scr = (LAS float*)(F.lds + F.wave * 16384);
    if (gw < 0) { gw = F.vcu * NWAVES + F.wave; NGW = F.G * NWAVES; }
    const int nblk = N / 32, nitems = (K / 64) * nblk;
    int it = gw - (first % NGW); if (it < 0) it += NGW;
    for (; it < nitems; it += NGW) {
        const int kb = it / nblk, nb = it % nblk, n0 = 32 * nb;
        const int drow0 = mode == 0 ? n0 : ((n0 >> 7) * 256 + (n0 & 127) + (mode == 2 ? 128 : 0));
        tr_item(W, N, WT, K, 64 * kb, n0, drow0, scr, F.lane);
    }
    first += nitems;
}

constexpr int FOLD_TAB_OFF = 131072;
__device__ __forceinline__ void fold_table(Frame& F, const float* gain, const float* mx, const float* mc, int osh, int osc) {
    LAS float* tab = (LAS float*)(F.lds + FOLD_TAB_OFF);
    for (int k = F.tid; k < 1024; k += NTHR) { const float g = gain[k]; tab[k] = g * (1.0f + mx[osc + k]); tab[1024 + k] = g * (1.0f + mc[osc + k]); tab[2048 + k] = mx[osh + k]; tab[3072 + k] = mc[osh + k]; }
    __syncthreads();
}
__device__ __forceinline__ void tr_item_fold(const float* W, int N, bf16* WTl, bf16* WTc, int k0, int n0, int drow0, float* bl, float* bc, LAS float* scr, const LAS float* tab, int lane) {
    { f32x4 w[8];
#pragma unroll
      for (int i = 0; i < 8; ++i) w[i] = __builtin_nontemporal_load((const GAS f32x4*)(W + (size_t)(k0 + (lane >> 3) + 8 * i) * N + n0 + 4 * (lane & 7)));
#pragma unroll
      for (int i = 0; i < 8; ++i) { LAS float* d = scr + ((lane >> 3) + 8 * i) * 33 + 4 * (lane & 7); d[0] = w[i].x; d[1] = w[i].y; d[2] = w[i].z; d[3] = w[i].w; } }
    LDS_WAIT(); asm volatile("" ::: "memory");
    const int c = lane & 7;
    const LAS float* t = tab + k0 + 8 * c;
    const f32x4 al0 = *(const LAS f32x4*)t, al1 = *(const LAS f32x4*)(t + 4), ac0 = *(const LAS f32x4*)(t + 1024), ac1 = *(const LAS f32x4*)(t + 1028);
    const f32x4 sl0 = *(const LAS f32x4*)(t + 2048), sl1 = *(const LAS f32x4*)(t + 2052), sc0 = *(const LAS f32x4*)(t + 3072), sc1 = *(const LAS f32x4*)(t + 3076);
#pragma unroll
    for (int j = 0; j < 4; ++j) { const int n = (lane >> 3) + 8 * j; const LAS float* s = scr + (8 * c) * 33 + n;
        const f32x4 x0 = (f32x4){s[0 * 33], s[1 * 33], s[2 * 33], s[3 * 33]}, x1 = (f32x4){s[4 * 33], s[5 * 33], s[6 * 33], s[7 * 33]};
        const f32x4 a0 = x0 * al0, a1 = x1 * al1, b0 = x0 * ac0, b1 = x1 * ac1;
        v4u o; o.x = pk2(a0.x, a0.y); o.y = pk2(a0.z, a0.w); o.z = pk2(a1.x, a1.y); o.w = pk2(a1.z, a1.w);
        __builtin_nontemporal_store(o, (GAS v4u*)(WTl + (size_t)(drow0 + n) * 1024 + k0 + 8 * c));
        o.x = pk2(b0.x, b0.y); o.y = pk2(b0.z, b0.w); o.z = pk2(b1.x, b1.y); o.w = pk2(b1.z, b1.w);
        __builtin_nontemporal_store(o, (GAS v4u*)(WTc + (size_t)(drow0 + n) * 1024 + k0 + 8 * c));
        const f32x4 pl4 = x0 * sl0 + x1 * sl1, pc4 = x0 * sc0 + x1 * sc1;
        float pl = (pl4.x + pl4.y) + (pl4.z + pl4.w), pc = (pc4.x + pc4.y) + (pc4.z + pc4.w);
        pl = dpp_add<0xB1>(pl); pl = dpp_add<0x4E>(pl); pl = dpp_add<0x141>(pl);
        pc = dpp_add<0xB1>(pc); pc = dpp_add<0x4E>(pc); pc = dpp_add<0x141>(pc);
        if (c == 0) { unsafeAtomicAdd(bl + n0 + n, pl); unsafeAtomicAdd(bc + n0 + n, pc); } }
    LDS_WAIT(); asm volatile("" ::: "memory");
}
__device__ __forceinline__ void tr_matrix_fold(const Frame& F, const float* W, int N, bf16* WTl, bf16* WTc, int mode, float* bl, float* bc, int& first, int gw, int NGW, int lo = 0, int hi = -1) {
    LAS float* scr = (LAS float*)(F.lds + F.wave * 16384); const LAS float* tab = (const LAS float*)(F.lds + FOLD_TAB_OFF);
    const int nblk = N / 32; if (hi < 0) hi = (D / 64) * nblk;
    int it = gw - (first % NGW); if (it < 0) it += NGW;
    for (it += lo; it < hi; it += NGW) {
        const int kb = it / nblk, nb = it % nblk, n0 = 32 * nb;
        const int drow0 = mode == 0 ? n0 : ((n0 >> 7) * 256 + (n0 & 127) + (mode == 2 ? 128 : 0));
        tr_item_fold(W, N, WTl, WTc, 64 * kb, n0, drow0, bl, bc, scr, tab, F.lane);
    }
    first += hi - lo;
}
__device__ __forceinline__ bool idle_last_round(const Frame& F, int nunits, int& gw, int& NGW) {
    const int nbusy = nunits % F.G;
    if (nbusy == 0) { gw = F.vcu * NWAVES + F.wave; NGW = F.G * NWAVES; return true; }
    if (F.vcu < nbusy) return false;
    gw = (F.vcu - nbusy) * NWAVES + F.wave; NGW = (F.G - nbusy) * NWAVES; return true;
}
__device__ __forceinline__ void ph_convert_ffn_gu(Frame& F, int which, int gw, int NGW) {
    fold_table(F, F.in[I_N2G], modp(F, 0, 0), modp(F, 0, 1), M_SH2, M_SC2);
    float* BA = (float*)(F.ws + WS_BIASA) + which * DFF;
    int first = 0;
    tr_matrix_fold(F, which ? F.in[I_FFNU] : F.in[I_FFNG], DFF, (bf16*)(F.ws + WS_WFFNGU), (bf16*)(F.ws + WS_WCTX), 1 + which, BA, BA + 2 * DFF, first, gw, NGW);
}
constexpr int SSDIN_ITEMS = (D / 64) * (SSD_IN_REAL / 32), SSDIN_SPLIT = 1200;
__device__ __forceinline__ void ph_convert_ffn(Frame& F, int gw, int NGW) {
    fold_table(F, F.in[I_N1G] + D, modp(F, 1, 0), modp(F, 1, 1), M_SH1, M_SC1);
    float* BB = (float*)(F.ws + WS_BIASB);
    int first = 0;
    tr_matrix(F, F.in[I_FFND], DFF, D, (bf16*)(F.ws + WS_WFFND), 0, first, gw, NGW);
    tr_matrix_fold(F, F.in[I_SSDWIN], SSD_IN_REAL, (bf16*)(F.ws + WS_WSSDIN), (bf16*)(F.ws + WS_WCTX2), 0, BB, BB + SSD_INP, first, gw, NGW, 0, SSDIN_SPLIT);
}
__device__ __forceinline__ void ph_convert_ssd(Frame& F, int gw, int NGW) {
    fold_table(F, F.in[I_N1G] + D, modp(F, 1, 0), modp(F, 1, 1), M_SH1, M_SC1);
    float* BB = (float*)(F.ws + WS_BIASB);
    int first = 0;
    tr_matrix_fold(F, F.in[I_SSDWIN], SSD_IN_REAL, (bf16*)(F.ws + WS_WSSDIN), (bf16*)(F.ws + WS_WCTX2), 0, BB, BB + SSD_INP, first, gw, NGW, SSDIN_SPLIT, SSDIN_ITEMS);
    tr_matrix(F, F.in[I_SSDWOUT], DIN, D, (bf16*)(F.ws + WS_WSSDOUT), 0, first, gw, NGW);
    for (int v = 0; v < 2; ++v) { v4u* p = (v4u*)((bf16*)(F.ws + (v ? WS_WCTX2 : WS_WSSDIN)) + (size_t)SSD_IN_REAL * D); const int n16 = (SSD_INP - SSD_IN_REAL) * D * 2 / 16;
      for (int i = gw * 64 + F.lane; i < n16; i += NGW * 64) p[i] = (v4u){0u, 0u, 0u, 0u}; }
}
__device__ __forceinline__ void adaln_units(Frame& F, int ulo, int uhi) {
    if (ulo + F.vcu >= uhi) return;
    LAS float* scx = (LAS float*)F.lds;
    LAS float* scc = scx + 1024;
    LAS float* red = scc + 1024;
    const float* c = F.in[I_C]; const float* cc = F.in[I_CCTX];
    for (int i = F.tid; i < 1024; i += NTHR) { const float a = c[i], b = cc[i]; scx[i] = a * sigmoid_f(a); scc[i] = b * sigmoid_f(b); }
    __syncthreads();
    float* MOD = (float*)(F.ws + WS_MOD);
    for (int u = ulo + F.vcu; u < uhi; u += F.G) {
        const int layer = u / 96, n0 = (u % 96) * 64;
        const float* W = F.in[I_ADAW] + (size_t)layer * 1024 * 6144 + n0 + F.lane;
        float ax = 0.f, ac = 0.f; const int kb = F.wave * 128;
#pragma unroll 1
        for (int k0 = 0; k0 < 128; k0 += 32) { float w[32];
#pragma unroll
            for (int k = 0; k < 32; ++k) w[k] = __builtin_nontemporal_load(W + (size_t)(kb + k0 + k) * 6144);
#pragma unroll
            for (int k = 0; k < 32; ++k) { ax += scx[kb + k0 + k] * w[k]; ac += scc[kb + k0 + k] * w[k]; } }
        red[(F.wave * 2 + 0) * 64 + F.lane] = ax; red[(F.wave * 2 + 1) * 64 + F.lane] = ac;
        __syncthreads();
        if (F.tid < 128) { const int s = F.tid >> 6, l = F.tid & 63; float t = 0.f;
#pragma unroll
            for (int w = 0; w < 8; ++w) t += red[(w * 2 + s) * 64 + l];
            MOD[(size_t)(layer * 2 + s) * 6144 + n0 + l] = t + F.in[I_ADAB][layer * 6144 + n0 + l]; }
        __syncthreads();
    }
}
constexpr int ADA_FIRST = 32;
__device__ __forceinline__ void ph_prologue(Frame& F) {
    const int nb = 0;
    adaln_units(F, 0, 192);
    __syncthreads();
    const int gw = (F.vcu - nb) * NWAVES + F.wave, NGW = (F.G - nb) * NWAVES;
    {
        float* ct = (float*)(F.ws + WS_ROPE); float* st = ct + 4096;
        for (int idx = (F.vcu - nb) * NTHR + F.tid; idx < 4096; idx += (F.G - nb) * NTHR) { const int pos = idx >> 4, i = idx & 15;
            const float inv = (float)pow(10000.0, -(double)i / 16.0); const float ang = (float)pos * inv;
            ct[idx] = (float)cos((double)ang); st[idx] = (float)sin((double)ang); }
    }
    { float* z = (float*)(F.ws + WS_SSQA); for (int i = (F.vcu - nb) * NTHR + F.tid; i < 96 * 1024; i += (F.G - nb) * NTHR) z[i] = 0.f; }
    int first = 0;
    tr_matrix(F, F.in[I_ABWIN], D, AB_IN, (bf16*)(F.ws + WS_WABIN), 0, first, gw, NGW);
    tr_matrix(F, F.in[I_ABWOUT], D, D, (bf16*)(F.ws + WS_WABOUT), 0, first, gw, NGW);
}
constexpr int MOE_GU_ITEMS = NEXP * 2 * (D / 64) * (FFE / 32);
struct GuItem { const float* W; bf16* WT; int k0, n0, drow0; };
__device__ __forceinline__ GuItem gu_item(const Frame& F, int it) {
    constexpr int PER_M = (D / 64) * (FFE / 32), NB = FFE / 32;
    const int e = it / (2 * PER_M), rem = it % (2 * PER_M), mat = rem / PER_M, idx = rem % PER_M, kb = idx / NB, n0 = 32 * (idx % NB);
    GuItem g; g.W = (mat ? F.in[I_MOEU] : F.in[I_MOEG]) + (size_t)e * D * FFE; g.WT = (bf16*)(F.ws + WS_WMOE) + (size_t)e * 2 * FFE * D;
    g.k0 = 64 * kb; g.n0 = n0; g.drow0 = (n0 >> 7) * 256 + (n0 & 127) + (mat ? 128 : 0); return g;
}
__device__ __forceinline__ void moe_gu_convert(Frame& F, int lo, int hi, int gw, int NGW) {
    LAS float* scr = (LAS float*)(F.lds + F.wave * 16384);
    int it = lo + gw; if (it >= hi) return;
    f32x4 wa[8], wb[8];
    GuItem ga = gu_item(F, it), gb = ga; tr_load(ga.W, FFE, ga.k0, ga.n0, F.lane, wa);
    for (;;) {
        const int itb = it + NGW; const bool hb = itb < hi;
        if (hb) { gb = gu_item(F, itb); tr_load(gb.W, FFE, gb.k0, gb.n0, F.lane, wb); }
        tr_finish(wa, ga.WT, D, ga.k0, ga.drow0, scr, F.lane);
        if (!hb) break;
        it = itb + NGW; const bool ha = it < hi;
        if (ha) { ga = gu_item(F, it); tr_load(ga.W, FFE, ga.k0, ga.n0, F.lane, wa); }
        tr_finish(wb, gb.WT, D, gb.k0, gb.drow0, scr, F.lane);
        if (!ha) break;
    }
}
constexpr int MOE_DN_ITEMS = NEXP * (FFE / 64) * (D / 32), MOE_DN_PER_E = (FFE / 64) * (D / 32);
__device__ __forceinline__ void moe_dn_convert(Frame& F, int lo, int hi, int gw, int NGW) {
    LAS float* scr = (LAS float*)(F.lds + F.wave * 16384);
    for (int it = lo + gw; it < hi; it += NGW) {
        const int e = it / MOE_DN_PER_E, idx = it % MOE_DN_PER_E, kb = idx / (D / 32), n0 = 32 * (idx % (D / 32));
        bf16* WT = (bf16*)(F.ws + (e < 4 ? WS_WDA : WS_WDB)) + (size_t)(e & 3) * D * FFE;
        tr_item(F.in[I_MOED] + (size_t)e * FFE * D, D, WT, FFE, 64 * kb, n0, n0, scr, F.lane);
    }
}
__device__ __forceinline__ void idle_round_convert(Frame& F, int nunits, int lo, int hi) {
    const int full = nunits / F.G, nbusy = nunits - full * F.G;
    if ((int)blockIdx.x >= nbusy) moe_gu_convert(F, lo, hi, ((int)blockIdx.x - nbusy) * NWAVES + F.wave, (F.G - nbusy) * NWAVES);
}


template <bool BF> __device__ __forceinline__ void load_row4(const void* row, int lane, f32x4 (&v)[4]) {
    if (BF) { const GAS v2u* p = (const GAS v2u*)row + lane;
#pragma unroll
        for (int j = 0; j < 4; ++j) { const v2u a = p[64 * j]; v[j] = (f32x4){bflo(a.x), bfhi(a.x), bflo(a.y), bfhi(a.y)}; } }
    else { const GAS f32x4* p = (const GAS f32x4*)row + lane;
#pragma unroll
        for (int j = 0; j < 4; ++j) v[j] = __builtin_nontemporal_load(p + 64 * j); }
}
template <bool LAT_BF, bool CTX_BF, int NPART>
__device__ __forceinline__ void ph_modulate(Frame& F, const void* src0, const void* src1, const float* gain, const float* mx, const float* mc, int osh, int osc, bf16* H, int nrows,
                                            const float* part, const float* gatec, bf16* xw) {
    const int gw = F.vcu * NWAVES + F.wave, NGW = F.G * NWAVES;
    f32x4 ca[4], cb[4];
#pragma unroll
    for (int j = 0; j < 4; ++j) { const int c = 4 * (64 * j + F.lane); ca[j] = *(const f32x4*)(gain + c) * (*(const f32x4*)(mx + osc + c) + 1.0f); cb[j] = *(const f32x4*)(mx + osh + c); }
    for (int r0 = gw; r0 < nrows; r0 += 2 * NGW) {
        int rr[2]; f32x4 v[2][4];
#pragma unroll
        for (int k = 0; k < 2; ++k) { const int r = r0 + k * NGW; rr[k] = r < nrows ? r : r0;
            if (rr[k] < L) load_row4<LAT_BF>((const char*)src0 + (size_t)rr[k] * D * (LAT_BF ? 2 : 4), F.lane, v[k]);
            else load_row4<CTX_BF>((const char*)src1 + (size_t)(rr[k] - L) * D * (CTX_BF ? 2 : 4), F.lane, v[k]); }
#pragma unroll
        for (int k = 0; k < 2; ++k) { const int r = rr[k];
            if (NPART > 0 && r >= L) {
#pragma unroll
                for (int j = 0; j < 4; ++j) { const int c = 4 * (64 * j + F.lane); f32x4 s = (f32x4){0.f, 0.f, 0.f, 0.f};
#pragma unroll
                    for (int q = 0; q < NPART; ++q) s += *(const f32x4*)(part + ((size_t)q * LC + (r - L)) * D + c);
                    v[k][j] += *(const f32x4*)(gatec + c) * s;
                    if (xw) { v2u o; o.x = pk2(v[k][j].x, v[k][j].y); o.y = pk2(v[k][j].z, v[k][j].w); *(GAS v2u*)(xw + (size_t)r * D + c) = o; } }
            }
            float s2 = 0.f;
#pragma unroll
            for (int j = 0; j < 4; ++j) s2 += (v[k][j].x * v[k][j].x + v[k][j].y * v[k][j].y) + (v[k][j].z * v[k][j].z + v[k][j].w * v[k][j].w);
            const float rstd = __builtin_amdgcn_rsqf(wave_sum(s2) * (1.0f / D) + EPS);
            GAS v2u* o8 = (GAS v2u*)(H + (size_t)r * D) + F.lane;
#pragma unroll
            for (int j = 0; j < 4; ++j) { const int c = 4 * (64 * j + F.lane);
                f32x4 A = ca[j], B = cb[j];
                if (r >= L) { A = *(const f32x4*)(gain + c) * (*(const f32x4*)(mc + osc + c) + 1.0f); B = *(const f32x4*)(mc + osh + c); }
                const f32x4 y = v[k][j] * rstd * A + B;
                v2u o; o.x = pk2(y.x, y.y); o.y = pk2(y.z, y.w); o8[64 * j] = o; }
        }
    }
}
__device__ __forceinline__ void ctx_publish(Frame& F, int nu, int cw) {
    const int c = (int)blockIdx.x, nP = nu < F.G ? nu : F.G;
    if (c >= nP) return;
    unsigned* ctl = (unsigned*)(F.ws + WS_CTL);
    VM_WAIT(); __syncthreads();
    if (F.tid == 0) {
        unsigned mine = 0; for (int x = c; x < nu; x += F.G) ++mine;
        __builtin_amdgcn_fence(__ATOMIC_RELEASE, "agent"); VM_WAIT();
        (void)xb_add(&ctl[cw], mine);
    }
}
__device__ __forceinline__ int ctx_reducers_first(const Frame& F, int nu) { return F.G >= nu + 64 ? nu : 0; }
__device__ __forceinline__ int ctx_reducers_count(const Frame& F, int nu) { return F.G >= nu + 64 ? 32 : (nu < F.G ? nu : F.G); }
template <bool BASE_BF, int NPART>
__device__ __forceinline__ void ctx_reduce(Frame& F, int nu, int cw, const void* base, const float* gatec, bf16* X, float* ssq) {
    const int first = ctx_reducers_first(F, nu), nR = ctx_reducers_count(F, nu), c = (int)blockIdx.x - first;
    if (c < 0 || c >= nR) return;
    unsigned* ctl = (unsigned*)(F.ws + WS_CTL); const float* part = (const float*)(F.ws + WS_PART);
    VM_WAIT(); __syncthreads();
    if (F.tid == 0) {
        __builtin_amdgcn_fence(__ATOMIC_ACQUIRE, "agent");
        XB_SPIN(xb_ld(&ctl[cw]) < (unsigned)nu, ctl + CW_BAR);
        VM_WAIT();
    }
    __syncthreads();
    for (int r = c * NWAVES + F.wave; r < LC; r += nR * NWAVES) {
        f32x4 v[4]; load_row4<BASE_BF>((const char*)base + (size_t)r * D * (BASE_BF ? 2 : 4), F.lane, v);
        float s2 = 0.f;
#pragma unroll
        for (int j = 0; j < 4; ++j) { const int cc = 4 * (64 * j + F.lane); f32x4 s = (f32x4){0.f, 0.f, 0.f, 0.f};
#pragma unroll
            for (int q = 0; q < NPART; ++q) s += *(const f32x4*)(part + ((size_t)q * LC + r) * D + cc);
            v[j] += *(const f32x4*)(gatec + cc) * s;
            s2 += (v[j].x * v[j].x + v[j].y * v[j].y) + (v[j].z * v[j].z + v[j].w * v[j].w);
            v2u o; o.x = pk2(v[j].x, v[j].y); o.y = pk2(v[j].z, v[j].w); *(GAS v2u*)(X + (size_t)(L + r) * D + cc) = o; }
        s2 = wave_sum(s2);
        if (F.lane == 0) ssq[L + r] = s2;
    }
}

constexpr float QSCL = 0.125f * 1.4426950408889634f;
__device__ __forceinline__ void ph_ab_elem(Frame& F) {
    const bf16* PAB = (const bf16*)(F.ws + WS_PAB); bf16* MIX = (bf16*)(F.ws + WS_MIX);
    bf16* QR = (bf16*)(F.ws + WS_QR); bf16* KR = (bf16*)(F.ws + WS_KR); bf16* VT = (bf16*)(F.ws + WS_VT);
    const float* ct = (const float*)(F.ws + WS_ROPE); const float* st = ct + 4096;
    const int lane = F.lane;
    float cw[3][8];
#pragma unroll
    for (int k = 0; k < 3; ++k)
#pragma unroll
        for (int j = 0; j < 8; ++j) cw[k][j] = F.in[I_ABCONV][k * 512 + 8 * lane + j];
    LAS unsigned char* vl = F.lds;
    for (int tile = F.vcu; tile < MT / 16; tile += F.G) {
        const int r0 = tile * 16; const bool isctx = r0 >= L; const int slo = isctx ? L : 0, shi = isctx ? MT : L;
        for (int rr = 0; rr < 2; ++rr) {
            const int r = r0 + F.wave * 2 + rr;
            float acc[8];
#pragma unroll
            for (int j = 0; j < 8; ++j) acc[j] = 0.f;
#pragma unroll
            for (int k = 0; k < 3; ++k) { const int q = r + k - 1;
                if (q >= slo && q < shi) { const v4u gc = *(const GAS v4u*)(PAB + (size_t)q * AB_IN + 512 + 8 * lane), ha = *(const GAS v4u*)(PAB + (size_t)q * AB_IN + 1024 + 8 * lane);
                    acc[0] += cw[k][0] * bflo(gc.x) * bflo(ha.x); acc[1] += cw[k][1] * bfhi(gc.x) * bfhi(ha.x); acc[2] += cw[k][2] * bflo(gc.y) * bflo(ha.y); acc[3] += cw[k][3] * bfhi(gc.y) * bfhi(ha.y);
                    acc[4] += cw[k][4] * bflo(gc.z) * bflo(ha.z); acc[5] += cw[k][5] * bfhi(gc.z) * bfhi(ha.z); acc[6] += cw[k][6] * bflo(gc.w) * bflo(ha.w); acc[7] += cw[k][7] * bfhi(gc.w) * bfhi(ha.w); } }
            { const v4u gb = *(const GAS v4u*)(PAB + (size_t)r * AB_IN + 8 * lane); v4u o;
              o.x = pk2(acc[0] * bflo(gb.x), acc[1] * bfhi(gb.x)); o.y = pk2(acc[2] * bflo(gb.y), acc[3] * bfhi(gb.y)); o.z = pk2(acc[4] * bflo(gb.z), acc[5] * bfhi(gb.z)); o.w = pk2(acc[6] * bflo(gb.w), acc[7] * bfhi(gb.w));
              *(GAS v4u*)(MIX + (size_t)r * D + 8 * lane) = o; }
            const int sub = lane & 7, axis = sub >> 2, half = (sub >> 1) & 1;
            const int pos = axis == 0 ? (r >> 6) : (r & 63);
            f32x4 c0 = (f32x4){1.f, 1.f, 1.f, 1.f}, c1 = c0, s0 = (f32x4){0.f, 0.f, 0.f, 0.f}, s1 = s0;
            if (!isctx) { const float* cp = ct + pos * 16 + 8 * (lane & 1); const float* sp = st + pos * 16 + 8 * (lane & 1);
                c0 = *(const f32x4*)cp; c1 = *(const f32x4*)(cp + 4); s0 = *(const f32x4*)sp; s1 = *(const f32x4*)(sp + 4);
                if (half == 0) { s0 = -s0; s1 = -s1; } }
            {
                const v4u a = *(const GAS v4u*)(PAB + (size_t)r * AB_IN + 1536 + 8 * lane);
                v4u p; p.x = (unsigned)__builtin_amdgcn_update_dpp(0, (int)a.x, 0x4E, 0xf, 0xf, true); p.y = (unsigned)__builtin_amdgcn_update_dpp(0, (int)a.y, 0x4E, 0xf, 0xf, true); p.z = (unsigned)__builtin_amdgcn_update_dpp(0, (int)a.z, 0x4E, 0xf, 0xf, true); p.w = (unsigned)__builtin_amdgcn_update_dpp(0, (int)a.w, 0x4E, 0xf, 0xf, true);
                const f32x4 qc0 = c0 * QSCL, qc1 = c1 * QSCL, qs0 = s0 * QSCL, qs1 = s1 * QSCL;
                v4u o; o.x = pk2(bflo(a.x) * qc0.x + bflo(p.x) * qs0.x, bfhi(a.x) * qc0.y + bfhi(p.x) * qs0.y); o.y = pk2(bflo(a.y) * qc0.z + bflo(p.y) * qs0.z, bfhi(a.y) * qc0.w + bfhi(p.y) * qs0.w);
                o.z = pk2(bflo(a.z) * qc1.x + bflo(p.z) * qs1.x, bfhi(a.z) * qc1.y + bfhi(p.z) * qs1.y); o.w = pk2(bflo(a.w) * qc1.z + bflo(p.w) * qs1.z, bfhi(a.w) * qc1.w + bfhi(p.w) * qs1.w);
                *(GAS v4u*)(QR + ((size_t)(lane >> 3) * MT + r) * 64 + 8 * sub) = o;
            }
            {
                const int kl = lane & 15;
                const v4u a = *(const GAS v4u*)(PAB + (size_t)r * AB_IN + 2048 + 8 * kl);
                v4u p; p.x = (unsigned)__builtin_amdgcn_update_dpp(0, (int)a.x, 0x4E, 0xf, 0xf, true); p.y = (unsigned)__builtin_amdgcn_update_dpp(0, (int)a.y, 0x4E, 0xf, 0xf, true); p.z = (unsigned)__builtin_amdgcn_update_dpp(0, (int)a.z, 0x4E, 0xf, 0xf, true); p.w = (unsigned)__builtin_amdgcn_update_dpp(0, (int)a.w, 0x4E, 0xf, 0xf, true);
                v4u o; o.x = pk2(bflo(a.x) * c0.x + bflo(p.x) * s0.x, bfhi(a.x) * c0.y + bfhi(p.x) * s0.y); o.y = pk2(bflo(a.y) * c0.z + bflo(p.y) * s0.z, bfhi(a.y) * c0.w + bfhi(p.y) * s0.w);
                o.z = pk2(bflo(a.z) * c1.x + bflo(p.z) * s1.x, bfhi(a.z) * c1.y + bfhi(p.z) * s1.y); o.w = pk2(bflo(a.w) * c1.z + bflo(p.w) * s1.z, bfhi(a.w) * c1.w + bfhi(p.w) * s1.w);
                if (lane < 16) *(GAS v4u*)(KR + ((size_t)(lane >> 3) * MT + r) * 64 + 8 * sub) = o;
            }
        }
        if (F.tid < 256) { const int p = F.tid, row = p >> 4, c8 = (p & 15) * 8;
            *(LAS v4u*)(vl + row * 272 + c8 * 2) = *(const GAS v4u*)(PAB + (size_t)(r0 + row) * AB_IN + 2176 + c8); }
        __syncthreads();
        if (F.tid < 256) { const int p = F.tid, ch = p >> 1, rg = p & 1;
            const LAS bf16* s = (const LAS bf16*)(vl + (8 * rg) * 272 + ch * 2);
            v4u o; o.x = (unsigned)s[0] | ((unsigned)s[136] << 16); o.y = (unsigned)s[2 * 136] | ((unsigned)s[3 * 136] << 16); o.z = (unsigned)s[4 * 136] | ((unsigned)s[5 * 136] << 16); o.w = (unsigned)s[6 * 136] | ((unsigned)s[7 * 136] << 16);
            *(GAS v4u*)(VT + (size_t)ch * MT + r0 + 8 * rg) = o; }
        __syncthreads();
    }
}


__device__ __forceinline__ void ssd_dt_pass(Frame& F, int gw, int NGW) {
    const float* DR = (const float*)(F.ws + WS_DTRAW); float* DTF = (float*)(F.ws + WS_DTS); float* DTB = DTF + (size_t)32 * MT; float* CUMF = DTB + (size_t)32 * MT; float* CUMB = CUMF + (size_t)32 * MT;
    float* WF = (float*)(F.ws + WS_WF); float* WB = WF + (size_t)32 * MT; float* DEC = (float*)(F.ws + WS_DEC);
    const int lane = F.lane;
    for (int task = gw; task < NCH * 8; task += NGW) { const int c = task >> 3, jq = task & 7; const bool fwd = jq < 4;
        float v[2][8];
#pragma unroll
        for (int hb = 0; hb < 2; ++hb) { const float* row = DR + (size_t)(c * 128 + hb * 64 + lane) * 64 + 8 * jq;
#pragma unroll
            for (int q4 = 0; q4 < 2; ++q4) { const f32x4 r = *(const f32x4*)(row + 4 * q4);
#pragma unroll
                for (int q = 0; q < 4; ++q) { const int jj = 4 * q4 + q, j = 8 * jq + jj; v[hb][jj] = softplus_f(r[q] + (fwd ? F.in[I_DTBF][j] : F.in[I_DTBB][j - 32])); } } }
        float* DT = fwd ? DTF : DTB; float* CU = fwd ? CUMF : CUMB; float* WW = fwd ? WF : WB;
#pragma unroll
        for (int jj = 0; jj < 8; ++jj) { const int h = (8 * jq + jj) & 31; const float A = -__expf(fwd ? F.in[I_ALOGF][h] : F.in[I_ALOGB][h]);
            const float a0 = v[0][jj] * A, a1 = v[1][jj] * A;
            float p0 = a0, p1 = a1;
            p0 = dpp_add<0x111>(p0); p1 = dpp_add<0x111>(p1); p0 = dpp_add<0x112>(p0); p1 = dpp_add<0x112>(p1);
            p0 = dpp_add<0x114>(p0); p1 = dpp_add<0x114>(p1); p0 = dpp_add<0x118>(p0); p1 = dpp_add<0x118>(p1);
            const int i0 = __float_as_int(p0), i1 = __float_as_int(p1);
            const float s00 = __int_as_float(__builtin_amdgcn_readlane(i0, 15)), s01 = __int_as_float(__builtin_amdgcn_readlane(i0, 31)), s02 = __int_as_float(__builtin_amdgcn_readlane(i0, 47)), s03 = __int_as_float(__builtin_amdgcn_readlane(i0, 63));
            const float s10 = __int_as_float(__builtin_amdgcn_readlane(i1, 15)), s11 = __int_as_float(__builtin_amdgcn_readlane(i1, 31)), s12 = __int_as_float(__builtin_amdgcn_readlane(i1, 47)), s13 = __int_as_float(__builtin_amdgcn_readlane(i1, 63));
            const float T0 = (s00 + s01) + (s02 + s03);
            p0 += lane < 16 ? 0.f : lane < 32 ? s00 : lane < 48 ? s00 + s01 : (s00 + s01) + s02;
            p1 += T0 + (lane < 16 ? 0.f : lane < 32 ? s10 : lane < 48 ? s10 + s11 : (s10 + s11) + s12);
            const float T = T0 + ((s10 + s11) + (s12 + s13));
            const float c0 = fwd ? p0 : T - p0 + a0, c1 = fwd ? p1 : T - p1 + a1;
            const size_t o = (size_t)h * MT + c * 128 + lane;
            DT[o] = v[0][jj]; DT[o + 64] = v[1][jj]; CU[o] = c0; CU[o + 64] = c1;
            WW[o] = __expf(T - c0) * v[0][jj]; WW[o + 64] = __expf(T - c1) * v[1][jj];
            if (lane == 0) DEC[((fwd ? 0 : 1) * NCH + c) * 32 + h] = __expf(T); } }
}
__device__ __forceinline__ void ph_ssd_conv(Frame& F) {
    const bf16* XB = (const bf16*)(F.ws + WS_XBCR);
    bf16* XT = (bf16*)(F.ws + WS_XT); bf16* BT = (bf16*)(F.ws + WS_BT); bf16* BMm = (bf16*)(F.ws + WS_BM); bf16* CMm = (bf16*)(F.ws + WS_CM);
    const float* cwp = F.in[I_SSDCW]; const float* cbp = F.in[I_SSDCB];
    LAS unsigned char* tl = F.lds;
    const int ntiles = NCH * 24;
    v4u preA[5], preB[5];
#define CONV_LOAD(pre, tile_) do { const int c_ = (tile_) / 24, cb_ = (tile_) % 24, t0_ = c_ * 128, ch0_ = cb_ * 128; const int slo_ = c_ < 128 ? 0 : L, shi_ = c_ < 128 ? L : MT; \
        _Pragma("unroll") for (int i_ = 0; i_ < 5; ++i_) { const int p_ = F.tid + NTHR * i_, row_ = p_ >> 4, c8_ = (p_ & 15) * 8; const int t_ = t0_ - 1 + row_; \
            pre[i_] = (v4u){0u, 0u, 0u, 0u}; if (p_ < 130 * 16 && t_ >= slo_ && t_ < shi_) pre[i_] = __builtin_nontemporal_load((const GAS v4u*)(XB + (size_t)t_ * XBCW + ch0_ + c8_)); } } while (0)
    if (F.vcu < ntiles) CONV_LOAD(preA, F.vcu);
    if (F.vcu + F.G < ntiles) CONV_LOAD(preB, F.vcu + F.G);
    LAS float* cwl = (LAS float*)(F.lds + 130 * 272 + 64);
    for (int i = F.tid; i < 3 * XBCW; i += NTHR) cwl[i] = cwp[i];
    for (int i = F.tid; i < XBCW; i += NTHR) cwl[3 * XBCW + i] = cbp[i];
    __syncthreads();
    auto conv_tile = [&](int tile, v4u (&pre)[5]) {
        const int c = tile / 24, cb = tile % 24, t0 = c * 128, ch0 = cb * 128;
#pragma unroll
        for (int i = 0; i < 5; ++i) { const int p = F.tid + NTHR * i, row = p >> 4, c8 = (p & 15) * 8; if (p < 130 * 16) *(LAS v4u*)(tl + row * 272 + ((c8 * 2) ^ (((row >> 3) & 7) << 4))) = pre[i]; }
        __syncthreads();
        if (tile + 2 * F.G < ntiles) CONV_LOAD(pre, tile + 2 * F.G);
        if (cb < 20) {
            bf16* dst = BT + (size_t)(ch0 - 2048) * MT;
#pragma unroll
            for (int i = 0; i < 4; ++i) { const int p = F.tid + NTHR * i, ch = p >> 4, tg = p & 15;
                const float w0 = cwl[ch0 + ch], w1 = cwl[XBCW + ch0 + ch], w2 = cwl[2 * XBCW + ch0 + ch], bb = cwl[3 * XBCW + ch0 + ch];
                float xin[10];
#pragma unroll
                for (int j = 0; j < 10; ++j) { const int row = 8 * tg + j; xin[j] = bf1(*(const LAS bf16*)(tl + row * 272 + ((ch * 2) ^ (((row >> 3) & 7) << 4)))); }
                float y[8];
#pragma unroll
                for (int j = 0; j < 8; ++j) { const float a = w0 * xin[j] + w1 * xin[j + 1] + w2 * xin[j + 2] + bb; y[j] = a * sigmoid_f(a); }
                v4u o; o.x = pk2(y[0], y[1]); o.y = pk2(y[2], y[3]); o.z = pk2(y[4], y[5]); o.w = pk2(y[6], y[7]);
                if (cb < 16) { const int cg_ = ch0 + ch, hd = cg_ >> 6, p_ = cg_ & 63, ptq = 2 * (p_ >> 5) + ((p_ >> 2) & 1), rq = 4 * ((p_ >> 3) & 3) + (p_ & 3);
                    *(GAS v4u*)(XT + ((size_t)(((hd * NCH + c) * 4 + (tg >> 2)) * 4 + ptq) * 16 + rq) * 32 + 8 * (tg & 3)) = o; }
                else *(GAS v4u*)(dst + (size_t)ch * MT + t0 + 8 * tg) = o; }
        }
        if (cb >= 16) {
            bf16* dst = cb < 20 ? BMm + (ch0 - 2048) : CMm + (ch0 - 2560);
#pragma unroll
            for (int i = 0; i < 4; ++i) { const int p = F.tid + NTHR * i, row = p >> 4, cg = p & 15;
                const v4u a0 = *(const LAS v4u*)(tl + row * 272 + ((cg * 16) ^ (((row >> 3) & 7) << 4))), a1 = *(const LAS v4u*)(tl + (row + 1) * 272 + ((cg * 16) ^ ((((row + 1) >> 3) & 7) << 4))), a2 = *(const LAS v4u*)(tl + (row + 2) * 272 + ((cg * 16) ^ ((((row + 2) >> 3) & 7) << 4)));
                const LAS float* w0 = cwl + ch0 + 8 * cg; const LAS float* w1 = w0 + XBCW; const LAS float* w2 = w1 + XBCW; const LAS float* bb = w2 + XBCW;
                float y[8];
#define CV(j, f, q) { const float a = w0[j] * f(a0.q) + w1[j] * f(a1.q) + w2[j] * f(a2.q) + bb[j]; y[j] = a * sigmoid_f(a); }
                CV(0, bflo, x) CV(1, bfhi, x) CV(2, bflo, y) CV(3, bfhi, y) CV(4, bflo, z) CV(5, bfhi, z) CV(6, bflo, w) CV(7, bfhi, w)
#undef CV
                v4u o; o.x = pk2(y[0], y[1]); o.y = pk2(y[2], y[3]); o.z = pk2(y[4], y[5]); o.w = pk2(y[6], y[7]);
                *(GAS v4u*)(dst + (size_t)(t0 + row) * 512 + 8 * cg) = o; }
        }
        __syncthreads();
    };
    { int tile = F.vcu;
      for (;;) { if (tile >= ntiles) break; conv_tile(tile, preA); tile += F.G; if (tile >= ntiles) break; conv_tile(tile, preB); tile += F.G; } }
#undef CONV_LOAD
    { int gw_, ngw_; __syncthreads();
      if (idle_last_round(F, ntiles, gw_, ngw_)) { ssd_dt_pass(F, gw_, ngw_); moe_dn_convert(F, 0, 1900, gw_, ngw_); } }
}

__device__ __forceinline__ void ph_moe_route(Frame& F) {
    LAS float* R = (LAS float*)F.lds;
    for (int i = F.tid; i < 8192; i += NTHR) R[(i & 7) * 1024 + (i >> 3)] = F.in[I_ROUTER][i];
    __syncthreads();
    const bf16* X = (const bf16*)(F.ws + WS_X); float* RS = (float*)(F.ws + WS_RSTD);
    int* TE = (int*)(F.ws + WS_TOKE); float* TW = (float*)(F.ws + WS_TOKW); int* HIST = (int*)(F.ws + WS_CTL) + CW_HIST;
    const float* gain = F.in[I_N2G] + D; const float* m = modp(F, 1, 0);
    const int gw = F.vcu * NWAVES + F.wave, NGW = F.G * NWAVES;
    f32x4 ca[4], cb[4];
#pragma unroll
    for (int j = 0; j < 4; ++j) { const int c = 4 * (64 * j + F.lane); ca[j] = *(const f32x4*)(gain + c) * (*(const f32x4*)(m + M_SC2 + c) + 1.0f); cb[j] = *(const f32x4*)(m + M_SH2 + c); }
    for (int r = gw; r < L; r += NGW) {
        f32x4 v[4]; float s2 = 0.f;
        load_row4<true>(X + (size_t)r * D, F.lane, v);
#pragma unroll
        for (int j = 0; j < 4; ++j) s2 += (v[j].x * v[j].x + v[j].y * v[j].y) + (v[j].z * v[j].z + v[j].w * v[j].w);
        const float rstd = 1.0f / sqrtf(wave_sum(s2) * (1.0f / D) + EPS);
        float lg[8];
#pragma unroll
        for (int e = 0; e < 8; ++e) lg[e] = 0.f;
#pragma unroll
        for (int j = 0; j < 4; ++j) { const int c = 4 * (64 * j + F.lane);
            const f32x4 y = v[j] * rstd * ca[j] + cb[j];
#pragma unroll
            for (int e = 0; e < 8; ++e) { const f32x4 rr = *(const LAS f32x4*)(R + e * 1024 + c); lg[e] += (y.x * rr.x + y.y * rr.y) + (y.z * rr.z + y.w * rr.w); } }
#pragma unroll
        for (int e = 0; e < 8; ++e) lg[e] = wave_sum(lg[e]);
        int e0 = 0; float v0 = lg[0];
#pragma unroll
        for (int e = 1; e < 8; ++e) if (lg[e] > v0) { v0 = lg[e]; e0 = e; }
        int e1 = -1; float v1 = -3.0e38f;
#pragma unroll
        for (int e = 0; e < 8; ++e) if (e != e0 && lg[e] > v1) { v1 = lg[e]; e1 = e; }
        if (F.lane == 0) { const float ex = __expf(v1 - v0), w0 = 1.0f / (1.0f + ex); RS[r] = rstd;
            TE[2 * r] = e0; TE[2 * r + 1] = e1; TW[2 * r] = w0; TW[2 * r + 1] = ex * w0;
            atomicAdd(&HIST[(r >> 8) * 8 + e0], 1); atomicAdd(&HIST[(r >> 8) * 8 + e1], 1); }
    }
}
__device__ __forceinline__ void moe_segments(Frame& F, LAS int* hist, LAS int* cnt, LAS int* seg) {
    const int* HIST = (const int*)(F.ws + WS_CTL) + CW_HIST;
    if (F.tid < 512) hist[F.tid] = HIST[F.tid];
    __syncthreads();
    { const float v = wave_sum((float)hist[F.lane * 8 + F.wave]); if (F.lane == 0) cnt[F.wave] = (int)v; }
    __syncthreads();
    if (F.tid == 0) { int s = 0; for (int e = 0; e < 8; ++e) { seg[e] = s; s += (cnt[e] + 255) & ~255; } seg[8] = s; }
    __syncthreads();
}
__device__ __forceinline__ void ph_moe_scatter(Frame& F) {
    LAS int* hist = (LAS int*)F.lds; LAS int* cnt = hist + 512; LAS int* seg = cnt + 8; LAS int* base = seg + 16; LAS int* wcnt = base + 8; LAS int* epos = wcnt + 64;
    moe_segments(F, hist, cnt, seg);
    const int* TE = (const int*)(F.ws + WS_TOKE); int* TP = (int*)(F.ws + WS_TOKP);
    const bf16* X = (const bf16*)(F.ws + WS_X); const float* RS = (const float*)(F.ws + WS_RSTD); bf16* H2S = (bf16*)(F.ws + WS_H2S);
    f32x4 ca[4], cb[4];
    { const float* gain = F.in[I_N2G] + D; const float* m = modp(F, 1, 0);
#pragma unroll
      for (int j = 0; j < 4; ++j) { const int c = 4 * (64 * j + F.lane); ca[j] = *(const f32x4*)(gain + c) * (*(const f32x4*)(m + M_SC2 + c) + 1.0f); cb[j] = *(const f32x4*)(m + M_SH2 + c); } }
    for (int uu = F.vcu; uu < 264; uu += F.G) {
        if (uu < 256) {
            const int u = uu >> 2, qtr = uu & 3;
            if (F.tid < 8) { int s = seg[F.tid]; for (int t = 0; t < u; ++t) s += hist[t * 8 + F.tid]; base[F.tid] = s; }
            const int ent = u * 512 + F.tid;
            const int ex = TE[ent];
            int rank = 0;
#pragma unroll
            for (int e = 0; e < 8; ++e) { const unsigned long long mk = __ballot(ex == e);
                if (ex == e) rank = __popcll(mk & ((1ull << F.lane) - 1ull));
                if (F.lane == 0) wcnt[F.wave * 8 + e] = __popcll(mk); }
            __syncthreads();
            int pos = base[ex] + rank;
            for (int w = 0; w < F.wave; ++w) pos += wcnt[w * 8 + ex];
            if (qtr == 0) TP[ent] = pos;
            epos[F.tid] = pos;
            __syncthreads();
            for (int t0_ = 64 * qtr + F.wave; t0_ < 64 * qtr + 64; t0_ += 2 * NWAVES) {
                f32x4 xv[2][4]; float rs[2]; int d0[2], d1[2];
#pragma unroll
                for (int k = 0; k < 2; ++k) { const int ti = t0_ + k * NWAVES, tok = u * 256 + ti; load_row4<true>(X + (size_t)tok * D, F.lane, xv[k]); rs[k] = RS[tok]; d0[k] = epos[2 * ti]; d1[k] = epos[2 * ti + 1]; }
#pragma unroll
                for (int k = 0; k < 2; ++k) { GAS v2u* o0 = (GAS v2u*)(H2S + (size_t)d0[k] * D) + F.lane; GAS v2u* o1 = (GAS v2u*)(H2S + (size_t)d1[k] * D) + F.lane;
#pragma unroll
                    for (int j = 0; j < 4; ++j) { const f32x4 y = xv[k][j] * rs[k] * ca[j] + cb[j]; v2u o; o.x = pk2(y.x, y.y); o.y = pk2(y.z, y.w); o0[64 * j] = o; o1[64 * j] = o; } } }
            __syncthreads();
        } else {
            const int e = uu - 256, lo = seg[e] + cnt[e], hi = seg[e + 1];
            GAS v4u* d = (GAS v4u*)(H2S + (size_t)lo * D); const int n16 = (hi - lo) * (D * 2 / 16);
            for (int i = F.tid; i < n16; i += NTHR) d[i] = (v4u){0u, 0u, 0u, 0u};
        }
    }
}
__device__ __forceinline__ f32x4 ld4_sc1(const void* p) { f32x4 v; asm volatile("global_load_dwordx4 %0, %1, off sc1\n\ts_waitcnt vmcnt(0)" : "=v"(v) : "v"(p) : "memory"); return v; }
__device__ __forceinline__ int ph_moe_route_scatter(Frame& F) {
    LAS float* R = (LAS float*)F.lds;
    LAS int* cntg = (LAS int*)(F.lds + 32768);
    LAS int* tel = cntg + 2048;
    LAS int* epos = tel + 128;
    LAS int* wcnt = epos + 128;
    LAS int* tot = wcnt + 16;
    LAS int* bef = tot + 8; LAS int* seg = bef + 8; LAS int* base = seg + 16;
    for (int i = F.tid; i < 8192; i += NTHR) R[(i & 7) * 1024 + (i >> 3)] = F.in[I_ROUTER][i];
    const bf16* X = (const bf16*)(F.ws + WS_X); bf16* H2S = (bf16*)(F.ws + WS_H2S);
    float* TW = (float*)(F.ws + WS_TOKW); int* TP = (int*)(F.ws + WS_TOKP);
    unsigned* ctl = (unsigned*)(F.ws + WS_CTL); int* HIST = (int*)ctl + CW_HIST; int* CNT = (int*)ctl + CW_CNT;
    const float* gain = F.in[I_N2G] + D; const float* m = modp(F, 1, 0);
    const int lane = F.lane;
    f32x4 ca[4], cb[4];
#pragma unroll
    for (int j = 0; j < 4; ++j) { const int c = 4 * (64 * j + lane); ca[j] = *(const f32x4*)(gain + c) * (*(const f32x4*)(m + M_SC2 + c) + 1.0f); cb[j] = *(const f32x4*)(m + M_SH2 + c); }
    const bool active = F.vcu < 256; const int u = F.vcu >> 2, qtr = F.vcu & 3; const int tok0 = 256 * u + 64 * qtr;
    v2u raw[8][4]; float rsd[8];
    if (active) {
#pragma unroll
        for (int k = 0; k < 8; ++k) { const GAS v2u* p = (const GAS v2u*)(X + (size_t)(tok0 + 8 * F.wave + k) * D) + lane;
#pragma unroll
            for (int j = 0; j < 4; ++j) raw[k][j] = p[64 * j]; }
    }
    __syncthreads();
    if (active) {
#pragma unroll
        for (int k = 0; k < 8; ++k) { const int tl = 8 * F.wave + k;
            f32x4 v[4]; float s2 = 0.f;
#pragma unroll
            for (int j = 0; j < 4; ++j) { v[j] = (f32x4){bflo(raw[k][j].x), bfhi(raw[k][j].x), bflo(raw[k][j].y), bfhi(raw[k][j].y)}; s2 += (v[j].x * v[j].x + v[j].y * v[j].y) + (v[j].z * v[j].z + v[j].w * v[j].w); }
            const float rstd = 1.0f / sqrtf(wave_sum(s2) * (1.0f / D) + EPS); rsd[k] = rstd;
            float lg[8];
#pragma unroll
            for (int e = 0; e < 8; ++e) lg[e] = 0.f;
#pragma unroll
            for (int j = 0; j < 4; ++j) { const int c = 4 * (64 * j + lane);
                const f32x4 y = v[j] * rstd * ca[j] + cb[j];
#pragma unroll
                for (int e = 0; e < 8; ++e) { const f32x4 rr = *(const LAS f32x4*)(R + e * 1024 + c); lg[e] += (y.x * rr.x + y.y * rr.y) + (y.z * rr.z + y.w * rr.w); } }
#pragma unroll
            for (int e = 0; e < 8; ++e) lg[e] = wave_sum(lg[e]);
            int e0 = 0; float v0 = lg[0];
#pragma unroll
            for (int e = 1; e < 8; ++e) if (lg[e] > v0) { v0 = lg[e]; e0 = e; }
            int e1 = -1; float v1 = -3.0e38f;
#pragma unroll
            for (int e = 0; e < 8; ++e) if (e != e0 && lg[e] > v1) { v1 = lg[e]; e1 = e; }
            if (lane == 0) { const float ex = __expf(v1 - v0), w0 = 1.0f / (1.0f + ex);
                tel[2 * tl] = e0; tel[2 * tl + 1] = e1; TW[2 * (tok0 + tl)] = w0; TW[2 * (tok0 + tl) + 1] = ex * w0; }
        }
    }
    __syncthreads();
    int ex = 0, rank = 0;
    if (active && F.tid < 128) { ex = tel[F.tid];
#pragma unroll
        for (int e = 0; e < 8; ++e) { const unsigned long long mk = __ballot(ex == e);
            if (ex == e) rank = __popcll(mk & ((1ull << lane) - 1ull));
            if (lane == 0) wcnt[F.wave * 8 + e] = __popcll(mk); } }
    __syncthreads();
    if (active && F.tid < 8) { const int cnt = wcnt[F.tid] + wcnt[8 + F.tid];
        __hip_atomic_store(&CNT[F.vcu * 8 + F.tid], cnt, __ATOMIC_RELAXED, __HIP_MEMORY_SCOPE_AGENT); atomicAdd(&HIST[u * 8 + F.tid], cnt); }
    VM_WAIT(); __syncthreads();
    if (F.tid == 0) { (void)xb_add(&ctl[CW_SOFT1], 1u); XB_SPIN(xb_ld(&ctl[CW_SOFT1]) < (unsigned)F.G, ctl + CW_BAR); }
    __syncthreads();
    { const f32x4 c4 = ld4_sc1(CNT + F.tid * 4); *(LAS f32x4*)(cntg + F.tid * 4) = c4; }
    __syncthreads();
    {
        const int e = F.wave; int t = 0, b = 0;
#pragma unroll
        for (int i = 0; i < 4; ++i) { const int wg = lane * 4 + i; const int c = cntg[wg * 8 + e]; t += c; b += wg < F.vcu ? c : 0; }
        const float tf = wave_sum((float)t), bf = wave_sum((float)b);
        if (lane == 0) { tot[e] = (int)tf; bef[e] = (int)bf; }
    }
    __syncthreads();
    if (F.tid == 0) { int s = 0; for (int e = 0; e < 8; ++e) { seg[e] = s; base[e] = s + bef[e]; s += (tot[e] + 255) & ~255; } seg[8] = s; }
    __syncthreads();
    const int NT = seg[8] >> 8;
    if (active) {
        if (F.tid < 128) { int pos = base[ex] + rank; if (F.wave == 1) pos += wcnt[ex];
            epos[F.tid] = pos; TP[2 * tok0 + F.tid] = pos; }
        __syncthreads();
#pragma unroll
        for (int k = 0; k < 8; ++k) { const int tl = 8 * F.wave + k; const int d0 = epos[2 * tl], d1 = epos[2 * tl + 1];
            GAS v2u* o0 = (GAS v2u*)(H2S + (size_t)d0 * D) + lane; GAS v2u* o1 = (GAS v2u*)(H2S + (size_t)d1 * D) + lane;
#pragma unroll
            for (int j = 0; j < 4; ++j) { const v2u a = raw[k][j]; const f32x4 y = (f32x4){bflo(a.x), bfhi(a.x), bflo(a.y), bfhi(a.y)} * rsd[k] * ca[j] + cb[j];
                v2u o; o.x = pk2(y.x, y.y); o.y = pk2(y.z, y.w); o0[64 * j] = o; o1[64 * j] = o; } }
    }
    for (int e = 0; e < 8; ++e) {
        const int lo = seg[e] + tot[e], hi = seg[e + 1];
        GAS v4u* d = (GAS v4u*)(H2S + (size_t)lo * D); const int n16 = (hi - lo) * (D * 2 / 16);
        for (int i = F.vcu * NTHR + F.tid; i < n16; i += F.G * NTHR) d[i] = (v4u){0u, 0u, 0u, 0u};
    }
    __syncthreads();
    return NT;
}
constexpr int FIN_R = 2;
__device__ __forceinline__ void ph_final(Frame& F) {
    const bf16* X = (const bf16*)(F.ws + WS_X); const bf16* YO = (const bf16*)(F.ws + WS_H2S);
    const int* TP = (const int*)(F.ws + WS_TOKP); const float* TW = (const float*)(F.ws + WS_TOKW);
    const float* g2 = modp(F, 1, 0) + M_G2; const float* fg = F.in[I_FINALG];
    const float* YP = (const float*)(F.ws + WS_YPART);
    const int gw = F.vcu * NWAVES + F.wave, NGW = F.G * NWAVES;
    f32x4 cg[4], cf[4];
#pragma unroll
    for (int j = 0; j < 4; ++j) { const int c = 4 * (64 * j + F.lane); cg[j] = *(const f32x4*)(g2 + c); cf[j] = *(const f32x4*)(fg + c); }
    for (int r0 = gw; r0 < L; r0 += FIN_R * NGW) {
        int rr[FIN_R], pa[FIN_R], pb[FIN_R]; float wa[FIN_R], wb[FIN_R]; f32x4 xv[FIN_R][4]; v2u ya[FIN_R][4], yb[FIN_R][4];
#pragma unroll
        for (int k = 0; k < FIN_R; ++k) { const int r = r0 + k * NGW; rr[k] = r < L ? r : r0; pa[k] = TP[2 * rr[k]]; pb[k] = TP[2 * rr[k] + 1]; wa[k] = TW[2 * rr[k]]; wb[k] = TW[2 * rr[k] + 1]; }
#pragma unroll
        for (int k = 0; k < FIN_R; ++k) { load_row4<true>(X + (size_t)rr[k] * D, F.lane, xv[k]);
            const GAS v2u* y0 = (const GAS v2u*)(YO + (size_t)pa[k] * D) + F.lane; const GAS v2u* y1 = (const GAS v2u*)(YO + (size_t)pb[k] * D) + F.lane;
#pragma unroll
            for (int j = 0; j < 4; ++j) { ya[k][j] = __builtin_nontemporal_load(y0 + 64 * j); yb[k][j] = __builtin_nontemporal_load(y1 + 64 * j); } }
#pragma unroll
        for (int k = 0; k < FIN_R; ++k) { const int r = rr[k], p0 = pa[k], p1 = pb[k]; const float w0 = wa[k], w1 = wb[k];
            f32x4 v[4]; float s2 = 0.f;
#pragma unroll
            for (int j = 0; j < 4; ++j) { const int c = 4 * (64 * j + F.lane); const v2u a = ya[k][j], b = yb[k][j]; const f32x4 g = cg[j];
                f32x4 fa = (f32x4){bflo(a.x), bfhi(a.x), bflo(a.y), bfhi(a.y)}, fb = (f32x4){bflo(b.x), bfhi(b.x), bflo(b.y), bfhi(b.y)};
                if (p0 >= 32768) { fa = (f32x4){0.f, 0.f, 0.f, 0.f}; for (int q = 0; q < 7; ++q) fa += *(const f32x4*)(YP + ((size_t)q * 2048 + (p0 - 32768)) * D + c); }
                if (p1 >= 32768) { fb = (f32x4){0.f, 0.f, 0.f, 0.f}; for (int q = 0; q < 7; ++q) fb += *(const f32x4*)(YP + ((size_t)q * 2048 + (p1 - 32768)) * D + c); }
                const f32x4 f = fa * w0 + fb * w1;
                v[j] = xv[k][j] + g * f; s2 += (v[j].x * v[j].x + v[j].y * v[j].y) + (v[j].z * v[j].z + v[j].w * v[j].w); }
            const float rstd = 1.0f / sqrtf(wave_sum(s2) * (1.0f / D) + EPS);
            GAS f32x4* o = (GAS f32x4*)(F.out + (size_t)r * D) + F.lane;
#pragma unroll
            for (int j = 0; j < 4; ++j) __builtin_nontemporal_store(v[j] * rstd * cf[j], &o[64 * j]);
        }
    }
}


typedef short bf16x8v __attribute__((ext_vector_type(8)));
__device__ __forceinline__ bf16x8v as_frag(v4u a) { return __builtin_bit_cast(bf16x8v, a); }
constexpr float LOG2E_ = 1.4426950408889634f;
#define MFMA16(a, b, c) __builtin_amdgcn_mfma_f32_16x16x32_bf16((a), (b), (c), 0, 0, 0)
__device__ __forceinline__ int prm_row(int i2, int par, int r) { return 32 * i2 + 8 * (r >> 2) + 4 * par + (r & 3); }

__device__ __forceinline__ void ph_ssd_s1(Frame& F) {
    const bf16* XT = (const bf16*)(F.ws + WS_XT); const bf16* BT = (const bf16*)(F.ws + WS_BT);
    const float* DTF = (const float*)(F.ws + WS_WF); const float* DTB = DTF + (size_t)32 * MT;
    bf16* ST = (bf16*)(F.ws + WS_STATES);
    LAS unsigned char* btl = F.lds;
    LAS float* wtab = (LAS float*)(F.lds + 128 * 272);
    LAS float* wtot = wtab + 1024;
    const int lane = F.lane, r16 = lane & 15, gq = lane >> 4;
    v4u nbt[4]; float ndtf = 0.f, ndtb = 0.f;
#define S1_PREFETCH(u_) do { const int c_ = (u_) >> 3, g_ = ((u_) >> 1) & 3, hh_ = (u_) & 1, t0_ = c_ * 128; int tq_ = F.tid; asm volatile("" : "+v"(tq_)); \
        _Pragma("unroll") for (int i_ = 0; i_ < 4; ++i_) { const int p_ = tq_ + NTHR * i_, n_ = p_ >> 4, c8_ = (p_ & 15) * 8; nbt[i_] = *(const GAS v4u*)(BT + (size_t)(g_ * 128 + n_) * MT + t0_ + c8_); } \
        { const int h_ = 8 * g_ + 4 * hh_ + (tq_ >> 7); ndtf = DTF[(size_t)h_ * MT + t0_ + (tq_ & 127)]; ndtb = DTB[(size_t)h_ * MT + t0_ + (tq_ & 127)]; } } while (0)
    if (F.vcu < NCH * 8) S1_PREFETCH(F.vcu);
    for (int u = F.vcu; u < NCH * 8; u += F.G) {
        const int c = u >> 3, g = (u >> 1) & 3, hh = u & 1, t0 = c * 128;
        int tid_ = F.tid; asm volatile("" : "+v"(tid_));
        v4u xr[4][4];
        { const int hx = 8 * g + 4 * hh + (F.wave >> 1);
#pragma unroll
          for (int ks = 0; ks < 4; ++ks)
#pragma unroll
            for (int pt = 0; pt < 4; ++pt) xr[ks][pt] = *(const GAS v4u*)(XT + ((size_t)(((hx * NCH + c) * 4 + ks) * 4 + pt) * 16 + r16) * 32 + 8 * gq); }
#pragma unroll
        for (int i = 0; i < 4; ++i) { const int p = tid_ + NTHR * i, n = p >> 4, c8 = (p & 15) * 8; *(LAS v4u*)(btl + n * 272 + c8 * 2) = nbt[i]; }
        { const int j = tid_ >> 7, l = tid_ & 127; wtab[(j * 2 + 0) * 128 + l] = ndtf; wtab[(j * 2 + 1) * 128 + l] = ndtb; }
        __syncthreads();
        {
            const int j = F.wave >> 1, dir = F.wave & 1, h = 8 * g + 4 * hh + j;
            f32x4 acc[8][4];
#pragma unroll
            for (int a = 0; a < 8; ++a)
#pragma unroll
                for (int b = 0; b < 4; ++b) acc[a][b] = (f32x4){0.f, 0.f, 0.f, 0.f};
            const LAS float* wt = wtab + (j * 2 + dir) * 128;
            if (u + F.G < NCH * 8) S1_PREFETCH(u + F.G);
#pragma unroll
            for (int ks = 0; ks < 4; ++ks) {
                const f32x4 w0 = *(const LAS f32x4*)(wt + 32 * ks + 8 * gq), w1 = *(const LAS f32x4*)(wt + 32 * ks + 8 * gq + 4);
                bf16x8v bfr[4];
#pragma unroll
                for (int pt = 0; pt < 4; ++pt) { const v4u x = xr[ks][pt];
                    v4u y; y.x = pk2(bflo(x.x) * w0.x, bfhi(x.x) * w0.y); y.y = pk2(bflo(x.y) * w0.z, bfhi(x.y) * w0.w); y.z = pk2(bflo(x.z) * w1.x, bfhi(x.z) * w1.y); y.w = pk2(bflo(x.w) * w1.z, bfhi(x.w) * w1.w);
                    bfr[pt] = as_frag(y); }
#pragma unroll
                for (int nt = 0; nt < 8; ++nt) { const bf16x8v af = as_frag(*(const LAS v4u*)(btl + prm_row(nt >> 1, nt & 1, r16) * 272 + (32 * ks + 8 * gq) * 2));
#pragma unroll
                    for (int pt = 0; pt < 4; ++pt) acc[nt][pt] = MFMA16(af, bfr[pt], acc[nt][pt]); }
            }
            bf16* so = ST + ((size_t)((dir * NCH + c) * 32 + h) * 64) * 128;
#pragma unroll
            for (int pt = 0; pt < 4; ++pt)
#pragma unroll
                for (int i2 = 0; i2 < 4; ++i2) { const f32x4 a = acc[2 * i2][pt], b = acc[2 * i2 + 1][pt];
                    v4u o; o.x = pk2(a[0], a[1]); o.y = pk2(a[2], a[3]); o.z = pk2(b[0], b[1]); o.w = pk2(b[2], b[3]);
                    *(GAS v4u*)(so + (size_t)(((pt * 4 + i2) * 16 + r16) * 32) + 8 * gq) = o; }
        }
        __syncthreads();
    }
    { const int nun = NCH * 8, full = nun / F.G, nbusy = nun - full * F.G; __syncthreads();
      if (F.vcu >= nbusy) moe_dn_convert(F, 1900, 5700, (F.vcu - nbusy) * NWAVES + F.wave, (F.G - nbusy) * NWAVES); }
}
#undef S1_PREFETCH

__device__ __forceinline__ void ph_ssd_s2(Frame& F) {
    const float* DEC = (const float*)(F.ws + WS_DEC); bf16* ST = (bf16*)(F.ws + WS_STATES);
    constexpr int NB = 10;
    static_assert(NCH == 13 * NB, "S2 batch schedule");
    for (int e = F.vcu * NTHR + F.tid; e < 2 * 32 * 64 * 32; e += F.G * NTHR) {
        const int dir = e >> 16, h = (e >> 11) & 31, rem = e & 2047;
        const size_t eoff = (size_t)h * 8192 + (size_t)rem * 4; const size_t cstride = (size_t)32 * 8192;
        bf16* base = ST + (size_t)dir * NCH * cstride + eoff;
        const float* dec = DEC + (size_t)dir * NCH * 32 + h;
        float H0 = 0.f, H1 = 0.f, H2 = 0.f, H3 = 0.f;
        v2u sa[NB], sb[NB]; float da[NB], db[NB];
#define S2_CK(idx_) (dir == 0 ? ((idx_) < 2 ? 128 + (idx_) : (idx_) - 2) : 129 - (idx_))
#define S2_LOAD(s_, d_, b_) do { _Pragma("unroll") for (int i = 0; i < NB; ++i) { const int ck = S2_CK((b_) + i); s_[i] = __builtin_nontemporal_load((const GAS v2u*)(base + (size_t)ck * cstride)); d_[i] = dec[ck * 32]; } } while (0)
#define S2_PROC(s_, d_, b_) do { _Pragma("unroll") for (int i = 0; i < NB; ++i) { const int ck = S2_CK((b_) + i); v2u o; o.x = pk2(H0, H1); o.y = pk2(H2, H3); *(GAS v2u*)(base + (size_t)ck * cstride) = o; \
                H0 = d_[i] * H0 + bflo(s_[i].x); H1 = d_[i] * H1 + bfhi(s_[i].x); H2 = d_[i] * H2 + bflo(s_[i].y); H3 = d_[i] * H3 + bfhi(s_[i].y); } } while (0)
        S2_LOAD(sa, da, 0);
#pragma unroll 1
        for (int b = 0; b < 12 * NB; b += 2 * NB) { S2_LOAD(sb, db, b + NB); S2_PROC(sa, da, b); S2_LOAD(sa, da, b + 2 * NB); S2_PROC(sb, db, b + NB); }
        S2_PROC(sa, da, 12 * NB);
#undef S2_CK
#undef S2_LOAD
#undef S2_PROC
    }
}

constexpr int S12_D = 6, S12_SLOT = 25600, S12_BOFF = 16384, S12_WOFF = 24576, S12_DECOFF = S12_D * S12_SLOT;
static_assert(S12_DECOFF + NCH * 4 <= RING_BYTES, "S12 LDS map");
__device__ __forceinline__ void ph_ssd_s12(Frame& F) {
    const bf16* XT = (const bf16*)(F.ws + WS_XT); const bf16* BT = (const bf16*)(F.ws + WS_BT);
    const float* WFB = (const float*)(F.ws + WS_WF); const float* DEC = (const float*)(F.ws + WS_DEC); bf16* ST = (bf16*)(F.ws + WS_STATES);
    const int lane = F.lane, r16 = lane & 15, gq = lane >> 4;
    LAS float* dectab = (LAS float*)(F.lds + S12_DECOFF);
#define S12_CK(d_, idx_) ((d_) == 0 ? ((idx_) < 2 ? 128 + (idx_) : (idx_) - 2) : 129 - (idx_))
    for (int task = F.vcu; task < 256; task += F.G) {
        const int d = task >> 7, h = (task >> 2) & 31, i2 = task & 3, g = h >> 3;
        __syncthreads();
        for (int i = F.tid; i < NCH; i += NTHR) dectab[i] = DEC[(d * NCH + S12_CK(d, i)) * 32 + h];
        __syncthreads();
        if (F.wave >= 4) {
            const int hw = F.wave - 4;
            const float* wsrc = WFB + (size_t)d * 32 * MT + (size_t)h * MT + hw * 32 + (lane & 7) * 4;
            const bf16* bsrc0; const bf16* bsrc1;
            { const int bb0 = hw * 2, bb1 = hw * 2 + 1;
              bsrc0 = BT + (size_t)(g * 128 + prm_row(i2, bb0 >> 2, r16)) * MT + 32 * (bb0 & 3) + 8 * gq;
              bsrc1 = BT + (size_t)(g * 128 + prm_row(i2, bb1 >> 2, r16)) * MT + 32 * (bb1 & 3) + 8 * gq; }
            const bf16* xsrc = XT + (size_t)h * NCH * 8192 + (size_t)(hw * 4) * 512 + lane * 8;
#define S12_ISSUE(step_) do { const int st_ = (step_) < NCH ? (step_) : NCH - 1; const int ck_ = S12_CK(d, st_); LAS unsigned char* sb_ = F.lds + ((step_) % S12_D) * S12_SLOT; \
                _Pragma("unroll") for (int q_ = 0; q_ < 4; ++q_) __builtin_amdgcn_global_load_lds((const unsigned*)(xsrc + (size_t)ck_ * 8192 + q_ * 512), (LAS unsigned*)(sb_ + (hw * 4 + q_) * 1024), 16, 0, 0); \
                __builtin_amdgcn_global_load_lds((const unsigned*)(bsrc0 + ck_ * 128), (LAS unsigned*)(sb_ + S12_BOFF + (hw * 2) * 1024), 16, 0, 0); \
                __builtin_amdgcn_global_load_lds((const unsigned*)(bsrc1 + ck_ * 128), (LAS unsigned*)(sb_ + S12_BOFF + (hw * 2 + 1) * 1024), 16, 0, 0); \
                if (lane < 8) __builtin_amdgcn_global_load_lds((const unsigned*)(wsrc + ck_ * 128), (LAS unsigned*)(sb_ + S12_WOFF + hw * 128), 16, 0, 0); } while (0)
#pragma unroll
            for (int s = 0; s < S12_D; ++s) S12_ISSUE(s);
            asm volatile("s_waitcnt vmcnt(35)" ::: "memory");
            __builtin_amdgcn_s_barrier(); asm volatile("" ::: "memory");
#pragma unroll 1
            for (int i = 0; i < NCH; ++i) {
                asm volatile("s_waitcnt vmcnt(28)" ::: "memory");
                __builtin_amdgcn_s_barrier(); asm volatile("" ::: "memory");
                S12_ISSUE(i + S12_D);
            }
            asm volatile("s_waitcnt vmcnt(0)" ::: "memory");
#undef S12_ISSUE
        } else {
            const int pt = F.wave;
            f32x4 acc0 = (f32x4){0.f, 0.f, 0.f, 0.f}, acc1 = acc0;
            bf16* so = ST + (size_t)d * NCH * 32 * 8192 + (size_t)h * 8192 + (size_t)(((pt * 4 + i2) * 16 + r16) * 32) + 8 * gq;
            v4u xa[4], b0a[4], b1a[4], xb[4], b0b[4], b1b[4]; f32x4 w0[4], w1[4];
#define S12_LOADRAW(x_, b0_, b1_, step_) do { const LAS unsigned char* sb_ = F.lds + ((step_) % S12_D) * S12_SLOT; \
                _Pragma("unroll") for (int ks = 0; ks < 4; ++ks) { w0[ks] = *(const LAS f32x4*)(sb_ + S12_WOFF + (32 * ks + 8 * gq) * 4); w1[ks] = *(const LAS f32x4*)(sb_ + S12_WOFF + (32 * ks + 8 * gq) * 4 + 16); \
                    x_[ks] = *(const LAS v4u*)(sb_ + (ks * 4 + pt) * 1024 + r16 * 64 + gq * 16); \
                    b0_[ks] = *(const LAS v4u*)(sb_ + S12_BOFF + (0 * 4 + ks) * 1024 + lane * 16); b1_[ks] = *(const LAS v4u*)(sb_ + S12_BOFF + (1 * 4 + ks) * 1024 + lane * 16); } } while (0)
#define S12_SCALE(x_) do { _Pragma("unroll") for (int ks = 0; ks < 4; ++ks) { const v4u x = x_[ks]; const f32x4 wa = w0[ks], wb = w1[ks]; v4u y; \
                    y.x = pk2(bflo(x.x) * wa.x, bfhi(x.x) * wa.y); y.y = pk2(bflo(x.y) * wa.z, bfhi(x.y) * wa.w); y.z = pk2(bflo(x.z) * wb.x, bfhi(x.z) * wb.y); y.w = pk2(bflo(x.w) * wb.z, bfhi(x.w) * wb.w); x_[ks] = y; } } while (0)
#define S12_STEP(x_, b0_, b1_, i_) do { const int ck_ = S12_CK(d, (i_)); \
                { v4u o; o.x = pk2(acc0[0], acc0[1]); o.y = pk2(acc0[2], acc0[3]); o.z = pk2(acc1[0], acc1[1]); o.w = pk2(acc1[2], acc1[3]); *(GAS v4u*)(so + (size_t)ck_ * 32 * 8192) = o; } \
                const float dec_ = dectab[(i_)]; acc0 *= dec_; acc1 *= dec_; \
                _Pragma("unroll") for (int ks = 0; ks < 4; ++ks) { acc0 = MFMA16(as_frag(b0_[ks]), as_frag(x_[ks]), acc0); acc1 = MFMA16(as_frag(b1_[ks]), as_frag(x_[ks]), acc1); } } while (0)
#define S12_BAR() do { asm volatile("s_waitcnt lgkmcnt(0)" ::: "memory"); __builtin_amdgcn_s_barrier(); asm volatile("" ::: "memory"); } while (0)
            S12_BAR();
            S12_LOADRAW(xa, b0a, b1a, 0); S12_SCALE(xa);
#pragma unroll 1
            for (int i = 0; i < NCH; i += 2) {
                S12_BAR();
                S12_LOADRAW(xb, b0b, b1b, i + 1);
                S12_STEP(xa, b0a, b1a, i);
                S12_SCALE(xb);
                S12_BAR();
                if (i + 2 < NCH) S12_LOADRAW(xa, b0a, b1a, i + 2);
                S12_STEP(xb, b0b, b1b, i + 1);
                if (i + 2 < NCH) S12_SCALE(xa);
            }
#undef S12_LOADRAW
#undef S12_SCALE
#undef S12_STEP
#undef S12_BAR
        }
        __syncthreads();
    }
#undef S12_CK
}

__device__ __forceinline__ void ph_ssd_s3(Frame& F) {
    const bf16* XT = (const bf16*)(F.ws + WS_XT); const bf16* BMm = (const bf16*)(F.ws + WS_BM); const bf16* CMm = (const bf16*)(F.ws + WS_CM);
    const float* DTF = (const float*)(F.ws + WS_DTS); const float* DTB = DTF + (size_t)32 * MT; const float* CUMF = DTB + (size_t)32 * MT; const float* CUMB = CUMF + (size_t)32 * MT;
    const bf16* ST = (const bf16*)(F.ws + WS_STATES); bf16* Z = (bf16*)(F.ws + WS_Z); const float* ng = F.in[I_SSDNG];
    LAS unsigned char* bml = F.lds;
    LAS unsigned char* cml = F.lds + 128 * 272;
    LAS float* tab = (LAS float*)(F.lds + 192 * 272);
    LAS float* ssq = tab + 8 * 5 * 128;
    const int lane = F.lane, r16 = lane & 15, gq = lane >> 4;
    v4u nbm[4], ncm[2]; float ncf[2], ncb[2], ndf[2], ndb[2];
#define S3_PREFETCH(u_) do { const int c_ = (u_) >> 3, g_ = ((u_) >> 1) & 3, lh_ = (u_) & 1, t0_ = c_ * 128; int tq_ = F.tid; asm volatile("" : "+v"(tq_)); \
        _Pragma("unroll") for (int i_ = 0; i_ < 4; ++i_) { const int p_ = tq_ + NTHR * i_, row_ = p_ >> 4, c8_ = (p_ & 15) * 8; nbm[i_] = *(const GAS v4u*)(BMm + (size_t)(t0_ + row_) * 512 + g_ * 128 + c8_); } \
        _Pragma("unroll") for (int i_ = 0; i_ < 2; ++i_) { const int p_ = tq_ + NTHR * i_, row_ = p_ >> 4, c8_ = (p_ & 15) * 8; ncm[i_] = *(const GAS v4u*)(CMm + (size_t)(t0_ + 64 * lh_ + row_) * 512 + g_ * 128 + c8_); \
            const size_t o_ = (size_t)(8 * g_ + (p_ >> 7)) * MT + t0_ + (p_ & 127); ncf[i_] = CUMF[o_]; ncb[i_] = CUMB[o_]; ndf[i_] = DTF[o_]; ndb[i_] = DTB[o_]; } } while (0)
    if (F.vcu < 128 * 8) S3_PREFETCH(F.vcu);
    for (int u = F.vcu; u < 128 * 8; u += F.G) {
        const int c = u >> 3, g = (u >> 1) & 3, lh = u & 1, t0 = c * 128;
        __syncthreads();
        int tid_ = F.tid; asm volatile("" : "+v"(tid_));
#pragma unroll
        for (int i = 0; i < 4; ++i) { const int p = tid_ + NTHR * i, row = p >> 4, c8 = (p & 15) * 8; *(LAS v4u*)(bml + row * 272 + c8 * 2) = nbm[i]; }
#pragma unroll
        for (int i = 0; i < 2; ++i) { const int p = tid_ + NTHR * i, row = p >> 4, c8 = (p & 15) * 8; *(LAS v4u*)(cml + row * 272 + c8 * 2) = ncm[i]; }
#pragma unroll
        for (int i = 0; i < 2; ++i) { const int p = tid_ + NTHR * i, j = p >> 7, l = p & 127;
            const float cf = ncf[i] * LOG2E_, cb = ncb[i] * LOG2E_, df = ndf[i], db = ndb[i];
            tab[(j * 5 + 0) * 128 + l] = cf; tab[(j * 5 + 1) * 128 + l] = cb; tab[(j * 5 + 2) * 128 + l] = __builtin_amdgcn_logf(df) - cf; tab[(j * 5 + 3) * 128 + l] = __builtin_amdgcn_logf(db) - cb;
            tab[(j * 5 + 4) * 128 + l] = df + db; }
        __syncthreads();
        const int h = 8 * g + F.wave;
        const float Dk = F.in[I_SSDD][h];
        const LAS float* tcf = tab + (F.wave * 5) * 128; const LAS float* tcb = tcf + 128; const LAS float* tdf = tcb + 128; const LAS float* tdb = tdf + 128; const LAS float* tds = tdb + 128;
        f32x4 acc[4][4];
#pragma unroll
        for (int a = 0; a < 4; ++a)
#pragma unroll
            for (int b = 0; b < 4; ++b) acc[a][b] = (f32x4){0.f, 0.f, 0.f, 0.f};
#pragma unroll 1
        for (int i2 = 0; i2 < 4; ++i2) {
            bf16x8v xf[4], bmf[2][4];
#pragma unroll
            for (int pt = 0; pt < 4; ++pt) xf[pt] = as_frag(*(const GAS v4u*)(XT + ((size_t)(((h * NCH + c) * 4 + i2) * 4 + pt) * 16 + r16) * 32 + 8 * gq));
#pragma unroll
            for (int par = 0; par < 2; ++par)
#pragma unroll
                for (int nk = 0; nk < 4; ++nk) bmf[par][nk] = as_frag(*(const LAS v4u*)(bml + prm_row(i2, par, r16) * 272 + (32 * nk + 8 * gq) * 2));
            const int sb = 32 * i2 + 8 * gq;
            const f32x4 dfs0 = *(const LAS f32x4*)(tdf + sb), dfs1 = *(const LAS f32x4*)(tdf + sb + 4), dbs0 = *(const LAS f32x4*)(tdb + sb), dbs1 = *(const LAS f32x4*)(tdb + sb + 4);
#pragma unroll
            for (int lt = 0; lt < 4; ++lt) {
                const int ll = 16 * lt + r16, l = 64 * lh + ll;
                const float cfl = tcf[l], cbl = tcb[l], dsl = tds[l];
                f32x4 g0 = (f32x4){0.f, 0.f, 0.f, 0.f}, g1 = g0;
#pragma unroll
                for (int nk = 0; nk < 4; ++nk) { const bf16x8v cf = as_frag(*(const LAS v4u*)(cml + ll * 272 + (32 * nk + 8 * gq) * 2));
                    g0 = MFMA16(bmf[0][nk], cf, g0); g1 = MFMA16(bmf[1][nk], cf, g1); }
                float m[8];
                const int ltile0 = 64 * lh + 16 * lt; const int blk = (32 * i2 + 31 < ltile0) ? 0 : ((32 * i2 > ltile0 + 15) ? 2 : 1);
                if (blk == 0) {
#pragma unroll
                    for (int e = 0; e < 8; ++e) { const float dfs = e < 4 ? dfs0[e & 3] : dfs1[e & 3], gv = e < 4 ? g0[e & 3] : g1[e & 3]; m[e] = gv * __builtin_amdgcn_exp2f(cfl + dfs); }
                } else if (blk == 2) {
#pragma unroll
                    for (int e = 0; e < 8; ++e) { const float dbs = e < 4 ? dbs0[e & 3] : dbs1[e & 3], gv = e < 4 ? g0[e & 3] : g1[e & 3]; m[e] = gv * __builtin_amdgcn_exp2f(cbl + dbs); }
                } else {
#pragma unroll
                    for (int e = 0; e < 8; ++e) { const int s = sb + e;
                        const float dfs = e < 4 ? dfs0[e & 3] : dfs1[e & 3], dbs = e < 4 ? dbs0[e & 3] : dbs1[e & 3], gv = e < 4 ? g0[e & 3] : g1[e & 3];
                        float w = __builtin_amdgcn_exp2f(s < l ? cfl + dfs : cbl + dbs); const bool dg = s == l;
                        w = dg ? dsl : w; m[e] = gv * w + (dg ? Dk : 0.f); }
                }
                asm volatile("" : "+v"(m[0]), "+v"(m[1]), "+v"(m[2]), "+v"(m[3]), "+v"(m[4]), "+v"(m[5]), "+v"(m[6]), "+v"(m[7]));
                v4u mp; mp.x = pk2(m[0], m[1]); mp.y = pk2(m[2], m[3]); mp.z = pk2(m[4], m[5]); mp.w = pk2(m[6], m[7]);
                const bf16x8v mf = as_frag(mp);
#pragma unroll
                for (int pt = 0; pt < 4; ++pt) acc[lt][pt] = MFMA16(xf[pt], mf, acc[lt][pt]);
            }
        }
        if (u + F.G < 128 * 8) S3_PREFETCH(u + F.G);
#pragma unroll 1
        for (int dir = 0; dir < 2; ++dir) {
            const bf16* hs = ST + ((size_t)((dir * NCH + c) * 32 + h) * 64) * 128;
            float el[4];
#pragma unroll
            for (int lt = 0; lt < 4; ++lt) { const int l = 64 * lh + 16 * lt + r16; el[lt] = __builtin_amdgcn_exp2f(dir == 0 ? tcf[l] : tcb[l]); }
            f32x4 tacc[4][4];
#pragma unroll
            for (int a = 0; a < 4; ++a)
#pragma unroll
                for (int b = 0; b < 4; ++b) tacc[a][b] = (f32x4){0.f, 0.f, 0.f, 0.f};
#pragma unroll 1
            for (int nk = 0; nk < 4; ++nk) {
                bf16x8v hf[4];
#pragma unroll
                for (int pt = 0; pt < 4; ++pt) hf[pt] = as_frag(*(const GAS v4u*)(hs + (size_t)(((pt * 4 + nk) * 16 + r16) * 32) + 8 * gq));
#pragma unroll
                for (int lt = 0; lt < 4; ++lt) { const int ll = 16 * lt + r16;
                    const bf16x8v cf = as_frag(*(const LAS v4u*)(cml + ll * 272 + (32 * nk + 8 * gq) * 2));
#pragma unroll
                    for (int pt = 0; pt < 4; ++pt) tacc[lt][pt] = MFMA16(hf[pt], cf, tacc[lt][pt]); }
            }
#pragma unroll
            for (int lt = 0; lt < 4; ++lt)
#pragma unroll
                for (int pt = 0; pt < 4; ++pt) acc[lt][pt] += tacc[lt][pt] * el[lt];
        }
#pragma unroll
        for (int lt = 0; lt < 4; ++lt) { const int l = 64 * lh + 16 * lt + r16; float ss = 0.f;
#pragma unroll
            for (int q = 0; q < 2; ++q) { const v4u zv = *(const GAS v4u*)(Z + (size_t)(t0 + l) * DIN + h * 64 + 32 * q + 8 * gq);
                const float zz[8] = {bflo(zv.x), bfhi(zv.x), bflo(zv.y), bfhi(zv.y), bflo(zv.z), bfhi(zv.z), bflo(zv.w), bfhi(zv.w)};
#pragma unroll
                for (int e = 0; e < 4; ++e) { float v0 = acc[lt][2 * q][e] * zz[e] * sigmoid_f(zz[e]), v1 = acc[lt][2 * q + 1][e] * zz[4 + e] * sigmoid_f(zz[4 + e]);
                    acc[lt][2 * q][e] = v0; acc[lt][2 * q + 1][e] = v1; ss += v0 * v0 + v1 * v1; } }
            ss += __shfl_xor(ss, 16); ss += __shfl_xor(ss, 32);
            if (gq == 0) ssq[(16 * lt + r16) * 8 + F.wave] = ss; }
        __syncthreads();
#pragma unroll
        for (int lt = 0; lt < 4; ++lt) { const int ll = 16 * lt + r16, l = 64 * lh + ll;
            const f32x4 s0 = *(const LAS f32x4*)(ssq + ll * 8), s1 = *(const LAS f32x4*)(ssq + ll * 8 + 4);
            const float rs = 1.0f / sqrtf(((s0.x + s0.y) + (s0.z + s0.w) + (s1.x + s1.y) + (s1.z + s1.w)) * (1.0f / 512.0f) + EPS);
#pragma unroll
            for (int q = 0; q < 2; ++q) { const int ch = h * 64 + 32 * q + 8 * gq; const f32x4 a = acc[lt][2 * q] * rs, b = acc[lt][2 * q + 1] * rs;
                const f32x4 g0 = *(const f32x4*)(ng + ch), g1 = *(const f32x4*)(ng + ch + 4);
                v4u o; o.x = pk2(a[0] * g0.x, a[1] * g0.y); o.y = pk2(a[2] * g0.z, a[3] * g0.w); o.z = pk2(b[0] * g1.x, b[1] * g1.y); o.w = pk2(b[2] * g1.z, b[3] * g1.w);
                *(GAS v4u*)(Z + (size_t)(t0 + l) * DIN + ch) = o; } }
    }
    __syncthreads();
}
#undef S3_PREFETCH

__device__ __forceinline__ float vmax_f(float a, float b) { return __builtin_amdgcn_fmed3f(a, b, __builtin_inff()); }
__device__ __forceinline__ float vmin_f(float a, float b) { return __builtin_amdgcn_fmed3f(a, b, -__builtin_inff()); }
__device__ __forceinline__ float vmax3_f(float a, float b, float c) { return vmax_f(a, vmax_f(b, c)); }
__device__ __forceinline__ int attn_next_blk(int kb, int qb, bool isctx) {
    for (int k = kb + 1; k < 5; ++k) { if (k >= 3) return k; if (!isctx) { const int b = qb - 1 + k; if (b >= 0 && b < 128) return k; } }
    return 5;
}
__device__ __forceinline__ void ph_attn(Frame& F) {
    const bf16* QR = (const bf16*)(F.ws + WS_QR); const bf16* KR = (const bf16*)(F.ws + WS_KR); const bf16* VT = (const bf16*)(F.ws + WS_VT); bf16* MIX = (bf16*)(F.ws + WS_MIX);
    constexpr int KBYTES = 128 * 144, BUFB = KBYTES + 64 * 272;
    const int lane = F.lane, r16 = lane & 15, gq = lane >> 4;
    constexpr float LOG2E = 1.4426950408889634f;
    const int p0 = F.tid, p1 = F.tid + NTHR;
    const int kro0 = (p0 >> 3) * 144 + (p0 & 7) * 16, kro1 = (p1 >> 3) * 144 + (p1 & 7) * 16;
    const int vro0 = KBYTES + (p0 >> 4) * 272 + (p0 & 15) * 16, vro1 = KBYTES + (p1 >> 4) * 272 + (p1 & 15) * 16;
    for (int u = F.vcu; u < 130 * 8; u += F.G) {
        const int qb = u >> 3, hq = u & 7, kvh = hq >> 2; const bool isctx = qb >= 128;
        const int row0 = qb * 128;
        const int qrow = row0 + 16 * F.wave + r16;
        bf16x8v qf[2];
#pragma unroll
        for (int ks = 0; ks < 2; ++ks) qf[ks] = as_frag(*(const GAS v4u*)(QR + ((size_t)hq * MT + qrow) * 64 + 32 * ks + 8 * gq));
        float m2 = F.in[I_ABSINK][hq] * LOG2E, lsum = 1.0f;
        f32x4 oacc[4];
#pragma unroll
        for (int a = 0; a < 4; ++a) oacc[a] = (f32x4){0.f, 0.f, 0.f, 0.f};
        const int qi = 16 * F.wave + r16;
        const bf16* kbase = KR + (size_t)kvh * MT * 64; const bf16* vbase = VT + (size_t)kvh * 64 * MT;
#define ATT_KEY0(kb) ((kb) < 3 ? (qb - 1 + (kb)) * 128 : L + ((kb) - 3) * 128)
#define ATT_LOAD(kb) do { const int k0_ = ATT_KEY0(kb); \
            kr0 = *(const GAS v4u*)(kbase + (size_t)(k0_ + (p0 >> 3)) * 64 + (p0 & 7) * 8); kr1 = *(const GAS v4u*)(kbase + (size_t)(k0_ + (p1 >> 3)) * 64 + (p1 & 7) * 8); \
            vr0 = *(const GAS v4u*)(vbase + (size_t)(p0 >> 4) * MT + k0_ + (p0 & 15) * 8); vr1 = *(const GAS v4u*)(vbase + (size_t)(p1 >> 4) * MT + k0_ + (p1 & 15) * 8); } while (0)
#define ATT_WRITE(buf) do { LAS unsigned char* b_ = F.lds + (buf) * BUFB; *(LAS v4u*)(b_ + kro0) = kr0; *(LAS v4u*)(b_ + kro1) = kr1; *(LAS v4u*)(b_ + vro0) = vr0; *(LAS v4u*)(b_ + vro1) = vr1; } while (0)
        v4u kr0, kr1, vr0, vr1;
        int kb = attn_next_blk(-1, qb, isctx), cur = 0;
        __syncthreads();
        ATT_LOAD(kb); ATT_WRITE(0);
        __syncthreads();
        while (kb < 5) {
            const int nkb = attn_next_blk(kb, qb, isctx);
            if (nkb < 5) ATT_LOAD(nkb);
            const LAS unsigned char* kl = F.lds + cur * BUFB; const LAS unsigned char* vl = kl + KBYTES;
            const int mode = (kb == 0) ? 1 : ((kb == 2) ? 2 : 0);
            f32x4 sacc[8];
#pragma unroll
            for (int kt = 0; kt < 8; ++kt) { sacc[kt] = (f32x4){0.f, 0.f, 0.f, 0.f};
#pragma unroll
                for (int ks = 0; ks < 2; ++ks) { const bf16x8v kf = as_frag(*(const LAS v4u*)(kl + prm_row(kt >> 1, kt & 1, r16) * 144 + (32 * ks + 8 * gq) * 2));
                    sacc[kt] = MFMA16(kf, qf[ks], sacc[kt]); } }
            float bm = -1.0e30f;
#pragma unroll 1
            for (int rep_ = 0; rep_ < (mode != 0 ? 1 : 0); ++rep_) {
                const float msgn = mode == 1 ? 1.0e30f : -1.0e30f, limf = (float)(qi - 8 * gq);
#pragma unroll
                for (int kt = 0; kt < 8; ++kt)
#pragma unroll
                    for (int e = 0; e < 4; ++e) { const float jc = (float)(32 * (kt >> 1) + 4 * (kt & 1) + e);
                        sacc[kt][e] += vmin_f(0.f, msgn * (jc - limf)); }
            }
#pragma unroll
            for (int kt = 0; kt < 8; ++kt) bm = vmax3_f(bm, vmax_f(sacc[kt][0], sacc[kt][1]), vmax_f(sacc[kt][2], sacc[kt][3]));
            bm = vmax_f(bm, __shfl_xor(bm, 16)); bm = vmax_f(bm, __shfl_xor(bm, 32));
            const float mn = vmax_f(m2, bm), alpha = __builtin_amdgcn_exp2f(m2 - mn); m2 = mn;
            float ps = 0.f;
            bf16x8v pf[4];
#pragma unroll
            for (int i2 = 0; i2 < 4; ++i2) { float p[8];
#pragma unroll
                for (int e = 0; e < 4; ++e) { p[e] = __builtin_amdgcn_exp2f(sacc[2 * i2][e] - mn); p[4 + e] = __builtin_amdgcn_exp2f(sacc[2 * i2 + 1][e] - mn); }
#pragma unroll
                for (int e = 0; e < 8; ++e) ps += p[e];
                v4u pk; pk.x = pk2(p[0], p[1]); pk.y = pk2(p[2], p[3]); pk.z = pk2(p[4], p[5]); pk.w = pk2(p[6], p[7]); pf[i2] = as_frag(pk); }
            ps += __shfl_xor(ps, 16); ps += __shfl_xor(ps, 32);
            lsum = lsum * alpha + ps;
#pragma unroll
            for (int dt = 0; dt < 4; ++dt) { oacc[dt] = oacc[dt] * alpha;
#pragma unroll
                for (int i2 = 0; i2 < 4; ++i2) { const bf16x8v vf = as_frag(*(const LAS v4u*)(vl + prm_row(dt >> 1, dt & 1, r16) * 272 + (32 * i2 + 8 * gq) * 2));
                    oacc[dt] = MFMA16(vf, pf[i2], oacc[dt]); } }
            if (nkb < 5) ATT_WRITE(cur ^ 1);
            __syncthreads();
            kb = nkb; cur ^= 1;
        }
#undef ATT_KEY0
#undef ATT_LOAD
#undef ATT_WRITE
        const float il = 1.0f / lsum;
#pragma unroll
        for (int i = 0; i < 2; ++i) { const f32x4 a = oacc[2 * i] * il, b = oacc[2 * i + 1] * il;
            v4u o; o.x = pk2(a[0], a[1]); o.y = pk2(a[2], a[3]); o.z = pk2(b[0], b[1]); o.w = pk2(b[2], b[3]);
            *(GAS v4u*)(MIX + (size_t)qrow * D + 512 + 64 * hq + 32 * i + 8 * gq) = o; }
    }
    __syncthreads();
}

constexpr int NPH = 23;
#ifndef WGM_MOE_GU
#define WGM_MOE_GU 4
#endif
#ifndef WGM_MOE_DN
#define WGM_MOE_DN 4
#endif
__device__ __forceinline__ int moe_dn_idle_cut(int G, int nM) {
    const int nwg = nM * (2 * FFE / 256), nbusy = nwg % G, nidle = nbusy ? G - nbusy : 0;
    int items = nidle * NWAVES * 9 / 2; if (items > MOE_DN_ITEMS / 2) items = MOE_DN_ITEMS / 2;
    return MOE_DN_ITEMS / 2 + items;
}
struct Args { const float* in[30]; float* out; unsigned char* ws; int ph_lo, ph_hi; };
__global__ void __launch_bounds__(NTHR, 2) mk_fwd(Args args) {
    extern __shared__ __attribute__((aligned(16))) unsigned char lds[];
    Frame F;
    F.lds = (LAS unsigned char*)lds;
    F.tid = threadIdx.x; F.lane = F.tid & 63; F.wave = __builtin_amdgcn_readfirstlane(F.tid >> 6);
    F.G = gridDim.x; { const int bx = blockIdx.x; F.vcu = (F.G % 8 == 0) ? (bx % 8) * (F.G / 8) + bx / 8 : bx; }
#pragma unroll
    for (int i = 0; i < 30; ++i) F.in[i] = args.in[i];
    F.out = args.out; F.ws = args.ws;
    unsigned char* ws = args.ws;
    volatile LAS unsigned* MISC = (volatile LAS unsigned*)(F.lds + MISC_OFF);
    for (int u = F.tid; u < (LDS_BYTES - LDSCTL_OFF) / 4; u += NTHR) ((LAS unsigned*)(F.lds + LDSCTL_OFF))[u] = 0u;
    __syncthreads();
    const int lo = args.ph_lo, hi = args.ph_hi;
    XcdBarrier bar; bar.bar = (unsigned*)(ws + WS_CTL) + CW_BAR; bar.x = 0; bar.st = nullptr;
    if (hi - lo > 1) bar = xcd_barrier_post((unsigned*)(ws + WS_CTL) + CW_BAR, MISC + 8);
#define IN(k) (lo <= (k) && (k) < hi)
#define SEAM(k) do { if (IN(k) && IN((k) + 1)) xcd_barrier(bar); } while (0)
    LAS unsigned char* ring = F.lds;
    bf16* X = (bf16*)(ws + WS_X); bf16* H = (bf16*)(ws + WS_H);

    if (IN(0)) { ph_prologue(F); } SEAM(0);
    if (IN(1)) { ph_modulate<false, false, 0>(F, F.in[I_X], F.in[I_CTX], F.in[I_N1G], modp(F, 0, 0), modp(F, 0, 1), M_SH1, M_SC1, H, MT, nullptr, nullptr, nullptr); } SEAM(1);
    if (IN(2)) { pg8::Gemm g{H, (const bf16*)(ws + WS_WABIN), D, D, 0}; pg8::StaticOrder S; S.init(MT, AB_IN, F.G, (int)blockIdx.x);
        pg8::EpiStoreBf16 E{(bf16*)(ws + WS_PAB), AB_IN};
        pg8::gemm_phase<pg8::EpiStoreBf16, pg8::StaticOrder, true, true>(ring, g, S, E);
        idle_round_convert(F, (MT / 256) * (AB_IN / 256), 0, 11400); } SEAM(2);
    if (IN(3)) { ph_ab_elem(F); int gw_, ngw_; if (idle_last_round(F, MT / 16, gw_, ngw_)) { __syncthreads(); ph_convert_ffn_gu(F, 0, gw_, ngw_); } } SEAM(3);
    if (IN(4)) { ph_attn(F); int gw_, ngw_; if (idle_last_round(F, 130 * 8, gw_, ngw_)) { __syncthreads(); ph_convert_ffn_gu(F, 1, gw_, ngw_); } } SEAM(4);
    if (IN(5)) {
        { int nu_ = 16, kl_ = 256; asm volatile("" : "+s"(nu_), "+s"(kl_)); pg8::Gemm g{(const bf16*)(ws + WS_MIX), (const bf16*)(ws + WS_WABOUT), D, kl_, 0}; pg8::SplitOrder S{64, 4, nu_, 256, F.G, (int)blockIdx.x};
          pg8::EpiPart E{(float*)(ws + WS_PART), 64, 256, LC};
          pg8::gemm_phase<pg8::EpiPart, pg8::SplitOrder, true, true>(ring, g, S, E); }
        ctx_publish(F, 16, CW_PCNT);
        { pg8::Gemm g{(const bf16*)(ws + WS_MIX), (const bf16*)(ws + WS_WABOUT), D, D, 0}; pg8::StaticOrder S; S.init(L, D, F.G, (int)blockIdx.x);
          pg8::EpiRes<true> E{X, F.in[I_X], modp(F, 0, 0) + M_G1, (float*)(ws + WS_SSQA)};
          pg8::gemm_phase<pg8::EpiRes<true>, pg8::StaticOrder, true, true>(ring, g, S, E); }
        ctx_reduce<false, 4>(F, 16, CW_PCNT, F.in[I_CTX], modp(F, 0, 1) + M_G1, X, (float*)(ws + WS_SSQA));
        { const int nc_ = ctx_reducers_first(F, 16) ? 16 + 32 : 16; if ((int)blockIdx.x >= nc_) ph_convert_ffn(F, ((int)blockIdx.x - nc_) * NWAVES + F.wave, (F.G - nc_) * NWAVES); } } if (IN(5) && IN(7)) xcd_barrier(bar);
    if (IN(7)) { pg8::Gemm g{X, (const bf16*)(ws + WS_WFFNGU), D, D, (size_t)(WS_WCTX - WS_WFFNGU)}; pg8::StaticOrder S; S.init(MT, 2 * DFF, F.G, (int)blockIdx.x); S.pe_pm = L / 256;
        pg8::EpiSwiGLUFold E{(bf16*)(ws + WS_ACT0), DFF, (const float*)(ws + WS_SSQA), (const float*)(ws + WS_BIASA)};
        pg8::gemm_phase<pg8::EpiSwiGLUFold, pg8::StaticOrder, true, true>(ring, g, S, E);
        idle_round_convert(F, (MT / 256) * (2 * DFF / 256), 11400, 18000); } SEAM(7);
    if (IN(8)) {
        { int nu_ = 44, kl_ = 256; asm volatile("" : "+s"(nu_), "+s"(kl_)); pg8::Gemm g{(const bf16*)(ws + WS_ACT0), (const bf16*)(ws + WS_WFFND), DFF, kl_, 0}; pg8::SplitOrder S{64, 4, nu_, 256, F.G, (int)blockIdx.x};
          pg8::EpiPart E{(float*)(ws + WS_PART), 64, 256, LC};
          pg8::gemm_phase<pg8::EpiPart, pg8::SplitOrder, true, true>(ring, g, S, E); }
        ctx_publish(F, 44, CW_PCNT + 64);
        { pg8::Gemm g{(const bf16*)(ws + WS_ACT0), (const bf16*)(ws + WS_WFFND), DFF, DFF, 0}; pg8::StaticOrder S; S.init(L, D, F.G, (int)blockIdx.x);
          pg8::EpiRes<false> E{X, X, modp(F, 0, 0) + M_G2, (float*)(ws + WS_SSQB)};
          pg8::gemm_phase<pg8::EpiRes<false>, pg8::StaticOrder, true, true>(ring, g, S, E); }
        ctx_reduce<true, 11>(F, 44, CW_PCNT + 64, X + (size_t)L * D, modp(F, 0, 1) + M_G2, X, (float*)(ws + WS_SSQB));
        { const int nc_ = ctx_reducers_first(F, 44) ? 44 + 32 : 44; if ((int)blockIdx.x >= nc_) ph_convert_ssd(F, ((int)blockIdx.x - nc_) * NWAVES + F.wave, (F.G - nc_) * NWAVES); } } if (IN(8) && IN(10)) xcd_barrier(bar);
    if (IN(10)) { pg8::Gemm g{X, (const bf16*)(ws + WS_WSSDIN), D, D, (size_t)(WS_WCTX2 - WS_WSSDIN)}; pg8::StaticOrder S; S.init(MT, SSD_INP, F.G, (int)blockIdx.x); S.pe_pm = L / 256;
        pg8::EpiSsdIn E{(bf16*)(ws + WS_Z), (bf16*)(ws + WS_XBCR), (float*)(ws + WS_DTRAW), (const float*)(ws + WS_SSQB), (const float*)(ws + WS_BIASB)};
        pg8::gemm_phase<pg8::EpiSsdIn, pg8::StaticOrder, true, true>(ring, g, S, E);
        idle_round_convert(F, (MT / 256) * (SSD_INP / 256), 18000, MOE_GU_ITEMS); } SEAM(10);
    if (IN(11)) { ph_ssd_conv(F); } SEAM(11);
    if (IN(12)) { ph_ssd_s12(F); } if (IN(12) && IN(14)) xcd_barrier(bar);
    if (IN(14)) { ph_ssd_s3(F); } if (IN(14) && IN(16)) xcd_barrier(bar);
    if (IN(16)) { pg8::Gemm g{(const bf16*)(ws + WS_Z), (const bf16*)(ws + WS_WSSDOUT), DIN, DIN, 0}; pg8::StaticOrder S; S.init(L, D, F.G, (int)blockIdx.x);
        pg8::EpiRes<false> E{X, X, modp(F, 1, 0) + M_G1};
        pg8::gemm_phase<pg8::EpiRes<false>, pg8::StaticOrder, true, true>(ring, g, S, E); } SEAM(16);
    if (F.G >= 256) {
        if (IN(17) && IN(18)) { const int nt_ = ph_moe_route_scatter(F);
            const int dn_cut = moe_dn_idle_cut(F.G, nt_);
            { const int gw_ = F.vcu * NWAVES + F.wave, NGW_ = F.G * NWAVES;
              moe_dn_convert(F, 1900, MOE_DN_ITEMS / 2, gw_, NGW_); moe_dn_convert(F, dn_cut, MOE_DN_ITEMS, gw_, NGW_); } }
        SEAM(18);
    } else {
    if (IN(17)) { ph_moe_route(F); } SEAM(17);
    if (IN(18)) { ph_moe_scatter(F);
        const int dn_cut = moe_dn_idle_cut(F.G, ((LAS int*)F.lds)[512 + 8 + 8] >> 8);
        __syncthreads();
        { const int gw_ = F.vcu * NWAVES + F.wave, NGW_ = F.G * NWAVES;
          moe_dn_convert(F, 1900, MOE_DN_ITEMS / 2, gw_, NGW_); moe_dn_convert(F, dn_cut, MOE_DN_ITEMS, gw_, NGW_); } } SEAM(18);
    }
    if (IN(19) || IN(21)) {
        LAS int* hist = (LAS int*)F.lds; LAS int* cnt = hist + 512; LAS int* seg = cnt + 8;
        pg8::GroupedOrder S;
        if (IN(19)) {
            moe_segments(F, hist, cnt, seg);
            S.nM = seg[8] >> 8; S.nN = 2 * FFE / 256; S.nwg = S.nM * S.nN; S.G = F.G; S.c = (int)blockIdx.x; S.WGM = WGM_MOE_GU;
            S.ts1 = seg[1] >> 8; S.ts2 = seg[2] >> 8; S.ts3 = seg[3] >> 8; S.ts4 = seg[4] >> 8; S.ts5 = seg[5] >> 8; S.ts6 = seg[6] >> 8; S.ts7 = seg[7] >> 8;
            __syncthreads();
            pg8::Gemm g{(const bf16*)(ws + WS_H2S), (const bf16*)(ws + WS_WMOE), D, D, (size_t)2 * FFE * D * 2};
            pg8::EpiSwiGLU E{(bf16*)(ws + WS_ACTM), FFE};
            pg8::gemm_phase<pg8::EpiSwiGLU, pg8::GroupedOrder, true, true>(ring, g, S, E);
            { const int full = S.nwg / F.G, nbusy = S.nwg - full * F.G;
              if ((int)blockIdx.x >= nbusy) moe_dn_convert(F, 7168, moe_dn_idle_cut(F.G, S.nM), ((int)blockIdx.x - nbusy) * NWAVES + F.wave, (F.G - nbusy) * NWAVES); }
        }
        SEAM(19);
        if (IN(21)) {
            __syncthreads();
            moe_segments(F, hist, cnt, seg);
            const int NT = seg[8] >> 8;
            S.nM = NT < 128 ? NT : 128; S.nN = D / 256; S.nwg = S.nM * S.nN; S.G = F.G; S.c = (int)blockIdx.x; S.WGM = WGM_MOE_DN;
            S.ts1 = seg[1] >> 8; S.ts2 = seg[2] >> 8; S.ts3 = seg[3] >> 8; S.ts4 = seg[4] >> 8; S.ts5 = seg[5] >> 8; S.ts6 = seg[6] >> 8; S.ts7 = seg[7] >> 8;
            __syncthreads();
            { pg8::Gemm g{(const bf16*)(ws + WS_ACTM), (const bf16*)(ws + WS_WDA), FFE, FFE, WD_BYTES, (WS_WDB - WS_WDA) - 4 * WD_BYTES};
              pg8::EpiStoreBf16 E{(bf16*)(ws + WS_H2S), D};
              pg8::gemm_phase<pg8::EpiStoreBf16, pg8::GroupedOrder, true, true>(ring, g, S, E); }
            if (NT > 128) {
                pg8::Gemm g{(const bf16*)(ws + WS_ACTM), (const bf16*)(ws + WS_WDA), FFE, 512, WD_BYTES, (WS_WDB - WS_WDA) - 4 * WD_BYTES};
                pg8::SplitGroupedOrder S2{128, NT, D / 256, 7, 512, F.G, (int)blockIdx.x, S.ts1, S.ts2, S.ts3, S.ts4, S.ts5, S.ts6, S.ts7};
                pg8::EpiPart E{(float*)(ws + WS_YPART), 128, 512, 2048};
                pg8::gemm_phase<pg8::EpiPart, pg8::SplitGroupedOrder, true, true>(ring, g, S2, E); }
        }
        SEAM(21);
    } else { SEAM(19); if (IN(20)) { const int gw_ = F.vcu * NWAVES + F.wave, NGW_ = F.G * NWAVES; moe_dn_convert(F, 0, MOE_DN_ITEMS, gw_, NGW_); }
        SEAM(20); SEAM(21); }
    if (IN(22)) { ph_final(F); }
#undef IN
#undef SEAM
}

extern "C" void kernel_launch(void* const* d_in, const int* in_sizes, int n_in, void* d_out, int out_size, void* d_ws, size_t ws_size, hipStream_t stream) {
    static int grid = 0;
    if (grid == 0) {
        if (n_in != 30 || in_sizes[0] != L * D || out_size != L * D || ws_size < WS_END) { fprintf(stderr, "kernel_launch: unexpected shapes (n_in %d, in0 %d, out %d, ws %zu < %zu); nothing launched\n", n_in, n_in > 0 ? in_sizes[0] : -1, out_size, ws_size, (size_t)WS_END); grid = -1; return; }
        int dev = 0, cus = 0, per_cu = 0;
        if (hipGetDevice(&dev) != hipSuccess || hipDeviceGetAttribute(&cus, hipDeviceAttributeMultiprocessorCount, dev) != hipSuccess) { grid = -1; return; }
        if (hipFuncSetAttribute((const void*)mk_fwd, hipFuncAttributeMaxDynamicSharedMemorySize, LDS_BYTES) != hipSuccess) { fprintf(stderr, "kernel_launch: hipFuncSetAttribute failed\n"); grid = -1; return; }
        if (hipOccupancyMaxActiveBlocksPerMultiprocessor(&per_cu, (const void*)mk_fwd, NTHR, LDS_BYTES) != hipSuccess || per_cu < 1)
            fprintf(stderr, "kernel_launch: note: occupancy query reports %d workgroups per CU\n", per_cu);
        (void)hipGetLastError();
        grid = cus;
    }
    if (grid < 0) return;
    if (hipMemsetAsync((char*)d_ws + WS_CTL, 0, CTL_ZERO_BYTES, stream) != hipSuccess) return;
    Args a{};
    for (int i = 0; i < 30; ++i) a.in[i] = (const float*)d_in[i];
    a.out = (float*)d_out; a.ws = (unsigned char*)d_ws;
    if (MK_N_LAUNCHES == 1) { a.ph_lo = 0; a.ph_hi = NPH; hipLaunchKernelGGL(mk_fwd, dim3(grid), dim3(NTHR), LDS_BYTES, stream, a); }
    else { for (int p = 0; p < NPH; ++p) { a.ph_lo = p; a.ph_hi = p + 1; hipLaunchKernelGGL(mk_fwd, dim3(grid), dim3(NTHR), LDS_BYTES, stream, a); } }
}
```
